# Optimizing an MI355X kernel written in HIP

```python
import jax, jax.numpy as jnp
from jax import lax
import numpy as np

D_MODEL = 1024
BATCH = 8
SEQ = 2048
DEPTH = 1

CHUNK = 64
Q_BLOCK = 128
EPS = 1e-6

GLA_HEADS = 4
GLA_DK = 64
GLA_DV = 128
GLA_RANK = 16
GLA_TAU = 16.0
SB_HEADS = 8
SB_DH = 64
MEM_LEN = 256
MEM_HEADS = 4
MEM_DH = D_MODEL // MEM_HEADS
PEER_HEADS = 8
PEER_NKEYS = 128
PEER_N = PEER_NKEYS * PEER_NKEYS
PEER_DQ = 256
PEER_TOPK = 16
PEER_TOK_BLOCK = 128

GLA_QK = GLA_HEADS * GLA_DK
GLA_V = GLA_HEADS * GLA_DV
SB_W = SB_HEADS * SB_DH
MIX_W = GLA_V + SB_W
_SPLIT_SIZES = (GLA_QK, GLA_QK, GLA_V, GLA_V, GLA_RANK, SB_W, SB_W, SB_W)
IN_COLS = sum(_SPLIT_SIZES)

kernel_name = "hybrid_gla_stickbreak_peer_block"


def _rmsnorm(x, g):
    xf = x.astype(jnp.float32)
    y = xf * lax.rsqrt(jnp.mean(xf * xf, axis=-1, keepdims=True) + EPS)
    return (y * g.astype(jnp.float32)).astype(x.dtype)


def _gla(q, k, v, g):
    B_, S_, H, dk = q.shape
    dv = v.shape[-1]
    n = S_ // CHUNK

    def to_chunks(t):
        return t.reshape(B_, n, CHUNK, H, t.shape[-1]).transpose(1, 0, 3, 2, 4)

    qc, kc, vc, gc = (to_chunks(t) for t in (q * (dk ** -0.5), k, v, g))
    causal = jnp.tril(jnp.ones((CHUNK, CHUNK), dtype=bool))

    def step(state, inp):
        q_, k_, v_, g_ = inp
        b = jnp.cumsum(g_.astype(jnp.float32), axis=-2)
        b_last = b[..., -1:, :]
        o_inter = jnp.einsum('bhcd,bhde->bhce', q_ * jnp.exp(b), state)
        diff = b[:, :, :, None, :] - b[:, :, None, :, :]
        decay = jnp.where(causal[:, :, None], jnp.exp(jnp.minimum(diff, 0.0)), 0.0)
        attn = jnp.einsum('bhtd,bhsd,bhtsd->bhts', q_, k_, decay)
        o = o_inter + jnp.einsum('bhts,bhse->bhte', attn, v_)
        new_state = state * jnp.exp(b_last).swapaxes(-1, -2) + jnp.einsum(
            'bhsd,bhse->bhde', k_ * jnp.exp(b_last - b), v_)
        return new_state, o

    state0 = jnp.zeros((B_, H, dk, dv), jnp.float32)
    _, o = lax.scan(step, state0, (qc, kc, vc, gc))
    return o.transpose(1, 0, 3, 2, 4).reshape(B_, S_, H, dv)


def _stick_breaking(q, k, v):
    B_, S_, H, d = q.shape
    qh = q.transpose(0, 2, 1, 3).astype(jnp.float32) * (d ** -0.5)
    kh = k.transpose(0, 2, 1, 3).astype(jnp.float32)
    vh = v.transpose(0, 2, 1, 3).astype(jnp.float32)
    outs = []
    for i in range(S_ // Q_BLOCK):
        start, end = i * Q_BLOCK, (i + 1) * Q_BLOCK
        z = jnp.einsum('bhtd,bhsd->bhts', qh[:, :, start:end], kh[:, :, :end])
        mask = jnp.arange(end)[None, :] < jnp.arange(start, end)[:, None]
        log_1m = jnp.where(mask, jax.nn.log_sigmoid(-z), 0.0)
        suffix = lax.cumsum(log_1m, axis=3, reverse=True) - log_1m
        a = jnp.where(mask, jnp.exp(jax.nn.log_sigmoid(z) + suffix), 0.0)
        outs.append(jnp.einsum('bhts,bhsd->bhtd', a, vh[:, :, :end]))
    o = jnp.concatenate(outs, axis=2)
    return o.transpose(0, 2, 1, 3)


def _mem_xattn(hn, memn, w_q, w_kv, w_o):
    B_, S_, D = hn.shape
    M = memn.shape[1]
    q = (hn @ w_q).reshape(B_, S_, MEM_HEADS, MEM_DH)
    k, v = jnp.split(memn @ w_kv, 2, axis=-1)
    k = k.reshape(B_, M, MEM_HEADS, MEM_DH)
    v = v.reshape(B_, M, MEM_HEADS, MEM_DH)
    s = jnp.einsum('bshd,bmhd->bhsm', q, k).astype(jnp.float32) * (MEM_DH ** -0.5)
    p = jax.nn.softmax(s, axis=-1).astype(v.dtype)
    o = jnp.einsum('bhsm,bmhd->bshd', p, v).reshape(B_, S_, D)
    return o @ w_o


def _peer(xn, w_pq, sub_keys, u, v_emb):
    B_, S_, D = xn.shape
    T = B_ * S_
    H, K = PEER_HEADS, PEER_TOPK
    xt = xn.reshape(T, D)
    q = (xt @ w_pq).reshape(T, H, 2, PEER_DQ // 2)
    s = jnp.einsum('thpd,hpnd->thpn', q, sub_keys).astype(jnp.float32)
    top_s, top_i = lax.top_k(s, K)
    cand_s = top_s[:, :, 0, :, None] + top_s[:, :, 1, None, :]
    cand_i = top_i[:, :, 0, :, None] * PEER_NKEYS + top_i[:, :, 1, None, :]
    best_s, best_j = lax.top_k(cand_s.reshape(T, H, K * K), K)
    expert = jnp.take_along_axis(cand_i.reshape(T, H, K * K), best_j, axis=-1)
    gate = jax.nn.softmax(best_s, axis=-1)

    nb = T // PEER_TOK_BLOCK

    def block(args):
        xb, eb, gb = args
        ub = u[eb]
        act = jax.nn.gelu(jnp.einsum('thkd,td->thk', ub, xb).astype(jnp.float32),
                          approximate=False)
        w = (gb * act).astype(xb.dtype)
        return jnp.einsum('thk,thkd->td', w, v_emb[eb])

    out = lax.map(block, (xt.reshape(nb, PEER_TOK_BLOCK, D),
                          expert.reshape(nb, PEER_TOK_BLOCK, H, K),
                          gate.reshape(nb, PEER_TOK_BLOCK, H, K)))
    return out.reshape(B_, S_, D)


def setup_inputs(seed: int = 0) -> dict:
    key = jax.random.key(seed)
    ks = jax.random.split(key, 24)
    nrm = jax.random.normal
    f32 = jnp.float32
    L, D = DEPTH, D_MODEL

    def gain(k, shape):
        return 1.0 + 0.02 * nrm(k, shape, f32)

    return {
        "x": nrm(ks[0], (BATCH, SEQ, D), f32),
        "mem": nrm(ks[1], (BATCH, MEM_LEN, D), f32),
        "g_mix": gain(ks[2], (L, D)),
        "w_in": nrm(ks[3], (L, D, IN_COLS), f32) * D ** -0.5,
        "w_alpha_up": nrm(ks[4], (L, GLA_RANK, GLA_QK), f32) * GLA_RANK ** -0.5,
        "b_alpha": 0.1 * nrm(ks[5], (L, GLA_QK), f32),
        "g_gla_out": gain(ks[6], (L, GLA_DV)),
        "w_out": nrm(ks[7], (L, MIX_W, D), f32) * MIX_W ** -0.5,
        "g_mem_q": gain(ks[8], (L, D)),
        "g_mem_kv": gain(ks[9], (L, D)),
        "w_mq": nrm(ks[10], (L, D, D), f32) * D ** -0.5,
        "w_mkv": nrm(ks[11], (L, D, 2 * D), f32) * D ** -0.5,
        "w_mo": nrm(ks[12], (L, D, D), f32) * D ** -0.5,
        "g_ffn": gain(ks[13], (L, D)),
        "w_pq": nrm(ks[14], (L, D, PEER_HEADS * PEER_DQ), f32) * D ** -0.5,
        "sub_keys": nrm(ks[15], (L, PEER_HEADS, 2, PEER_NKEYS, PEER_DQ // 2), f32) * (PEER_DQ // 2) ** -0.5,
        "peer_u": nrm(ks[16], (L, PEER_N, D), f32) * D ** -0.5,
        "peer_v": nrm(ks[17], (L, PEER_N, D), f32) * (PEER_HEADS * PEER_TOPK) ** -0.5,
        "g_final": gain(ks[18], (D,)),
    }


def reference(x, mem, g_mix, w_in, w_alpha_up, b_alpha, g_gla_out, w_out,
              g_mem_q, g_mem_kv, w_mq, w_mkv, w_mo, g_ffn, w_pq, sub_keys,
              peer_u, peer_v, g_final):
    B_, S_, D = x.shape
    split_idx = np.cumsum(_SPLIT_SIZES)[:-1].tolist()
    h = x
    for i in range(DEPTH):
        hn = _rmsnorm(h, g_mix[i])
        proj = hn @ w_in[i]
        qg, kg, vg, og, alr, qs, ksb, vs = jnp.split(proj, split_idx, axis=-1)
        log_alpha = jax.nn.log_sigmoid(
            (alr @ w_alpha_up[i] + b_alpha[i]).astype(jnp.float32)) / GLA_TAU
        o_gla = _gla(qg.reshape(B_, S_, GLA_HEADS, GLA_DK),
                     kg.reshape(B_, S_, GLA_HEADS, GLA_DK),
                     vg.reshape(B_, S_, GLA_HEADS, GLA_DV),
                     log_alpha.reshape(B_, S_, GLA_HEADS, GLA_DK))
        o_gla = _rmsnorm(o_gla, g_gla_out[i]).reshape(B_, S_, GLA_V)
        o_gla = o_gla * jax.nn.silu(og.astype(jnp.float32))
        o_sb = _stick_breaking(qs.reshape(B_, S_, SB_HEADS, SB_DH),
                               ksb.reshape(B_, S_, SB_HEADS, SB_DH),
                               vs.reshape(B_, S_, SB_HEADS, SB_DH)).reshape(B_, S_, SB_W)
        mix = jnp.concatenate([o_gla, o_sb], axis=-1).astype(h.dtype)
        h = h + mix @ w_out[i]
        h = h + _mem_xattn(_rmsnorm(h, g_mem_q[i]), _rmsnorm(mem, g_mem_kv[i]),
                           w_mq[i], w_mkv[i], w_mo[i])
        h = h + _peer(_rmsnorm(h, g_ffn[i]), w_pq[i], sub_keys[i], peer_u[i], peer_v[i])
    return _rmsnorm(h, g_final)
```

```cpp
#include <hip/hip_runtime.h>
#include <math.h>
#include <stdint.h>

#define NB 8
#define SEQ 2048
#define DM 1024
#define NTOK (NB * SEQ)
#define INC 3088
#define MEML 256
#define EPSV 1e-6f

__global__ __launch_bounds__(256) void k_rmsnorm(const float* __restrict__ in, const float* __restrict__ g,
                                                 float* __restrict__ out) {
  __shared__ float red[4];
  const int row = blockIdx.x, tid = threadIdx.x;
  const float4 v = *(const float4*)(in + (size_t)row * DM + tid * 4);
  float ss = v.x * v.x + v.y * v.y + v.z * v.z + v.w * v.w;
  for (int o = 32; o > 0; o >>= 1) ss += __shfl_xor(ss, o);
  if ((tid & 63) == 0) red[tid >> 6] = ss;
  __syncthreads();
  const float tot = red[0] + red[1] + red[2] + red[3];
  const float r = rsqrtf(tot * (1.0f / DM) + EPSV);
  const float4 gg = *(const float4*)(g + tid * 4);
  float4 o4;
  o4.x = v.x * r * gg.x; o4.y = v.y * r * gg.y; o4.z = v.z * r * gg.z; o4.w = v.w * r * gg.w;
  *(float4*)(out + (size_t)row * DM + tid * 4) = o4;
}

template <bool RES>
__global__ __launch_bounds__(256) void k_sgemm(const float* __restrict__ A, int lda, const float* __restrict__ B, int ldb,
                                               float* C, int ldc, const float* R, int N, int K) {
  __shared__ float As[16][68];
  __shared__ float Bs[16][68];
  const int bm = blockIdx.y * 64, bn = blockIdx.x * 64;
  const int tid = threadIdx.x, tx = tid & 15, ty = tid >> 4;
  float acc[4][4];
#pragma unroll
  for (int i = 0; i < 4; ++i)
#pragma unroll
    for (int j = 0; j < 4; ++j) acc[i][j] = 0.f;
  const int arow = tid >> 2, akq = (tid & 3) * 4;
  const int bk = tid >> 4, bn4 = (tid & 15) * 4;
  for (int k0 = 0; k0 < K; k0 += 16) {
    const float4 a = *(const float4*)(A + (size_t)(bm + arow) * lda + k0 + akq);
    float4 b = make_float4(0.f, 0.f, 0.f, 0.f);
    if (bn + bn4 < N) b = *(const float4*)(B + (size_t)(k0 + bk) * ldb + bn + bn4);
    __syncthreads();
    As[akq + 0][arow] = a.x; As[akq + 1][arow] = a.y; As[akq + 2][arow] = a.z; As[akq + 3][arow] = a.w;
    *(float4*)&Bs[bk][bn4] = b;
    __syncthreads();
#pragma unroll
    for (int kk = 0; kk < 16; ++kk) {
      const float4 av = *(const float4*)&As[kk][ty * 4];
      const float4 bv = *(const float4*)&Bs[kk][tx * 4];
      const float aa[4] = {av.x, av.y, av.z, av.w};
      const float bb[4] = {bv.x, bv.y, bv.z, bv.w};
#pragma unroll
      for (int i = 0; i < 4; ++i)
#pragma unroll
        for (int j = 0; j < 4; ++j) acc[i][j] = fmaf(aa[i], bb[j], acc[i][j]);
    }
  }
  if (bn + tx * 4 < N) {
#pragma unroll
    for (int i = 0; i < 4; ++i) {
      const size_t off = (size_t)(bm + ty * 4 + i) * ldc + bn + tx * 4;
      float4 o = make_float4(acc[i][0], acc[i][1], acc[i][2], acc[i][3]);
      if (RES) {
        const float4 rr = *(const float4*)(R + off);
        o.x += rr.x; o.y += rr.y; o.z += rr.z; o.w += rr.w;
      }
      *(float4*)(C + off) = o;
    }
  }
}

__device__ __forceinline__ float log_sigmoid_f(float x) { return fminf(x, 0.f) - log1pf(expf(-fabsf(x))); }
__device__ __forceinline__ float softplus_f(float x) { return fmaxf(x, 0.f) + log1pf(expf(-fabsf(x))); }

__global__ __launch_bounds__(256) void k_logalpha(const float* __restrict__ proj, const float* __restrict__ wup,
                                                  const float* __restrict__ balpha, float* __restrict__ la) {
  const int t = blockIdx.x, c = threadIdx.x;
  const float* alr = proj + (size_t)t * INC + 1536;
  float s = balpha[c];
#pragma unroll
  for (int r = 0; r < 16; ++r) s = fmaf(alr[r], wup[r * 256 + c], s);
  la[(size_t)t * 256 + c] = log_sigmoid_f(s) * (1.0f / 16.0f);
}

__global__ __launch_bounds__(256) void k_gla_seq(const float* __restrict__ proj, const float* __restrict__ la,
                                                 float* __restrict__ ogla  ) {
  __shared__ float sq[64], sk[64], sa[64], sv[128], so[2][128];
  const int b = blockIdx.x >> 2, h = blockIdx.x & 3;
  const int tid = threadIdx.x, e = tid & 127, half = tid >> 7;
  float S[32];
#pragma unroll
  for (int i = 0; i < 32; ++i) S[i] = 0.f;
  for (int t = 0; t < SEQ; ++t) {
    const size_t tok = (size_t)b * SEQ + t;
    const float* pr = proj + tok * INC;
    if (tid < 64) {
      sq[tid] = pr[h * 64 + tid] * 0.125f;
      sk[tid] = pr[256 + h * 64 + tid];
      sa[tid] = expf(la[tok * 256 + h * 64 + tid]);
    } else if (tid >= 128) {
      sv[tid - 128] = pr[512 + h * 128 + (tid - 128)];
    }
    __syncthreads();
    const float v = sv[e];
    float o = 0.f;
#pragma unroll
    for (int i = 0; i < 32; ++i) {
      const int d = half * 32 + i;
      S[i] = fmaf(sa[d], S[i], sk[d] * v);
      o = fmaf(sq[d], S[i], o);
    }
    so[half][e] = o;
    __syncthreads();
    if (tid < 128) ogla[tok * 512 + h * 128 + tid] = so[0][tid] + so[1][tid];
  }
}

__global__ __launch_bounds__(128) void k_gla_post(const float* __restrict__ ogla, const float* __restrict__ proj,
                                                  const float* __restrict__ g, float* __restrict__ mix) {
  __shared__ float red[2];
  const int tl = blockIdx.x >> 2, h = blockIdx.x & 3, e = threadIdx.x;
  const float o = ogla[(size_t)tl * 512 + h * 128 + e];
  float ss = o * o;
  for (int k = 32; k > 0; k >>= 1) ss += __shfl_xor(ss, k);
  if ((e & 63) == 0) red[e >> 6] = ss;
  __syncthreads();
  const float r = rsqrtf((red[0] + red[1]) * (1.0f / 128.0f) + EPSV);
  const float og = proj[(size_t)tl * INC + 1024 + h * 128 + e];
  const float sil = og / (1.0f + expf(-og));
  mix[(size_t)tl * DM + h * 128 + e] = o * r * g[e] * sil;
}

__global__ __launch_bounds__(64) void k_sb_naive(const float* __restrict__ proj, float* __restrict__ mix) {
  const int bh = blockIdx.y, b = bh >> 3, h = bh & 7;
  const int t = blockIdx.x * 64 + threadIdx.x;
  const float* base = proj + (size_t)b * SEQ * INC;
  float q[64], o[64];
#pragma unroll
  for (int d = 0; d < 64; d += 4) {
    const float4 v = *(const float4*)(base + (size_t)t * INC + 1552 + h * 64 + d);
    q[d] = v.x * 0.125f; q[d + 1] = v.y * 0.125f; q[d + 2] = v.z * 0.125f; q[d + 3] = v.w * 0.125f;
  }
#pragma unroll
  for (int d = 0; d < 64; ++d) o[d] = 0.f;
  float R = 0.f;
  for (int s = t - 1; s >= 0; --s) {
    const float* kr = base + (size_t)s * INC + 2064 + h * 64;
    const float* vr = base + (size_t)s * INC + 2576 + h * 64;
    float z = 0.f;
#pragma unroll
    for (int d = 0; d < 64; d += 4) {
      const float4 kv = *(const float4*)(kr + d);
      z = fmaf(q[d], kv.x, z); z = fmaf(q[d + 1], kv.y, z); z = fmaf(q[d + 2], kv.z, z); z = fmaf(q[d + 3], kv.w, z);
    }
    const float sp = softplus_f(z);
    const float a = expf(z - sp - R);
    R += sp;
#pragma unroll
    for (int d = 0; d < 64; d += 4) {
      const float4 vv = *(const float4*)(vr + d);
      o[d] = fmaf(a, vv.x, o[d]); o[d + 1] = fmaf(a, vv.y, o[d + 1]);
      o[d + 2] = fmaf(a, vv.z, o[d + 2]); o[d + 3] = fmaf(a, vv.w, o[d + 3]);
    }
  }
  float* op = mix + ((size_t)b * SEQ + t) * DM + 512 + h * 64;
#pragma unroll
  for (int d = 0; d < 64; d += 4) *(float4*)(op + d) = make_float4(o[d], o[d + 1], o[d + 2], o[d + 3]);
}

__global__ __launch_bounds__(256) void k_memattn(const float* __restrict__ qm, const float* __restrict__ kvm,
                                                 float* __restrict__ om) {
  __shared__ float qs[1024];
  __shared__ float ps[256];
  __shared__ float red[8];
  const int t = blockIdx.x, b = t / SEQ, tid = threadIdx.x, lane = tid & 63, w = tid >> 6;
  *(float4*)&qs[tid * 4] = *(const float4*)(qm + (size_t)t * DM + tid * 4);
  __syncthreads();
  for (int h = 0; h < 4; ++h) {
    const float4 qv = *(const float4*)&qs[h * 256 + lane * 4];
    for (int i = 0; i < 64; ++i) {
      const int m = w * 64 + i;
      const float4 kv = *(const float4*)(kvm + (size_t)(b * MEML + m) * 2048 + h * 256 + lane * 4);
      float s = qv.x * kv.x + qv.y * kv.y + qv.z * kv.z + qv.w * kv.w;
      for (int o = 32; o > 0; o >>= 1) s += __shfl_xor(s, o);
      if (lane == 0) ps[m] = s * 0.0625f;
    }
    __syncthreads();
    float s = ps[tid];
    float mx = s;
    for (int o = 32; o > 0; o >>= 1) mx = fmaxf(mx, __shfl_xor(mx, o));
    if (lane == 0) red[w] = mx;
    __syncthreads();
    mx = fmaxf(fmaxf(red[0], red[1]), fmaxf(red[2], red[3]));
    const float e = expf(s - mx);
    float sm = e;
    for (int o = 32; o > 0; o >>= 1) sm += __shfl_xor(sm, o);
    if (lane == 0) red[4 + w] = sm;
    __syncthreads();
    sm = red[4] + red[5] + red[6] + red[7];
    ps[tid] = e / sm;
    __syncthreads();
    float o = 0.f;
    for (int m = 0; m < 256; ++m) o = fmaf(ps[m], kvm[(size_t)(b * MEML + m) * 2048 + 1024 + h * 256 + tid], o);
    om[(size_t)t * DM + h * 256 + tid] = o;
    __syncthreads();
  }
}

__global__ __launch_bounds__(256) void k_peer(const float* xn  , const float* __restrict__ qp,
                                              const float* __restrict__ subk, const float* __restrict__ pu,
                                              const float* __restrict__ pv, const float* __restrict__ h2,
                                              const float* __restrict__ gfin, float* out) {
  __shared__ float xs[1024];
  __shared__ float qs[2048];
  __shared__ float sc[16][128];
  __shared__ float tv[16][16];
  __shared__ int ti[16][16];
  __shared__ float cand[8][256];
  __shared__ float gate[128];
  __shared__ int eid[128];
  __shared__ float wk[128];
  __shared__ float red[4];
  const int t = blockIdx.x, tid = threadIdx.x, lane = tid & 63, w = tid >> 6;
  *(float4*)&xs[tid * 4] = *(const float4*)(xn + (size_t)t * DM + tid * 4);
  *(float4*)&qs[tid * 4] = *(const float4*)(qp + (size_t)t * 2048 + tid * 4);
  *(float4*)&qs[1024 + tid * 4] = *(const float4*)(qp + (size_t)t * 2048 + 1024 + tid * 4);
  __syncthreads();
  for (int idx = tid; idx < 2048; idx += 256) {
    const int hp = idx >> 7, n = idx & 127;
    const float* kr = subk + (size_t)(hp * 128 + n) * 128;
    float s = 0.f;
    for (int d = 0; d < 128; d += 4) {
      const float4 kv = *(const float4*)(kr + d);
      s = fmaf(qs[hp * 128 + d], kv.x, s); s = fmaf(qs[hp * 128 + d + 1], kv.y, s);
      s = fmaf(qs[hp * 128 + d + 2], kv.z, s); s = fmaf(qs[hp * 128 + d + 3], kv.w, s);
    }
    sc[hp][n] = s;
  }
  __syncthreads();
  if (tid < 16) {
    for (int r = 0; r < 16; ++r) {
      float best = -INFINITY; int bi = 0;
      for (int n = 0; n < 128; ++n) { const float v = sc[tid][n]; if (v > best) { best = v; bi = n; } }
      tv[tid][r] = best; ti[tid][r] = bi; sc[tid][bi] = -INFINITY;
    }
  }
  __syncthreads();
  for (int idx = tid; idx < 2048; idx += 256) {
    const int h = idx >> 8, c = idx & 255;
    cand[h][c] = tv[2 * h][c >> 4] + tv[2 * h + 1][c & 15];
  }
  __syncthreads();
  if (tid < 8) {
    const int h = tid;
    float mx = 0.f, sum = 0.f;
    for (int r = 0; r < 16; ++r) {
      float best = -INFINITY; int bj = 0;
      for (int c = 0; c < 256; ++c) { const float v = cand[h][c]; if (v > best) { best = v; bj = c; } }
      cand[h][bj] = -INFINITY;
      if (r == 0) mx = best;
      const float e = expf(best - mx);
      sum += e;
      gate[h * 16 + r] = e;
      eid[h * 16 + r] = ti[2 * h][bj >> 4] * 128 + ti[2 * h + 1][bj & 15];
    }
    const float inv = 1.0f / sum;
    for (int r = 0; r < 16; ++r) gate[h * 16 + r] *= inv;
  }
  __syncthreads();
  for (int k = w; k < 128; k += 4) {
    const float* ur = pu + (size_t)eid[k] * DM;
    float s = 0.f;
#pragma unroll
    for (int i = 0; i < 4; ++i) {
      const float4 uv = *(const float4*)(ur + i * 256 + lane * 4);
      const float4 xv = *(const float4*)&xs[i * 256 + lane * 4];
      s += uv.x * xv.x + uv.y * xv.y + uv.z * xv.z + uv.w * xv.w;
    }
    for (int o = 32; o > 0; o >>= 1) s += __shfl_xor(s, o);
    if (lane == 0) {
      const float act = 0.5f * s * (1.0f + erff(s * 0.70710678118654752f));
      wk[k] = gate[k] * act;
    }
  }
  __syncthreads();
  float4 acc = *(const float4*)(h2 + (size_t)t * DM + tid * 4);
  for (int k = 0; k < 128; ++k) {
    const float4 vv = *(const float4*)(pv + (size_t)eid[k] * DM + tid * 4);
    const float wv = wk[k];
    acc.x = fmaf(wv, vv.x, acc.x); acc.y = fmaf(wv, vv.y, acc.y);
    acc.z = fmaf(wv, vv.z, acc.z); acc.w = fmaf(wv, vv.w, acc.w);
  }
  float ss = acc.x * acc.x + acc.y * acc.y + acc.z * acc.z + acc.w * acc.w;
  for (int o = 32; o > 0; o >>= 1) ss += __shfl_xor(ss, o);
  if (lane == 0) red[w] = ss;
  __syncthreads();
  const float r = rsqrtf((red[0] + red[1] + red[2] + red[3]) * (1.0f / DM) + EPSV);
  const float4 gg = *(const float4*)(gfin + tid * 4);
  *(float4*)(out + (size_t)t * DM + tid * 4) =
      make_float4(acc.x * r * gg.x, acc.y * r * gg.y, acc.z * r * gg.z, acc.w * r * gg.w);
}

extern "C" void kernel_launch(void* const* d_in, const int* in_sizes, int n_in, void* d_out, int out_size, void* d_ws,
                              size_t ws_size, hipStream_t stream) {
  const float* x = (const float*)d_in[0];
  const float* mem = (const float*)d_in[1];
  const float* g_mix = (const float*)d_in[2];
  const float* w_in = (const float*)d_in[3];
  const float* w_up = (const float*)d_in[4];
  const float* b_alpha = (const float*)d_in[5];
  const float* g_gla = (const float*)d_in[6];
  const float* w_out = (const float*)d_in[7];
  const float* g_mq = (const float*)d_in[8];
  const float* g_mkv = (const float*)d_in[9];
  const float* w_mq = (const float*)d_in[10];
  const float* w_mkv = (const float*)d_in[11];
  const float* w_mo = (const float*)d_in[12];
  const float* g_ffn = (const float*)d_in[13];
  const float* w_pq = (const float*)d_in[14];
  const float* subk = (const float*)d_in[15];
  const float* pu = (const float*)d_in[16];
  const float* pv = (const float*)d_in[17];
  const float* g_fin = (const float*)d_in[18];
  float* out = (float*)d_out;
  float* ws = (float*)d_ws;
  const size_t M16 = (size_t)16 * 1024 * 1024;
  float* hbuf = ws;
  float* mix = ws + M16;
  float* big = ws + 2 * M16;
  float* hn = out;

  k_rmsnorm<<<NTOK, 256, 0, stream>>>(x, g_mix, hn);
  const int HT = NTOK / 2;
  float* projh = big;
  float* lah = big + (size_t)HT * INC;
  float* oglah = lah + (size_t)HT * 256;
  for (int half = 0; half < 2; ++half) {
    const size_t t0 = (size_t)half * HT;
    k_sgemm<false><<<dim3((INC + 63) / 64, HT / 64), 256, 0, stream>>>(hn + t0 * DM, DM, w_in, INC, projh, INC, nullptr,
                                                                       INC, DM);
    k_logalpha<<<HT, 256, 0, stream>>>(projh, w_up, b_alpha, lah);
    k_gla_seq<<<16, 256, 0, stream>>>(projh, lah, oglah);
    k_gla_post<<<HT * 4, 128, 0, stream>>>(oglah, projh, g_gla, mix + t0 * DM);
    k_sb_naive<<<dim3(SEQ / 64, 32), 64, 0, stream>>>(projh, mix + t0 * DM);
  }
  k_sgemm<true><<<dim3(DM / 64, NTOK / 64), 256, 0, stream>>>(mix, DM, w_out, DM, hbuf, DM, x, DM, DM);
  float* qm = big;
  float* memn = big + M16;
  float* kvm = memn + (size_t)2 * 1024 * 1024;
  float* om = mix;
  k_rmsnorm<<<NTOK, 256, 0, stream>>>(hbuf, g_mq, hn);
  k_sgemm<false><<<dim3(DM / 64, NTOK / 64), 256, 0, stream>>>(hn, DM, w_mq, DM, qm, DM, nullptr, DM, DM);
  k_rmsnorm<<<NB * MEML, 256, 0, stream>>>(mem, g_mkv, memn);
  k_sgemm<false><<<dim3(2048 / 64, NB * MEML / 64), 256, 0, stream>>>(memn, DM, w_mkv, 2048, kvm, 2048, nullptr, 2048, DM);
  k_memattn<<<NTOK, 256, 0, stream>>>(qm, kvm, om);
  k_sgemm<true><<<dim3(DM / 64, NTOK / 64), 256, 0, stream>>>(om, DM, w_mo, DM, hbuf, DM, hbuf, DM, DM);
  float* qp = big;
  k_rmsnorm<<<NTOK, 256, 0, stream>>>(hbuf, g_ffn, hn);
  k_sgemm<false><<<dim3(2048 / 64, NTOK / 64), 256, 0, stream>>>(hn, DM, w_pq, 2048, qp, 2048, nullptr, 2048, DM);
  k_peer<<<NTOK, 256, 0, stream>>>(hn, qp, subk, pu, pv, hbuf, g_fin, out);
}
```

```cpp
#include <hip/hip_runtime.h>
#include <hip/hip_cooperative_groups.h>
#include <math.h>
#include <stdio.h>
#include <stdint.h>
namespace cg = cooperative_groups;

#define NB 8
#define SEQ 2048
#define DM 1024
#define NTOK (NB * SEQ)
#define INC 3088
#define MEML 256
#define EPSV 1e-6f

typedef __attribute__((ext_vector_type(8))) __bf16 bf8;
typedef __attribute__((ext_vector_type(4))) __bf16 bf4;
typedef __attribute__((ext_vector_type(2))) __bf16 bf2;
typedef __attribute__((ext_vector_type(16))) float f16v;
typedef __attribute__((ext_vector_type(8))) float f8v;
typedef __attribute__((ext_vector_type(4))) float f4v;
typedef __attribute__((ext_vector_type(2))) float f2v;
typedef unsigned short u16;

#define DI __device__ __forceinline__
#define MFMA(a, b, c) __builtin_amdgcn_mfma_f32_32x32x16_bf16((a), (b), (c), 0, 0, 0)

DI int crow(int i, int h) { return (i & 3) + 8 * (i >> 2) + 4 * h; }
DI int tpos(int t) { return (t & ~12) | ((t & 4) << 1) | ((t & 8) >> 1); }
DI float bf2f(u16 v) { return __uint_as_float(((unsigned)v) << 16); }
DI bf8 cvt8(f8v v) { return __builtin_convertvector(v, bf8); }
DI bf4 cvt4(f4v v) { return __builtin_convertvector(v, bf4); }
DI f16v zero16() { f16v z = {0.f, 0.f, 0.f, 0.f, 0.f, 0.f, 0.f, 0.f, 0.f, 0.f, 0.f, 0.f, 0.f, 0.f, 0.f, 0.f}; return z; }

#define MiB ((size_t)1 << 20)
#define OFF_WIN   ((size_t)0)
#define OFF_WOUT  (OFF_WIN + 97 * 65536)
#define OFF_WMQ   (OFF_WOUT + 32 * 65536)
#define OFF_WMKV  (OFF_WMQ + 32 * 65536)
#define OFF_WMO   (OFF_WMKV + 64 * 65536)
#define OFF_WPQ   (OFF_WMO + 32 * 65536)
#define OFF_SUBK  (OFF_WPQ + 64 * 65536)
#define OFF_ACT   (21 * MiB)
#define OFF_GQ    (OFF_ACT)
#define OFF_GK    (OFF_GQ + 8 * MiB)
#define OFF_GVT   (OFF_GK + 8 * MiB)
#define OFF_OG    (OFF_GVT + 16 * MiB)
#define OFF_SQ    (OFF_OG + 16 * MiB)
#define OFF_SK    (OFF_SQ + 16 * MiB)
#define OFF_SVT   (OFF_SK + 16 * MiB)
#define OFF_LA    (OFF_SVT + 16 * MiB)
#define OFF_LKV   (OFF_LA + 16 * MiB)
#define OFF_DD    (OFF_LKV + 32 * MiB)
#define OFF_OSB   (OFF_DD + 1 * MiB)
#define OFF_KM    (OFF_OSB + 16 * MiB)
#define OFF_VMT   (OFF_KM + 4 * MiB)
#define OFF_PU    (OFF_VMT + 4 * MiB)
#define OFF_PV    (OFF_PU + 32 * MiB)
#define OFF_SS    (OFF_LA)

#define LDS_ROW 2064
#define LDS_A_BYTES (64 * LDS_ROW)

struct MKParams {
  const float *x, *mem, *g_mix, *w_in, *w_up, *b_alpha, *g_gla, *w_out, *g_mq, *g_mkv, *w_mq, *w_mkv, *w_mo, *g_ffn, *w_pq,
      *subk, *pu, *pv, *g_fin;
  float* out;
  char* ws;
};
extern __shared__ __attribute__((aligned(16))) char smem[];

template <typename ColFn>
DI void prep_w(bf8* dst, const float* __restrict__ W, int ldw, int ntiles, const float* __restrict__ gain, ColFn colfn,
               int gtid, int gthreads) {
  const int total = ntiles * 4096;
  for (int u = gtid; u < total; u += gthreads) {
    const int lane = u & 63, ks = (u >> 6) & 63, nt = u >> 12;
    const int r = lane & 31, h = lane >> 5;
    float sc = 1.f;
    const int col = colfn(32 * nt + r, sc);
    f8v v;
#pragma unroll
    for (int j = 0; j < 8; ++j) {
      const int k = 16 * ks + 8 * h + j;
      float val = 0.f;
      if (col >= 0) val = W[(size_t)k * ldw + col] * sc * (gain ? gain[k] : 1.f);
      v[j] = val;
    }
    dst[u] = cvt8(v);
  }
}

DI void phase_prep(const MKParams& p, int gtid, int gthreads) {
  char* ws = p.ws;
  prep_w((bf8*)(ws + OFF_WIN), p.w_in, INC, 97, p.g_mix,
         [](int n, float& sc) -> int {
           if (n < 256) { sc = 0.125f; return n; }
           if (n < 1536) return n;
           if (n < 2048) { sc = 0.125f; return n + 16; }
           if (n < 3072) return n + 16;
           if (n < 3088) return n - 1536;
           return -1;
         }, gtid, gthreads);
  prep_w((bf8*)(ws + OFF_WOUT), p.w_out, 1024, 32, nullptr, [](int n, float& sc) -> int { return n; }, gtid, gthreads);
  prep_w((bf8*)(ws + OFF_WMQ), p.w_mq, 1024, 32, p.g_mq, [](int n, float& sc) -> int { sc = 0.0625f; return n; }, gtid, gthreads);
  prep_w((bf8*)(ws + OFF_WMKV), p.w_mkv, 2048, 64, p.g_mkv, [](int n, float& sc) -> int { return n; }, gtid, gthreads);
  prep_w((bf8*)(ws + OFF_WMO), p.w_mo, 1024, 32, nullptr, [](int n, float& sc) -> int { return n; }, gtid, gthreads);
  prep_w((bf8*)(ws + OFF_WPQ), p.w_pq, 2048, 64, p.g_ffn, [](int n, float& sc) -> int { return n; }, gtid, gthreads);
  {
    bf8* dst = (bf8*)(ws + OFF_SUBK);
    const int total = 16 * 4 * 8 * 64;
    for (int u = gtid; u < total; u += gthreads) {
      const int lane = u & 63, ks = (u >> 6) & 7, mt = (u >> 9) & 3, hp = u >> 11;
      const int r = lane & 31, h = lane >> 5;
      const float* s = p.subk + ((size_t)(hp * 128 + 32 * mt + r)) * 128 + 16 * ks + 8 * h;
      const f4v a = *(const f4v*)s, b = *(const f4v*)(s + 4);
      f8v v = {a[0], a[1], a[2], a[3], b[0], b[1], b[2], b[3]};
      dst[u] = cvt8(v);
    }
  }
}

DI void phase_prep_tables(const MKParams& p, int gtid, int gthreads) {
  bf8* du = (bf8*)(p.ws + OFF_PU);
  bf8* dv = (bf8*)(p.ws + OFF_PV);
  const int total = 16384 * 128;
  for (int u = gtid; u < total; u += gthreads) {
    const int d0 = (u & 127) * 8;
    const f4v g0 = *(const f4v*)(p.g_ffn + d0), g1 = *(const f4v*)(p.g_ffn + d0 + 4);
    const f4v a = *(const f4v*)(p.pu + (size_t)u * 8), b = *(const f4v*)(p.pu + (size_t)u * 8 + 4);
    f8v v = {a[0] * g0[0], a[1] * g0[1], a[2] * g0[2], a[3] * g0[3], b[0] * g1[0], b[1] * g1[1], b[2] * g1[2], b[3] * g1[3]};
    du[u] = cvt8(v);
    const f4v c = *(const f4v*)(p.pv + (size_t)u * 8), d = *(const f4v*)(p.pv + (size_t)u * 8 + 4);
    f8v w = {c[0], c[1], c[2], c[3], d[0], d[1], d[2], d[3]};
    dv[u] = cvt8(w);
  }
}

DI void load_norm_tile(const float* __restrict__ src, char* ldsA, int wave, int lane) {
#pragma unroll 2
  for (int i = 0; i < 8; ++i) {
    const int row = 8 * wave + i;
    const f4v* pr = (const f4v*)(src + (size_t)row * DM);
    f4v v[4];
#pragma unroll
    for (int c = 0; c < 4; ++c) v[c] = pr[lane + 64 * c];
    float ss = 0.f;
#pragma unroll
    for (int c = 0; c < 4; ++c) ss += v[c][0] * v[c][0] + v[c][1] * v[c][1] + v[c][2] * v[c][2] + v[c][3] * v[c][3];
#pragma unroll
    for (int o = 32; o > 0; o >>= 1) ss += __shfl_xor(ss, o);
    const float rs = rsqrtf(ss * (1.0f / DM) + EPSV);
#pragma unroll
    for (int c = 0; c < 4; ++c) {
      f4v t = v[c] * rs;
      *(bf4*)(ldsA + row * LDS_ROW + (lane * 4 + 256 * c) * 2) = cvt4(t);
    }
  }
}

#define GEMM_PF 4
template <bool SWAP, bool RES = false>
DI void gemm_chunk(const char* ldsA, const bf8* __restrict__ wf, int lane, f16v (&acc)[2][2], const float* res = nullptr) {
  __builtin_amdgcn_sched_barrier(0);
  const int r = lane & 31, h = lane >> 5;
  const char* xa0 = ldsA + r * LDS_ROW + h * 16;
  const char* xa1 = xa0 + 32 * LDS_ROW;
  const bf8* w0p = wf + lane;
  const bf8* w1p = wf + 64 * 64 + lane;
  if (RES) {
#pragma unroll
    for (int ntl = 0; ntl < 2; ++ntl)
#pragma unroll
      for (int tt = 0; tt < 2; ++tt)
#pragma unroll
        for (int g = 0; g < 4; ++g) {
          const f4v x = *(const f4v*)(res + (size_t)(32 * tt + r) * DM + 32 * ntl + 8 * g + 4 * h);
          acc[ntl][tt][4 * g] = x[0]; acc[ntl][tt][4 * g + 1] = x[1]; acc[ntl][tt][4 * g + 2] = x[2]; acc[ntl][tt][4 * g + 3] = x[3];
        }
  } else {
    acc[0][0] = zero16(); acc[0][1] = zero16(); acc[1][0] = zero16(); acc[1][1] = zero16();
  }
  bf8 w0[GEMM_PF], w1[GEMM_PF];
#pragma unroll
  for (int i = 0; i < GEMM_PF; ++i) { w0[i] = w0p[i * 64]; w1[i] = w1p[i * 64]; }
#pragma unroll 1
  for (int ks0 = 0; ks0 < 64 - GEMM_PF; ks0 += GEMM_PF) {
#pragma unroll
    for (int i = 0; i < GEMM_PF; ++i) {
      const int ks = ks0 + i;
      const bf8 a0 = w0[i], a1 = w1[i];
      w0[i] = w0p[(ks + GEMM_PF) * 64];
      w1[i] = w1p[(ks + GEMM_PF) * 64];
      const bf8 x0 = *(const bf8*)(xa0 + ks * 32);
      const bf8 x1 = *(const bf8*)(xa1 + ks * 32);
      if (SWAP) {
        acc[0][0] = MFMA(a0, x0, acc[0][0]); acc[0][1] = MFMA(a0, x1, acc[0][1]);
        acc[1][0] = MFMA(a1, x0, acc[1][0]); acc[1][1] = MFMA(a1, x1, acc[1][1]);
      } else {
        acc[0][0] = MFMA(x0, a0, acc[0][0]); acc[0][1] = MFMA(x1, a0, acc[0][1]);
        acc[1][0] = MFMA(x0, a1, acc[1][0]); acc[1][1] = MFMA(x1, a1, acc[1][1]);
      }
    }
  }
#pragma unroll
  for (int i = 0; i < GEMM_PF; ++i) {
    const int ks = 64 - GEMM_PF + i;
    const bf8 a0 = w0[i], a1 = w1[i];
    const bf8 x0 = *(const bf8*)(xa0 + ks * 32);
    const bf8 x1 = *(const bf8*)(xa1 + ks * 32);
    if (SWAP) {
      acc[0][0] = MFMA(a0, x0, acc[0][0]); acc[0][1] = MFMA(a0, x1, acc[0][1]);
      acc[1][0] = MFMA(a1, x0, acc[1][0]); acc[1][1] = MFMA(a1, x1, acc[1][1]);
    } else {
      acc[0][0] = MFMA(x0, a0, acc[0][0]); acc[0][1] = MFMA(x1, a0, acc[0][1]);
      acc[1][0] = MFMA(x0, a1, acc[1][0]); acc[1][1] = MFMA(x1, a1, acc[1][1]);
    }
  }
}

DI void store_swap_bf16(u16* dst, size_t ld, const f16v (&acc)[2][2], int lane) {
  const int r = lane & 31, h = lane >> 5;
#pragma unroll
  for (int ntl = 0; ntl < 2; ++ntl)
#pragma unroll
    for (int tt = 0; tt < 2; ++tt)
#pragma unroll
      for (int g = 0; g < 4; ++g) {
        f4v v = {acc[ntl][tt][4 * g], acc[ntl][tt][4 * g + 1], acc[ntl][tt][4 * g + 2], acc[ntl][tt][4 * g + 3]};
        *(bf4*)(dst + (size_t)(32 * tt + r) * ld + 32 * ntl + 8 * g + 4 * h) = cvt4(v);
      }
}
DI void store_vt_bf16(u16* dst, size_t ld, const f16v (&acc)[2][2], int lane) {
  const int r = lane & 31, h = lane >> 5;
#pragma unroll
  for (int ntl = 0; ntl < 2; ++ntl)
#pragma unroll
    for (int tt = 0; tt < 2; ++tt)
#pragma unroll
      for (int s = 0; s < 2; ++s) {
        f8v v;
#pragma unroll
        for (int j = 0; j < 8; ++j) v[j] = acc[ntl][tt][8 * s + j];
        *(bf8*)(dst + (size_t)(32 * ntl + r) * ld + 32 * tt + 16 * s + 8 * h) = cvt8(v);
      }
}

DI float log_sigmoid_acc(float x) { return fminf(x, 0.f) - log1pf(expf(-fabsf(x))); }

DI void phase_a_tile(const MKParams& p, int tile, int wave, int lane) {
  asm volatile("" : "+v"(lane));
  char* ws = p.ws;
  char* ldsA = smem;
  float* alr_s = (float*)(smem + LDS_A_BYTES);
  const int b = tile >> 5, c = tile & 31;
  const size_t tok0 = (size_t)tile * 64;
  __syncthreads();
  load_norm_tile(p.x + tok0 * DM, ldsA, wave, lane);
  __syncthreads();
  const bf8* wf = (const bf8*)(ws + OFF_WIN);
  f16v acc[2][2];
  const int t0 = c * 64;
  gemm_chunk<true>(ldsA, wf + (size_t)(0 * 16 + 2 * wave) * 4096, lane, acc);
  {
    u16* base = (u16*)(ws + (wave < 4 ? OFF_GQ : OFF_GK)) + ((size_t)(b * 4 + (wave & 3)) * SEQ + t0) * 64;
    store_swap_bf16(base, 64, acc, lane);
  }
  gemm_chunk<false>(ldsA, wf + (size_t)(1 * 16 + 2 * wave) * 4096, lane, acc);
  {
    u16* base = (u16*)(ws + OFF_GVT) + ((size_t)(b * 4 + (wave >> 1)) * 128 + 64 * (wave & 1)) * SEQ + t0;
    store_vt_bf16(base, SEQ, acc, lane);
  }
  gemm_chunk<true>(ldsA, wf + (size_t)(2 * 16 + 2 * wave) * 4096, lane, acc);
  store_swap_bf16((u16*)(ws + OFF_OG) + tok0 * 512 + 64 * wave, 512, acc, lane);
  gemm_chunk<true>(ldsA, wf + (size_t)(3 * 16 + 2 * wave) * 4096, lane, acc);
  store_swap_bf16((u16*)(ws + OFF_SQ) + ((size_t)(b * 8 + wave) * SEQ + t0) * 64, 64, acc, lane);
  gemm_chunk<true>(ldsA, wf + (size_t)(4 * 16 + 2 * wave) * 4096, lane, acc);
  store_swap_bf16((u16*)(ws + OFF_SK) + ((size_t)(b * 8 + wave) * SEQ + t0) * 64, 64, acc, lane);
  gemm_chunk<false>(ldsA, wf + (size_t)(5 * 16 + 2 * wave) * 4096, lane, acc);
  store_vt_bf16((u16*)(ws + OFF_SVT) + ((size_t)(b * 8 + wave) * 64) * SEQ + t0, SEQ, acc, lane);
  if (wave == 7) {
    const int r = lane & 31, h = lane >> 5;
    const bf8* wp = wf + (size_t)96 * 4096 + lane;
    const char* xa0 = ldsA + r * LDS_ROW + h * 16;
    const char* xa1 = xa0 + 32 * LDS_ROW;
    f16v a0 = zero16(), a1 = zero16();
#pragma unroll 8
    for (int ks = 0; ks < 64; ++ks) {
      const bf8 w = wp[ks * 64];
      a0 = MFMA(w, *(const bf8*)(xa0 + ks * 32), a0);
      a1 = MFMA(w, *(const bf8*)(xa1 + ks * 32), a1);
    }
#pragma unroll
    for (int i = 0; i < 8; ++i) {
      alr_s[(r) * 16 + crow(i, h)] = a0[i];
      alr_s[(32 + r) * 16 + crow(i, h)] = a1[i];
    }
  }
  __syncthreads();
  {
    const int tid = wave * 64 + lane;
    const int tk = tid >> 3, c0 = (tid & 7) * 32;
    float a[16];
#pragma unroll
    for (int rr = 0; rr < 16; ++rr) a[rr] = alr_s[tk * 16 + rr];
    float* dst = (float*)(ws + OFF_LA) + (tok0 + tk) * 256 + c0;
#pragma unroll 4
    for (int cc = 0; cc < 32; ++cc) {
      float s = p.b_alpha[c0 + cc];
#pragma unroll
      for (int rr = 0; rr < 16; ++rr) s = fmaf(a[rr], p.w_up[rr * 256 + c0 + cc], s);
      dst[cc] = log_sigmoid_acc(s) * (1.0f / 16.0f);
    }
  }
}

DI void phase_a_memkv(const MKParams& p, int item, int wave, int lane) {
  asm volatile("" : "+v"(lane));
  char* ws = p.ws;
  char* ldsA = smem;
  const int rt = item >> 2, cc = item & 3;
  const int b = rt >> 2, m0 = (rt & 3) * 64;
  __syncthreads();
  load_norm_tile(p.mem + (size_t)rt * 64 * DM, ldsA, wave, lane);
  __syncthreads();
  const bf8* wf = (const bf8*)(ws + OFF_WMKV);
  f16v acc[2][2];
  if (cc < 2) {
    gemm_chunk<true>(ldsA, wf + (size_t)(cc * 16 + 2 * wave) * 4096, lane, acc);
    const int f0 = 512 * cc + 64 * wave;
    u16* base = (u16*)(ws + OFF_KM) + ((size_t)(b * 4 + (f0 >> 8)) * 256 + m0) * 256 + (f0 & 255);
    store_swap_bf16(base, 256, acc, lane);
  } else {
    gemm_chunk<false>(ldsA, wf + (size_t)(cc * 16 + 2 * wave) * 4096, lane, acc);
    const int f0 = 512 * (cc - 2) + 64 * wave;
    u16* base = (u16*)(ws + OFF_VMT) + ((size_t)(b * 4 + (f0 >> 8)) * 256 + (f0 & 255)) * 256 + m0;
    store_vt_bf16(base, 256, acc, lane);
  }
}
#define SB_THR 30.0f

DI bf8 pack8(const f16v& x, int s) {
  f8v v;
#pragma unroll
  for (int j = 0; j < 8; ++j) v[j] = x[8 * s + j];
  return cvt8(v);
}

DI void sb_item(const MKParams& p, int item, int lane) {
  asm volatile("" : "+v"(lane));
  char* ws = p.ws;
  const int r = lane & 31, h = lane >> 5;
  const int bh = item >> 6, qt = item & 63;
  const u16* SQ = (const u16*)(ws + OFF_SQ) + (size_t)bh * SEQ * 64;
  const u16* SK = (const u16*)(ws + OFF_SK) + (size_t)bh * SEQ * 64;
  const u16* SVT = (const u16*)(ws + OFF_SVT) + (size_t)bh * 64 * SEQ;
  bf8 qf[4];
#pragma unroll
  for (int ks = 0; ks < 4; ++ks) qf[ks] = *(const bf8*)(SQ + (size_t)(32 * qt + r) * 64 + 16 * ks + 8 * h);
  bf8 tri[2];
#pragma unroll
  for (int s = 0; s < 2; ++s) {
    f8v t;
#pragma unroll
    for (int j = 0; j < 8; ++j) t[j] = (16 * s + 8 * (j >> 2) + 4 * h + (j & 3) >= r) ? 1.0f : 0.0f;
    tri[s] = cvt8(t);
  }
  f16v o0 = zero16(), o1 = zero16();
  float R = 0.f;
  for (int kt = qt; kt >= 0; --kt) {
    bf8 kf[4], vf[2][2];
#pragma unroll
    for (int ks = 0; ks < 4; ++ks) kf[ks] = *(const bf8*)(SK + (size_t)(32 * kt + r) * 64 + 16 * ks + 8 * h);
#pragma unroll
    for (int mt = 0; mt < 2; ++mt)
#pragma unroll
      for (int s = 0; s < 2; ++s) vf[mt][s] = *(const bf8*)(SVT + (size_t)(32 * mt + r) * SEQ + 32 * kt + 16 * s + 8 * h);
    f16v z = zero16();
#pragma unroll
    for (int ks = 0; ks < 4; ++ks) z = MFMA(kf[ks], qf[ks], z);
    const bool diag = (kt == qt);
    f16v sp;
    float tot = 0.f;
#pragma unroll
    for (int i = 0; i < 16; ++i) {
      const float zz = z[i];
      const float sv = fmaxf(zz, 0.f) + __logf(1.0f + __expf(-fabsf(zz)));
      const bool valid = !diag || (crow(i, h) < r);
      sp[i] = valid ? sv : 0.f;
      tot += sp[i];
    }
    tot += __shfl_xor(tot, 32);
    f16v C = MFMA(tri[0], pack8(sp, 0), zero16());
    C = MFMA(tri[1], pack8(sp, 1), C);
    f16v a;
#pragma unroll
    for (int i = 0; i < 16; ++i) {
      const bool valid = !diag || (crow(i, h) < r);
      a[i] = valid ? __expf(z[i] - C[i] - R) : 0.f;
    }
    const bf8 a0 = pack8(a, 0), a1 = pack8(a, 1);
    o0 = MFMA(vf[0][0], a0, o0); o0 = MFMA(vf[0][1], a1, o0);
    o1 = MFMA(vf[1][0], a0, o1); o1 = MFMA(vf[1][1], a1, o1);
    R += tot;
    if (__all(R > SB_THR)) break;
  }
  const int b = bh >> 3, hd = bh & 7;
  u16* dst = (u16*)(ws + OFF_OSB) + ((size_t)b * SEQ + 32 * qt + r) * 512 + hd * 64 + 4 * h;
#pragma unroll
  for (int g = 0; g < 4; ++g) {
    f4v v0 = {o0[4 * g], o0[4 * g + 1], o0[4 * g + 2], o0[4 * g + 3]};
    f4v v1 = {o1[4 * g], o1[4 * g + 1], o1[4 * g + 2], o1[4 * g + 3]};
    *(bf4*)(dst + 8 * g) = cvt4(v0);
    *(bf4*)(dst + 32 + 8 * g) = cvt4(v1);
  }
}

DI void gla_g1_item(const MKParams& p, int item, int wave, int lane) {
  asm volatile("" : "+v"(lane));
  char* ws = p.ws;
  const int r = lane & 31, h = lane >> 5;
  const int bh = item >> 5, c = item & 31, b = bh >> 2, hd = bh & 3;
  char* kl = smem + wave * 9216;
  u16* GQ = (u16*)(ws + OFF_GQ) + ((size_t)bh * SEQ + 64 * c) * 64;
  u16* GK = (u16*)(ws + OFF_GK) + ((size_t)bh * SEQ + 64 * c) * 64;
  const float* LA = (const float*)(ws + OFF_LA) + ((size_t)b * SEQ + 64 * c) * 256 + hd * 64;
  float bc = 0.f;
#pragma unroll 1
  for (int g = 0; g < 4; ++g) {
    float la_[16];
    u16 q_[16], k_[16];
#pragma unroll
    for (int i = 0; i < 16; ++i) {
      const int t = 16 * g + i;
      la_[i] = LA[(size_t)t * 256 + lane];
      q_[i] = GQ[t * 64 + lane];
      k_[i] = GK[t * 64 + lane];
    }
#pragma unroll
    for (int i = 0; i < 16; ++i) {
      const int t = 16 * g + i;
      bc += la_[i];
      const float eq = __expf(bc);
      const float qn = bf2f(q_[i]) * eq, kn = bf2f(k_[i]) / eq;
      const bf2 pk = __builtin_convertvector((f2v){qn, kn}, bf2);
      const unsigned u = __builtin_bit_cast(unsigned, pk);
      GQ[t * 64 + lane] = (u16)(u & 0xffff);
      GK[t * 64 + lane] = (u16)(u >> 16);
      *(u16*)(kl + lane * 144 + tpos(t) * 2) = (u16)(u >> 16);
    }
  }
  ((float*)(ws + OFF_DD))[(size_t)item * 64 + lane] = __expf(bc);
  asm volatile("s_waitcnt lgkmcnt(0)" ::: "memory");
  const u16* GVT = (const u16*)(ws + OFF_GVT) + (size_t)bh * 128 * SEQ + 64 * c;
  float* LKV = (float*)(ws + OFF_LKV) + (size_t)item * 128 * 64;
  bf8 kb[2][4];
#pragma unroll
  for (int nt = 0; nt < 2; ++nt)
#pragma unroll
    for (int s = 0; s < 4; ++s) kb[nt][s] = *(const bf8*)(kl + (32 * nt + r) * 144 + (16 * s + 8 * h) * 2);
#pragma unroll 1
  for (int mt = 0; mt < 4; ++mt) {
    f16v a0 = zero16(), a1 = zero16();
#pragma unroll
    for (int s = 0; s < 4; ++s) {
      const bf8 vf = *(const bf8*)(GVT + (size_t)(32 * mt + r) * SEQ + 16 * s + 8 * h);
      a0 = MFMA(vf, kb[0][s], a0);
      a1 = MFMA(vf, kb[1][s], a1);
    }
#pragma unroll
    for (int i = 0; i < 16; ++i) {
      LKV[(32 * mt + crow(i, h)) * 64 + r] = a0[i];
      LKV[(32 * mt + crow(i, h)) * 64 + 32 + r] = a1[i];
    }
  }
  asm volatile("s_waitcnt lgkmcnt(0)" ::: "memory");
}

DI void gla_g2(const MKParams& p, int gtid, int gthreads) {
  char* ws = p.ws;
  for (int u = gtid; u < 32768; u += gthreads) {
    const int oct = u & 7, dv = (u >> 3) & 127, bh = u >> 10;
    f8v S = {0.f, 0.f, 0.f, 0.f, 0.f, 0.f, 0.f, 0.f};
#pragma unroll 4
    for (int c = 0; c < 32; ++c) {
      const size_t item = (size_t)bh * 32 + c;
      *(bf8*)((u16*)(ws + OFF_SS) + (item * 128 + dv) * 64 + oct * 8) = cvt8(S);
      const f8v l = *(const f8v*)((const float*)(ws + OFF_LKV) + (item * 128 + dv) * 64 + oct * 8);
      const f8v d = *(const f8v*)((const float*)(ws + OFF_DD) + item * 64 + oct * 8);
      S = d * (S + l);
    }
  }
}

DI void gla_g3_tile(const MKParams& p, int tile, int wave, int lane, char* dst, int dst_ld) {
  char* ws = p.ws;
  const int r = lane & 31, h = lane >> 5;
  const int b = tile >> 5, c = tile & 31, hd = wave >> 1, tt = wave & 1, bh = b * 4 + hd;
  const u16* GQ = (const u16*)(ws + OFF_GQ) + ((size_t)bh * SEQ + 64 * c) * 64;
  const u16* GK = (const u16*)(ws + OFF_GK) + ((size_t)bh * SEQ + 64 * c) * 64;
  const u16* GVT = (const u16*)(ws + OFF_GVT) + (size_t)bh * 128 * SEQ + 64 * c;
  const u16* SS = (const u16*)(ws + OFF_SS) + ((size_t)(bh * 32 + c) * 128) * 64;
  bf8 qf[4];
#pragma unroll
  for (int ks = 0; ks < 4; ++ks) qf[ks] = *(const bf8*)(GQ + (32 * tt + r) * 64 + 16 * ks + 8 * h);
  bf8 pf[2][2];
#pragma unroll
  for (int kt = 0; kt < 2; ++kt) {
    if (kt <= tt) {
      f16v pt = zero16();
#pragma unroll
      for (int ks = 0; ks < 4; ++ks) {
        const bf8 kf = *(const bf8*)(GK + (32 * kt + r) * 64 + 16 * ks + 8 * h);
        pt = MFMA(kf, qf[ks], pt);
      }
      if (kt == tt) {
#pragma unroll
        for (int i = 0; i < 16; ++i) pt[i] = (crow(i, h) <= r) ? pt[i] : 0.f;
      }
      pf[kt][0] = pack8(pt, 0);
      pf[kt][1] = pack8(pt, 1);
    }
  }
  f16v o[4];
#pragma unroll
  for (int mt = 0; mt < 4; ++mt) {
    o[mt] = zero16();
#pragma unroll
    for (int ks = 0; ks < 4; ++ks) {
      const bf8 sf = *(const bf8*)(SS + (32 * mt + r) * 64 + 16 * ks + 8 * h);
      o[mt] = MFMA(sf, qf[ks], o[mt]);
    }
#pragma unroll
    for (int kt = 0; kt < 2; ++kt) {
      if (kt <= tt) {
#pragma unroll
        for (int s = 0; s < 2; ++s) {
          const bf8 vf = *(const bf8*)(GVT + (size_t)(32 * mt + r) * SEQ + 32 * kt + 16 * s + 8 * h);
          o[mt] = MFMA(vf, pf[kt][s], o[mt]);
        }
      }
    }
  }
  float ss = 0.f;
#pragma unroll
  for (int mt = 0; mt < 4; ++mt)
#pragma unroll
    for (int i = 0; i < 16; ++i) ss += o[mt][i] * o[mt][i];
  ss += __shfl_xor(ss, 32);
  const float rr = rsqrtf(ss * (1.0f / 128.0f) + EPSV);
  const size_t tok = (size_t)tile * 64 + 32 * tt + r;
  const u16* OG = (const u16*)(ws + OFF_OG) + tok * 512 + hd * 128;
#pragma unroll
  for (int mt = 0; mt < 4; ++mt)
#pragma unroll
    for (int g = 0; g < 4; ++g) {
      const int dv0 = 32 * mt + 8 * g + 4 * h;
      const ushort4 og4 = *(const ushort4*)(OG + dv0);
      const f4v gg = *(const f4v*)(p.g_gla + dv0);
      const float og[4] = {bf2f(og4.x), bf2f(og4.y), bf2f(og4.z), bf2f(og4.w)};
      f4v v;
#pragma unroll
      for (int j = 0; j < 4; ++j) v[j] = o[mt][4 * g + j] * rr * gg[j] * (og[j] / (1.0f + __expf(-og[j])));
      *(bf4*)(dst + (size_t)(32 * tt + r) * dst_ld + (hd * 128 + dv0) * 2) = cvt4(v);
    }
}
DI void gemm_1024(const char* ldsA, const bf8* __restrict__ wf, int wave, int lane, f16v (&a0)[2][2], f16v (&a1)[2][2]) {
  gemm_chunk<true>(ldsA, wf + (size_t)(2 * wave) * 4096, lane, a0);
  gemm_chunk<true>(ldsA, wf + (size_t)(16 + 2 * wave) * 4096, lane, a1);
}
DI void gemm_1024_res(const char* ldsA, const bf8* __restrict__ wf, int wave, int lane, f16v (&a0)[2][2], f16v (&a1)[2][2],
                      const float* res) {
  gemm_chunk<true, true>(ldsA, wf + (size_t)(2 * wave) * 4096, lane, a0, res + 64 * wave);
  gemm_chunk<true, true>(ldsA, wf + (size_t)(16 + 2 * wave) * 4096, lane, a1, res + 512 + 64 * wave);
}

DI void store_f32_ssq(const f16v (&a)[2][2], float* dst, int f0, int lane, float (&ssq)[2]) {
  const int r = lane & 31, h = lane >> 5;
#pragma unroll
  for (int ntl = 0; ntl < 2; ++ntl)
#pragma unroll
    for (int tt = 0; tt < 2; ++tt)
#pragma unroll
      for (int g = 0; g < 4; ++g) {
        f4v v = {a[ntl][tt][4 * g], a[ntl][tt][4 * g + 1], a[ntl][tt][4 * g + 2], a[ntl][tt][4 * g + 3]};
        ssq[tt] += v[0] * v[0] + v[1] * v[1] + v[2] * v[2] + v[3] * v[3];
        *(f4v*)(dst + (size_t)(32 * tt + r) * DM + f0 + 32 * ntl + 8 * g + 4 * h) = v;
      }
}

struct Pk { bf4 v[2][2][4]; };
DI void pack_acc(Pk& pk, const f16v (&a)[2][2], float s0, float s1) {
#pragma unroll
  for (int ntl = 0; ntl < 2; ++ntl)
#pragma unroll
    for (int tt = 0; tt < 2; ++tt)
#pragma unroll
      for (int g = 0; g < 4; ++g) {
        const float sc = tt ? s1 : s0;
        f4v v = {a[ntl][tt][4 * g] * sc, a[ntl][tt][4 * g + 1] * sc, a[ntl][tt][4 * g + 2] * sc, a[ntl][tt][4 * g + 3] * sc};
        pk.v[ntl][tt][g] = cvt4(v);
      }
}
DI void pk_to_lds(char* ldsA, const Pk& pk, int f0, int lane) {
  const int r = lane & 31, h = lane >> 5;
#pragma unroll
  for (int ntl = 0; ntl < 2; ++ntl)
#pragma unroll
    for (int tt = 0; tt < 2; ++tt)
#pragma unroll
      for (int g = 0; g < 4; ++g)
        *(bf4*)(ldsA + (32 * tt + r) * LDS_ROW + (f0 + 32 * ntl + 8 * g + 4 * h) * 2) = pk.v[ntl][tt][g];
}

DI void rms_from_partials(float* red, int wave, int lane, const float (&ssq)[2], float& rs0, float& rs1) {
  red[(wave * 2 + 0) * 64 + lane] = ssq[0];
  red[(wave * 2 + 1) * 64 + lane] = ssq[1];
  __syncthreads();
  const int r = lane & 31;
  float t0 = 0.f, t1 = 0.f;
#pragma unroll
  for (int w = 0; w < 8; ++w) {
    t0 += red[(w * 2 + 0) * 64 + r] + red[(w * 2 + 0) * 64 + 32 + r];
    t1 += red[(w * 2 + 1) * 64 + r] + red[(w * 2 + 1) * 64 + 32 + r];
  }
  rs0 = rsqrtf(t0 * (1.0f / DM) + EPSV);
  rs1 = rsqrtf(t1 * (1.0f / DM) + EPSV);
}

DI void mem_attn(const MKParams& p, char* ldsA, int b, int wave, int lane) {
  char* ws = p.ws;
  const int r = lane & 31, h = lane >> 5;
  const int hm = wave >> 1, tt = wave & 1;
  const u16* KM = (const u16*)(ws + OFF_KM) + (size_t)(b * 4 + hm) * 256 * 256;
  const u16* VMT = (const u16*)(ws + OFF_VMT) + (size_t)(b * 4 + hm) * 256 * 256;
  char* qrow = ldsA + (32 * tt + r) * LDS_ROW + hm * 512;
  f16v s[8];
#pragma unroll
  for (int mt = 0; mt < 8; ++mt) s[mt] = zero16();
#pragma unroll 2
  for (int ks = 0; ks < 16; ++ks) {
    const bf8 qf = *(const bf8*)(qrow + (16 * ks + 8 * h) * 2);
#pragma unroll
    for (int mt = 0; mt < 8; ++mt) {
      const bf8 kf = *(const bf8*)(KM + (32 * mt + r) * 256 + 16 * ks + 8 * h);
      s[mt] = MFMA(kf, qf, s[mt]);
    }
  }
  float mx = -INFINITY;
#pragma unroll
  for (int mt = 0; mt < 8; ++mt)
#pragma unroll
    for (int i = 0; i < 16; ++i) mx = fmaxf(mx, s[mt][i]);
  mx = fmaxf(mx, __shfl_xor(mx, 32));
  float l = 0.f;
  bf8 pf[8][2];
#pragma unroll
  for (int mt = 0; mt < 8; ++mt) {
#pragma unroll
    for (int i = 0; i < 16; ++i) { s[mt][i] = __expf(s[mt][i] - mx); l += s[mt][i]; }
    pf[mt][0] = pack8(s[mt], 0);
    pf[mt][1] = pack8(s[mt], 1);
  }
  l += __shfl_xor(l, 32);
  const float inv = 1.0f / l;
#pragma unroll
  for (int grp = 0; grp < 2; ++grp) {
    f16v o[4];
#pragma unroll
    for (int m4 = 0; m4 < 4; ++m4) o[m4] = zero16();
#pragma unroll
    for (int kt = 0; kt < 8; ++kt)
#pragma unroll
      for (int sx = 0; sx < 2; ++sx)
#pragma unroll
        for (int m4 = 0; m4 < 4; ++m4) {
          const bf8 vf = *(const bf8*)(VMT + (32 * (4 * grp + m4) + r) * 256 + 32 * kt + 16 * sx + 8 * h);
          o[m4] = MFMA(vf, pf[kt][sx], o[m4]);
        }
#pragma unroll
    for (int m4 = 0; m4 < 4; ++m4)
#pragma unroll
      for (int g = 0; g < 4; ++g) {
        f4v v = {o[m4][4 * g] * inv, o[m4][4 * g + 1] * inv, o[m4][4 * g + 2] * inv, o[m4][4 * g + 3] * inv};
        *(bf4*)(qrow + (32 * (4 * grp + m4) + 8 * g + 4 * h) * 2) = cvt4(v);
      }
  }
}

DI void phase_c_tile(const MKParams& p, int tile, int wave, int lane, float& rs0, float& rs1) {
  asm volatile("" : "+v"(lane));
  char* ws = p.ws;
  char* ldsA = smem;
  float* red = (float*)(smem + LDS_A_BYTES);
  const size_t tok0 = (size_t)tile * 64;
  const int tid = wave * 64 + lane;
  __syncthreads();
  gla_g3_tile(p, tile, wave, lane, ldsA, LDS_ROW);
  {
    const char* osb = ws + OFF_OSB + tok0 * 1024;
#pragma unroll
    for (int it = 0; it < 8; ++it) {
      const int idx = tid + 512 * it, row = idx >> 6, ch = idx & 63;
      *(uint4*)(ldsA + row * LDS_ROW + 1024 + ch * 16) = *(const uint4*)(osb + (size_t)row * 1024 + ch * 16);
    }
  }
  __syncthreads();
  f16v acc[2][2];
  Pk pk0, pk1;
  float* hdst = p.out + tok0 * DM;
  {
    float ssq[2] = {0.f, 0.f};
    const bf8* wf = (const bf8*)(ws + OFF_WOUT);
    gemm_chunk<true, true>(ldsA, wf + (size_t)(2 * wave) * 4096, lane, acc, p.x + tok0 * DM + 64 * wave);
    store_f32_ssq(acc, hdst, 64 * wave, lane, ssq);
    pack_acc(pk0, acc, 1.f, 1.f);
    gemm_chunk<true, true>(ldsA, wf + (size_t)(16 + 2 * wave) * 4096, lane, acc, p.x + tok0 * DM + 512 + 64 * wave);
    store_f32_ssq(acc, hdst, 512 + 64 * wave, lane, ssq);
    pack_acc(pk1, acc, 1.f, 1.f);
    rms_from_partials(red, wave, lane, ssq, rs0, rs1);
  }
  pk_to_lds(ldsA, pk0, 64 * wave, lane);
  pk_to_lds(ldsA, pk1, 512 + 64 * wave, lane);
  __syncthreads();
  {
    const bf8* wf = (const bf8*)(ws + OFF_WMQ);
    gemm_chunk<true>(ldsA, wf + (size_t)(2 * wave) * 4096, lane, acc);
    pack_acc(pk0, acc, rs0, rs1);
    gemm_chunk<true>(ldsA, wf + (size_t)(16 + 2 * wave) * 4096, lane, acc);
    pack_acc(pk1, acc, rs0, rs1);
  }
  __syncthreads();
  pk_to_lds(ldsA, pk0, 64 * wave, lane);
  pk_to_lds(ldsA, pk1, 512 + 64 * wave, lane);
  __syncthreads();
  mem_attn(p, ldsA, tile >> 5, wave, lane);
  __syncthreads();
  {
    float ssq[2] = {0.f, 0.f};
    const bf8* wf = (const bf8*)(ws + OFF_WMO);
    gemm_chunk<true, true>(ldsA, wf + (size_t)(2 * wave) * 4096, lane, acc, hdst + 64 * wave);
    store_f32_ssq(acc, hdst, 64 * wave, lane, ssq);
    pack_acc(pk0, acc, 1.f, 1.f);
    gemm_chunk<true, true>(ldsA, wf + (size_t)(16 + 2 * wave) * 4096, lane, acc, hdst + 512 + 64 * wave);
    store_f32_ssq(acc, hdst, 512 + 64 * wave, lane, ssq);
    pack_acc(pk1, acc, 1.f, 1.f);
    rms_from_partials(red, wave, lane, ssq, rs0, rs1);
  }
  pk_to_lds(ldsA, pk0, 64 * wave, lane);
  pk_to_lds(ldsA, pk1, 512 + 64 * wave, lane);
  __syncthreads();
}
#define OFF_EG (OFF_LKV + 16 * MiB)
DI char* qp_scratch(char* ws, int blk) {
  return blk < 192 ? ws + OFF_SQ + (size_t)blk * 262144 : ws + OFF_LKV + (size_t)(blk - 192) * 262144;
}

DI unsigned f2ord(float v) { const unsigned u = __float_as_uint(v); return (u & 0x80000000u) ? ~u : (u | 0x80000000u); }
DI float ord2f(unsigned u) { return __uint_as_float((u & 0x80000000u) ? (u ^ 0x80000000u) : ~u); }

DI void ins16(unsigned (&L)[16], unsigned x) {
#pragma unroll
  for (int s = 0; s < 16; ++s) {
    const unsigned hi = max(L[s], x);
    x = min(L[s], x);
    L[s] = hi;
  }
}
DI void merge_halves16(unsigned (&L)[16]) {
  unsigned O[16];
#pragma unroll
  for (int s = 0; s < 16; ++s) O[s] = (unsigned)__shfl_xor((int)L[s], 32);
#pragma unroll
  for (int s = 0; s < 16; ++s) L[s] = max(L[s], O[15 - s]);
#pragma unroll
  for (int d = 8; d > 0; d >>= 1)
#pragma unroll
    for (int i = 0; i < 16; ++i)
      if ((i & d) == 0) {
        const unsigned hi = max(L[i], L[i + d]), lo = min(L[i], L[i + d]);
        L[i] = hi; L[i + d] = lo;
      }
}

DI void peer_top16(const char* ws, const u16* qp, int hp, int tt, int lane, unsigned (&L)[16]) {
  const int r = lane & 31, h = lane >> 5;
  const bf8* sk = (const bf8*)(ws + OFF_SUBK) + (size_t)hp * 4 * 8 * 64 + lane;
  f16v s[4];
#pragma unroll
  for (int mt = 0; mt < 4; ++mt) s[mt] = zero16();
#pragma unroll
  for (int ks = 0; ks < 8; ++ks) {
    const bf8 qf = *(const bf8*)(qp + (size_t)(32 * tt + r) * 2048 + hp * 128 + 16 * ks + 8 * h);
#pragma unroll
    for (int mt = 0; mt < 4; ++mt) s[mt] = MFMA(sk[(mt * 8 + ks) * 64], qf, s[mt]);
  }
#pragma unroll
  for (int i = 0; i < 16; ++i) L[i] = 0u;
#pragma unroll
  for (int mt = 0; mt < 4; ++mt)
#pragma unroll
    for (int i = 0; i < 16; ++i) {
      const unsigned key = (f2ord(s[mt][i]) & ~127u) | (unsigned)(127 - (32 * mt + crow(i, h)));
      ins16(L, key);
    }
  merge_halves16(L);
}

DI void peer_select(const char* ws, const u16* qp, uint2* eg, unsigned char* idxs  , int head,
                    int tt, int lane) {
  const int r = lane & 31, h = lane >> 5;
  unsigned La[16], Lb[16];
  peer_top16(ws, qp, 2 * head, tt, lane, La);
  __builtin_amdgcn_sched_barrier(0);
  peer_top16(ws, qp, 2 * head + 1, tt, lane, Lb);
  __builtin_amdgcn_sched_barrier(0);
  if (h == 0) {
#pragma unroll
    for (int g = 0; g < 4; ++g) {
      unsigned wa = 0, wb = 0;
#pragma unroll
      for (int j = 0; j < 4; ++j) {
        wa |= (127u - (La[4 * g + j] & 127u)) << (8 * j);
        wb |= (127u - (Lb[4 * g + j] & 127u)) << (8 * j);
      }
      *(unsigned*)(idxs + r * 32 + 4 * g) = wa;
      *(unsigned*)(idxs + r * 32 + 16 + 4 * g) = wb;
    }
  }
  float fa[16], fb[16];
#pragma unroll
  for (int i = 0; i < 16; ++i) { fa[i] = ord2f(La[i] & ~127u); fb[i] = ord2f(Lb[i] & ~127u); }
  unsigned C[16];
#pragma unroll
  for (int i = 0; i < 16; ++i) C[i] = 0u;
#define PEER_CAND(a, b) ins16(C, (f2ord(fa[a] + fb[b]) & ~255u) | (unsigned)(255 - ((a) * 16 + (b))));
#define PEER_ROW1(a) PEER_CAND(a, 0)
#define PEER_ROW2(a) PEER_ROW1(a) PEER_CAND(a, 1)
#define PEER_ROW3(a) PEER_ROW2(a) PEER_CAND(a, 2)
#define PEER_ROW4(a) PEER_ROW3(a) PEER_CAND(a, 3)
#define PEER_ROW5(a) PEER_ROW4(a) PEER_CAND(a, 4)
#define PEER_ROW8(a) PEER_ROW5(a) PEER_CAND(a, 5) PEER_CAND(a, 6) PEER_CAND(a, 7)
#define PEER_ROW16(a) PEER_ROW8(a) PEER_CAND(a, 8) PEER_CAND(a, 9) PEER_CAND(a, 10) PEER_CAND(a, 11) PEER_CAND(a, 12) PEER_CAND(a, 13) PEER_CAND(a, 14) PEER_CAND(a, 15)
  PEER_ROW16(0) PEER_ROW8(1) PEER_ROW5(2) PEER_ROW4(3) PEER_ROW3(4) PEER_ROW2(5) PEER_ROW2(6) PEER_ROW2(7)
  PEER_ROW1(8) PEER_ROW1(9) PEER_ROW1(10) PEER_ROW1(11) PEER_ROW1(12) PEER_ROW1(13) PEER_ROW1(14) PEER_ROW1(15)
  asm volatile("s_waitcnt lgkmcnt(0)" ::: "memory");
  const float vmax = ord2f(C[0] & ~255u);
  float ex[16], sum = 0.f;
#pragma unroll
  for (int i = 0; i < 16; ++i) { ex[i] = __expf(ord2f(C[i] & ~255u) - vmax); sum += ex[i]; }
  const float inv = 1.0f / sum;
  const unsigned hmask = 0u - (unsigned)h;
#pragma unroll
  for (int i = 0; i < 8; ++i) {
    const unsigned ck = C[i] ^ ((C[i] ^ C[8 + i]) & hmask);
    const unsigned gb = __float_as_uint(ex[i]) ^ ((__float_as_uint(ex[i]) ^ __float_as_uint(ex[8 + i])) & hmask);
    const float g = __uint_as_float(gb) * inv;
    const unsigned code = 255u - (ck & 255u);
    const unsigned ia = idxs[r * 32 + (code >> 4)], ib = idxs[r * 32 + 16 + (code & 15u)];
    eg[(size_t)(32 * tt + r) * 128 + head * 16 + 8 * h + i] = make_uint2(ia * 128u + ib, __float_as_uint(g));
  }
  asm volatile("s_waitcnt lgkmcnt(0)" ::: "memory");
}

DI float wave_sum(float v) {
#pragma unroll
  for (int o = 32; o > 0; o >>= 1) v += __shfl_xor(v, o);
  return v;
}

DI void peer_gather_token(const MKParams& p, const char* ldsA, const uint2* eg, int tl, size_t tok, float rs, int lane) {
  const char* ws = p.ws;
  const char* xrow = ldsA + tl * LDS_ROW;
  const uint4 x0 = *(const uint4*)(xrow + 16 * lane), x1 = *(const uint4*)(xrow + 1024 + 16 * lane);
  const unsigned xr[8] = {x0.x, x0.y, x0.z, x0.w, x1.x, x1.y, x1.z, x1.w};
  float acc[16];
#pragma unroll
  for (int j = 0; j < 16; ++j) acc[j] = 0.f;
  const char* PU = ws + OFF_PU + 16 * lane;
  const char* PV = ws + OFF_PV + 16 * lane;
#pragma unroll 1
  for (int half = 0; half < 2; ++half) {
    const uint2 e = eg[(size_t)tl * 128 + 64 * half + lane];
    const int myeid = (int)e.x;
    const float mygate = __uint_as_float(e.y);
    float mya = 0.f;
#pragma unroll 4
    for (int k = 0; k < 64; ++k) {
      const int eid = __builtin_amdgcn_readlane(myeid, k);
      const uint4 u0 = *(const uint4*)(PU + (size_t)eid * 2048), u1 = *(const uint4*)(PU + (size_t)eid * 2048 + 1024);
      const unsigned ur[8] = {u0.x, u0.y, u0.z, u0.w, u1.x, u1.y, u1.z, u1.w};
      float d = 0.f;
#pragma unroll
      for (int j = 0; j < 8; ++j)
        d = __builtin_amdgcn_fdot2_f32_bf16(__builtin_bit_cast(bf2, ur[j]), __builtin_bit_cast(bf2, xr[j]), d, false);
      d = wave_sum(d);
      mya = (lane == k) ? d : mya;
    }
    const float a = mya * rs;
    const float wgt = mygate * 0.5f * a * (1.0f + erff(a * 0.70710678118654752f));
#pragma unroll 4
    for (int k = 0; k < 64; ++k) {
      const int eid = __builtin_amdgcn_readlane(myeid, k);
      const float wk = __uint_as_float((unsigned)__builtin_amdgcn_readlane((int)__float_as_uint(wgt), k));
      const uint4 v0 = *(const uint4*)(PV + (size_t)eid * 2048), v1 = *(const uint4*)(PV + (size_t)eid * 2048 + 1024);
      const unsigned vr[8] = {v0.x, v0.y, v0.z, v0.w, v1.x, v1.y, v1.z, v1.w};
#pragma unroll
      for (int j = 0; j < 8; ++j) {
        acc[2 * j] = fmaf(wk, __uint_as_float(vr[j] << 16), acc[2 * j]);
        acc[2 * j + 1] = fmaf(wk, __uint_as_float(vr[j] & 0xffff0000u), acc[2 * j + 1]);
      }
    }
  }
  float* orow = p.out + tok * DM;
  float ss = 0.f;
#pragma unroll
  for (int q = 0; q < 4; ++q) {
    const int d0 = (q >> 1) * 512 + 8 * lane + 4 * (q & 1);
    const f4v hv = *(const f4v*)(orow + d0);
#pragma unroll
    for (int j = 0; j < 4; ++j) { acc[4 * q + j] += hv[j]; ss += acc[4 * q + j] * acc[4 * q + j]; }
  }
  ss = wave_sum(ss);
  const float rf = rsqrtf(ss * (1.0f / DM) + EPSV);
#pragma unroll
  for (int q = 0; q < 4; ++q) {
    const int d0 = (q >> 1) * 512 + 8 * lane + 4 * (q & 1);
    const f4v gg = *(const f4v*)(p.g_fin + d0);
    f4v o = {acc[4 * q] * rf * gg[0], acc[4 * q + 1] * rf * gg[1], acc[4 * q + 2] * rf * gg[2], acc[4 * q + 3] * rf * gg[3]};
    *(f4v*)(orow + d0) = o;
  }
}

DI void phase_d_tile(const MKParams& p, int tile, int wave, int lane, float rs0, float rs1) {
  asm volatile("" : "+v"(lane));
  char* ws = p.ws;
  char* ldsA = smem;
  float* rs_s = (float*)(smem + LDS_A_BYTES);
  unsigned char* idxs = (unsigned char*)(smem + LDS_A_BYTES + 4096) + wave * 1024;
  u16* qp = (u16*)qp_scratch(ws, blockIdx.x);
  uint2* eg = (uint2*)(ws + OFF_EG + (size_t)blockIdx.x * 65536);
  const size_t tok0 = (size_t)tile * 64;
  if (wave == 0) { if (lane < 32) rs_s[lane] = rs0; else rs_s[lane] = rs1; }
  {
    f16v acc[2][2];
    const bf8* wf = (const bf8*)(ws + OFF_WPQ);
#pragma unroll 1
    for (int c = 0; c < 4; ++c) {
      int l2 = lane;
      asm volatile("" : "+v"(l2));
      const int r = l2 & 31, h = l2 >> 5;
      gemm_chunk<true>(ldsA, wf + (size_t)(c * 16 + 2 * wave) * 4096, l2, acc);
#pragma unroll
      for (int ntl = 0; ntl < 2; ++ntl)
#pragma unroll
        for (int tt = 0; tt < 2; ++tt)
#pragma unroll
          for (int g = 0; g < 4; ++g) {
            const float sc = tt ? rs1 : rs0;
            f4v v = {acc[ntl][tt][4 * g] * sc, acc[ntl][tt][4 * g + 1] * sc, acc[ntl][tt][4 * g + 2] * sc, acc[ntl][tt][4 * g + 3] * sc};
            *(bf4*)(qp + (size_t)(32 * tt + r) * 2048 + 512 * c + 64 * wave + 32 * ntl + 8 * g + 4 * h) = cvt4(v);
          }
    }
  }
  __syncthreads();
#pragma unroll 1
  for (int tt = 0; tt < 2; ++tt) {
    int l2 = lane;
    asm volatile("" : "+v"(l2));
    peer_select(ws, qp, eg, idxs, wave, tt, l2);
  }
  __syncthreads();
#pragma unroll 1
  for (int i = 0; i < 8; ++i) {
    const int tl = 8 * wave + i;
    int l2 = lane;
    asm volatile("" : "+v"(l2));
    peer_gather_token(p, ldsA, eg, tl, tok0 + tl, rs_s[tl], l2);
  }
}
__global__ __launch_bounds__(512) void mk(MKParams p) {
  cg::grid_group grid = cg::this_grid();
  const int tid = threadIdx.x;
  const int wave = __builtin_amdgcn_readfirstlane(tid >> 6), lane = tid & 63;
  const int gtid = blockIdx.x * 512 + tid, gthreads = gridDim.x * 512;
  const int gw = blockIdx.x * 8 + wave, nw = gridDim.x * 8;
  phase_prep(p, gtid, gthreads);
  phase_prep_tables(p, gtid, gthreads);
  grid.sync();
  for (int tile = blockIdx.x; tile < 256; tile += gridDim.x) phase_a_tile(p, tile, wave, lane);
  for (int item = blockIdx.x; item < 128; item += gridDim.x) phase_a_memkv(p, item, wave, lane);
  grid.sync();
  for (int it = gw; it < 4096; it += nw) sb_item(p, it, lane);
  for (int it = nw - 1 - gw; it < 1024; it += nw) gla_g1_item(p, it, wave, lane);
  grid.sync();
  gla_g2(p, gtid, gthreads);
  grid.sync();
  for (int tile = blockIdx.x; tile < 256; tile += gridDim.x) {
    float rs0, rs1;
    phase_c_tile(p, tile, wave, lane, rs0, rs1);
    phase_d_tile(p, tile, wave, lane, rs0, rs1);
  }
}
#define MK_LDS (160 * 1024)
extern "C" void kernel_launch(void* const* d_in, const int* in_sizes, int n_in, void* d_out, int out_size, void* d_ws,
                              size_t ws_size, hipStream_t stream) {
  MKParams p{};
  p.x = (const float*)d_in[0]; p.mem = (const float*)d_in[1]; p.g_mix = (const float*)d_in[2];
  p.w_in = (const float*)d_in[3]; p.w_up = (const float*)d_in[4]; p.b_alpha = (const float*)d_in[5];
  p.g_gla = (const float*)d_in[6]; p.w_out = (const float*)d_in[7]; p.g_mq = (const float*)d_in[8];
  p.g_mkv = (const float*)d_in[9]; p.w_mq = (const float*)d_in[10]; p.w_mkv = (const float*)d_in[11];
  p.w_mo = (const float*)d_in[12]; p.g_ffn = (const float*)d_in[13]; p.w_pq = (const float*)d_in[14];
  p.subk = (const float*)d_in[15]; p.pu = (const float*)d_in[16]; p.pv = (const float*)d_in[17];
  p.g_fin = (const float*)d_in[18];
  p.out = (float*)d_out; p.ws = (char*)d_ws;
  float* out = (float*)d_out;
  char* wsb = (char*)d_ws;
  float* ws = (float*)d_ws;
  static int grid_blocks = 0;
  if (!grid_blocks) {
    int dev = 0, cus = 0, per_cu = 0;
    (void)hipGetDevice(&dev);
    (void)hipDeviceGetAttribute(&cus, hipDeviceAttributeMultiprocessorCount, dev);
    (void)hipFuncSetAttribute((const void*)mk, hipFuncAttributeMaxDynamicSharedMemorySize, MK_LDS);
    (void)hipOccupancyMaxActiveBlocksPerMultiprocessor(&per_cu, mk, 512, MK_LDS);
    grid_blocks = cus * per_cu;
    fprintf(stderr, "mk: cus=%d per_cu=%d grid=%d ws=%zu\n", cus, per_cu, grid_blocks, ws_size);
  }
  {
    void* args[] = {(void*)&p};
    hipError_t e = hipLaunchCooperativeKernel((const void*)mk, dim3(grid_blocks), dim3(512), args, MK_LDS, stream);
    if (e != hipSuccess) fprintf(stderr, "coop launch failed: %s grid %d\n", hipGetErrorString(e), grid_blocks);
  }
}
```

```cpp
#include <hip/hip_runtime.h>
#include <hip/hip_cooperative_groups.h>
#include <math.h>
#include <stdio.h>
#include <stdint.h>
namespace cg = cooperative_groups;

#define NB 8
#define SEQ 2048
#define DM 1024
#define NTOK (NB * SEQ)
#define INC 3088
#define MEML 256
#define EPSV 1e-6f

typedef __attribute__((ext_vector_type(8))) __bf16 bf8;
typedef __attribute__((ext_vector_type(4))) __bf16 bf4;
typedef __attribute__((ext_vector_type(2))) __bf16 bf2;
typedef __attribute__((ext_vector_type(16))) float f16v;
typedef __attribute__((ext_vector_type(8))) float f8v;
typedef __attribute__((ext_vector_type(4))) float f4v;
typedef __attribute__((ext_vector_type(2))) float f2v;
typedef unsigned short u16;

#define DI __device__ __forceinline__
#define MFMA(a, b, c) __builtin_amdgcn_mfma_f32_32x32x16_bf16((a), (b), (c), 0, 0, 0)

DI int crow(int i, int h) { return (i & 3) + 8 * (i >> 2) + 4 * h; }
DI int tpos(int t) { return (t & ~12) | ((t & 4) << 1) | ((t & 8) >> 1); }
DI float bf2f(u16 v) { return __uint_as_float(((unsigned)v) << 16); }
DI bf8 cvt8(f8v v) { return __builtin_convertvector(v, bf8); }
DI bf4 cvt4(f4v v) { return __builtin_convertvector(v, bf4); }
DI f16v zero16() { f16v z = {0.f, 0.f, 0.f, 0.f, 0.f, 0.f, 0.f, 0.f, 0.f, 0.f, 0.f, 0.f, 0.f, 0.f, 0.f, 0.f}; return z; }

#define MiB ((size_t)1 << 20)
#define OFF_WIN   ((size_t)0)
#define OFF_WOUT  (OFF_WIN + 97 * 65536)
#define OFF_WMQ   (OFF_WOUT + 32 * 65536)
#define OFF_WMKV  (OFF_WMQ + 32 * 65536)
#define OFF_WMO   (OFF_WMKV + 64 * 65536)
#define OFF_WPQ   (OFF_WMO + 32 * 65536)
#define OFF_SUBK  (OFF_WPQ + 64 * 65536)
#define OFF_ACT   (21 * MiB)
#define OFF_GQ    (OFF_ACT)
#define OFF_GK    (OFF_GQ + 8 * MiB)
#define OFF_GVT   (OFF_GK + 8 * MiB)
#define OFF_OG    (OFF_GVT + 16 * MiB)
#define OFF_SQ    (OFF_OG + 16 * MiB)
#define OFF_SK    (OFF_SQ + 16 * MiB)
#define OFF_SVT   (OFF_SK + 16 * MiB)
#define OFF_LA    (OFF_SVT + 16 * MiB)
#define OFF_LKV   (OFF_LA + 16 * MiB)
#define OFF_DD    (OFF_LKV + 32 * MiB)
#define OFF_OSB   (OFF_DD + 1 * MiB)
#define OFF_KM    (OFF_OSB + 16 * MiB)
#define OFF_VMT   (OFF_KM + 4 * MiB)
#define OFF_PU    (OFF_VMT + 4 * MiB)
#define OFF_PV    (OFF_PU + 16 * MiB)
#define OFF_SU    (OFF_PV + 16 * MiB)
#define OFF_SV    (OFF_SU + 65536)
#define OFF_SS    (OFF_LA)

#define LDS_ROW 2064
#define LDS_A_BYTES (64 * LDS_ROW)

struct MKParams {
  const float *x, *mem, *g_mix, *w_in, *w_up, *b_alpha, *g_gla, *w_out, *g_mq, *g_mkv, *w_mq, *w_mkv, *w_mo, *g_ffn, *w_pq,
      *subk, *pu, *pv, *g_fin;
  float* out;
  char* ws;
};
extern __shared__ __attribute__((aligned(16))) char smem[];

template <typename ColFn>
DI void prep_w(bf8* dst, const float* __restrict__ W, int ldw, int ntiles, const float* __restrict__ gain, ColFn colfn,
               int gtid, int gthreads) {
  const int total = ntiles * 4096;
  for (int u = gtid; u < total; u += gthreads) {
    const int lane = u & 63, ks = (u >> 6) & 63, nt = u >> 12;
    const int r = lane & 31, h = lane >> 5;
    float sc = 1.f;
    const int col = colfn(32 * nt + r, sc);
    f8v v;
#pragma unroll
    for (int j = 0; j < 8; ++j) {
      const int k = 16 * ks + 8 * h + j;
      float val = 0.f;
      if (col >= 0) val = W[(size_t)k * ldw + col] * sc * (gain ? gain[k] : 1.f);
      v[j] = val;
    }
    dst[u] = cvt8(v);
  }
}

DI void phase_prep(const MKParams& p, int gtid, int gthreads) {
  char* ws = p.ws;
  prep_w((bf8*)(ws + OFF_WIN), p.w_in, INC, 97, p.g_mix,
         [](int n, float& sc) -> int {
           if (n < 256) { sc = 0.125f; return n; }
           if (n < 1536) return n;
           if (n < 2048) { sc = 0.125f; return n + 16; }
           if (n < 3072) return n + 16;
           if (n < 3088) return n - 1536;
           return -1;
         }, gtid, gthreads);
  prep_w((bf8*)(ws + OFF_WOUT), p.w_out, 1024, 32, nullptr, [](int n, float& sc) -> int { return n; }, gtid, gthreads);
  prep_w((bf8*)(ws + OFF_WMQ), p.w_mq, 1024, 32, p.g_mq, [](int n, float& sc) -> int { sc = 0.0625f; return n; }, gtid, gthreads);
  prep_w((bf8*)(ws + OFF_WMKV), p.w_mkv, 2048, 64, p.g_mkv, [](int n, float& sc) -> int { return n; }, gtid, gthreads);
  prep_w((bf8*)(ws + OFF_WMO), p.w_mo, 1024, 32, nullptr, [](int n, float& sc) -> int { return n; }, gtid, gthreads);
  prep_w((bf8*)(ws + OFF_WPQ), p.w_pq, 2048, 64, p.g_ffn, [](int n, float& sc) -> int { return n; }, gtid, gthreads);
  {
    bf8* dst = (bf8*)(ws + OFF_SUBK);
    const int total = 16 * 4 * 8 * 64;
    for (int u = gtid; u < total; u += gthreads) {
      const int lane = u & 63, ks = (u >> 6) & 7, mt = (u >> 9) & 3, hp = u >> 11;
      const int r = lane & 31, h = lane >> 5;
      const float* s = p.subk + ((size_t)(hp * 128 + 32 * mt + r)) * 128 + 16 * ks + 8 * h;
      const f4v a = *(const f4v*)s, b = *(const f4v*)(s + 4);
      f8v v = {a[0], a[1], a[2], a[3], b[0], b[1], b[2], b[3]};
      dst[u] = cvt8(v);
    }
  }
}

DI void phase_prep_tables(const MKParams& p, int gwave, int nwaves, int lane) {
  for (int row = gwave; row < 32768; row += nwaves) {
    const int e = row & 16383;
    const bool isv = row >= 16384;
    const float* src = (isv ? p.pv : p.pu) + (size_t)e * DM + 16 * lane;
    f4v v[4];
#pragma unroll
    for (int q = 0; q < 4; ++q) v[q] = *(const f4v*)(src + 4 * q);
    if (!isv) {
#pragma unroll
      for (int q = 0; q < 4; ++q) v[q] = v[q] * *(const f4v*)(p.g_ffn + 16 * lane + 4 * q);
    }
    float am = 0.f;
#pragma unroll
    for (int q = 0; q < 4; ++q)
#pragma unroll
      for (int j = 0; j < 4; ++j) am = fmaxf(am, fabsf(v[q][j]));
#pragma unroll
    for (int o = 32; o > 0; o >>= 1) am = fmaxf(am, __shfl_xor(am, o));
    int k = 0;
    if (am > 0.f) k = 7 - ilogbf(am);
    k = max(-100, min(100, k));
    const float sc = ldexpf(1.0f, k);
    unsigned w[4];
#pragma unroll
    for (int q = 0; q < 4; ++q) {
      int pk = 0;
      pk = __builtin_amdgcn_cvt_pk_fp8_f32(v[q][0] * sc, v[q][1] * sc, pk, false);
      pk = __builtin_amdgcn_cvt_pk_fp8_f32(v[q][2] * sc, v[q][3] * sc, pk, true);
      w[q] = (unsigned)pk;
    }
    *(uint4*)(p.ws + (isv ? OFF_PV : OFF_PU) + (size_t)e * 1024 + 16 * lane) = make_uint4(w[0], w[1], w[2], w[3]);
    if (lane == 0) ((float*)(p.ws + (isv ? OFF_SV : OFF_SU)))[e] = ldexpf(1.0f, -k);
  }
}

DI void load_norm_tile(const float* __restrict__ src, char* ldsA, int wave, int lane) {
#pragma unroll 2
  for (int i = 0; i < 8; ++i) {
    const int row = 8 * wave + i;
    const f4v* pr = (const f4v*)(src + (size_t)row * DM);
    f4v v[4];
#pragma unroll
    for (int c = 0; c < 4; ++c) v[c] = pr[lane + 64 * c];
    float ss = 0.f;
#pragma unroll
    for (int c = 0; c < 4; ++c) ss += v[c][0] * v[c][0] + v[c][1] * v[c][1] + v[c][2] * v[c][2] + v[c][3] * v[c][3];
#pragma unroll
    for (int o = 32; o > 0; o >>= 1) ss += __shfl_xor(ss, o);
    const float rs = rsqrtf(ss * (1.0f / DM) + EPSV);
#pragma unroll
    for (int c = 0; c < 4; ++c) {
      f4v t = v[c] * rs;
      *(bf4*)(ldsA + row * LDS_ROW + (lane * 4 + 256 * c) * 2) = cvt4(t);
    }
  }
}

#define GEMM_PF 4
template <bool SWAP, bool RES = false>
DI void gemm_chunk(const char* ldsA, const bf8* __restrict__ wf, int lane, f16v (&acc)[2][2], const float* res = nullptr) {
  __builtin_amdgcn_sched_barrier(0);
  const int r = lane & 31, h = lane >> 5;
  const char* xa0 = ldsA + r * LDS_ROW + h * 16;
  const char* xa1 = xa0 + 32 * LDS_ROW;
  const bf8* w0p = wf + lane;
  const bf8* w1p = wf + 64 * 64 + lane;
  if (RES) {
#pragma unroll
    for (int ntl = 0; ntl < 2; ++ntl)
#pragma unroll
      for (int tt = 0; tt < 2; ++tt)
#pragma unroll
        for (int g = 0; g < 4; ++g) {
          const f4v x = *(const f4v*)(res + (size_t)(32 * tt + r) * DM + 32 * ntl + 8 * g + 4 * h);
          acc[ntl][tt][4 * g] = x[0]; acc[ntl][tt][4 * g + 1] = x[1]; acc[ntl][tt][4 * g + 2] = x[2]; acc[ntl][tt][4 * g + 3] = x[3];
        }
  } else {
    acc[0][0] = zero16(); acc[0][1] = zero16(); acc[1][0] = zero16(); acc[1][1] = zero16();
  }
  bf8 w0[GEMM_PF], w1[GEMM_PF];
#pragma unroll
  for (int i = 0; i < GEMM_PF; ++i) { w0[i] = w0p[i * 64]; w1[i] = w1p[i * 64]; }
#pragma unroll 1
  for (int ks0 = 0; ks0 < 64 - GEMM_PF; ks0 += GEMM_PF) {
#pragma unroll
    for (int i = 0; i < GEMM_PF; ++i) {
      const int ks = ks0 + i;
      const bf8 a0 = w0[i], a1 = w1[i];
      w0[i] = w0p[(ks + GEMM_PF) * 64];
      w1[i] = w1p[(ks + GEMM_PF) * 64];
      const bf8 x0 = *(const bf8*)(xa0 + ks * 32);
      const bf8 x1 = *(const bf8*)(xa1 + ks * 32);
      if (SWAP) {
        acc[0][0] = MFMA(a0, x0, acc[0][0]); acc[0][1] = MFMA(a0, x1, acc[0][1]);
        acc[1][0] = MFMA(a1, x0, acc[1][0]); acc[1][1] = MFMA(a1, x1, acc[1][1]);
      } else {
        acc[0][0] = MFMA(x0, a0, acc[0][0]); acc[0][1] = MFMA(x1, a0, acc[0][1]);
        acc[1][0] = MFMA(x0, a1, acc[1][0]); acc[1][1] = MFMA(x1, a1, acc[1][1]);
      }
    }
  }
#pragma unroll
  for (int i = 0; i < GEMM_PF; ++i) {
    const int ks = 64 - GEMM_PF + i;
    const bf8 a0 = w0[i], a1 = w1[i];
    const bf8 x0 = *(const bf8*)(xa0 + ks * 32);
    const bf8 x1 = *(const bf8*)(xa1 + ks * 32);
    if (SWAP) {
      acc[0][0] = MFMA(a0, x0, acc[0][0]); acc[0][1] = MFMA(a0, x1, acc[0][1]);
      acc[1][0] = MFMA(a1, x0, acc[1][0]); acc[1][1] = MFMA(a1, x1, acc[1][1]);
    } else {
      acc[0][0] = MFMA(x0, a0, acc[0][0]); acc[0][1] = MFMA(x1, a0, acc[0][1]);
      acc[1][0] = MFMA(x0, a1, acc[1][0]); acc[1][1] = MFMA(x1, a1, acc[1][1]);
    }
  }
}

DI void store_swap_bf16(u16* dst, size_t ld, const f16v (&acc)[2][2], int lane) {
  const int r = lane & 31, h = lane >> 5;
#pragma unroll
  for (int ntl = 0; ntl < 2; ++ntl)
#pragma unroll
    for (int tt = 0; tt < 2; ++tt)
#pragma unroll
      for (int g = 0; g < 4; ++g) {
        f4v v = {acc[ntl][tt][4 * g], acc[ntl][tt][4 * g + 1], acc[ntl][tt][4 * g + 2], acc[ntl][tt][4 * g + 3]};
        *(bf4*)(dst + (size_t)(32 * tt + r) * ld + 32 * ntl + 8 * g + 4 * h) = cvt4(v);
      }
}
DI void store_vt_bf16(u16* dst, size_t ld, const f16v (&acc)[2][2], int lane) {
  const int r = lane & 31, h = lane >> 5;
#pragma unroll
  for (int ntl = 0; ntl < 2; ++ntl)
#pragma unroll
    for (int tt = 0; tt < 2; ++tt)
#pragma unroll
      for (int s = 0; s < 2; ++s) {
        f8v v;
#pragma unroll
        for (int j = 0; j < 8; ++j) v[j] = acc[ntl][tt][8 * s + j];
        *(bf8*)(dst + (size_t)(32 * ntl + r) * ld + 32 * tt + 16 * s + 8 * h) = cvt8(v);
      }
}

DI float log_sigmoid_acc(float x) { return fminf(x, 0.f) - log1pf(expf(-fabsf(x))); }

DI void phase_a_tile(const MKParams& p, int tile, int wave, int lane) {
  asm volatile("" : "+v"(lane));
  char* ws = p.ws;
  char* ldsA = smem;
  float* alr_s = (float*)(smem + LDS_A_BYTES);
  const int b = tile >> 5, c = tile & 31;
  const size_t tok0 = (size_t)tile * 64;
  __syncthreads();
  load_norm_tile(p.x + tok0 * DM, ldsA, wave, lane);
  __syncthreads();
  const bf8* wf = (const bf8*)(ws + OFF_WIN);
  f16v acc[2][2];
  const int t0 = c * 64;
  gemm_chunk<true>(ldsA, wf + (size_t)(0 * 16 + 2 * wave) * 4096, lane, acc);
  {
    u16* base = (u16*)(ws + (wave < 4 ? OFF_GQ : OFF_GK)) + ((size_t)(b * 4 + (wave & 3)) * SEQ + t0) * 64;
    store_swap_bf16(base, 64, acc, lane);
  }
  gemm_chunk<false>(ldsA, wf + (size_t)(1 * 16 + 2 * wave) * 4096, lane, acc);
  {
    u16* base = (u16*)(ws + OFF_GVT) + ((size_t)(b * 4 + (wave >> 1)) * 128 + 64 * (wave & 1)) * SEQ + t0;
    store_vt_bf16(base, SEQ, acc, lane);
  }
  gemm_chunk<true>(ldsA, wf + (size_t)(2 * 16 + 2 * wave) * 4096, lane, acc);
  store_swap_bf16((u16*)(ws + OFF_OG) + tok0 * 512 + 64 * wave, 512, acc, lane);
  gemm_chunk<true>(ldsA, wf + (size_t)(3 * 16 + 2 * wave) * 4096, lane, acc);
  store_swap_bf16((u16*)(ws + OFF_SQ) + ((size_t)(b * 8 + wave) * SEQ + t0) * 64, 64, acc, lane);
  gemm_chunk<true>(ldsA, wf + (size_t)(4 * 16 + 2 * wave) * 4096, lane, acc);
  store_swap_bf16((u16*)(ws + OFF_SK) + ((size_t)(b * 8 + wave) * SEQ + t0) * 64, 64, acc, lane);
  gemm_chunk<false>(ldsA, wf + (size_t)(5 * 16 + 2 * wave) * 4096, lane, acc);
  store_vt_bf16((u16*)(ws + OFF_SVT) + ((size_t)(b * 8 + wave) * 64) * SEQ + t0, SEQ, acc, lane);
  if (wave == 7) {
    const int r = lane & 31, h = lane >> 5;
    const bf8* wp = wf + (size_t)96 * 4096 + lane;
    const char* xa0 = ldsA + r * LDS_ROW + h * 16;
    const char* xa1 = xa0 + 32 * LDS_ROW;
    f16v a0 = zero16(), a1 = zero16();
#pragma unroll 8
    for (int ks = 0; ks < 64; ++ks) {
      const bf8 w = wp[ks * 64];
      a0 = MFMA(w, *(const bf8*)(xa0 + ks * 32), a0);
      a1 = MFMA(w, *(const bf8*)(xa1 + ks * 32), a1);
    }
#pragma unroll
    for (int i = 0; i < 8; ++i) {
      alr_s[(r) * 16 + crow(i, h)] = a0[i];
      alr_s[(32 + r) * 16 + crow(i, h)] = a1[i];
    }
  }
  __syncthreads();
  {
    const int tid = wave * 64 + lane;
    const int tk = tid >> 3, c0 = (tid & 7) * 32;
    float a[16];
#pragma unroll
    for (int rr = 0; rr < 16; ++rr) a[rr] = alr_s[tk * 16 + rr];
    float* dst = (float*)(ws + OFF_LA) + (tok0 + tk) * 256 + c0;
#pragma unroll 4
    for (int cc = 0; cc < 32; ++cc) {
      float s = p.b_alpha[c0 + cc];
#pragma unroll
      for (int rr = 0; rr < 16; ++rr) s = fmaf(a[rr], p.w_up[rr * 256 + c0 + cc], s);
      dst[cc] = log_sigmoid_acc(s) * (1.0f / 16.0f);
    }
  }
}

DI void phase_a_memkv(const MKParams& p, int item, int wave, int lane) {
  asm volatile("" : "+v"(lane));
  char* ws = p.ws;
  char* ldsA = smem;
  const int rt = item >> 2, cc = item & 3;
  const int b = rt >> 2, m0 = (rt & 3) * 64;
  __syncthreads();
  load_norm_tile(p.mem + (size_t)rt * 64 * DM, ldsA, wave, lane);
  __syncthreads();
  const bf8* wf = (const bf8*)(ws + OFF_WMKV);
  f16v acc[2][2];
  if (cc < 2) {
    gemm_chunk<true>(ldsA, wf + (size_t)(cc * 16 + 2 * wave) * 4096, lane, acc);
    const int f0 = 512 * cc + 64 * wave;
    u16* base = (u16*)(ws + OFF_KM) + ((size_t)(b * 4 + (f0 >> 8)) * 256 + m0) * 256 + (f0 & 255);
    store_swap_bf16(base, 256, acc, lane);
  } else {
    gemm_chunk<false>(ldsA, wf + (size_t)(cc * 16 + 2 * wave) * 4096, lane, acc);
    const int f0 = 512 * (cc - 2) + 64 * wave;
    u16* base = (u16*)(ws + OFF_VMT) + ((size_t)(b * 4 + (f0 >> 8)) * 256 + (f0 & 255)) * 256 + m0;
    store_vt_bf16(base, 256, acc, lane);
  }
}
#define SB_THR 30.0f

DI bf8 pack8(const f16v& x, int s) {
  f8v v;
#pragma unroll
  for (int j = 0; j < 8; ++j) v[j] = x[8 * s + j];
  return cvt8(v);
}

DI void sb_item(const MKParams& p, int item, int lane) {
  asm volatile("" : "+v"(lane));
  char* ws = p.ws;
  const int r = lane & 31, h = lane >> 5;
  const int bh = item >> 6, qt = item & 63;
  const u16* SQ = (const u16*)(ws + OFF_SQ) + (size_t)bh * SEQ * 64;
  const u16* SK = (const u16*)(ws + OFF_SK) + (size_t)bh * SEQ * 64;
  const u16* SVT = (const u16*)(ws + OFF_SVT) + (size_t)bh * 64 * SEQ;
  bf8 qf[4];
#pragma unroll
  for (int ks = 0; ks < 4; ++ks) qf[ks] = *(const bf8*)(SQ + (size_t)(32 * qt + r) * 64 + 16 * ks + 8 * h);
  bf8 tri[2];
#pragma unroll
  for (int s = 0; s < 2; ++s) {
    f8v t;
#pragma unroll
    for (int j = 0; j < 8; ++j) t[j] = (16 * s + 8 * (j >> 2) + 4 * h + (j & 3) >= r) ? 1.0f : 0.0f;
    tri[s] = cvt8(t);
  }
  f16v o0 = zero16(), o1 = zero16();
  float R = 0.f;
  for (int kt = qt; kt >= 0; --kt) {
    bf8 kf[4], vf[2][2];
#pragma unroll
    for (int ks = 0; ks < 4; ++ks) kf[ks] = *(const bf8*)(SK + (size_t)(32 * kt + r) * 64 + 16 * ks + 8 * h);
#pragma unroll
    for (int mt = 0; mt < 2; ++mt)
#pragma unroll
      for (int s = 0; s < 2; ++s) vf[mt][s] = *(const bf8*)(SVT + (size_t)(32 * mt + r) * SEQ + 32 * kt + 16 * s + 8 * h);
    f16v z = zero16();
#pragma unroll
    for (int ks = 0; ks < 4; ++ks) z = MFMA(kf[ks], qf[ks], z);
    const bool diag = (kt == qt);
    f16v sp;
    float tot = 0.f;
#pragma unroll
    for (int i = 0; i < 16; ++i) {
      const float zz = z[i];
      const float sv = fmaxf(zz, 0.f) + __logf(1.0f + __expf(-fabsf(zz)));
      const bool valid = !diag || (crow(i, h) < r);
      sp[i] = valid ? sv : 0.f;
      tot += sp[i];
    }
    tot += __shfl_xor(tot, 32);
    f16v C = MFMA(tri[0], pack8(sp, 0), zero16());
    C = MFMA(tri[1], pack8(sp, 1), C);
    f16v a;
#pragma unroll
    for (int i = 0; i < 16; ++i) {
      const bool valid = !diag || (crow(i, h) < r);
      a[i] = valid ? __expf(z[i] - C[i] - R) : 0.f;
    }
    const bf8 a0 = pack8(a, 0), a1 = pack8(a, 1);
    o0 = MFMA(vf[0][0], a0, o0); o0 = MFMA(vf[0][1], a1, o0);
    o1 = MFMA(vf[1][0], a0, o1); o1 = MFMA(vf[1][1], a1, o1);
    R += tot;
    if (__all(R > SB_THR)) break;
  }
  const int b = bh >> 3, hd = bh & 7;
  u16* dst = (u16*)(ws + OFF_OSB) + ((size_t)b * SEQ + 32 * qt + r) * 512 + hd * 64 + 4 * h;
#pragma unroll
  for (int g = 0; g < 4; ++g) {
    f4v v0 = {o0[4 * g], o0[4 * g + 1], o0[4 * g + 2], o0[4 * g + 3]};
    f4v v1 = {o1[4 * g], o1[4 * g + 1], o1[4 * g + 2], o1[4 * g + 3]};
    *(bf4*)(dst + 8 * g) = cvt4(v0);
    *(bf4*)(dst + 32 + 8 * g) = cvt4(v1);
  }
}

DI void gla_g1_item(const MKParams& p, int item, int wave, int lane) {
  asm volatile("" : "+v"(lane));
  char* ws = p.ws;
  const int r = lane & 31, h = lane >> 5;
  const int bh = item >> 5, c = item & 31, b = bh >> 2, hd = bh & 3;
  char* kl = smem + wave * 9216;
  u16* GQ = (u16*)(ws + OFF_GQ) + ((size_t)bh * SEQ + 64 * c) * 64;
  u16* GK = (u16*)(ws + OFF_GK) + ((size_t)bh * SEQ + 64 * c) * 64;
  const float* LA = (const float*)(ws + OFF_LA) + ((size_t)b * SEQ + 64 * c) * 256 + hd * 64;
  float bc = 0.f;
#pragma unroll 1
  for (int g = 0; g < 4; ++g) {
    float la_[16];
    u16 q_[16], k_[16];
#pragma unroll
    for (int i = 0; i < 16; ++i) {
      const int t = 16 * g + i;
      la_[i] = LA[(size_t)t * 256 + lane];
      q_[i] = GQ[t * 64 + lane];
      k_[i] = GK[t * 64 + lane];
    }
#pragma unroll
    for (int i = 0; i < 16; ++i) {
      const int t = 16 * g + i;
      bc += la_[i];
      const float eq = __expf(bc);
      const float qn = bf2f(q_[i]) * eq, kn = bf2f(k_[i]) / eq;
      const bf2 pk = __builtin_convertvector((f2v){qn, kn}, bf2);
      const unsigned u = __builtin_bit_cast(unsigned, pk);
      GQ[t * 64 + lane] = (u16)(u & 0xffff);
      GK[t * 64 + lane] = (u16)(u >> 16);
      *(u16*)(kl + lane * 144 + tpos(t) * 2) = (u16)(u >> 16);
    }
  }
  ((float*)(ws + OFF_DD))[(size_t)item * 64 + lane] = __expf(bc);
  asm volatile("s_waitcnt lgkmcnt(0)" ::: "memory");
  const u16* GVT = (const u16*)(ws + OFF_GVT) + (size_t)bh * 128 * SEQ + 64 * c;
  float* LKV = (float*)(ws + OFF_LKV) + (size_t)item * 128 * 64;
  bf8 kb[2][4];
#pragma unroll
  for (int nt = 0; nt < 2; ++nt)
#pragma unroll
    for (int s = 0; s < 4; ++s) kb[nt][s] = *(const bf8*)(kl + (32 * nt + r) * 144 + (16 * s + 8 * h) * 2);
#pragma unroll 1
  for (int mt = 0; mt < 4; ++mt) {
    f16v a0 = zero16(), a1 = zero16();
#pragma unroll
    for (int s = 0; s < 4; ++s) {
      const bf8 vf = *(const bf8*)(GVT + (size_t)(32 * mt + r) * SEQ + 16 * s + 8 * h);
      a0 = MFMA(vf, kb[0][s], a0);
      a1 = MFMA(vf, kb[1][s], a1);
    }
#pragma unroll
    for (int i = 0; i < 16; ++i) {
      LKV[(32 * mt + crow(i, h)) * 64 + r] = a0[i];
      LKV[(32 * mt + crow(i, h)) * 64 + 32 + r] = a1[i];
    }
  }
  asm volatile("s_waitcnt lgkmcnt(0)" ::: "memory");
}

DI void gla_g2(const MKParams& p, int gtid, int gthreads) {
  char* ws = p.ws;
  for (int u = gtid; u < 32768; u += gthreads) {
    const int oct = u & 7, dv = (u >> 3) & 127, bh = u >> 10;
    f8v S = {0.f, 0.f, 0.f, 0.f, 0.f, 0.f, 0.f, 0.f};
#pragma unroll 4
    for (int c = 0; c < 32; ++c) {
      const size_t item = (size_t)bh * 32 + c;
      *(bf8*)((u16*)(ws + OFF_SS) + (item * 128 + dv) * 64 + oct * 8) = cvt8(S);
      const f8v l = *(const f8v*)((const float*)(ws + OFF_LKV) + (item * 128 + dv) * 64 + oct * 8);
      const f8v d = *(const f8v*)((const float*)(ws + OFF_DD) + item * 64 + oct * 8);
      S = d * (S + l);
    }
  }
}

DI void gla_g3_tile(const MKParams& p, int tile, int wave, int lane, char* dst, int dst_ld) {
  char* ws = p.ws;
  const int r = lane & 31, h = lane >> 5;
  const int b = tile >> 5, c = tile & 31, hd = wave >> 1, tt = wave & 1, bh = b * 4 + hd;
  const u16* GQ = (const u16*)(ws + OFF_GQ) + ((size_t)bh * SEQ + 64 * c) * 64;
  const u16* GK = (const u16*)(ws + OFF_GK) + ((size_t)bh * SEQ + 64 * c) * 64;
  const u16* GVT = (const u16*)(ws + OFF_GVT) + (size_t)bh * 128 * SEQ + 64 * c;
  const u16* SS = (const u16*)(ws + OFF_SS) + ((size_t)(bh * 32 + c) * 128) * 64;
  bf8 qf[4];
#pragma unroll
  for (int ks = 0; ks < 4; ++ks) qf[ks] = *(const bf8*)(GQ + (32 * tt + r) * 64 + 16 * ks + 8 * h);
  bf8 pf[2][2];
#pragma unroll
  for (int kt = 0; kt < 2; ++kt) {
    if (kt <= tt) {
      f16v pt = zero16();
#pragma unroll
      for (int ks = 0; ks < 4; ++ks) {
        const bf8 kf = *(const bf8*)(GK + (32 * kt + r) * 64 + 16 * ks + 8 * h);
        pt = MFMA(kf, qf[ks], pt);
      }
      if (kt == tt) {
#pragma unroll
        for (int i = 0; i < 16; ++i) pt[i] = (crow(i, h) <= r) ? pt[i] : 0.f;
      }
      pf[kt][0] = pack8(pt, 0);
      pf[kt][1] = pack8(pt, 1);
    }
  }
  f16v o[4];
#pragma unroll
  for (int mt = 0; mt < 4; ++mt) {
    o[mt] = zero16();
#pragma unroll
    for (int ks = 0; ks < 4; ++ks) {
      const bf8 sf = *(const bf8*)(SS + (32 * mt + r) * 64 + 16 * ks + 8 * h);
      o[mt] = MFMA(sf, qf[ks], o[mt]);
    }
#pragma unroll
    for (int kt = 0; kt < 2; ++kt) {
      if (kt <= tt) {
#pragma unroll
        for (int s = 0; s < 2; ++s) {
          const bf8 vf = *(const bf8*)(GVT + (size_t)(32 * mt + r) * SEQ + 32 * kt + 16 * s + 8 * h);
          o[mt] = MFMA(vf, pf[kt][s], o[mt]);
        }
      }
    }
  }
  float ss = 0.f;
#pragma unroll
  for (int mt = 0; mt < 4; ++mt)
#pragma unroll
    for (int i = 0; i < 16; ++i) ss += o[mt][i] * o[mt][i];
  ss += __shfl_xor(ss, 32);
  const float rr = rsqrtf(ss * (1.0f / 128.0f) + EPSV);
  const size_t tok = (size_t)tile * 64 + 32 * tt + r;
  const u16* OG = (const u16*)(ws + OFF_OG) + tok * 512 + hd * 128;
#pragma unroll
  for (int mt = 0; mt < 4; ++mt)
#pragma unroll
    for (int g = 0; g < 4; ++g) {
      const int dv0 = 32 * mt + 8 * g + 4 * h;
      const ushort4 og4 = *(const ushort4*)(OG + dv0);
      const f4v gg = *(const f4v*)(p.g_gla + dv0);
      const float og[4] = {bf2f(og4.x), bf2f(og4.y), bf2f(og4.z), bf2f(og4.w)};
      f4v v;
#pragma unroll
      for (int j = 0; j < 4; ++j) v[j] = o[mt][4 * g + j] * rr * gg[j] * (og[j] / (1.0f + __expf(-og[j])));
      *(bf4*)(dst + (size_t)(32 * tt + r) * dst_ld + (hd * 128 + dv0) * 2) = cvt4(v);
    }
}
DI void gemm_1024(const char* ldsA, const bf8* __restrict__ wf, int wave, int lane, f16v (&a0)[2][2], f16v (&a1)[2][2]) {
  gemm_chunk<true>(ldsA, wf + (size_t)(2 * wave) * 4096, lane, a0);
  gemm_chunk<true>(ldsA, wf + (size_t)(16 + 2 * wave) * 4096, lane, a1);
}
DI void gemm_1024_res(const char* ldsA, const bf8* __restrict__ wf, int wave, int lane, f16v (&a0)[2][2], f16v (&a1)[2][2],
                      const float* res) {
  gemm_chunk<true, true>(ldsA, wf + (size_t)(2 * wave) * 4096, lane, a0, res + 64 * wave);
  gemm_chunk<true, true>(ldsA, wf + (size_t)(16 + 2 * wave) * 4096, lane, a1, res + 512 + 64 * wave);
}

DI void store_f32_ssq(const f16v (&a)[2][2], float* dst, int f0, int lane, float (&ssq)[2]) {
  const int r = lane & 31, h = lane >> 5;
#pragma unroll
  for (int ntl = 0; ntl < 2; ++ntl)
#pragma unroll
    for (int tt = 0; tt < 2; ++tt)
#pragma unroll
      for (int g = 0; g < 4; ++g) {
        f4v v = {a[ntl][tt][4 * g], a[ntl][tt][4 * g + 1], a[ntl][tt][4 * g + 2], a[ntl][tt][4 * g + 3]};
        ssq[tt] += v[0] * v[0] + v[1] * v[1] + v[2] * v[2] + v[3] * v[3];
        *(f4v*)(dst + (size_t)(32 * tt + r) * DM + f0 + 32 * ntl + 8 * g + 4 * h) = v;
      }
}

struct Pk { bf4 v[2][2][4]; };
DI void pack_acc(Pk& pk, const f16v (&a)[2][2], float s0, float s1) {
#pragma unroll
  for (int ntl = 0; ntl < 2; ++ntl)
#pragma unroll
    for (int tt = 0; tt < 2; ++tt)
#pragma unroll
      for (int g = 0; g < 4; ++g) {
        const float sc = tt ? s1 : s0;
        f4v v = {a[ntl][tt][4 * g] * sc, a[ntl][tt][4 * g + 1] * sc, a[ntl][tt][4 * g + 2] * sc, a[ntl][tt][4 * g + 3] * sc};
        pk.v[ntl][tt][g] = cvt4(v);
      }
}
DI void pk_to_lds(char* ldsA, const Pk& pk, int f0, int lane) {
  const int r = lane & 31, h = lane >> 5;
#pragma unroll
  for (int ntl = 0; ntl < 2; ++ntl)
#pragma unroll
    for (int tt = 0; tt < 2; ++tt)
#pragma unroll
      for (int g = 0; g < 4; ++g)
        *(bf4*)(ldsA + (32 * tt + r) * LDS_ROW + (f0 + 32 * ntl + 8 * g + 4 * h) * 2) = pk.v[ntl][tt][g];
}

DI void rms_from_partials(float* red, int wave, int lane, const float (&ssq)[2], float& rs0, float& rs1) {
  red[(wave * 2 + 0) * 64 + lane] = ssq[0];
  red[(wave * 2 + 1) * 64 + lane] = ssq[1];
  __syncthreads();
  const int r = lane & 31;
  float t0 = 0.f, t1 = 0.f;
#pragma unroll
  for (int w = 0; w < 8; ++w) {
    t0 += red[(w * 2 + 0) * 64 + r] + red[(w * 2 + 0) * 64 + 32 + r];
    t1 += red[(w * 2 + 1) * 64 + r] + red[(w * 2 + 1) * 64 + 32 + r];
  }
  rs0 = rsqrtf(t0 * (1.0f / DM) + EPSV);
  rs1 = rsqrtf(t1 * (1.0f / DM) + EPSV);
}

DI void mem_attn(const MKParams& p, char* ldsA, int b, int wave, int lane) {
  char* ws = p.ws;
  const int r = lane & 31, h = lane >> 5;
  const int hm = wave >> 1, tt = wave & 1;
  const u16* KM = (const u16*)(ws + OFF_KM) + (size_t)(b * 4 + hm) * 256 * 256;
  const u16* VMT = (const u16*)(ws + OFF_VMT) + (size_t)(b * 4 + hm) * 256 * 256;
  char* qrow = ldsA + (32 * tt + r) * LDS_ROW + hm * 512;
  f16v s[8];
#pragma unroll
  for (int mt = 0; mt < 8; ++mt) s[mt] = zero16();
#pragma unroll 2
  for (int ks = 0; ks < 16; ++ks) {
    const bf8 qf = *(const bf8*)(qrow + (16 * ks + 8 * h) * 2);
#pragma unroll
    for (int mt = 0; mt < 8; ++mt) {
      const bf8 kf = *(const bf8*)(KM + (32 * mt + r) * 256 + 16 * ks + 8 * h);
      s[mt] = MFMA(kf, qf, s[mt]);
    }
  }
  float mx = -INFINITY;
#pragma unroll
  for (int mt = 0; mt < 8; ++mt)
#pragma unroll
    for (int i = 0; i < 16; ++i) mx = fmaxf(mx, s[mt][i]);
  mx = fmaxf(mx, __shfl_xor(mx, 32));
  float l = 0.f;
  bf8 pf[8][2];
#pragma unroll
  for (int mt = 0; mt < 8; ++mt) {
#pragma unroll
    for (int i = 0; i < 16; ++i) { s[mt][i] = __expf(s[mt][i] - mx); l += s[mt][i]; }
    pf[mt][0] = pack8(s[mt], 0);
    pf[mt][1] = pack8(s[mt], 1);
  }
  l += __shfl_xor(l, 32);
  const float inv = 1.0f / l;
#pragma unroll
  for (int grp = 0; grp < 2; ++grp) {
    f16v o[4];
#pragma unroll
    for (int m4 = 0; m4 < 4; ++m4) o[m4] = zero16();
#pragma unroll
    for (int kt = 0; kt < 8; ++kt)
#pragma unroll
      for (int sx = 0; sx < 2; ++sx)
#pragma unroll
        for (int m4 = 0; m4 < 4; ++m4) {
          const bf8 vf = *(const bf8*)(VMT + (32 * (4 * grp + m4) + r) * 256 + 32 * kt + 16 * sx + 8 * h);
          o[m4] = MFMA(vf, pf[kt][sx], o[m4]);
        }
#pragma unroll
    for (int m4 = 0; m4 < 4; ++m4)
#pragma unroll
      for (int g = 0; g < 4; ++g) {
        f4v v = {o[m4][4 * g] * inv, o[m4][4 * g + 1] * inv, o[m4][4 * g + 2] * inv, o[m4][4 * g + 3] * inv};
        *(bf4*)(qrow + (32 * (4 * grp + m4) + 8 * g + 4 * h) * 2) = cvt4(v);
      }
  }
}

DI void phase_c_tile(const MKParams& p, int tile, int wave, int lane, float& rs0, float& rs1) {
  asm volatile("" : "+v"(lane));
  char* ws = p.ws;
  char* ldsA = smem;
  float* red = (float*)(smem + LDS_A_BYTES);
  const size_t tok0 = (size_t)tile * 64;
  const int tid = wave * 64 + lane;
  __syncthreads();
  gla_g3_tile(p, tile, wave, lane, ldsA, LDS_ROW);
  {
    const char* osb = ws + OFF_OSB + tok0 * 1024;
#pragma unroll
    for (int it = 0; it < 8; ++it) {
      const int idx = tid + 512 * it, row = idx >> 6, ch = idx & 63;
      *(uint4*)(ldsA + row * LDS_ROW + 1024 + ch * 16) = *(const uint4*)(osb + (size_t)row * 1024 + ch * 16);
    }
  }
  __syncthreads();
  f16v acc[2][2];
  Pk pk0, pk1;
  float* hdst = p.out + tok0 * DM;
  {
    float ssq[2] = {0.f, 0.f};
    const bf8* wf = (const bf8*)(ws + OFF_WOUT);
    gemm_chunk<true, true>(ldsA, wf + (size_t)(2 * wave) * 4096, lane, acc, p.x + tok0 * DM + 64 * wave);
    store_f32_ssq(acc, hdst, 64 * wave, lane, ssq);
    pack_acc(pk0, acc, 1.f, 1.f);
    gemm_chunk<true, true>(ldsA, wf + (size_t)(16 + 2 * wave) * 4096, lane, acc, p.x + tok0 * DM + 512 + 64 * wave);
    store_f32_ssq(acc, hdst, 512 + 64 * wave, lane, ssq);
    pack_acc(pk1, acc, 1.f, 1.f);
    rms_from_partials(red, wave, lane, ssq, rs0, rs1);
  }
  pk_to_lds(ldsA, pk0, 64 * wave, lane);
  pk_to_lds(ldsA, pk1, 512 + 64 * wave, lane);
  __syncthreads();
  {
    const bf8* wf = (const bf8*)(ws + OFF_WMQ);
    gemm_chunk<true>(ldsA, wf + (size_t)(2 * wave) * 4096, lane, acc);
    pack_acc(pk0, acc, rs0, rs1);
    gemm_chunk<true>(ldsA, wf + (size_t)(16 + 2 * wave) * 4096, lane, acc);
    pack_acc(pk1, acc, rs0, rs1);
  }
  __syncthreads();
  pk_to_lds(ldsA, pk0, 64 * wave, lane);
  pk_to_lds(ldsA, pk1, 512 + 64 * wave, lane);
  __syncthreads();
  mem_attn(p, ldsA, tile >> 5, wave, lane);
  __syncthreads();
  {
    float ssq[2] = {0.f, 0.f};
    const bf8* wf = (const bf8*)(ws + OFF_WMO);
    gemm_chunk<true, true>(ldsA, wf + (size_t)(2 * wave) * 4096, lane, acc, hdst + 64 * wave);
    store_f32_ssq(acc, hdst, 64 * wave, lane, ssq);
    pack_acc(pk0, acc, 1.f, 1.f);
    gemm_chunk<true, true>(ldsA, wf + (size_t)(16 + 2 * wave) * 4096, lane, acc, hdst + 512 + 64 * wave);
    store_f32_ssq(acc, hdst, 512 + 64 * wave, lane, ssq);
    pack_acc(pk1, acc, 1.f, 1.f);
    rms_from_partials(red, wave, lane, ssq, rs0, rs1);
  }
  pk_to_lds(ldsA, pk0, 64 * wave, lane);
  pk_to_lds(ldsA, pk1, 512 + 64 * wave, lane);
  __syncthreads();
}
#define OFF_EG (OFF_LKV + 16 * MiB)
DI char* qp_scratch(char* ws, int blk) {
  return blk < 192 ? ws + OFF_SQ + (size_t)blk * 262144 : ws + OFF_LKV + (size_t)(blk - 192) * 262144;
}

DI unsigned f2ord(float v) { const unsigned u = __float_as_uint(v); return (u & 0x80000000u) ? ~u : (u | 0x80000000u); }
DI float ord2f(unsigned u) { return __uint_as_float((u & 0x80000000u) ? (u ^ 0x80000000u) : ~u); }

DI void ins16(unsigned (&L)[16], unsigned x) {
#pragma unroll
  for (int s = 0; s < 16; ++s) {
    const unsigned hi = max(L[s], x);
    x = min(L[s], x);
    L[s] = hi;
  }
}
DI void merge_halves16(unsigned (&L)[16]) {
  unsigned O[16];
#pragma unroll
  for (int s = 0; s < 16; ++s) O[s] = (unsigned)__shfl_xor((int)L[s], 32);
#pragma unroll
  for (int s = 0; s < 16; ++s) L[s] = max(L[s], O[15 - s]);
#pragma unroll
  for (int d = 8; d > 0; d >>= 1)
#pragma unroll
    for (int i = 0; i < 16; ++i)
      if ((i & d) == 0) {
        const unsigned hi = max(L[i], L[i + d]), lo = min(L[i], L[i + d]);
        L[i] = hi; L[i + d] = lo;
      }
}

DI void peer_top16(const char* ws, const u16* qp, int hp, int tt, int lane, unsigned (&L)[16]) {
  const int r = lane & 31, h = lane >> 5;
  const bf8* sk = (const bf8*)(ws + OFF_SUBK) + (size_t)hp * 4 * 8 * 64 + lane;
  f16v s[4];
#pragma unroll
  for (int mt = 0; mt < 4; ++mt) s[mt] = zero16();
#pragma unroll
  for (int ks = 0; ks < 8; ++ks) {
    const bf8 qf = *(const bf8*)(qp + (size_t)(32 * tt + r) * 2048 + hp * 128 + 16 * ks + 8 * h);
#pragma unroll
    for (int mt = 0; mt < 4; ++mt) s[mt] = MFMA(sk[(mt * 8 + ks) * 64], qf, s[mt]);
  }
#pragma unroll
  for (int i = 0; i < 16; ++i) L[i] = 0u;
#pragma unroll
  for (int mt = 0; mt < 4; ++mt)
#pragma unroll
    for (int i = 0; i < 16; ++i) {
      const unsigned key = (f2ord(s[mt][i]) & ~127u) | (unsigned)(127 - (32 * mt + crow(i, h)));
      ins16(L, key);
    }
  merge_halves16(L);
}

DI void peer_select(const char* ws, const u16* qp, uint2* eg, unsigned char* idxs  , int head,
                    int tt, int lane) {
  const int r = lane & 31, h = lane >> 5;
  unsigned La[16], Lb[16];
  peer_top16(ws, qp, 2 * head, tt, lane, La);
  __builtin_amdgcn_sched_barrier(0);
  peer_top16(ws, qp, 2 * head + 1, tt, lane, Lb);
  __builtin_amdgcn_sched_barrier(0);
  if (h == 0) {
#pragma unroll
    for (int g = 0; g < 4; ++g) {
      unsigned wa = 0, wb = 0;
#pragma unroll
      for (int j = 0; j < 4; ++j) {
        wa |= (127u - (La[4 * g + j] & 127u)) << (8 * j);
        wb |= (127u - (Lb[4 * g + j] & 127u)) << (8 * j);
      }
      *(unsigned*)(idxs + r * 32 + 4 * g) = wa;
      *(unsigned*)(idxs + r * 32 + 16 + 4 * g) = wb;
    }
  }
  float fa[16], fb[16];
#pragma unroll
  for (int i = 0; i < 16; ++i) { fa[i] = ord2f(La[i] & ~127u); fb[i] = ord2f(Lb[i] & ~127u); }
  unsigned C[16];
#pragma unroll
  for (int i = 0; i < 16; ++i) C[i] = 0u;
#define PEER_CAND(a, b) ins16(C, (f2ord(fa[a] + fb[b]) & ~255u) | (unsigned)(255 - ((a) * 16 + (b))));
#define PEER_ROW1(a) PEER_CAND(a, 0)
#define PEER_ROW2(a) PEER_ROW1(a) PEER_CAND(a, 1)
#define PEER_ROW3(a) PEER_ROW2(a) PEER_CAND(a, 2)
#define PEER_ROW4(a) PEER_ROW3(a) PEER_CAND(a, 3)
#define PEER_ROW5(a) PEER_ROW4(a) PEER_CAND(a, 4)
#define PEER_ROW8(a) PEER_ROW5(a) PEER_CAND(a, 5) PEER_CAND(a, 6) PEER_CAND(a, 7)
#define PEER_ROW16(a) PEER_ROW8(a) PEER_CAND(a, 8) PEER_CAND(a, 9) PEER_CAND(a, 10) PEER_CAND(a, 11) PEER_CAND(a, 12) PEER_CAND(a, 13) PEER_CAND(a, 14) PEER_CAND(a, 15)
  PEER_ROW16(0) PEER_ROW8(1) PEER_ROW5(2) PEER_ROW4(3) PEER_ROW3(4) PEER_ROW2(5) PEER_ROW2(6) PEER_ROW2(7)
  PEER_ROW1(8) PEER_ROW1(9) PEER_ROW1(10) PEER_ROW1(11) PEER_ROW1(12) PEER_ROW1(13) PEER_ROW1(14) PEER_ROW1(15)
  asm volatile("s_waitcnt lgkmcnt(0)" ::: "memory");
  const float vmax = ord2f(C[0] & ~255u);
  float ex[16], sum = 0.f;
#pragma unroll
  for (int i = 0; i < 16; ++i) { ex[i] = __expf(ord2f(C[i] & ~255u) - vmax); sum += ex[i]; }
  const float inv = 1.0f / sum;
  const unsigned hmask = 0u - (unsigned)h;
#pragma unroll
  for (int i = 0; i < 8; ++i) {
    const unsigned ck = C[i] ^ ((C[i] ^ C[8 + i]) & hmask);
    const unsigned gb = __float_as_uint(ex[i]) ^ ((__float_as_uint(ex[i]) ^ __float_as_uint(ex[8 + i])) & hmask);
    const float g = __uint_as_float(gb) * inv;
    const unsigned code = 255u - (ck & 255u);
    const unsigned ia = idxs[r * 32 + (code >> 4)], ib = idxs[r * 32 + 16 + (code & 15u)];
    eg[(size_t)(32 * tt + r) * 128 + head * 16 + 8 * h + i] = make_uint2(ia * 128u + ib, __float_as_uint(g));
  }
  asm volatile("s_waitcnt lgkmcnt(0)" ::: "memory");
}

DI float wave_sum(float v) {
#pragma unroll
  for (int o = 32; o > 0; o >>= 1) v += __shfl_xor(v, o);
  return v;
}

DI void reduce8(const float (&pv)[8], float& s0, float& s1) {
  float q[4], s[2];
#pragma unroll
  for (int m = 0; m < 4; ++m) {
    const auto r = __builtin_amdgcn_permlane32_swap(__float_as_uint(pv[m]), __float_as_uint(pv[m + 4]), false, false);
    q[m] = __uint_as_float(r[0]) + __uint_as_float(r[1]);
  }
#pragma unroll
  for (int m = 0; m < 2; ++m) {
    const auto r = __builtin_amdgcn_permlane16_swap(__float_as_uint(q[m]), __float_as_uint(q[m + 2]), false, false);
    s[m] = __uint_as_float(r[0]) + __uint_as_float(r[1]);
  }
#pragma unroll
  for (int m = 0; m < 2; ++m) {
    s[m] += __uint_as_float(__builtin_amdgcn_update_dpp(0, __float_as_uint(s[m]), 0x128, 0xf, 0xf, false));
    s[m] += __uint_as_float(__builtin_amdgcn_update_dpp(0, __float_as_uint(s[m]), 0x124, 0xf, 0xf, false));
    s[m] += __uint_as_float(__builtin_amdgcn_update_dpp(0, __float_as_uint(s[m]), 0x122, 0xf, 0xf, false));
    s[m] += __uint_as_float(__builtin_amdgcn_update_dpp(0, __float_as_uint(s[m]), 0x121, 0xf, 0xf, false));
  }
  s0 = s[0]; s1 = s[1];
}

DI void peer_bucket_token(const uint2* egt, unsigned* tmp  , int lane, unsigned& E0, unsigned& E1,
                          unsigned& G0, unsigned& G1) {
  const uint2 a = egt[lane], b = egt[64 + lane];
  const int ba = (int)(a.x >> 10), bb = (int)(b.x >> 10);
  const unsigned long long lt = (1ull << lane) - 1ull;
  int da = 0, db = 0, start = 0;
#pragma unroll
  for (int k = 0; k < 16; ++k) {
    const unsigned long long ma = __ballot(ba == k), mb = __ballot(bb == k);
    const int ca = __popcll(ma), cb = __popcll(mb);
    if (ba == k) da = start + __popcll(ma & lt);
    if (bb == k) db = start + ca + __popcll(mb & lt);
    start += ca + cb;
  }
  const int ia = (da & 1) * 64 + (da >> 3) + 16 * ((da >> 1) & 3);
  const int ib = (db & 1) * 64 + (db >> 3) + 16 * ((db >> 1) & 3);
  tmp[ia] = a.x; tmp[128 + ia] = a.y;
  tmp[ib] = b.x; tmp[128 + ib] = b.y;
  asm volatile("s_waitcnt lgkmcnt(0)" ::: "memory");
  E0 = tmp[lane]; E1 = tmp[64 + lane]; G0 = tmp[128 + lane]; G1 = tmp[192 + lane];
  asm volatile("s_waitcnt lgkmcnt(0)" ::: "memory");
}

DI void peer_finalize_token(const MKParams& p, float (&acc)[16], size_t tok, int lane) {
  float* orow = p.out + tok * DM + 16 * lane;
  float ss = 0.f;
#pragma unroll
  for (int q = 0; q < 4; ++q) {
    const f4v hv = *(const f4v*)(orow + 4 * q);
#pragma unroll
    for (int j = 0; j < 4; ++j) { acc[4 * q + j] += hv[j]; ss += acc[4 * q + j] * acc[4 * q + j]; }
  }
  ss = wave_sum(ss);
  const float rf = rsqrtf(ss * (1.0f / DM) + EPSV);
#pragma unroll
  for (int q = 0; q < 4; ++q) {
    const f4v gg = *(const f4v*)(p.g_fin + 16 * lane + 4 * q);
    f4v o = {acc[4 * q] * rf * gg[0], acc[4 * q + 1] * rf * gg[1], acc[4 * q + 2] * rf * gg[2], acc[4 * q + 3] * rf * gg[3]};
    *(f4v*)(orow + 4 * q) = o;
  }
}

DI void peer_usweep(const char* ws, const char* ldsA, int wave, int lane, const unsigned (&E)[8][2], float (&A)[8][2]) {
  const char* PU = ws + OFF_PU + 16 * lane;
#pragma unroll
  for (int i = 0; i < 8; ++i) { A[i][0] = 0.f; A[i][1] = 0.f; }
#pragma unroll 1
  for (int j = 0; j < 16; ++j) {
    const bool sel = ((lane & 15) == j);
#pragma unroll
    for (int i = 0; i < 8; ++i) {
      const char* xrow = ldsA + (8 * wave + i) * LDS_ROW + 32 * lane;
      const uint4 x0 = *(const uint4*)xrow, x1 = *(const uint4*)(xrow + 16);
      const unsigned xr[8] = {x0.x, x0.y, x0.z, x0.w, x1.x, x1.y, x1.z, x1.w};
      uint4 u0[8];
#pragma unroll
      for (int m = 0; m < 8; ++m) {
        const int e = __builtin_amdgcn_readlane((int)E[i][m & 1], j + 16 * (m >> 1));
        u0[m] = *(const uint4*)(PU + (size_t)e * 1024);
      }
      float pv[8];
#pragma unroll
      for (int m = 0; m < 8; ++m) {
        const unsigned uw[4] = {u0[m].x, u0[m].y, u0[m].z, u0[m].w};
        float dsum = 0.f;
#pragma unroll
        for (int q = 0; q < 4; ++q) {
          const bf2 lo = __builtin_amdgcn_cvt_scalef32_pk_bf16_fp8(uw[q], 1.0f, false);
          const bf2 hi = __builtin_amdgcn_cvt_scalef32_pk_bf16_fp8(uw[q], 1.0f, true);
          dsum = __builtin_amdgcn_fdot2_f32_bf16(lo, __builtin_bit_cast(bf2, xr[2 * q]), dsum, false);
          dsum = __builtin_amdgcn_fdot2_f32_bf16(hi, __builtin_bit_cast(bf2, xr[2 * q + 1]), dsum, false);
        }
        pv[m] = dsum;
      }
      float s0, s1;
      reduce8(pv, s0, s1);
      A[i][0] = sel ? s0 : A[i][0];
      A[i][1] = sel ? s1 : A[i][1];
    }
  }
}

template <int T0>
DI void peer_vsweep(const MKParams& p, int wave, int lane, size_t tok0, const unsigned (&E)[8][2], const unsigned (&Wb)[8][2]) {
  const char* PV = p.ws + OFF_PV + 16 * lane;
  float acc[4][16];
#pragma unroll
  for (int i = 0; i < 4; ++i)
#pragma unroll
    for (int q = 0; q < 16; ++q) acc[i][q] = 0.f;
#pragma unroll 1
  for (int j = 0; j < 16; ++j) {
#pragma unroll
    for (int i = 0; i < 4; ++i) {
      uint4 v0[8];
      unsigned wl[8];
#pragma unroll
      for (int m = 0; m < 8; ++m) {
        const int e = __builtin_amdgcn_readlane((int)E[T0 + i][m & 1], j + 16 * (m >> 1));
        wl[m] = (unsigned)__builtin_amdgcn_readlane((int)Wb[T0 + i][m & 1], j + 16 * (m >> 1));
        v0[m] = *(const uint4*)(PV + (size_t)e * 1024);
      }
#pragma unroll
      for (int m = 0; m < 8; ++m) {
        const unsigned vw[4] = {v0[m].x, v0[m].y, v0[m].z, v0[m].w};
        const bf2 wlo = __builtin_bit_cast(bf2, wl[m]), whi = __builtin_bit_cast(bf2, wl[m] << 16);
#pragma unroll
        for (int q = 0; q < 4; ++q) {
          const bf2 lo = __builtin_amdgcn_cvt_scalef32_pk_bf16_fp8(vw[q], 1.0f, false);
          const bf2 hi = __builtin_amdgcn_cvt_scalef32_pk_bf16_fp8(vw[q], 1.0f, true);
          acc[i][4 * q] = __builtin_amdgcn_fdot2_f32_bf16(lo, wlo, acc[i][4 * q], false);
          acc[i][4 * q + 1] = __builtin_amdgcn_fdot2_f32_bf16(lo, whi, acc[i][4 * q + 1], false);
          acc[i][4 * q + 2] = __builtin_amdgcn_fdot2_f32_bf16(hi, wlo, acc[i][4 * q + 2], false);
          acc[i][4 * q + 3] = __builtin_amdgcn_fdot2_f32_bf16(hi, whi, acc[i][4 * q + 3], false);
        }
      }
    }
  }
#pragma unroll
  for (int i = 0; i < 4; ++i) peer_finalize_token(p, acc[i], tok0 + 8 * wave + T0 + i, lane);
}

DI void phase_d_tile(const MKParams& p, int tile, int wave, int lane, float rs0, float rs1) {
  asm volatile("" : "+v"(lane));
  char* ws = p.ws;
  char* ldsA = smem;
  float* rs_s = (float*)(smem + LDS_A_BYTES);
  unsigned char* idxs = (unsigned char*)(smem + LDS_A_BYTES + 4096) + wave * 1024;
  u16* qp = (u16*)qp_scratch(ws, blockIdx.x);
  uint2* eg = (uint2*)(ws + OFF_EG + (size_t)blockIdx.x * 65536);
  const size_t tok0 = (size_t)tile * 64;
  if (wave == 0) { if (lane < 32) rs_s[lane] = rs0; else rs_s[lane] = rs1; }
  {
    f16v acc[2][2];
    const bf8* wf = (const bf8*)(ws + OFF_WPQ);
#pragma unroll 1
    for (int c = 0; c < 4; ++c) {
      int l2 = lane;
      asm volatile("" : "+v"(l2));
      const int r = l2 & 31, h = l2 >> 5;
      gemm_chunk<true>(ldsA, wf + (size_t)(c * 16 + 2 * wave) * 4096, l2, acc);
#pragma unroll
      for (int ntl = 0; ntl < 2; ++ntl)
#pragma unroll
        for (int tt = 0; tt < 2; ++tt)
#pragma unroll
          for (int g = 0; g < 4; ++g) {
            const float sc = tt ? rs1 : rs0;
            f4v v = {acc[ntl][tt][4 * g] * sc, acc[ntl][tt][4 * g + 1] * sc, acc[ntl][tt][4 * g + 2] * sc, acc[ntl][tt][4 * g + 3] * sc};
            *(bf4*)(qp + (size_t)(32 * tt + r) * 2048 + 512 * c + 64 * wave + 32 * ntl + 8 * g + 4 * h) = cvt4(v);
          }
    }
  }
  __syncthreads();
#pragma unroll 1
  for (int tt = 0; tt < 2; ++tt) {
    int l2 = lane;
    asm volatile("" : "+v"(l2));
    peer_select(ws, qp, eg, idxs, wave, tt, l2);
  }
  __syncthreads();
}

DI void phase_d_gather(const MKParams& p, int tile, int wave, int lane) {
  asm volatile("" : "+v"(lane));
  char* ws = p.ws;
  char* ldsA = smem;
  float* rs_s = (float*)(smem + LDS_A_BYTES);
  unsigned char* idxs = (unsigned char*)(smem + LDS_A_BYTES + 4096) + wave * 1024;
  const uint2* eg = (const uint2*)(ws + OFF_EG + (size_t)blockIdx.x * 65536);
  const size_t tok0 = (size_t)tile * 64;
  {
    int l2 = lane;
    asm volatile("" : "+v"(l2));
    unsigned E[8][2], G[8][2];
#pragma unroll
    for (int i = 0; i < 8; ++i)
      peer_bucket_token(eg + (size_t)(8 * wave + i) * 128, (unsigned*)idxs, l2, E[i][0], E[i][1], G[i][0], G[i][1]);
    float A[8][2];
    peer_usweep(ws, ldsA, wave, l2, E, A);
    unsigned Wb[8][2];
#pragma unroll
    for (int i = 0; i < 8; ++i) {
      const float rs = rs_s[8 * wave + i];
#pragma unroll
      for (int cc = 0; cc < 2; ++cc) {
        const float a = A[i][cc] * rs * ((const float*)(ws + OFF_SU))[E[i][cc]];
        const float w = __uint_as_float(G[i][cc]) * 0.5f * a * (1.0f + erff(a * 0.70710678118654752f)) *
                        ((const float*)(ws + OFF_SV))[E[i][cc]];
        Wb[i][cc] = __builtin_bit_cast(unsigned, __builtin_convertvector((f2v){w, 0.f}, bf2));
      }
    }
    __builtin_amdgcn_sched_barrier(0);
    peer_vsweep<0>(p, wave, l2, tok0, E, Wb);
    __builtin_amdgcn_sched_barrier(0);
    peer_vsweep<4>(p, wave, l2, tok0, E, Wb);
  }
}
__global__ __launch_bounds__(512) void mk(MKParams p) {
  cg::grid_group grid = cg::this_grid();
  const int tid = threadIdx.x;
  const int wave = __builtin_amdgcn_readfirstlane(tid >> 6), lane = tid & 63;
  const int gtid = blockIdx.x * 512 + tid, gthreads = gridDim.x * 512;
  const int gw = blockIdx.x * 8 + wave, nw = gridDim.x * 8;
  phase_prep(p, gtid, gthreads);
  phase_prep_tables(p, gw, nw, lane);
  grid.sync();
  for (int tile = blockIdx.x; tile < 256; tile += gridDim.x) phase_a_tile(p, tile, wave, lane);
  for (int item = blockIdx.x; item < 128; item += gridDim.x) phase_a_memkv(p, item, wave, lane);
  grid.sync();
  for (int it = gw; it < 4096; it += nw) sb_item(p, it, lane);
  for (int it = nw - 1 - gw; it < 1024; it += nw) gla_g1_item(p, it, wave, lane);
  grid.sync();
  gla_g2(p, gtid, gthreads);
  grid.sync();
  const int n_iter = (256 + gridDim.x - 1) / gridDim.x;
  for (int it = 0; it < n_iter; ++it) {
    const int tile = blockIdx.x + it * gridDim.x;
    if (tile < 256) {
      float rs0, rs1;
      phase_c_tile(p, tile, wave, lane, rs0, rs1);
      phase_d_tile(p, tile, wave, lane, rs0, rs1);
    }
    if (tile < 256) phase_d_gather(p, tile, wave, lane);
  }
}
#define MK_LDS (160 * 1024)
extern "C" void kernel_launch(void* const* d_in, const int* in_sizes, int n_in, void* d_out, int out_size, void* d_ws,
                              size_t ws_size, hipStream_t stream) {
  MKParams p{};
  p.x = (const float*)d_in[0]; p.mem = (const float*)d_in[1]; p.g_mix = (const float*)d_in[2];
  p.w_in = (const float*)d_in[3]; p.w_up = (const float*)d_in[4]; p.b_alpha = (const float*)d_in[5];
  p.g_gla = (const float*)d_in[6]; p.w_out = (const float*)d_in[7]; p.g_mq = (const float*)d_in[8];
  p.g_mkv = (const float*)d_in[9]; p.w_mq = (const float*)d_in[10]; p.w_mkv = (const float*)d_in[11];
  p.w_mo = (const float*)d_in[12]; p.g_ffn = (const float*)d_in[13]; p.w_pq = (const float*)d_in[14];
  p.subk = (const float*)d_in[15]; p.pu = (const float*)d_in[16]; p.pv = (const float*)d_in[17];
  p.g_fin = (const float*)d_in[18];
  p.out = (float*)d_out; p.ws = (char*)d_ws;
  float* out = (float*)d_out;
  char* wsb = (char*)d_ws;
  float* ws = (float*)d_ws;
  static int grid_blocks = 0;
  if (!grid_blocks) {
    int dev = 0, cus = 0, per_cu = 0;
    (void)hipGetDevice(&dev);
    (void)hipDeviceGetAttribute(&cus, hipDeviceAttributeMultiprocessorCount, dev);
    (void)hipFuncSetAttribute((const void*)mk, hipFuncAttributeMaxDynamicSharedMemorySize, MK_LDS);
    (void)hipOccupancyMaxActiveBlocksPerMultiprocessor(&per_cu, mk, 512, MK_LDS);
    grid_blocks = cus * per_cu;
    fprintf(stderr, "mk: cus=%d per_cu=%d grid=%d ws=%zu\n", cus, per_cu, grid_blocks, ws_size);
  }
  {
    void* args[] = {(void*)&p};
    hipError_t e = hipLaunchCooperativeKernel((const void*)mk, dim3(grid_blocks), dim3(512), args, MK_LDS, stream);
    if (e != hipSuccess) fprintf(stderr, "coop launch failed: %s grid %d\n", hipGetErrorString(e), grid_blocks);
  }
}
```

```cpp
#define GEMM_D 4
#include <hip/hip_runtime.h>
#include <hip/hip_cooperative_groups.h>
#include <math.h>
#include <stdio.h>
#include <stdint.h>
namespace cg = cooperative_groups;

#define NB 8
#define SEQ 2048
#define DM 1024
#define NTOK (NB * SEQ)
#define INC 3088
#define MEML 256
#define EPSV 1e-6f

typedef __attribute__((ext_vector_type(8))) __bf16 bf8;
typedef __attribute__((ext_vector_type(4))) __bf16 bf4;
typedef __attribute__((ext_vector_type(2))) __bf16 bf2;
typedef __attribute__((ext_vector_type(16))) float f16v;
typedef __attribute__((ext_vector_type(8))) float f8v;
typedef __attribute__((ext_vector_type(4))) float f4v;
typedef __attribute__((ext_vector_type(2))) float f2v;
typedef unsigned short u16;

#define DI __device__ __forceinline__
#define MFMA(a, b, c) __builtin_amdgcn_mfma_f32_32x32x16_bf16((a), (b), (c), 0, 0, 0)

DI int crow(int i, int h) { return (i & 3) + 8 * (i >> 2) + 4 * h; }
DI int tpos(int t) { return (t & ~12) | ((t & 4) << 1) | ((t & 8) >> 1); }
DI float bf2f(u16 v) { return __uint_as_float(((unsigned)v) << 16); }
DI bf8 cvt8(f8v v) { return __builtin_convertvector(v, bf8); }
DI bf4 cvt4(f4v v) { return __builtin_convertvector(v, bf4); }
DI f16v zero16() { f16v z = {0.f, 0.f, 0.f, 0.f, 0.f, 0.f, 0.f, 0.f, 0.f, 0.f, 0.f, 0.f, 0.f, 0.f, 0.f, 0.f}; return z; }

#define MiB ((size_t)1 << 20)
#define OFF_WIN   ((size_t)0)
#define OFF_WOUT  (OFF_WIN + 97 * 65536)
#define OFF_WMQ   (OFF_WOUT + 32 * 65536)
#define OFF_WMKV  (OFF_WMQ + 32 * 65536)
#define OFF_WMO   (OFF_WMKV + 64 * 65536)
#define OFF_WPQ   (OFF_WMO + 32 * 65536)
#define OFF_SUBK  (OFF_WPQ + 64 * 65536)
#define OFF_ACT   (21 * MiB)
#define OFF_GQ    (OFF_ACT)
#define OFF_GK    (OFF_GQ + 8 * MiB)
#define OFF_GVT   (OFF_GK + 8 * MiB)
#define OFF_OG    (OFF_GVT + 16 * MiB)
#define OFF_SQ    (OFF_OG + 16 * MiB)
#define OFF_SK    (OFF_SQ + 16 * MiB)
#define OFF_SVT   (OFF_SK + 16 * MiB)
#define OFF_LA    (OFF_SVT + 16 * MiB)
#define OFF_LKV   (OFF_LA + 16 * MiB)
#define OFF_DD    (OFF_LKV + 32 * MiB)
#define OFF_OSB   (OFF_DD + 1 * MiB)
#define OFF_KM    (OFF_OSB + 16 * MiB)
#define OFF_VMT   (OFF_KM + 4 * MiB)
#define OFF_PU    (OFF_VMT + 4 * MiB)
#define OFF_PV    (OFF_PU + 16 * MiB)
#define OFF_SU    (OFF_PV + 16 * MiB)
#define OFF_SV    (OFF_SU + 65536)
#define OFF_SS    (OFF_LA)

#define LDS_ROW 2064
#define LDS_A_BYTES (64 * LDS_ROW)

DI char* qp_scratch(char* ws, int blk) {
  return blk < 192 ? ws + OFF_SQ + (size_t)blk * 262144 : ws + OFF_LKV + (size_t)(blk - 192) * 262144;
}

struct MKParams {
  const float *x, *mem, *g_mix, *w_in, *w_up, *b_alpha, *g_gla, *w_out, *g_mq, *g_mkv, *w_mq, *w_mkv, *w_mo, *g_ffn, *w_pq,
      *subk, *pu, *pv, *g_fin;
  float* out;
  char* ws;
};
extern __shared__ __attribute__((aligned(16))) char smem[];

template <typename ColFn>
DI void prep_w(bf8* dst, const float* __restrict__ W, int ldw, int ntiles, const float* __restrict__ gain, ColFn colfn,
               int gtid, int gthreads) {
  const int total = ntiles * 4096;
  for (int u = gtid; u < total; u += gthreads) {
    const int lane = u & 63, ks = (u >> 6) & 63, nt = u >> 12;
    const int r = lane & 31, h = lane >> 5;
    float sc = 1.f;
    const int col = colfn(32 * nt + r, sc);
    f8v v;
#pragma unroll
    for (int j = 0; j < 8; ++j) {
      const int k = 16 * ks + 8 * h + j;
      float val = 0.f;
      if (col >= 0) val = W[(size_t)k * ldw + col] * sc * (gain ? gain[k] : 1.f);
      v[j] = val;
    }
    const int didx = (nt < (ntiles & ~15)) ? ((((nt >> 4) * 64 + ks) * 16 + (nt & 15)) * 64 + lane) : u;
    dst[didx] = cvt8(v);
  }
}

DI void phase_prep(const MKParams& p, int gtid, int gthreads) {
  char* ws = p.ws;
  prep_w((bf8*)(ws + OFF_WIN), p.w_in, INC, 97, p.g_mix,
         [](int n, float& sc) -> int {
           if (n < 256) { sc = 0.125f; return n; }
           if (n < 1536) return n;
           if (n < 2048) { sc = 0.125f; return n + 16; }
           if (n < 3072) return n + 16;
           if (n < 3088) return n - 1536;
           return -1;
         }, gtid, gthreads);
  prep_w((bf8*)(ws + OFF_WOUT), p.w_out, 1024, 32, nullptr, [](int n, float& sc) -> int { return n; }, gtid, gthreads);
  prep_w((bf8*)(ws + OFF_WMQ), p.w_mq, 1024, 32, p.g_mq, [](int n, float& sc) -> int { sc = 0.0625f; return n; }, gtid, gthreads);
  prep_w((bf8*)(ws + OFF_WMKV), p.w_mkv, 2048, 64, p.g_mkv, [](int n, float& sc) -> int { return n; }, gtid, gthreads);
  prep_w((bf8*)(ws + OFF_WMO), p.w_mo, 1024, 32, nullptr, [](int n, float& sc) -> int { return n; }, gtid, gthreads);
  prep_w((bf8*)(ws + OFF_WPQ), p.w_pq, 2048, 64, p.g_ffn, [](int n, float& sc) -> int { return n; }, gtid, gthreads);
  {
    bf8* dst = (bf8*)(ws + OFF_SUBK);
    const int total = 16 * 4 * 8 * 64;
    for (int u = gtid; u < total; u += gthreads) {
      const int lane = u & 63, ks = (u >> 6) & 7, mt = (u >> 9) & 3, hp = u >> 11;
      const int r = lane & 31, h = lane >> 5;
      const float* s = p.subk + ((size_t)(hp * 128 + 32 * mt + r)) * 128 + 16 * ks + 8 * h;
      const f4v a = *(const f4v*)s, b = *(const f4v*)(s + 4);
      f8v v = {a[0], a[1], a[2], a[3], b[0], b[1], b[2], b[3]};
      dst[u] = cvt8(v);
    }
  }
}

DI void phase_prep_tables(const MKParams& p, int gwave, int nwaves, int lane) {
  for (int row = gwave; row < 32768; row += nwaves) {
    const int e = row & 16383;
    const bool isv = row >= 16384;
    const float* src = (isv ? p.pv : p.pu) + (size_t)e * DM + 16 * lane;
    f4v v[4];
#pragma unroll
    for (int q = 0; q < 4; ++q) v[q] = *(const f4v*)(src + 4 * q);
    if (!isv) {
#pragma unroll
      for (int q = 0; q < 4; ++q) v[q] = v[q] * *(const f4v*)(p.g_ffn + 16 * lane + 4 * q);
    }
    float am = 0.f;
#pragma unroll
    for (int q = 0; q < 4; ++q)
#pragma unroll
      for (int j = 0; j < 4; ++j) am = fmaxf(am, fabsf(v[q][j]));
#pragma unroll
    for (int o = 32; o > 0; o >>= 1) am = fmaxf(am, __shfl_xor(am, o));
    int k = 0;
    if (am > 0.f) k = 7 - ilogbf(am);
    k = max(-100, min(100, k));
    const float sc = ldexpf(1.0f, k);
    unsigned w[4];
#pragma unroll
    for (int q = 0; q < 4; ++q) {
      int pk = 0;
      pk = __builtin_amdgcn_cvt_pk_fp8_f32(v[q][0] * sc, v[q][1] * sc, pk, false);
      pk = __builtin_amdgcn_cvt_pk_fp8_f32(v[q][2] * sc, v[q][3] * sc, pk, true);
      w[q] = (unsigned)pk;
    }
    *(uint4*)(p.ws + (isv ? OFF_PV : OFF_PU) + (size_t)e * 1024 + 16 * lane) = make_uint4(w[0], w[1], w[2], w[3]);
    if (lane == 0) ((float*)(p.ws + (isv ? OFF_SV : OFF_SU)))[e] = ldexpf(1.0f, -k);
  }
}

DI void load_norm_tile(const float* __restrict__ src, char* ldsA, int wave, int lane) {
#pragma unroll 2
  for (int i = 0; i < 8; ++i) {
    const int row = 8 * wave + i;
    const f4v* pr = (const f4v*)(src + (size_t)row * DM);
    f4v v[4];
#pragma unroll
    for (int c = 0; c < 4; ++c) v[c] = pr[lane + 64 * c];
    float ss = 0.f;
#pragma unroll
    for (int c = 0; c < 4; ++c) ss += v[c][0] * v[c][0] + v[c][1] * v[c][1] + v[c][2] * v[c][2] + v[c][3] * v[c][3];
#pragma unroll
    for (int o = 32; o > 0; o >>= 1) ss += __shfl_xor(ss, o);
    const float rs = rsqrtf(ss * (1.0f / DM) + EPSV);
#pragma unroll
    for (int c = 0; c < 4; ++c) {
      f4v t = v[c] * rs;
      *(bf4*)(ldsA + row * LDS_ROW + (lane * 4 + 256 * c) * 2) = cvt4(t);
    }
  }
}

#ifndef GEMM_D
#define GEMM_D 6
#endif
template <bool SWAP>
DI void gemm_step(f16v (&acc)[2][2], const bf8& a0, const bf8& a1, const bf8& x0, const bf8& x1) {
  if (SWAP) {
    acc[0][0] = MFMA(a0, x0, acc[0][0]); acc[0][1] = MFMA(a0, x1, acc[0][1]);
    acc[1][0] = MFMA(a1, x0, acc[1][0]); acc[1][1] = MFMA(a1, x1, acc[1][1]);
  } else {
    acc[0][0] = MFMA(x0, a0, acc[0][0]); acc[0][1] = MFMA(x1, a0, acc[0][1]);
    acc[1][0] = MFMA(x0, a1, acc[1][0]); acc[1][1] = MFMA(x1, a1, acc[1][1]);
  }
}
template <bool SWAP, bool RES = false>
DI void gemm_chunk(const char* ldsA, const bf8* __restrict__ wf, int lane, f16v (&acc)[2][2], const float* res = nullptr) {
  __builtin_amdgcn_sched_barrier(0);
  const int r = lane & 31, h = lane >> 5;
  const char* xa0 = ldsA + r * LDS_ROW + h * 16;
  const char* xa1 = xa0 + 32 * LDS_ROW;
  const bf8* w0p = wf + lane;
  const bf8* w1p = wf + 64 + lane;
  bf8 w0[GEMM_D], w1[GEMM_D];
#pragma unroll
  for (int i = 0; i < GEMM_D; ++i) { w0[i] = w0p[i * 1024]; w1[i] = w1p[i * 1024]; }
  if (RES) {
#pragma unroll
    for (int ntl = 0; ntl < 2; ++ntl)
#pragma unroll
      for (int tt = 0; tt < 2; ++tt)
#pragma unroll
        for (int g = 0; g < 4; ++g) {
          const f4v x = *(const f4v*)(res + (size_t)(32 * tt + r) * DM + 32 * ntl + 8 * g + 4 * h);
          acc[ntl][tt][4 * g] = x[0]; acc[ntl][tt][4 * g + 1] = x[1]; acc[ntl][tt][4 * g + 2] = x[2]; acc[ntl][tt][4 * g + 3] = x[3];
        }
  } else {
    acc[0][0] = zero16(); acc[0][1] = zero16(); acc[1][0] = zero16(); acc[1][1] = zero16();
  }
  bf8 x0 = *(const bf8*)(xa0), x1 = *(const bf8*)(xa1);
  constexpr int KMAIN = ((64 - 2 * GEMM_D) / GEMM_D + 1) * GEMM_D;
#pragma unroll 1
  for (int ks0 = 0; ks0 < KMAIN; ks0 += GEMM_D) {
#pragma unroll
    for (int i = 0; i < GEMM_D; ++i) {
      const int ks = ks0 + i;
      const bf8 xn0 = *(const bf8*)(xa0 + (ks + 1) * 32);
      const bf8 xn1 = *(const bf8*)(xa1 + (ks + 1) * 32);
      gemm_step<SWAP>(acc, w0[i], w1[i], x0, x1);
      w0[i] = w0p[(ks + GEMM_D) * 1024];
      w1[i] = w1p[(ks + GEMM_D) * 1024];
      x0 = xn0; x1 = xn1;
      __builtin_amdgcn_sched_group_barrier(0x100, 2, 0);
      __builtin_amdgcn_sched_group_barrier(0x008, 2, 0);
      __builtin_amdgcn_sched_group_barrier(0x020, 2, 0);
      __builtin_amdgcn_sched_group_barrier(0x008, 2, 0);
    }
  }
#pragma unroll
  for (int t = 0; t < 64 - KMAIN; ++t) {
    const int ks = KMAIN + t, i = t % GEMM_D;
    const bf8 xn0 = *(const bf8*)(xa0 + (ks + 1) * 32);
    const bf8 xn1 = *(const bf8*)(xa1 + (ks + 1) * 32);
    gemm_step<SWAP>(acc, w0[i], w1[i], x0, x1);
    if (ks + GEMM_D < 64) {
      w0[i] = w0p[(ks + GEMM_D) * 1024];
      w1[i] = w1p[(ks + GEMM_D) * 1024];
    }
    x0 = xn0; x1 = xn1;
    __builtin_amdgcn_sched_group_barrier(0x100, 2, 0);
    __builtin_amdgcn_sched_group_barrier(0x008, 2, 0);
    if (ks + GEMM_D < 64) __builtin_amdgcn_sched_group_barrier(0x020, 2, 0);
    __builtin_amdgcn_sched_group_barrier(0x008, 2, 0);
  }
}

DI void store_swap_bf16(u16* dst, size_t ld, const f16v (&acc)[2][2], int lane) {
  const int r = lane & 31, h = lane >> 5;
#pragma unroll
  for (int ntl = 0; ntl < 2; ++ntl)
#pragma unroll
    for (int tt = 0; tt < 2; ++tt)
#pragma unroll
      for (int g = 0; g < 4; ++g) {
        f4v v = {acc[ntl][tt][4 * g], acc[ntl][tt][4 * g + 1], acc[ntl][tt][4 * g + 2], acc[ntl][tt][4 * g + 3]};
        *(bf4*)(dst + (size_t)(32 * tt + r) * ld + 32 * ntl + 8 * g + 4 * h) = cvt4(v);
      }
}
DI void store_vt_bf16(u16* dst, size_t ld, const f16v (&acc)[2][2], int lane) {
  const int r = lane & 31, h = lane >> 5;
#pragma unroll
  for (int ntl = 0; ntl < 2; ++ntl)
#pragma unroll
    for (int tt = 0; tt < 2; ++tt)
#pragma unroll
      for (int s = 0; s < 2; ++s) {
        f8v v;
#pragma unroll
        for (int j = 0; j < 8; ++j) v[j] = acc[ntl][tt][8 * s + j];
        *(bf8*)(dst + (size_t)(32 * ntl + r) * ld + 32 * tt + 16 * s + 8 * h) = cvt8(v);
      }
}

DI float log_sigmoid_acc(float x) { return fminf(x, 0.f) - log1pf(expf(-fabsf(x))); }

DI void phase_a_tile(const MKParams& p, int tile, int wave, int lane) {
  asm volatile("" : "+v"(lane));
  char* ws = p.ws;
  char* ldsA = smem;
  float* alr_s = (float*)(smem + LDS_A_BYTES);
  const int b = tile >> 5, c = tile & 31;
  const size_t tok0 = (size_t)tile * 64;
  __syncthreads();
  load_norm_tile(p.x + tok0 * DM, ldsA, wave, lane);
  __syncthreads();
  const bf8* wf = (const bf8*)(ws + OFF_WIN);
  f16v acc[2][2];
  const int t0 = c * 64;
  gemm_chunk<true>(ldsA, wf + (size_t)0 * 65536 + 2 * wave * 64, lane, acc);
  {
    u16* base = (u16*)(ws + (wave < 4 ? OFF_GQ : OFF_GK)) + ((size_t)(b * 4 + (wave & 3)) * SEQ + t0) * 64;
    store_swap_bf16(base, 64, acc, lane);
  }
  gemm_chunk<false>(ldsA, wf + (size_t)1 * 65536 + 2 * wave * 64, lane, acc);
  {
    u16* base = (u16*)(ws + OFF_GVT) + ((size_t)(b * 4 + (wave >> 1)) * 128 + 64 * (wave & 1)) * SEQ + t0;
    store_vt_bf16(base, SEQ, acc, lane);
  }
  gemm_chunk<true>(ldsA, wf + (size_t)2 * 65536 + 2 * wave * 64, lane, acc);
  store_swap_bf16((u16*)(ws + OFF_OG) + tok0 * 512 + 64 * wave, 512, acc, lane);
  gemm_chunk<true>(ldsA, wf + (size_t)3 * 65536 + 2 * wave * 64, lane, acc);
  store_swap_bf16((u16*)(ws + OFF_SQ) + ((size_t)(b * 8 + wave) * SEQ + t0) * 64, 64, acc, lane);
  gemm_chunk<true>(ldsA, wf + (size_t)4 * 65536 + 2 * wave * 64, lane, acc);
  store_swap_bf16((u16*)(ws + OFF_SK) + ((size_t)(b * 8 + wave) * SEQ + t0) * 64, 64, acc, lane);
  gemm_chunk<false>(ldsA, wf + (size_t)5 * 65536 + 2 * wave * 64, lane, acc);
  store_vt_bf16((u16*)(ws + OFF_SVT) + ((size_t)(b * 8 + wave) * 64) * SEQ + t0, SEQ, acc, lane);
  if (wave == 7) {
    const int r = lane & 31, h = lane >> 5;
    const bf8* wp = wf + (size_t)96 * 4096 + lane;
    const char* xa0 = ldsA + r * LDS_ROW + h * 16;
    const char* xa1 = xa0 + 32 * LDS_ROW;
    f16v a0 = zero16(), a1 = zero16();
#pragma unroll 8
    for (int ks = 0; ks < 64; ++ks) {
      const bf8 w = wp[ks * 64];
      a0 = MFMA(w, *(const bf8*)(xa0 + ks * 32), a0);
      a1 = MFMA(w, *(const bf8*)(xa1 + ks * 32), a1);
    }
#pragma unroll
    for (int i = 0; i < 8; ++i) {
      alr_s[(r) * 16 + crow(i, h)] = a0[i];
      alr_s[(32 + r) * 16 + crow(i, h)] = a1[i];
    }
  }
  __syncthreads();
  {
    const int tid = wave * 64 + lane;
    const int tk = tid >> 3, c0 = (tid & 7) * 32;
    float a[16];
#pragma unroll
    for (int rr = 0; rr < 16; ++rr) a[rr] = alr_s[tk * 16 + rr];
    float* dst = (float*)(ws + OFF_LA) + (tok0 + tk) * 256 + c0;
#pragma unroll 4
    for (int cc = 0; cc < 32; ++cc) {
      float s = p.b_alpha[c0 + cc];
#pragma unroll
      for (int rr = 0; rr < 16; ++rr) s = fmaf(a[rr], p.w_up[rr * 256 + c0 + cc], s);
      dst[cc] = log_sigmoid_acc(s) * (1.0f / 16.0f);
    }
  }
}

DI void phase_a_memkv(const MKParams& p, int item, int wave, int lane) {
  asm volatile("" : "+v"(lane));
  char* ws = p.ws;
  char* ldsA = smem;
  const int rt = item >> 2, cc = item & 3;
  const int b = rt >> 2, m0 = (rt & 3) * 64;
  __syncthreads();
  load_norm_tile(p.mem + (size_t)rt * 64 * DM, ldsA, wave, lane);
  __syncthreads();
  const bf8* wf = (const bf8*)(ws + OFF_WMKV);
  f16v acc[2][2];
  if (cc < 2) {
    gemm_chunk<true>(ldsA, wf + (size_t)cc * 65536 + 2 * wave * 64, lane, acc);
    const int f0 = 512 * cc + 64 * wave;
    u16* base = (u16*)(ws + OFF_KM) + ((size_t)(b * 4 + (f0 >> 8)) * 256 + m0) * 256 + (f0 & 255);
    store_swap_bf16(base, 256, acc, lane);
  } else {
    gemm_chunk<false>(ldsA, wf + (size_t)cc * 65536 + 2 * wave * 64, lane, acc);
    const int f0 = 512 * (cc - 2) + 64 * wave;
    u16* base = (u16*)(ws + OFF_VMT) + ((size_t)(b * 4 + (f0 >> 8)) * 256 + (f0 & 255)) * 256 + m0;
    store_vt_bf16(base, 256, acc, lane);
  }
}
#define SB_THR 30.0f

DI bf8 pack8(const f16v& x, int s) {
  f8v v;
#pragma unroll
  for (int j = 0; j < 8; ++j) v[j] = x[8 * s + j];
  return cvt8(v);
}

DI void sb_item(const MKParams& p, int item, int lane) {
  asm volatile("" : "+v"(lane));
  char* ws = p.ws;
  const int r = lane & 31, h = lane >> 5;
  const int bh = item >> 6, qt = item & 63;
  const u16* SQ = (const u16*)(ws + OFF_SQ) + (size_t)bh * SEQ * 64;
  const u16* SK = (const u16*)(ws + OFF_SK) + (size_t)bh * SEQ * 64;
  const u16* SVT = (const u16*)(ws + OFF_SVT) + (size_t)bh * 64 * SEQ;
  bf8 qf[4];
#pragma unroll
  for (int ks = 0; ks < 4; ++ks) qf[ks] = *(const bf8*)(SQ + (size_t)(32 * qt + r) * 64 + 16 * ks + 8 * h);
  bf8 tri[2];
#pragma unroll
  for (int s = 0; s < 2; ++s) {
    f8v t;
#pragma unroll
    for (int j = 0; j < 8; ++j) t[j] = (16 * s + 8 * (j >> 2) + 4 * h + (j & 3) >= r) ? 1.0f : 0.0f;
    tri[s] = cvt8(t);
  }
  f16v o0 = zero16(), o1 = zero16();
  float R = 0.f;
  for (int kt = qt; kt >= 0; --kt) {
    bf8 kf[4], vf[2][2];
#pragma unroll
    for (int ks = 0; ks < 4; ++ks) kf[ks] = *(const bf8*)(SK + (size_t)(32 * kt + r) * 64 + 16 * ks + 8 * h);
#pragma unroll
    for (int mt = 0; mt < 2; ++mt)
#pragma unroll
      for (int s = 0; s < 2; ++s) vf[mt][s] = *(const bf8*)(SVT + (size_t)(32 * mt + r) * SEQ + 32 * kt + 16 * s + 8 * h);
    f16v z = zero16();
#pragma unroll
    for (int ks = 0; ks < 4; ++ks) z = MFMA(kf[ks], qf[ks], z);
    const bool diag = (kt == qt);
    f16v sp;
    float tot = 0.f;
#pragma unroll
    for (int i = 0; i < 16; ++i) {
      const float zz = z[i];
      const float sv = fmaxf(zz, 0.f) + __logf(1.0f + __expf(-fabsf(zz)));
      const bool valid = !diag || (crow(i, h) < r);
      sp[i] = valid ? sv : 0.f;
      tot += sp[i];
    }
    tot += __shfl_xor(tot, 32);
    f16v C = MFMA(tri[0], pack8(sp, 0), zero16());
    C = MFMA(tri[1], pack8(sp, 1), C);
    f16v a;
#pragma unroll
    for (int i = 0; i < 16; ++i) {
      const bool valid = !diag || (crow(i, h) < r);
      a[i] = valid ? __expf(z[i] - C[i] - R) : 0.f;
    }
    const bf8 a0 = pack8(a, 0), a1 = pack8(a, 1);
    o0 = MFMA(vf[0][0], a0, o0); o0 = MFMA(vf[0][1], a1, o0);
    o1 = MFMA(vf[1][0], a0, o1); o1 = MFMA(vf[1][1], a1, o1);
    R += tot;
    if (__all(R > SB_THR)) break;
  }
  const int b = bh >> 3, hd = bh & 7;
  u16* dst = (u16*)(ws + OFF_OSB) + ((size_t)b * SEQ + 32 * qt + r) * 512 + hd * 64 + 4 * h;
#pragma unroll
  for (int g = 0; g < 4; ++g) {
    f4v v0 = {o0[4 * g], o0[4 * g + 1], o0[4 * g + 2], o0[4 * g + 3]};
    f4v v1 = {o1[4 * g], o1[4 * g + 1], o1[4 * g + 2], o1[4 * g + 3]};
    *(bf4*)(dst + 8 * g) = cvt4(v0);
    *(bf4*)(dst + 32 + 8 * g) = cvt4(v1);
  }
}

DI void gla_g1_item(const MKParams& p, int item, int wave, int lane) {
  asm volatile("" : "+v"(lane));
  char* ws = p.ws;
  const int r = lane & 31, h = lane >> 5;
  const int bh = item >> 5, c = item & 31, b = bh >> 2, hd = bh & 3;
  char* kl = smem + wave * 9216;
  u16* GQ = (u16*)(ws + OFF_GQ) + ((size_t)bh * SEQ + 64 * c) * 64;
  u16* GK = (u16*)(ws + OFF_GK) + ((size_t)bh * SEQ + 64 * c) * 64;
  const float* LA = (const float*)(ws + OFF_LA) + ((size_t)b * SEQ + 64 * c) * 256 + hd * 64;
  float bc = 0.f;
#pragma unroll 1
  for (int g = 0; g < 4; ++g) {
    float la_[16];
    u16 q_[16], k_[16];
#pragma unroll
    for (int i = 0; i < 16; ++i) {
      const int t = 16 * g + i;
      la_[i] = LA[(size_t)t * 256 + lane];
      q_[i] = GQ[t * 64 + lane];
      k_[i] = GK[t * 64 + lane];
    }
#pragma unroll
    for (int i = 0; i < 16; ++i) {
      const int t = 16 * g + i;
      bc += la_[i];
      const float eq = __expf(bc);
      const float qn = bf2f(q_[i]) * eq, kn = bf2f(k_[i]) / eq;
      const bf2 pk = __builtin_convertvector((f2v){qn, kn}, bf2);
      const unsigned u = __builtin_bit_cast(unsigned, pk);
      GQ[t * 64 + lane] = (u16)(u & 0xffff);
      GK[t * 64 + lane] = (u16)(u >> 16);
      *(u16*)(kl + lane * 144 + tpos(t) * 2) = (u16)(u >> 16);
    }
  }
  ((float*)(ws + OFF_DD))[(size_t)item * 64 + lane] = __expf(bc);
  asm volatile("s_waitcnt lgkmcnt(0)" ::: "memory");
  const u16* GVT = (const u16*)(ws + OFF_GVT) + (size_t)bh * 128 * SEQ + 64 * c;
  float* LKV = (float*)(ws + OFF_LKV) + (size_t)item * 128 * 64;
  bf8 kb[2][4];
#pragma unroll
  for (int nt = 0; nt < 2; ++nt)
#pragma unroll
    for (int s = 0; s < 4; ++s) kb[nt][s] = *(const bf8*)(kl + (32 * nt + r) * 144 + (16 * s + 8 * h) * 2);
#pragma unroll 1
  for (int mt = 0; mt < 4; ++mt) {
    f16v a0 = zero16(), a1 = zero16();
#pragma unroll
    for (int s = 0; s < 4; ++s) {
      const bf8 vf = *(const bf8*)(GVT + (size_t)(32 * mt + r) * SEQ + 16 * s + 8 * h);
      a0 = MFMA(vf, kb[0][s], a0);
      a1 = MFMA(vf, kb[1][s], a1);
    }
#pragma unroll
    for (int i = 0; i < 16; ++i) {
      LKV[(32 * mt + crow(i, h)) * 64 + r] = a0[i];
      LKV[(32 * mt + crow(i, h)) * 64 + 32 + r] = a1[i];
    }
  }
  asm volatile("s_waitcnt lgkmcnt(0)" ::: "memory");
}

DI void gla_g2(const MKParams& p, int gtid, int gthreads) {
  char* ws = p.ws;
  for (int u = gtid; u < 32768; u += gthreads) {
    const int oct = u & 7, dv = (u >> 3) & 127, bh = u >> 10;
    f8v S = {0.f, 0.f, 0.f, 0.f, 0.f, 0.f, 0.f, 0.f};
#pragma unroll 4
    for (int c = 0; c < 32; ++c) {
      const size_t item = (size_t)bh * 32 + c;
      *(bf8*)((u16*)(ws + OFF_SS) + (item * 128 + dv) * 64 + oct * 8) = cvt8(S);
      const f8v l = *(const f8v*)((const float*)(ws + OFF_LKV) + (item * 128 + dv) * 64 + oct * 8);
      const f8v d = *(const f8v*)((const float*)(ws + OFF_DD) + item * 64 + oct * 8);
      S = d * (S + l);
    }
  }
}

DI void gla_g3_tile(const MKParams& p, int tile, int wave, int lane, char* dst, int dst_ld) {
  char* ws = p.ws;
  const int r = lane & 31, h = lane >> 5;
  const int b = tile >> 5, c = tile & 31, hd = wave >> 1, tt = wave & 1, bh = b * 4 + hd;
  const u16* GQ = (const u16*)(ws + OFF_GQ) + ((size_t)bh * SEQ + 64 * c) * 64;
  const u16* GK = (const u16*)(ws + OFF_GK) + ((size_t)bh * SEQ + 64 * c) * 64;
  const u16* GVT = (const u16*)(ws + OFF_GVT) + (size_t)bh * 128 * SEQ + 64 * c;
  const u16* SS = (const u16*)(ws + OFF_SS) + ((size_t)(bh * 32 + c) * 128) * 64;
  bf8 qf[4];
#pragma unroll
  for (int ks = 0; ks < 4; ++ks) qf[ks] = *(const bf8*)(GQ + (32 * tt + r) * 64 + 16 * ks + 8 * h);
  bf8 pf[2][2];
#pragma unroll
  for (int kt = 0; kt < 2; ++kt) {
    if (kt <= tt) {
      f16v pt = zero16();
#pragma unroll
      for (int ks = 0; ks < 4; ++ks) {
        const bf8 kf = *(const bf8*)(GK + (32 * kt + r) * 64 + 16 * ks + 8 * h);
        pt = MFMA(kf, qf[ks], pt);
      }
      if (kt == tt) {
#pragma unroll
        for (int i = 0; i < 16; ++i) pt[i] = (crow(i, h) <= r) ? pt[i] : 0.f;
      }
      pf[kt][0] = pack8(pt, 0);
      pf[kt][1] = pack8(pt, 1);
    }
  }
  f16v o[4];
#pragma unroll
  for (int mt = 0; mt < 4; ++mt) {
    o[mt] = zero16();
#pragma unroll
    for (int ks = 0; ks < 4; ++ks) {
      const bf8 sf = *(const bf8*)(SS + (32 * mt + r) * 64 + 16 * ks + 8 * h);
      o[mt] = MFMA(sf, qf[ks], o[mt]);
    }
#pragma unroll
    for (int kt = 0; kt < 2; ++kt) {
      if (kt <= tt) {
#pragma unroll
        for (int s = 0; s < 2; ++s) {
          const bf8 vf = *(const bf8*)(GVT + (size_t)(32 * mt + r) * SEQ + 32 * kt + 16 * s + 8 * h);
          o[mt] = MFMA(vf, pf[kt][s], o[mt]);
        }
      }
    }
  }
  float ss = 0.f;
#pragma unroll
  for (int mt = 0; mt < 4; ++mt)
#pragma unroll
    for (int i = 0; i < 16; ++i) ss += o[mt][i] * o[mt][i];
  ss += __shfl_xor(ss, 32);
  const float rr = rsqrtf(ss * (1.0f / 128.0f) + EPSV);
  const size_t tok = (size_t)tile * 64 + 32 * tt + r;
  const u16* OG = (const u16*)(ws + OFF_OG) + tok * 512 + hd * 128;
#pragma unroll
  for (int mt = 0; mt < 4; ++mt)
#pragma unroll
    for (int g = 0; g < 4; ++g) {
      const int dv0 = 32 * mt + 8 * g + 4 * h;
      const ushort4 og4 = *(const ushort4*)(OG + dv0);
      const f4v gg = *(const f4v*)(p.g_gla + dv0);
      const float og[4] = {bf2f(og4.x), bf2f(og4.y), bf2f(og4.z), bf2f(og4.w)};
      f4v v;
#pragma unroll
      for (int j = 0; j < 4; ++j) v[j] = o[mt][4 * g + j] * rr * gg[j] * (og[j] / (1.0f + __expf(-og[j])));
      *(bf4*)(dst + (size_t)(32 * tt + r) * dst_ld + (hd * 128 + dv0) * 2) = cvt4(v);
    }
}
DI void gemm_1024(const char* ldsA, const bf8* __restrict__ wf, int wave, int lane, f16v (&a0)[2][2], f16v (&a1)[2][2]) {
  gemm_chunk<true>(ldsA, wf + 2 * wave * 64, lane, a0);
  gemm_chunk<true>(ldsA, wf + 65536 + 2 * wave * 64, lane, a1);
}
DI void gemm_1024_res(const char* ldsA, const bf8* __restrict__ wf, int wave, int lane, f16v (&a0)[2][2], f16v (&a1)[2][2],
                      const float* res) {
  gemm_chunk<true, true>(ldsA, wf + 2 * wave * 64, lane, a0, res + 64 * wave);
  gemm_chunk<true, true>(ldsA, wf + 65536 + 2 * wave * 64, lane, a1, res + 512 + 64 * wave);
}

DI void store_f32_ssq(const f16v (&a)[2][2], float* dst, int f0, int lane, float (&ssq)[2]) {
  const int r = lane & 31, h = lane >> 5;
#pragma unroll
  for (int ntl = 0; ntl < 2; ++ntl)
#pragma unroll
    for (int tt = 0; tt < 2; ++tt)
#pragma unroll
      for (int g = 0; g < 4; ++g) {
        f4v v = {a[ntl][tt][4 * g], a[ntl][tt][4 * g + 1], a[ntl][tt][4 * g + 2], a[ntl][tt][4 * g + 3]};
        ssq[tt] += v[0] * v[0] + v[1] * v[1] + v[2] * v[2] + v[3] * v[3];
        *(f4v*)(dst + (size_t)(32 * tt + r) * DM + f0 + 32 * ntl + 8 * g + 4 * h) = v;
      }
}

DI void acc_to_scratch(u16* scr, const f16v (&a)[2][2], int f0, int lane, float s0, float s1) {
  const int r = lane & 31, h = lane >> 5;
#pragma unroll
  for (int ntl = 0; ntl < 2; ++ntl)
#pragma unroll
    for (int tt = 0; tt < 2; ++tt)
#pragma unroll
      for (int g = 0; g < 4; ++g) {
        const float sc = tt ? s1 : s0;
        f4v v = {a[ntl][tt][4 * g] * sc, a[ntl][tt][4 * g + 1] * sc, a[ntl][tt][4 * g + 2] * sc, a[ntl][tt][4 * g + 3] * sc};
        *(bf4*)(scr + (size_t)(32 * tt + r) * 1024 + f0 + 32 * ntl + 8 * g + 4 * h) = cvt4(v);
      }
}
typedef __attribute__((ext_vector_type(4))) unsigned u4v;
DI void scratch_to_lds(const u16* scr, char* ldsA, int tid) {
  asm volatile("" : "+v"(tid));
  const unsigned toff = (unsigned)tid * 16u;
#pragma unroll
  for (int half = 0; half < 2; ++half) {
    u4v v[8];
#pragma unroll
    for (int it = 0; it < 8; ++it)
      v[it] = __builtin_nontemporal_load((const u4v*)((const char*)scr + (size_t)(8192 * (8 * half + it)) + toff));
#pragma unroll
    for (int it = 0; it < 8; ++it) {
      const int idx = tid + 512 * (8 * half + it), row = idx >> 7, ch = idx & 127;
      *(u4v*)(ldsA + row * LDS_ROW + ch * 16) = v[it];
    }
  }
}

struct Pk { bf4 v[2][2][4]; };
DI void pack_acc(Pk& pk, const f16v (&a)[2][2], float s0, float s1) {
#pragma unroll
  for (int ntl = 0; ntl < 2; ++ntl)
#pragma unroll
    for (int tt = 0; tt < 2; ++tt)
#pragma unroll
      for (int g = 0; g < 4; ++g) {
        const float sc = tt ? s1 : s0;
        f4v v = {a[ntl][tt][4 * g] * sc, a[ntl][tt][4 * g + 1] * sc, a[ntl][tt][4 * g + 2] * sc, a[ntl][tt][4 * g + 3] * sc};
        pk.v[ntl][tt][g] = cvt4(v);
      }
}
DI void pk_to_lds(char* ldsA, const Pk& pk, int f0, int lane) {
  const int r = lane & 31, h = lane >> 5;
#pragma unroll
  for (int ntl = 0; ntl < 2; ++ntl)
#pragma unroll
    for (int tt = 0; tt < 2; ++tt)
#pragma unroll
      for (int g = 0; g < 4; ++g)
        *(bf4*)(ldsA + (32 * tt + r) * LDS_ROW + (f0 + 32 * ntl + 8 * g + 4 * h) * 2) = pk.v[ntl][tt][g];
}

DI void rms_from_partials(float* red, int wave, int lane, const float (&ssq)[2], float& rs0, float& rs1) {
  red[(wave * 2 + 0) * 64 + lane] = ssq[0];
  red[(wave * 2 + 1) * 64 + lane] = ssq[1];
  __syncthreads();
  const int r = lane & 31;
  float t0 = 0.f, t1 = 0.f;
#pragma unroll
  for (int w = 0; w < 8; ++w) {
    t0 += red[(w * 2 + 0) * 64 + r] + red[(w * 2 + 0) * 64 + 32 + r];
    t1 += red[(w * 2 + 1) * 64 + r] + red[(w * 2 + 1) * 64 + 32 + r];
  }
  rs0 = rsqrtf(t0 * (1.0f / DM) + EPSV);
  rs1 = rsqrtf(t1 * (1.0f / DM) + EPSV);
}

DI void mem_attn(const MKParams& p, char* ldsA, int b, int wave, int lane) {
  char* ws = p.ws;
  const int r = lane & 31, h = lane >> 5;
  const int hm = wave >> 1, tt = wave & 1;
  const u16* KM = (const u16*)(ws + OFF_KM) + (size_t)(b * 4 + hm) * 256 * 256;
  const u16* VMT = (const u16*)(ws + OFF_VMT) + (size_t)(b * 4 + hm) * 256 * 256;
  char* qrow = ldsA + (32 * tt + r) * LDS_ROW + hm * 512;
  const unsigned loff = (unsigned)((r * 256 + 8 * h) * 2);
  f16v s[8];
#pragma unroll
  for (int mt = 0; mt < 8; ++mt) s[mt] = zero16();
#pragma unroll 2
  for (int ks = 0; ks < 16; ++ks) {
    const bf8 qf = *(const bf8*)(qrow + (16 * ks + 8 * h) * 2);
#pragma unroll
    for (int mt = 0; mt < 8; ++mt) {
      const bf8 kf = *(const bf8*)((const char*)KM + (size_t)((32 * mt * 256 + 16 * ks) * 2) + loff);
      s[mt] = MFMA(kf, qf, s[mt]);
    }
  }
  float mx = -INFINITY;
#pragma unroll
  for (int mt = 0; mt < 8; ++mt)
#pragma unroll
    for (int i = 0; i < 16; ++i) mx = fmaxf(mx, s[mt][i]);
  mx = fmaxf(mx, __shfl_xor(mx, 32));
  float l = 0.f;
  bf8 pf[8][2];
#pragma unroll
  for (int mt = 0; mt < 8; ++mt) {
#pragma unroll
    for (int i = 0; i < 16; ++i) { s[mt][i] = __expf(s[mt][i] - mx); l += s[mt][i]; }
    pf[mt][0] = pack8(s[mt], 0);
    pf[mt][1] = pack8(s[mt], 1);
  }
  l += __shfl_xor(l, 32);
  const float inv = 1.0f / l;
#pragma unroll
  for (int grp = 0; grp < 2; ++grp) {
    f16v o[4];
#pragma unroll
    for (int m4 = 0; m4 < 4; ++m4) o[m4] = zero16();
#pragma unroll
    for (int kt = 0; kt < 8; ++kt)
#pragma unroll
      for (int sx = 0; sx < 2; ++sx)
#pragma unroll
        for (int m4 = 0; m4 < 4; ++m4) {
          const bf8 vf = *(const bf8*)((const char*)VMT + (size_t)((32 * (4 * grp + m4) * 256 + 32 * kt + 16 * sx) * 2) + loff);
          o[m4] = MFMA(vf, pf[kt][sx], o[m4]);
        }
#pragma unroll
    for (int m4 = 0; m4 < 4; ++m4)
#pragma unroll
      for (int g = 0; g < 4; ++g) {
        f4v v = {o[m4][4 * g] * inv, o[m4][4 * g + 1] * inv, o[m4][4 * g + 2] * inv, o[m4][4 * g + 3] * inv};
        *(bf4*)(qrow + (32 * (4 * grp + m4) + 8 * g + 4 * h) * 2) = cvt4(v);
      }
  }
}

DI void phase_c_tile(const MKParams& p, int tile, int wave, int lane, float& rs0, float& rs1) {
  asm volatile("" : "+v"(lane));
  char* ws = p.ws;
  char* ldsA = smem;
  float* red = (float*)(smem + LDS_A_BYTES);
  const size_t tok0 = (size_t)tile * 64;
  const int tid = wave * 64 + lane;
  __syncthreads();
  gla_g3_tile(p, tile, wave, lane, ldsA, LDS_ROW);
  {
    const char* osb = ws + OFF_OSB + tok0 * 1024;
#pragma unroll
    for (int it = 0; it < 8; ++it) {
      const int idx = tid + 512 * it, row = idx >> 6, ch = idx & 63;
      *(uint4*)(ldsA + row * LDS_ROW + 1024 + ch * 16) = *(const uint4*)(osb + (size_t)row * 1024 + ch * 16);
    }
  }
  __syncthreads();
  f16v acc[2][2];
  Pk pk0, pk1;
  float* hdst = p.out + tok0 * DM;
  {
    float ssq[2] = {0.f, 0.f};
    const bf8* wf = (const bf8*)(ws + OFF_WOUT);
    asm volatile("" : "+v"(lane));
    gemm_chunk<true, true>(ldsA, wf + 2 * wave * 64, lane, acc, p.x + tok0 * DM + 64 * wave);
    store_f32_ssq(acc, hdst, 64 * wave, lane, ssq);
    pack_acc(pk0, acc, 1.f, 1.f);
    asm volatile("" : "+v"(lane));
    gemm_chunk<true, true>(ldsA, wf + 65536 + 2 * wave * 64, lane, acc, p.x + tok0 * DM + 512 + 64 * wave);
    store_f32_ssq(acc, hdst, 512 + 64 * wave, lane, ssq);
    pack_acc(pk1, acc, 1.f, 1.f);
    rms_from_partials(red, wave, lane, ssq, rs0, rs1);
  }
  pk_to_lds(ldsA, pk0, 64 * wave, lane);
  pk_to_lds(ldsA, pk1, 512 + 64 * wave, lane);
  __syncthreads();
  {
    const bf8* wf = (const bf8*)(ws + OFF_WMQ);
    asm volatile("" : "+v"(lane));
    gemm_chunk<true>(ldsA, wf + 2 * wave * 64, lane, acc);
    pack_acc(pk0, acc, rs0, rs1);
    asm volatile("" : "+v"(lane));
    gemm_chunk<true>(ldsA, wf + 65536 + 2 * wave * 64, lane, acc);
    pack_acc(pk1, acc, rs0, rs1);
  }
  __syncthreads();
  pk_to_lds(ldsA, pk0, 64 * wave, lane);
  pk_to_lds(ldsA, pk1, 512 + 64 * wave, lane);
  __syncthreads();
  asm volatile("" : "+v"(lane));
  mem_attn(p, ldsA, tile >> 5, wave, lane);
  __syncthreads();
  {
    float ssq[2] = {0.f, 0.f};
    const bf8* wf = (const bf8*)(ws + OFF_WMO);
    asm volatile("" : "+v"(lane));
    gemm_chunk<true, true>(ldsA, wf + 2 * wave * 64, lane, acc, hdst + 64 * wave);
    store_f32_ssq(acc, hdst, 64 * wave, lane, ssq);
    pack_acc(pk0, acc, 1.f, 1.f);
    asm volatile("" : "+v"(lane));
    gemm_chunk<true, true>(ldsA, wf + 65536 + 2 * wave * 64, lane, acc, hdst + 512 + 64 * wave);
    store_f32_ssq(acc, hdst, 512 + 64 * wave, lane, ssq);
    pack_acc(pk1, acc, 1.f, 1.f);
    rms_from_partials(red, wave, lane, ssq, rs0, rs1);
  }
  pk_to_lds(ldsA, pk0, 64 * wave, lane);
  pk_to_lds(ldsA, pk1, 512 + 64 * wave, lane);
  __syncthreads();
}
#define OFF_EG (OFF_LKV + 16 * MiB)

DI unsigned f2ord(float v) { const unsigned u = __float_as_uint(v); return (u & 0x80000000u) ? ~u : (u | 0x80000000u); }
DI float ord2f(unsigned u) { return __uint_as_float((u & 0x80000000u) ? (u ^ 0x80000000u) : ~u); }

DI void ins16(unsigned (&L)[16], unsigned x) {
#pragma unroll
  for (int s = 0; s < 16; ++s) {
    const unsigned hi = max(L[s], x);
    x = min(L[s], x);
    L[s] = hi;
  }
}
DI void merge_halves16(unsigned (&L)[16]) {
  unsigned O[16];
#pragma unroll
  for (int s = 0; s < 16; ++s) O[s] = (unsigned)__shfl_xor((int)L[s], 32);
#pragma unroll
  for (int s = 0; s < 16; ++s) L[s] = max(L[s], O[15 - s]);
#pragma unroll
  for (int d = 8; d > 0; d >>= 1)
#pragma unroll
    for (int i = 0; i < 16; ++i)
      if ((i & d) == 0) {
        const unsigned hi = max(L[i], L[i + d]), lo = min(L[i], L[i + d]);
        L[i] = hi; L[i + d] = lo;
      }
}

DI void peer_top16(const char* ws, const u16* qp, int hp, int tt, int lane, unsigned (&L)[16]) {
  const int r = lane & 31, h = lane >> 5;
  const bf8* sk = (const bf8*)(ws + OFF_SUBK) + (size_t)hp * 4 * 8 * 64 + lane;
  f16v s[4];
#pragma unroll
  for (int mt = 0; mt < 4; ++mt) s[mt] = zero16();
#pragma unroll
  for (int ks = 0; ks < 8; ++ks) {
    const bf8 qf = *(const bf8*)(qp + (size_t)(32 * tt + r) * 2048 + hp * 128 + 16 * ks + 8 * h);
#pragma unroll
    for (int mt = 0; mt < 4; ++mt) s[mt] = MFMA(sk[(mt * 8 + ks) * 64], qf, s[mt]);
  }
#pragma unroll
  for (int i = 0; i < 16; ++i) L[i] = 0u;
#pragma unroll
  for (int mt = 0; mt < 4; ++mt)
#pragma unroll
    for (int i = 0; i < 16; ++i) {
      const unsigned key = (f2ord(s[mt][i]) & ~127u) | (unsigned)(127 - (32 * mt + crow(i, h)));
      ins16(L, key);
    }
  merge_halves16(L);
}

DI void peer_select(const char* ws, const u16* qp, uint2* eg, unsigned char* idxs  , int head,
                    int tt, int lane) {
  const int r = lane & 31, h = lane >> 5;
  unsigned La[16], Lb[16];
  peer_top16(ws, qp, 2 * head, tt, lane, La);
  __builtin_amdgcn_sched_barrier(0);
  peer_top16(ws, qp, 2 * head + 1, tt, lane, Lb);
  __builtin_amdgcn_sched_barrier(0);
  if (h == 0) {
#pragma unroll
    for (int g = 0; g < 4; ++g) {
      unsigned wa = 0, wb = 0;
#pragma unroll
      for (int j = 0; j < 4; ++j) {
        wa |= (127u - (La[4 * g + j] & 127u)) << (8 * j);
        wb |= (127u - (Lb[4 * g + j] & 127u)) << (8 * j);
      }
      *(unsigned*)(idxs + r * 32 + 4 * g) = wa;
      *(unsigned*)(idxs + r * 32 + 16 + 4 * g) = wb;
    }
  }
  float fa[16], fb[16];
#pragma unroll
  for (int i = 0; i < 16; ++i) { fa[i] = ord2f(La[i] & ~127u); fb[i] = ord2f(Lb[i] & ~127u); }
  unsigned C[16];
#pragma unroll
  for (int i = 0; i < 16; ++i) C[i] = 0u;
#define PEER_CAND(a, b) ins16(C, (f2ord(fa[a] + fb[b]) & ~255u) | (unsigned)(255 - ((a) * 16 + (b))));
#define PEER_ROW1(a) PEER_CAND(a, 0)
#define PEER_ROW2(a) PEER_ROW1(a) PEER_CAND(a, 1)
#define PEER_ROW3(a) PEER_ROW2(a) PEER_CAND(a, 2)
#define PEER_ROW4(a) PEER_ROW3(a) PEER_CAND(a, 3)
#define PEER_ROW5(a) PEER_ROW4(a) PEER_CAND(a, 4)
#define PEER_ROW8(a) PEER_ROW5(a) PEER_CAND(a, 5) PEER_CAND(a, 6) PEER_CAND(a, 7)
#define PEER_ROW16(a) PEER_ROW8(a) PEER_CAND(a, 8) PEER_CAND(a, 9) PEER_CAND(a, 10) PEER_CAND(a, 11) PEER_CAND(a, 12) PEER_CAND(a, 13) PEER_CAND(a, 14) PEER_CAND(a, 15)
  PEER_ROW16(0) PEER_ROW8(1) PEER_ROW5(2) PEER_ROW4(3) PEER_ROW3(4) PEER_ROW2(5) PEER_ROW2(6) PEER_ROW2(7)
  PEER_ROW1(8) PEER_ROW1(9) PEER_ROW1(10) PEER_ROW1(11) PEER_ROW1(12) PEER_ROW1(13) PEER_ROW1(14) PEER_ROW1(15)
  asm volatile("s_waitcnt lgkmcnt(0)" ::: "memory");
  const float vmax = ord2f(C[0] & ~255u);
  float ex[16], sum = 0.f;
#pragma unroll
  for (int i = 0; i < 16; ++i) { ex[i] = __expf(ord2f(C[i] & ~255u) - vmax); sum += ex[i]; }
  const float inv = 1.0f / sum;
  const unsigned hmask = 0u - (unsigned)h;
#pragma unroll
  for (int i = 0; i < 8; ++i) {
    const unsigned ck = C[i] ^ ((C[i] ^ C[8 + i]) & hmask);
    const unsigned gb = __float_as_uint(ex[i]) ^ ((__float_as_uint(ex[i]) ^ __float_as_uint(ex[8 + i])) & hmask);
    const float g = __uint_as_float(gb) * inv;
    const unsigned code = 255u - (ck & 255u);
    const unsigned ia = idxs[r * 32 + (code >> 4)], ib = idxs[r * 32 + 16 + (code & 15u)];
    eg[(size_t)(32 * tt + r) * 128 + head * 16 + 8 * h + i] = make_uint2(ia * 128u + ib, __float_as_uint(g));
  }
  asm volatile("s_waitcnt lgkmcnt(0)" ::: "memory");
}

DI float wave_sum(float v) {
#pragma unroll
  for (int o = 32; o > 0; o >>= 1) v += __shfl_xor(v, o);
  return v;
}

DI void reduce8(const float (&pv)[8], float& s0, float& s1) {
  float q[4], s[2];
#pragma unroll
  for (int m = 0; m < 4; ++m) {
    const auto r = __builtin_amdgcn_permlane32_swap(__float_as_uint(pv[m]), __float_as_uint(pv[m + 4]), false, false);
    q[m] = __uint_as_float(r[0]) + __uint_as_float(r[1]);
  }
#pragma unroll
  for (int m = 0; m < 2; ++m) {
    const auto r = __builtin_amdgcn_permlane16_swap(__float_as_uint(q[m]), __float_as_uint(q[m + 2]), false, false);
    s[m] = __uint_as_float(r[0]) + __uint_as_float(r[1]);
  }
#pragma unroll
  for (int m = 0; m < 2; ++m) {
    s[m] += __uint_as_float(__builtin_amdgcn_update_dpp(0, __float_as_uint(s[m]), 0x128, 0xf, 0xf, false));
    s[m] += __uint_as_float(__builtin_amdgcn_update_dpp(0, __float_as_uint(s[m]), 0x124, 0xf, 0xf, false));
    s[m] += __uint_as_float(__builtin_amdgcn_update_dpp(0, __float_as_uint(s[m]), 0x122, 0xf, 0xf, false));
    s[m] += __uint_as_float(__builtin_amdgcn_update_dpp(0, __float_as_uint(s[m]), 0x121, 0xf, 0xf, false));
  }
  s0 = s[0]; s1 = s[1];
}

DI void peer_bucket_token(const uint2* egt, unsigned* tmp  , int lane, unsigned& E0, unsigned& E1,
                          unsigned& G0, unsigned& G1) {
  const uint2 a = egt[lane], b = egt[64 + lane];
  const int ba = (int)(a.x >> 10), bb = (int)(b.x >> 10);
  const unsigned long long lt = (1ull << lane) - 1ull;
  int da = 0, db = 0, start = 0;
#pragma unroll
  for (int k = 0; k < 16; ++k) {
    const unsigned long long ma = __ballot(ba == k), mb = __ballot(bb == k);
    const int ca = __popcll(ma), cb = __popcll(mb);
    if (ba == k) da = start + __popcll(ma & lt);
    if (bb == k) db = start + ca + __popcll(mb & lt);
    start += ca + cb;
  }
  const int ia = (da & 1) * 64 + (da >> 3) + 16 * ((da >> 1) & 3);
  const int ib = (db & 1) * 64 + (db >> 3) + 16 * ((db >> 1) & 3);
  tmp[ia] = a.x; tmp[128 + ia] = a.y;
  tmp[ib] = b.x; tmp[128 + ib] = b.y;
  asm volatile("s_waitcnt lgkmcnt(0)" ::: "memory");
  E0 = tmp[lane]; E1 = tmp[64 + lane]; G0 = tmp[128 + lane]; G1 = tmp[192 + lane];
  asm volatile("s_waitcnt lgkmcnt(0)" ::: "memory");
}

DI void peer_finalize_token(const MKParams& p, float (&acc)[16], size_t tok, int lane) {
  float* orow = p.out + tok * DM + 16 * lane;
  float ss = 0.f;
#pragma unroll
  for (int q = 0; q < 4; ++q) {
    const f4v hv = *(const f4v*)(orow + 4 * q);
#pragma unroll
    for (int j = 0; j < 4; ++j) { acc[4 * q + j] += hv[j]; ss += acc[4 * q + j] * acc[4 * q + j]; }
  }
  ss = wave_sum(ss);
  const float rf = rsqrtf(ss * (1.0f / DM) + EPSV);
#pragma unroll
  for (int q = 0; q < 4; ++q) {
    const f4v gg = *(const f4v*)(p.g_fin + 16 * lane + 4 * q);
    f4v o = {acc[4 * q] * rf * gg[0], acc[4 * q + 1] * rf * gg[1], acc[4 * q + 2] * rf * gg[2], acc[4 * q + 3] * rf * gg[3]};
    *(f4v*)(orow + 4 * q) = o;
  }
}

DI void peer_usweep(const char* ws, const char* ldsA, int wave, int lane, const unsigned (&E)[8][2], float (&A)[8][2]) {
  const char* PU = ws + OFF_PU + 16 * lane;
#pragma unroll
  for (int i = 0; i < 8; ++i) { A[i][0] = 0.f; A[i][1] = 0.f; }
#pragma unroll 1
  for (int j = 0; j < 16; ++j) {
    const bool sel = ((lane & 15) == j);
#pragma unroll
    for (int i = 0; i < 8; ++i) {
      const char* xrow = ldsA + (8 * wave + i) * LDS_ROW + 32 * lane;
      const uint4 x0 = *(const uint4*)xrow, x1 = *(const uint4*)(xrow + 16);
      const unsigned xr[8] = {x0.x, x0.y, x0.z, x0.w, x1.x, x1.y, x1.z, x1.w};
      uint4 u0[8];
#pragma unroll
      for (int m = 0; m < 8; ++m) {
        const int e = __builtin_amdgcn_readlane((int)E[i][m & 1], j + 16 * (m >> 1));
        u0[m] = *(const uint4*)(PU + (size_t)e * 1024);
      }
      float pv[8];
#pragma unroll
      for (int m = 0; m < 8; ++m) {
        const unsigned uw[4] = {u0[m].x, u0[m].y, u0[m].z, u0[m].w};
        float dsum = 0.f;
#pragma unroll
        for (int q = 0; q < 4; ++q) {
          const bf2 lo = __builtin_amdgcn_cvt_scalef32_pk_bf16_fp8(uw[q], 1.0f, false);
          const bf2 hi = __builtin_amdgcn_cvt_scalef32_pk_bf16_fp8(uw[q], 1.0f, true);
          dsum = __builtin_amdgcn_fdot2_f32_bf16(lo, __builtin_bit_cast(bf2, xr[2 * q]), dsum, false);
          dsum = __builtin_amdgcn_fdot2_f32_bf16(hi, __builtin_bit_cast(bf2, xr[2 * q + 1]), dsum, false);
        }
        pv[m] = dsum;
      }
      float s0, s1;
      reduce8(pv, s0, s1);
      A[i][0] = sel ? s0 : A[i][0];
      A[i][1] = sel ? s1 : A[i][1];
    }
  }
}

template <int T0>
DI void peer_vsweep(const MKParams& p, int wave, int lane, size_t tok0, const unsigned (&E)[8][2], const unsigned (&Wb)[8][2]) {
  const char* PV = p.ws + OFF_PV + 16 * lane;
  float acc[4][16];
#pragma unroll
  for (int i = 0; i < 4; ++i)
#pragma unroll
    for (int q = 0; q < 16; ++q) acc[i][q] = 0.f;
#pragma unroll 1
  for (int j = 0; j < 16; ++j) {
#pragma unroll
    for (int i = 0; i < 4; ++i) {
      uint4 v0[8];
      unsigned wl[8];
#pragma unroll
      for (int m = 0; m < 8; ++m) {
        const int e = __builtin_amdgcn_readlane((int)E[T0 + i][m & 1], j + 16 * (m >> 1));
        wl[m] = (unsigned)__builtin_amdgcn_readlane((int)Wb[T0 + i][m & 1], j + 16 * (m >> 1));
        v0[m] = *(const uint4*)(PV + (size_t)e * 1024);
      }
#pragma unroll
      for (int m = 0; m < 8; ++m) {
        const unsigned vw[4] = {v0[m].x, v0[m].y, v0[m].z, v0[m].w};
        const bf2 wlo = __builtin_bit_cast(bf2, wl[m]), whi = __builtin_bit_cast(bf2, wl[m] << 16);
#pragma unroll
        for (int q = 0; q < 4; ++q) {
          const bf2 lo = __builtin_amdgcn_cvt_scalef32_pk_bf16_fp8(vw[q], 1.0f, false);
          const bf2 hi = __builtin_amdgcn_cvt_scalef32_pk_bf16_fp8(vw[q], 1.0f, true);
          acc[i][4 * q] = __builtin_amdgcn_fdot2_f32_bf16(lo, wlo, acc[i][4 * q], false);
          acc[i][4 * q + 1] = __builtin_amdgcn_fdot2_f32_bf16(lo, whi, acc[i][4 * q + 1], false);
          acc[i][4 * q + 2] = __builtin_amdgcn_fdot2_f32_bf16(hi, wlo, acc[i][4 * q + 2], false);
          acc[i][4 * q + 3] = __builtin_amdgcn_fdot2_f32_bf16(hi, whi, acc[i][4 * q + 3], false);
        }
      }
    }
  }
#pragma unroll
  for (int i = 0; i < 4; ++i) peer_finalize_token(p, acc[i], tok0 + 8 * wave + T0 + i, lane);
}

DI void phase_d_tile(const MKParams& p, int tile, int wave, int lane, float rs0, float rs1) {
  asm volatile("" : "+v"(lane));
  char* ws = p.ws;
  char* ldsA = smem;
  float* rs_s = (float*)(smem + LDS_A_BYTES);
  unsigned char* idxs = (unsigned char*)(smem + LDS_A_BYTES + 4096) + wave * 1024;
  u16* qp = (u16*)qp_scratch(ws, blockIdx.x);
  uint2* eg = (uint2*)(ws + OFF_EG + (size_t)blockIdx.x * 65536);
  const size_t tok0 = (size_t)tile * 64;
  if (wave == 0) { if (lane < 32) rs_s[lane] = rs0; else rs_s[lane] = rs1; }
  {
    f16v acc[2][2];
    const bf8* wf = (const bf8*)(ws + OFF_WPQ);
#pragma unroll 1
    for (int c = 0; c < 4; ++c) {
      int l2 = lane;
      asm volatile("" : "+v"(l2));
      const int r = l2 & 31, h = l2 >> 5;
      gemm_chunk<true>(ldsA, wf + (size_t)c * 65536 + 2 * wave * 64, l2, acc);
#pragma unroll
      for (int ntl = 0; ntl < 2; ++ntl)
#pragma unroll
        for (int tt = 0; tt < 2; ++tt)
#pragma unroll
          for (int g = 0; g < 4; ++g) {
            const float sc = tt ? rs1 : rs0;
            f4v v = {acc[ntl][tt][4 * g] * sc, acc[ntl][tt][4 * g + 1] * sc, acc[ntl][tt][4 * g + 2] * sc, acc[ntl][tt][4 * g + 3] * sc};
            *(bf4*)(qp + (size_t)(32 * tt + r) * 2048 + 512 * c + 64 * wave + 32 * ntl + 8 * g + 4 * h) = cvt4(v);
          }
    }
  }
  __syncthreads();
#pragma unroll 1
  for (int tt = 0; tt < 2; ++tt) {
    int l2 = lane;
    asm volatile("" : "+v"(l2));
    peer_select(ws, qp, eg, idxs, wave, tt, l2);
  }
  __syncthreads();
}

DI void phase_d_gather(const MKParams& p, int tile, int wave, int lane) {
  asm volatile("" : "+v"(lane));
  char* ws = p.ws;
  char* ldsA = smem;
  float* rs_s = (float*)(smem + LDS_A_BYTES);
  unsigned char* idxs = (unsigned char*)(smem + LDS_A_BYTES + 4096) + wave * 1024;
  const uint2* eg = (const uint2*)(ws + OFF_EG + (size_t)blockIdx.x * 65536);
  const size_t tok0 = (size_t)tile * 64;
  {
    int l2 = lane;
    asm volatile("" : "+v"(l2));
    unsigned E[8][2], G[8][2];
#pragma unroll
    for (int i = 0; i < 8; ++i)
      peer_bucket_token(eg + (size_t)(8 * wave + i) * 128, (unsigned*)idxs, l2, E[i][0], E[i][1], G[i][0], G[i][1]);
    float A[8][2];
    peer_usweep(ws, ldsA, wave, l2, E, A);
    unsigned Wb[8][2];
#pragma unroll
    for (int i = 0; i < 8; ++i) {
      const float rs = rs_s[8 * wave + i];
#pragma unroll
      for (int cc = 0; cc < 2; ++cc) {
        const float a = A[i][cc] * rs * ((const float*)(ws + OFF_SU))[E[i][cc]];
        const float w = __uint_as_float(G[i][cc]) * 0.5f * a * (1.0f + erff(a * 0.70710678118654752f)) *
                        ((const float*)(ws + OFF_SV))[E[i][cc]];
        Wb[i][cc] = __builtin_bit_cast(unsigned, __builtin_convertvector((f2v){w, 0.f}, bf2));
      }
    }
    __builtin_amdgcn_sched_barrier(0);
    peer_vsweep<0>(p, wave, l2, tok0, E, Wb);
    __builtin_amdgcn_sched_barrier(0);
    peer_vsweep<4>(p, wave, l2, tok0, E, Wb);
  }
}
__global__ __launch_bounds__(512) void mk(MKParams p) {
  cg::grid_group grid = cg::this_grid();
  const int tid = threadIdx.x;
  const int wave = __builtin_amdgcn_readfirstlane(tid >> 6), lane = tid & 63;
  const int gtid = blockIdx.x * 512 + tid, gthreads = gridDim.x * 512;
  const int gw = blockIdx.x * 8 + wave, nw = gridDim.x * 8;
  phase_prep(p, gtid, gthreads);
  phase_prep_tables(p, gw, nw, lane);
  grid.sync();
  for (int tile = blockIdx.x; tile < 256; tile += gridDim.x) phase_a_tile(p, tile, wave, lane);
  for (int item = blockIdx.x; item < 128; item += gridDim.x) phase_a_memkv(p, item, wave, lane);
  grid.sync();
  for (int it = gw; it < 4096; it += nw) sb_item(p, it, lane);
  for (int it = nw - 1 - gw; it < 1024; it += nw) gla_g1_item(p, it, wave, lane);
  grid.sync();
  gla_g2(p, gtid, gthreads);
  grid.sync();
  const int n_iter = (256 + gridDim.x - 1) / gridDim.x;
  for (int it = 0; it < n_iter; ++it) {
    const int tile = blockIdx.x + it * gridDim.x;
    if (tile < 256) {
      float rs0, rs1;
      phase_c_tile(p, tile, wave, lane, rs0, rs1);
      phase_d_tile(p, tile, wave, lane, rs0, rs1);
    }
    if (tile < 256) phase_d_gather(p, tile, wave, lane);
  }
}
#define MK_LDS (160 * 1024)
extern "C" void kernel_launch(void* const* d_in, const int* in_sizes, int n_in, void* d_out, int out_size, void* d_ws,
                              size_t ws_size, hipStream_t stream) {
  MKParams p{};
  p.x = (const float*)d_in[0]; p.mem = (const float*)d_in[1]; p.g_mix = (const float*)d_in[2];
  p.w_in = (const float*)d_in[3]; p.w_up = (const float*)d_in[4]; p.b_alpha = (const float*)d_in[5];
  p.g_gla = (const float*)d_in[6]; p.w_out = (const float*)d_in[7]; p.g_mq = (const float*)d_in[8];
  p.g_mkv = (const float*)d_in[9]; p.w_mq = (const float*)d_in[10]; p.w_mkv = (const float*)d_in[11];
  p.w_mo = (const float*)d_in[12]; p.g_ffn = (const float*)d_in[13]; p.w_pq = (const float*)d_in[14];
  p.subk = (const float*)d_in[15]; p.pu = (const float*)d_in[16]; p.pv = (const float*)d_in[17];
  p.g_fin = (const float*)d_in[18];
  p.out = (float*)d_out; p.ws = (char*)d_ws;
  float* out = (float*)d_out;
  char* wsb = (char*)d_ws;
  float* ws = (float*)d_ws;
  static int grid_blocks = 0;
  if (!grid_blocks) {
    int dev = 0, cus = 0, per_cu = 0;
    (void)hipGetDevice(&dev);
    (void)hipDeviceGetAttribute(&cus, hipDeviceAttributeMultiprocessorCount, dev);
    (void)hipFuncSetAttribute((const void*)mk, hipFuncAttributeMaxDynamicSharedMemorySize, MK_LDS);
    (void)hipOccupancyMaxActiveBlocksPerMultiprocessor(&per_cu, mk, 512, MK_LDS);
    grid_blocks = cus * per_cu;
    fprintf(stderr, "mk: cus=%d per_cu=%d grid=%d ws=%zu\n", cus, per_cu, grid_blocks, ws_size);
  }
  {
    void* args[] = {(void*)&p};
    hipError_t e = hipLaunchCooperativeKernel((const void*)mk, dim3(grid_blocks), dim3(512), args, MK_LDS, stream);
    if (e != hipSuccess) fprintf(stderr, "coop launch failed: %s grid %d\n", hipGetErrorString(e), grid_blocks);
  }
}
```

```cpp
#define GEMM_D 4
#include <hip/hip_runtime.h>
#include <hip/hip_cooperative_groups.h>
#include <math.h>
#include <stdio.h>
#include <stdint.h>
namespace cg = cooperative_groups;

#ifndef PROBE
#define PROBE 0
#endif
#define NB 8
#define SEQ 2048
#define DM 1024
#define NTOK (NB * SEQ)
#define INC 3088
#define MEML 256
#define EPSV 1e-6f

typedef __attribute__((ext_vector_type(8))) __bf16 bf8;
typedef __attribute__((ext_vector_type(4))) __bf16 bf4;
typedef __attribute__((ext_vector_type(2))) __bf16 bf2;
typedef __attribute__((ext_vector_type(16))) float f16v;
typedef __attribute__((ext_vector_type(8))) float f8v;
typedef __attribute__((ext_vector_type(4))) float f4v;
typedef __attribute__((ext_vector_type(2))) float f2v;
typedef unsigned short u16;

#define DI __device__ __forceinline__
#define MFMA(a, b, c) __builtin_amdgcn_mfma_f32_32x32x16_bf16((a), (b), (c), 0, 0, 0)

DI int crow(int i, int h) { return (i & 3) + 8 * (i >> 2) + 4 * h; }
DI int tpos(int t) { return (t & ~12) | ((t & 4) << 1) | ((t & 8) >> 1); }
DI float bf2f(u16 v) { return __uint_as_float(((unsigned)v) << 16); }
DI bf8 cvt8(f8v v) { return __builtin_convertvector(v, bf8); }
DI bf4 cvt4(f4v v) { return __builtin_convertvector(v, bf4); }
DI f16v zero16() { f16v z = {0.f, 0.f, 0.f, 0.f, 0.f, 0.f, 0.f, 0.f, 0.f, 0.f, 0.f, 0.f, 0.f, 0.f, 0.f, 0.f}; return z; }

#define MiB ((size_t)1 << 20)
#define OFF_WIN   ((size_t)0)
#define OFF_WOUT  (OFF_WIN + 97 * 65536)
#define OFF_WMQ   (OFF_WOUT + 32 * 65536)
#define OFF_WMKV  (OFF_WMQ + 32 * 65536)
#define OFF_WMO   (OFF_WMKV + 64 * 65536)
#define OFF_WPQ   (OFF_WMO + 32 * 65536)
#define OFF_SUBK  (OFF_WPQ + 64 * 65536)
#define OFF_ACT   (21 * MiB)
#define OFF_GQ    (OFF_ACT)
#define OFF_GK    (OFF_GQ + 8 * MiB)
#define OFF_GVT   (OFF_GK + 8 * MiB)
#define OFF_OG    (OFF_GVT + 16 * MiB)
#define OFF_SQ    (OFF_OG + 16 * MiB)
#define OFF_SK    (OFF_SQ + 16 * MiB)
#define OFF_SVT   (OFF_SK + 16 * MiB)
#define OFF_LA    (OFF_SVT + 16 * MiB)
#define OFF_LKV   (OFF_LA + 16 * MiB)
#define OFF_DD    (OFF_LKV + 32 * MiB)
#define OFF_OSB   (OFF_DD + 1 * MiB)
#define OFF_KM    (OFF_OSB + 16 * MiB)
#define OFF_VMT   (OFF_KM + 4 * MiB)
#define OFF_PU    (OFF_VMT + 4 * MiB)
#define OFF_PV    (OFF_PU + 16 * MiB)
#define OFF_SU    (OFF_PV + 16 * MiB)
#define OFF_SV    (OFF_SU + 65536)
#define OFF_SS    (OFF_LA)

#define LDS_ROW 2064
#define LDS_A_BYTES (64 * LDS_ROW)

DI char* qp_scratch(char* ws, int blk) {
  return blk < 192 ? ws + OFF_SQ + (size_t)blk * 262144 : ws + OFF_LKV + (size_t)(blk - 192) * 262144;
}

#define OFF_BAR (OFF_DD + 768 * 1024)
DI void grid_barrier(unsigned* ctr, unsigned target) {
  __syncthreads();
  if (threadIdx.x == 0) {
    __builtin_amdgcn_fence(__ATOMIC_RELEASE, "agent");
    asm volatile("s_waitcnt vmcnt(0)" ::: "memory");
    __hip_atomic_fetch_add(ctr, 1u, __ATOMIC_RELAXED, __HIP_MEMORY_SCOPE_AGENT);
    while (__hip_atomic_load(ctr, __ATOMIC_RELAXED, __HIP_MEMORY_SCOPE_AGENT) < target) __builtin_amdgcn_s_sleep(1);
    __builtin_amdgcn_fence(__ATOMIC_ACQUIRE, "agent");
    asm volatile("s_waitcnt vmcnt(0)" ::: "memory");
  }
  __syncthreads();
}

struct MKParams {
  const float *x, *mem, *g_mix, *w_in, *w_up, *b_alpha, *g_gla, *w_out, *g_mq, *g_mkv, *w_mq, *w_mkv, *w_mo, *g_ffn, *w_pq,
      *subk, *pu, *pv, *g_fin;
  float* out;
  char* ws;
};
extern __shared__ __attribute__((aligned(16))) char smem[];

template <typename ColFn>
DI void prep_w(bf8* dst, const float* __restrict__ W, int ldw, int ntiles, const float* __restrict__ gain, ColFn colfn,
               int gtid, int gthreads) {
  const int total = ntiles * 4096;
  for (int u = gtid; u < total; u += gthreads) {
    const int lane = u & 63, ks = (u >> 6) & 63, nt = u >> 12;
    const int r = lane & 31, h = lane >> 5;
    float sc = 1.f;
    const int col = colfn(32 * nt + r, sc);
    f8v v;
#pragma unroll
    for (int j = 0; j < 8; ++j) {
      const int k = 16 * ks + 8 * h + j;
      float val = 0.f;
      if (col >= 0) val = W[(size_t)k * ldw + col] * sc * (gain ? gain[k] : 1.f);
      v[j] = val;
    }
    const int didx = (nt < (ntiles & ~15)) ? ((((nt >> 4) * 64 + ks) * 16 + (nt & 15)) * 64 + lane) : u;
    dst[didx] = cvt8(v);
  }
}

DI void phase_prep(const MKParams& p, int gtid, int gthreads) {
  char* ws = p.ws;
  prep_w((bf8*)(ws + OFF_WIN), p.w_in, INC, 97, p.g_mix,
         [](int n, float& sc) -> int {
           if (n < 256) { sc = 0.125f; return n; }
           if (n < 1536) return n;
           if (n < 2048) { sc = 0.125f; return n + 16; }
           if (n < 3072) return n + 16;
           if (n < 3088) return n - 1536;
           return -1;
         }, gtid, gthreads);
  prep_w((bf8*)(ws + OFF_WOUT), p.w_out, 1024, 32, nullptr, [](int n, float& sc) -> int { return n; }, gtid, gthreads);
  prep_w((bf8*)(ws + OFF_WMQ), p.w_mq, 1024, 32, p.g_mq, [](int n, float& sc) -> int { sc = 0.0625f; return n; }, gtid, gthreads);
  prep_w((bf8*)(ws + OFF_WMKV), p.w_mkv, 2048, 64, p.g_mkv, [](int n, float& sc) -> int { return n; }, gtid, gthreads);
  prep_w((bf8*)(ws + OFF_WMO), p.w_mo, 1024, 32, nullptr, [](int n, float& sc) -> int { return n; }, gtid, gthreads);
  prep_w((bf8*)(ws + OFF_WPQ), p.w_pq, 2048, 64, p.g_ffn, [](int n, float& sc) -> int { return n; }, gtid, gthreads);
  {
    bf8* dst = (bf8*)(ws + OFF_SUBK);
    const int total = 16 * 4 * 8 * 64;
    for (int u = gtid; u < total; u += gthreads) {
      const int lane = u & 63, ks = (u >> 6) & 7, mt = (u >> 9) & 3, hp = u >> 11;
      const int r = lane & 31, h = lane >> 5;
      const float* s = p.subk + ((size_t)(hp * 128 + 32 * mt + r)) * 128 + 16 * ks + 8 * h;
      const f4v a = *(const f4v*)s, b = *(const f4v*)(s + 4);
      f8v v = {a[0], a[1], a[2], a[3], b[0], b[1], b[2], b[3]};
      dst[u] = cvt8(v);
    }
  }
}

DI void phase_prep_tables(const MKParams& p, int gwave, int nwaves, int lane) {
  for (int row = gwave; row < 32768; row += nwaves) {
    const int e = row & 16383;
    const bool isv = row >= 16384;
    const float* src = (isv ? p.pv : p.pu) + (size_t)e * DM + 16 * lane;
    f4v v[4];
#pragma unroll
    for (int q = 0; q < 4; ++q) v[q] = *(const f4v*)(src + 4 * q);
    if (!isv) {
#pragma unroll
      for (int q = 0; q < 4; ++q) v[q] = v[q] * *(const f4v*)(p.g_ffn + 16 * lane + 4 * q);
    }
    float am = 0.f;
#pragma unroll
    for (int q = 0; q < 4; ++q)
#pragma unroll
      for (int j = 0; j < 4; ++j) am = fmaxf(am, fabsf(v[q][j]));
#pragma unroll
    for (int o = 32; o > 0; o >>= 1) am = fmaxf(am, __shfl_xor(am, o));
    int k = 0;
    if (am > 0.f) k = 7 - ilogbf(am);
    k = max(-100, min(100, k));
    const float sc = ldexpf(1.0f, k);
    unsigned w[4];
#pragma unroll
    for (int q = 0; q < 4; ++q) {
      int pk = 0;
      pk = __builtin_amdgcn_cvt_pk_fp8_f32(v[q][0] * sc, v[q][1] * sc, pk, false);
      pk = __builtin_amdgcn_cvt_pk_fp8_f32(v[q][2] * sc, v[q][3] * sc, pk, true);
      w[q] = (unsigned)pk;
    }
    *(uint4*)(p.ws + (isv ? OFF_PV : OFF_PU) + (size_t)e * 1024 + 16 * lane) = make_uint4(w[0], w[1], w[2], w[3]);
    if (lane == 0) ((float*)(p.ws + (isv ? OFF_SV : OFF_SU)))[e] = ldexpf(1.0f, -k);
  }
}

DI void load_norm_tile(const float* __restrict__ src, char* ldsA, int wave, int lane) {
#pragma unroll 2
  for (int i = 0; i < 8; ++i) {
    const int row = 8 * wave + i;
    const f4v* pr = (const f4v*)(src + (size_t)row * DM);
    f4v v[4];
#pragma unroll
    for (int c = 0; c < 4; ++c) v[c] = pr[lane + 64 * c];
    float ss = 0.f;
#pragma unroll
    for (int c = 0; c < 4; ++c) ss += v[c][0] * v[c][0] + v[c][1] * v[c][1] + v[c][2] * v[c][2] + v[c][3] * v[c][3];
#pragma unroll
    for (int o = 32; o > 0; o >>= 1) ss += __shfl_xor(ss, o);
    const float rs = rsqrtf(ss * (1.0f / DM) + EPSV);
#pragma unroll
    for (int c = 0; c < 4; ++c) {
      f4v t = v[c] * rs;
      *(bf4*)(ldsA + row * LDS_ROW + (lane * 4 + 256 * c) * 2) = cvt4(t);
    }
  }
}

#ifndef GEMM_D
#define GEMM_D 6
#endif
template <bool SWAP>
DI void gemm_step(f16v (&acc)[2][2], const bf8& a0, const bf8& a1, const bf8& x0, const bf8& x1) {
  if (SWAP) {
    acc[0][0] = MFMA(a0, x0, acc[0][0]); acc[0][1] = MFMA(a0, x1, acc[0][1]);
    acc[1][0] = MFMA(a1, x0, acc[1][0]); acc[1][1] = MFMA(a1, x1, acc[1][1]);
  } else {
    acc[0][0] = MFMA(x0, a0, acc[0][0]); acc[0][1] = MFMA(x1, a0, acc[0][1]);
    acc[1][0] = MFMA(x0, a1, acc[1][0]); acc[1][1] = MFMA(x1, a1, acc[1][1]);
  }
}
template <bool SWAP, bool RES = false>
DI void gemm_chunk(const char* ldsA, const bf8* __restrict__ wf, int lane, f16v (&acc)[2][2], const float* res = nullptr) {
  __builtin_amdgcn_sched_barrier(0);
  const int r = lane & 31, h = lane >> 5;
  const char* xa0 = ldsA + r * LDS_ROW + h * 16;
  const char* xa1 = xa0 + 32 * LDS_ROW;
  const bf8* w0p = wf + lane;
  const bf8* w1p = wf + 64 + lane;
  bf8 w0[GEMM_D], w1[GEMM_D];
#pragma unroll
  for (int i = 0; i < GEMM_D; ++i) { w0[i] = w0p[i * 1024]; w1[i] = w1p[i * 1024]; }
  if (RES) {
#pragma unroll
    for (int ntl = 0; ntl < 2; ++ntl)
#pragma unroll
      for (int tt = 0; tt < 2; ++tt)
#pragma unroll
        for (int g = 0; g < 4; ++g) {
          const f4v x = *(const f4v*)(res + (size_t)(32 * tt + r) * DM + 32 * ntl + 8 * g + 4 * h);
          acc[ntl][tt][4 * g] = x[0]; acc[ntl][tt][4 * g + 1] = x[1]; acc[ntl][tt][4 * g + 2] = x[2]; acc[ntl][tt][4 * g + 3] = x[3];
        }
  } else {
    acc[0][0] = zero16(); acc[0][1] = zero16(); acc[1][0] = zero16(); acc[1][1] = zero16();
  }
  bf8 x0 = *(const bf8*)(xa0), x1 = *(const bf8*)(xa1);
  constexpr int KMAIN = ((64 - 2 * GEMM_D) / GEMM_D + 1) * GEMM_D;
#pragma unroll 1
  for (int ks0 = 0; ks0 < KMAIN; ks0 += GEMM_D) {
#pragma unroll
    for (int i = 0; i < GEMM_D; ++i) {
      const int ks = ks0 + i;
      const bf8 xn0 = *(const bf8*)(xa0 + (ks + 1) * 32);
      const bf8 xn1 = *(const bf8*)(xa1 + (ks + 1) * 32);
      gemm_step<SWAP>(acc, w0[i], w1[i], x0, x1);
      w0[i] = w0p[(ks + GEMM_D) * 1024];
      w1[i] = w1p[(ks + GEMM_D) * 1024];
      x0 = xn0; x1 = xn1;
      __builtin_amdgcn_sched_group_barrier(0x100, 2, 0);
      __builtin_amdgcn_sched_group_barrier(0x008, 2, 0);
      __builtin_amdgcn_sched_group_barrier(0x020, 2, 0);
      __builtin_amdgcn_sched_group_barrier(0x008, 2, 0);
    }
  }
#pragma unroll
  for (int t = 0; t < 64 - KMAIN; ++t) {
    const int ks = KMAIN + t, i = t % GEMM_D;
    const bf8 xn0 = *(const bf8*)(xa0 + (ks + 1) * 32);
    const bf8 xn1 = *(const bf8*)(xa1 + (ks + 1) * 32);
    gemm_step<SWAP>(acc, w0[i], w1[i], x0, x1);
    if (ks + GEMM_D < 64) {
      w0[i] = w0p[(ks + GEMM_D) * 1024];
      w1[i] = w1p[(ks + GEMM_D) * 1024];
    }
    x0 = xn0; x1 = xn1;
    __builtin_amdgcn_sched_group_barrier(0x100, 2, 0);
    __builtin_amdgcn_sched_group_barrier(0x008, 2, 0);
    if (ks + GEMM_D < 64) __builtin_amdgcn_sched_group_barrier(0x020, 2, 0);
    __builtin_amdgcn_sched_group_barrier(0x008, 2, 0);
  }
}

DI void store_swap_bf16(u16* dst, size_t ld, const f16v (&acc)[2][2], int lane) {
  const int r = lane & 31, h = lane >> 5;
#pragma unroll
  for (int ntl = 0; ntl < 2; ++ntl)
#pragma unroll
    for (int tt = 0; tt < 2; ++tt)
#pragma unroll
      for (int g = 0; g < 4; ++g) {
        f4v v = {acc[ntl][tt][4 * g], acc[ntl][tt][4 * g + 1], acc[ntl][tt][4 * g + 2], acc[ntl][tt][4 * g + 3]};
        *(bf4*)(dst + (size_t)(32 * tt + r) * ld + 32 * ntl + 8 * g + 4 * h) = cvt4(v);
      }
}
DI void store_vt_bf16(u16* dst, size_t ld, const f16v (&acc)[2][2], int lane) {
  const int r = lane & 31, h = lane >> 5;
#pragma unroll
  for (int ntl = 0; ntl < 2; ++ntl)
#pragma unroll
    for (int tt = 0; tt < 2; ++tt)
#pragma unroll
      for (int s = 0; s < 2; ++s) {
        f8v v;
#pragma unroll
        for (int j = 0; j < 8; ++j) v[j] = acc[ntl][tt][8 * s + j];
        *(bf8*)(dst + (size_t)(32 * ntl + r) * ld + 32 * tt + 16 * s + 8 * h) = cvt8(v);
      }
}

DI float log_sigmoid_acc(float x) { return fminf(x, 0.f) - log1pf(expf(-fabsf(x))); }

DI void phase_a_tile(const MKParams& p, int tile, int wave, int lane) {
  asm volatile("" : "+v"(lane));
  char* ws = p.ws;
  char* ldsA = smem;
  float* alr_s = (float*)(smem + LDS_A_BYTES);
  const int b = tile >> 5, c = tile & 31;
  const size_t tok0 = (size_t)tile * 64;
  __syncthreads();
  load_norm_tile(p.x + tok0 * DM, ldsA, wave, lane);
#if PROBE == 10
  __syncthreads();
  load_norm_tile(p.x + tok0 * DM, ldsA, wave, lane);
#endif
  __syncthreads();
  const bf8* wf = (const bf8*)(ws + OFF_WIN);
  f16v acc[2][2];
  const int t0 = c * 64;
  gemm_chunk<true>(ldsA, wf + (size_t)0 * 65536 + 2 * wave * 64, lane, acc);
  {
    u16* base = (u16*)(ws + (wave < 4 ? OFF_GQ : OFF_GK)) + ((size_t)(b * 4 + (wave & 3)) * SEQ + t0) * 64;
    store_swap_bf16(base, 64, acc, lane);
#if PROBE == 11
    store_swap_bf16(base, 64, acc, lane);
#endif
  }
  gemm_chunk<false>(ldsA, wf + (size_t)1 * 65536 + 2 * wave * 64, lane, acc);
  {
    u16* base = (u16*)(ws + OFF_GVT) + ((size_t)(b * 4 + (wave >> 1)) * 128 + 64 * (wave & 1)) * SEQ + t0;
    store_vt_bf16(base, SEQ, acc, lane);
#if PROBE == 11
    store_vt_bf16(base, SEQ, acc, lane);
#endif
  }
  gemm_chunk<true>(ldsA, wf + (size_t)2 * 65536 + 2 * wave * 64, lane, acc);
  store_swap_bf16((u16*)(ws + OFF_OG) + tok0 * 512 + 64 * wave, 512, acc, lane);
#if PROBE == 11
  store_swap_bf16((u16*)(ws + OFF_OG) + tok0 * 512 + 64 * wave, 512, acc, lane);
#endif
  gemm_chunk<true>(ldsA, wf + (size_t)3 * 65536 + 2 * wave * 64, lane, acc);
  store_swap_bf16((u16*)(ws + OFF_SQ) + ((size_t)(b * 8 + wave) * SEQ + t0) * 64, 64, acc, lane);
#if PROBE == 11
  store_swap_bf16((u16*)(ws + OFF_SQ) + ((size_t)(b * 8 + wave) * SEQ + t0) * 64, 64, acc, lane);
#endif
  gemm_chunk<true>(ldsA, wf + (size_t)4 * 65536 + 2 * wave * 64, lane, acc);
  store_swap_bf16((u16*)(ws + OFF_SK) + ((size_t)(b * 8 + wave) * SEQ + t0) * 64, 64, acc, lane);
#if PROBE == 11
  store_swap_bf16((u16*)(ws + OFF_SK) + ((size_t)(b * 8 + wave) * SEQ + t0) * 64, 64, acc, lane);
#endif
  gemm_chunk<false>(ldsA, wf + (size_t)5 * 65536 + 2 * wave * 64, lane, acc);
  store_vt_bf16((u16*)(ws + OFF_SVT) + ((size_t)(b * 8 + wave) * 64) * SEQ + t0, SEQ, acc, lane);
#if PROBE == 11
  store_vt_bf16((u16*)(ws + OFF_SVT) + ((size_t)(b * 8 + wave) * 64) * SEQ + t0, SEQ, acc, lane);
#endif
#if PROBE == 12
  for (int rep_ = 0; rep_ < 2; ++rep_) {
  __syncthreads();
#else
  {
#endif
    float* part = (float*)(smem + LDS_A_BYTES);
    const int r = lane & 31, h = lane >> 5;
    const bf8* wp = wf + (size_t)96 * 4096 + lane;
    bf8 wfr[8];
#pragma unroll
    for (int i = 0; i < 8; ++i) wfr[i] = wp[(8 * wave + i) * 64];
    const char* xa0 = ldsA + r * LDS_ROW + h * 16 + wave * 256;
    const char* xa1 = xa0 + 32 * LDS_ROW;
    f16v a0 = zero16(), a1 = zero16();
#pragma unroll
    for (int i = 0; i < 8; ++i) {
      a0 = MFMA(wfr[i], *(const bf8*)(xa0 + i * 32), a0);
      a1 = MFMA(wfr[i], *(const bf8*)(xa1 + i * 32), a1);
    }
    float* pw = part + (wave & 3) * 1024;
    if (wave < 4) {
#pragma unroll
      for (int i = 0; i < 8; ++i) { pw[r * 16 + crow(i, h)] = a0[i]; pw[(32 + r) * 16 + crow(i, h)] = a1[i]; }
    }
    __syncthreads();
    if (wave >= 4) {
#pragma unroll
      for (int i = 0; i < 8; ++i) { pw[r * 16 + crow(i, h)] += a0[i]; pw[(32 + r) * 16 + crow(i, h)] += a1[i]; }
    }
    __syncthreads();
    const int tid = wave * 64 + lane;
    {
      const f4v* p4 = (const f4v*)part;
      if (tid < 256) { f4v s = p4[tid] + p4[256 + tid] + p4[512 + tid] + p4[768 + tid]; ((f4v*)part)[tid] = s; }
    }
    __syncthreads();
    const int col = tid & 255, tg = tid >> 8;
    float wu[16];
#pragma unroll
    for (int rr = 0; rr < 16; ++rr) wu[rr] = p.w_up[rr * 256 + col];
    const float bb = p.b_alpha[col];
    float* dst = (float*)(ws + OFF_LA) + (tok0 + 32 * tg) * 256 + col;
#pragma unroll 4
    for (int t = 0; t < 32; ++t) {
      const f4v* ar = (const f4v*)(part + (32 * tg + t) * 16);
      const f4v q0 = ar[0], q1 = ar[1], q2 = ar[2], q3 = ar[3];
      float s = bb;
      s = fmaf(q0[0], wu[0], s); s = fmaf(q0[1], wu[1], s); s = fmaf(q0[2], wu[2], s); s = fmaf(q0[3], wu[3], s);
      s = fmaf(q1[0], wu[4], s); s = fmaf(q1[1], wu[5], s); s = fmaf(q1[2], wu[6], s); s = fmaf(q1[3], wu[7], s);
      s = fmaf(q2[0], wu[8], s); s = fmaf(q2[1], wu[9], s); s = fmaf(q2[2], wu[10], s); s = fmaf(q2[3], wu[11], s);
      s = fmaf(q3[0], wu[12], s); s = fmaf(q3[1], wu[13], s); s = fmaf(q3[2], wu[14], s); s = fmaf(q3[3], wu[15], s);
      const float ls = fminf(s, 0.f) - __logf(1.0f + __expf(-fabsf(s)));
      dst[(size_t)t * 256] = ls * (1.0f / 16.0f);
    }
  }
}

DI void phase_a_memkv(const MKParams& p, int item, int wave, int lane) {
  asm volatile("" : "+v"(lane));
  char* ws = p.ws;
  char* ldsA = smem;
  const int rt = item >> 2, cc = item & 3;
  const int b = rt >> 2, m0 = (rt & 3) * 64;
  __syncthreads();
  load_norm_tile(p.mem + (size_t)rt * 64 * DM, ldsA, wave, lane);
  __syncthreads();
  const bf8* wf = (const bf8*)(ws + OFF_WMKV);
  f16v acc[2][2];
  if (cc < 2) {
    gemm_chunk<true>(ldsA, wf + (size_t)cc * 65536 + 2 * wave * 64, lane, acc);
    const int f0 = 512 * cc + 64 * wave;
    u16* base = (u16*)(ws + OFF_KM) + ((size_t)(b * 4 + (f0 >> 8)) * 256 + m0) * 256 + (f0 & 255);
    store_swap_bf16(base, 256, acc, lane);
  } else {
    gemm_chunk<false>(ldsA, wf + (size_t)cc * 65536 + 2 * wave * 64, lane, acc);
    const int f0 = 512 * (cc - 2) + 64 * wave;
    u16* base = (u16*)(ws + OFF_VMT) + ((size_t)(b * 4 + (f0 >> 8)) * 256 + (f0 & 255)) * 256 + m0;
    store_vt_bf16(base, 256, acc, lane);
  }
}
#define SB_THR 30.0f

DI bf8 pack8(const f16v& x, int s) {
  f8v v;
#pragma unroll
  for (int j = 0; j < 8; ++j) v[j] = x[8 * s + j];
  return cvt8(v);
}

DI void sb_item(const MKParams& p, int item, int lane) {
  asm volatile("" : "+v"(lane));
  char* ws = p.ws;
  const int r = lane & 31, h = lane >> 5;
  const int bh = item >> 6, qt = item & 63;
  const u16* SQ = (const u16*)(ws + OFF_SQ) + (size_t)bh * SEQ * 64;
  const u16* SK = (const u16*)(ws + OFF_SK) + (size_t)bh * SEQ * 64;
  const u16* SVT = (const u16*)(ws + OFF_SVT) + (size_t)bh * 64 * SEQ;
  bf8 qf[4];
#pragma unroll
  for (int ks = 0; ks < 4; ++ks) qf[ks] = *(const bf8*)(SQ + (size_t)(32 * qt + r) * 64 + 16 * ks + 8 * h);
  bf8 tri[2];
#pragma unroll
  for (int s = 0; s < 2; ++s) {
    f8v t;
#pragma unroll
    for (int j = 0; j < 8; ++j) t[j] = (16 * s + 8 * (j >> 2) + 4 * h + (j & 3) >= r) ? 1.0f : 0.0f;
    tri[s] = cvt8(t);
  }
  f16v o0 = zero16(), o1 = zero16();
  float R = 0.f;
  for (int kt = qt; kt >= 0; --kt) {
    bf8 kf[4], vf[2][2];
#pragma unroll
    for (int ks = 0; ks < 4; ++ks) kf[ks] = *(const bf8*)(SK + (size_t)(32 * kt + r) * 64 + 16 * ks + 8 * h);
#pragma unroll
    for (int mt = 0; mt < 2; ++mt)
#pragma unroll
      for (int s = 0; s < 2; ++s) vf[mt][s] = *(const bf8*)(SVT + (size_t)(32 * mt + r) * SEQ + 32 * kt + 16 * s + 8 * h);
    f16v z = zero16();
#pragma unroll
    for (int ks = 0; ks < 4; ++ks) z = MFMA(kf[ks], qf[ks], z);
    const bool diag = (kt == qt);
    f16v sp;
    float tot = 0.f;
#pragma unroll
    for (int i = 0; i < 16; ++i) {
      const float zz = z[i];
      const float sv = fmaxf(zz, 0.f) + __logf(1.0f + __expf(-fabsf(zz)));
      const bool valid = !diag || (crow(i, h) < r);
      sp[i] = valid ? sv : 0.f;
      tot += sp[i];
    }
    tot += __shfl_xor(tot, 32);
    f16v C = MFMA(tri[0], pack8(sp, 0), zero16());
    C = MFMA(tri[1], pack8(sp, 1), C);
    f16v a;
#pragma unroll
    for (int i = 0; i < 16; ++i) {
      const bool valid = !diag || (crow(i, h) < r);
      a[i] = valid ? __expf(z[i] - C[i] - R) : 0.f;
    }
    const bf8 a0 = pack8(a, 0), a1 = pack8(a, 1);
    o0 = MFMA(vf[0][0], a0, o0); o0 = MFMA(vf[0][1], a1, o0);
    o1 = MFMA(vf[1][0], a0, o1); o1 = MFMA(vf[1][1], a1, o1);
    R += tot;
    if (__all(R > SB_THR)) break;
  }
  const int b = bh >> 3, hd = bh & 7;
  u16* dst = (u16*)(ws + OFF_OSB) + ((size_t)b * SEQ + 32 * qt + r) * 512 + hd * 64 + 4 * h;
#pragma unroll
  for (int g = 0; g < 4; ++g) {
    f4v v0 = {o0[4 * g], o0[4 * g + 1], o0[4 * g + 2], o0[4 * g + 3]};
    f4v v1 = {o1[4 * g], o1[4 * g + 1], o1[4 * g + 2], o1[4 * g + 3]};
    *(bf4*)(dst + 8 * g) = cvt4(v0);
    *(bf4*)(dst + 32 + 8 * g) = cvt4(v1);
  }
}

DI void gla_g1_item(const MKParams& p, int item, int wave, int lane) {
  asm volatile("" : "+v"(lane));
  char* ws = p.ws;
  const int r = lane & 31, h = lane >> 5;
  const int bh = item >> 5, c = item & 31, b = bh >> 2, hd = bh & 3;
  char* kl = smem + wave * 9216;
  u16* GQ = (u16*)(ws + OFF_GQ) + ((size_t)bh * SEQ + 64 * c) * 64;
  u16* GK = (u16*)(ws + OFF_GK) + ((size_t)bh * SEQ + 64 * c) * 64;
  const float* LA = (const float*)(ws + OFF_LA) + ((size_t)b * SEQ + 64 * c) * 256 + hd * 64;
  float bc = 0.f;
#pragma unroll 1
  for (int g = 0; g < 4; ++g) {
    float la_[16];
    u16 q_[16], k_[16];
#pragma unroll
    for (int i = 0; i < 16; ++i) {
      const int t = 16 * g + i;
      la_[i] = LA[(size_t)t * 256 + lane];
      q_[i] = GQ[t * 64 + lane];
      k_[i] = GK[t * 64 + lane];
    }
#pragma unroll
    for (int i = 0; i < 16; ++i) {
      const int t = 16 * g + i;
      bc += la_[i];
      const float eq = __expf(bc);
      const float qn = bf2f(q_[i]) * eq, kn = bf2f(k_[i]) / eq;
      const bf2 pk = __builtin_convertvector((f2v){qn, kn}, bf2);
      const unsigned u = __builtin_bit_cast(unsigned, pk);
      GQ[t * 64 + lane] = (u16)(u & 0xffff);
      GK[t * 64 + lane] = (u16)(u >> 16);
      *(u16*)(kl + lane * 144 + tpos(t) * 2) = (u16)(u >> 16);
    }
  }
  ((float*)(ws + OFF_DD))[(size_t)item * 64 + lane] = __expf(bc);
  asm volatile("s_waitcnt lgkmcnt(0)" ::: "memory");
  const u16* GVT = (const u16*)(ws + OFF_GVT) + (size_t)bh * 128 * SEQ + 64 * c;
  float* LKV = (float*)(ws + OFF_LKV) + (size_t)item * 128 * 64;
  bf8 kb[2][4];
#pragma unroll
  for (int nt = 0; nt < 2; ++nt)
#pragma unroll
    for (int s = 0; s < 4; ++s) kb[nt][s] = *(const bf8*)(kl + (32 * nt + r) * 144 + (16 * s + 8 * h) * 2);
#pragma unroll 1
  for (int mt = 0; mt < 4; ++mt) {
    f16v a0 = zero16(), a1 = zero16();
#pragma unroll
    for (int s = 0; s < 4; ++s) {
      const bf8 vf = *(const bf8*)(GVT + (size_t)(32 * mt + r) * SEQ + 16 * s + 8 * h);
      a0 = MFMA(vf, kb[0][s], a0);
      a1 = MFMA(vf, kb[1][s], a1);
    }
#pragma unroll
    for (int i = 0; i < 16; ++i) {
      LKV[(32 * mt + crow(i, h)) * 64 + r] = a0[i];
      LKV[(32 * mt + crow(i, h)) * 64 + 32 + r] = a1[i];
    }
  }
  asm volatile("s_waitcnt lgkmcnt(0)" ::: "memory");
}

DI void gla_g2(const MKParams& p, int gtid, int gthreads) {
  char* ws = p.ws;
  for (int u = gtid; u < 32768; u += gthreads) {
    const int oct = u & 7, dv = (u >> 3) & 127, bh = u >> 10;
    f8v S = {0.f, 0.f, 0.f, 0.f, 0.f, 0.f, 0.f, 0.f};
#pragma unroll 4
    for (int c = 0; c < 32; ++c) {
      const size_t item = (size_t)bh * 32 + c;
      *(bf8*)((u16*)(ws + OFF_SS) + (item * 128 + dv) * 64 + oct * 8) = cvt8(S);
      const f8v l = *(const f8v*)((const float*)(ws + OFF_LKV) + (item * 128 + dv) * 64 + oct * 8);
      const f8v d = *(const f8v*)((const float*)(ws + OFF_DD) + item * 64 + oct * 8);
      S = d * (S + l);
    }
  }
}

DI void gla_g3_tile(const MKParams& p, int tile, int wave, int lane, char* dst, int dst_ld) {
  char* ws = p.ws;
  const int r = lane & 31, h = lane >> 5;
  const int b = tile >> 5, c = tile & 31, hd = wave >> 1, tt = wave & 1, bh = b * 4 + hd;
  const u16* GQ = (const u16*)(ws + OFF_GQ) + ((size_t)bh * SEQ + 64 * c) * 64;
  const u16* GK = (const u16*)(ws + OFF_GK) + ((size_t)bh * SEQ + 64 * c) * 64;
  const u16* GVT = (const u16*)(ws + OFF_GVT) + (size_t)bh * 128 * SEQ + 64 * c;
  const u16* SS = (const u16*)(ws + OFF_SS) + ((size_t)(bh * 32 + c) * 128) * 64;
  bf8 qf[4];
#pragma unroll
  for (int ks = 0; ks < 4; ++ks) qf[ks] = *(const bf8*)(GQ + (32 * tt + r) * 64 + 16 * ks + 8 * h);
  bf8 pf[2][2];
#pragma unroll
  for (int kt = 0; kt < 2; ++kt) {
    if (kt <= tt) {
      f16v pt = zero16();
#pragma unroll
      for (int ks = 0; ks < 4; ++ks) {
        const bf8 kf = *(const bf8*)(GK + (32 * kt + r) * 64 + 16 * ks + 8 * h);
        pt = MFMA(kf, qf[ks], pt);
      }
      if (kt == tt) {
#pragma unroll
        for (int i = 0; i < 16; ++i) pt[i] = (crow(i, h) <= r) ? pt[i] : 0.f;
      }
      pf[kt][0] = pack8(pt, 0);
      pf[kt][1] = pack8(pt, 1);
    }
  }
  f16v o[4];
#pragma unroll
  for (int mt = 0; mt < 4; ++mt) {
    o[mt] = zero16();
#pragma unroll
    for (int ks = 0; ks < 4; ++ks) {
      const bf8 sf = *(const bf8*)(SS + (32 * mt + r) * 64 + 16 * ks + 8 * h);
      o[mt] = MFMA(sf, qf[ks], o[mt]);
    }
#pragma unroll
    for (int kt = 0; kt < 2; ++kt) {
      if (kt <= tt) {
#pragma unroll
        for (int s = 0; s < 2; ++s) {
          const bf8 vf = *(const bf8*)(GVT + (size_t)(32 * mt + r) * SEQ + 32 * kt + 16 * s + 8 * h);
          o[mt] = MFMA(vf, pf[kt][s], o[mt]);
        }
      }
    }
  }
  float ss = 0.f;
#pragma unroll
  for (int mt = 0; mt < 4; ++mt)
#pragma unroll
    for (int i = 0; i < 16; ++i) ss += o[mt][i] * o[mt][i];
  ss += __shfl_xor(ss, 32);
  const float rr = rsqrtf(ss * (1.0f / 128.0f) + EPSV);
  const size_t tok = (size_t)tile * 64 + 32 * tt + r;
  const u16* OG = (const u16*)(ws + OFF_OG) + tok * 512 + hd * 128;
#pragma unroll
  for (int mt = 0; mt < 4; ++mt)
#pragma unroll
    for (int g = 0; g < 4; ++g) {
      const int dv0 = 32 * mt + 8 * g + 4 * h;
      const ushort4 og4 = *(const ushort4*)(OG + dv0);
      const f4v gg = *(const f4v*)(p.g_gla + dv0);
      const float og[4] = {bf2f(og4.x), bf2f(og4.y), bf2f(og4.z), bf2f(og4.w)};
      f4v v;
#pragma unroll
      for (int j = 0; j < 4; ++j) v[j] = o[mt][4 * g + j] * rr * gg[j] * (og[j] / (1.0f + __expf(-og[j])));
      *(bf4*)(dst + (size_t)(32 * tt + r) * dst_ld + (hd * 128 + dv0) * 2) = cvt4(v);
    }
}
DI void gemm_1024(const char* ldsA, const bf8* __restrict__ wf, int wave, int lane, f16v (&a0)[2][2], f16v (&a1)[2][2]) {
  gemm_chunk<true>(ldsA, wf + 2 * wave * 64, lane, a0);
  gemm_chunk<true>(ldsA, wf + 65536 + 2 * wave * 64, lane, a1);
}
DI void gemm_1024_res(const char* ldsA, const bf8* __restrict__ wf, int wave, int lane, f16v (&a0)[2][2], f16v (&a1)[2][2],
                      const float* res) {
  gemm_chunk<true, true>(ldsA, wf + 2 * wave * 64, lane, a0, res + 64 * wave);
  gemm_chunk<true, true>(ldsA, wf + 65536 + 2 * wave * 64, lane, a1, res + 512 + 64 * wave);
}

DI void store_f32_ssq(const f16v (&a)[2][2], float* dst, int f0, int lane, float (&ssq)[2]) {
  const int r = lane & 31, h = lane >> 5;
#pragma unroll
  for (int ntl = 0; ntl < 2; ++ntl)
#pragma unroll
    for (int tt = 0; tt < 2; ++tt)
#pragma unroll
      for (int g = 0; g < 4; ++g) {
        f4v v = {a[ntl][tt][4 * g], a[ntl][tt][4 * g + 1], a[ntl][tt][4 * g + 2], a[ntl][tt][4 * g + 3]};
        ssq[tt] += v[0] * v[0] + v[1] * v[1] + v[2] * v[2] + v[3] * v[3];
        *(f4v*)(dst + (size_t)(32 * tt + r) * DM + f0 + 32 * ntl + 8 * g + 4 * h) = v;
      }
}

DI void acc_to_scratch(u16* scr, const f16v (&a)[2][2], int f0, int lane, float s0, float s1) {
  const int r = lane & 31, h = lane >> 5;
#pragma unroll
  for (int ntl = 0; ntl < 2; ++ntl)
#pragma unroll
    for (int tt = 0; tt < 2; ++tt)
#pragma unroll
      for (int g = 0; g < 4; ++g) {
        const float sc = tt ? s1 : s0;
        f4v v = {a[ntl][tt][4 * g] * sc, a[ntl][tt][4 * g + 1] * sc, a[ntl][tt][4 * g + 2] * sc, a[ntl][tt][4 * g + 3] * sc};
        *(bf4*)(scr + (size_t)(32 * tt + r) * 1024 + f0 + 32 * ntl + 8 * g + 4 * h) = cvt4(v);
      }
}
typedef __attribute__((ext_vector_type(4))) unsigned u4v;
DI void scratch_to_lds(const u16* scr, char* ldsA, int tid) {
  asm volatile("" : "+v"(tid));
  const unsigned toff = (unsigned)tid * 16u;
#pragma unroll
  for (int half = 0; half < 2; ++half) {
    u4v v[8];
#pragma unroll
    for (int it = 0; it < 8; ++it)
      v[it] = __builtin_nontemporal_load((const u4v*)((const char*)scr + (size_t)(8192 * (8 * half + it)) + toff));
#pragma unroll
    for (int it = 0; it < 8; ++it) {
      const int idx = tid + 512 * (8 * half + it), row = idx >> 7, ch = idx & 127;
      *(u4v*)(ldsA + row * LDS_ROW + ch * 16) = v[it];
    }
  }
}

struct Pk { bf4 v[2][2][4]; };
DI void pack_acc(Pk& pk, const f16v (&a)[2][2], float s0, float s1) {
#pragma unroll
  for (int ntl = 0; ntl < 2; ++ntl)
#pragma unroll
    for (int tt = 0; tt < 2; ++tt)
#pragma unroll
      for (int g = 0; g < 4; ++g) {
        const float sc = tt ? s1 : s0;
        f4v v = {a[ntl][tt][4 * g] * sc, a[ntl][tt][4 * g + 1] * sc, a[ntl][tt][4 * g + 2] * sc, a[ntl][tt][4 * g + 3] * sc};
        pk.v[ntl][tt][g] = cvt4(v);
      }
}
DI void pk_to_lds(char* ldsA, const Pk& pk, int f0, int lane) {
  const int r = lane & 31, h = lane >> 5;
#pragma unroll
  for (int ntl = 0; ntl < 2; ++ntl)
#pragma unroll
    for (int tt = 0; tt < 2; ++tt)
#pragma unroll
      for (int g = 0; g < 4; ++g)
        *(bf4*)(ldsA + (32 * tt + r) * LDS_ROW + (f0 + 32 * ntl + 8 * g + 4 * h) * 2) = pk.v[ntl][tt][g];
}

DI void rms_from_partials(float* red, int wave, int lane, const float (&ssq)[2], float& rs0, float& rs1) {
  red[(wave * 2 + 0) * 64 + lane] = ssq[0];
  red[(wave * 2 + 1) * 64 + lane] = ssq[1];
  __syncthreads();
  const int r = lane & 31;
  float t0 = 0.f, t1 = 0.f;
#pragma unroll
  for (int w = 0; w < 8; ++w) {
    t0 += red[(w * 2 + 0) * 64 + r] + red[(w * 2 + 0) * 64 + 32 + r];
    t1 += red[(w * 2 + 1) * 64 + r] + red[(w * 2 + 1) * 64 + 32 + r];
  }
  rs0 = rsqrtf(t0 * (1.0f / DM) + EPSV);
  rs1 = rsqrtf(t1 * (1.0f / DM) + EPSV);
}

DI void mem_attn(const MKParams& p, char* ldsA, int b, int wave, int lane) {
  char* ws = p.ws;
  const int r = lane & 31, h = lane >> 5;
  const int hm = wave >> 1, tt = wave & 1;
  const u16* KM = (const u16*)(ws + OFF_KM) + (size_t)(b * 4 + hm) * 256 * 256;
  const u16* VMT = (const u16*)(ws + OFF_VMT) + (size_t)(b * 4 + hm) * 256 * 256;
  char* qrow = ldsA + (32 * tt + r) * LDS_ROW + hm * 512;
  const unsigned loff = (unsigned)((r * 256 + 8 * h) * 2);
  f16v s[8];
#pragma unroll
  for (int mt = 0; mt < 8; ++mt) s[mt] = zero16();
#pragma unroll 2
  for (int ks = 0; ks < 16; ++ks) {
    const bf8 qf = *(const bf8*)(qrow + (16 * ks + 8 * h) * 2);
#pragma unroll
    for (int mt = 0; mt < 8; ++mt) {
      const bf8 kf = *(const bf8*)((const char*)KM + (size_t)((32 * mt * 256 + 16 * ks) * 2) + loff);
      s[mt] = MFMA(kf, qf, s[mt]);
    }
  }
  float mx = -INFINITY;
#pragma unroll
  for (int mt = 0; mt < 8; ++mt)
#pragma unroll
    for (int i = 0; i < 16; ++i) mx = fmaxf(mx, s[mt][i]);
  mx = fmaxf(mx, __shfl_xor(mx, 32));
  float l = 0.f;
  bf8 pf[8][2];
#pragma unroll
  for (int mt = 0; mt < 8; ++mt) {
#pragma unroll
    for (int i = 0; i < 16; ++i) { s[mt][i] = __expf(s[mt][i] - mx); l += s[mt][i]; }
    pf[mt][0] = pack8(s[mt], 0);
    pf[mt][1] = pack8(s[mt], 1);
  }
  l += __shfl_xor(l, 32);
  const float inv = 1.0f / l;
#pragma unroll
  for (int grp = 0; grp < 2; ++grp) {
    f16v o[4];
#pragma unroll
    for (int m4 = 0; m4 < 4; ++m4) o[m4] = zero16();
#pragma unroll
    for (int kt = 0; kt < 8; ++kt)
#pragma unroll
      for (int sx = 0; sx < 2; ++sx)
#pragma unroll
        for (int m4 = 0; m4 < 4; ++m4) {
          const bf8 vf = *(const bf8*)((const char*)VMT + (size_t)((32 * (4 * grp + m4) * 256 + 32 * kt + 16 * sx) * 2) + loff);
          o[m4] = MFMA(vf, pf[kt][sx], o[m4]);
        }
#pragma unroll
    for (int m4 = 0; m4 < 4; ++m4)
#pragma unroll
      for (int g = 0; g < 4; ++g) {
        f4v v = {o[m4][4 * g] * inv, o[m4][4 * g + 1] * inv, o[m4][4 * g + 2] * inv, o[m4][4 * g + 3] * inv};
        *(bf4*)(qrow + (32 * (4 * grp + m4) + 8 * g + 4 * h) * 2) = cvt4(v);
      }
  }
}

DI void phase_c_tile(const MKParams& p, int tile, int wave, int lane, float& rs0, float& rs1) {
  asm volatile("" : "+v"(lane));
  char* ws = p.ws;
  char* ldsA = smem;
  float* red = (float*)(smem + LDS_A_BYTES);
  const size_t tok0 = (size_t)tile * 64;
  const int tid = wave * 64 + lane;
  __syncthreads();
#if PROBE == 15
  for (int rep_ = 0; rep_ < 2; ++rep_) {
#else
  {
#endif
  gla_g3_tile(p, tile, wave, lane, ldsA, LDS_ROW);
  {
    const char* osb = ws + OFF_OSB + tok0 * 1024;
#pragma unroll
    for (int it = 0; it < 8; ++it) {
      const int idx = tid + 512 * it, row = idx >> 6, ch = idx & 63;
      *(uint4*)(ldsA + row * LDS_ROW + 1024 + ch * 16) = *(const uint4*)(osb + (size_t)row * 1024 + ch * 16);
    }
  }
  }
  __syncthreads();
  f16v acc[2][2];
  Pk pk0, pk1;
  float* hdst = p.out + tok0 * DM;
  {
    float ssq[2] = {0.f, 0.f};
    const bf8* wf = (const bf8*)(ws + OFF_WOUT);
    asm volatile("" : "+v"(lane));
    gemm_chunk<true, true>(ldsA, wf + 2 * wave * 64, lane, acc, p.x + tok0 * DM + 64 * wave);
    store_f32_ssq(acc, hdst, 64 * wave, lane, ssq);
    pack_acc(pk0, acc, 1.f, 1.f);
    asm volatile("" : "+v"(lane));
    gemm_chunk<true, true>(ldsA, wf + 65536 + 2 * wave * 64, lane, acc, p.x + tok0 * DM + 512 + 64 * wave);
    store_f32_ssq(acc, hdst, 512 + 64 * wave, lane, ssq);
    pack_acc(pk1, acc, 1.f, 1.f);
    rms_from_partials(red, wave, lane, ssq, rs0, rs1);
  }
  pk_to_lds(ldsA, pk0, 64 * wave, lane);
  pk_to_lds(ldsA, pk1, 512 + 64 * wave, lane);
  __syncthreads();
  {
    const bf8* wf = (const bf8*)(ws + OFF_WMQ);
    asm volatile("" : "+v"(lane));
    gemm_chunk<true>(ldsA, wf + 2 * wave * 64, lane, acc);
    pack_acc(pk0, acc, rs0, rs1);
    asm volatile("" : "+v"(lane));
    gemm_chunk<true>(ldsA, wf + 65536 + 2 * wave * 64, lane, acc);
    pack_acc(pk1, acc, rs0, rs1);
  }
  __syncthreads();
  pk_to_lds(ldsA, pk0, 64 * wave, lane);
  pk_to_lds(ldsA, pk1, 512 + 64 * wave, lane);
  __syncthreads();
  asm volatile("" : "+v"(lane));
  mem_attn(p, ldsA, tile >> 5, wave, lane);
  __syncthreads();
  {
    float ssq[2] = {0.f, 0.f};
    const bf8* wf = (const bf8*)(ws + OFF_WMO);
    asm volatile("" : "+v"(lane));
    gemm_chunk<true, true>(ldsA, wf + 2 * wave * 64, lane, acc, hdst + 64 * wave);
    store_f32_ssq(acc, hdst, 64 * wave, lane, ssq);
    pack_acc(pk0, acc, 1.f, 1.f);
    asm volatile("" : "+v"(lane));
    gemm_chunk<true, true>(ldsA, wf + 65536 + 2 * wave * 64, lane, acc, hdst + 512 + 64 * wave);
    store_f32_ssq(acc, hdst, 512 + 64 * wave, lane, ssq);
    pack_acc(pk1, acc, 1.f, 1.f);
    rms_from_partials(red, wave, lane, ssq, rs0, rs1);
  }
  pk_to_lds(ldsA, pk0, 64 * wave, lane);
  pk_to_lds(ldsA, pk1, 512 + 64 * wave, lane);
  __syncthreads();
}
#define OFF_EG (OFF_LKV + 16 * MiB)

DI unsigned f2ord(float v) { const unsigned u = __float_as_uint(v); return (u & 0x80000000u) ? ~u : (u | 0x80000000u); }
DI float ord2f(unsigned u) { return __uint_as_float((u & 0x80000000u) ? (u ^ 0x80000000u) : ~u); }

DI void ins16(unsigned (&L)[16], unsigned x) {
#pragma unroll
  for (int s = 0; s < 16; ++s) {
    const unsigned hi = max(L[s], x);
    x = min(L[s], x);
    L[s] = hi;
  }
}
DI void merge_halves16(unsigned (&L)[16]) {
  unsigned O[16];
#pragma unroll
  for (int s = 0; s < 16; ++s) O[s] = (unsigned)__shfl_xor((int)L[s], 32);
#pragma unroll
  for (int s = 0; s < 16; ++s) L[s] = max(L[s], O[15 - s]);
#pragma unroll
  for (int d = 8; d > 0; d >>= 1)
#pragma unroll
    for (int i = 0; i < 16; ++i)
      if ((i & d) == 0) {
        const unsigned hi = max(L[i], L[i + d]), lo = min(L[i], L[i + d]);
        L[i] = hi; L[i + d] = lo;
      }
}

DI void peer_top16(const char* ws, const u16* qp, int hp, int tt, int lane, unsigned (&L)[16]) {
  const int r = lane & 31, h = lane >> 5;
  const bf8* sk = (const bf8*)(ws + OFF_SUBK) + (size_t)hp * 4 * 8 * 64 + lane;
  f16v s[4];
#pragma unroll
  for (int mt = 0; mt < 4; ++mt) s[mt] = zero16();
#pragma unroll
  for (int ks = 0; ks < 8; ++ks) {
    const bf8 qf = *(const bf8*)(qp + (size_t)(32 * tt + r) * 2048 + hp * 128 + 16 * ks + 8 * h);
#pragma unroll
    for (int mt = 0; mt < 4; ++mt) s[mt] = MFMA(sk[(mt * 8 + ks) * 64], qf, s[mt]);
  }
#pragma unroll
  for (int i = 0; i < 16; ++i) L[i] = 0u;
#pragma unroll
  for (int mt = 0; mt < 4; ++mt)
#pragma unroll
    for (int i = 0; i < 16; ++i) {
      const unsigned key = (f2ord(s[mt][i]) & ~127u) | (unsigned)(127 - (32 * mt + crow(i, h)));
      ins16(L, key);
    }
  merge_halves16(L);
}

DI void peer_select(const char* ws, const u16* qp, uint2* eg, unsigned char* idxs  , int head,
                    int tt, int lane) {
  const int r = lane & 31, h = lane >> 5;
  unsigned La[16], Lb[16];
  peer_top16(ws, qp, 2 * head, tt, lane, La);
  __builtin_amdgcn_sched_barrier(0);
  peer_top16(ws, qp, 2 * head + 1, tt, lane, Lb);
  __builtin_amdgcn_sched_barrier(0);
  if (h == 0) {
#pragma unroll
    for (int g = 0; g < 4; ++g) {
      unsigned wa = 0, wb = 0;
#pragma unroll
      for (int j = 0; j < 4; ++j) {
        wa |= (127u - (La[4 * g + j] & 127u)) << (8 * j);
        wb |= (127u - (Lb[4 * g + j] & 127u)) << (8 * j);
      }
      *(unsigned*)(idxs + r * 32 + 4 * g) = wa;
      *(unsigned*)(idxs + r * 32 + 16 + 4 * g) = wb;
    }
  }
  float fa[16], fb[16];
#pragma unroll
  for (int i = 0; i < 16; ++i) { fa[i] = ord2f(La[i] & ~127u); fb[i] = ord2f(Lb[i] & ~127u); }
  unsigned C[16];
#pragma unroll
  for (int i = 0; i < 16; ++i) C[i] = 0u;
#define PEER_CAND(a, b) ins16(C, (f2ord(fa[a] + fb[b]) & ~255u) | (unsigned)(255 - ((a) * 16 + (b))));
#define PEER_ROW1(a) PEER_CAND(a, 0)
#define PEER_ROW2(a) PEER_ROW1(a) PEER_CAND(a, 1)
#define PEER_ROW3(a) PEER_ROW2(a) PEER_CAND(a, 2)
#define PEER_ROW4(a) PEER_ROW3(a) PEER_CAND(a, 3)
#define PEER_ROW5(a) PEER_ROW4(a) PEER_CAND(a, 4)
#define PEER_ROW8(a) PEER_ROW5(a) PEER_CAND(a, 5) PEER_CAND(a, 6) PEER_CAND(a, 7)
#define PEER_ROW16(a) PEER_ROW8(a) PEER_CAND(a, 8) PEER_CAND(a, 9) PEER_CAND(a, 10) PEER_CAND(a, 11) PEER_CAND(a, 12) PEER_CAND(a, 13) PEER_CAND(a, 14) PEER_CAND(a, 15)
  PEER_ROW16(0) PEER_ROW8(1) PEER_ROW5(2) PEER_ROW4(3) PEER_ROW3(4) PEER_ROW2(5) PEER_ROW2(6) PEER_ROW2(7)
  PEER_ROW1(8) PEER_ROW1(9) PEER_ROW1(10) PEER_ROW1(11) PEER_ROW1(12) PEER_ROW1(13) PEER_ROW1(14) PEER_ROW1(15)
  asm volatile("s_waitcnt lgkmcnt(0)" ::: "memory");
  const float vmax = ord2f(C[0] & ~255u);
  float ex[16], sum = 0.f;
#pragma unroll
  for (int i = 0; i < 16; ++i) { ex[i] = __expf(ord2f(C[i] & ~255u) - vmax); sum += ex[i]; }
  const float inv = 1.0f / sum;
  const unsigned hmask = 0u - (unsigned)h;
#pragma unroll
  for (int i = 0; i < 8; ++i) {
    const unsigned ck = C[i] ^ ((C[i] ^ C[8 + i]) & hmask);
    const unsigned gb = __float_as_uint(ex[i]) ^ ((__float_as_uint(ex[i]) ^ __float_as_uint(ex[8 + i])) & hmask);
    const float g = __uint_as_float(gb) * inv;
    const unsigned code = 255u - (ck & 255u);
    const unsigned ia = idxs[r * 32 + (code >> 4)], ib = idxs[r * 32 + 16 + (code & 15u)];
    eg[(size_t)(32 * tt + r) * 128 + head * 16 + 8 * h + i] = make_uint2(ia * 128u + ib, __float_as_uint(g));
  }
  asm volatile("s_waitcnt lgkmcnt(0)" ::: "memory");
}

DI float wave_sum(float v) {
#pragma unroll
  for (int o = 32; o > 0; o >>= 1) v += __shfl_xor(v, o);
  return v;
}

DI void reduce8(const float (&pv)[8], float& s0, float& s1) {
  float q[4], s[2];
#pragma unroll
  for (int m = 0; m < 4; ++m) {
    const auto r = __builtin_amdgcn_permlane32_swap(__float_as_uint(pv[m]), __float_as_uint(pv[m + 4]), false, false);
    q[m] = __uint_as_float(r[0]) + __uint_as_float(r[1]);
  }
#pragma unroll
  for (int m = 0; m < 2; ++m) {
    const auto r = __builtin_amdgcn_permlane16_swap(__float_as_uint(q[m]), __float_as_uint(q[m + 2]), false, false);
    s[m] = __uint_as_float(r[0]) + __uint_as_float(r[1]);
  }
#pragma unroll
  for (int m = 0; m < 2; ++m) {
    s[m] += __uint_as_float(__builtin_amdgcn_update_dpp(0, __float_as_uint(s[m]), 0x128, 0xf, 0xf, false));
    s[m] += __uint_as_float(__builtin_amdgcn_update_dpp(0, __float_as_uint(s[m]), 0x124, 0xf, 0xf, false));
    s[m] += __uint_as_float(__builtin_amdgcn_update_dpp(0, __float_as_uint(s[m]), 0x122, 0xf, 0xf, false));
    s[m] += __uint_as_float(__builtin_amdgcn_update_dpp(0, __float_as_uint(s[m]), 0x121, 0xf, 0xf, false));
  }
  s0 = s[0]; s1 = s[1];
}

DI void peer_bucket_token(const uint2* egt, unsigned* tmp  , int lane, unsigned& E0, unsigned& E1,
                          unsigned& G0, unsigned& G1) {
  const uint2 a = egt[lane], b = egt[64 + lane];
  const int ba = (int)(a.x >> 10), bb = (int)(b.x >> 10);
  const unsigned long long lt = (1ull << lane) - 1ull;
  int da = 0, db = 0, start = 0;
#pragma unroll
  for (int k = 0; k < 16; ++k) {
    const unsigned long long ma = __ballot(ba == k), mb = __ballot(bb == k);
    const int ca = __popcll(ma), cb = __popcll(mb);
    if (ba == k) da = start + __popcll(ma & lt);
    if (bb == k) db = start + ca + __popcll(mb & lt);
    start += ca + cb;
  }
  const int ia = (da & 1) * 64 + (da >> 3) + 16 * ((da >> 1) & 3);
  const int ib = (db & 1) * 64 + (db >> 3) + 16 * ((db >> 1) & 3);
  tmp[ia] = a.x; tmp[128 + ia] = a.y;
  tmp[ib] = b.x; tmp[128 + ib] = b.y;
  asm volatile("s_waitcnt lgkmcnt(0)" ::: "memory");
  E0 = tmp[lane]; E1 = tmp[64 + lane]; G0 = tmp[128 + lane]; G1 = tmp[192 + lane];
  asm volatile("s_waitcnt lgkmcnt(0)" ::: "memory");
}

DI void peer_finalize_token(const MKParams& p, float (&acc)[16], size_t tok, int lane) {
  float* orow = p.out + tok * DM + 16 * lane;
  float ss = 0.f;
#pragma unroll
  for (int q = 0; q < 4; ++q) {
    const f4v hv = *(const f4v*)(orow + 4 * q);
#pragma unroll
    for (int j = 0; j < 4; ++j) { acc[4 * q + j] += hv[j]; ss += acc[4 * q + j] * acc[4 * q + j]; }
  }
  ss = wave_sum(ss);
  const float rf = rsqrtf(ss * (1.0f / DM) + EPSV);
#pragma unroll
  for (int q = 0; q < 4; ++q) {
    const f4v gg = *(const f4v*)(p.g_fin + 16 * lane + 4 * q);
    f4v o = {acc[4 * q] * rf * gg[0], acc[4 * q + 1] * rf * gg[1], acc[4 * q + 2] * rf * gg[2], acc[4 * q + 3] * rf * gg[3]};
    *(f4v*)(orow + 4 * q) = o;
  }
}

DI void peer_usweep(const char* ws, const char* ldsA, int wave, int lane, const unsigned (&E)[8][2], float (&A)[8][2]) {
  const char* PU = ws + OFF_PU + 16 * lane;
#pragma unroll
  for (int i = 0; i < 8; ++i) { A[i][0] = 0.f; A[i][1] = 0.f; }
#pragma unroll 1
  for (int j = 0; j < 16; ++j) {
    const bool sel = ((lane & 15) == j);
#pragma unroll
    for (int i = 0; i < 8; ++i) {
      const char* xrow = ldsA + (8 * wave + i) * LDS_ROW + 32 * lane;
      const uint4 x0 = *(const uint4*)xrow, x1 = *(const uint4*)(xrow + 16);
      const unsigned xr[8] = {x0.x, x0.y, x0.z, x0.w, x1.x, x1.y, x1.z, x1.w};
      uint4 u0[8];
#pragma unroll
      for (int m = 0; m < 8; ++m) {
        const int e = __builtin_amdgcn_readlane((int)E[i][m & 1], j + 16 * (m >> 1));
        u0[m] = *(const uint4*)(PU + (size_t)e * 1024);
      }
      float pv[8];
#pragma unroll
      for (int m = 0; m < 8; ++m) {
        const unsigned uw[4] = {u0[m].x, u0[m].y, u0[m].z, u0[m].w};
        float dsum = 0.f;
#pragma unroll
        for (int q = 0; q < 4; ++q) {
          const bf2 lo = __builtin_amdgcn_cvt_scalef32_pk_bf16_fp8(uw[q], 1.0f, false);
          const bf2 hi = __builtin_amdgcn_cvt_scalef32_pk_bf16_fp8(uw[q], 1.0f, true);
          dsum = __builtin_amdgcn_fdot2_f32_bf16(lo, __builtin_bit_cast(bf2, xr[2 * q]), dsum, false);
          dsum = __builtin_amdgcn_fdot2_f32_bf16(hi, __builtin_bit_cast(bf2, xr[2 * q + 1]), dsum, false);
        }
        pv[m] = dsum;
      }
      float s0, s1;
      reduce8(pv, s0, s1);
      A[i][0] = sel ? s0 : A[i][0];
      A[i][1] = sel ? s1 : A[i][1];
    }
  }
}

template <int T0>
DI void peer_vsweep(const MKParams& p, int wave, int lane, size_t tok0, const unsigned (&E)[8][2], const unsigned (&Wb)[8][2]) {
  const char* PV = p.ws + OFF_PV + 16 * lane;
  float acc[4][16];
#pragma unroll
  for (int i = 0; i < 4; ++i)
#pragma unroll
    for (int q = 0; q < 16; ++q) acc[i][q] = 0.f;
#pragma unroll 1
  for (int j = 0; j < 16; ++j) {
#pragma unroll
    for (int i = 0; i < 4; ++i) {
      uint4 v0[8];
      unsigned wl[8];
#pragma unroll
      for (int m = 0; m < 8; ++m) {
        const int e = __builtin_amdgcn_readlane((int)E[T0 + i][m & 1], j + 16 * (m >> 1));
        wl[m] = (unsigned)__builtin_amdgcn_readlane((int)Wb[T0 + i][m & 1], j + 16 * (m >> 1));
        v0[m] = *(const uint4*)(PV + (size_t)e * 1024);
      }
#pragma unroll
      for (int m = 0; m < 8; ++m) {
        const unsigned vw[4] = {v0[m].x, v0[m].y, v0[m].z, v0[m].w};
        const bf2 wlo = __builtin_bit_cast(bf2, wl[m]), whi = __builtin_bit_cast(bf2, wl[m] << 16);
#pragma unroll
        for (int q = 0; q < 4; ++q) {
          const bf2 lo = __builtin_amdgcn_cvt_scalef32_pk_bf16_fp8(vw[q], 1.0f, false);
          const bf2 hi = __builtin_amdgcn_cvt_scalef32_pk_bf16_fp8(vw[q], 1.0f, true);
          acc[i][4 * q] = __builtin_amdgcn_fdot2_f32_bf16(lo, wlo, acc[i][4 * q], false);
          acc[i][4 * q + 1] = __builtin_amdgcn_fdot2_f32_bf16(lo, whi, acc[i][4 * q + 1], false);
          acc[i][4 * q + 2] = __builtin_amdgcn_fdot2_f32_bf16(hi, wlo, acc[i][4 * q + 2], false);
          acc[i][4 * q + 3] = __builtin_amdgcn_fdot2_f32_bf16(hi, whi, acc[i][4 * q + 3], false);
        }
      }
    }
  }
#pragma unroll
  for (int i = 0; i < 4; ++i) peer_finalize_token(p, acc[i], tok0 + 8 * wave + T0 + i, lane);
}

DI void phase_d_tile(const MKParams& p, int tile, int wave, int lane, float rs0, float rs1) {
  asm volatile("" : "+v"(lane));
  char* ws = p.ws;
  char* ldsA = smem;
  float* rs_s = (float*)(smem + LDS_A_BYTES);
  unsigned char* idxs = (unsigned char*)(smem + LDS_A_BYTES + 4096) + wave * 1024;
  u16* qp = (u16*)qp_scratch(ws, blockIdx.x);
  uint2* eg = (uint2*)(ws + OFF_EG + (size_t)blockIdx.x * 65536);
  const size_t tok0 = (size_t)tile * 64;
  if (wave == 0) { if (lane < 32) rs_s[lane] = rs0; else rs_s[lane] = rs1; }
  {
    f16v acc[2][2];
    const bf8* wf = (const bf8*)(ws + OFF_WPQ);
#if PROBE == 17
    for (int rep_ = 0; rep_ < 2; ++rep_)
#endif
#pragma unroll 1
    for (int c = 0; c < 4; ++c) {
      int l2 = lane;
      asm volatile("" : "+v"(l2));
      const int r = l2 & 31, h = l2 >> 5;
      gemm_chunk<true>(ldsA, wf + (size_t)c * 65536 + 2 * wave * 64, l2, acc);
#pragma unroll
      for (int ntl = 0; ntl < 2; ++ntl)
#pragma unroll
        for (int tt = 0; tt < 2; ++tt)
#pragma unroll
          for (int g = 0; g < 4; ++g) {
            const float sc = tt ? rs1 : rs0;
            f4v v = {acc[ntl][tt][4 * g] * sc, acc[ntl][tt][4 * g + 1] * sc, acc[ntl][tt][4 * g + 2] * sc, acc[ntl][tt][4 * g + 3] * sc};
            *(bf4*)(qp + (size_t)(32 * tt + r) * 2048 + 512 * c + 64 * wave + 32 * ntl + 8 * g + 4 * h) = cvt4(v);
          }
    }
  }
  __syncthreads();
#if PROBE == 16
  for (int rep_ = 0; rep_ < 2; ++rep_)
#endif
#pragma unroll 1
  for (int tt = 0; tt < 2; ++tt) {
    int l2 = lane;
    asm volatile("" : "+v"(l2));
    peer_select(ws, qp, eg, idxs, wave, tt, l2);
  }
  __syncthreads();
}

DI void phase_d_gather(const MKParams& p, int tile, int wave, int lane) {
  asm volatile("" : "+v"(lane));
  char* ws = p.ws;
  char* ldsA = smem;
  float* rs_s = (float*)(smem + LDS_A_BYTES);
  unsigned char* idxs = (unsigned char*)(smem + LDS_A_BYTES + 4096) + wave * 1024;
  const uint2* eg = (const uint2*)(ws + OFF_EG + (size_t)blockIdx.x * 65536);
  const size_t tok0 = (size_t)tile * 64;
  {
    int l2 = lane;
    asm volatile("" : "+v"(l2));
    unsigned E[8][2], G[8][2];
#pragma unroll
    for (int i = 0; i < 8; ++i)
      peer_bucket_token(eg + (size_t)(8 * wave + i) * 128, (unsigned*)idxs, l2, E[i][0], E[i][1], G[i][0], G[i][1]);
    float A[8][2];
    peer_usweep(ws, ldsA, wave, l2, E, A);
    unsigned Wb[8][2];
#pragma unroll
    for (int i = 0; i < 8; ++i) {
      const float rs = rs_s[8 * wave + i];
#pragma unroll
      for (int cc = 0; cc < 2; ++cc) {
        const float a = A[i][cc] * rs * ((const float*)(ws + OFF_SU))[E[i][cc]];
        const float w = __uint_as_float(G[i][cc]) * 0.5f * a * (1.0f + erff(a * 0.70710678118654752f)) *
                        ((const float*)(ws + OFF_SV))[E[i][cc]];
        Wb[i][cc] = __builtin_bit_cast(unsigned, __builtin_convertvector((f2v){w, 0.f}, bf2));
      }
    }
    __builtin_amdgcn_sched_barrier(0);
    peer_vsweep<0>(p, wave, l2, tok0, E, Wb);
    __builtin_amdgcn_sched_barrier(0);
    peer_vsweep<4>(p, wave, l2, tok0, E, Wb);
  }
}
__global__ __launch_bounds__(512) void mk(MKParams p) {
  cg::grid_group grid = cg::this_grid();
  const int tid = threadIdx.x;
  const int wave = __builtin_amdgcn_readfirstlane(tid >> 6), lane = tid & 63;
  const int gtid = blockIdx.x * 512 + tid, gthreads = gridDim.x * 512;
  const int gw = blockIdx.x * 8 + wave, nw = gridDim.x * 8;
  unsigned* bar = (unsigned*)(p.ws + OFF_BAR);
  phase_prep(p, gtid, gthreads);
  phase_prep_tables(p, gw, nw, lane);
  grid.sync();
  for (int tile = blockIdx.x; tile < 256; tile += gridDim.x) phase_a_tile(p, tile, wave, lane);
  for (int item = blockIdx.x; item < 128; item += gridDim.x) phase_a_memkv(p, item, wave, lane);
#if PROBE == 13
  for (int item = blockIdx.x; item < 128; item += gridDim.x) phase_a_memkv(p, item, wave, lane);
#endif
  grid_barrier(bar, 1u * gridDim.x);
  for (int it = gw; it < 4096; it += nw) sb_item(p, it, lane);
  for (int it = nw - 1 - gw; it < 1024; it += nw) gla_g1_item(p, it, wave, lane);
  grid_barrier(bar, 2u * gridDim.x);
  gla_g2(p, gtid, gthreads);
#if PROBE == 14
  gla_g2(p, gtid, gthreads);
#endif
#if PROBE == 18
  grid.sync(); grid.sync(); grid.sync(); grid.sync();
#endif
  grid_barrier(bar, 3u * gridDim.x);
  const int n_iter = (256 + gridDim.x - 1) / gridDim.x;
  for (int it = 0; it < n_iter; ++it) {
    const int tile = blockIdx.x + it * gridDim.x;
    if (tile < 256) {
      float rs0, rs1;
      phase_c_tile(p, tile, wave, lane, rs0, rs1);
      phase_d_tile(p, tile, wave, lane, rs0, rs1);
    }
    if (tile < 256) phase_d_gather(p, tile, wave, lane);
  }
}
#define MK_LDS (160 * 1024)
extern "C" void kernel_launch(void* const* d_in, const int* in_sizes, int n_in, void* d_out, int out_size, void* d_ws,
                              size_t ws_size, hipStream_t stream) {
  MKParams p{};
  p.x = (const float*)d_in[0]; p.mem = (const float*)d_in[1]; p.g_mix = (const float*)d_in[2];
  p.w_in = (const float*)d_in[3]; p.w_up = (const float*)d_in[4]; p.b_alpha = (const float*)d_in[5];
  p.g_gla = (const float*)d_in[6]; p.w_out = (const float*)d_in[7]; p.g_mq = (const float*)d_in[8];
  p.g_mkv = (const float*)d_in[9]; p.w_mq = (const float*)d_in[10]; p.w_mkv = (const float*)d_in[11];
  p.w_mo = (const float*)d_in[12]; p.g_ffn = (const float*)d_in[13]; p.w_pq = (const float*)d_in[14];
  p.subk = (const float*)d_in[15]; p.pu = (const float*)d_in[16]; p.pv = (const float*)d_in[17];
  p.g_fin = (const float*)d_in[18];
  p.out = (float*)d_out; p.ws = (char*)d_ws;
  float* out = (float*)d_out;
  char* wsb = (char*)d_ws;
  float* ws = (float*)d_ws;
  static int grid_blocks = 0;
  if (!grid_blocks) {
    int dev = 0, cus = 0, per_cu = 0;
    (void)hipGetDevice(&dev);
    (void)hipDeviceGetAttribute(&cus, hipDeviceAttributeMultiprocessorCount, dev);
    (void)hipFuncSetAttribute((const void*)mk, hipFuncAttributeMaxDynamicSharedMemorySize, MK_LDS);
    (void)hipOccupancyMaxActiveBlocksPerMultiprocessor(&per_cu, mk, 512, MK_LDS);
    grid_blocks = cus * per_cu;
    fprintf(stderr, "mk: cus=%d per_cu=%d grid=%d ws=%zu\n", cus, per_cu, grid_blocks, ws_size);
  }
  (void)hipMemsetAsync((char*)d_ws + OFF_BAR, 0, 64, stream);
  {
    void* args[] = {(void*)&p};
    hipError_t e = hipLaunchCooperativeKernel((const void*)mk, dim3(grid_blocks), dim3(512), args, MK_LDS, stream);
    if (e != hipSuccess) fprintf(stderr, "coop launch failed: %s grid %d\n", hipGetErrorString(e), grid_blocks);
  }
}
```

```cpp
#define GEMM_D 4
#define TABLES_IN_B 1
#define REMAP 0
#define FIRST_CG 1
#define GATHER_ALIGN 0
#include <hip/hip_runtime.h>
#include <hip/hip_cooperative_groups.h>
#include <math.h>
#include <stdio.h>
#include <stdint.h>
namespace cg = cooperative_groups;

#ifndef PROBE
#define PROBE 0
#endif
#ifndef TABLES_IN_B
#define TABLES_IN_B 1
#endif
#define NB 8
#define SEQ 2048
#define DM 1024
#define NTOK (NB * SEQ)
#define INC 3088
#define MEML 256
#define EPSV 1e-6f

typedef __attribute__((ext_vector_type(8))) __bf16 bf8;
typedef __attribute__((ext_vector_type(4))) __bf16 bf4;
typedef __attribute__((ext_vector_type(2))) __bf16 bf2;
typedef __attribute__((ext_vector_type(16))) float f16v;
typedef __attribute__((ext_vector_type(8))) float f8v;
typedef __attribute__((ext_vector_type(4))) float f4v;
typedef __attribute__((ext_vector_type(2))) float f2v;
typedef unsigned short u16;

#define DI __device__ __forceinline__
#define MFMA(a, b, c) __builtin_amdgcn_mfma_f32_32x32x16_bf16((a), (b), (c), 0, 0, 0)

DI int crow(int i, int h) { return (i & 3) + 8 * (i >> 2) + 4 * h; }
DI int tpos(int t) { return (t & ~12) | ((t & 4) << 1) | ((t & 8) >> 1); }
DI float bf2f(u16 v) { return __uint_as_float(((unsigned)v) << 16); }
DI bf8 cvt8(f8v v) { return __builtin_convertvector(v, bf8); }
DI bf4 cvt4(f4v v) { return __builtin_convertvector(v, bf4); }
DI f16v zero16() { f16v z = {0.f, 0.f, 0.f, 0.f, 0.f, 0.f, 0.f, 0.f, 0.f, 0.f, 0.f, 0.f, 0.f, 0.f, 0.f, 0.f}; return z; }

#define MiB ((size_t)1 << 20)
#define OFF_WIN   ((size_t)0)
#define OFF_WOUT  (OFF_WIN + 97 * 65536)
#define OFF_WMQ   (OFF_WOUT + 32 * 65536)
#define OFF_WMKV  (OFF_WMQ + 32 * 65536)
#define OFF_WMO   (OFF_WMKV + 64 * 65536)
#define OFF_WPQ   (OFF_WMO + 32 * 65536)
#define OFF_SUBK  (OFF_WPQ + 64 * 65536)
#define OFF_ACT   (21 * MiB)
#define OFF_GQ    (OFF_ACT)
#define OFF_GK    (OFF_GQ + 8 * MiB)
#define OFF_GVT   (OFF_GK + 8 * MiB)
#define OFF_OG    (OFF_GVT + 16 * MiB)
#define OFF_SQ    (OFF_OG + 16 * MiB)
#define OFF_SK    (OFF_SQ + 16 * MiB)
#define OFF_SVT   (OFF_SK + 16 * MiB)
#define OFF_LA    (OFF_SVT + 16 * MiB)
#define OFF_LKV   (OFF_LA + 16 * MiB)
#define OFF_DD    (OFF_LKV + 32 * MiB)
#define OFF_OSB   (OFF_DD + 1 * MiB)
#define OFF_KM    (OFF_OSB + 16 * MiB)
#define OFF_VMT   (OFF_KM + 4 * MiB)
#define OFF_PU    (OFF_VMT + 4 * MiB)
#define OFF_PV    (OFF_PU + 16 * MiB)
#define OFF_SU    (OFF_PV + 16 * MiB)
#define OFF_SV    (OFF_SU + 65536)
#define OFF_SS    (OFF_LA)

#define LDS_ROW 2064
#define LDS_A_BYTES (64 * LDS_ROW)

DI char* qp_scratch(char* ws, int blk) {
  return blk < 192 ? ws + OFF_SQ + (size_t)blk * 262144 : ws + OFF_LKV + (size_t)(blk - 192) * 262144;
}

#define OFF_BAR (OFF_DD + 768 * 1024)
DI void grid_barrier(unsigned* ctr, unsigned target) {
  __syncthreads();
  if (threadIdx.x == 0) {
    __builtin_amdgcn_fence(__ATOMIC_RELEASE, "agent");
    asm volatile("s_waitcnt vmcnt(0)" ::: "memory");
    __hip_atomic_fetch_add(ctr, 1u, __ATOMIC_RELAXED, __HIP_MEMORY_SCOPE_AGENT);
    while (__hip_atomic_load(ctr, __ATOMIC_RELAXED, __HIP_MEMORY_SCOPE_AGENT) < target) __builtin_amdgcn_s_sleep(1);
    __builtin_amdgcn_fence(__ATOMIC_ACQUIRE, "agent");
    asm volatile("s_waitcnt vmcnt(0)" ::: "memory");
  }
  __syncthreads();
}

struct MKParams {
  const float *x, *mem, *g_mix, *w_in, *w_up, *b_alpha, *g_gla, *w_out, *g_mq, *g_mkv, *w_mq, *w_mkv, *w_mo, *g_ffn, *w_pq,
      *subk, *pu, *pv, *g_fin;
  float* out;
  char* ws;
};
extern __shared__ __attribute__((aligned(16))) char smem[];

template <typename ColFn>
DI void prep_w(bf8* dst, const float* __restrict__ W, int ldw, int ntiles, const float* __restrict__ gain, ColFn colfn,
               int gtid, int gthreads) {
  const int total = ntiles * 4096;
  for (int u = gtid; u < total; u += gthreads) {
    const int lane = u & 63, ks = (u >> 6) & 63, nt = u >> 12;
    const int r = lane & 31, h = lane >> 5;
    float sc = 1.f;
    const int col = colfn(32 * nt + r, sc);
    f8v v;
#pragma unroll
    for (int j = 0; j < 8; ++j) {
      const int k = 16 * ks + 8 * h + j;
      float val = 0.f;
      if (col >= 0) val = W[(size_t)k * ldw + col] * sc * (gain ? gain[k] : 1.f);
      v[j] = val;
    }
    const int didx = (nt < (ntiles & ~15)) ? ((((nt >> 4) * 64 + ks) * 16 + (nt & 15)) * 64 + lane) : u;
    dst[didx] = cvt8(v);
  }
}

DI void phase_prep(const MKParams& p, int gtid, int gthreads) {
  char* ws = p.ws;
  prep_w((bf8*)(ws + OFF_WIN), p.w_in, INC, 97, p.g_mix,
         [](int n, float& sc) -> int {
           if (n < 256) { sc = 0.125f; return n; }
           if (n < 1536) return n;
           if (n < 2048) { sc = 0.125f; return n + 16; }
           if (n < 3072) return n + 16;
           if (n < 3088) return n - 1536;
           return -1;
         }, gtid, gthreads);
  prep_w((bf8*)(ws + OFF_WOUT), p.w_out, 1024, 32, nullptr, [](int n, float& sc) -> int { return n; }, gtid, gthreads);
  prep_w((bf8*)(ws + OFF_WMQ), p.w_mq, 1024, 32, p.g_mq, [](int n, float& sc) -> int { sc = 0.0625f; return n; }, gtid, gthreads);
  prep_w((bf8*)(ws + OFF_WMKV), p.w_mkv, 2048, 64, p.g_mkv, [](int n, float& sc) -> int { return n; }, gtid, gthreads);
  prep_w((bf8*)(ws + OFF_WMO), p.w_mo, 1024, 32, nullptr, [](int n, float& sc) -> int { return n; }, gtid, gthreads);
  prep_w((bf8*)(ws + OFF_WPQ), p.w_pq, 2048, 64, p.g_ffn, [](int n, float& sc) -> int { return n; }, gtid, gthreads);
  {
    bf8* dst = (bf8*)(ws + OFF_SUBK);
    const int total = 16 * 4 * 8 * 64;
    for (int u = gtid; u < total; u += gthreads) {
      const int lane = u & 63, ks = (u >> 6) & 7, mt = (u >> 9) & 3, hp = u >> 11;
      const int r = lane & 31, h = lane >> 5;
      const float* s = p.subk + ((size_t)(hp * 128 + 32 * mt + r)) * 128 + 16 * ks + 8 * h;
      const f4v a = *(const f4v*)s, b = *(const f4v*)(s + 4);
      f8v v = {a[0], a[1], a[2], a[3], b[0], b[1], b[2], b[3]};
      dst[u] = cvt8(v);
    }
  }
}

DI void phase_prep_tables(const MKParams& p, int gwave, int nwaves, int lane) {
  for (int row = gwave; row < 32768; row += nwaves) {
    const int e = row & 16383;
    const bool isv = row >= 16384;
    const float* src = (isv ? p.pv : p.pu) + (size_t)e * DM + 16 * lane;
    f4v v[4];
#pragma unroll
    for (int q = 0; q < 4; ++q) v[q] = *(const f4v*)(src + 4 * q);
    if (!isv) {
#pragma unroll
      for (int q = 0; q < 4; ++q) v[q] = v[q] * *(const f4v*)(p.g_ffn + 16 * lane + 4 * q);
    }
    float am = 0.f;
#pragma unroll
    for (int q = 0; q < 4; ++q)
#pragma unroll
      for (int j = 0; j < 4; ++j) am = fmaxf(am, fabsf(v[q][j]));
#pragma unroll
    for (int o = 32; o > 0; o >>= 1) am = fmaxf(am, __shfl_xor(am, o));
    int k = 0;
    if (am > 0.f) k = 7 - ilogbf(am);
    k = max(-100, min(100, k));
    const float sc = ldexpf(1.0f, k);
    unsigned w[4];
#pragma unroll
    for (int q = 0; q < 4; ++q) {
      int pk = 0;
      pk = __builtin_amdgcn_cvt_pk_fp8_f32(v[q][0] * sc, v[q][1] * sc, pk, false);
      pk = __builtin_amdgcn_cvt_pk_fp8_f32(v[q][2] * sc, v[q][3] * sc, pk, true);
      w[q] = (unsigned)pk;
    }
    *(uint4*)(p.ws + (isv ? OFF_PV : OFF_PU) + (size_t)e * 1024 + 16 * lane) = make_uint4(w[0], w[1], w[2], w[3]);
    if (lane == 0) ((float*)(p.ws + (isv ? OFF_SV : OFF_SU)))[e] = ldexpf(1.0f, -k);
  }
}

DI void load_norm_tile(const float* __restrict__ src, char* ldsA, int wave, int lane) {
#pragma unroll 2
  for (int i = 0; i < 8; ++i) {
    const int row = 8 * wave + i;
    const f4v* pr = (const f4v*)(src + (size_t)row * DM);
    f4v v[4];
#pragma unroll
    for (int c = 0; c < 4; ++c) v[c] = pr[lane + 64 * c];
    float ss = 0.f;
#pragma unroll
    for (int c = 0; c < 4; ++c) ss += v[c][0] * v[c][0] + v[c][1] * v[c][1] + v[c][2] * v[c][2] + v[c][3] * v[c][3];
#pragma unroll
    for (int o = 32; o > 0; o >>= 1) ss += __shfl_xor(ss, o);
    const float rs = rsqrtf(ss * (1.0f / DM) + EPSV);
#pragma unroll
    for (int c = 0; c < 4; ++c) {
      f4v t = v[c] * rs;
      *(bf4*)(ldsA + row * LDS_ROW + (lane * 4 + 256 * c) * 2) = cvt4(t);
    }
  }
}

#ifndef GEMM_D
#define GEMM_D 6
#endif
template <bool SWAP>
DI void gemm_step(f16v (&acc)[2][2], const bf8& a0, const bf8& a1, const bf8& x0, const bf8& x1) {
  if (SWAP) {
    acc[0][0] = MFMA(a0, x0, acc[0][0]); acc[0][1] = MFMA(a0, x1, acc[0][1]);
    acc[1][0] = MFMA(a1, x0, acc[1][0]); acc[1][1] = MFMA(a1, x1, acc[1][1]);
  } else {
    acc[0][0] = MFMA(x0, a0, acc[0][0]); acc[0][1] = MFMA(x1, a0, acc[0][1]);
    acc[1][0] = MFMA(x0, a1, acc[1][0]); acc[1][1] = MFMA(x1, a1, acc[1][1]);
  }
}
template <bool SWAP, bool RES = false>
DI void gemm_chunk(const char* ldsA, const bf8* __restrict__ wf, int lane, f16v (&acc)[2][2], const float* res = nullptr) {
  __builtin_amdgcn_sched_barrier(0);
  const int r = lane & 31, h = lane >> 5;
  const char* xa0 = ldsA + r * LDS_ROW + h * 16;
  const char* xa1 = xa0 + 32 * LDS_ROW;
  const bf8* w0p = wf + lane;
  const bf8* w1p = wf + 64 + lane;
  bf8 w0[GEMM_D], w1[GEMM_D];
#pragma unroll
  for (int i = 0; i < GEMM_D; ++i) { w0[i] = w0p[i * 1024]; w1[i] = w1p[i * 1024]; }
  if (RES) {
#pragma unroll
    for (int ntl = 0; ntl < 2; ++ntl)
#pragma unroll
      for (int tt = 0; tt < 2; ++tt)
#pragma unroll
        for (int g = 0; g < 4; ++g) {
          const f4v x = *(const f4v*)(res + (size_t)(32 * tt + r) * DM + 32 * ntl + 8 * g + 4 * h);
          acc[ntl][tt][4 * g] = x[0]; acc[ntl][tt][4 * g + 1] = x[1]; acc[ntl][tt][4 * g + 2] = x[2]; acc[ntl][tt][4 * g + 3] = x[3];
        }
  } else {
    acc[0][0] = zero16(); acc[0][1] = zero16(); acc[1][0] = zero16(); acc[1][1] = zero16();
  }
  bf8 x0 = *(const bf8*)(xa0), x1 = *(const bf8*)(xa1);
  constexpr int KMAIN = ((64 - 2 * GEMM_D) / GEMM_D + 1) * GEMM_D;
#pragma unroll 1
  for (int ks0 = 0; ks0 < KMAIN; ks0 += GEMM_D) {
#pragma unroll
    for (int i = 0; i < GEMM_D; ++i) {
      const int ks = ks0 + i;
      const bf8 xn0 = *(const bf8*)(xa0 + (ks + 1) * 32);
      const bf8 xn1 = *(const bf8*)(xa1 + (ks + 1) * 32);
      gemm_step<SWAP>(acc, w0[i], w1[i], x0, x1);
      w0[i] = w0p[(ks + GEMM_D) * 1024];
      w1[i] = w1p[(ks + GEMM_D) * 1024];
      x0 = xn0; x1 = xn1;
      __builtin_amdgcn_sched_group_barrier(0x100, 2, 0);
      __builtin_amdgcn_sched_group_barrier(0x008, 2, 0);
      __builtin_amdgcn_sched_group_barrier(0x020, 2, 0);
      __builtin_amdgcn_sched_group_barrier(0x008, 2, 0);
    }
  }
#pragma unroll
  for (int t = 0; t < 64 - KMAIN; ++t) {
    const int ks = KMAIN + t, i = t % GEMM_D;
    const bf8 xn0 = *(const bf8*)(xa0 + (ks + 1) * 32);
    const bf8 xn1 = *(const bf8*)(xa1 + (ks + 1) * 32);
    gemm_step<SWAP>(acc, w0[i], w1[i], x0, x1);
    if (ks + GEMM_D < 64) {
      w0[i] = w0p[(ks + GEMM_D) * 1024];
      w1[i] = w1p[(ks + GEMM_D) * 1024];
    }
    x0 = xn0; x1 = xn1;
    __builtin_amdgcn_sched_group_barrier(0x100, 2, 0);
    __builtin_amdgcn_sched_group_barrier(0x008, 2, 0);
    if (ks + GEMM_D < 64) __builtin_amdgcn_sched_group_barrier(0x020, 2, 0);
    __builtin_amdgcn_sched_group_barrier(0x008, 2, 0);
  }
}

DI void store_swap_bf16(u16* dst, size_t ld, const f16v (&acc)[2][2], int lane) {
  const int r = lane & 31, h = lane >> 5;
#pragma unroll
  for (int ntl = 0; ntl < 2; ++ntl)
#pragma unroll
    for (int tt = 0; tt < 2; ++tt)
#pragma unroll
      for (int g = 0; g < 4; ++g) {
        f4v v = {acc[ntl][tt][4 * g], acc[ntl][tt][4 * g + 1], acc[ntl][tt][4 * g + 2], acc[ntl][tt][4 * g + 3]};
        *(bf4*)(dst + (size_t)(32 * tt + r) * ld + 32 * ntl + 8 * g + 4 * h) = cvt4(v);
      }
}
DI void store_vt_bf16(u16* dst, size_t ld, const f16v (&acc)[2][2], int lane) {
  const int r = lane & 31, h = lane >> 5;
#pragma unroll
  for (int ntl = 0; ntl < 2; ++ntl)
#pragma unroll
    for (int tt = 0; tt < 2; ++tt)
#pragma unroll
      for (int s = 0; s < 2; ++s) {
        f8v v;
#pragma unroll
        for (int j = 0; j < 8; ++j) v[j] = acc[ntl][tt][8 * s + j];
        *(bf8*)(dst + (size_t)(32 * ntl + r) * ld + 32 * tt + 16 * s + 8 * h) = cvt8(v);
      }
}

DI float log_sigmoid_acc(float x) { return fminf(x, 0.f) - log1pf(expf(-fabsf(x))); }

DI void phase_a_tile(const MKParams& p, int tile, int wave, int lane) {
  asm volatile("" : "+v"(lane));
  char* ws = p.ws;
  char* ldsA = smem;
  float* alr_s = (float*)(smem + LDS_A_BYTES);
  const int b = tile >> 5, c = tile & 31;
  const size_t tok0 = (size_t)tile * 64;
  __syncthreads();
  load_norm_tile(p.x + tok0 * DM, ldsA, wave, lane);
#if PROBE == 10
  __syncthreads();
  load_norm_tile(p.x + tok0 * DM, ldsA, wave, lane);
#endif
  __syncthreads();
  const bf8* wf = (const bf8*)(ws + OFF_WIN);
  f16v acc[2][2];
  const int t0 = c * 64;
  gemm_chunk<true>(ldsA, wf + (size_t)0 * 65536 + 2 * wave * 64, lane, acc);
  {
    u16* base = (u16*)(ws + (wave < 4 ? OFF_GQ : OFF_GK)) + ((size_t)(b * 4 + (wave & 3)) * SEQ + t0) * 64;
    store_swap_bf16(base, 64, acc, lane);
#if PROBE == 11
    store_swap_bf16(base, 64, acc, lane);
#endif
  }
  gemm_chunk<false>(ldsA, wf + (size_t)1 * 65536 + 2 * wave * 64, lane, acc);
  {
    u16* base = (u16*)(ws + OFF_GVT) + ((size_t)(b * 4 + (wave >> 1)) * 128 + 64 * (wave & 1)) * SEQ + t0;
    store_vt_bf16(base, SEQ, acc, lane);
#if PROBE == 11
    store_vt_bf16(base, SEQ, acc, lane);
#endif
  }
  gemm_chunk<true>(ldsA, wf + (size_t)2 * 65536 + 2 * wave * 64, lane, acc);
  store_swap_bf16((u16*)(ws + OFF_OG) + tok0 * 512 + 64 * wave, 512, acc, lane);
#if PROBE == 11
  store_swap_bf16((u16*)(ws + OFF_OG) + tok0 * 512 + 64 * wave, 512, acc, lane);
#endif
  gemm_chunk<true>(ldsA, wf + (size_t)3 * 65536 + 2 * wave * 64, lane, acc);
  store_swap_bf16((u16*)(ws + OFF_SQ) + ((size_t)(b * 8 + wave) * SEQ + t0) * 64, 64, acc, lane);
#if PROBE == 11
  store_swap_bf16((u16*)(ws + OFF_SQ) + ((size_t)(b * 8 + wave) * SEQ + t0) * 64, 64, acc, lane);
#endif
  gemm_chunk<true>(ldsA, wf + (size_t)4 * 65536 + 2 * wave * 64, lane, acc);
  store_swap_bf16((u16*)(ws + OFF_SK) + ((size_t)(b * 8 + wave) * SEQ + t0) * 64, 64, acc, lane);
#if PROBE == 11
  store_swap_bf16((u16*)(ws + OFF_SK) + ((size_t)(b * 8 + wave) * SEQ + t0) * 64, 64, acc, lane);
#endif
  gemm_chunk<false>(ldsA, wf + (size_t)5 * 65536 + 2 * wave * 64, lane, acc);
  store_vt_bf16((u16*)(ws + OFF_SVT) + ((size_t)(b * 8 + wave) * 64) * SEQ + t0, SEQ, acc, lane);
#if PROBE == 11
  store_vt_bf16((u16*)(ws + OFF_SVT) + ((size_t)(b * 8 + wave) * 64) * SEQ + t0, SEQ, acc, lane);
#endif
#if PROBE == 12
  for (int rep_ = 0; rep_ < 2; ++rep_) {
  __syncthreads();
#else
  {
#endif
    float* part = (float*)(smem + LDS_A_BYTES);
    const int r = lane & 31, h = lane >> 5;
    const bf8* wp = wf + (size_t)96 * 4096 + lane;
    bf8 wfr[8];
#pragma unroll
    for (int i = 0; i < 8; ++i) wfr[i] = wp[(8 * wave + i) * 64];
    const char* xa0 = ldsA + r * LDS_ROW + h * 16 + wave * 256;
    const char* xa1 = xa0 + 32 * LDS_ROW;
    f16v a0 = zero16(), a1 = zero16();
#pragma unroll
    for (int i = 0; i < 8; ++i) {
      a0 = MFMA(wfr[i], *(const bf8*)(xa0 + i * 32), a0);
      a1 = MFMA(wfr[i], *(const bf8*)(xa1 + i * 32), a1);
    }
    float* pw = part + (wave & 3) * 1024;
    if (wave < 4) {
#pragma unroll
      for (int i = 0; i < 8; ++i) { pw[r * 16 + crow(i, h)] = a0[i]; pw[(32 + r) * 16 + crow(i, h)] = a1[i]; }
    }
    __syncthreads();
    if (wave >= 4) {
#pragma unroll
      for (int i = 0; i < 8; ++i) { pw[r * 16 + crow(i, h)] += a0[i]; pw[(32 + r) * 16 + crow(i, h)] += a1[i]; }
    }
    __syncthreads();
    const int tid = wave * 64 + lane;
    {
      const f4v* p4 = (const f4v*)part;
      if (tid < 256) { f4v s = p4[tid] + p4[256 + tid] + p4[512 + tid] + p4[768 + tid]; ((f4v*)part)[tid] = s; }
    }
    __syncthreads();
    const int col = tid & 255, tg = tid >> 8;
    float wu[16];
#pragma unroll
    for (int rr = 0; rr < 16; ++rr) wu[rr] = p.w_up[rr * 256 + col];
    const float bb = p.b_alpha[col];
    float* dst = (float*)(ws + OFF_LA) + (tok0 + 32 * tg) * 256 + col;
#pragma unroll 4
    for (int t = 0; t < 32; ++t) {
      const f4v* ar = (const f4v*)(part + (32 * tg + t) * 16);
      const f4v q0 = ar[0], q1 = ar[1], q2 = ar[2], q3 = ar[3];
      float s = bb;
      s = fmaf(q0[0], wu[0], s); s = fmaf(q0[1], wu[1], s); s = fmaf(q0[2], wu[2], s); s = fmaf(q0[3], wu[3], s);
      s = fmaf(q1[0], wu[4], s); s = fmaf(q1[1], wu[5], s); s = fmaf(q1[2], wu[6], s); s = fmaf(q1[3], wu[7], s);
      s = fmaf(q2[0], wu[8], s); s = fmaf(q2[1], wu[9], s); s = fmaf(q2[2], wu[10], s); s = fmaf(q2[3], wu[11], s);
      s = fmaf(q3[0], wu[12], s); s = fmaf(q3[1], wu[13], s); s = fmaf(q3[2], wu[14], s); s = fmaf(q3[3], wu[15], s);
      const float ls = fminf(s, 0.f) - __logf(1.0f + __expf(-fabsf(s)));
      dst[(size_t)t * 256] = ls * (1.0f / 16.0f);
    }
  }
}

DI void phase_a_memkv(const MKParams& p, int item, int wave, int lane) {
  asm volatile("" : "+v"(lane));
  char* ws = p.ws;
  char* ldsA = smem;
  const int rt = item >> 2, cc = item & 3;
  const int b = rt >> 2, m0 = (rt & 3) * 64;
  __syncthreads();
  load_norm_tile(p.mem + (size_t)rt * 64 * DM, ldsA, wave, lane);
  __syncthreads();
  const bf8* wf = (const bf8*)(ws + OFF_WMKV);
  f16v acc[2][2];
  if (cc < 2) {
    gemm_chunk<true>(ldsA, wf + (size_t)cc * 65536 + 2 * wave * 64, lane, acc);
    const int f0 = 512 * cc + 64 * wave;
    u16* base = (u16*)(ws + OFF_KM) + ((size_t)(b * 4 + (f0 >> 8)) * 256 + m0) * 256 + (f0 & 255);
    store_swap_bf16(base, 256, acc, lane);
  } else {
    gemm_chunk<false>(ldsA, wf + (size_t)cc * 65536 + 2 * wave * 64, lane, acc);
    const int f0 = 512 * (cc - 2) + 64 * wave;
    u16* base = (u16*)(ws + OFF_VMT) + ((size_t)(b * 4 + (f0 >> 8)) * 256 + (f0 & 255)) * 256 + m0;
    store_vt_bf16(base, 256, acc, lane);
  }
}
#define SB_THR 30.0f

DI bf8 pack8(const f16v& x, int s) {
  f8v v;
#pragma unroll
  for (int j = 0; j < 8; ++j) v[j] = x[8 * s + j];
  return cvt8(v);
}

DI void sb_item(const MKParams& p, int item, int lane) {
  asm volatile("" : "+v"(lane));
  char* ws = p.ws;
  const int r = lane & 31, h = lane >> 5;
  const int bh = item >> 6, qt = item & 63;
  const u16* SQ = (const u16*)(ws + OFF_SQ) + (size_t)bh * SEQ * 64;
  const u16* SK = (const u16*)(ws + OFF_SK) + (size_t)bh * SEQ * 64;
  const u16* SVT = (const u16*)(ws + OFF_SVT) + (size_t)bh * 64 * SEQ;
  bf8 qf[4];
#pragma unroll
  for (int ks = 0; ks < 4; ++ks) qf[ks] = *(const bf8*)(SQ + (size_t)(32 * qt + r) * 64 + 16 * ks + 8 * h);
  bf8 tri[2];
#pragma unroll
  for (int s = 0; s < 2; ++s) {
    f8v t;
#pragma unroll
    for (int j = 0; j < 8; ++j) t[j] = (16 * s + 8 * (j >> 2) + 4 * h + (j & 3) >= r) ? 1.0f : 0.0f;
    tri[s] = cvt8(t);
  }
  f16v o0 = zero16(), o1 = zero16();
  float R = 0.f;
  for (int kt = qt; kt >= 0; --kt) {
    bf8 kf[4], vf[2][2];
#pragma unroll
    for (int ks = 0; ks < 4; ++ks) kf[ks] = *(const bf8*)(SK + (size_t)(32 * kt + r) * 64 + 16 * ks + 8 * h);
#pragma unroll
    for (int mt = 0; mt < 2; ++mt)
#pragma unroll
      for (int s = 0; s < 2; ++s) vf[mt][s] = *(const bf8*)(SVT + (size_t)(32 * mt + r) * SEQ + 32 * kt + 16 * s + 8 * h);
    f16v z = zero16();
#pragma unroll
    for (int ks = 0; ks < 4; ++ks) z = MFMA(kf[ks], qf[ks], z);
    const bool diag = (kt == qt);
    f16v sp;
    float tot = 0.f;
#pragma unroll
    for (int i = 0; i < 16; ++i) {
      const float zz = z[i];
      const float sv = fmaxf(zz, 0.f) + __logf(1.0f + __expf(-fabsf(zz)));
      const bool valid = !diag || (crow(i, h) < r);
      sp[i] = valid ? sv : 0.f;
      tot += sp[i];
    }
    tot += __shfl_xor(tot, 32);
    f16v C = MFMA(tri[0], pack8(sp, 0), zero16());
    C = MFMA(tri[1], pack8(sp, 1), C);
    f16v a;
#pragma unroll
    for (int i = 0; i < 16; ++i) {
      const bool valid = !diag || (crow(i, h) < r);
      a[i] = valid ? __expf(z[i] - C[i] - R) : 0.f;
    }
    const bf8 a0 = pack8(a, 0), a1 = pack8(a, 1);
    o0 = MFMA(vf[0][0], a0, o0); o0 = MFMA(vf[0][1], a1, o0);
    o1 = MFMA(vf[1][0], a0, o1); o1 = MFMA(vf[1][1], a1, o1);
    R += tot;
    if (__all(R > SB_THR)) break;
  }
  const int b = bh >> 3, hd = bh & 7;
  u16* dst = (u16*)(ws + OFF_OSB) + ((size_t)b * SEQ + 32 * qt + r) * 512 + hd * 64 + 4 * h;
#pragma unroll
  for (int g = 0; g < 4; ++g) {
    f4v v0 = {o0[4 * g], o0[4 * g + 1], o0[4 * g + 2], o0[4 * g + 3]};
    f4v v1 = {o1[4 * g], o1[4 * g + 1], o1[4 * g + 2], o1[4 * g + 3]};
    *(bf4*)(dst + 8 * g) = cvt4(v0);
    *(bf4*)(dst + 32 + 8 * g) = cvt4(v1);
  }
}

DI void gla_g1_item(const MKParams& p, int item, int wave, int lane) {
  asm volatile("" : "+v"(lane));
  char* ws = p.ws;
  const int r = lane & 31, h = lane >> 5;
  const int bh = item >> 5, c = item & 31, b = bh >> 2, hd = bh & 3;
  char* kl = smem + wave * 9216;
  u16* GQ = (u16*)(ws + OFF_GQ) + ((size_t)bh * SEQ + 64 * c) * 64;
  u16* GK = (u16*)(ws + OFF_GK) + ((size_t)bh * SEQ + 64 * c) * 64;
  const float* LA = (const float*)(ws + OFF_LA) + ((size_t)b * SEQ + 64 * c) * 256 + hd * 64;
  float bc = 0.f;
#pragma unroll 1
  for (int g = 0; g < 4; ++g) {
    float la_[16];
    u16 q_[16], k_[16];
#pragma unroll
    for (int i = 0; i < 16; ++i) {
      const int t = 16 * g + i;
      la_[i] = LA[(size_t)t * 256 + lane];
      q_[i] = GQ[t * 64 + lane];
      k_[i] = GK[t * 64 + lane];
    }
#pragma unroll
    for (int i = 0; i < 16; ++i) {
      const int t = 16 * g + i;
      bc += la_[i];
      const float eq = __expf(bc);
      const float qn = bf2f(q_[i]) * eq, kn = bf2f(k_[i]) / eq;
      const bf2 pk = __builtin_convertvector((f2v){qn, kn}, bf2);
      const unsigned u = __builtin_bit_cast(unsigned, pk);
      GQ[t * 64 + lane] = (u16)(u & 0xffff);
      GK[t * 64 + lane] = (u16)(u >> 16);
      *(u16*)(kl + lane * 144 + tpos(t) * 2) = (u16)(u >> 16);
    }
  }
  ((float*)(ws + OFF_DD))[(size_t)item * 64 + lane] = __expf(bc);
  asm volatile("s_waitcnt lgkmcnt(0)" ::: "memory");
  const u16* GVT = (const u16*)(ws + OFF_GVT) + (size_t)bh * 128 * SEQ + 64 * c;
  float* LKV = (float*)(ws + OFF_LKV) + (size_t)item * 128 * 64;
  bf8 kb[2][4];
#pragma unroll
  for (int nt = 0; nt < 2; ++nt)
#pragma unroll
    for (int s = 0; s < 4; ++s) kb[nt][s] = *(const bf8*)(kl + (32 * nt + r) * 144 + (16 * s + 8 * h) * 2);
#pragma unroll 1
  for (int mt = 0; mt < 4; ++mt) {
    f16v a0 = zero16(), a1 = zero16();
#pragma unroll
    for (int s = 0; s < 4; ++s) {
      const bf8 vf = *(const bf8*)(GVT + (size_t)(32 * mt + r) * SEQ + 16 * s + 8 * h);
      a0 = MFMA(vf, kb[0][s], a0);
      a1 = MFMA(vf, kb[1][s], a1);
    }
#pragma unroll
    for (int i = 0; i < 16; ++i) {
      LKV[(32 * mt + crow(i, h)) * 64 + r] = a0[i];
      LKV[(32 * mt + crow(i, h)) * 64 + 32 + r] = a1[i];
    }
  }
  asm volatile("s_waitcnt lgkmcnt(0)" ::: "memory");
}

DI void gla_g2(const MKParams& p, int gtid, int gthreads) {
  char* ws = p.ws;
  for (int u = gtid; u < 32768; u += gthreads) {
    const int oct = u & 7, dv = (u >> 3) & 127, bh = u >> 10;
    f8v S = {0.f, 0.f, 0.f, 0.f, 0.f, 0.f, 0.f, 0.f};
#pragma unroll 4
    for (int c = 0; c < 32; ++c) {
      const size_t item = (size_t)bh * 32 + c;
      *(bf8*)((u16*)(ws + OFF_SS) + (item * 128 + dv) * 64 + oct * 8) = cvt8(S);
      const f8v l = *(const f8v*)((const float*)(ws + OFF_LKV) + (item * 128 + dv) * 64 + oct * 8);
      const f8v d = *(const f8v*)((const float*)(ws + OFF_DD) + item * 64 + oct * 8);
      S = d * (S + l);
    }
  }
}

DI void gla_g3_tile(const MKParams& p, int tile, int wave, int lane, char* dst, int dst_ld) {
  char* ws = p.ws;
  const int r = lane & 31, h = lane >> 5;
  const int b = tile >> 5, c = tile & 31, hd = wave >> 1, tt = wave & 1, bh = b * 4 + hd;
  const u16* GQ = (const u16*)(ws + OFF_GQ) + ((size_t)bh * SEQ + 64 * c) * 64;
  const u16* GK = (const u16*)(ws + OFF_GK) + ((size_t)bh * SEQ + 64 * c) * 64;
  const u16* GVT = (const u16*)(ws + OFF_GVT) + (size_t)bh * 128 * SEQ + 64 * c;
  const u16* SS = (const u16*)(ws + OFF_SS) + ((size_t)(bh * 32 + c) * 128) * 64;
  bf8 qf[4];
#pragma unroll
  for (int ks = 0; ks < 4; ++ks) qf[ks] = *(const bf8*)(GQ + (32 * tt + r) * 64 + 16 * ks + 8 * h);
  bf8 pf[2][2];
#pragma unroll
  for (int kt = 0; kt < 2; ++kt) {
    if (kt <= tt) {
      f16v pt = zero16();
#pragma unroll
      for (int ks = 0; ks < 4; ++ks) {
        const bf8 kf = *(const bf8*)(GK + (32 * kt + r) * 64 + 16 * ks + 8 * h);
        pt = MFMA(kf, qf[ks], pt);
      }
      if (kt == tt) {
#pragma unroll
        for (int i = 0; i < 16; ++i) pt[i] = (crow(i, h) <= r) ? pt[i] : 0.f;
      }
      pf[kt][0] = pack8(pt, 0);
      pf[kt][1] = pack8(pt, 1);
    }
  }
  f16v o[4];
#pragma unroll
  for (int mt = 0; mt < 4; ++mt) {
    o[mt] = zero16();
#pragma unroll
    for (int ks = 0; ks < 4; ++ks) {
      const bf8 sf = *(const bf8*)(SS + (32 * mt + r) * 64 + 16 * ks + 8 * h);
      o[mt] = MFMA(sf, qf[ks], o[mt]);
    }
#pragma unroll
    for (int kt = 0; kt < 2; ++kt) {
      if (kt <= tt) {
#pragma unroll
        for (int s = 0; s < 2; ++s) {
          const bf8 vf = *(const bf8*)(GVT + (size_t)(32 * mt + r) * SEQ + 32 * kt + 16 * s + 8 * h);
          o[mt] = MFMA(vf, pf[kt][s], o[mt]);
        }
      }
    }
  }
  float ss = 0.f;
#pragma unroll
  for (int mt = 0; mt < 4; ++mt)
#pragma unroll
    for (int i = 0; i < 16; ++i) ss += o[mt][i] * o[mt][i];
  ss += __shfl_xor(ss, 32);
  const float rr = rsqrtf(ss * (1.0f / 128.0f) + EPSV);
  const size_t tok = (size_t)tile * 64 + 32 * tt + r;
  const u16* OG = (const u16*)(ws + OFF_OG) + tok * 512 + hd * 128;
#pragma unroll
  for (int mt = 0; mt < 4; ++mt)
#pragma unroll
    for (int g = 0; g < 4; ++g) {
      const int dv0 = 32 * mt + 8 * g + 4 * h;
      const ushort4 og4 = *(const ushort4*)(OG + dv0);
      const f4v gg = *(const f4v*)(p.g_gla + dv0);
      const float og[4] = {bf2f(og4.x), bf2f(og4.y), bf2f(og4.z), bf2f(og4.w)};
      f4v v;
#pragma unroll
      for (int j = 0; j < 4; ++j) v[j] = o[mt][4 * g + j] * rr * gg[j] * (og[j] / (1.0f + __expf(-og[j])));
      *(bf4*)(dst + (size_t)(32 * tt + r) * dst_ld + (hd * 128 + dv0) * 2) = cvt4(v);
    }
}
DI void gemm_1024(const char* ldsA, const bf8* __restrict__ wf, int wave, int lane, f16v (&a0)[2][2], f16v (&a1)[2][2]) {
  gemm_chunk<true>(ldsA, wf + 2 * wave * 64, lane, a0);
  gemm_chunk<true>(ldsA, wf + 65536 + 2 * wave * 64, lane, a1);
}
DI void gemm_1024_res(const char* ldsA, const bf8* __restrict__ wf, int wave, int lane, f16v (&a0)[2][2], f16v (&a1)[2][2],
                      const float* res) {
  gemm_chunk<true, true>(ldsA, wf + 2 * wave * 64, lane, a0, res + 64 * wave);
  gemm_chunk<true, true>(ldsA, wf + 65536 + 2 * wave * 64, lane, a1, res + 512 + 64 * wave);
}

DI void store_f32_ssq(const f16v (&a)[2][2], float* dst, int f0, int lane, float (&ssq)[2]) {
  const int r = lane & 31, h = lane >> 5;
#pragma unroll
  for (int ntl = 0; ntl < 2; ++ntl)
#pragma unroll
    for (int tt = 0; tt < 2; ++tt)
#pragma unroll
      for (int g = 0; g < 4; ++g) {
        f4v v = {a[ntl][tt][4 * g], a[ntl][tt][4 * g + 1], a[ntl][tt][4 * g + 2], a[ntl][tt][4 * g + 3]};
        ssq[tt] += v[0] * v[0] + v[1] * v[1] + v[2] * v[2] + v[3] * v[3];
        *(f4v*)(dst + (size_t)(32 * tt + r) * DM + f0 + 32 * ntl + 8 * g + 4 * h) = v;
      }
}

DI void acc_to_scratch(u16* scr, const f16v (&a)[2][2], int f0, int lane, float s0, float s1) {
  const int r = lane & 31, h = lane >> 5;
#pragma unroll
  for (int ntl = 0; ntl < 2; ++ntl)
#pragma unroll
    for (int tt = 0; tt < 2; ++tt)
#pragma unroll
      for (int g = 0; g < 4; ++g) {
        const float sc = tt ? s1 : s0;
        f4v v = {a[ntl][tt][4 * g] * sc, a[ntl][tt][4 * g + 1] * sc, a[ntl][tt][4 * g + 2] * sc, a[ntl][tt][4 * g + 3] * sc};
        *(bf4*)(scr + (size_t)(32 * tt + r) * 1024 + f0 + 32 * ntl + 8 * g + 4 * h) = cvt4(v);
      }
}
typedef __attribute__((ext_vector_type(4))) unsigned u4v;
DI void scratch_to_lds(const u16* scr, char* ldsA, int tid) {
  asm volatile("" : "+v"(tid));
  const unsigned toff = (unsigned)tid * 16u;
#pragma unroll
  for (int half = 0; half < 2; ++half) {
    u4v v[8];
#pragma unroll
    for (int it = 0; it < 8; ++it)
      v[it] = __builtin_nontemporal_load((const u4v*)((const char*)scr + (size_t)(8192 * (8 * half + it)) + toff));
#pragma unroll
    for (int it = 0; it < 8; ++it) {
      const int idx = tid + 512 * (8 * half + it), row = idx >> 7, ch = idx & 127;
      *(u4v*)(ldsA + row * LDS_ROW + ch * 16) = v[it];
    }
  }
}

struct Pk { bf4 v[2][2][4]; };
DI void pack_acc(Pk& pk, const f16v (&a)[2][2], float s0, float s1) {
#pragma unroll
  for (int ntl = 0; ntl < 2; ++ntl)
#pragma unroll
    for (int tt = 0; tt < 2; ++tt)
#pragma unroll
      for (int g = 0; g < 4; ++g) {
        const float sc = tt ? s1 : s0;
        f4v v = {a[ntl][tt][4 * g] * sc, a[ntl][tt][4 * g + 1] * sc, a[ntl][tt][4 * g + 2] * sc, a[ntl][tt][4 * g + 3] * sc};
        pk.v[ntl][tt][g] = cvt4(v);
      }
}
DI void pk_to_lds(char* ldsA, const Pk& pk, int f0, int lane) {
  const int r = lane & 31, h = lane >> 5;
#pragma unroll
  for (int ntl = 0; ntl < 2; ++ntl)
#pragma unroll
    for (int tt = 0; tt < 2; ++tt)
#pragma unroll
      for (int g = 0; g < 4; ++g)
        *(bf4*)(ldsA + (32 * tt + r) * LDS_ROW + (f0 + 32 * ntl + 8 * g + 4 * h) * 2) = pk.v[ntl][tt][g];
}

DI void rms_from_partials(float* red, int wave, int lane, const float (&ssq)[2], float& rs0, float& rs1) {
  red[(wave * 2 + 0) * 64 + lane] = ssq[0];
  red[(wave * 2 + 1) * 64 + lane] = ssq[1];
  __syncthreads();
  const int r = lane & 31;
  float t0 = 0.f, t1 = 0.f;
#pragma unroll
  for (int w = 0; w < 8; ++w) {
    t0 += red[(w * 2 + 0) * 64 + r] + red[(w * 2 + 0) * 64 + 32 + r];
    t1 += red[(w * 2 + 1) * 64 + r] + red[(w * 2 + 1) * 64 + 32 + r];
  }
  rs0 = rsqrtf(t0 * (1.0f / DM) + EPSV);
  rs1 = rsqrtf(t1 * (1.0f / DM) + EPSV);
}

template <bool WRITE = true>
DI void mem_attn(const MKParams& p, char* ldsA, int b, int wave, int lane) {
  char* ws = p.ws;
  const int r = lane & 31, h = lane >> 5;
  const int hm = wave >> 1, tt = wave & 1;
  const u16* KM = (const u16*)(ws + OFF_KM) + (size_t)(b * 4 + hm) * 256 * 256;
  const u16* VMT = (const u16*)(ws + OFF_VMT) + (size_t)(b * 4 + hm) * 256 * 256;
  char* qrow = ldsA + (32 * tt + r) * LDS_ROW + hm * 512;
  const unsigned loff = (unsigned)((r * 256 + 8 * h) * 2);
  f16v s[8];
#pragma unroll
  for (int mt = 0; mt < 8; ++mt) s[mt] = zero16();
#pragma unroll 2
  for (int ks = 0; ks < 16; ++ks) {
    const bf8 qf = *(const bf8*)(qrow + (16 * ks + 8 * h) * 2);
#pragma unroll
    for (int mt = 0; mt < 8; ++mt) {
      const bf8 kf = *(const bf8*)((const char*)KM + (size_t)((32 * mt * 256 + 16 * ks) * 2) + loff);
      s[mt] = MFMA(kf, qf, s[mt]);
    }
  }
  float mx = -INFINITY;
#pragma unroll
  for (int mt = 0; mt < 8; ++mt)
#pragma unroll
    for (int i = 0; i < 16; ++i) mx = fmaxf(mx, s[mt][i]);
  mx = fmaxf(mx, __shfl_xor(mx, 32));
  float l = 0.f;
  bf8 pf[8][2];
#pragma unroll
  for (int mt = 0; mt < 8; ++mt) {
#pragma unroll
    for (int i = 0; i < 16; ++i) { s[mt][i] = __expf(s[mt][i] - mx); l += s[mt][i]; }
    pf[mt][0] = pack8(s[mt], 0);
    pf[mt][1] = pack8(s[mt], 1);
  }
  l += __shfl_xor(l, 32);
  const float inv = 1.0f / l;
#pragma unroll
  for (int grp = 0; grp < 2; ++grp) {
    f16v o[4];
#pragma unroll
    for (int m4 = 0; m4 < 4; ++m4) o[m4] = zero16();
#pragma unroll
    for (int kt = 0; kt < 8; ++kt)
#pragma unroll
      for (int sx = 0; sx < 2; ++sx)
#pragma unroll
        for (int m4 = 0; m4 < 4; ++m4) {
          const bf8 vf = *(const bf8*)((const char*)VMT + (size_t)((32 * (4 * grp + m4) * 256 + 32 * kt + 16 * sx) * 2) + loff);
          o[m4] = MFMA(vf, pf[kt][sx], o[m4]);
        }
#pragma unroll
    for (int m4 = 0; m4 < 4; ++m4)
#pragma unroll
      for (int g = 0; g < 4; ++g) {
        f4v v = {o[m4][4 * g] * inv, o[m4][4 * g + 1] * inv, o[m4][4 * g + 2] * inv, o[m4][4 * g + 3] * inv};
        if (WRITE || v[0] == 123.456f) *(bf4*)(qrow + (32 * (4 * grp + m4) + 8 * g + 4 * h) * 2) = cvt4(v);
      }
  }
}

DI void phase_c_tile(const MKParams& p, int tile, int wave, int lane, float& rs0, float& rs1) {
  asm volatile("" : "+v"(lane));
  char* ws = p.ws;
  char* ldsA = smem;
  float* red = (float*)(smem + LDS_A_BYTES);
  const size_t tok0 = (size_t)tile * 64;
  const int tid = wave * 64 + lane;
  __syncthreads();
#if PROBE == 15
  gla_g3_tile(p, tile, wave, lane, ldsA, LDS_ROW);
  __builtin_amdgcn_sched_barrier(0);
  asm volatile("" : "+v"(lane));
#endif
  {
  gla_g3_tile(p, tile, wave, lane, ldsA, LDS_ROW);
  {
    const char* osb = ws + OFF_OSB + tok0 * 1024;
#pragma unroll
    for (int it = 0; it < 8; ++it) {
      const int idx = tid + 512 * it, row = idx >> 6, ch = idx & 63;
      *(uint4*)(ldsA + row * LDS_ROW + 1024 + ch * 16) = *(const uint4*)(osb + (size_t)row * 1024 + ch * 16);
    }
  }
  }
  __syncthreads();
  f16v acc[2][2];
  Pk pk0, pk1;
  float* hdst = p.out + tok0 * DM;
  {
    float ssq[2] = {0.f, 0.f};
    const bf8* wf = (const bf8*)(ws + OFF_WOUT);
    asm volatile("" : "+v"(lane));
    gemm_chunk<true, true>(ldsA, wf + 2 * wave * 64, lane, acc, p.x + tok0 * DM + 64 * wave);
    store_f32_ssq(acc, hdst, 64 * wave, lane, ssq);
    pack_acc(pk0, acc, 1.f, 1.f);
    asm volatile("" : "+v"(lane));
    gemm_chunk<true, true>(ldsA, wf + 65536 + 2 * wave * 64, lane, acc, p.x + tok0 * DM + 512 + 64 * wave);
    store_f32_ssq(acc, hdst, 512 + 64 * wave, lane, ssq);
    pack_acc(pk1, acc, 1.f, 1.f);
    rms_from_partials(red, wave, lane, ssq, rs0, rs1);
  }
  pk_to_lds(ldsA, pk0, 64 * wave, lane);
  pk_to_lds(ldsA, pk1, 512 + 64 * wave, lane);
  __syncthreads();
  {
    const bf8* wf = (const bf8*)(ws + OFF_WMQ);
    asm volatile("" : "+v"(lane));
    gemm_chunk<true>(ldsA, wf + 2 * wave * 64, lane, acc);
    pack_acc(pk0, acc, rs0, rs1);
    asm volatile("" : "+v"(lane));
    gemm_chunk<true>(ldsA, wf + 65536 + 2 * wave * 64, lane, acc);
    pack_acc(pk1, acc, rs0, rs1);
  }
  __syncthreads();
  pk_to_lds(ldsA, pk0, 64 * wave, lane);
  pk_to_lds(ldsA, pk1, 512 + 64 * wave, lane);
  __syncthreads();
#if PROBE == 22
  asm volatile("" : "+v"(lane));
  mem_attn<false>(p, ldsA, tile >> 5, wave, lane);
#endif
  asm volatile("" : "+v"(lane));
  mem_attn<true>(p, ldsA, tile >> 5, wave, lane);
  __syncthreads();
  {
    float ssq[2] = {0.f, 0.f};
    const bf8* wf = (const bf8*)(ws + OFF_WMO);
    asm volatile("" : "+v"(lane));
    gemm_chunk<true, true>(ldsA, wf + 2 * wave * 64, lane, acc, hdst + 64 * wave);
    store_f32_ssq(acc, hdst, 64 * wave, lane, ssq);
    pack_acc(pk0, acc, 1.f, 1.f);
    asm volatile("" : "+v"(lane));
    gemm_chunk<true, true>(ldsA, wf + 65536 + 2 * wave * 64, lane, acc, hdst + 512 + 64 * wave);
    store_f32_ssq(acc, hdst, 512 + 64 * wave, lane, ssq);
    pack_acc(pk1, acc, 1.f, 1.f);
    rms_from_partials(red, wave, lane, ssq, rs0, rs1);
  }
  pk_to_lds(ldsA, pk0, 64 * wave, lane);
  pk_to_lds(ldsA, pk1, 512 + 64 * wave, lane);
  __syncthreads();
}
#define OFF_EG (OFF_LKV + 16 * MiB)

DI unsigned f2ord(float v) { const unsigned u = __float_as_uint(v); return (u & 0x80000000u) ? ~u : (u | 0x80000000u); }
DI float ord2f(unsigned u) { return __uint_as_float((u & 0x80000000u) ? (u ^ 0x80000000u) : ~u); }

DI void ins16(unsigned (&L)[16], unsigned x) {
#pragma unroll
  for (int s = 0; s < 16; ++s) {
    const unsigned hi = max(L[s], x);
    x = min(L[s], x);
    L[s] = hi;
  }
}
DI void merge_halves16(unsigned (&L)[16]) {
  unsigned O[16];
#pragma unroll
  for (int s = 0; s < 16; ++s) O[s] = (unsigned)__shfl_xor((int)L[s], 32);
#pragma unroll
  for (int s = 0; s < 16; ++s) L[s] = max(L[s], O[15 - s]);
#pragma unroll
  for (int d = 8; d > 0; d >>= 1)
#pragma unroll
    for (int i = 0; i < 16; ++i)
      if ((i & d) == 0) {
        const unsigned hi = max(L[i], L[i + d]), lo = min(L[i], L[i + d]);
        L[i] = hi; L[i + d] = lo;
      }
}

DI void peer_top16(const char* ws, const u16* qp, int hp, int tt, int lane, unsigned (&L)[16]) {
  const int r = lane & 31, h = lane >> 5;
  const bf8* sk = (const bf8*)(ws + OFF_SUBK) + (size_t)hp * 4 * 8 * 64 + lane;
  f16v s[4];
#pragma unroll
  for (int mt = 0; mt < 4; ++mt) s[mt] = zero16();
#pragma unroll
  for (int ks = 0; ks < 8; ++ks) {
    const bf8 qf = *(const bf8*)(qp + (size_t)(32 * tt + r) * 2048 + hp * 128 + 16 * ks + 8 * h);
#pragma unroll
    for (int mt = 0; mt < 4; ++mt) s[mt] = MFMA(sk[(mt * 8 + ks) * 64], qf, s[mt]);
  }
#pragma unroll
  for (int i = 0; i < 16; ++i) L[i] = 0u;
#pragma unroll
  for (int mt = 0; mt < 4; ++mt)
#pragma unroll
    for (int i = 0; i < 16; ++i) {
      const unsigned key = (f2ord(s[mt][i]) & ~127u) | (unsigned)(127 - (32 * mt + crow(i, h)));
      ins16(L, key);
    }
  merge_halves16(L);
}

DI void peer_select(const char* ws, const u16* qp, uint2* eg, unsigned char* idxs  , int head,
                    int tt, int lane) {
  const int r = lane & 31, h = lane >> 5;
  unsigned La[16], Lb[16];
  peer_top16(ws, qp, 2 * head, tt, lane, La);
  __builtin_amdgcn_sched_barrier(0);
  peer_top16(ws, qp, 2 * head + 1, tt, lane, Lb);
  __builtin_amdgcn_sched_barrier(0);
  if (h == 0) {
#pragma unroll
    for (int g = 0; g < 4; ++g) {
      unsigned wa = 0, wb = 0;
#pragma unroll
      for (int j = 0; j < 4; ++j) {
        wa |= (127u - (La[4 * g + j] & 127u)) << (8 * j);
        wb |= (127u - (Lb[4 * g + j] & 127u)) << (8 * j);
      }
      *(unsigned*)(idxs + r * 32 + 4 * g) = wa;
      *(unsigned*)(idxs + r * 32 + 16 + 4 * g) = wb;
    }
  }
  float fa[16], fb[16];
#pragma unroll
  for (int i = 0; i < 16; ++i) { fa[i] = ord2f(La[i] & ~127u); fb[i] = ord2f(Lb[i] & ~127u); }
  unsigned C[16];
#pragma unroll
  for (int i = 0; i < 16; ++i) C[i] = 0u;
#define PEER_CAND(a, b) ins16(C, (f2ord(fa[a] + fb[b]) & ~255u) | (unsigned)(255 - ((a) * 16 + (b))));
#define PEER_ROW1(a) PEER_CAND(a, 0)
#define PEER_ROW2(a) PEER_ROW1(a) PEER_CAND(a, 1)
#define PEER_ROW3(a) PEER_ROW2(a) PEER_CAND(a, 2)
#define PEER_ROW4(a) PEER_ROW3(a) PEER_CAND(a, 3)
#define PEER_ROW5(a) PEER_ROW4(a) PEER_CAND(a, 4)
#define PEER_ROW8(a) PEER_ROW5(a) PEER_CAND(a, 5) PEER_CAND(a, 6) PEER_CAND(a, 7)
#define PEER_ROW16(a) PEER_ROW8(a) PEER_CAND(a, 8) PEER_CAND(a, 9) PEER_CAND(a, 10) PEER_CAND(a, 11) PEER_CAND(a, 12) PEER_CAND(a, 13) PEER_CAND(a, 14) PEER_CAND(a, 15)
  PEER_ROW16(0) PEER_ROW8(1) PEER_ROW5(2) PEER_ROW4(3) PEER_ROW3(4) PEER_ROW2(5) PEER_ROW2(6) PEER_ROW2(7)
  PEER_ROW1(8) PEER_ROW1(9) PEER_ROW1(10) PEER_ROW1(11) PEER_ROW1(12) PEER_ROW1(13) PEER_ROW1(14) PEER_ROW1(15)
  asm volatile("s_waitcnt lgkmcnt(0)" ::: "memory");
  const float vmax = ord2f(C[0] & ~255u);
  float ex[16], sum = 0.f;
#pragma unroll
  for (int i = 0; i < 16; ++i) { ex[i] = __expf(ord2f(C[i] & ~255u) - vmax); sum += ex[i]; }
  const float inv = 1.0f / sum;
  const unsigned hmask = 0u - (unsigned)h;
#pragma unroll
  for (int i = 0; i < 8; ++i) {
    const unsigned ck = C[i] ^ ((C[i] ^ C[8 + i]) & hmask);
    const unsigned gb = __float_as_uint(ex[i]) ^ ((__float_as_uint(ex[i]) ^ __float_as_uint(ex[8 + i])) & hmask);
    const float g = __uint_as_float(gb) * inv;
    const unsigned code = 255u - (ck & 255u);
    const unsigned ia = idxs[r * 32 + (code >> 4)], ib = idxs[r * 32 + 16 + (code & 15u)];
    eg[(size_t)(32 * tt + r) * 128 + head * 16 + 8 * h + i] = make_uint2(ia * 128u + ib, __float_as_uint(g));
  }
  asm volatile("s_waitcnt lgkmcnt(0)" ::: "memory");
}

DI float wave_sum(float v) {
#pragma unroll
  for (int o = 32; o > 0; o >>= 1) v += __shfl_xor(v, o);
  return v;
}

DI void reduce8(const float (&pv)[8], float& s0, float& s1) {
  float q[4], s[2];
#pragma unroll
  for (int m = 0; m < 4; ++m) {
    const auto r = __builtin_amdgcn_permlane32_swap(__float_as_uint(pv[m]), __float_as_uint(pv[m + 4]), false, false);
    q[m] = __uint_as_float(r[0]) + __uint_as_float(r[1]);
  }
#pragma unroll
  for (int m = 0; m < 2; ++m) {
    const auto r = __builtin_amdgcn_permlane16_swap(__float_as_uint(q[m]), __float_as_uint(q[m + 2]), false, false);
    s[m] = __uint_as_float(r[0]) + __uint_as_float(r[1]);
  }
#pragma unroll
  for (int m = 0; m < 2; ++m) {
    s[m] += __uint_as_float(__builtin_amdgcn_update_dpp(0, __float_as_uint(s[m]), 0x128, 0xf, 0xf, false));
    s[m] += __uint_as_float(__builtin_amdgcn_update_dpp(0, __float_as_uint(s[m]), 0x124, 0xf, 0xf, false));
    s[m] += __uint_as_float(__builtin_amdgcn_update_dpp(0, __float_as_uint(s[m]), 0x122, 0xf, 0xf, false));
    s[m] += __uint_as_float(__builtin_amdgcn_update_dpp(0, __float_as_uint(s[m]), 0x121, 0xf, 0xf, false));
  }
  s0 = s[0]; s1 = s[1];
}

DI void peer_bucket_token(const uint2* egt, unsigned* tmp  , int lane, unsigned& E0, unsigned& E1,
                          unsigned& G0, unsigned& G1) {
  const uint2 a = egt[lane], b = egt[64 + lane];
  const int ba = (int)(a.x >> 10), bb = (int)(b.x >> 10);
  const unsigned long long lt = (1ull << lane) - 1ull;
  int da = 0, db = 0, start = 0;
#pragma unroll
  for (int k = 0; k < 16; ++k) {
    const unsigned long long ma = __ballot(ba == k), mb = __ballot(bb == k);
    const int ca = __popcll(ma), cb = __popcll(mb);
    if (ba == k) da = start + __popcll(ma & lt);
    if (bb == k) db = start + ca + __popcll(mb & lt);
    start += ca + cb;
  }
  const int ia = (da & 1) * 64 + (da >> 3) + 16 * ((da >> 1) & 3);
  const int ib = (db & 1) * 64 + (db >> 3) + 16 * ((db >> 1) & 3);
  tmp[ia] = a.x; tmp[128 + ia] = a.y;
  tmp[ib] = b.x; tmp[128 + ib] = b.y;
  asm volatile("s_waitcnt lgkmcnt(0)" ::: "memory");
  E0 = tmp[lane]; E1 = tmp[64 + lane]; G0 = tmp[128 + lane]; G1 = tmp[192 + lane];
  asm volatile("s_waitcnt lgkmcnt(0)" ::: "memory");
}

DI void peer_finalize_token(const MKParams& p, float (&acc)[16], size_t tok, int lane) {
  float* orow = p.out + tok * DM + 16 * lane;
  float ss = 0.f;
#pragma unroll
  for (int q = 0; q < 4; ++q) {
    const f4v hv = *(const f4v*)(orow + 4 * q);
#pragma unroll
    for (int j = 0; j < 4; ++j) { acc[4 * q + j] += hv[j]; ss += acc[4 * q + j] * acc[4 * q + j]; }
  }
  ss = wave_sum(ss);
  const float rf = rsqrtf(ss * (1.0f / DM) + EPSV);
#pragma unroll
  for (int q = 0; q < 4; ++q) {
    const f4v gg = *(const f4v*)(p.g_fin + 16 * lane + 4 * q);
    f4v o = {acc[4 * q] * rf * gg[0], acc[4 * q + 1] * rf * gg[1], acc[4 * q + 2] * rf * gg[2], acc[4 * q + 3] * rf * gg[3]};
    *(f4v*)(orow + 4 * q) = o;
  }
}

DI void peer_usweep(const char* ws, const char* ldsA, int wave, int lane, const unsigned (&E)[8][2], float (&A)[8][2]) {
  const char* PU = ws + OFF_PU + 16 * lane;
#pragma unroll
  for (int i = 0; i < 8; ++i) { A[i][0] = 0.f; A[i][1] = 0.f; }
  int jn[8];
#pragma unroll
  for (int i = 0; i < 8; ++i) jn[i] = 0;
#pragma unroll 1
  for (int k = 0; k < 16; ++k) {
#pragma unroll
    for (int i = 0; i < 8; ++i) {
      while (jn[i] < 16 && (__builtin_amdgcn_readlane((int)E[i][0], jn[i]) >> 10) <= k) {
        const int j = jn[i];
        const bool sel = ((lane & 15) == j);
        const char* xrow = ldsA + (8 * wave + i) * LDS_ROW + 32 * lane;
        const uint4 x0 = *(const uint4*)xrow, x1 = *(const uint4*)(xrow + 16);
        const unsigned xr[8] = {x0.x, x0.y, x0.z, x0.w, x1.x, x1.y, x1.z, x1.w};
        uint4 u0[8];
#pragma unroll
        for (int m = 0; m < 8; ++m) {
          const int e = __builtin_amdgcn_readlane((int)E[i][m & 1], j + 16 * (m >> 1));
          u0[m] = *(const uint4*)(PU + (size_t)e * 1024);
        }
        float pv[8];
#pragma unroll
        for (int m = 0; m < 8; ++m) {
          const unsigned uw[4] = {u0[m].x, u0[m].y, u0[m].z, u0[m].w};
          float dsum = 0.f;
#pragma unroll
          for (int q = 0; q < 4; ++q) {
            const bf2 lo = __builtin_amdgcn_cvt_scalef32_pk_bf16_fp8(uw[q], 1.0f, false);
            const bf2 hi = __builtin_amdgcn_cvt_scalef32_pk_bf16_fp8(uw[q], 1.0f, true);
            dsum = __builtin_amdgcn_fdot2_f32_bf16(lo, __builtin_bit_cast(bf2, xr[2 * q]), dsum, false);
            dsum = __builtin_amdgcn_fdot2_f32_bf16(hi, __builtin_bit_cast(bf2, xr[2 * q + 1]), dsum, false);
          }
#if PROBE == 30
          {
            unsigned uw2[4] = {uw[0], uw[1], uw[2], uw[3]};
            asm volatile("" : "+v"(uw2[0]), "+v"(uw2[1]), "+v"(uw2[2]), "+v"(uw2[3]));
            float d2 = 0.f;
#pragma unroll
            for (int q = 0; q < 4; ++q) {
              const bf2 lo = __builtin_amdgcn_cvt_scalef32_pk_bf16_fp8(uw2[q], 1.0f, false);
              const bf2 hi = __builtin_amdgcn_cvt_scalef32_pk_bf16_fp8(uw2[q], 1.0f, true);
              d2 = __builtin_amdgcn_fdot2_f32_bf16(lo, __builtin_bit_cast(bf2, xr[2 * q]), d2, false);
              d2 = __builtin_amdgcn_fdot2_f32_bf16(hi, __builtin_bit_cast(bf2, xr[2 * q + 1]), d2, false);
            }
            dsum = 0.5f * (dsum + d2);
          }
#endif
          pv[m] = dsum;
        }
        float s0, s1;
        reduce8(pv, s0, s1);
        A[i][0] = sel ? s0 : A[i][0];
        A[i][1] = sel ? s1 : A[i][1];
        jn[i] = j + 1;
      }
    }
  }
}

template <int T0>
DI void peer_vsweep(const MKParams& p, int wave, int lane, size_t tok0, const unsigned (&E)[8][2], const unsigned (&Wb)[8][2]) {
  const char* PV = p.ws + OFF_PV + 16 * lane;
  f2v acc2[4][8];
#pragma unroll
  for (int i = 0; i < 4; ++i)
#pragma unroll
    for (int q = 0; q < 8; ++q) acc2[i][q] = (f2v){0.f, 0.f};
  int jn[4];
#pragma unroll
  for (int i = 0; i < 4; ++i) jn[i] = 0;
#pragma unroll 1
  for (int k = 0; k < 16; ++k) {
#pragma unroll
    for (int i = 0; i < 4; ++i) {
      while (jn[i] < 16 && (__builtin_amdgcn_readlane((int)E[T0 + i][0], jn[i]) >> 10) <= k) {
        const int j = jn[i];
        uint4 v0[8];
        float wl[8];
#pragma unroll
        for (int m = 0; m < 8; ++m) {
          const int e = __builtin_amdgcn_readlane((int)E[T0 + i][m & 1], j + 16 * (m >> 1));
          wl[m] = __uint_as_float((unsigned)__builtin_amdgcn_readlane((int)Wb[T0 + i][m & 1], j + 16 * (m >> 1)));
          v0[m] = *(const uint4*)(PV + (size_t)e * 1024);
        }
#pragma unroll
        for (int m = 0; m < 8; ++m) {
          const unsigned vw[4] = {v0[m].x, v0[m].y, v0[m].z, v0[m].w};
          const f2v ww = {wl[m], wl[m]};
#pragma unroll
          for (int q = 0; q < 4; ++q) {
            const f2v lo = __builtin_amdgcn_cvt_pk_f32_fp8((int)vw[q], false);
            const f2v hi = __builtin_amdgcn_cvt_pk_f32_fp8((int)vw[q], true);
            acc2[i][2 * q] = __builtin_elementwise_fma(lo, ww, acc2[i][2 * q]);
            acc2[i][2 * q + 1] = __builtin_elementwise_fma(hi, ww, acc2[i][2 * q + 1]);
          }
        }
        jn[i] = j + 1;
      }
    }
  }
#pragma unroll
  for (int i = 0; i < 4; ++i) {
    float acc[16];
#pragma unroll
    for (int q = 0; q < 8; ++q) { acc[2 * q] = acc2[i][q][0]; acc[2 * q + 1] = acc2[i][q][1]; }
    peer_finalize_token(p, acc, tok0 + 8 * wave + T0 + i, lane);
  }
}

DI void phase_d_tile(const MKParams& p, int tile, int wave, int lane, float rs0, float rs1) {
  asm volatile("" : "+v"(lane));
  char* ws = p.ws;
  char* ldsA = smem;
  float* rs_s = (float*)(smem + LDS_A_BYTES);
  unsigned char* idxs = (unsigned char*)(smem + LDS_A_BYTES + 4096) + wave * 1024;
  u16* qp = (u16*)qp_scratch(ws, blockIdx.x);
  uint2* eg = (uint2*)(ws + OFF_EG + (size_t)blockIdx.x * 65536);
  const size_t tok0 = (size_t)tile * 64;
  if (wave == 0) { if (lane < 32) rs_s[lane] = rs0; else rs_s[lane] = rs1; }
  {
    f16v acc[2][2];
    const bf8* wf = (const bf8*)(ws + OFF_WPQ);
#if PROBE == 17
    for (int rep_ = 0; rep_ < 2; ++rep_)
#endif
#pragma unroll 1
    for (int c = 0; c < 4; ++c) {
      int l2 = lane;
      asm volatile("" : "+v"(l2));
      const int r = l2 & 31, h = l2 >> 5;
      gemm_chunk<true>(ldsA, wf + (size_t)c * 65536 + 2 * wave * 64, l2, acc);
#pragma unroll
      for (int ntl = 0; ntl < 2; ++ntl)
#pragma unroll
        for (int tt = 0; tt < 2; ++tt)
#pragma unroll
          for (int g = 0; g < 4; ++g) {
            const float sc = tt ? rs1 : rs0;
            f4v v = {acc[ntl][tt][4 * g] * sc, acc[ntl][tt][4 * g + 1] * sc, acc[ntl][tt][4 * g + 2] * sc, acc[ntl][tt][4 * g + 3] * sc};
            *(bf4*)(qp + (size_t)(32 * tt + r) * 2048 + 512 * c + 64 * wave + 32 * ntl + 8 * g + 4 * h) = cvt4(v);
          }
    }
  }
  __syncthreads();
#if PROBE == 16
  for (int rep_ = 0; rep_ < 2; ++rep_)
#endif
#pragma unroll 1
  for (int tt = 0; tt < 2; ++tt) {
    int l2 = lane;
    asm volatile("" : "+v"(l2));
    peer_select(ws, qp, eg, idxs, wave, tt, l2);
  }
  __syncthreads();
}

DI void phase_d_gather(const MKParams& p, int tile, int wave, int lane) {
  asm volatile("" : "+v"(lane));
  char* ws = p.ws;
  char* ldsA = smem;
  float* rs_s = (float*)(smem + LDS_A_BYTES);
  unsigned char* idxs = (unsigned char*)(smem + LDS_A_BYTES + 4096) + wave * 1024;
  const uint2* eg = (const uint2*)(ws + OFF_EG + (size_t)blockIdx.x * 65536);
  const size_t tok0 = (size_t)tile * 64;
  {
    int l2 = lane;
    asm volatile("" : "+v"(l2));
    unsigned E[8][2], G[8][2];
#pragma unroll
    for (int i = 0; i < 8; ++i)
      peer_bucket_token(eg + (size_t)(8 * wave + i) * 128, (unsigned*)idxs, l2, E[i][0], E[i][1], G[i][0], G[i][1]);
    float A[8][2];
    peer_usweep(ws, ldsA, wave, l2, E, A);
    unsigned Wb[8][2];
#pragma unroll
    for (int i = 0; i < 8; ++i) {
      const float rs = rs_s[8 * wave + i];
#pragma unroll
      for (int cc = 0; cc < 2; ++cc) {
        const float a = A[i][cc] * rs * ((const float*)(ws + OFF_SU))[E[i][cc]];
        const float w = __uint_as_float(G[i][cc]) * 0.5f * a * (1.0f + erff(a * 0.70710678118654752f)) *
                        ((const float*)(ws + OFF_SV))[E[i][cc]];
        Wb[i][cc] = __float_as_uint(w);
      }
    }
    __builtin_amdgcn_sched_barrier(0);
    peer_vsweep<0>(p, wave, l2, tok0, E, Wb);
    __builtin_amdgcn_sched_barrier(0);
    peer_vsweep<4>(p, wave, l2, tok0, E, Wb);
  }
}
#ifndef REMAP
#define REMAP 1
#endif
DI int tile_of(int blk, int nblk) { return (REMAP && nblk == 256) ? ((blk & 7) * 32 + (blk >> 3)) : blk; }

__global__ __launch_bounds__(512) void mk(MKParams p) {
  cg::grid_group grid = cg::this_grid();
  const int tid = threadIdx.x;
  const int wave = __builtin_amdgcn_readfirstlane(tid >> 6), lane = tid & 63;
  const int gtid = blockIdx.x * 512 + tid, gthreads = gridDim.x * 512;
  const int gw = blockIdx.x * 8 + wave, nw = gridDim.x * 8;
  unsigned* bar = (unsigned*)(p.ws + OFF_BAR);
  phase_prep(p, gtid, gthreads);
#if !TABLES_IN_B
  phase_prep_tables(p, gw, nw, lane);
#endif
#if FIRST_CG
  grid.sync();
#else
  grid_barrier(bar, 1u * gridDim.x);
#endif
  for (int tile = blockIdx.x; tile < 256; tile += gridDim.x) phase_a_tile(p, tile_of(tile, gridDim.x), wave, lane);
  for (int item = blockIdx.x; item < 128; item += gridDim.x) phase_a_memkv(p, item, wave, lane);
#if PROBE == 13
  for (int item = blockIdx.x; item < 128; item += gridDim.x) phase_a_memkv(p, item, wave, lane);
#endif
  grid_barrier(bar, (2u - FIRST_CG) * gridDim.x);
  for (int it = gw; it < 4096; it += nw) sb_item(p, it, lane);
  for (int it = nw - 1 - gw; it < 1024; it += nw) gla_g1_item(p, it, wave, lane);
#if TABLES_IN_B
  phase_prep_tables(p, gw, nw, lane);
#endif
  grid_barrier(bar, (3u - FIRST_CG) * gridDim.x);
  gla_g2(p, gtid, gthreads);
#if PROBE == 14
  gla_g2(p, gtid, gthreads);
#endif
#if PROBE == 18
  grid.sync(); grid.sync(); grid.sync(); grid.sync();
#endif
  grid_barrier(bar, (4u - FIRST_CG) * gridDim.x);
  for (int t0 = blockIdx.x; t0 < 256; t0 += gridDim.x) {
    const int tile = tile_of(t0, gridDim.x);
    float rs0, rs1;
    phase_c_tile(p, tile, wave, lane, rs0, rs1);
    phase_d_tile(p, tile, wave, lane, rs0, rs1);
#if GATHER_ALIGN
    grid_barrier(bar, (5u - FIRST_CG) * gridDim.x);
#endif
    phase_d_gather(p, tile, wave, lane);
  }
#if !FIRST_CG
  grid.sync();
#endif
}
#define MK_LDS (160 * 1024)
extern "C" void kernel_launch(void* const* d_in, const int* in_sizes, int n_in, void* d_out, int out_size, void* d_ws,
                              size_t ws_size, hipStream_t stream) {
  MKParams p{};
  p.x = (const float*)d_in[0]; p.mem = (const float*)d_in[1]; p.g_mix = (const float*)d_in[2];
  p.w_in = (const float*)d_in[3]; p.w_up = (const float*)d_in[4]; p.b_alpha = (const float*)d_in[5];
  p.g_gla = (const float*)d_in[6]; p.w_out = (const float*)d_in[7]; p.g_mq = (const float*)d_in[8];
  p.g_mkv = (const float*)d_in[9]; p.w_mq = (const float*)d_in[10]; p.w_mkv = (const float*)d_in[11];
  p.w_mo = (const float*)d_in[12]; p.g_ffn = (const float*)d_in[13]; p.w_pq = (const float*)d_in[14];
  p.subk = (const float*)d_in[15]; p.pu = (const float*)d_in[16]; p.pv = (const float*)d_in[17];
  p.g_fin = (const float*)d_in[18];
  p.out = (float*)d_out; p.ws = (char*)d_ws;
  float* out = (float*)d_out;
  char* wsb = (char*)d_ws;
  float* ws = (float*)d_ws;
  static int grid_blocks = 0;
  if (!grid_blocks) {
    int dev = 0, cus = 0, per_cu = 0;
    (void)hipGetDevice(&dev);
    (void)hipDeviceGetAttribute(&cus, hipDeviceAttributeMultiprocessorCount, dev);
    (void)hipFuncSetAttribute((const void*)mk, hipFuncAttributeMaxDynamicSharedMemorySize, MK_LDS);
    (void)hipOccupancyMaxActiveBlocksPerMultiprocessor(&per_cu, mk, 512, MK_LDS);
    grid_blocks = cus * per_cu;
    fprintf(stderr, "mk: cus=%d per_cu=%d grid=%d ws=%zu\n", cus, per_cu, grid_blocks, ws_size);
  }
  (void)hipMemsetAsync((char*)d_ws + OFF_BAR, 0, 64, stream);
  {
    void* args[] = {(void*)&p};
    hipError_t e = hipLaunchCooperativeKernel((const void*)mk, dim3(grid_blocks), dim3(512), args, MK_LDS, stream);
    if (e != hipSuccess) fprintf(stderr, "coop launch failed: %s grid %d\n", hipGetErrorString(e), grid_blocks);
  }
}
```

```cpp
#define GEMM_D 8
#define TABLES_IN_B 1
#define REMAP 0
#define FIRST_CG 1
#define GATHER_ALIGN 0
#include <hip/hip_runtime.h>
#include <hip/hip_cooperative_groups.h>
#include <math.h>
#include <stdio.h>
#include <stdint.h>
namespace cg = cooperative_groups;

#ifndef PROBE
#define PROBE 0
#endif
#ifndef TABLES_IN_B
#define TABLES_IN_B 1
#endif
#define NB 8
#define SEQ 2048
#define DM 1024
#define NTOK (NB * SEQ)
#define INC 3088
#define MEML 256
#define EPSV 1e-6f

typedef __attribute__((ext_vector_type(8))) __bf16 bf8;
typedef __attribute__((ext_vector_type(4))) __bf16 bf4;
typedef __attribute__((ext_vector_type(2))) __bf16 bf2;
typedef __attribute__((ext_vector_type(16))) float f16v;
typedef __attribute__((ext_vector_type(8))) float f8v;
typedef __attribute__((ext_vector_type(4))) float f4v;
typedef __attribute__((ext_vector_type(2))) float f2v;
typedef unsigned short u16;

#define DI __device__ __forceinline__
#define MFMA(a, b, c) __builtin_amdgcn_mfma_f32_32x32x16_bf16((a), (b), (c), 0, 0, 0)

DI int crow(int i, int h) { return (i & 3) + 8 * (i >> 2) + 4 * h; }
DI int tpos(int t) { return (t & ~12) | ((t & 4) << 1) | ((t & 8) >> 1); }
DI float bf2f(u16 v) { return __uint_as_float(((unsigned)v) << 16); }
DI bf8 cvt8(f8v v) { return __builtin_convertvector(v, bf8); }
DI bf4 cvt4(f4v v) { return __builtin_convertvector(v, bf4); }
DI f16v zero16() { f16v z = {0.f, 0.f, 0.f, 0.f, 0.f, 0.f, 0.f, 0.f, 0.f, 0.f, 0.f, 0.f, 0.f, 0.f, 0.f, 0.f}; return z; }

#define MiB ((size_t)1 << 20)
#define OFF_WIN   ((size_t)0)
#define OFF_WOUT  (OFF_WIN + 97 * 65536)
#define OFF_WMQ   (OFF_WOUT + 32 * 65536)
#define OFF_WMKV  (OFF_WMQ + 32 * 65536)
#define OFF_WMO   (OFF_WMKV + 64 * 65536)
#define OFF_WPQ   (OFF_WMO + 32 * 65536)
#define OFF_SUBK  (OFF_WPQ + 64 * 65536)
#define OFF_ACT   (21 * MiB)
#define OFF_GQ    (OFF_ACT)
#define OFF_GK    (OFF_GQ + 8 * MiB)
#define OFF_GVT   (OFF_GK + 8 * MiB)
#define OFF_OG    (OFF_GVT + 16 * MiB)
#define OFF_SQ    (OFF_OG + 16 * MiB)
#define OFF_SK    (OFF_SQ + 16 * MiB)
#define OFF_SVT   (OFF_SK + 16 * MiB)
#define OFF_LA    (OFF_SVT + 16 * MiB)
#define OFF_LKV   (OFF_LA + 16 * MiB)
#define OFF_DD    (OFF_LKV + 32 * MiB)
#define OFF_OSB   (OFF_DD + 1 * MiB)
#define OFF_KM    (OFF_OSB + 16 * MiB)
#define OFF_VMT   (OFF_KM + 4 * MiB)
#define OFF_PU    (OFF_VMT + 4 * MiB)
#define OFF_PV    (OFF_PU + 16 * MiB)
#define OFF_SU    (OFF_PV + 16 * MiB)
#define OFF_SV    (OFF_SU + 65536)
#define OFF_SS    (OFF_LA)

#define LDS_ROW 2064
#define LDS_A_BYTES (64 * LDS_ROW)

DI char* qp_scratch(char* ws, int blk) {
  return blk < 192 ? ws + OFF_SQ + (size_t)blk * 262144 : ws + OFF_LKV + (size_t)(blk - 192) * 262144;
}

#define OFF_BAR (OFF_DD + 768 * 1024)
DI void grid_barrier(unsigned* ctr, unsigned target) {
  __syncthreads();
  if (threadIdx.x == 0) {
    __builtin_amdgcn_fence(__ATOMIC_RELEASE, "agent");
    asm volatile("s_waitcnt vmcnt(0)" ::: "memory");
    __hip_atomic_fetch_add(ctr, 1u, __ATOMIC_RELAXED, __HIP_MEMORY_SCOPE_AGENT);
    while (__hip_atomic_load(ctr, __ATOMIC_RELAXED, __HIP_MEMORY_SCOPE_AGENT) < target) __builtin_amdgcn_s_sleep(1);
    __builtin_amdgcn_fence(__ATOMIC_ACQUIRE, "agent");
    asm volatile("s_waitcnt vmcnt(0)" ::: "memory");
  }
  __syncthreads();
}

struct MKParams {
  const float *x, *mem, *g_mix, *w_in, *w_up, *b_alpha, *g_gla, *w_out, *g_mq, *g_mkv, *w_mq, *w_mkv, *w_mo, *g_ffn, *w_pq,
      *subk, *pu, *pv, *g_fin;
  float* out;
  char* ws;
};
extern __shared__ __attribute__((aligned(16))) char smem[];

template <typename ColFn>
DI void prep_w(bf8* dst, const float* __restrict__ W, int ldw, int ntiles, const float* __restrict__ gain, ColFn colfn,
               int gtid, int gthreads) {
  const int total = ntiles * 4096;
  for (int u = gtid; u < total; u += gthreads) {
    const int lane = u & 63, ks = (u >> 6) & 63, nt = u >> 12;
    const int r = lane & 31, h = lane >> 5;
    float sc = 1.f;
    const int col = colfn(32 * nt + r, sc);
    f8v v;
#pragma unroll
    for (int j = 0; j < 8; ++j) {
      const int k = 16 * ks + 8 * h + j;
      float val = 0.f;
      if (col >= 0) val = W[(size_t)k * ldw + col] * sc * (gain ? gain[k] : 1.f);
      v[j] = val;
    }
    const int didx = (nt < (ntiles & ~15)) ? ((((nt >> 4) * 64 + ks) * 16 + (nt & 15)) * 64 + lane) : u;
    dst[didx] = cvt8(v);
  }
}

DI void phase_prep(const MKParams& p, int gtid, int gthreads) {
  char* ws = p.ws;
  prep_w((bf8*)(ws + OFF_WIN), p.w_in, INC, 97, p.g_mix,
         [](int n, float& sc) -> int {
           if (n < 256) { sc = 0.125f; return n; }
           if (n < 1536) return n;
           if (n < 2048) { sc = 0.125f; return n + 16; }
           if (n < 3072) return n + 16;
           if (n < 3088) return n - 1536;
           return -1;
         }, gtid, gthreads);
  prep_w((bf8*)(ws + OFF_WOUT), p.w_out, 1024, 32, nullptr, [](int n, float& sc) -> int { return n; }, gtid, gthreads);
  prep_w((bf8*)(ws + OFF_WMQ), p.w_mq, 1024, 32, p.g_mq, [](int n, float& sc) -> int { sc = 0.0625f; return n; }, gtid, gthreads);
  prep_w((bf8*)(ws + OFF_WMKV), p.w_mkv, 2048, 64, p.g_mkv, [](int n, float& sc) -> int { return n; }, gtid, gthreads);
  prep_w((bf8*)(ws + OFF_WMO), p.w_mo, 1024, 32, nullptr, [](int n, float& sc) -> int { return n; }, gtid, gthreads);
  prep_w((bf8*)(ws + OFF_WPQ), p.w_pq, 2048, 64, p.g_ffn, [](int n, float& sc) -> int { return n; }, gtid, gthreads);
  {
    bf8* dst = (bf8*)(ws + OFF_SUBK);
    const int total = 16 * 4 * 8 * 64;
    for (int u = gtid; u < total; u += gthreads) {
      const int lane = u & 63, ks = (u >> 6) & 7, mt = (u >> 9) & 3, hp = u >> 11;
      const int r = lane & 31, h = lane >> 5;
      const float* s = p.subk + ((size_t)(hp * 128 + 32 * mt + r)) * 128 + 16 * ks + 8 * h;
      const f4v a = *(const f4v*)s, b = *(const f4v*)(s + 4);
      f8v v = {a[0], a[1], a[2], a[3], b[0], b[1], b[2], b[3]};
      dst[u] = cvt8(v);
    }
  }
}

DI void phase_prep_tables(const MKParams& p, int gwave, int nwaves, int lane) {
  for (int row = gwave; row < 32768; row += nwaves) {
    const int e = row & 16383;
    const bool isv = row >= 16384;
    const float* src = (isv ? p.pv : p.pu) + (size_t)e * DM + 16 * lane;
    f4v v[4];
#pragma unroll
    for (int q = 0; q < 4; ++q) v[q] = *(const f4v*)(src + 4 * q);
    if (!isv) {
#pragma unroll
      for (int q = 0; q < 4; ++q) v[q] = v[q] * *(const f4v*)(p.g_ffn + 16 * lane + 4 * q);
    }
    float am = 0.f;
#pragma unroll
    for (int q = 0; q < 4; ++q)
#pragma unroll
      for (int j = 0; j < 4; ++j) am = fmaxf(am, fabsf(v[q][j]));
#pragma unroll
    for (int o = 32; o > 0; o >>= 1) am = fmaxf(am, __shfl_xor(am, o));
    int k = 0;
    if (am > 0.f) k = 7 - ilogbf(am);
    k = max(-100, min(100, k));
    const float sc = ldexpf(1.0f, k);
    unsigned w[4];
#pragma unroll
    for (int q = 0; q < 4; ++q) {
      int pk = 0;
      pk = __builtin_amdgcn_cvt_pk_fp8_f32(v[q][0] * sc, v[q][1] * sc, pk, false);
      pk = __builtin_amdgcn_cvt_pk_fp8_f32(v[q][2] * sc, v[q][3] * sc, pk, true);
      w[q] = (unsigned)pk;
    }
    *(uint4*)(p.ws + (isv ? OFF_PV : OFF_PU) + (size_t)e * 1024 + 16 * lane) = make_uint4(w[0], w[1], w[2], w[3]);
    if (lane == 0) ((float*)(p.ws + (isv ? OFF_SV : OFF_SU)))[e] = ldexpf(1.0f, -k);
  }
}

DI void load_norm_tile(const float* __restrict__ src, char* ldsA, int wave, int lane) {
#pragma unroll 2
  for (int i = 0; i < 8; ++i) {
    const int row = 8 * wave + i;
    const f4v* pr = (const f4v*)(src + (size_t)row * DM);
    f4v v[4];
#pragma unroll
    for (int c = 0; c < 4; ++c) v[c] = pr[lane + 64 * c];
    float ss = 0.f;
#pragma unroll
    for (int c = 0; c < 4; ++c) ss += v[c][0] * v[c][0] + v[c][1] * v[c][1] + v[c][2] * v[c][2] + v[c][3] * v[c][3];
#pragma unroll
    for (int o = 32; o > 0; o >>= 1) ss += __shfl_xor(ss, o);
    const float rs = rsqrtf(ss * (1.0f / DM) + EPSV);
#pragma unroll
    for (int c = 0; c < 4; ++c) {
      f4v t = v[c] * rs;
      *(bf4*)(ldsA + row * LDS_ROW + (lane * 4 + 256 * c) * 2) = cvt4(t);
    }
  }
}

#ifndef GEMM_D
#define GEMM_D 6
#endif
template <bool SWAP>
DI void gemm_step(f16v (&acc)[2][2], const bf8& a0, const bf8& a1, const bf8& x0, const bf8& x1) {
  if (SWAP) {
    acc[0][0] = MFMA(a0, x0, acc[0][0]); acc[0][1] = MFMA(a0, x1, acc[0][1]);
    acc[1][0] = MFMA(a1, x0, acc[1][0]); acc[1][1] = MFMA(a1, x1, acc[1][1]);
  } else {
    acc[0][0] = MFMA(x0, a0, acc[0][0]); acc[0][1] = MFMA(x1, a0, acc[0][1]);
    acc[1][0] = MFMA(x0, a1, acc[1][0]); acc[1][1] = MFMA(x1, a1, acc[1][1]);
  }
}
struct Ring { bf8 w0[GEMM_D], w1[GEMM_D]; };
DI void ring_fill(Ring& rg, const bf8* __restrict__ wf, int lane) {
#pragma unroll
  for (int i = 0; i < GEMM_D; ++i) { rg.w0[i] = wf[lane + i * 1024]; rg.w1[i] = wf[64 + lane + i * 1024]; }
}
template <bool SWAP, bool RES, bool FIRST, bool NEXT>
DI void gemm_chunk_r(const char* ldsA, const bf8* __restrict__ wf, const bf8* __restrict__ wnext, int lane, f16v (&acc)[2][2],
                     Ring& rg, const float* res = nullptr) {
  __builtin_amdgcn_sched_barrier(0);
  const int r = lane & 31, h = lane >> 5;
  const char* xa0 = ldsA + r * LDS_ROW + h * 16;
  const char* xa1 = xa0 + 32 * LDS_ROW;
  const bf8* w0p = wf + lane;
  const bf8* w1p = wf + 64 + lane;
  if (FIRST) ring_fill(rg, wf, lane);
  if (RES) {
#pragma unroll
    for (int ntl = 0; ntl < 2; ++ntl)
#pragma unroll
      for (int tt = 0; tt < 2; ++tt)
#pragma unroll
        for (int g = 0; g < 4; ++g) {
          const f4v x = *(const f4v*)(res + (size_t)(32 * tt + r) * DM + 32 * ntl + 8 * g + 4 * h);
          acc[ntl][tt][4 * g] = x[0]; acc[ntl][tt][4 * g + 1] = x[1]; acc[ntl][tt][4 * g + 2] = x[2]; acc[ntl][tt][4 * g + 3] = x[3];
        }
  } else {
    acc[0][0] = zero16(); acc[0][1] = zero16(); acc[1][0] = zero16(); acc[1][1] = zero16();
  }
  bf8 x0 = *(const bf8*)(xa0), x1 = *(const bf8*)(xa1);
  constexpr int KMAIN = ((64 - 2 * GEMM_D) / GEMM_D + 1) * GEMM_D;
#pragma unroll 1
  for (int ks0 = 0; ks0 < KMAIN; ks0 += GEMM_D) {
#pragma unroll
    for (int i = 0; i < GEMM_D; ++i) {
      const int ks = ks0 + i;
      const bf8 xn0 = *(const bf8*)(xa0 + (ks + 1) * 32);
      const bf8 xn1 = *(const bf8*)(xa1 + (ks + 1) * 32);
      gemm_step<SWAP>(acc, rg.w0[i], rg.w1[i], x0, x1);
      rg.w0[i] = w0p[(ks + GEMM_D) * 1024];
      rg.w1[i] = w1p[(ks + GEMM_D) * 1024];
      x0 = xn0; x1 = xn1;
      __builtin_amdgcn_sched_group_barrier(0x100, 2, 0);
      __builtin_amdgcn_sched_group_barrier(0x008, 2, 0);
      __builtin_amdgcn_sched_group_barrier(0x020, 2, 0);
      __builtin_amdgcn_sched_group_barrier(0x008, 2, 0);
    }
  }
#pragma unroll
  for (int t = 0; t < 64 - KMAIN; ++t) {
    const int ks = KMAIN + t, i = t % GEMM_D;
    const bf8 xn0 = *(const bf8*)(xa0 + (ks + 1) * 32);
    const bf8 xn1 = *(const bf8*)(xa1 + (ks + 1) * 32);
    gemm_step<SWAP>(acc, rg.w0[i], rg.w1[i], x0, x1);
    const bool refill = (ks + GEMM_D < 64) || NEXT;
    if (ks + GEMM_D < 64) {
      rg.w0[i] = w0p[(ks + GEMM_D) * 1024];
      rg.w1[i] = w1p[(ks + GEMM_D) * 1024];
    } else if (NEXT) {
      rg.w0[i] = wnext[lane + (ks + GEMM_D - 64) * 1024];
      rg.w1[i] = wnext[64 + lane + (ks + GEMM_D - 64) * 1024];
    }
    x0 = xn0; x1 = xn1;
    __builtin_amdgcn_sched_group_barrier(0x100, 2, 0);
    __builtin_amdgcn_sched_group_barrier(0x008, 2, 0);
    if (refill) __builtin_amdgcn_sched_group_barrier(0x020, 2, 0);
    __builtin_amdgcn_sched_group_barrier(0x008, 2, 0);
  }
}
template <bool SWAP, bool RES = false>
DI void gemm_chunk(const char* ldsA, const bf8* __restrict__ wf, int lane, f16v (&acc)[2][2], const float* res = nullptr) {
  Ring rg;
  gemm_chunk_r<SWAP, RES, true, false>(ldsA, wf, nullptr, lane, acc, rg, res);
}

DI void store_swap_bf16(u16* dst, size_t ld, const f16v (&acc)[2][2], int lane) {
  const int r = lane & 31, h = lane >> 5;
#pragma unroll
  for (int ntl = 0; ntl < 2; ++ntl)
#pragma unroll
    for (int tt = 0; tt < 2; ++tt)
#pragma unroll
      for (int g = 0; g < 4; ++g) {
        f4v v = {acc[ntl][tt][4 * g], acc[ntl][tt][4 * g + 1], acc[ntl][tt][4 * g + 2], acc[ntl][tt][4 * g + 3]};
        *(bf4*)(dst + (size_t)(32 * tt + r) * ld + 32 * ntl + 8 * g + 4 * h) = cvt4(v);
      }
}
DI void store_vt_bf16(u16* dst, size_t ld, const f16v (&acc)[2][2], int lane) {
  const int r = lane & 31, h = lane >> 5;
#pragma unroll
  for (int ntl = 0; ntl < 2; ++ntl)
#pragma unroll
    for (int tt = 0; tt < 2; ++tt)
#pragma unroll
      for (int s = 0; s < 2; ++s) {
        f8v v;
#pragma unroll
        for (int j = 0; j < 8; ++j) v[j] = acc[ntl][tt][8 * s + j];
        *(bf8*)(dst + (size_t)(32 * ntl + r) * ld + 32 * tt + 16 * s + 8 * h) = cvt8(v);
      }
}

DI float log_sigmoid_acc(float x) { return fminf(x, 0.f) - log1pf(expf(-fabsf(x))); }

DI void phase_a_tile(const MKParams& p, int tile, int wave, int lane) {
  asm volatile("" : "+v"(lane));
  char* ws = p.ws;
  char* ldsA = smem;
  float* alr_s = (float*)(smem + LDS_A_BYTES);
  const int b = tile >> 5, c = tile & 31;
  const size_t tok0 = (size_t)tile * 64;
  __syncthreads();
  load_norm_tile(p.x + tok0 * DM, ldsA, wave, lane);
#if PROBE == 10
  __syncthreads();
  load_norm_tile(p.x + tok0 * DM, ldsA, wave, lane);
#endif
  __syncthreads();
  const bf8* wf = (const bf8*)(ws + OFF_WIN);
  f16v acc[2][2];
  Ring rg;
  const int t0 = c * 64;
  gemm_chunk_r<true, false, true, true>(ldsA, wf + (size_t)0 * 65536 + 2 * wave * 64, wf + (size_t)1 * 65536 + 2 * wave * 64, lane, acc, rg);
  {
    u16* base = (u16*)(ws + (wave < 4 ? OFF_GQ : OFF_GK)) + ((size_t)(b * 4 + (wave & 3)) * SEQ + t0) * 64;
    store_swap_bf16(base, 64, acc, lane);
#if PROBE == 11
    store_swap_bf16(base, 64, acc, lane);
#endif
  }
  gemm_chunk_r<false, false, false, true>(ldsA, wf + (size_t)1 * 65536 + 2 * wave * 64, wf + (size_t)2 * 65536 + 2 * wave * 64, lane, acc, rg);
  {
    u16* base = (u16*)(ws + OFF_GVT) + ((size_t)(b * 4 + (wave >> 1)) * 128 + 64 * (wave & 1)) * SEQ + t0;
    store_vt_bf16(base, SEQ, acc, lane);
#if PROBE == 11
    store_vt_bf16(base, SEQ, acc, lane);
#endif
  }
  gemm_chunk_r<true, false, false, true>(ldsA, wf + (size_t)2 * 65536 + 2 * wave * 64, wf + (size_t)3 * 65536 + 2 * wave * 64, lane, acc, rg);
  store_swap_bf16((u16*)(ws + OFF_OG) + tok0 * 512 + 64 * wave, 512, acc, lane);
#if PROBE == 11
  store_swap_bf16((u16*)(ws + OFF_OG) + tok0 * 512 + 64 * wave, 512, acc, lane);
#endif
  gemm_chunk_r<true, false, false, true>(ldsA, wf + (size_t)3 * 65536 + 2 * wave * 64, wf + (size_t)4 * 65536 + 2 * wave * 64, lane, acc, rg);
  store_swap_bf16((u16*)(ws + OFF_SQ) + ((size_t)(b * 8 + wave) * SEQ + t0) * 64, 64, acc, lane);
#if PROBE == 11
  store_swap_bf16((u16*)(ws + OFF_SQ) + ((size_t)(b * 8 + wave) * SEQ + t0) * 64, 64, acc, lane);
#endif
  gemm_chunk_r<true, false, false, true>(ldsA, wf + (size_t)4 * 65536 + 2 * wave * 64, wf + (size_t)5 * 65536 + 2 * wave * 64, lane, acc, rg);
  store_swap_bf16((u16*)(ws + OFF_SK) + ((size_t)(b * 8 + wave) * SEQ + t0) * 64, 64, acc, lane);
#if PROBE == 11
  store_swap_bf16((u16*)(ws + OFF_SK) + ((size_t)(b * 8 + wave) * SEQ + t0) * 64, 64, acc, lane);
#endif
  gemm_chunk_r<false, false, false, false>(ldsA, wf + (size_t)5 * 65536 + 2 * wave * 64, nullptr, lane, acc, rg);
  store_vt_bf16((u16*)(ws + OFF_SVT) + ((size_t)(b * 8 + wave) * 64) * SEQ + t0, SEQ, acc, lane);
#if PROBE == 11
  store_vt_bf16((u16*)(ws + OFF_SVT) + ((size_t)(b * 8 + wave) * 64) * SEQ + t0, SEQ, acc, lane);
#endif
#if PROBE == 12
  for (int rep_ = 0; rep_ < 2; ++rep_) {
  __syncthreads();
#else
  {
#endif
    float* part = (float*)(smem + LDS_A_BYTES);
    const int r = lane & 31, h = lane >> 5;
    const bf8* wp = wf + (size_t)96 * 4096 + lane;
    bf8 wfr[8];
#pragma unroll
    for (int i = 0; i < 8; ++i) wfr[i] = wp[(8 * wave + i) * 64];
    const char* xa0 = ldsA + r * LDS_ROW + h * 16 + wave * 256;
    const char* xa1 = xa0 + 32 * LDS_ROW;
    f16v a0 = zero16(), a1 = zero16();
#pragma unroll
    for (int i = 0; i < 8; ++i) {
      a0 = MFMA(wfr[i], *(const bf8*)(xa0 + i * 32), a0);
      a1 = MFMA(wfr[i], *(const bf8*)(xa1 + i * 32), a1);
    }
    float* pw = part + (wave & 3) * 1024;
    if (wave < 4) {
#pragma unroll
      for (int i = 0; i < 8; ++i) { pw[r * 16 + crow(i, h)] = a0[i]; pw[(32 + r) * 16 + crow(i, h)] = a1[i]; }
    }
    __syncthreads();
    if (wave >= 4) {
#pragma unroll
      for (int i = 0; i < 8; ++i) { pw[r * 16 + crow(i, h)] += a0[i]; pw[(32 + r) * 16 + crow(i, h)] += a1[i]; }
    }
    __syncthreads();
    const int tid = wave * 64 + lane;
    {
      const f4v* p4 = (const f4v*)part;
      if (tid < 256) { f4v s = p4[tid] + p4[256 + tid] + p4[512 + tid] + p4[768 + tid]; ((f4v*)part)[tid] = s; }
    }
    __syncthreads();
    const int col = tid & 255, tg = tid >> 8;
    float wu[16];
#pragma unroll
    for (int rr = 0; rr < 16; ++rr) wu[rr] = p.w_up[rr * 256 + col];
    const float bb = p.b_alpha[col];
    float* dst = (float*)(ws + OFF_LA) + (tok0 + 32 * tg) * 256 + col;
#pragma unroll 4
    for (int t = 0; t < 32; ++t) {
      const f4v* ar = (const f4v*)(part + (32 * tg + t) * 16);
      const f4v q0 = ar[0], q1 = ar[1], q2 = ar[2], q3 = ar[3];
      float s = bb;
      s = fmaf(q0[0], wu[0], s); s = fmaf(q0[1], wu[1], s); s = fmaf(q0[2], wu[2], s); s = fmaf(q0[3], wu[3], s);
      s = fmaf(q1[0], wu[4], s); s = fmaf(q1[1], wu[5], s); s = fmaf(q1[2], wu[6], s); s = fmaf(q1[3], wu[7], s);
      s = fmaf(q2[0], wu[8], s); s = fmaf(q2[1], wu[9], s); s = fmaf(q2[2], wu[10], s); s = fmaf(q2[3], wu[11], s);
      s = fmaf(q3[0], wu[12], s); s = fmaf(q3[1], wu[13], s); s = fmaf(q3[2], wu[14], s); s = fmaf(q3[3], wu[15], s);
      const float ls = fminf(s, 0.f) - __logf(1.0f + __expf(-fabsf(s)));
      dst[(size_t)t * 256] = ls * (1.0f / 16.0f);
    }
  }
}

DI void phase_a_memkv(const MKParams& p, int item, int wave, int lane) {
  asm volatile("" : "+v"(lane));
  char* ws = p.ws;
  char* ldsA = smem;
  const int rt = item >> 2, cc = item & 3;
  const int b = rt >> 2, m0 = (rt & 3) * 64;
  __syncthreads();
  load_norm_tile(p.mem + (size_t)rt * 64 * DM, ldsA, wave, lane);
  __syncthreads();
  const bf8* wf = (const bf8*)(ws + OFF_WMKV);
  f16v acc[2][2];
  if (cc < 2) {
    gemm_chunk<true>(ldsA, wf + (size_t)cc * 65536 + 2 * wave * 64, lane, acc);
    const int f0 = 512 * cc + 64 * wave;
    u16* base = (u16*)(ws + OFF_KM) + ((size_t)(b * 4 + (f0 >> 8)) * 256 + m0) * 256 + (f0 & 255);
    store_swap_bf16(base, 256, acc, lane);
  } else {
    gemm_chunk<false>(ldsA, wf + (size_t)cc * 65536 + 2 * wave * 64, lane, acc);
    const int f0 = 512 * (cc - 2) + 64 * wave;
    u16* base = (u16*)(ws + OFF_VMT) + ((size_t)(b * 4 + (f0 >> 8)) * 256 + (f0 & 255)) * 256 + m0;
    store_vt_bf16(base, 256, acc, lane);
  }
}
#define SB_THR 30.0f

DI bf8 pack8(const f16v& x, int s) {
  f8v v;
#pragma unroll
  for (int j = 0; j < 8; ++j) v[j] = x[8 * s + j];
  return cvt8(v);
}

DI void sb_item(const MKParams& p, int item, int lane) {
  asm volatile("" : "+v"(lane));
  char* ws = p.ws;
  const int r = lane & 31, h = lane >> 5;
  const int bh = item >> 6, qt = item & 63;
  const u16* SQ = (const u16*)(ws + OFF_SQ) + (size_t)bh * SEQ * 64;
  const u16* SK = (const u16*)(ws + OFF_SK) + (size_t)bh * SEQ * 64;
  const u16* SVT = (const u16*)(ws + OFF_SVT) + (size_t)bh * 64 * SEQ;
  bf8 qf[4];
#pragma unroll
  for (int ks = 0; ks < 4; ++ks) qf[ks] = *(const bf8*)(SQ + (size_t)(32 * qt + r) * 64 + 16 * ks + 8 * h);
  bf8 tri[2];
#pragma unroll
  for (int s = 0; s < 2; ++s) {
    f8v t;
#pragma unroll
    for (int j = 0; j < 8; ++j) t[j] = (16 * s + 8 * (j >> 2) + 4 * h + (j & 3) >= r) ? 1.0f : 0.0f;
    tri[s] = cvt8(t);
  }
  f16v o0 = zero16(), o1 = zero16();
  float R = 0.f;
  for (int kt = qt; kt >= 0; --kt) {
    bf8 kf[4], vf[2][2];
#pragma unroll
    for (int ks = 0; ks < 4; ++ks) kf[ks] = *(const bf8*)(SK + (size_t)(32 * kt + r) * 64 + 16 * ks + 8 * h);
#pragma unroll
    for (int mt = 0; mt < 2; ++mt)
#pragma unroll
      for (int s = 0; s < 2; ++s) vf[mt][s] = *(const bf8*)(SVT + (size_t)(32 * mt + r) * SEQ + 32 * kt + 16 * s + 8 * h);
    f16v z = zero16();
#pragma unroll
    for (int ks = 0; ks < 4; ++ks) z = MFMA(kf[ks], qf[ks], z);
    const bool diag = (kt == qt);
    f16v sp;
    float tot = 0.f;
#pragma unroll
    for (int i = 0; i < 16; ++i) {
      const float zz = z[i];
      const float sv = fmaxf(zz, 0.f) + __logf(1.0f + __expf(-fabsf(zz)));
      const bool valid = !diag || (crow(i, h) < r);
      sp[i] = valid ? sv : 0.f;
      tot += sp[i];
    }
    tot += __shfl_xor(tot, 32);
    f16v C = MFMA(tri[0], pack8(sp, 0), zero16());
    C = MFMA(tri[1], pack8(sp, 1), C);
    f16v a;
#pragma unroll
    for (int i = 0; i < 16; ++i) {
      const bool valid = !diag || (crow(i, h) < r);
      a[i] = valid ? __expf(z[i] - C[i] - R) : 0.f;
    }
    const bf8 a0 = pack8(a, 0), a1 = pack8(a, 1);
    o0 = MFMA(vf[0][0], a0, o0); o0 = MFMA(vf[0][1], a1, o0);
    o1 = MFMA(vf[1][0], a0, o1); o1 = MFMA(vf[1][1], a1, o1);
    R += tot;
    if (__all(R > SB_THR)) break;
  }
  const int b = bh >> 3, hd = bh & 7;
  u16* dst = (u16*)(ws + OFF_OSB) + ((size_t)b * SEQ + 32 * qt + r) * 512 + hd * 64 + 4 * h;
#pragma unroll
  for (int g = 0; g < 4; ++g) {
    f4v v0 = {o0[4 * g], o0[4 * g + 1], o0[4 * g + 2], o0[4 * g + 3]};
    f4v v1 = {o1[4 * g], o1[4 * g + 1], o1[4 * g + 2], o1[4 * g + 3]};
    *(bf4*)(dst + 8 * g) = cvt4(v0);
    *(bf4*)(dst + 32 + 8 * g) = cvt4(v1);
  }
}

DI void gla_g1_item(const MKParams& p, int item, int wave, int lane) {
  asm volatile("" : "+v"(lane));
  char* ws = p.ws;
  const int r = lane & 31, h = lane >> 5;
  const int bh = item >> 5, c = item & 31, b = bh >> 2, hd = bh & 3;
  char* kl = smem + wave * 9216;
  u16* GQ = (u16*)(ws + OFF_GQ) + ((size_t)bh * SEQ + 64 * c) * 64;
  u16* GK = (u16*)(ws + OFF_GK) + ((size_t)bh * SEQ + 64 * c) * 64;
  const float* LA = (const float*)(ws + OFF_LA) + ((size_t)b * SEQ + 64 * c) * 256 + hd * 64;
  float bc = 0.f;
#pragma unroll 1
  for (int g = 0; g < 4; ++g) {
    float la_[16];
    u16 q_[16], k_[16];
#pragma unroll
    for (int i = 0; i < 16; ++i) {
      const int t = 16 * g + i;
      la_[i] = LA[(size_t)t * 256 + lane];
      q_[i] = GQ[t * 64 + lane];
      k_[i] = GK[t * 64 + lane];
    }
#pragma unroll
    for (int i = 0; i < 16; ++i) {
      const int t = 16 * g + i;
      bc += la_[i];
      const float eq = __expf(bc);
      const float qn = bf2f(q_[i]) * eq, kn = bf2f(k_[i]) / eq;
      const bf2 pk = __builtin_convertvector((f2v){qn, kn}, bf2);
      const unsigned u = __builtin_bit_cast(unsigned, pk);
      GQ[t * 64 + lane] = (u16)(u & 0xffff);
      GK[t * 64 + lane] = (u16)(u >> 16);
      *(u16*)(kl + lane * 144 + tpos(t) * 2) = (u16)(u >> 16);
    }
  }
  ((float*)(ws + OFF_DD))[(size_t)item * 64 + lane] = __expf(bc);
  asm volatile("s_waitcnt lgkmcnt(0)" ::: "memory");
  const u16* GVT = (const u16*)(ws + OFF_GVT) + (size_t)bh * 128 * SEQ + 64 * c;
  float* LKV = (float*)(ws + OFF_LKV) + (size_t)item * 128 * 64;
  bf8 kb[2][4];
#pragma unroll
  for (int nt = 0; nt < 2; ++nt)
#pragma unroll
    for (int s = 0; s < 4; ++s) kb[nt][s] = *(const bf8*)(kl + (32 * nt + r) * 144 + (16 * s + 8 * h) * 2);
#pragma unroll 1
  for (int mt = 0; mt < 4; ++mt) {
    f16v a0 = zero16(), a1 = zero16();
#pragma unroll
    for (int s = 0; s < 4; ++s) {
      const bf8 vf = *(const bf8*)(GVT + (size_t)(32 * mt + r) * SEQ + 16 * s + 8 * h);
      a0 = MFMA(vf, kb[0][s], a0);
      a1 = MFMA(vf, kb[1][s], a1);
    }
#pragma unroll
    for (int i = 0; i < 16; ++i) {
      LKV[(32 * mt + crow(i, h)) * 64 + r] = a0[i];
      LKV[(32 * mt + crow(i, h)) * 64 + 32 + r] = a1[i];
    }
  }
  asm volatile("s_waitcnt lgkmcnt(0)" ::: "memory");
}

DI void gla_g2(const MKParams& p, int gtid, int gthreads) {
  char* ws = p.ws;
  for (int u = gtid; u < 32768; u += gthreads) {
    const int oct = u & 7, dv = (u >> 3) & 127, bh = u >> 10;
    f8v S = {0.f, 0.f, 0.f, 0.f, 0.f, 0.f, 0.f, 0.f};
#pragma unroll 4
    for (int c = 0; c < 32; ++c) {
      const size_t item = (size_t)bh * 32 + c;
      *(bf8*)((u16*)(ws + OFF_SS) + (item * 128 + dv) * 64 + oct * 8) = cvt8(S);
      const f8v l = *(const f8v*)((const float*)(ws + OFF_LKV) + (item * 128 + dv) * 64 + oct * 8);
      const f8v d = *(const f8v*)((const float*)(ws + OFF_DD) + item * 64 + oct * 8);
      S = d * (S + l);
    }
  }
}

DI void gla_g3_tile(const MKParams& p, int tile, int wave, int lane, char* dst, int dst_ld) {
  char* ws = p.ws;
  const int r = lane & 31, h = lane >> 5;
  const int b = tile >> 5, c = tile & 31, hd = wave >> 1, tt = wave & 1, bh = b * 4 + hd;
  const u16* GQ = (const u16*)(ws + OFF_GQ) + ((size_t)bh * SEQ + 64 * c) * 64;
  const u16* GK = (const u16*)(ws + OFF_GK) + ((size_t)bh * SEQ + 64 * c) * 64;
  const u16* GVT = (const u16*)(ws + OFF_GVT) + (size_t)bh * 128 * SEQ + 64 * c;
  const u16* SS = (const u16*)(ws + OFF_SS) + ((size_t)(bh * 32 + c) * 128) * 64;
  bf8 qf[4];
#pragma unroll
  for (int ks = 0; ks < 4; ++ks) qf[ks] = *(const bf8*)(GQ + (32 * tt + r) * 64 + 16 * ks + 8 * h);
  bf8 pf[2][2];
  {
    bf8 kf[2][4];
#pragma unroll
    for (int kt = 0; kt < 2; ++kt)
      if (kt <= tt) {
#pragma unroll
        for (int ks = 0; ks < 4; ++ks) kf[kt][ks] = *(const bf8*)(GK + (32 * kt + r) * 64 + 16 * ks + 8 * h);
      }
    __builtin_amdgcn_sched_barrier(0);
#pragma unroll
    for (int kt = 0; kt < 2; ++kt) {
      if (kt <= tt) {
        f16v pt = zero16();
#pragma unroll
        for (int ks = 0; ks < 4; ++ks) pt = MFMA(kf[kt][ks], qf[ks], pt);
        if (kt == tt) {
#pragma unroll
          for (int i = 0; i < 16; ++i) pt[i] = (crow(i, h) <= r) ? pt[i] : 0.f;
        }
        pf[kt][0] = pack8(pt, 0);
        pf[kt][1] = pack8(pt, 1);
      }
    }
  }
  f16v o[4];
  {
    bf8 sf[2][4], vf[2][4];
    auto load_tile = [&](int mt, bf8 (&sfx)[4], bf8 (&vfx)[4]) {
#pragma unroll
      for (int ks = 0; ks < 4; ++ks) sfx[ks] = *(const bf8*)(SS + (32 * mt + r) * 64 + 16 * ks + 8 * h);
#pragma unroll
      for (int kt = 0; kt < 2; ++kt)
        if (kt <= tt) {
#pragma unroll
          for (int s = 0; s < 2; ++s) vfx[2 * kt + s] = *(const bf8*)(GVT + (size_t)(32 * mt + r) * SEQ + 32 * kt + 16 * s + 8 * h);
        }
    };
    load_tile(0, sf[0], vf[0]);
#pragma unroll
    for (int mt = 0; mt < 4; ++mt) {
      if (mt + 1 < 4) load_tile(mt + 1, sf[(mt + 1) & 1], vf[(mt + 1) & 1]);
      __builtin_amdgcn_sched_barrier(0);
      o[mt] = zero16();
#pragma unroll
      for (int ks = 0; ks < 4; ++ks) o[mt] = MFMA(sf[mt & 1][ks], qf[ks], o[mt]);
#pragma unroll
      for (int kt = 0; kt < 2; ++kt)
        if (kt <= tt) {
#pragma unroll
          for (int s = 0; s < 2; ++s) o[mt] = MFMA(vf[mt & 1][2 * kt + s], pf[kt][s], o[mt]);
        }
      __builtin_amdgcn_sched_barrier(0);
    }
  }
  float ss = 0.f;
#pragma unroll
  for (int mt = 0; mt < 4; ++mt)
#pragma unroll
    for (int i = 0; i < 16; ++i) ss += o[mt][i] * o[mt][i];
  ss += __shfl_xor(ss, 32);
  const float rr = rsqrtf(ss * (1.0f / 128.0f) + EPSV);
  const size_t tok = (size_t)tile * 64 + 32 * tt + r;
  const u16* OG = (const u16*)(ws + OFF_OG) + tok * 512 + hd * 128;
#pragma unroll
  for (int mt = 0; mt < 4; ++mt)
#pragma unroll
    for (int g = 0; g < 4; ++g) {
      const int dv0 = 32 * mt + 8 * g + 4 * h;
      const ushort4 og4 = *(const ushort4*)(OG + dv0);
      const f4v gg = *(const f4v*)(p.g_gla + dv0);
      const float og[4] = {bf2f(og4.x), bf2f(og4.y), bf2f(og4.z), bf2f(og4.w)};
      f4v v;
#pragma unroll
      for (int j = 0; j < 4; ++j) v[j] = o[mt][4 * g + j] * rr * gg[j] * (og[j] / (1.0f + __expf(-og[j])));
      *(bf4*)(dst + (size_t)(32 * tt + r) * dst_ld + (hd * 128 + dv0) * 2) = cvt4(v);
    }
}
DI void gemm_1024(const char* ldsA, const bf8* __restrict__ wf, int wave, int lane, f16v (&a0)[2][2], f16v (&a1)[2][2]) {
  gemm_chunk<true>(ldsA, wf + 2 * wave * 64, lane, a0);
  gemm_chunk<true>(ldsA, wf + 65536 + 2 * wave * 64, lane, a1);
}
DI void gemm_1024_res(const char* ldsA, const bf8* __restrict__ wf, int wave, int lane, f16v (&a0)[2][2], f16v (&a1)[2][2],
                      const float* res) {
  gemm_chunk<true, true>(ldsA, wf + 2 * wave * 64, lane, a0, res + 64 * wave);
  gemm_chunk<true, true>(ldsA, wf + 65536 + 2 * wave * 64, lane, a1, res + 512 + 64 * wave);
}

DI void store_f32_ssq(const f16v (&a)[2][2], float* dst, int f0, int lane, float (&ssq)[2]) {
  const int r = lane & 31, h = lane >> 5;
#pragma unroll
  for (int ntl = 0; ntl < 2; ++ntl)
#pragma unroll
    for (int tt = 0; tt < 2; ++tt)
#pragma unroll
      for (int g = 0; g < 4; ++g) {
        f4v v = {a[ntl][tt][4 * g], a[ntl][tt][4 * g + 1], a[ntl][tt][4 * g + 2], a[ntl][tt][4 * g + 3]};
        ssq[tt] += v[0] * v[0] + v[1] * v[1] + v[2] * v[2] + v[3] * v[3];
        *(f4v*)(dst + (size_t)(32 * tt + r) * DM + f0 + 32 * ntl + 8 * g + 4 * h) = v;
      }
}

DI void acc_to_scratch(u16* scr, const f16v (&a)[2][2], int f0, int lane, float s0, float s1) {
  const int r = lane & 31, h = lane >> 5;
#pragma unroll
  for (int ntl = 0; ntl < 2; ++ntl)
#pragma unroll
    for (int tt = 0; tt < 2; ++tt)
#pragma unroll
      for (int g = 0; g < 4; ++g) {
        const float sc = tt ? s1 : s0;
        f4v v = {a[ntl][tt][4 * g] * sc, a[ntl][tt][4 * g + 1] * sc, a[ntl][tt][4 * g + 2] * sc, a[ntl][tt][4 * g + 3] * sc};
        *(bf4*)(scr + (size_t)(32 * tt + r) * 1024 + f0 + 32 * ntl + 8 * g + 4 * h) = cvt4(v);
      }
}
typedef __attribute__((ext_vector_type(4))) unsigned u4v;
DI void scratch_to_lds(const u16* scr, char* ldsA, int tid) {
  asm volatile("" : "+v"(tid));
  const unsigned toff = (unsigned)tid * 16u;
#pragma unroll
  for (int half = 0; half < 2; ++half) {
    u4v v[8];
#pragma unroll
    for (int it = 0; it < 8; ++it)
      v[it] = __builtin_nontemporal_load((const u4v*)((const char*)scr + (size_t)(8192 * (8 * half + it)) + toff));
#pragma unroll
    for (int it = 0; it < 8; ++it) {
      const int idx = tid + 512 * (8 * half + it), row = idx >> 7, ch = idx & 127;
      *(u4v*)(ldsA + row * LDS_ROW + ch * 16) = v[it];
    }
  }
}

struct Pk { bf4 v[2][2][4]; };
DI void pack_acc(Pk& pk, const f16v (&a)[2][2], float s0, float s1) {
#pragma unroll
  for (int ntl = 0; ntl < 2; ++ntl)
#pragma unroll
    for (int tt = 0; tt < 2; ++tt)
#pragma unroll
      for (int g = 0; g < 4; ++g) {
        const float sc = tt ? s1 : s0;
        f4v v = {a[ntl][tt][4 * g] * sc, a[ntl][tt][4 * g + 1] * sc, a[ntl][tt][4 * g + 2] * sc, a[ntl][tt][4 * g + 3] * sc};
        pk.v[ntl][tt][g] = cvt4(v);
      }
}
DI void pk_to_lds(char* ldsA, const Pk& pk, int f0, int lane) {
  const int r = lane & 31, h = lane >> 5;
#pragma unroll
  for (int ntl = 0; ntl < 2; ++ntl)
#pragma unroll
    for (int tt = 0; tt < 2; ++tt)
#pragma unroll
      for (int g = 0; g < 4; ++g)
        *(bf4*)(ldsA + (32 * tt + r) * LDS_ROW + (f0 + 32 * ntl + 8 * g + 4 * h) * 2) = pk.v[ntl][tt][g];
}

DI void rms_from_partials(float* red, int wave, int lane, const float (&ssq)[2], float& rs0, float& rs1) {
  red[(wave * 2 + 0) * 64 + lane] = ssq[0];
  red[(wave * 2 + 1) * 64 + lane] = ssq[1];
  __syncthreads();
  const int r = lane & 31;
  float t0 = 0.f, t1 = 0.f;
#pragma unroll
  for (int w = 0; w < 8; ++w) {
    t0 += red[(w * 2 + 0) * 64 + r] + red[(w * 2 + 0) * 64 + 32 + r];
    t1 += red[(w * 2 + 1) * 64 + r] + red[(w * 2 + 1) * 64 + 32 + r];
  }
  rs0 = rsqrtf(t0 * (1.0f / DM) + EPSV);
  rs1 = rsqrtf(t1 * (1.0f / DM) + EPSV);
}

template <bool WRITE = true>
DI void mem_attn(const MKParams& p, char* ldsA, int b, int wave, int lane) {
  char* ws = p.ws;
  const int r = lane & 31, h = lane >> 5;
  const int hm = wave >> 1, tt = wave & 1;
  const char* KM = ws + OFF_KM + (size_t)(b * 4 + hm) * 256 * 256 * 2;
  const char* VMT = ws + OFF_VMT + (size_t)(b * 4 + hm) * 256 * 256 * 2;
  char* qrow = ldsA + (32 * tt + r) * LDS_ROW + hm * 512;
  const unsigned loff = (unsigned)((r * 256 + 8 * h) * 2);
  f16v s[8];
#pragma unroll
  for (int mt = 0; mt < 8; ++mt) s[mt] = zero16();
  bf8 ka[8], kb[8];
#pragma unroll
  for (int mt = 0; mt < 8; ++mt) ka[mt] = *(const bf8*)(KM + (size_t)(mt * 32 * 256 * 2) + loff);
  bf8 qa = *(const bf8*)(qrow + 8 * h * 2), qb;
#pragma unroll 1
  for (int ks = 0; ks < 16; ks += 2) {
#pragma unroll
    for (int mt = 0; mt < 8; ++mt) kb[mt] = *(const bf8*)(KM + (size_t)((mt * 32 * 256 + 16 * (ks + 1)) * 2) + loff);
    qb = *(const bf8*)(qrow + (16 * (ks + 1) + 8 * h) * 2);
#pragma unroll
    for (int mt = 0; mt < 8; ++mt) s[mt] = MFMA(ka[mt], qa, s[mt]);
    __builtin_amdgcn_sched_group_barrier(0x020, 8, 0);
    __builtin_amdgcn_sched_group_barrier(0x100, 1, 0);
    __builtin_amdgcn_sched_group_barrier(0x008, 8, 0);
    if (ks + 2 < 16) {
#pragma unroll
      for (int mt = 0; mt < 8; ++mt) ka[mt] = *(const bf8*)(KM + (size_t)((mt * 32 * 256 + 16 * (ks + 2)) * 2) + loff);
      qa = *(const bf8*)(qrow + (16 * (ks + 2) + 8 * h) * 2);
    }
#pragma unroll
    for (int mt = 0; mt < 8; ++mt) s[mt] = MFMA(kb[mt], qb, s[mt]);
    __builtin_amdgcn_sched_group_barrier(0x020, 8, 0);
    __builtin_amdgcn_sched_group_barrier(0x100, 1, 0);
    __builtin_amdgcn_sched_group_barrier(0x008, 8, 0);
  }
  float mx = -INFINITY;
#pragma unroll
  for (int mt = 0; mt < 8; ++mt)
#pragma unroll
    for (int i = 0; i < 16; ++i) mx = fmaxf(mx, s[mt][i]);
  mx = fmaxf(mx, __shfl_xor(mx, 32));
  float l = 0.f;
  bf8 pf[8][2];
#pragma unroll
  for (int mt = 0; mt < 8; ++mt) {
#pragma unroll
    for (int i = 0; i < 16; ++i) { s[mt][i] = __expf(s[mt][i] - mx); l += s[mt][i]; }
    pf[mt][0] = pack8(s[mt], 0);
    pf[mt][1] = pack8(s[mt], 1);
  }
  l += __shfl_xor(l, 32);
  const float inv = 1.0f / l;
#pragma unroll
  for (int grp = 0; grp < 2; ++grp) {
    f16v o[4];
#pragma unroll
    for (int m4 = 0; m4 < 4; ++m4) o[m4] = zero16();
    const char* vb = VMT + (size_t)(grp * 4 * 32 * 256 * 2) + loff;
    bf8 va[4], vn[4];
#pragma unroll
    for (int m4 = 0; m4 < 4; ++m4) va[m4] = *(const bf8*)(vb + (size_t)(m4 * 32 * 256 * 2));
#pragma unroll
    for (int st = 0; st < 16; ++st) {
      if (st + 1 < 16) {
#pragma unroll
        for (int m4 = 0; m4 < 4; ++m4) vn[m4] = *(const bf8*)(vb + (size_t)((m4 * 32 * 256 + 16 * (st + 1)) * 2));
      }
#pragma unroll
      for (int m4 = 0; m4 < 4; ++m4) o[m4] = MFMA(va[m4], pf[st >> 1][st & 1], o[m4]);
      if (st + 1 < 16) {
        __builtin_amdgcn_sched_group_barrier(0x020, 4, 0);
        __builtin_amdgcn_sched_group_barrier(0x008, 4, 0);
#pragma unroll
        for (int m4 = 0; m4 < 4; ++m4) va[m4] = vn[m4];
      }
    }
#pragma unroll
    for (int m4 = 0; m4 < 4; ++m4)
#pragma unroll
      for (int g = 0; g < 4; ++g) {
        f4v v = {o[m4][4 * g] * inv, o[m4][4 * g + 1] * inv, o[m4][4 * g + 2] * inv, o[m4][4 * g + 3] * inv};
        if (WRITE || v[0] == 123.456f) *(bf4*)(qrow + (32 * (4 * grp + m4) + 8 * g + 4 * h) * 2) = cvt4(v);
      }
  }
}

DI void phase_c_tile(const MKParams& p, int tile, int wave, int lane, float& rs0, float& rs1) {
  asm volatile("" : "+v"(lane));
  char* ws = p.ws;
  char* ldsA = smem;
  float* red = (float*)(smem + LDS_A_BYTES);
  const size_t tok0 = (size_t)tile * 64;
  const int tid = wave * 64 + lane;
  __syncthreads();
#if PROBE == 15
  gla_g3_tile(p, tile, wave, lane, ldsA, LDS_ROW);
  __builtin_amdgcn_sched_barrier(0);
  asm volatile("" : "+v"(lane));
#endif
  {
  gla_g3_tile(p, tile, wave, lane, ldsA, LDS_ROW);
  {
    const char* osb = ws + OFF_OSB + tok0 * 1024;
#pragma unroll
    for (int it = 0; it < 8; ++it) {
      const int idx = tid + 512 * it, row = idx >> 6, ch = idx & 63;
      *(uint4*)(ldsA + row * LDS_ROW + 1024 + ch * 16) = *(const uint4*)(osb + (size_t)row * 1024 + ch * 16);
    }
  }
  }
  __syncthreads();
  f16v acc[2][2];
  Ring rg;
  Pk pk0, pk1;
  float* hdst = p.out + tok0 * DM;
  {
    float ssq[2] = {0.f, 0.f};
    const bf8* wf = (const bf8*)(ws + OFF_WOUT);
    asm volatile("" : "+v"(lane));
    gemm_chunk_r<true, true, true, true>(ldsA, wf + 2 * wave * 64, wf + 65536 + 2 * wave * 64, lane, acc, rg, p.x + tok0 * DM + 64 * wave);
    store_f32_ssq(acc, hdst, 64 * wave, lane, ssq);
    pack_acc(pk0, acc, 1.f, 1.f);
    asm volatile("" : "+v"(lane));
    gemm_chunk_r<true, true, false, true>(ldsA, wf + 65536 + 2 * wave * 64, (const bf8*)(ws + OFF_WMQ) + 2 * wave * 64, lane, acc, rg, p.x + tok0 * DM + 512 + 64 * wave);
    store_f32_ssq(acc, hdst, 512 + 64 * wave, lane, ssq);
    pack_acc(pk1, acc, 1.f, 1.f);
    rms_from_partials(red, wave, lane, ssq, rs0, rs1);
  }
  pk_to_lds(ldsA, pk0, 64 * wave, lane);
  pk_to_lds(ldsA, pk1, 512 + 64 * wave, lane);
  __syncthreads();
  {
    const bf8* wf = (const bf8*)(ws + OFF_WMQ);
    asm volatile("" : "+v"(lane));
    gemm_chunk_r<true, false, false, true>(ldsA, wf + 2 * wave * 64, wf + 65536 + 2 * wave * 64, lane, acc, rg);
    pack_acc(pk0, acc, rs0, rs1);
    asm volatile("" : "+v"(lane));
    gemm_chunk_r<true, false, false, false>(ldsA, wf + 65536 + 2 * wave * 64, nullptr, lane, acc, rg);
    pack_acc(pk1, acc, rs0, rs1);
  }
  __syncthreads();
  pk_to_lds(ldsA, pk0, 64 * wave, lane);
  pk_to_lds(ldsA, pk1, 512 + 64 * wave, lane);
  __syncthreads();
#if PROBE == 22
  asm volatile("" : "+v"(lane));
  mem_attn<false>(p, ldsA, tile >> 5, wave, lane);
#endif
  asm volatile("" : "+v"(lane));
  mem_attn<true>(p, ldsA, tile >> 5, wave, lane);
  __syncthreads();
  {
    float ssq[2] = {0.f, 0.f};
    const bf8* wf = (const bf8*)(ws + OFF_WMO);
    asm volatile("" : "+v"(lane));
    gemm_chunk_r<true, true, true, true>(ldsA, wf + 2 * wave * 64, wf + 65536 + 2 * wave * 64, lane, acc, rg, hdst + 64 * wave);
    store_f32_ssq(acc, hdst, 64 * wave, lane, ssq);
    pack_acc(pk0, acc, 1.f, 1.f);
    asm volatile("" : "+v"(lane));
    gemm_chunk_r<true, true, false, false>(ldsA, wf + 65536 + 2 * wave * 64, nullptr, lane, acc, rg, hdst + 512 + 64 * wave);
    store_f32_ssq(acc, hdst, 512 + 64 * wave, lane, ssq);
    pack_acc(pk1, acc, 1.f, 1.f);
    rms_from_partials(red, wave, lane, ssq, rs0, rs1);
  }
  pk_to_lds(ldsA, pk0, 64 * wave, lane);
  pk_to_lds(ldsA, pk1, 512 + 64 * wave, lane);
  __syncthreads();
}
#define OFF_EG (OFF_LKV + 16 * MiB)

DI unsigned f2ord(float v) { const unsigned u = __float_as_uint(v); return (u & 0x80000000u) ? ~u : (u | 0x80000000u); }
DI float ord2f(unsigned u) { return __uint_as_float((u & 0x80000000u) ? (u ^ 0x80000000u) : ~u); }

DI void ins16(unsigned (&L)[16], unsigned x) {
#pragma unroll
  for (int s = 0; s < 16; ++s) {
    const unsigned hi = max(L[s], x);
    x = min(L[s], x);
    L[s] = hi;
  }
}
DI void merge_halves16(unsigned (&L)[16]) {
  unsigned O[16];
#pragma unroll
  for (int s = 0; s < 16; ++s) O[s] = (unsigned)__shfl_xor((int)L[s], 32);
#pragma unroll
  for (int s = 0; s < 16; ++s) L[s] = max(L[s], O[15 - s]);
#pragma unroll
  for (int d = 8; d > 0; d >>= 1)
#pragma unroll
    for (int i = 0; i < 16; ++i)
      if ((i & d) == 0) {
        const unsigned hi = max(L[i], L[i + d]), lo = min(L[i], L[i + d]);
        L[i] = hi; L[i + d] = lo;
      }
}

DI void peer_top16(const char* ws, const u16* qp, int hp, int tt, int lane, unsigned (&L)[16]) {
  const int r = lane & 31, h = lane >> 5;
  const bf8* sk = (const bf8*)(ws + OFF_SUBK) + (size_t)hp * 4 * 8 * 64 + lane;
  f16v s[4];
#pragma unroll
  for (int mt = 0; mt < 4; ++mt) s[mt] = zero16();
  bf8 qf[8];
#pragma unroll
  for (int ks = 0; ks < 8; ++ks) qf[ks] = *(const bf8*)(qp + (size_t)(32 * tt + r) * 2048 + hp * 128 + 16 * ks + 8 * h);
#pragma unroll
  for (int half = 0; half < 2; ++half) {
    bf8 kf[4][4];
#pragma unroll
    for (int k4 = 0; k4 < 4; ++k4)
#pragma unroll
      for (int mt = 0; mt < 4; ++mt) kf[k4][mt] = sk[(mt * 8 + 4 * half + k4) * 64];
    __builtin_amdgcn_sched_barrier(0);
#pragma unroll
    for (int k4 = 0; k4 < 4; ++k4)
#pragma unroll
      for (int mt = 0; mt < 4; ++mt) s[mt] = MFMA(kf[k4][mt], qf[4 * half + k4], s[mt]);
    __builtin_amdgcn_sched_barrier(0);
  }
#pragma unroll
  for (int i = 0; i < 16; ++i) L[i] = 0u;
#pragma unroll
  for (int mt = 0; mt < 4; ++mt)
#pragma unroll
    for (int i = 0; i < 16; ++i) {
      const unsigned key = (f2ord(s[mt][i]) & ~127u) | (unsigned)(127 - (32 * mt + crow(i, h)));
      ins16(L, key);
    }
  merge_halves16(L);
}

DI void peer_select(const char* ws, const u16* qp, uint2* eg, unsigned char* idxs  , int head,
                    int tt, int lane) {
  const int r = lane & 31, h = lane >> 5;
  unsigned La[16], Lb[16];
  peer_top16(ws, qp, 2 * head, tt, lane, La);
  __builtin_amdgcn_sched_barrier(0);
  peer_top16(ws, qp, 2 * head + 1, tt, lane, Lb);
  __builtin_amdgcn_sched_barrier(0);
  if (h == 0) {
#pragma unroll
    for (int g = 0; g < 4; ++g) {
      unsigned wa = 0, wb = 0;
#pragma unroll
      for (int j = 0; j < 4; ++j) {
        wa |= (127u - (La[4 * g + j] & 127u)) << (8 * j);
        wb |= (127u - (Lb[4 * g + j] & 127u)) << (8 * j);
      }
      *(unsigned*)(idxs + r * 32 + 4 * g) = wa;
      *(unsigned*)(idxs + r * 32 + 16 + 4 * g) = wb;
    }
  }
  float fa[16], fb[16];
#pragma unroll
  for (int i = 0; i < 16; ++i) { fa[i] = ord2f(La[i] & ~127u); fb[i] = ord2f(Lb[i] & ~127u); }
  unsigned C[16];
#pragma unroll
  for (int i = 0; i < 16; ++i) C[i] = 0u;
#define PEER_CAND(a, b) ins16(C, (f2ord(fa[a] + fb[b]) & ~255u) | (unsigned)(255 - ((a) * 16 + (b))));
#define PEER_ROW1(a) PEER_CAND(a, 0)
#define PEER_ROW2(a) PEER_ROW1(a) PEER_CAND(a, 1)
#define PEER_ROW3(a) PEER_ROW2(a) PEER_CAND(a, 2)
#define PEER_ROW4(a) PEER_ROW3(a) PEER_CAND(a, 3)
#define PEER_ROW5(a) PEER_ROW4(a) PEER_CAND(a, 4)
#define PEER_ROW8(a) PEER_ROW5(a) PEER_CAND(a, 5) PEER_CAND(a, 6) PEER_CAND(a, 7)
#define PEER_ROW16(a) PEER_ROW8(a) PEER_CAND(a, 8) PEER_CAND(a, 9) PEER_CAND(a, 10) PEER_CAND(a, 11) PEER_CAND(a, 12) PEER_CAND(a, 13) PEER_CAND(a, 14) PEER_CAND(a, 15)
  PEER_ROW16(0) PEER_ROW8(1) PEER_ROW5(2) PEER_ROW4(3) PEER_ROW3(4) PEER_ROW2(5) PEER_ROW2(6) PEER_ROW2(7)
  PEER_ROW1(8) PEER_ROW1(9) PEER_ROW1(10) PEER_ROW1(11) PEER_ROW1(12) PEER_ROW1(13) PEER_ROW1(14) PEER_ROW1(15)
  asm volatile("s_waitcnt lgkmcnt(0)" ::: "memory");
  const float vmax = ord2f(C[0] & ~255u);
  float ex[16], sum = 0.f;
#pragma unroll
  for (int i = 0; i < 16; ++i) { ex[i] = __expf(ord2f(C[i] & ~255u) - vmax); sum += ex[i]; }
  const float inv = 1.0f / sum;
  const unsigned hmask = 0u - (unsigned)h;
#pragma unroll
  for (int i = 0; i < 8; ++i) {
    const unsigned ck = C[i] ^ ((C[i] ^ C[8 + i]) & hmask);
    const unsigned gb = __float_as_uint(ex[i]) ^ ((__float_as_uint(ex[i]) ^ __float_as_uint(ex[8 + i])) & hmask);
    const float g = __uint_as_float(gb) * inv;
    const unsigned code = 255u - (ck & 255u);
    const unsigned ia = idxs[r * 32 + (code >> 4)], ib = idxs[r * 32 + 16 + (code & 15u)];
    eg[(size_t)(32 * tt + r) * 128 + head * 16 + 8 * h + i] = make_uint2(ia * 128u + ib, __float_as_uint(g));
  }
  asm volatile("s_waitcnt lgkmcnt(0)" ::: "memory");
}

DI float wave_sum(float v) {
#pragma unroll
  for (int o = 32; o > 0; o >>= 1) v += __shfl_xor(v, o);
  return v;
}

DI void reduce8(const float (&pv)[8], float& s0, float& s1) {
  float q[4], s[2];
#pragma unroll
  for (int m = 0; m < 4; ++m) {
    const auto r = __builtin_amdgcn_permlane32_swap(__float_as_uint(pv[m]), __float_as_uint(pv[m + 4]), false, false);
    q[m] = __uint_as_float(r[0]) + __uint_as_float(r[1]);
  }
#pragma unroll
  for (int m = 0; m < 2; ++m) {
    const auto r = __builtin_amdgcn_permlane16_swap(__float_as_uint(q[m]), __float_as_uint(q[m + 2]), false, false);
    s[m] = __uint_as_float(r[0]) + __uint_as_float(r[1]);
  }
#pragma unroll
  for (int m = 0; m < 2; ++m) {
    s[m] += __uint_as_float(__builtin_amdgcn_update_dpp(0, __float_as_uint(s[m]), 0x128, 0xf, 0xf, false));
    s[m] += __uint_as_float(__builtin_amdgcn_update_dpp(0, __float_as_uint(s[m]), 0x124, 0xf, 0xf, false));
    s[m] += __uint_as_float(__builtin_amdgcn_update_dpp(0, __float_as_uint(s[m]), 0x122, 0xf, 0xf, false));
    s[m] += __uint_as_float(__builtin_amdgcn_update_dpp(0, __float_as_uint(s[m]), 0x121, 0xf, 0xf, false));
  }
  s0 = s[0]; s1 = s[1];
}

DI void peer_bucket_token(const uint2* egt, unsigned* tmp  , int lane, unsigned& E0, unsigned& E1,
                          unsigned& G0, unsigned& G1) {
  const uint2 a = egt[lane], b = egt[64 + lane];
  const int ba = (int)(a.x >> 10), bb = (int)(b.x >> 10);
  const unsigned long long lt = (1ull << lane) - 1ull;
  int da = 0, db = 0, start = 0;
#pragma unroll
  for (int k = 0; k < 16; ++k) {
    const unsigned long long ma = __ballot(ba == k), mb = __ballot(bb == k);
    const int ca = __popcll(ma), cb = __popcll(mb);
    if (ba == k) da = start + __popcll(ma & lt);
    if (bb == k) db = start + ca + __popcll(mb & lt);
    start += ca + cb;
  }
  const int ia = (da & 1) * 64 + (da >> 3) + 16 * ((da >> 1) & 3);
  const int ib = (db & 1) * 64 + (db >> 3) + 16 * ((db >> 1) & 3);
  tmp[ia] = a.x; tmp[128 + ia] = a.y;
  tmp[ib] = b.x; tmp[128 + ib] = b.y;
  asm volatile("s_waitcnt lgkmcnt(0)" ::: "memory");
  E0 = tmp[lane]; E1 = tmp[64 + lane]; G0 = tmp[128 + lane]; G1 = tmp[192 + lane];
  asm volatile("s_waitcnt lgkmcnt(0)" ::: "memory");
}

template <bool GWRITE = true>
DI void peer_finalize_token(const MKParams& p, float (&acc)[16], size_t tok, int lane) {
  float* orow = p.out + tok * DM + 16 * lane;
  float ss = 0.f;
#pragma unroll
  for (int q = 0; q < 4; ++q) {
    const f4v hv = *(const f4v*)(orow + 4 * q);
#pragma unroll
    for (int j = 0; j < 4; ++j) { acc[4 * q + j] += hv[j]; ss += acc[4 * q + j] * acc[4 * q + j]; }
  }
  ss = wave_sum(ss);
  const float rf = rsqrtf(ss * (1.0f / DM) + EPSV);
#pragma unroll
  for (int q = 0; q < 4; ++q) {
    const f4v gg = *(const f4v*)(p.g_fin + 16 * lane + 4 * q);
    f4v o = {acc[4 * q] * rf * gg[0], acc[4 * q + 1] * rf * gg[1], acc[4 * q + 2] * rf * gg[2], acc[4 * q + 3] * rf * gg[3]};
    if (GWRITE || o[0] == 123.456f) *(f4v*)(orow + 4 * q) = o;
  }
}

DI void peer_usweep(const char* ws, const char* ldsA, int wave, int lane, const unsigned (&E)[8][2], float (&A)[8][2]) {
  const char* PU = ws + OFF_PU + 16 * lane;
#pragma unroll
  for (int i = 0; i < 8; ++i) { A[i][0] = 0.f; A[i][1] = 0.f; }
  int jn[8];
#pragma unroll
  for (int i = 0; i < 8; ++i) jn[i] = 0;
#pragma unroll 1
  for (int k = 0; k < 16; ++k) {
#pragma unroll
    for (int i = 0; i < 8; ++i) {
      while (jn[i] < 16 && (__builtin_amdgcn_readlane((int)E[i][0], jn[i]) >> 10) <= k) {
        const int j = jn[i];
        const bool sel = ((lane & 15) == j);
        const char* xrow = ldsA + (8 * wave + i) * LDS_ROW + 32 * lane;
        const uint4 x0 = *(const uint4*)xrow, x1 = *(const uint4*)(xrow + 16);
        const unsigned xr[8] = {x0.x, x0.y, x0.z, x0.w, x1.x, x1.y, x1.z, x1.w};
        uint4 u0[8];
#pragma unroll
        for (int m = 0; m < 8; ++m) {
          const int e = __builtin_amdgcn_readlane((int)E[i][m & 1], j + 16 * (m >> 1));
          u0[m] = *(const uint4*)(PU + (size_t)e * 1024);
        }
        float pv[8];
#pragma unroll
        for (int m = 0; m < 8; ++m) {
          const unsigned uw[4] = {u0[m].x, u0[m].y, u0[m].z, u0[m].w};
          float dsum = 0.f;
#pragma unroll
          for (int q = 0; q < 4; ++q) {
            const bf2 lo = __builtin_amdgcn_cvt_scalef32_pk_bf16_fp8(uw[q], 1.0f, false);
            const bf2 hi = __builtin_amdgcn_cvt_scalef32_pk_bf16_fp8(uw[q], 1.0f, true);
            dsum = __builtin_amdgcn_fdot2_f32_bf16(lo, __builtin_bit_cast(bf2, xr[2 * q]), dsum, false);
            dsum = __builtin_amdgcn_fdot2_f32_bf16(hi, __builtin_bit_cast(bf2, xr[2 * q + 1]), dsum, false);
          }
#if PROBE == 30
          {
            unsigned uw2[4] = {uw[0], uw[1], uw[2], uw[3]};
            asm volatile("" : "+v"(uw2[0]), "+v"(uw2[1]), "+v"(uw2[2]), "+v"(uw2[3]));
            float d2 = 0.f;
#pragma unroll
            for (int q = 0; q < 4; ++q) {
              const bf2 lo = __builtin_amdgcn_cvt_scalef32_pk_bf16_fp8(uw2[q], 1.0f, false);
              const bf2 hi = __builtin_amdgcn_cvt_scalef32_pk_bf16_fp8(uw2[q], 1.0f, true);
              d2 = __builtin_amdgcn_fdot2_f32_bf16(lo, __builtin_bit_cast(bf2, xr[2 * q]), d2, false);
              d2 = __builtin_amdgcn_fdot2_f32_bf16(hi, __builtin_bit_cast(bf2, xr[2 * q + 1]), d2, false);
            }
            dsum = 0.5f * (dsum + d2);
          }
#endif
          pv[m] = dsum;
        }
        float s0, s1;
        reduce8(pv, s0, s1);
        A[i][0] = sel ? s0 : A[i][0];
        A[i][1] = sel ? s1 : A[i][1];
        jn[i] = j + 1;
      }
    }
  }
}

template <int T0, bool GWRITE = true>
DI void peer_vsweep(const MKParams& p, int wave, int lane, size_t tok0, const unsigned (&E)[8][2], const unsigned (&Wb)[8][2]) {
  const char* PV = p.ws + OFF_PV + 16 * lane;
  f2v acc2[4][8];
#pragma unroll
  for (int i = 0; i < 4; ++i)
#pragma unroll
    for (int q = 0; q < 8; ++q) acc2[i][q] = (f2v){0.f, 0.f};
  int jn[4];
#pragma unroll
  for (int i = 0; i < 4; ++i) jn[i] = 0;
#pragma unroll 1
  for (int k = 0; k < 16; ++k) {
#pragma unroll
    for (int i = 0; i < 4; ++i) {
      while (jn[i] < 16 && (__builtin_amdgcn_readlane((int)E[T0 + i][0], jn[i]) >> 10) <= k) {
        const int j = jn[i];
        uint4 v0[8];
        float wl[8];
#pragma unroll
        for (int m = 0; m < 8; ++m) {
          const int e = __builtin_amdgcn_readlane((int)E[T0 + i][m & 1], j + 16 * (m >> 1));
          wl[m] = __uint_as_float((unsigned)__builtin_amdgcn_readlane((int)Wb[T0 + i][m & 1], j + 16 * (m >> 1)));
          v0[m] = *(const uint4*)(PV + (size_t)e * 1024);
        }
#pragma unroll
        for (int m = 0; m < 8; ++m) {
          const unsigned vw[4] = {v0[m].x, v0[m].y, v0[m].z, v0[m].w};
          const f2v ww = {wl[m], wl[m]};
#pragma unroll
          for (int q = 0; q < 4; ++q) {
            const f2v lo = __builtin_amdgcn_cvt_pk_f32_fp8((int)vw[q], false);
            const f2v hi = __builtin_amdgcn_cvt_pk_f32_fp8((int)vw[q], true);
            acc2[i][2 * q] = __builtin_elementwise_fma(lo, ww, acc2[i][2 * q]);
            acc2[i][2 * q + 1] = __builtin_elementwise_fma(hi, ww, acc2[i][2 * q + 1]);
          }
        }
        jn[i] = j + 1;
      }
    }
  }
#pragma unroll
  for (int i = 0; i < 4; ++i) {
    float acc[16];
#pragma unroll
    for (int q = 0; q < 8; ++q) { acc[2 * q] = acc2[i][q][0]; acc[2 * q + 1] = acc2[i][q][1]; }
    peer_finalize_token<GWRITE>(p, acc, tok0 + 8 * wave + T0 + i, lane);
  }
}

DI void phase_d_tile(const MKParams& p, int tile, int wave, int lane, float rs0, float rs1) {
  asm volatile("" : "+v"(lane));
  char* ws = p.ws;
  char* ldsA = smem;
  float* rs_s = (float*)(smem + LDS_A_BYTES);
  unsigned char* idxs = (unsigned char*)(smem + LDS_A_BYTES + 4096) + wave * 1024;
  u16* qp = (u16*)qp_scratch(ws, blockIdx.x);
  uint2* eg = (uint2*)(ws + OFF_EG + (size_t)blockIdx.x * 65536);
  const size_t tok0 = (size_t)tile * 64;
  if (wave == 0) { if (lane < 32) rs_s[lane] = rs0; else rs_s[lane] = rs1; }
  {
    f16v acc[2][2];
    Ring rg;
    const bf8* wf = (const bf8*)(ws + OFF_WPQ);
#if PROBE == 17
    for (int rep_ = 0; rep_ < 2; ++rep_)
#endif
#pragma unroll 1
    for (int c = 0; c < 4; ++c) {
      int l2 = lane;
      asm volatile("" : "+v"(l2));
      const int r = l2 & 31, h = l2 >> 5;
      if (c == 0) gemm_chunk_r<true, false, true, true>(ldsA, wf + 2 * wave * 64, wf + 65536 + 2 * wave * 64, l2, acc, rg);
      else if (c < 3) gemm_chunk_r<true, false, false, true>(ldsA, wf + (size_t)c * 65536 + 2 * wave * 64, wf + (size_t)(c + 1) * 65536 + 2 * wave * 64, l2, acc, rg);
      else gemm_chunk_r<true, false, false, false>(ldsA, wf + (size_t)c * 65536 + 2 * wave * 64, nullptr, l2, acc, rg);
#pragma unroll
      for (int ntl = 0; ntl < 2; ++ntl)
#pragma unroll
        for (int tt = 0; tt < 2; ++tt)
#pragma unroll
          for (int g = 0; g < 4; ++g) {
            const float sc = tt ? rs1 : rs0;
            f4v v = {acc[ntl][tt][4 * g] * sc, acc[ntl][tt][4 * g + 1] * sc, acc[ntl][tt][4 * g + 2] * sc, acc[ntl][tt][4 * g + 3] * sc};
            *(bf4*)(qp + (size_t)(32 * tt + r) * 2048 + 512 * c + 64 * wave + 32 * ntl + 8 * g + 4 * h) = cvt4(v);
          }
    }
  }
  __syncthreads();
#if PROBE == 16
  for (int rep_ = 0; rep_ < 2; ++rep_)
#endif
#pragma unroll 1
  for (int tt = 0; tt < 2; ++tt) {
    int l2 = lane;
    asm volatile("" : "+v"(l2));
    peer_select(ws, qp, eg, idxs, wave, tt, l2);
  }
  __syncthreads();
}

template <bool GWRITE = true>
DI void phase_d_gather(const MKParams& p, int tile, int wave, int lane) {
  asm volatile("" : "+v"(lane));
  char* ws = p.ws;
  char* ldsA = smem;
  float* rs_s = (float*)(smem + LDS_A_BYTES);
  unsigned char* idxs = (unsigned char*)(smem + LDS_A_BYTES + 4096) + wave * 1024;
  const uint2* eg = (const uint2*)(ws + OFF_EG + (size_t)blockIdx.x * 65536);
  const size_t tok0 = (size_t)tile * 64;
  {
    int l2 = lane;
    asm volatile("" : "+v"(l2));
    unsigned E[8][2], G[8][2];
#pragma unroll
    for (int i = 0; i < 8; ++i)
      peer_bucket_token(eg + (size_t)(8 * wave + i) * 128, (unsigned*)idxs, l2, E[i][0], E[i][1], G[i][0], G[i][1]);
    float A[8][2];
    peer_usweep(ws, ldsA, wave, l2, E, A);
    unsigned Wb[8][2];
#pragma unroll
    for (int i = 0; i < 8; ++i) {
      const float rs = rs_s[8 * wave + i];
#pragma unroll
      for (int cc = 0; cc < 2; ++cc) {
        const float a = A[i][cc] * rs * ((const float*)(ws + OFF_SU))[E[i][cc]];
        const float w = __uint_as_float(G[i][cc]) * 0.5f * a * (1.0f + erff(a * 0.70710678118654752f)) *
                        ((const float*)(ws + OFF_SV))[E[i][cc]];
        Wb[i][cc] = __float_as_uint(w);
      }
    }
    __builtin_amdgcn_sched_barrier(0);
    peer_vsweep<0, GWRITE>(p, wave, l2, tok0, E, Wb);
    __builtin_amdgcn_sched_barrier(0);
    peer_vsweep<4, GWRITE>(p, wave, l2, tok0, E, Wb);
  }
}
#ifndef REMAP
#define REMAP 1
#endif
DI int tile_of(int blk, int nblk) { return (REMAP && nblk == 256) ? ((blk & 7) * 32 + (blk >> 3)) : blk; }

__global__ __launch_bounds__(512) void mk(MKParams p) {
  cg::grid_group grid = cg::this_grid();
  const int tid = threadIdx.x;
  const int wave = __builtin_amdgcn_readfirstlane(tid >> 6), lane = tid & 63;
  const int gtid = blockIdx.x * 512 + tid, gthreads = gridDim.x * 512;
  const int gw = blockIdx.x * 8 + wave, nw = gridDim.x * 8;
  unsigned* bar = (unsigned*)(p.ws + OFF_BAR);
  phase_prep(p, gtid, gthreads);
#if !TABLES_IN_B
  phase_prep_tables(p, gw, nw, lane);
#endif
#if FIRST_CG
  grid.sync();
#else
  grid_barrier(bar, 1u * gridDim.x);
#endif
  for (int tile = blockIdx.x; tile < 256; tile += gridDim.x) phase_a_tile(p, tile_of(tile, gridDim.x), wave, lane);
#if PROBE == 40
  for (int tile = blockIdx.x; tile < 256; tile += gridDim.x) phase_a_tile(p, tile_of(tile, gridDim.x), wave, lane);
#endif
  for (int item = blockIdx.x; item < 128; item += gridDim.x) phase_a_memkv(p, item, wave, lane);
#if PROBE == 13
  for (int item = blockIdx.x; item < 128; item += gridDim.x) phase_a_memkv(p, item, wave, lane);
#endif
  grid_barrier(bar, (2u - FIRST_CG) * gridDim.x);
  for (int it = gw; it < 4096; it += nw) sb_item(p, it, lane);
#if PROBE == 44
  for (int it = gw; it < 4096; it += nw) sb_item(p, it, lane);
  phase_prep_tables(p, gw, nw, lane);
#endif
  for (int it = nw - 1 - gw; it < 1024; it += nw) gla_g1_item(p, it, wave, lane);
#if TABLES_IN_B
  phase_prep_tables(p, gw, nw, lane);
#endif
  grid_barrier(bar, (3u - FIRST_CG) * gridDim.x);
  gla_g2(p, gtid, gthreads);
#if PROBE == 14
  gla_g2(p, gtid, gthreads);
#endif
#if PROBE == 18
  grid.sync(); grid.sync(); grid.sync(); grid.sync();
#endif
  grid_barrier(bar, (4u - FIRST_CG) * gridDim.x);
  for (int t0 = blockIdx.x; t0 < 256; t0 += gridDim.x) {
    const int tile = tile_of(t0, gridDim.x);
    float rs0, rs1;
#if PROBE == 41
    phase_c_tile(p, tile, wave, lane, rs0, rs1);
#endif
    phase_c_tile(p, tile, wave, lane, rs0, rs1);
#if PROBE == 42
    phase_d_tile(p, tile, wave, lane, rs0, rs1);
#endif
    phase_d_tile(p, tile, wave, lane, rs0, rs1);
#if GATHER_ALIGN
    grid_barrier(bar, (5u - FIRST_CG) * gridDim.x);
#endif
#if PROBE == 43
    phase_d_gather<false>(p, tile, wave, lane);
#endif
    phase_d_gather<true>(p, tile, wave, lane);
  }
#if !FIRST_CG
  grid.sync();
#endif
}
#define MK_LDS (160 * 1024)
extern "C" void kernel_launch(void* const* d_in, const int* in_sizes, int n_in, void* d_out, int out_size, void* d_ws,
                              size_t ws_size, hipStream_t stream) {
  MKParams p{};
  p.x = (const float*)d_in[0]; p.mem = (const float*)d_in[1]; p.g_mix = (const float*)d_in[2];
  p.w_in = (const float*)d_in[3]; p.w_up = (const float*)d_in[4]; p.b_alpha = (const float*)d_in[5];
  p.g_gla = (const float*)d_in[6]; p.w_out = (const float*)d_in[7]; p.g_mq = (const float*)d_in[8];
  p.g_mkv = (const float*)d_in[9]; p.w_mq = (const float*)d_in[10]; p.w_mkv = (const float*)d_in[11];
  p.w_mo = (const float*)d_in[12]; p.g_ffn = (const float*)d_in[13]; p.w_pq = (const float*)d_in[14];
  p.subk = (const float*)d_in[15]; p.pu = (const float*)d_in[16]; p.pv = (const float*)d_in[17];
  p.g_fin = (const float*)d_in[18];
  p.out = (float*)d_out; p.ws = (char*)d_ws;
  float* out = (float*)d_out;
  char* wsb = (char*)d_ws;
  float* ws = (float*)d_ws;
  static int grid_blocks = 0;
  if (!grid_blocks) {
    int dev = 0, cus = 0, per_cu = 0;
    (void)hipGetDevice(&dev);
    (void)hipDeviceGetAttribute(&cus, hipDeviceAttributeMultiprocessorCount, dev);
    (void)hipFuncSetAttribute((const void*)mk, hipFuncAttributeMaxDynamicSharedMemorySize, MK_LDS);
    (void)hipOccupancyMaxActiveBlocksPerMultiprocessor(&per_cu, mk, 512, MK_LDS);
    grid_blocks = cus * per_cu;
    fprintf(stderr, "mk: cus=%d per_cu=%d grid=%d ws=%zu\n", cus, per_cu, grid_blocks, ws_size);
  }
  (void)hipMemsetAsync((char*)d_ws + OFF_BAR, 0, 64, stream);
  {
    void* args[] = {(void*)&p};
    hipError_t e = hipLaunchCooperativeKernel((const void*)mk, dim3(grid_blocks), dim3(512), args, MK_LDS, stream);
    if (e != hipSuccess) fprintf(stderr, "coop launch failed: %s grid %d\n", hipGetErrorString(e), grid_blocks);
  }
}
```

```cpp
#define GEMM_D 8
#define TABLES_IN_B 1
#define REMAP 0
#define FIRST_CG 1
#define GATHER_ALIGN 0
#include <hip/hip_runtime.h>
#include <hip/hip_cooperative_groups.h>
#include <math.h>
#include <stdio.h>
#include <stdint.h>
namespace cg = cooperative_groups;

#ifndef PROBE
#define PROBE 0
#endif
#ifndef TABLES_IN_B
#define TABLES_IN_B 1
#endif
#define NB 8
#define SEQ 2048
#define DM 1024
#define NTOK (NB * SEQ)
#define INC 3088
#define MEML 256
#define EPSV 1e-6f

typedef __attribute__((ext_vector_type(8))) __bf16 bf8;
typedef __attribute__((ext_vector_type(4))) __bf16 bf4;
typedef __attribute__((ext_vector_type(2))) __bf16 bf2;
typedef __attribute__((ext_vector_type(16))) float f16v;
typedef __attribute__((ext_vector_type(8))) float f8v;
typedef __attribute__((ext_vector_type(4))) float f4v;
typedef __attribute__((ext_vector_type(2))) float f2v;
typedef unsigned short u16;

#define DI __device__ __forceinline__
#define MFMA(a, b, c) __builtin_amdgcn_mfma_f32_32x32x16_bf16((a), (b), (c), 0, 0, 0)

DI int crow(int i, int h) { return (i & 3) + 8 * (i >> 2) + 4 * h; }
DI int tpos(int t) { return (t & ~12) | ((t & 4) << 1) | ((t & 8) >> 1); }
DI float bf2f(u16 v) { return __uint_as_float(((unsigned)v) << 16); }
DI bf8 cvt8(f8v v) { return __builtin_convertvector(v, bf8); }
DI bf4 cvt4(f4v v) { return __builtin_convertvector(v, bf4); }
DI f16v zero16() { f16v z = {0.f, 0.f, 0.f, 0.f, 0.f, 0.f, 0.f, 0.f, 0.f, 0.f, 0.f, 0.f, 0.f, 0.f, 0.f, 0.f}; return z; }

#define MiB ((size_t)1 << 20)
#define OFF_WIN   ((size_t)0)
#define OFF_WOUT  (OFF_WIN + 97 * 65536)
#define OFF_WMQ   (OFF_WOUT + 32 * 65536)
#define OFF_WMKV  (OFF_WMQ + 32 * 65536)
#define OFF_WMO   (OFF_WMKV + 64 * 65536)
#define OFF_WPQ   (OFF_WMO + 32 * 65536)
#define OFF_SUBK  (OFF_WPQ + 64 * 65536)
#define OFF_ACT   (21 * MiB)
#define OFF_GQ    (OFF_ACT)
#define OFF_GK    (OFF_GQ + 8 * MiB)
#define OFF_GVT   (OFF_GK + 8 * MiB)
#define OFF_OG    (OFF_GVT + 16 * MiB)
#define OFF_SQ    (OFF_OG + 16 * MiB)
#define OFF_SK    (OFF_SQ + 16 * MiB)
#define OFF_SVT   (OFF_SK + 16 * MiB)
#define OFF_LA    (OFF_SVT + 16 * MiB)
#define OFF_LKV   (OFF_LA + 16 * MiB)
#define OFF_DD    (OFF_LKV + 32 * MiB)
#define OFF_OSB   (OFF_DD + 1 * MiB)
#define OFF_KM    (OFF_OSB + 16 * MiB)
#define OFF_VMT   (OFF_KM + 4 * MiB)
#define OFF_PU    (OFF_VMT + 4 * MiB)
#define OFF_PV    (OFF_PU + 16 * MiB)
#define OFF_SU    (OFF_PV + 16 * MiB)
#define OFF_SV    (OFF_SU + 65536)
#define OFF_SS    (OFF_LA)

#define LDS_ROW 2064
#define LDS_A_BYTES (64 * LDS_ROW)

DI char* qp_scratch(char* ws, int blk) {
  return blk < 192 ? ws + OFF_SQ + (size_t)blk * 262144 : ws + OFF_LKV + (size_t)(blk - 192) * 262144;
}

#define OFF_BAR (OFF_DD + 768 * 1024)
DI void grid_barrier(unsigned* ctr, unsigned target) {
  __syncthreads();
  if (threadIdx.x == 0) {
    __builtin_amdgcn_fence(__ATOMIC_RELEASE, "agent");
    asm volatile("s_waitcnt vmcnt(0)" ::: "memory");
    __hip_atomic_fetch_add(ctr, 1u, __ATOMIC_RELAXED, __HIP_MEMORY_SCOPE_AGENT);
    while (__hip_atomic_load(ctr, __ATOMIC_RELAXED, __HIP_MEMORY_SCOPE_AGENT) < target) __builtin_amdgcn_s_sleep(1);
    __builtin_amdgcn_fence(__ATOMIC_ACQUIRE, "agent");
    asm volatile("s_waitcnt vmcnt(0)" ::: "memory");
  }
  __syncthreads();
}

struct MKParams {
  const float *x, *mem, *g_mix, *w_in, *w_up, *b_alpha, *g_gla, *w_out, *g_mq, *g_mkv, *w_mq, *w_mkv, *w_mo, *g_ffn, *w_pq,
      *subk, *pu, *pv, *g_fin;
  float* out;
  char* ws;
};
extern __shared__ __attribute__((aligned(16))) char smem[];

template <typename ColFn>
DI void prep_w(bf8* dst, const float* __restrict__ W, int ldw, int ntiles, const float* __restrict__ gain, ColFn colfn,
               int gtid, int gthreads) {
  const int total = ntiles * 4096;
  for (int u = gtid; u < total; u += gthreads) {
    const int lane = u & 63, ks = (u >> 6) & 63, nt = u >> 12;
    const int r = lane & 31, h = lane >> 5;
    float sc = 1.f;
    const int col = colfn(32 * nt + r, sc);
    f8v v;
#pragma unroll
    for (int j = 0; j < 8; ++j) {
      const int k = 16 * ks + 8 * h + j;
      float val = 0.f;
      if (col >= 0) val = W[(size_t)k * ldw + col] * sc * (gain ? gain[k] : 1.f);
      v[j] = val;
    }
    const int didx = (nt < (ntiles & ~15)) ? ((((nt >> 4) * 64 + ks) * 16 + (nt & 15)) * 64 + lane) : u;
    dst[didx] = cvt8(v);
  }
}

DI void phase_prep(const MKParams& p, int gtid, int gthreads) {
  char* ws = p.ws;
  prep_w((bf8*)(ws + OFF_WIN), p.w_in, INC, 97, p.g_mix,
         [](int n, float& sc) -> int {
           if (n < 256) { sc = 0.125f; return n; }
           if (n < 1536) return n;
           if (n < 2048) { sc = 0.125f; return n + 16; }
           if (n < 3072) return n + 16;
           if (n < 3088) return n - 1536;
           return -1;
         }, gtid, gthreads);
  prep_w((bf8*)(ws + OFF_WOUT), p.w_out, 1024, 32, nullptr, [](int n, float& sc) -> int { return n; }, gtid, gthreads);
  prep_w((bf8*)(ws + OFF_WMQ), p.w_mq, 1024, 32, p.g_mq, [](int n, float& sc) -> int { sc = 0.0625f; return n; }, gtid, gthreads);
  prep_w((bf8*)(ws + OFF_WMKV), p.w_mkv, 2048, 64, p.g_mkv, [](int n, float& sc) -> int { return n; }, gtid, gthreads);
  prep_w((bf8*)(ws + OFF_WMO), p.w_mo, 1024, 32, nullptr, [](int n, float& sc) -> int { return n; }, gtid, gthreads);
  prep_w((bf8*)(ws + OFF_WPQ), p.w_pq, 2048, 64, p.g_ffn, [](int n, float& sc) -> int { return n; }, gtid, gthreads);
  {
    bf8* dst = (bf8*)(ws + OFF_SUBK);
    const int total = 16 * 4 * 8 * 64;
    for (int u = gtid; u < total; u += gthreads) {
      const int lane = u & 63, ks = (u >> 6) & 7, mt = (u >> 9) & 3, hp = u >> 11;
      const int r = lane & 31, h = lane >> 5;
      const float* s = p.subk + ((size_t)(hp * 128 + 32 * mt + r)) * 128 + 16 * ks + 8 * h;
      const f4v a = *(const f4v*)s, b = *(const f4v*)(s + 4);
      f8v v = {a[0], a[1], a[2], a[3], b[0], b[1], b[2], b[3]};
      dst[u] = cvt8(v);
    }
  }
}

DI void phase_prep_tables(const MKParams& p, int gwave, int nwaves, int lane) {
  for (int row = gwave; row < 32768; row += nwaves) {
    const int e = row & 16383;
    const bool isv = row >= 16384;
    const float* src = (isv ? p.pv : p.pu) + (size_t)e * DM + 16 * lane;
    f4v v[4];
#pragma unroll
    for (int q = 0; q < 4; ++q) v[q] = *(const f4v*)(src + 4 * q);
    if (!isv) {
#pragma unroll
      for (int q = 0; q < 4; ++q) v[q] = v[q] * *(const f4v*)(p.g_ffn + 16 * lane + 4 * q);
    }
    float am = 0.f;
#pragma unroll
    for (int q = 0; q < 4; ++q)
#pragma unroll
      for (int j = 0; j < 4; ++j) am = fmaxf(am, fabsf(v[q][j]));
#pragma unroll
    for (int o = 32; o > 0; o >>= 1) am = fmaxf(am, __shfl_xor(am, o));
    int k = 0;
    if (am > 0.f) k = 7 - ilogbf(am);
    k = max(-100, min(100, k));
    const float sc = ldexpf(1.0f, k);
    unsigned w[4];
#pragma unroll
    for (int q = 0; q < 4; ++q) {
      int pk = 0;
      pk = __builtin_amdgcn_cvt_pk_fp8_f32(v[q][0] * sc, v[q][1] * sc, pk, false);
      pk = __builtin_amdgcn_cvt_pk_fp8_f32(v[q][2] * sc, v[q][3] * sc, pk, true);
      w[q] = (unsigned)pk;
    }
    *(uint4*)(p.ws + (isv ? OFF_PV : OFF_PU) + (size_t)e * 1024 + 16 * lane) = make_uint4(w[0], w[1], w[2], w[3]);
    if (lane == 0) ((float*)(p.ws + (isv ? OFF_SV : OFF_SU)))[e] = ldexpf(1.0f, -k);
  }
}

DI void load_norm_tile(const float* __restrict__ src, char* ldsA, int wave, int lane) {
#pragma unroll 2
  for (int i = 0; i < 8; ++i) {
    const int row = 8 * wave + i;
    const f4v* pr = (const f4v*)(src + (size_t)row * DM);
    f4v v[4];
#pragma unroll
    for (int c = 0; c < 4; ++c) v[c] = pr[lane + 64 * c];
    float ss = 0.f;
#pragma unroll
    for (int c = 0; c < 4; ++c) ss += v[c][0] * v[c][0] + v[c][1] * v[c][1] + v[c][2] * v[c][2] + v[c][3] * v[c][3];
#pragma unroll
    for (int o = 32; o > 0; o >>= 1) ss += __shfl_xor(ss, o);
    const float rs = rsqrtf(ss * (1.0f / DM) + EPSV);
#pragma unroll
    for (int c = 0; c < 4; ++c) {
      f4v t = v[c] * rs;
      *(bf4*)(ldsA + row * LDS_ROW + (lane * 4 + 256 * c) * 2) = cvt4(t);
    }
  }
}

#ifndef GEMM_D
#define GEMM_D 6
#endif
template <bool SWAP>
DI void gemm_step(f16v (&acc)[2][2], const bf8& a0, const bf8& a1, const bf8& x0, const bf8& x1) {
  if (SWAP) {
    acc[0][0] = MFMA(a0, x0, acc[0][0]); acc[0][1] = MFMA(a0, x1, acc[0][1]);
    acc[1][0] = MFMA(a1, x0, acc[1][0]); acc[1][1] = MFMA(a1, x1, acc[1][1]);
  } else {
    acc[0][0] = MFMA(x0, a0, acc[0][0]); acc[0][1] = MFMA(x1, a0, acc[0][1]);
    acc[1][0] = MFMA(x0, a1, acc[1][0]); acc[1][1] = MFMA(x1, a1, acc[1][1]);
  }
}
struct Ring { bf8 w0[GEMM_D], w1[GEMM_D]; };
DI void ring_fill(Ring& rg, const bf8* __restrict__ wf, int lane) {
#pragma unroll
  for (int i = 0; i < GEMM_D; ++i) { rg.w0[i] = wf[lane + i * 1024]; rg.w1[i] = wf[64 + lane + i * 1024]; }
}
template <bool SWAP, bool RES, bool FIRST, bool NEXT>
DI void gemm_chunk_r(const char* ldsA, const bf8* __restrict__ wf, const bf8* __restrict__ wnext, int lane, f16v (&acc)[2][2],
                     Ring& rg, const float* res = nullptr) {
  __builtin_amdgcn_sched_barrier(0);
  const int r = lane & 31, h = lane >> 5;
  const char* xa0 = ldsA + r * LDS_ROW + h * 16;
  const char* xa1 = xa0 + 32 * LDS_ROW;
  const bf8* w0p = wf + lane;
  const bf8* w1p = wf + 64 + lane;
  if (FIRST) ring_fill(rg, wf, lane);
  if (RES) {
#pragma unroll
    for (int ntl = 0; ntl < 2; ++ntl)
#pragma unroll
      for (int tt = 0; tt < 2; ++tt)
#pragma unroll
        for (int g = 0; g < 4; ++g) {
          const f4v x = *(const f4v*)(res + (size_t)(32 * tt + r) * DM + 32 * ntl + 8 * g + 4 * h);
          acc[ntl][tt][4 * g] = x[0]; acc[ntl][tt][4 * g + 1] = x[1]; acc[ntl][tt][4 * g + 2] = x[2]; acc[ntl][tt][4 * g + 3] = x[3];
        }
  } else {
    acc[0][0] = zero16(); acc[0][1] = zero16(); acc[1][0] = zero16(); acc[1][1] = zero16();
  }
  bf8 x0 = *(const bf8*)(xa0), x1 = *(const bf8*)(xa1);
  constexpr int KMAIN = ((64 - 2 * GEMM_D) / GEMM_D + 1) * GEMM_D;
#pragma unroll 1
  for (int ks0 = 0; ks0 < KMAIN; ks0 += GEMM_D) {
#pragma unroll
    for (int i = 0; i < GEMM_D; ++i) {
      const int ks = ks0 + i;
      const bf8 xn0 = *(const bf8*)(xa0 + (ks + 1) * 32);
      const bf8 xn1 = *(const bf8*)(xa1 + (ks + 1) * 32);
      gemm_step<SWAP>(acc, rg.w0[i], rg.w1[i], x0, x1);
      rg.w0[i] = w0p[(ks + GEMM_D) * 1024];
      rg.w1[i] = w1p[(ks + GEMM_D) * 1024];
      x0 = xn0; x1 = xn1;
      __builtin_amdgcn_sched_group_barrier(0x100, 2, 0);
      __builtin_amdgcn_sched_group_barrier(0x008, 2, 0);
      __builtin_amdgcn_sched_group_barrier(0x020, 2, 0);
      __builtin_amdgcn_sched_group_barrier(0x008, 2, 0);
    }
  }
#pragma unroll
  for (int t = 0; t < 64 - KMAIN; ++t) {
    const int ks = KMAIN + t, i = t % GEMM_D;
    const bf8 xn0 = *(const bf8*)(xa0 + (ks + 1) * 32);
    const bf8 xn1 = *(const bf8*)(xa1 + (ks + 1) * 32);
    gemm_step<SWAP>(acc, rg.w0[i], rg.w1[i], x0, x1);
    const bool refill = (ks + GEMM_D < 64) || NEXT;
    if (ks + GEMM_D < 64) {
      rg.w0[i] = w0p[(ks + GEMM_D) * 1024];
      rg.w1[i] = w1p[(ks + GEMM_D) * 1024];
    } else if (NEXT) {
      rg.w0[i] = wnext[lane + (ks + GEMM_D - 64) * 1024];
      rg.w1[i] = wnext[64 + lane + (ks + GEMM_D - 64) * 1024];
    }
    x0 = xn0; x1 = xn1;
    __builtin_amdgcn_sched_group_barrier(0x100, 2, 0);
    __builtin_amdgcn_sched_group_barrier(0x008, 2, 0);
    if (refill) __builtin_amdgcn_sched_group_barrier(0x020, 2, 0);
    __builtin_amdgcn_sched_group_barrier(0x008, 2, 0);
  }
}
template <bool SWAP, bool RES = false>
DI void gemm_chunk(const char* ldsA, const bf8* __restrict__ wf, int lane, f16v (&acc)[2][2], const float* res = nullptr) {
  Ring rg;
  gemm_chunk_r<SWAP, RES, true, false>(ldsA, wf, nullptr, lane, acc, rg, res);
}

DI void store_swap_bf16(u16* dst, size_t ld, const f16v (&acc)[2][2], int lane) {
  const int r = lane & 31, h = lane >> 5;
#pragma unroll
  for (int ntl = 0; ntl < 2; ++ntl)
#pragma unroll
    for (int tt = 0; tt < 2; ++tt)
#pragma unroll
      for (int g = 0; g < 4; ++g) {
        f4v v = {acc[ntl][tt][4 * g], acc[ntl][tt][4 * g + 1], acc[ntl][tt][4 * g + 2], acc[ntl][tt][4 * g + 3]};
        *(bf4*)(dst + (size_t)(32 * tt + r) * ld + 32 * ntl + 8 * g + 4 * h) = cvt4(v);
      }
}
DI void store_vt_bf16(u16* dst, size_t ld, const f16v (&acc)[2][2], int lane) {
  const int r = lane & 31, h = lane >> 5;
#pragma unroll
  for (int ntl = 0; ntl < 2; ++ntl)
#pragma unroll
    for (int tt = 0; tt < 2; ++tt)
#pragma unroll
      for (int s = 0; s < 2; ++s) {
        f8v v;
#pragma unroll
        for (int j = 0; j < 8; ++j) v[j] = acc[ntl][tt][8 * s + j];
        *(bf8*)(dst + (size_t)(32 * ntl + r) * ld + 32 * tt + 16 * s + 8 * h) = cvt8(v);
      }
}

DI float log_sigmoid_acc(float x) { return fminf(x, 0.f) - log1pf(expf(-fabsf(x))); }

DI void phase_a_tile(const MKParams& p, int tile, int wave, int lane) {
  asm volatile("" : "+v"(lane));
  char* ws = p.ws;
  char* ldsA = smem;
  float* alr_s = (float*)(smem + LDS_A_BYTES);
  const int b = tile >> 5, c = tile & 31;
  const size_t tok0 = (size_t)tile * 64;
  __syncthreads();
  load_norm_tile(p.x + tok0 * DM, ldsA, wave, lane);
#if PROBE == 10
  __syncthreads();
  load_norm_tile(p.x + tok0 * DM, ldsA, wave, lane);
#endif
  __syncthreads();
  const bf8* wf = (const bf8*)(ws + OFF_WIN);
  f16v acc[2][2];
  Ring rg;
  const int t0 = c * 64;
  gemm_chunk_r<true, false, true, true>(ldsA, wf + (size_t)0 * 65536 + 2 * wave * 64, wf + (size_t)1 * 65536 + 2 * wave * 64, lane, acc, rg);
  {
    u16* base = (u16*)(ws + (wave < 4 ? OFF_GQ : OFF_GK)) + ((size_t)(b * 4 + (wave & 3)) * SEQ + t0) * 64;
    store_swap_bf16(base, 64, acc, lane);
#if PROBE == 11
    store_swap_bf16(base, 64, acc, lane);
#endif
  }
  gemm_chunk_r<false, false, false, true>(ldsA, wf + (size_t)1 * 65536 + 2 * wave * 64, wf + (size_t)2 * 65536 + 2 * wave * 64, lane, acc, rg);
  {
    u16* base = (u16*)(ws + OFF_GVT) + ((size_t)(b * 4 + (wave >> 1)) * 128 + 64 * (wave & 1)) * SEQ + t0;
    store_vt_bf16(base, SEQ, acc, lane);
#if PROBE == 11
    store_vt_bf16(base, SEQ, acc, lane);
#endif
  }
  gemm_chunk_r<true, false, false, true>(ldsA, wf + (size_t)2 * 65536 + 2 * wave * 64, wf + (size_t)3 * 65536 + 2 * wave * 64, lane, acc, rg);
  store_swap_bf16((u16*)(ws + OFF_OG) + tok0 * 512 + 64 * wave, 512, acc, lane);
#if PROBE == 11
  store_swap_bf16((u16*)(ws + OFF_OG) + tok0 * 512 + 64 * wave, 512, acc, lane);
#endif
  gemm_chunk_r<true, false, false, true>(ldsA, wf + (size_t)3 * 65536 + 2 * wave * 64, wf + (size_t)4 * 65536 + 2 * wave * 64, lane, acc, rg);
  store_swap_bf16((u16*)(ws + OFF_SQ) + ((size_t)(b * 8 + wave) * SEQ + t0) * 64, 64, acc, lane);
#if PROBE == 11
  store_swap_bf16((u16*)(ws + OFF_SQ) + ((size_t)(b * 8 + wave) * SEQ + t0) * 64, 64, acc, lane);
#endif
  gemm_chunk_r<true, false, false, true>(ldsA, wf + (size_t)4 * 65536 + 2 * wave * 64, wf + (size_t)5 * 65536 + 2 * wave * 64, lane, acc, rg);
  store_swap_bf16((u16*)(ws + OFF_SK) + ((size_t)(b * 8 + wave) * SEQ + t0) * 64, 64, acc, lane);
#if PROBE == 11
  store_swap_bf16((u16*)(ws + OFF_SK) + ((size_t)(b * 8 + wave) * SEQ + t0) * 64, 64, acc, lane);
#endif
  gemm_chunk_r<false, false, false, false>(ldsA, wf + (size_t)5 * 65536 + 2 * wave * 64, nullptr, lane, acc, rg);
  store_vt_bf16((u16*)(ws + OFF_SVT) + ((size_t)(b * 8 + wave) * 64) * SEQ + t0, SEQ, acc, lane);
#if PROBE == 11
  store_vt_bf16((u16*)(ws + OFF_SVT) + ((size_t)(b * 8 + wave) * 64) * SEQ + t0, SEQ, acc, lane);
#endif
#if PROBE == 12
  for (int rep_ = 0; rep_ < 2; ++rep_) {
  __syncthreads();
#else
  {
#endif
    float* part = (float*)(smem + LDS_A_BYTES);
    const int r = lane & 31, h = lane >> 5;
    const bf8* wp = wf + (size_t)96 * 4096 + lane;
    bf8 wfr[8];
#pragma unroll
    for (int i = 0; i < 8; ++i) wfr[i] = wp[(8 * wave + i) * 64];
    const char* xa0 = ldsA + r * LDS_ROW + h * 16 + wave * 256;
    const char* xa1 = xa0 + 32 * LDS_ROW;
    f16v a0 = zero16(), a1 = zero16();
#pragma unroll
    for (int i = 0; i < 8; ++i) {
      a0 = MFMA(wfr[i], *(const bf8*)(xa0 + i * 32), a0);
      a1 = MFMA(wfr[i], *(const bf8*)(xa1 + i * 32), a1);
    }
    float* pw = part + (wave & 3) * 1024;
    if (wave < 4) {
#pragma unroll
      for (int i = 0; i < 8; ++i) { pw[r * 16 + crow(i, h)] = a0[i]; pw[(32 + r) * 16 + crow(i, h)] = a1[i]; }
    }
    __syncthreads();
    if (wave >= 4) {
#pragma unroll
      for (int i = 0; i < 8; ++i) { pw[r * 16 + crow(i, h)] += a0[i]; pw[(32 + r) * 16 + crow(i, h)] += a1[i]; }
    }
    __syncthreads();
    const int tid = wave * 64 + lane;
    {
      const f4v* p4 = (const f4v*)part;
      if (tid < 256) { f4v s = p4[tid] + p4[256 + tid] + p4[512 + tid] + p4[768 + tid]; ((f4v*)part)[tid] = s; }
    }
    __syncthreads();
    const int col = tid & 255, tg = tid >> 8;
    float wu[16];
#pragma unroll
    for (int rr = 0; rr < 16; ++rr) wu[rr] = p.w_up[rr * 256 + col];
    const float bb = p.b_alpha[col];
    float* dst = (float*)(ws + OFF_LA) + (tok0 + 32 * tg) * 256 + col;
#pragma unroll 4
    for (int t = 0; t < 32; ++t) {
      const f4v* ar = (const f4v*)(part + (32 * tg + t) * 16);
      const f4v q0 = ar[0], q1 = ar[1], q2 = ar[2], q3 = ar[3];
      float s = bb;
      s = fmaf(q0[0], wu[0], s); s = fmaf(q0[1], wu[1], s); s = fmaf(q0[2], wu[2], s); s = fmaf(q0[3], wu[3], s);
      s = fmaf(q1[0], wu[4], s); s = fmaf(q1[1], wu[5], s); s = fmaf(q1[2], wu[6], s); s = fmaf(q1[3], wu[7], s);
      s = fmaf(q2[0], wu[8], s); s = fmaf(q2[1], wu[9], s); s = fmaf(q2[2], wu[10], s); s = fmaf(q2[3], wu[11], s);
      s = fmaf(q3[0], wu[12], s); s = fmaf(q3[1], wu[13], s); s = fmaf(q3[2], wu[14], s); s = fmaf(q3[3], wu[15], s);
      const float ls = fminf(s, 0.f) - __logf(1.0f + __expf(-fabsf(s)));
      dst[(size_t)t * 256] = ls * (1.0f / 16.0f);
    }
  }
}

DI void phase_a_memkv(const MKParams& p, int item, int wave, int lane) {
  asm volatile("" : "+v"(lane));
  char* ws = p.ws;
  char* ldsA = smem;
  const int rt = item >> 2, cc = item & 3;
  const int b = rt >> 2, m0 = (rt & 3) * 64;
  __syncthreads();
  load_norm_tile(p.mem + (size_t)rt * 64 * DM, ldsA, wave, lane);
  __syncthreads();
  const bf8* wf = (const bf8*)(ws + OFF_WMKV);
  f16v acc[2][2];
  if (cc < 2) {
    gemm_chunk<true>(ldsA, wf + (size_t)cc * 65536 + 2 * wave * 64, lane, acc);
    const int f0 = 512 * cc + 64 * wave;
    u16* base = (u16*)(ws + OFF_KM) + ((size_t)(b * 4 + (f0 >> 8)) * 256 + m0) * 256 + (f0 & 255);
    store_swap_bf16(base, 256, acc, lane);
  } else {
    gemm_chunk<false>(ldsA, wf + (size_t)cc * 65536 + 2 * wave * 64, lane, acc);
    const int f0 = 512 * (cc - 2) + 64 * wave;
    u16* base = (u16*)(ws + OFF_VMT) + ((size_t)(b * 4 + (f0 >> 8)) * 256 + (f0 & 255)) * 256 + m0;
    store_vt_bf16(base, 256, acc, lane);
  }
}
#define SB_THR 30.0f

DI bf8 pack8(const f16v& x, int s) {
  f8v v;
#pragma unroll
  for (int j = 0; j < 8; ++j) v[j] = x[8 * s + j];
  return cvt8(v);
}

DI void sb_item(const MKParams& p, int item, int lane) {
  asm volatile("" : "+v"(lane));
  char* ws = p.ws;
  const int r = lane & 31, h = lane >> 5;
  const int bh = item >> 6, qt = item & 63;
  const u16* SQ = (const u16*)(ws + OFF_SQ) + (size_t)bh * SEQ * 64;
  const u16* SK = (const u16*)(ws + OFF_SK) + (size_t)bh * SEQ * 64;
  const u16* SVT = (const u16*)(ws + OFF_SVT) + (size_t)bh * 64 * SEQ;
  bf8 qf[4];
#pragma unroll
  for (int ks = 0; ks < 4; ++ks) qf[ks] = *(const bf8*)(SQ + (size_t)(32 * qt + r) * 64 + 16 * ks + 8 * h);
  bf8 tri[2];
#pragma unroll
  for (int s = 0; s < 2; ++s) {
    f8v t;
#pragma unroll
    for (int j = 0; j < 8; ++j) t[j] = (16 * s + 8 * (j >> 2) + 4 * h + (j & 3) >= r) ? 1.0f : 0.0f;
    tri[s] = cvt8(t);
  }
  f16v o0 = zero16(), o1 = zero16();
  float R = 0.f;
  for (int kt = qt; kt >= 0; --kt) {
    bf8 kf[4], vf[2][2];
#pragma unroll
    for (int ks = 0; ks < 4; ++ks) kf[ks] = *(const bf8*)(SK + (size_t)(32 * kt + r) * 64 + 16 * ks + 8 * h);
#pragma unroll
    for (int mt = 0; mt < 2; ++mt)
#pragma unroll
      for (int s = 0; s < 2; ++s) vf[mt][s] = *(const bf8*)(SVT + (size_t)(32 * mt + r) * SEQ + 32 * kt + 16 * s + 8 * h);
    f16v z = zero16();
#pragma unroll
    for (int ks = 0; ks < 4; ++ks) z = MFMA(kf[ks], qf[ks], z);
    const bool diag = (kt == qt);
    f16v sp;
    float tot = 0.f;
#pragma unroll
    for (int i = 0; i < 16; ++i) {
      const float zz = z[i];
      const float sv = fmaxf(zz, 0.f) + __logf(1.0f + __expf(-fabsf(zz)));
      const bool valid = !diag || (crow(i, h) < r);
      sp[i] = valid ? sv : 0.f;
      tot += sp[i];
    }
    tot += __shfl_xor(tot, 32);
    f16v C = MFMA(tri[0], pack8(sp, 0), zero16());
    C = MFMA(tri[1], pack8(sp, 1), C);
    f16v a;
#pragma unroll
    for (int i = 0; i < 16; ++i) {
      const bool valid = !diag || (crow(i, h) < r);
      a[i] = valid ? __expf(z[i] - C[i] - R) : 0.f;
    }
    const bf8 a0 = pack8(a, 0), a1 = pack8(a, 1);
    o0 = MFMA(vf[0][0], a0, o0); o0 = MFMA(vf[0][1], a1, o0);
    o1 = MFMA(vf[1][0], a0, o1); o1 = MFMA(vf[1][1], a1, o1);
    R += tot;
    if (__all(R > SB_THR)) break;
  }
  const int b = bh >> 3, hd = bh & 7;
  u16* dst = (u16*)(ws + OFF_OSB) + ((size_t)b * SEQ + 32 * qt + r) * 512 + hd * 64 + 4 * h;
#pragma unroll
  for (int g = 0; g < 4; ++g) {
    f4v v0 = {o0[4 * g], o0[4 * g + 1], o0[4 * g + 2], o0[4 * g + 3]};
    f4v v1 = {o1[4 * g], o1[4 * g + 1], o1[4 * g + 2], o1[4 * g + 3]};
    *(bf4*)(dst + 8 * g) = cvt4(v0);
    *(bf4*)(dst + 32 + 8 * g) = cvt4(v1);
  }
}

DI void gla_g1_item(const MKParams& p, int item, int wave, int lane) {
  asm volatile("" : "+v"(lane));
  char* ws = p.ws;
  const int r = lane & 31, h = lane >> 5;
  const int bh = item >> 5, c = item & 31, b = bh >> 2, hd = bh & 3;
  char* kl = smem + wave * 9216;
  u16* GQ = (u16*)(ws + OFF_GQ) + ((size_t)bh * SEQ + 64 * c) * 64;
  u16* GK = (u16*)(ws + OFF_GK) + ((size_t)bh * SEQ + 64 * c) * 64;
  const float* LA = (const float*)(ws + OFF_LA) + ((size_t)b * SEQ + 64 * c) * 256 + hd * 64;
  float bc = 0.f;
#pragma unroll 1
  for (int g = 0; g < 4; ++g) {
    float la_[16];
    u16 q_[16], k_[16];
#pragma unroll
    for (int i = 0; i < 16; ++i) {
      const int t = 16 * g + i;
      la_[i] = LA[(size_t)t * 256 + lane];
      q_[i] = GQ[t * 64 + lane];
      k_[i] = GK[t * 64 + lane];
    }
#pragma unroll
    for (int i = 0; i < 16; ++i) {
      const int t = 16 * g + i;
      bc += la_[i];
      const float eq = __expf(bc);
      const float qn = bf2f(q_[i]) * eq, kn = bf2f(k_[i]) / eq;
      const bf2 pk = __builtin_convertvector((f2v){qn, kn}, bf2);
      const unsigned u = __builtin_bit_cast(unsigned, pk);
      GQ[t * 64 + lane] = (u16)(u & 0xffff);
      GK[t * 64 + lane] = (u16)(u >> 16);
      *(u16*)(kl + lane * 144 + tpos(t) * 2) = (u16)(u >> 16);
    }
  }
  ((float*)(ws + OFF_DD))[(size_t)item * 64 + lane] = __expf(bc);
  asm volatile("s_waitcnt lgkmcnt(0)" ::: "memory");
  const u16* GVT = (const u16*)(ws + OFF_GVT) + (size_t)bh * 128 * SEQ + 64 * c;
  float* LKV = (float*)(ws + OFF_LKV) + (size_t)item * 128 * 64;
  bf8 kb[2][4];
#pragma unroll
  for (int nt = 0; nt < 2; ++nt)
#pragma unroll
    for (int s = 0; s < 4; ++s) kb[nt][s] = *(const bf8*)(kl + (32 * nt + r) * 144 + (16 * s + 8 * h) * 2);
#pragma unroll 1
  for (int mt = 0; mt < 4; ++mt) {
    f16v a0 = zero16(), a1 = zero16();
#pragma unroll
    for (int s = 0; s < 4; ++s) {
      const bf8 vf = *(const bf8*)(GVT + (size_t)(32 * mt + r) * SEQ + 16 * s + 8 * h);
      a0 = MFMA(vf, kb[0][s], a0);
      a1 = MFMA(vf, kb[1][s], a1);
    }
#pragma unroll
    for (int i = 0; i < 16; ++i) {
      LKV[(32 * mt + crow(i, h)) * 64 + r] = a0[i];
      LKV[(32 * mt + crow(i, h)) * 64 + 32 + r] = a1[i];
    }
  }
  asm volatile("s_waitcnt lgkmcnt(0)" ::: "memory");
}

DI void gla_g2(const MKParams& p, int gtid, int gthreads) {
  char* ws = p.ws;
  for (int u = gtid; u < 32768; u += gthreads) {
    const int oct = u & 7, dv = (u >> 3) & 127, bh = u >> 10;
    f8v S = {0.f, 0.f, 0.f, 0.f, 0.f, 0.f, 0.f, 0.f};
#pragma unroll 4
    for (int c = 0; c < 32; ++c) {
      const size_t item = (size_t)bh * 32 + c;
      *(bf8*)((u16*)(ws + OFF_SS) + (item * 128 + dv) * 64 + oct * 8) = cvt8(S);
      const f8v l = *(const f8v*)((const float*)(ws + OFF_LKV) + (item * 128 + dv) * 64 + oct * 8);
      const f8v d = *(const f8v*)((const float*)(ws + OFF_DD) + item * 64 + oct * 8);
      S = d * (S + l);
    }
  }
}

DI void gla_g3_tile(const MKParams& p, int tile, int wave, int lane, char* dst, int dst_ld) {
  char* ws = p.ws;
  const int r = lane & 31, h = lane >> 5;
  const int b = tile >> 5, c = tile & 31, hd = wave >> 1, tt = wave & 1, bh = b * 4 + hd;
  const u16* GQ = (const u16*)(ws + OFF_GQ) + ((size_t)bh * SEQ + 64 * c) * 64;
  const u16* GK = (const u16*)(ws + OFF_GK) + ((size_t)bh * SEQ + 64 * c) * 64;
  const u16* GVT = (const u16*)(ws + OFF_GVT) + (size_t)bh * 128 * SEQ + 64 * c;
  const u16* SS = (const u16*)(ws + OFF_SS) + ((size_t)(bh * 32 + c) * 128) * 64;
  bf8 qf[4];
#pragma unroll
  for (int ks = 0; ks < 4; ++ks) qf[ks] = *(const bf8*)(GQ + (32 * tt + r) * 64 + 16 * ks + 8 * h);
  bf8 pf[2][2];
  {
    bf8 kf[2][4];
#pragma unroll
    for (int kt = 0; kt < 2; ++kt)
      if (kt <= tt) {
#pragma unroll
        for (int ks = 0; ks < 4; ++ks) kf[kt][ks] = *(const bf8*)(GK + (32 * kt + r) * 64 + 16 * ks + 8 * h);
      }
    __builtin_amdgcn_sched_barrier(0);
#pragma unroll
    for (int kt = 0; kt < 2; ++kt) {
      if (kt <= tt) {
        f16v pt = zero16();
#pragma unroll
        for (int ks = 0; ks < 4; ++ks) pt = MFMA(kf[kt][ks], qf[ks], pt);
        if (kt == tt) {
#pragma unroll
          for (int i = 0; i < 16; ++i) pt[i] = (crow(i, h) <= r) ? pt[i] : 0.f;
        }
        pf[kt][0] = pack8(pt, 0);
        pf[kt][1] = pack8(pt, 1);
      }
    }
  }
  f16v o[4];
  {
    bf8 sf[2][4], vf[2][4];
    auto load_tile = [&](int mt, bf8 (&sfx)[4], bf8 (&vfx)[4]) {
#pragma unroll
      for (int ks = 0; ks < 4; ++ks) sfx[ks] = *(const bf8*)(SS + (32 * mt + r) * 64 + 16 * ks + 8 * h);
#pragma unroll
      for (int kt = 0; kt < 2; ++kt)
        if (kt <= tt) {
#pragma unroll
          for (int s = 0; s < 2; ++s) vfx[2 * kt + s] = *(const bf8*)(GVT + (size_t)(32 * mt + r) * SEQ + 32 * kt + 16 * s + 8 * h);
        }
    };
    load_tile(0, sf[0], vf[0]);
#pragma unroll
    for (int mt = 0; mt < 4; ++mt) {
      if (mt + 1 < 4) load_tile(mt + 1, sf[(mt + 1) & 1], vf[(mt + 1) & 1]);
      __builtin_amdgcn_sched_barrier(0);
      o[mt] = zero16();
#pragma unroll
      for (int ks = 0; ks < 4; ++ks) o[mt] = MFMA(sf[mt & 1][ks], qf[ks], o[mt]);
#pragma unroll
      for (int kt = 0; kt < 2; ++kt)
        if (kt <= tt) {
#pragma unroll
          for (int s = 0; s < 2; ++s) o[mt] = MFMA(vf[mt & 1][2 * kt + s], pf[kt][s], o[mt]);
        }
      __builtin_amdgcn_sched_barrier(0);
    }
  }
  float ss = 0.f;
#pragma unroll
  for (int mt = 0; mt < 4; ++mt)
#pragma unroll
    for (int i = 0; i < 16; ++i) ss += o[mt][i] * o[mt][i];
  ss += __shfl_xor(ss, 32);
  const float rr = rsqrtf(ss * (1.0f / 128.0f) + EPSV);
  const size_t tok = (size_t)tile * 64 + 32 * tt + r;
  const u16* OG = (const u16*)(ws + OFF_OG) + tok * 512 + hd * 128;
#pragma unroll
  for (int mt = 0; mt < 4; ++mt)
#pragma unroll
    for (int g = 0; g < 4; ++g) {
      const int dv0 = 32 * mt + 8 * g + 4 * h;
      const ushort4 og4 = *(const ushort4*)(OG + dv0);
      const f4v gg = *(const f4v*)(p.g_gla + dv0);
      const float og[4] = {bf2f(og4.x), bf2f(og4.y), bf2f(og4.z), bf2f(og4.w)};
      f4v v;
#pragma unroll
      for (int j = 0; j < 4; ++j) v[j] = o[mt][4 * g + j] * rr * gg[j] * (og[j] / (1.0f + __expf(-og[j])));
      *(bf4*)(dst + (size_t)(32 * tt + r) * dst_ld + (hd * 128 + dv0) * 2) = cvt4(v);
    }
}
DI void gemm_1024(const char* ldsA, const bf8* __restrict__ wf, int wave, int lane, f16v (&a0)[2][2], f16v (&a1)[2][2]) {
  gemm_chunk<true>(ldsA, wf + 2 * wave * 64, lane, a0);
  gemm_chunk<true>(ldsA, wf + 65536 + 2 * wave * 64, lane, a1);
}
DI void gemm_1024_res(const char* ldsA, const bf8* __restrict__ wf, int wave, int lane, f16v (&a0)[2][2], f16v (&a1)[2][2],
                      const float* res) {
  gemm_chunk<true, true>(ldsA, wf + 2 * wave * 64, lane, a0, res + 64 * wave);
  gemm_chunk<true, true>(ldsA, wf + 65536 + 2 * wave * 64, lane, a1, res + 512 + 64 * wave);
}

DI void store_f32_ssq(const f16v (&a)[2][2], float* dst, int f0, int lane, float (&ssq)[2]) {
  const int r = lane & 31, h = lane >> 5;
#pragma unroll
  for (int ntl = 0; ntl < 2; ++ntl)
#pragma unroll
    for (int tt = 0; tt < 2; ++tt)
#pragma unroll
      for (int g = 0; g < 4; ++g) {
        f4v v = {a[ntl][tt][4 * g], a[ntl][tt][4 * g + 1], a[ntl][tt][4 * g + 2], a[ntl][tt][4 * g + 3]};
        ssq[tt] += v[0] * v[0] + v[1] * v[1] + v[2] * v[2] + v[3] * v[3];
        *(f4v*)(dst + (size_t)(32 * tt + r) * DM + f0 + 32 * ntl + 8 * g + 4 * h) = v;
      }
}

DI void acc_to_scratch(u16* scr, const f16v (&a)[2][2], int f0, int lane, float s0, float s1) {
  const int r = lane & 31, h = lane >> 5;
#pragma unroll
  for (int ntl = 0; ntl < 2; ++ntl)
#pragma unroll
    for (int tt = 0; tt < 2; ++tt)
#pragma unroll
      for (int g = 0; g < 4; ++g) {
        const float sc = tt ? s1 : s0;
        f4v v = {a[ntl][tt][4 * g] * sc, a[ntl][tt][4 * g + 1] * sc, a[ntl][tt][4 * g + 2] * sc, a[ntl][tt][4 * g + 3] * sc};
        *(bf4*)(scr + (size_t)(32 * tt + r) * 1024 + f0 + 32 * ntl + 8 * g + 4 * h) = cvt4(v);
      }
}
typedef __attribute__((ext_vector_type(4))) unsigned u4v;
DI void scratch_to_lds(const u16* scr, char* ldsA, int tid) {
  asm volatile("" : "+v"(tid));
  const unsigned toff = (unsigned)tid * 16u;
#pragma unroll
  for (int half = 0; half < 2; ++half) {
    u4v v[8];
#pragma unroll
    for (int it = 0; it < 8; ++it)
      v[it] = __builtin_nontemporal_load((const u4v*)((const char*)scr + (size_t)(8192 * (8 * half + it)) + toff));
#pragma unroll
    for (int it = 0; it < 8; ++it) {
      const int idx = tid + 512 * (8 * half + it), row = idx >> 7, ch = idx & 127;
      *(u4v*)(ldsA + row * LDS_ROW + ch * 16) = v[it];
    }
  }
}

struct Pk { bf4 v[2][2][4]; };
DI void pack_acc(Pk& pk, const f16v (&a)[2][2], float s0, float s1) {
#pragma unroll
  for (int ntl = 0; ntl < 2; ++ntl)
#pragma unroll
    for (int tt = 0; tt < 2; ++tt)
#pragma unroll
      for (int g = 0; g < 4; ++g) {
        const float sc = tt ? s1 : s0;
        f4v v = {a[ntl][tt][4 * g] * sc, a[ntl][tt][4 * g + 1] * sc, a[ntl][tt][4 * g + 2] * sc, a[ntl][tt][4 * g + 3] * sc};
        pk.v[ntl][tt][g] = cvt4(v);
      }
}
DI void pk_to_lds(char* ldsA, const Pk& pk, int f0, int lane) {
  const int r = lane & 31, h = lane >> 5;
#pragma unroll
  for (int ntl = 0; ntl < 2; ++ntl)
#pragma unroll
    for (int tt = 0; tt < 2; ++tt)
#pragma unroll
      for (int g = 0; g < 4; ++g)
        *(bf4*)(ldsA + (32 * tt + r) * LDS_ROW + (f0 + 32 * ntl + 8 * g + 4 * h) * 2) = pk.v[ntl][tt][g];
}

DI void rms_from_partials(float* red, int wave, int lane, const float (&ssq)[2], float& rs0, float& rs1) {
  red[(wave * 2 + 0) * 64 + lane] = ssq[0];
  red[(wave * 2 + 1) * 64 + lane] = ssq[1];
  __syncthreads();
  const int r = lane & 31;
  float t0 = 0.f, t1 = 0.f;
#pragma unroll
  for (int w = 0; w < 8; ++w) {
    t0 += red[(w * 2 + 0) * 64 + r] + red[(w * 2 + 0) * 64 + 32 + r];
    t1 += red[(w * 2 + 1) * 64 + r] + red[(w * 2 + 1) * 64 + 32 + r];
  }
  rs0 = rsqrtf(t0 * (1.0f / DM) + EPSV);
  rs1 = rsqrtf(t1 * (1.0f / DM) + EPSV);
}

template <bool WRITE = true>
DI void mem_attn(const MKParams& p, char* ldsA, int b, int wave, int lane) {
  char* ws = p.ws;
  const int r = lane & 31, h = lane >> 5;
  const int hm = wave >> 1, tt = wave & 1;
  const char* KM = ws + OFF_KM + (size_t)(b * 4 + hm) * 256 * 256 * 2;
  const char* VMT = ws + OFF_VMT + (size_t)(b * 4 + hm) * 256 * 256 * 2;
  char* qrow = ldsA + (32 * tt + r) * LDS_ROW + hm * 512;
  const unsigned loff = (unsigned)((r * 256 + 8 * h) * 2);
  f16v s[8];
#pragma unroll
  for (int mt = 0; mt < 8; ++mt) s[mt] = zero16();
  bf8 ka[8], kb[8];
#pragma unroll
  for (int mt = 0; mt < 8; ++mt) ka[mt] = *(const bf8*)(KM + (size_t)(mt * 32 * 256 * 2) + loff);
  bf8 qa = *(const bf8*)(qrow + 8 * h * 2), qb;
#pragma unroll 1
  for (int ks = 0; ks < 16; ks += 2) {
#pragma unroll
    for (int mt = 0; mt < 8; ++mt) kb[mt] = *(const bf8*)(KM + (size_t)((mt * 32 * 256 + 16 * (ks + 1)) * 2) + loff);
    qb = *(const bf8*)(qrow + (16 * (ks + 1) + 8 * h) * 2);
#pragma unroll
    for (int mt = 0; mt < 8; ++mt) s[mt] = MFMA(ka[mt], qa, s[mt]);
    __builtin_amdgcn_sched_group_barrier(0x020, 8, 0);
    __builtin_amdgcn_sched_group_barrier(0x100, 1, 0);
    __builtin_amdgcn_sched_group_barrier(0x008, 8, 0);
    if (ks + 2 < 16) {
#pragma unroll
      for (int mt = 0; mt < 8; ++mt) ka[mt] = *(const bf8*)(KM + (size_t)((mt * 32 * 256 + 16 * (ks + 2)) * 2) + loff);
      qa = *(const bf8*)(qrow + (16 * (ks + 2) + 8 * h) * 2);
    }
#pragma unroll
    for (int mt = 0; mt < 8; ++mt) s[mt] = MFMA(kb[mt], qb, s[mt]);
    __builtin_amdgcn_sched_group_barrier(0x020, 8, 0);
    __builtin_amdgcn_sched_group_barrier(0x100, 1, 0);
    __builtin_amdgcn_sched_group_barrier(0x008, 8, 0);
  }
  float mx = -INFINITY;
#pragma unroll
  for (int mt = 0; mt < 8; ++mt)
#pragma unroll
    for (int i = 0; i < 16; ++i) mx = fmaxf(mx, s[mt][i]);
  mx = fmaxf(mx, __shfl_xor(mx, 32));
  float l = 0.f;
  bf8 pf[8][2];
#pragma unroll
  for (int mt = 0; mt < 8; ++mt) {
#pragma unroll
    for (int i = 0; i < 16; ++i) { s[mt][i] = __expf(s[mt][i] - mx); l += s[mt][i]; }
    pf[mt][0] = pack8(s[mt], 0);
    pf[mt][1] = pack8(s[mt], 1);
  }
  l += __shfl_xor(l, 32);
  const float inv = 1.0f / l;
#pragma unroll
  for (int grp = 0; grp < 2; ++grp) {
    f16v o[4];
#pragma unroll
    for (int m4 = 0; m4 < 4; ++m4) o[m4] = zero16();
    const char* vb = VMT + (size_t)(grp * 4 * 32 * 256 * 2) + loff;
    bf8 va[4], vn[4];
#pragma unroll
    for (int m4 = 0; m4 < 4; ++m4) va[m4] = *(const bf8*)(vb + (size_t)(m4 * 32 * 256 * 2));
#pragma unroll
    for (int st = 0; st < 16; ++st) {
      if (st + 1 < 16) {
#pragma unroll
        for (int m4 = 0; m4 < 4; ++m4) vn[m4] = *(const bf8*)(vb + (size_t)((m4 * 32 * 256 + 16 * (st + 1)) * 2));
      }
#pragma unroll
      for (int m4 = 0; m4 < 4; ++m4) o[m4] = MFMA(va[m4], pf[st >> 1][st & 1], o[m4]);
      if (st + 1 < 16) {
        __builtin_amdgcn_sched_group_barrier(0x020, 4, 0);
        __builtin_amdgcn_sched_group_barrier(0x008, 4, 0);
#pragma unroll
        for (int m4 = 0; m4 < 4; ++m4) va[m4] = vn[m4];
      }
    }
#pragma unroll
    for (int m4 = 0; m4 < 4; ++m4)
#pragma unroll
      for (int g = 0; g < 4; ++g) {
        f4v v = {o[m4][4 * g] * inv, o[m4][4 * g + 1] * inv, o[m4][4 * g + 2] * inv, o[m4][4 * g + 3] * inv};
        if (WRITE || v[0] == 123.456f) *(bf4*)(qrow + (32 * (4 * grp + m4) + 8 * g + 4 * h) * 2) = cvt4(v);
      }
  }
}

DI void phase_c_tile(const MKParams& p, int tile, int wave, int lane, float& rs0, float& rs1) {
  asm volatile("" : "+v"(lane));
  char* ws = p.ws;
  char* ldsA = smem;
  float* red = (float*)(smem + LDS_A_BYTES);
  const size_t tok0 = (size_t)tile * 64;
  const int tid = wave * 64 + lane;
  __syncthreads();
#if PROBE == 15
  gla_g3_tile(p, tile, wave, lane, ldsA, LDS_ROW);
  __builtin_amdgcn_sched_barrier(0);
  asm volatile("" : "+v"(lane));
#endif
  {
  gla_g3_tile(p, tile, wave, lane, ldsA, LDS_ROW);
  {
    const char* osb = ws + OFF_OSB + tok0 * 1024;
#pragma unroll
    for (int it = 0; it < 8; ++it) {
      const int idx = tid + 512 * it, row = idx >> 6, ch = idx & 63;
      *(uint4*)(ldsA + row * LDS_ROW + 1024 + ch * 16) = *(const uint4*)(osb + (size_t)row * 1024 + ch * 16);
    }
  }
  }
  __syncthreads();
  f16v acc[2][2];
  Ring rg;
  Pk pk0, pk1;
  float* hdst = p.out + tok0 * DM;
  {
    float ssq[2] = {0.f, 0.f};
    const bf8* wf = (const bf8*)(ws + OFF_WOUT);
    asm volatile("" : "+v"(lane));
    gemm_chunk_r<true, true, true, true>(ldsA, wf + 2 * wave * 64, wf + 65536 + 2 * wave * 64, lane, acc, rg, p.x + tok0 * DM + 64 * wave);
    store_f32_ssq(acc, hdst, 64 * wave, lane, ssq);
    pack_acc(pk0, acc, 1.f, 1.f);
    asm volatile("" : "+v"(lane));
    gemm_chunk_r<true, true, false, true>(ldsA, wf + 65536 + 2 * wave * 64, (const bf8*)(ws + OFF_WMQ) + 2 * wave * 64, lane, acc, rg, p.x + tok0 * DM + 512 + 64 * wave);
    store_f32_ssq(acc, hdst, 512 + 64 * wave, lane, ssq);
    pack_acc(pk1, acc, 1.f, 1.f);
    rms_from_partials(red, wave, lane, ssq, rs0, rs1);
  }
  pk_to_lds(ldsA, pk0, 64 * wave, lane);
  pk_to_lds(ldsA, pk1, 512 + 64 * wave, lane);
  __syncthreads();
  {
    const bf8* wf = (const bf8*)(ws + OFF_WMQ);
    asm volatile("" : "+v"(lane));
    gemm_chunk_r<true, false, false, true>(ldsA, wf + 2 * wave * 64, wf + 65536 + 2 * wave * 64, lane, acc, rg);
    pack_acc(pk0, acc, rs0, rs1);
    asm volatile("" : "+v"(lane));
    gemm_chunk_r<true, false, false, false>(ldsA, wf + 65536 + 2 * wave * 64, nullptr, lane, acc, rg);
    pack_acc(pk1, acc, rs0, rs1);
  }
  __syncthreads();
  pk_to_lds(ldsA, pk0, 64 * wave, lane);
  pk_to_lds(ldsA, pk1, 512 + 64 * wave, lane);
  __syncthreads();
#if PROBE == 22
  asm volatile("" : "+v"(lane));
  mem_attn<false>(p, ldsA, tile >> 5, wave, lane);
#endif
  asm volatile("" : "+v"(lane));
  mem_attn<true>(p, ldsA, tile >> 5, wave, lane);
  __syncthreads();
  {
    float ssq[2] = {0.f, 0.f};
    const bf8* wf = (const bf8*)(ws + OFF_WMO);
    asm volatile("" : "+v"(lane));
    gemm_chunk_r<true, true, true, true>(ldsA, wf + 2 * wave * 64, wf + 65536 + 2 * wave * 64, lane, acc, rg, hdst + 64 * wave);
    store_f32_ssq(acc, hdst, 64 * wave, lane, ssq);
    pack_acc(pk0, acc, 1.f, 1.f);
    asm volatile("" : "+v"(lane));
    gemm_chunk_r<true, true, false, false>(ldsA, wf + 65536 + 2 * wave * 64, nullptr, lane, acc, rg, hdst + 512 + 64 * wave);
    store_f32_ssq(acc, hdst, 512 + 64 * wave, lane, ssq);
    pack_acc(pk1, acc, 1.f, 1.f);
    rms_from_partials(red, wave, lane, ssq, rs0, rs1);
  }
  pk_to_lds(ldsA, pk0, 64 * wave, lane);
  pk_to_lds(ldsA, pk1, 512 + 64 * wave, lane);
  __syncthreads();
}
#define OFF_EG (OFF_LKV + 16 * MiB)

DI unsigned f2ord(float v) { const unsigned u = __float_as_uint(v); return (u & 0x80000000u) ? ~u : (u | 0x80000000u); }
DI float ord2f(unsigned u) { return __uint_as_float((u & 0x80000000u) ? (u ^ 0x80000000u) : ~u); }

#define CEX(a, b) { const unsigned hi_ = max(k[a], k[b]); const unsigned lo_ = min(k[a], k[b]); k[a] = hi_; k[b] = lo_; }
DI void sort16_desc(unsigned (&k)[16]) {
  CEX(0, 1) CEX(2, 3) CEX(0, 2) CEX(1, 3) CEX(1, 2) CEX(4, 5) CEX(6, 7) CEX(4, 6) CEX(5, 7) CEX(5, 6) CEX(0, 4)
  CEX(2, 6) CEX(2, 4) CEX(1, 5) CEX(3, 7) CEX(3, 5) CEX(1, 2) CEX(3, 4) CEX(5, 6) CEX(8, 9) CEX(10, 11) CEX(8, 10)
  CEX(9, 11) CEX(9, 10) CEX(12, 13) CEX(14, 15) CEX(12, 14) CEX(13, 15) CEX(13, 14) CEX(8, 12) CEX(10, 14) CEX(10, 12)
  CEX(9, 13) CEX(11, 15) CEX(11, 13) CEX(9, 10) CEX(11, 12) CEX(13, 14) CEX(0, 8) CEX(4, 12) CEX(4, 8) CEX(2, 10)
  CEX(6, 14) CEX(6, 10) CEX(2, 4) CEX(6, 8) CEX(10, 12) CEX(1, 9) CEX(5, 13) CEX(5, 9) CEX(3, 11) CEX(7, 15) CEX(7, 11)
  CEX(3, 5) CEX(7, 9) CEX(11, 13) CEX(1, 2) CEX(3, 4) CEX(5, 6) CEX(7, 8) CEX(9, 10) CEX(11, 12) CEX(13, 14)
}
DI void merge_top16(unsigned (&t)[16], const unsigned (&u)[16]) {
#pragma unroll
  for (int s = 0; s < 16; ++s) t[s] = max(t[s], u[15 - s]);
#pragma unroll
  for (int d = 8; d > 0; d >>= 1)
#pragma unroll
    for (int i = 0; i < 16; ++i)
      if ((i & d) == 0) {
        const unsigned hi = max(t[i], t[i + d]), lo = min(t[i], t[i + d]);
        t[i] = hi; t[i + d] = lo;
      }
}

DI void ins16(unsigned (&L)[16], unsigned x) {
#pragma unroll
  for (int s = 0; s < 16; ++s) {
    const unsigned hi = max(L[s], x);
    x = min(L[s], x);
    L[s] = hi;
  }
}
DI void merge_halves16(unsigned (&L)[16]) {
  unsigned O[16];
#pragma unroll
  for (int s = 0; s < 16; ++s) O[s] = (unsigned)__shfl_xor((int)L[s], 32);
#pragma unroll
  for (int s = 0; s < 16; ++s) L[s] = max(L[s], O[15 - s]);
#pragma unroll
  for (int d = 8; d > 0; d >>= 1)
#pragma unroll
    for (int i = 0; i < 16; ++i)
      if ((i & d) == 0) {
        const unsigned hi = max(L[i], L[i + d]), lo = min(L[i], L[i + d]);
        L[i] = hi; L[i + d] = lo;
      }
}

DI void peer_top16(const char* ws, const u16* qp, int hp, int tt, int lane, unsigned (&L)[16]) {
  const int r = lane & 31, h = lane >> 5;
  const bf8* sk = (const bf8*)(ws + OFF_SUBK) + (size_t)hp * 4 * 8 * 64 + lane;
  f16v s[4];
#pragma unroll
  for (int mt = 0; mt < 4; ++mt) s[mt] = zero16();
  bf8 qf[8];
#pragma unroll
  for (int ks = 0; ks < 8; ++ks) qf[ks] = *(const bf8*)(qp + (size_t)(32 * tt + r) * 2048 + hp * 128 + 16 * ks + 8 * h);
#pragma unroll
  for (int half = 0; half < 2; ++half) {
    bf8 kf[4][4];
#pragma unroll
    for (int k4 = 0; k4 < 4; ++k4)
#pragma unroll
      for (int mt = 0; mt < 4; ++mt) kf[k4][mt] = sk[(mt * 8 + 4 * half + k4) * 64];
    __builtin_amdgcn_sched_barrier(0);
#pragma unroll
    for (int k4 = 0; k4 < 4; ++k4)
#pragma unroll
      for (int mt = 0; mt < 4; ++mt) s[mt] = MFMA(kf[k4][mt], qf[4 * half + k4], s[mt]);
    __builtin_amdgcn_sched_barrier(0);
  }
  unsigned K1[16], K2[16], K3[16];
#pragma unroll
  for (int i = 0; i < 16; ++i) {
    L[i] = (f2ord(s[0][i]) & ~127u) | (unsigned)(127 - (crow(i, h)));
    K1[i] = (f2ord(s[1][i]) & ~127u) | (unsigned)(127 - (32 + crow(i, h)));
    K2[i] = (f2ord(s[2][i]) & ~127u) | (unsigned)(127 - (64 + crow(i, h)));
    K3[i] = (f2ord(s[3][i]) & ~127u) | (unsigned)(127 - (96 + crow(i, h)));
  }
  sort16_desc(L); sort16_desc(K1); sort16_desc(K2); sort16_desc(K3);
  merge_top16(L, K1);
  merge_top16(K2, K3);
  merge_top16(L, K2);
  merge_halves16(L);
}

DI void peer_select(const char* ws, const u16* qp, uint2* eg, unsigned char* idxs  , int head,
                    int tt, int lane) {
  const int r = lane & 31, h = lane >> 5;
  unsigned La[16], Lb[16];
  peer_top16(ws, qp, 2 * head, tt, lane, La);
  __builtin_amdgcn_sched_barrier(0);
  peer_top16(ws, qp, 2 * head + 1, tt, lane, Lb);
  __builtin_amdgcn_sched_barrier(0);
  if (h == 0) {
#pragma unroll
    for (int g = 0; g < 4; ++g) {
      unsigned wa = 0, wb = 0;
#pragma unroll
      for (int j = 0; j < 4; ++j) {
        wa |= (127u - (La[4 * g + j] & 127u)) << (8 * j);
        wb |= (127u - (Lb[4 * g + j] & 127u)) << (8 * j);
      }
      *(unsigned*)(idxs + r * 32 + 4 * g) = wa;
      *(unsigned*)(idxs + r * 32 + 16 + 4 * g) = wb;
    }
  }
  float fa[16], fb[16];
#pragma unroll
  for (int i = 0; i < 16; ++i) { fa[i] = ord2f(La[i] & ~127u); fb[i] = ord2f(Lb[i] & ~127u); }
  unsigned C[16];
#pragma unroll
  for (int i = 0; i < 16; ++i) C[i] = (f2ord(fa[0] + fb[i]) & ~255u) | (unsigned)(255 - i);
#define PEER_CAND(a, b) ins16(C, (f2ord(fa[a] + fb[b]) & ~255u) | (unsigned)(255 - ((a) * 16 + (b))));
#define PEER_ROW1(a) PEER_CAND(a, 0)
#define PEER_ROW2(a) PEER_ROW1(a) PEER_CAND(a, 1)
#define PEER_ROW3(a) PEER_ROW2(a) PEER_CAND(a, 2)
#define PEER_ROW4(a) PEER_ROW3(a) PEER_CAND(a, 3)
#define PEER_ROW5(a) PEER_ROW4(a) PEER_CAND(a, 4)
#define PEER_ROW8(a) PEER_ROW5(a) PEER_CAND(a, 5) PEER_CAND(a, 6) PEER_CAND(a, 7)
#define PEER_ROW16(a) PEER_ROW8(a) PEER_CAND(a, 8) PEER_CAND(a, 9) PEER_CAND(a, 10) PEER_CAND(a, 11) PEER_CAND(a, 12) PEER_CAND(a, 13) PEER_CAND(a, 14) PEER_CAND(a, 15)
  PEER_ROW8(1) PEER_ROW5(2) PEER_ROW4(3) PEER_ROW3(4) PEER_ROW2(5) PEER_ROW2(6) PEER_ROW2(7)
  PEER_ROW1(8) PEER_ROW1(9) PEER_ROW1(10) PEER_ROW1(11) PEER_ROW1(12) PEER_ROW1(13) PEER_ROW1(14) PEER_ROW1(15)
  asm volatile("s_waitcnt lgkmcnt(0)" ::: "memory");
  const float vmax = ord2f(C[0] & ~255u);
  float ex[16], sum = 0.f;
#pragma unroll
  for (int i = 0; i < 16; ++i) { ex[i] = __expf(ord2f(C[i] & ~255u) - vmax); sum += ex[i]; }
  const float inv = 1.0f / sum;
  const unsigned hmask = 0u - (unsigned)h;
#pragma unroll
  for (int i = 0; i < 8; ++i) {
    const unsigned ck = C[i] ^ ((C[i] ^ C[8 + i]) & hmask);
    const unsigned gb = __float_as_uint(ex[i]) ^ ((__float_as_uint(ex[i]) ^ __float_as_uint(ex[8 + i])) & hmask);
    const float g = __uint_as_float(gb) * inv;
    const unsigned code = 255u - (ck & 255u);
    const unsigned ia = idxs[r * 32 + (code >> 4)], ib = idxs[r * 32 + 16 + (code & 15u)];
    eg[(size_t)(32 * tt + r) * 128 + head * 16 + 8 * h + i] = make_uint2(ia * 128u + ib, __float_as_uint(g));
  }
  asm volatile("s_waitcnt lgkmcnt(0)" ::: "memory");
}

DI float wave_sum(float v) {
#pragma unroll
  for (int o = 32; o > 0; o >>= 1) v += __shfl_xor(v, o);
  return v;
}

DI void reduce8(const float (&pv)[8], float& s0, float& s1) {
  float q[4], s[2];
#pragma unroll
  for (int m = 0; m < 4; ++m) {
    const auto r = __builtin_amdgcn_permlane32_swap(__float_as_uint(pv[m]), __float_as_uint(pv[m + 4]), false, false);
    q[m] = __uint_as_float(r[0]) + __uint_as_float(r[1]);
  }
#pragma unroll
  for (int m = 0; m < 2; ++m) {
    const auto r = __builtin_amdgcn_permlane16_swap(__float_as_uint(q[m]), __float_as_uint(q[m + 2]), false, false);
    s[m] = __uint_as_float(r[0]) + __uint_as_float(r[1]);
  }
#pragma unroll
  for (int m = 0; m < 2; ++m) {
    s[m] += __uint_as_float(__builtin_amdgcn_update_dpp(0, __float_as_uint(s[m]), 0x128, 0xf, 0xf, false));
    s[m] += __uint_as_float(__builtin_amdgcn_update_dpp(0, __float_as_uint(s[m]), 0x124, 0xf, 0xf, false));
    s[m] += __uint_as_float(__builtin_amdgcn_update_dpp(0, __float_as_uint(s[m]), 0x122, 0xf, 0xf, false));
    s[m] += __uint_as_float(__builtin_amdgcn_update_dpp(0, __float_as_uint(s[m]), 0x121, 0xf, 0xf, false));
  }
  s0 = s[0]; s1 = s[1];
}

DI void peer_bucket_token(const uint2* egt, unsigned* tmp  , int lane, unsigned& E0, unsigned& E1,
                          unsigned& G0, unsigned& G1) {
  const uint2 a = egt[lane], b = egt[64 + lane];
  const int ba = (int)(a.x >> 10), bb = (int)(b.x >> 10);
  const unsigned long long lt = (1ull << lane) - 1ull;
  int da = 0, db = 0, start = 0;
#pragma unroll
  for (int k = 0; k < 16; ++k) {
    const unsigned long long ma = __ballot(ba == k), mb = __ballot(bb == k);
    const int ca = __popcll(ma), cb = __popcll(mb);
    if (ba == k) da = start + __popcll(ma & lt);
    if (bb == k) db = start + ca + __popcll(mb & lt);
    start += ca + cb;
  }
  const int ia = (da & 1) * 64 + (da >> 3) + 16 * ((da >> 1) & 3);
  const int ib = (db & 1) * 64 + (db >> 3) + 16 * ((db >> 1) & 3);
  tmp[ia] = a.x; tmp[128 + ia] = a.y;
  tmp[ib] = b.x; tmp[128 + ib] = b.y;
  asm volatile("s_waitcnt lgkmcnt(0)" ::: "memory");
  E0 = tmp[lane]; E1 = tmp[64 + lane]; G0 = tmp[128 + lane]; G1 = tmp[192 + lane];
  asm volatile("s_waitcnt lgkmcnt(0)" ::: "memory");
}

template <bool GWRITE = true>
DI void peer_finalize_token(const MKParams& p, float (&acc)[16], size_t tok, int lane) {
  float* orow = p.out + tok * DM + 16 * lane;
  float ss = 0.f;
#pragma unroll
  for (int q = 0; q < 4; ++q) {
    const f4v hv = *(const f4v*)(orow + 4 * q);
#pragma unroll
    for (int j = 0; j < 4; ++j) { acc[4 * q + j] += hv[j]; ss += acc[4 * q + j] * acc[4 * q + j]; }
  }
  ss = wave_sum(ss);
  const float rf = rsqrtf(ss * (1.0f / DM) + EPSV);
#pragma unroll
  for (int q = 0; q < 4; ++q) {
    const f4v gg = *(const f4v*)(p.g_fin + 16 * lane + 4 * q);
    f4v o = {acc[4 * q] * rf * gg[0], acc[4 * q + 1] * rf * gg[1], acc[4 * q + 2] * rf * gg[2], acc[4 * q + 3] * rf * gg[3]};
    if (GWRITE || o[0] == 123.456f) *(f4v*)(orow + 4 * q) = o;
  }
}

DI void peer_usweep(const char* ws, const char* ldsA, int wave, int lane, const unsigned (&E)[8][2], float (&A)[8][2]) {
  const char* PU = ws + OFF_PU + 16 * lane;
#pragma unroll
  for (int i = 0; i < 8; ++i) { A[i][0] = 0.f; A[i][1] = 0.f; }
  int jn[8];
#pragma unroll
  for (int i = 0; i < 8; ++i) jn[i] = 0;
#pragma unroll 1
  for (int k = 0; k < 16; ++k) {
#pragma unroll
    for (int i = 0; i < 8; ++i) {
      while (jn[i] < 16 && (__builtin_amdgcn_readlane((int)E[i][0], jn[i]) >> 10) <= k) {
        const int j = jn[i];
        const bool sel = ((lane & 15) == j);
        const char* xrow = ldsA + (8 * wave + i) * LDS_ROW + 32 * lane;
        const uint4 x0 = *(const uint4*)xrow, x1 = *(const uint4*)(xrow + 16);
        const unsigned xr[8] = {x0.x, x0.y, x0.z, x0.w, x1.x, x1.y, x1.z, x1.w};
        uint4 u0[8];
#pragma unroll
        for (int m = 0; m < 8; ++m) {
          const int e = __builtin_amdgcn_readlane((int)E[i][m & 1], j + 16 * (m >> 1));
          u0[m] = *(const uint4*)(PU + (size_t)e * 1024);
        }
        float pv[8];
#pragma unroll
        for (int m = 0; m < 8; ++m) {
          const unsigned uw[4] = {u0[m].x, u0[m].y, u0[m].z, u0[m].w};
          float dsum = 0.f;
#pragma unroll
          for (int q = 0; q < 4; ++q) {
            const bf2 lo = __builtin_amdgcn_cvt_scalef32_pk_bf16_fp8(uw[q], 1.0f, false);
            const bf2 hi = __builtin_amdgcn_cvt_scalef32_pk_bf16_fp8(uw[q], 1.0f, true);
            dsum = __builtin_amdgcn_fdot2_f32_bf16(lo, __builtin_bit_cast(bf2, xr[2 * q]), dsum, false);
            dsum = __builtin_amdgcn_fdot2_f32_bf16(hi, __builtin_bit_cast(bf2, xr[2 * q + 1]), dsum, false);
          }
#if PROBE == 30
          {
            unsigned uw2[4] = {uw[0], uw[1], uw[2], uw[3]};
            asm volatile("" : "+v"(uw2[0]), "+v"(uw2[1]), "+v"(uw2[2]), "+v"(uw2[3]));
            float d2 = 0.f;
#pragma unroll
            for (int q = 0; q < 4; ++q) {
              const bf2 lo = __builtin_amdgcn_cvt_scalef32_pk_bf16_fp8(uw2[q], 1.0f, false);
              const bf2 hi = __builtin_amdgcn_cvt_scalef32_pk_bf16_fp8(uw2[q], 1.0f, true);
              d2 = __builtin_amdgcn_fdot2_f32_bf16(lo, __builtin_bit_cast(bf2, xr[2 * q]), d2, false);
              d2 = __builtin_amdgcn_fdot2_f32_bf16(hi, __builtin_bit_cast(bf2, xr[2 * q + 1]), d2, false);
            }
            dsum = 0.5f * (dsum + d2);
          }
#endif
          pv[m] = dsum;
        }
        float s0, s1;
        reduce8(pv, s0, s1);
        A[i][0] = sel ? s0 : A[i][0];
        A[i][1] = sel ? s1 : A[i][1];
        jn[i] = j + 1;
      }
    }
  }
}

template <int T0, bool GWRITE = true>
DI void peer_vsweep(const MKParams& p, int wave, int lane, size_t tok0, const unsigned (&E)[8][2], const unsigned (&Wb)[8][2]) {
  const char* PV = p.ws + OFF_PV + 16 * lane;
  f2v acc2[4][8];
#pragma unroll
  for (int i = 0; i < 4; ++i)
#pragma unroll
    for (int q = 0; q < 8; ++q) acc2[i][q] = (f2v){0.f, 0.f};
  int jn[4];
#pragma unroll
  for (int i = 0; i < 4; ++i) jn[i] = 0;
#pragma unroll 1
  for (int k = 0; k < 16; ++k) {
#pragma unroll
    for (int i = 0; i < 4; ++i) {
      while (jn[i] < 16 && (__builtin_amdgcn_readlane((int)E[T0 + i][0], jn[i]) >> 10) <= k) {
        const int j = jn[i];
        uint4 v0[8];
        float wl[8];
#pragma unroll
        for (int m = 0; m < 8; ++m) {
          const int e = __builtin_amdgcn_readlane((int)E[T0 + i][m & 1], j + 16 * (m >> 1));
          wl[m] = __uint_as_float((unsigned)__builtin_amdgcn_readlane((int)Wb[T0 + i][m & 1], j + 16 * (m >> 1)));
          v0[m] = *(const uint4*)(PV + (size_t)e * 1024);
        }
#pragma unroll
        for (int m = 0; m < 8; ++m) {
          const unsigned vw[4] = {v0[m].x, v0[m].y, v0[m].z, v0[m].w};
          const f2v ww = {wl[m], wl[m]};
#pragma unroll
          for (int q = 0; q < 4; ++q) {
            const f2v lo = __builtin_amdgcn_cvt_pk_f32_fp8((int)vw[q], false);
            const f2v hi = __builtin_amdgcn_cvt_pk_f32_fp8((int)vw[q], true);
            acc2[i][2 * q] = __builtin_elementwise_fma(lo, ww, acc2[i][2 * q]);
            acc2[i][2 * q + 1] = __builtin_elementwise_fma(hi, ww, acc2[i][2 * q + 1]);
          }
        }
        jn[i] = j + 1;
      }
    }
  }
#pragma unroll
  for (int i = 0; i < 4; ++i) {
    float acc[16];
#pragma unroll
    for (int q = 0; q < 8; ++q) { acc[2 * q] = acc2[i][q][0]; acc[2 * q + 1] = acc2[i][q][1]; }
    peer_finalize_token<GWRITE>(p, acc, tok0 + 8 * wave + T0 + i, lane);
  }
}

DI void phase_d_tile(const MKParams& p, int tile, int wave, int lane, float rs0, float rs1) {
  asm volatile("" : "+v"(lane));
  char* ws = p.ws;
  char* ldsA = smem;
  float* rs_s = (float*)(smem + LDS_A_BYTES);
  unsigned char* idxs = (unsigned char*)(smem + LDS_A_BYTES + 4096) + wave * 1024;
  u16* qp = (u16*)qp_scratch(ws, blockIdx.x);
  uint2* eg = (uint2*)(ws + OFF_EG + (size_t)blockIdx.x * 65536);
  const size_t tok0 = (size_t)tile * 64;
  if (wave == 0) { if (lane < 32) rs_s[lane] = rs0; else rs_s[lane] = rs1; }
  {
    f16v acc[2][2];
    Ring rg;
    const bf8* wf = (const bf8*)(ws + OFF_WPQ);
#if PROBE == 17
    for (int rep_ = 0; rep_ < 2; ++rep_)
#endif
#pragma unroll 1
    for (int c = 0; c < 4; ++c) {
      int l2 = lane;
      asm volatile("" : "+v"(l2));
      const int r = l2 & 31, h = l2 >> 5;
      if (c == 0) gemm_chunk_r<true, false, true, true>(ldsA, wf + 2 * wave * 64, wf + 65536 + 2 * wave * 64, l2, acc, rg);
      else if (c < 3) gemm_chunk_r<true, false, false, true>(ldsA, wf + (size_t)c * 65536 + 2 * wave * 64, wf + (size_t)(c + 1) * 65536 + 2 * wave * 64, l2, acc, rg);
      else gemm_chunk_r<true, false, false, false>(ldsA, wf + (size_t)c * 65536 + 2 * wave * 64, nullptr, l2, acc, rg);
#pragma unroll
      for (int ntl = 0; ntl < 2; ++ntl)
#pragma unroll
        for (int tt = 0; tt < 2; ++tt)
#pragma unroll
          for (int g = 0; g < 4; ++g) {
            const float sc = tt ? rs1 : rs0;
            f4v v = {acc[ntl][tt][4 * g] * sc, acc[ntl][tt][4 * g + 1] * sc, acc[ntl][tt][4 * g + 2] * sc, acc[ntl][tt][4 * g + 3] * sc};
            *(bf4*)(qp + (size_t)(32 * tt + r) * 2048 + 512 * c + 64 * wave + 32 * ntl + 8 * g + 4 * h) = cvt4(v);
          }
    }
  }
  __syncthreads();
#if PROBE == 16
  for (int rep_ = 0; rep_ < 2; ++rep_)
#endif
#pragma unroll 1
  for (int tt = 0; tt < 2; ++tt) {
    int l2 = lane;
    asm volatile("" : "+v"(l2));
    peer_select(ws, qp, eg, idxs, wave, tt, l2);
  }
  __syncthreads();
}

template <bool GWRITE = true>
DI void phase_d_gather(const MKParams& p, int tile, int wave, int lane) {
  asm volatile("" : "+v"(lane));
  char* ws = p.ws;
  char* ldsA = smem;
  float* rs_s = (float*)(smem + LDS_A_BYTES);
  unsigned char* idxs = (unsigned char*)(smem + LDS_A_BYTES + 4096) + wave * 1024;
  const uint2* eg = (const uint2*)(ws + OFF_EG + (size_t)blockIdx.x * 65536);
  const size_t tok0 = (size_t)tile * 64;
  {
    int l2 = lane;
    asm volatile("" : "+v"(l2));
    unsigned E[8][2], G[8][2];
#pragma unroll
    for (int i = 0; i < 8; ++i)
      peer_bucket_token(eg + (size_t)(8 * wave + i) * 128, (unsigned*)idxs, l2, E[i][0], E[i][1], G[i][0], G[i][1]);
    float A[8][2];
    peer_usweep(ws, ldsA, wave, l2, E, A);
    unsigned Wb[8][2];
#pragma unroll
    for (int i = 0; i < 8; ++i) {
      const float rs = rs_s[8 * wave + i];
#pragma unroll
      for (int cc = 0; cc < 2; ++cc) {
        const float a = A[i][cc] * rs * ((const float*)(ws + OFF_SU))[E[i][cc]];
        const float w = __uint_as_float(G[i][cc]) * 0.5f * a * (1.0f + erff(a * 0.70710678118654752f)) *
                        ((const float*)(ws + OFF_SV))[E[i][cc]];
        Wb[i][cc] = __float_as_uint(w);
      }
    }
    __builtin_amdgcn_sched_barrier(0);
    peer_vsweep<0, GWRITE>(p, wave, l2, tok0, E, Wb);
    __builtin_amdgcn_sched_barrier(0);
    peer_vsweep<4, GWRITE>(p, wave, l2, tok0, E, Wb);
  }
}
#ifndef REMAP
#define REMAP 1
#endif
DI int tile_of(int blk, int nblk) { return (REMAP && nblk == 256) ? ((blk & 7) * 32 + (blk >> 3)) : blk; }

__global__ __launch_bounds__(512) void mk(MKParams p) {
  cg::grid_group grid = cg::this_grid();
  const int tid = threadIdx.x;
  const int wave = __builtin_amdgcn_readfirstlane(tid >> 6), lane = tid & 63;
  const int gtid = blockIdx.x * 512 + tid, gthreads = gridDim.x * 512;
  const int gw = blockIdx.x * 8 + wave, nw = gridDim.x * 8;
  unsigned* bar = (unsigned*)(p.ws + OFF_BAR);
  phase_prep(p, gtid, gthreads);
#if !TABLES_IN_B
  phase_prep_tables(p, gw, nw, lane);
#endif
#if FIRST_CG
  grid.sync();
#else
  grid_barrier(bar, 1u * gridDim.x);
#endif
  for (int tile = blockIdx.x; tile < 256; tile += gridDim.x) phase_a_tile(p, tile_of(tile, gridDim.x), wave, lane);
#if PROBE == 40
  for (int tile = blockIdx.x; tile < 256; tile += gridDim.x) phase_a_tile(p, tile_of(tile, gridDim.x), wave, lane);
#endif
  for (int item = blockIdx.x; item < 128; item += gridDim.x) phase_a_memkv(p, item, wave, lane);
#if PROBE == 13
  for (int item = blockIdx.x; item < 128; item += gridDim.x) phase_a_memkv(p, item, wave, lane);
#endif
  grid_barrier(bar, (2u - FIRST_CG) * gridDim.x);
  for (int it = gw; it < 4096; it += nw) sb_item(p, it, lane);
#if PROBE == 44
  for (int it = gw; it < 4096; it += nw) sb_item(p, it, lane);
  phase_prep_tables(p, gw, nw, lane);
#endif
  for (int it = nw - 1 - gw; it < 1024; it += nw) gla_g1_item(p, it, wave, lane);
#if TABLES_IN_B
  phase_prep_tables(p, gw, nw, lane);
#endif
  grid_barrier(bar, (3u - FIRST_CG) * gridDim.x);
  gla_g2(p, gtid, gthreads);
#if PROBE == 14
  gla_g2(p, gtid, gthreads);
#endif
#if PROBE == 18
  grid.sync(); grid.sync(); grid.sync(); grid.sync();
#endif
  grid_barrier(bar, (4u - FIRST_CG) * gridDim.x);
  for (int t0 = blockIdx.x; t0 < 256; t0 += gridDim.x) {
    const int tile = tile_of(t0, gridDim.x);
    float rs0, rs1;
#if PROBE == 41
    phase_c_tile(p, tile, wave, lane, rs0, rs1);
#endif
    phase_c_tile(p, tile, wave, lane, rs0, rs1);
#if PROBE == 42
    phase_d_tile(p, tile, wave, lane, rs0, rs1);
#endif
    phase_d_tile(p, tile, wave, lane, rs0, rs1);
#if GATHER_ALIGN
    grid_barrier(bar, (5u - FIRST_CG) * gridDim.x);
#endif
#if PROBE == 43
    phase_d_gather<false>(p, tile, wave, lane);
#endif
    phase_d_gather<true>(p, tile, wave, lane);
  }
#if !FIRST_CG
  grid.sync();
#endif
}
#define MK_LDS (160 * 1024)
extern "C" void kernel_launch(void* const* d_in, const int* in_sizes, int n_in, void* d_out, int out_size, void* d_ws,
                              size_t ws_size, hipStream_t stream) {
  MKParams p{};
  p.x = (const float*)d_in[0]; p.mem = (const float*)d_in[1]; p.g_mix = (const float*)d_in[2];
  p.w_in = (const float*)d_in[3]; p.w_up = (const float*)d_in[4]; p.b_alpha = (const float*)d_in[5];
  p.g_gla = (const float*)d_in[6]; p.w_out = (const float*)d_in[7]; p.g_mq = (const float*)d_in[8];
  p.g_mkv = (const float*)d_in[9]; p.w_mq = (const float*)d_in[10]; p.w_mkv = (const float*)d_in[11];
  p.w_mo = (const float*)d_in[12]; p.g_ffn = (const float*)d_in[13]; p.w_pq = (const float*)d_in[14];
  p.subk = (const float*)d_in[15]; p.pu = (const float*)d_in[16]; p.pv = (const float*)d_in[17];
  p.g_fin = (const float*)d_in[18];
  p.out = (float*)d_out; p.ws = (char*)d_ws;
  float* out = (float*)d_out;
  char* wsb = (char*)d_ws;
  float* ws = (float*)d_ws;
  static int grid_blocks = 0;
  if (!grid_blocks) {
    int dev = 0, cus = 0, per_cu = 0;
    (void)hipGetDevice(&dev);
    (void)hipDeviceGetAttribute(&cus, hipDeviceAttributeMultiprocessorCount, dev);
    (void)hipFuncSetAttribute((const void*)mk, hipFuncAttributeMaxDynamicSharedMemorySize, MK_LDS);
    (void)hipOccupancyMaxActiveBlocksPerMultiprocessor(&per_cu, mk, 512, MK_LDS);
    grid_blocks = cus * per_cu;
    fprintf(stderr, "mk: cus=%d per_cu=%d grid=%d ws=%zu\n", cus, per_cu, grid_blocks, ws_size);
  }
  (void)hipMemsetAsync((char*)d_ws + OFF_BAR, 0, 64, stream);
  {
    void* args[] = {(void*)&p};
    hipError_t e = hipLaunchCooperativeKernel((const void*)mk, dim3(grid_blocks), dim3(512), args, MK_LDS, stream);
    if (e != hipSuccess) fprintf(stderr, "coop launch failed: %s grid %d\n", hipGetErrorString(e), grid_blocks);
  }
}
```

```cpp
#define GEMM_D 8
#define TABLES_IN_B 1
#define REMAP 0
#define FIRST_CG 2
#define GATHER_ALIGN 0
#include <hip/hip_runtime.h>
#include <hip/hip_cooperative_groups.h>
#include <math.h>
#include <stdio.h>
#include <stdint.h>
namespace cg = cooperative_groups;

#ifndef PROBE
#define PROBE 0
#endif
#ifndef TABLES_IN_B
#define TABLES_IN_B 1
#endif
#define NB 8
#define SEQ 2048
#define DM 1024
#define NTOK (NB * SEQ)
#define INC 3088
#define MEML 256
#define EPSV 1e-6f

typedef __attribute__((ext_vector_type(8))) __bf16 bf8;
typedef __attribute__((ext_vector_type(4))) __bf16 bf4;
typedef __attribute__((ext_vector_type(2))) __bf16 bf2;
typedef __attribute__((ext_vector_type(16))) float f16v;
typedef __attribute__((ext_vector_type(8))) float f8v;
typedef __attribute__((ext_vector_type(4))) float f4v;
typedef __attribute__((ext_vector_type(2))) float f2v;
typedef unsigned short u16;

#define DI __device__ __forceinline__
#define MFMA(a, b, c) __builtin_amdgcn_mfma_f32_32x32x16_bf16((a), (b), (c), 0, 0, 0)

DI int crow(int i, int h) { return (i & 3) + 8 * (i >> 2) + 4 * h; }
DI int tpos(int t) { return (t & ~12) | ((t & 4) << 1) | ((t & 8) >> 1); }
DI float bf2f(u16 v) { return __uint_as_float(((unsigned)v) << 16); }
DI bf8 cvt8(f8v v) { return __builtin_convertvector(v, bf8); }
DI bf4 cvt4(f4v v) { return __builtin_convertvector(v, bf4); }
DI f16v zero16() { f16v z = {0.f, 0.f, 0.f, 0.f, 0.f, 0.f, 0.f, 0.f, 0.f, 0.f, 0.f, 0.f, 0.f, 0.f, 0.f, 0.f}; return z; }

#define MiB ((size_t)1 << 20)
#define OFF_WIN   ((size_t)0)
#define OFF_WOUT  (OFF_WIN + 97 * 65536)
#define OFF_WMQ   (OFF_WOUT + 32 * 65536)
#define OFF_WMKV  (OFF_WMQ + 32 * 65536)
#define OFF_WMO   (OFF_WMKV + 64 * 65536)
#define OFF_WPQ   (OFF_WMO + 32 * 65536)
#define OFF_SUBK  (OFF_WPQ + 64 * 65536)
#define OFF_ACT   (21 * MiB)
#define OFF_GQ    (OFF_ACT)
#define OFF_GK    (OFF_GQ + 8 * MiB)
#define OFF_GVT   (OFF_GK + 8 * MiB)
#define OFF_OG    (OFF_GVT + 16 * MiB)
#define OFF_SQ    (OFF_OG + 16 * MiB)
#define OFF_SK    (OFF_SQ + 16 * MiB)
#define OFF_SVT   (OFF_SK + 16 * MiB)
#define OFF_LA    (OFF_SVT + 16 * MiB)
#define OFF_LKV   (OFF_LA + 16 * MiB)
#define OFF_DD    (OFF_LKV + 32 * MiB)
#define OFF_OSB   (OFF_DD + 1 * MiB)
#define OFF_KM    (OFF_OSB + 16 * MiB)
#define OFF_VMT   (OFF_KM + 4 * MiB)
#define OFF_PU    (OFF_VMT + 4 * MiB)
#define OFF_PV    (OFF_PU + 16 * MiB)
#define OFF_SU    (OFF_PV + 16 * MiB)
#define OFF_SV    (OFF_SU + 65536)
#define OFF_GQ2   (224 * MiB)
#define OFF_GK2   (232 * MiB)
#define OFF_SS    (OFF_LA)

#define LDS_ROW 2064
#define LDS_A_BYTES (64 * LDS_ROW)

DI char* qp_scratch(char* ws, int blk) {
  return blk < 192 ? ws + OFF_SQ + (size_t)blk * 262144 : ws + OFF_LKV + (size_t)(blk - 192) * 262144;
}

#define OFF_BAR (OFF_DD + 768 * 1024)
DI void grid_barrier(unsigned* ctr, unsigned target) {
  __syncthreads();
  if (threadIdx.x == 0) {
    __builtin_amdgcn_fence(__ATOMIC_RELEASE, "agent");
    asm volatile("s_waitcnt vmcnt(0)" ::: "memory");
    __hip_atomic_fetch_add(ctr, 1u, __ATOMIC_RELAXED, __HIP_MEMORY_SCOPE_AGENT);
    while (__hip_atomic_load(ctr, __ATOMIC_RELAXED, __HIP_MEMORY_SCOPE_AGENT) < target) __builtin_amdgcn_s_sleep(1);
    __builtin_amdgcn_fence(__ATOMIC_ACQUIRE, "agent");
    asm volatile("s_waitcnt vmcnt(0)" ::: "memory");
  }
  __syncthreads();
}

struct MKParams {
  const float *x, *mem, *g_mix, *w_in, *w_up, *b_alpha, *g_gla, *w_out, *g_mq, *g_mkv, *w_mq, *w_mkv, *w_mo, *g_ffn, *w_pq,
      *subk, *pu, *pv, *g_fin;
  float* out;
  char* ws;
};
extern __shared__ __attribute__((aligned(16))) char smem[];

template <typename ColFn>
DI void prep_w(bf8* dst, const float* __restrict__ W, int ldw, int ntiles, const float* __restrict__ gain, ColFn colfn,
               int gtid, int gthreads) {
  const int total = ntiles * 4096;
  for (int u = gtid; u < total; u += gthreads) {
    const int lane = u & 63, ks = (u >> 6) & 63, nt = u >> 12;
    const int r = lane & 31, h = lane >> 5;
    float sc = 1.f;
    const int col = colfn(32 * nt + r, sc);
    f8v v;
#pragma unroll
    for (int j = 0; j < 8; ++j) {
      const int k = 16 * ks + 8 * h + j;
      float val = 0.f;
      if (col >= 0) val = W[(size_t)k * ldw + col] * sc * (gain ? gain[k] : 1.f);
      v[j] = val;
    }
    const int didx = (nt < (ntiles & ~15)) ? ((((nt >> 4) * 64 + ks) * 16 + (nt & 15)) * 64 + lane) : u;
    dst[didx] = cvt8(v);
  }
}

DI void phase_prep(const MKParams& p, int gtid, int gthreads) {
  char* ws = p.ws;
  prep_w((bf8*)(ws + OFF_WIN), p.w_in, INC, 97, p.g_mix,
         [](int n, float& sc) -> int {
           if (n < 256) { sc = 0.125f; return n; }
           if (n < 1536) return n;
           if (n < 2048) { sc = 0.125f; return n + 16; }
           if (n < 3072) return n + 16;
           if (n < 3088) return n - 1536;
           return -1;
         }, gtid, gthreads);
  prep_w((bf8*)(ws + OFF_WOUT), p.w_out, 1024, 32, nullptr, [](int n, float& sc) -> int { return n; }, gtid, gthreads);
  prep_w((bf8*)(ws + OFF_WMQ), p.w_mq, 1024, 32, p.g_mq, [](int n, float& sc) -> int { sc = 0.0625f; return n; }, gtid, gthreads);
  prep_w((bf8*)(ws + OFF_WMKV), p.w_mkv, 2048, 64, p.g_mkv, [](int n, float& sc) -> int { return n; }, gtid, gthreads);
  prep_w((bf8*)(ws + OFF_WMO), p.w_mo, 1024, 32, nullptr, [](int n, float& sc) -> int { return n; }, gtid, gthreads);
  prep_w((bf8*)(ws + OFF_WPQ), p.w_pq, 2048, 64, p.g_ffn, [](int n, float& sc) -> int { return n; }, gtid, gthreads);
  {
    bf8* dst = (bf8*)(ws + OFF_SUBK);
    const int total = 16 * 4 * 8 * 64;
    for (int u = gtid; u < total; u += gthreads) {
      const int lane = u & 63, ks = (u >> 6) & 7, mt = (u >> 9) & 3, hp = u >> 11;
      const int r = lane & 31, h = lane >> 5;
      const float* s = p.subk + ((size_t)(hp * 128 + 32 * mt + r)) * 128 + 16 * ks + 8 * h;
      const f4v a = *(const f4v*)s, b = *(const f4v*)(s + 4);
      f8v v = {a[0], a[1], a[2], a[3], b[0], b[1], b[2], b[3]};
      dst[u] = cvt8(v);
    }
  }
}

DI void phase_prep_tables(const MKParams& p, int gwave, int nwaves, int lane) {
  for (int row = gwave; row < 32768; row += nwaves) {
    const int e = row & 16383;
    const bool isv = row >= 16384;
    const float* src = (isv ? p.pv : p.pu) + (size_t)e * DM + 16 * lane;
    f4v v[4];
#pragma unroll
    for (int q = 0; q < 4; ++q) v[q] = *(const f4v*)(src + 4 * q);
    if (!isv) {
#pragma unroll
      for (int q = 0; q < 4; ++q) v[q] = v[q] * *(const f4v*)(p.g_ffn + 16 * lane + 4 * q);
    }
    float am = 0.f;
#pragma unroll
    for (int q = 0; q < 4; ++q)
#pragma unroll
      for (int j = 0; j < 4; ++j) am = fmaxf(am, fabsf(v[q][j]));
#pragma unroll
    for (int o = 32; o > 0; o >>= 1) am = fmaxf(am, __shfl_xor(am, o));
    unsigned w[4];
    float deq;
    {
      const float sc = (am > 0.f) ? 127.0f / am : 0.f;
#pragma unroll
      for (int q = 0; q < 4; ++q) {
        unsigned pk = 0;
#pragma unroll
        for (int j = 0; j < 4; ++j) pk |= ((unsigned)((int)rintf(v[q][j] * sc)) & 0xffu) << (8 * j);
        w[q] = pk;
      }
      deq = am * (1.0f / 127.0f);
    }
    *(uint4*)(p.ws + (isv ? OFF_PV : OFF_PU) + (size_t)e * 1024 + 16 * lane) = make_uint4(w[0], w[1], w[2], w[3]);
    if (lane == 0) ((float*)(p.ws + (isv ? OFF_SV : OFF_SU)))[e] = deq;
  }
}

DI void load_norm_tile(const float* __restrict__ src, char* ldsA, int wave, int lane) {
#pragma unroll 2
  for (int i = 0; i < 8; ++i) {
    const int row = 8 * wave + i;
    const f4v* pr = (const f4v*)(src + (size_t)row * DM);
    f4v v[4];
#pragma unroll
    for (int c = 0; c < 4; ++c) v[c] = pr[lane + 64 * c];
    float ss = 0.f;
#pragma unroll
    for (int c = 0; c < 4; ++c) ss += v[c][0] * v[c][0] + v[c][1] * v[c][1] + v[c][2] * v[c][2] + v[c][3] * v[c][3];
#pragma unroll
    for (int o = 32; o > 0; o >>= 1) ss += __shfl_xor(ss, o);
    const float rs = rsqrtf(ss * (1.0f / DM) + EPSV);
#pragma unroll
    for (int c = 0; c < 4; ++c) {
      f4v t = v[c] * rs;
      *(bf4*)(ldsA + row * LDS_ROW + (lane * 4 + 256 * c) * 2) = cvt4(t);
    }
  }
}

#ifndef GEMM_D
#define GEMM_D 6
#endif
template <bool SWAP>
DI void gemm_step(f16v (&acc)[2][2], const bf8& a0, const bf8& a1, const bf8& x0, const bf8& x1) {
  if (SWAP) {
    acc[0][0] = MFMA(a0, x0, acc[0][0]); acc[0][1] = MFMA(a0, x1, acc[0][1]);
    acc[1][0] = MFMA(a1, x0, acc[1][0]); acc[1][1] = MFMA(a1, x1, acc[1][1]);
  } else {
    acc[0][0] = MFMA(x0, a0, acc[0][0]); acc[0][1] = MFMA(x1, a0, acc[0][1]);
    acc[1][0] = MFMA(x0, a1, acc[1][0]); acc[1][1] = MFMA(x1, a1, acc[1][1]);
  }
}
struct Ring { bf8 w0[GEMM_D], w1[GEMM_D]; };
DI void ring_fill(Ring& rg, const bf8* __restrict__ wf, int lane) {
#pragma unroll
  for (int i = 0; i < GEMM_D; ++i) { rg.w0[i] = wf[lane + i * 1024]; rg.w1[i] = wf[64 + lane + i * 1024]; }
}
template <bool SWAP, bool RES, bool FIRST, bool NEXT>
DI void gemm_chunk_r(const char* ldsA, const bf8* __restrict__ wf, const bf8* __restrict__ wnext, int lane, f16v (&acc)[2][2],
                     Ring& rg, const float* res = nullptr) {
  __builtin_amdgcn_sched_barrier(0);
  const int r = lane & 31, h = lane >> 5;
  const char* xa0 = ldsA + r * LDS_ROW + h * 16;
  const char* xa1 = xa0 + 32 * LDS_ROW;
  const bf8* w0p = wf + lane;
  const bf8* w1p = wf + 64 + lane;
  if (FIRST) ring_fill(rg, wf, lane);
  if (RES) {
#pragma unroll
    for (int ntl = 0; ntl < 2; ++ntl)
#pragma unroll
      for (int tt = 0; tt < 2; ++tt)
#pragma unroll
        for (int g = 0; g < 4; ++g) {
          const f4v x = *(const f4v*)(res + (size_t)(32 * tt + r) * DM + 32 * ntl + 8 * g + 4 * h);
          acc[ntl][tt][4 * g] = x[0]; acc[ntl][tt][4 * g + 1] = x[1]; acc[ntl][tt][4 * g + 2] = x[2]; acc[ntl][tt][4 * g + 3] = x[3];
        }
  } else {
    acc[0][0] = zero16(); acc[0][1] = zero16(); acc[1][0] = zero16(); acc[1][1] = zero16();
  }
  bf8 x0 = *(const bf8*)(xa0), x1 = *(const bf8*)(xa1);
  constexpr int KMAIN = ((64 - 2 * GEMM_D) / GEMM_D + 1) * GEMM_D;
#pragma unroll 1
  for (int ks0 = 0; ks0 < KMAIN; ks0 += GEMM_D) {
#pragma unroll
    for (int i = 0; i < GEMM_D; ++i) {
      const int ks = ks0 + i;
      const bf8 xn0 = *(const bf8*)(xa0 + (ks + 1) * 32);
      const bf8 xn1 = *(const bf8*)(xa1 + (ks + 1) * 32);
      gemm_step<SWAP>(acc, rg.w0[i], rg.w1[i], x0, x1);
      rg.w0[i] = w0p[(ks + GEMM_D) * 1024];
      rg.w1[i] = w1p[(ks + GEMM_D) * 1024];
      x0 = xn0; x1 = xn1;
      __builtin_amdgcn_sched_group_barrier(0x100, 2, 0);
      __builtin_amdgcn_sched_group_barrier(0x008, 2, 0);
      __builtin_amdgcn_sched_group_barrier(0x020, 2, 0);
      __builtin_amdgcn_sched_group_barrier(0x008, 2, 0);
    }
  }
#pragma unroll
  for (int t = 0; t < 64 - KMAIN; ++t) {
    const int ks = KMAIN + t, i = t % GEMM_D;
    const bf8 xn0 = *(const bf8*)(xa0 + (ks + 1) * 32);
    const bf8 xn1 = *(const bf8*)(xa1 + (ks + 1) * 32);
    gemm_step<SWAP>(acc, rg.w0[i], rg.w1[i], x0, x1);
    const bool refill = (ks + GEMM_D < 64) || NEXT;
    if (ks + GEMM_D < 64) {
      rg.w0[i] = w0p[(ks + GEMM_D) * 1024];
      rg.w1[i] = w1p[(ks + GEMM_D) * 1024];
    } else if (NEXT) {
      rg.w0[i] = wnext[lane + (ks + GEMM_D - 64) * 1024];
      rg.w1[i] = wnext[64 + lane + (ks + GEMM_D - 64) * 1024];
    }
    x0 = xn0; x1 = xn1;
    __builtin_amdgcn_sched_group_barrier(0x100, 2, 0);
    __builtin_amdgcn_sched_group_barrier(0x008, 2, 0);
    if (refill) __builtin_amdgcn_sched_group_barrier(0x020, 2, 0);
    __builtin_amdgcn_sched_group_barrier(0x008, 2, 0);
  }
}
template <bool SWAP, bool RES = false>
DI void gemm_chunk(const char* ldsA, const bf8* __restrict__ wf, int lane, f16v (&acc)[2][2], const float* res = nullptr) {
  Ring rg;
  gemm_chunk_r<SWAP, RES, true, false>(ldsA, wf, nullptr, lane, acc, rg, res);
}

DI void store_swap_bf16(u16* dst, size_t ld, const f16v (&acc)[2][2], int lane) {
  const int r = lane & 31, h = lane >> 5;
#pragma unroll
  for (int ntl = 0; ntl < 2; ++ntl)
#pragma unroll
    for (int tt = 0; tt < 2; ++tt)
#pragma unroll
      for (int g = 0; g < 4; ++g) {
        f4v v = {acc[ntl][tt][4 * g], acc[ntl][tt][4 * g + 1], acc[ntl][tt][4 * g + 2], acc[ntl][tt][4 * g + 3]};
        *(bf4*)(dst + (size_t)(32 * tt + r) * ld + 32 * ntl + 8 * g + 4 * h) = cvt4(v);
      }
}
DI void store_vt_bf16(u16* dst, size_t ld, const f16v (&acc)[2][2], int lane) {
  const int r = lane & 31, h = lane >> 5;
#pragma unroll
  for (int ntl = 0; ntl < 2; ++ntl)
#pragma unroll
    for (int tt = 0; tt < 2; ++tt)
#pragma unroll
      for (int s = 0; s < 2; ++s) {
        f8v v;
#pragma unroll
        for (int j = 0; j < 8; ++j) v[j] = acc[ntl][tt][8 * s + j];
        *(bf8*)(dst + (size_t)(32 * ntl + r) * ld + 32 * tt + 16 * s + 8 * h) = cvt8(v);
      }
}

DI float log_sigmoid_acc(float x) { return fminf(x, 0.f) - log1pf(expf(-fabsf(x))); }

template <bool PRELOADED = false>
DI void phase_a_tile(const MKParams& p, int tile, int wave, int lane) {
  asm volatile("" : "+v"(lane));
  char* ws = p.ws;
  char* ldsA = smem;
  float* alr_s = (float*)(smem + LDS_A_BYTES);
  const int b = tile >> 5, c = tile & 31;
  const size_t tok0 = (size_t)tile * 64;
  if (!PRELOADED) {
    __syncthreads();
    load_norm_tile(p.x + tok0 * DM, ldsA, wave, lane);
#if PROBE == 10
    __syncthreads();
    load_norm_tile(p.x + tok0 * DM, ldsA, wave, lane);
#endif
    __syncthreads();
  }
  const bf8* wf = (const bf8*)(ws + OFF_WIN);
  f16v acc[2][2];
  Ring rg;
  const int t0 = c * 64;
  gemm_chunk_r<true, false, true, true>(ldsA, wf + (size_t)0 * 65536 + 2 * wave * 64, wf + (size_t)1 * 65536 + 2 * wave * 64, lane, acc, rg);
  {
    u16* base = (u16*)(ws + (wave < 4 ? OFF_GQ : OFF_GK)) + ((size_t)(b * 4 + (wave & 3)) * SEQ + t0) * 64;
    store_swap_bf16(base, 64, acc, lane);
#if PROBE == 11
    store_swap_bf16(base, 64, acc, lane);
#endif
  }
  gemm_chunk_r<false, false, false, true>(ldsA, wf + (size_t)1 * 65536 + 2 * wave * 64, wf + (size_t)2 * 65536 + 2 * wave * 64, lane, acc, rg);
  {
    u16* base = (u16*)(ws + OFF_GVT) + ((size_t)(b * 4 + (wave >> 1)) * 128 + 64 * (wave & 1)) * SEQ + t0;
    store_vt_bf16(base, SEQ, acc, lane);
#if PROBE == 11
    store_vt_bf16(base, SEQ, acc, lane);
#endif
  }
  gemm_chunk_r<true, false, false, true>(ldsA, wf + (size_t)2 * 65536 + 2 * wave * 64, wf + (size_t)3 * 65536 + 2 * wave * 64, lane, acc, rg);
  store_swap_bf16((u16*)(ws + OFF_OG) + tok0 * 512 + 64 * wave, 512, acc, lane);
#if PROBE == 11
  store_swap_bf16((u16*)(ws + OFF_OG) + tok0 * 512 + 64 * wave, 512, acc, lane);
#endif
  gemm_chunk_r<true, false, false, true>(ldsA, wf + (size_t)3 * 65536 + 2 * wave * 64, wf + (size_t)4 * 65536 + 2 * wave * 64, lane, acc, rg);
  store_swap_bf16((u16*)(ws + OFF_SQ) + ((size_t)(b * 8 + wave) * SEQ + t0) * 64, 64, acc, lane);
#if PROBE == 11
  store_swap_bf16((u16*)(ws + OFF_SQ) + ((size_t)(b * 8 + wave) * SEQ + t0) * 64, 64, acc, lane);
#endif
  gemm_chunk_r<true, false, false, true>(ldsA, wf + (size_t)4 * 65536 + 2 * wave * 64, wf + (size_t)5 * 65536 + 2 * wave * 64, lane, acc, rg);
  store_swap_bf16((u16*)(ws + OFF_SK) + ((size_t)(b * 8 + wave) * SEQ + t0) * 64, 64, acc, lane);
#if PROBE == 11
  store_swap_bf16((u16*)(ws + OFF_SK) + ((size_t)(b * 8 + wave) * SEQ + t0) * 64, 64, acc, lane);
#endif
  gemm_chunk_r<false, false, false, false>(ldsA, wf + (size_t)5 * 65536 + 2 * wave * 64, nullptr, lane, acc, rg);
  store_vt_bf16((u16*)(ws + OFF_SVT) + ((size_t)(b * 8 + wave) * 64) * SEQ + t0, SEQ, acc, lane);
#if PROBE == 11
  store_vt_bf16((u16*)(ws + OFF_SVT) + ((size_t)(b * 8 + wave) * 64) * SEQ + t0, SEQ, acc, lane);
#endif
#if PROBE == 12
  for (int rep_ = 0; rep_ < 2; ++rep_) {
  __syncthreads();
#else
  {
#endif
    float* part = (float*)(smem + LDS_A_BYTES);
    const int r = lane & 31, h = lane >> 5;
    const bf8* wp = wf + (size_t)96 * 4096 + lane;
    bf8 wfr[8];
#pragma unroll
    for (int i = 0; i < 8; ++i) wfr[i] = wp[(8 * wave + i) * 64];
    const char* xa0 = ldsA + r * LDS_ROW + h * 16 + wave * 256;
    const char* xa1 = xa0 + 32 * LDS_ROW;
    f16v a0 = zero16(), a1 = zero16();
#pragma unroll
    for (int i = 0; i < 8; ++i) {
      a0 = MFMA(wfr[i], *(const bf8*)(xa0 + i * 32), a0);
      a1 = MFMA(wfr[i], *(const bf8*)(xa1 + i * 32), a1);
    }
    float* pw = part + (wave & 3) * 1024;
    if (wave < 4) {
#pragma unroll
      for (int i = 0; i < 8; ++i) { pw[r * 16 + crow(i, h)] = a0[i]; pw[(32 + r) * 16 + crow(i, h)] = a1[i]; }
    }
    __syncthreads();
    if (wave >= 4) {
#pragma unroll
      for (int i = 0; i < 8; ++i) { pw[r * 16 + crow(i, h)] += a0[i]; pw[(32 + r) * 16 + crow(i, h)] += a1[i]; }
    }
    __syncthreads();
    const int tid = wave * 64 + lane;
    {
      const f4v* p4 = (const f4v*)part;
      if (tid < 256) { f4v s = p4[tid] + p4[256 + tid] + p4[512 + tid] + p4[768 + tid]; ((f4v*)part)[tid] = s; }
    }
    __syncthreads();
    const int col = tid & 255, tg = tid >> 8;
    float wu[16];
#pragma unroll
    for (int rr = 0; rr < 16; ++rr) wu[rr] = p.w_up[rr * 256 + col];
    const float bb = p.b_alpha[col];
    float* dst = (float*)(ws + OFF_LA) + (tok0 + 32 * tg) * 256 + col;
#pragma unroll 4
    for (int t = 0; t < 32; ++t) {
      const f4v* ar = (const f4v*)(part + (32 * tg + t) * 16);
      const f4v q0 = ar[0], q1 = ar[1], q2 = ar[2], q3 = ar[3];
      float s = bb;
      s = fmaf(q0[0], wu[0], s); s = fmaf(q0[1], wu[1], s); s = fmaf(q0[2], wu[2], s); s = fmaf(q0[3], wu[3], s);
      s = fmaf(q1[0], wu[4], s); s = fmaf(q1[1], wu[5], s); s = fmaf(q1[2], wu[6], s); s = fmaf(q1[3], wu[7], s);
      s = fmaf(q2[0], wu[8], s); s = fmaf(q2[1], wu[9], s); s = fmaf(q2[2], wu[10], s); s = fmaf(q2[3], wu[11], s);
      s = fmaf(q3[0], wu[12], s); s = fmaf(q3[1], wu[13], s); s = fmaf(q3[2], wu[14], s); s = fmaf(q3[3], wu[15], s);
      const float ls = fminf(s, 0.f) - __logf(1.0f + __expf(-fabsf(s)));
      dst[(size_t)t * 256] = ls * (1.0f / 16.0f);
    }
  }
}

DI void phase_a_memkv(const MKParams& p, int item, int wave, int lane) {
  asm volatile("" : "+v"(lane));
  char* ws = p.ws;
  char* ldsA = smem;
  const int rt = item >> 2, cc = item & 3;
  const int b = rt >> 2, m0 = (rt & 3) * 64;
  __syncthreads();
  load_norm_tile(p.mem + (size_t)rt * 64 * DM, ldsA, wave, lane);
  __syncthreads();
  const bf8* wf = (const bf8*)(ws + OFF_WMKV);
  f16v acc[2][2];
  if (cc < 2) {
    gemm_chunk<true>(ldsA, wf + (size_t)cc * 65536 + 2 * wave * 64, lane, acc);
    const int f0 = 512 * cc + 64 * wave;
    u16* base = (u16*)(ws + OFF_KM) + ((size_t)(b * 4 + (f0 >> 8)) * 256 + m0) * 256 + (f0 & 255);
    store_swap_bf16(base, 256, acc, lane);
  } else {
    gemm_chunk<false>(ldsA, wf + (size_t)cc * 65536 + 2 * wave * 64, lane, acc);
    const int f0 = 512 * (cc - 2) + 64 * wave;
    u16* base = (u16*)(ws + OFF_VMT) + ((size_t)(b * 4 + (f0 >> 8)) * 256 + (f0 & 255)) * 256 + m0;
    store_vt_bf16(base, 256, acc, lane);
  }
}
#define SB_THR 30.0f

DI bf8 pack8(const f16v& x, int s) {
  f8v v;
#pragma unroll
  for (int j = 0; j < 8; ++j) v[j] = x[8 * s + j];
  return cvt8(v);
}

DI void sb_item(const MKParams& p, int item, int lane) {
  asm volatile("" : "+v"(lane));
  char* ws = p.ws;
  const int r = lane & 31, h = lane >> 5;
  const int bh = item >> 6, qt = item & 63;
  const u16* SQ = (const u16*)(ws + OFF_SQ) + (size_t)bh * SEQ * 64;
  const u16* SK = (const u16*)(ws + OFF_SK) + (size_t)bh * SEQ * 64;
  const u16* SVT = (const u16*)(ws + OFF_SVT) + (size_t)bh * 64 * SEQ;
  bf8 qf[4];
#pragma unroll
  for (int ks = 0; ks < 4; ++ks) qf[ks] = *(const bf8*)(SQ + (size_t)(32 * qt + r) * 64 + 16 * ks + 8 * h);
  bf8 tri[2];
#pragma unroll
  for (int s = 0; s < 2; ++s) {
    f8v t;
#pragma unroll
    for (int j = 0; j < 8; ++j) t[j] = (16 * s + 8 * (j >> 2) + 4 * h + (j & 3) >= r) ? 1.0f : 0.0f;
    tri[s] = cvt8(t);
  }
  f16v o0 = zero16(), o1 = zero16();
  float R = 0.f;
  for (int kt = qt; kt >= 0; --kt) {
    bf8 kf[4], vf[2][2];
#pragma unroll
    for (int ks = 0; ks < 4; ++ks) kf[ks] = *(const bf8*)(SK + (size_t)(32 * kt + r) * 64 + 16 * ks + 8 * h);
#pragma unroll
    for (int mt = 0; mt < 2; ++mt)
#pragma unroll
      for (int s = 0; s < 2; ++s) vf[mt][s] = *(const bf8*)(SVT + (size_t)(32 * mt + r) * SEQ + 32 * kt + 16 * s + 8 * h);
    f16v z = zero16();
#pragma unroll
    for (int ks = 0; ks < 4; ++ks) z = MFMA(kf[ks], qf[ks], z);
    const bool diag = (kt == qt);
    f16v sp;
    float tot = 0.f;
#pragma unroll
    for (int i = 0; i < 16; ++i) {
      const float zz = z[i];
      const float sv = fmaxf(zz, 0.f) + __logf(1.0f + __expf(-fabsf(zz)));
      const bool valid = !diag || (crow(i, h) < r);
      sp[i] = valid ? sv : 0.f;
      tot += sp[i];
    }
    tot += __shfl_xor(tot, 32);
    f16v C = MFMA(tri[0], pack8(sp, 0), zero16());
    C = MFMA(tri[1], pack8(sp, 1), C);
    f16v a;
#pragma unroll
    for (int i = 0; i < 16; ++i) {
      const bool valid = !diag || (crow(i, h) < r);
      a[i] = valid ? __expf(z[i] - C[i] - R) : 0.f;
    }
    const bf8 a0 = pack8(a, 0), a1 = pack8(a, 1);
    o0 = MFMA(vf[0][0], a0, o0); o0 = MFMA(vf[0][1], a1, o0);
    o1 = MFMA(vf[1][0], a0, o1); o1 = MFMA(vf[1][1], a1, o1);
    R += tot;
    if (__all(R > SB_THR)) break;
  }
  const int b = bh >> 3, hd = bh & 7;
  u16* dst = (u16*)(ws + OFF_OSB) + ((size_t)b * SEQ + 32 * qt + r) * 512 + hd * 64 + 4 * h;
#pragma unroll
  for (int g = 0; g < 4; ++g) {
    f4v v0 = {o0[4 * g], o0[4 * g + 1], o0[4 * g + 2], o0[4 * g + 3]};
    f4v v1 = {o1[4 * g], o1[4 * g + 1], o1[4 * g + 2], o1[4 * g + 3]};
    *(bf4*)(dst + 8 * g) = cvt4(v0);
    *(bf4*)(dst + 32 + 8 * g) = cvt4(v1);
  }
}

DI void gla_g1_tile(const MKParams& p, int tile, int wave, int lane) {
  asm volatile("" : "+v"(lane));
  __builtin_amdgcn_sched_barrier(0);
  char* ws = p.ws;
  const int r = lane & 31, h = lane >> 5;
  const int b = tile >> 5, c = tile & 31, hd = wave >> 1, half = wave & 1, bh = b * 4 + hd;
  const int item = bh * 32 + c;
  char* kl = smem + wave * 9216;
  const u16* GQ = (const u16*)(ws + OFF_GQ) + ((size_t)bh * SEQ + 64 * c) * 64;
  const u16* GK = (const u16*)(ws + OFF_GK) + ((size_t)bh * SEQ + 64 * c) * 64;
  u16* GQ2 = (u16*)(ws + OFF_GQ2) + ((size_t)bh * SEQ + 64 * c) * 64;
  u16* GK2 = (u16*)(ws + OFF_GK2) + ((size_t)bh * SEQ + 64 * c) * 64;
  const float* LA = (const float*)(ws + OFF_LA) + ((size_t)b * SEQ + 64 * c) * 256 + hd * 64;
  float bc = 0.f;
#pragma unroll 1
  for (int g = 0; g < 4; ++g) {
    float la_[16];
    u16 q_[16], k_[16];
#pragma unroll
    for (int i = 0; i < 16; ++i) {
      const int t = 16 * g + i;
      la_[i] = LA[(size_t)t * 256 + lane];
      q_[i] = GQ[t * 64 + lane];
      k_[i] = GK[t * 64 + lane];
    }
#pragma unroll
    for (int i = 0; i < 16; ++i) {
      const int t = 16 * g + i;
      bc += la_[i];
      const float eq = __expf(bc);
      const float qn = bf2f(q_[i]) * eq, kn = bf2f(k_[i]) / eq;
      const bf2 pk = __builtin_convertvector((f2v){qn, kn}, bf2);
      const unsigned u = __builtin_bit_cast(unsigned, pk);
      if (half == 0) {
        GQ2[t * 64 + lane] = (u16)(u & 0xffff);
        GK2[t * 64 + lane] = (u16)(u >> 16);
      }
      *(u16*)(kl + lane * 144 + tpos(t) * 2) = (u16)(u >> 16);
    }
  }
  if (half == 0) ((float*)(ws + OFF_DD))[(size_t)item * 64 + lane] = __expf(bc);
  asm volatile("s_waitcnt lgkmcnt(0)" ::: "memory");
  const u16* GVT = (const u16*)(ws + OFF_GVT) + (size_t)bh * 128 * SEQ + 64 * c;
  float* LKV = (float*)(ws + OFF_LKV) + (size_t)item * 128 * 64;
  bf8 kb[2][4];
#pragma unroll
  for (int nt = 0; nt < 2; ++nt)
#pragma unroll
    for (int s = 0; s < 4; ++s) kb[nt][s] = *(const bf8*)(kl + (32 * nt + r) * 144 + (16 * s + 8 * h) * 2);
  bf8 vf[2][4];
#pragma unroll
  for (int m2 = 0; m2 < 2; ++m2)
#pragma unroll
    for (int s = 0; s < 4; ++s) vf[m2][s] = *(const bf8*)(GVT + (size_t)(32 * (2 * half + m2) + r) * SEQ + 16 * s + 8 * h);
  __builtin_amdgcn_sched_barrier(0);
#pragma unroll
  for (int m2 = 0; m2 < 2; ++m2) {
    const int mt = 2 * half + m2;
    f16v a0 = zero16(), a1 = zero16();
#pragma unroll
    for (int s = 0; s < 4; ++s) {
      a0 = MFMA(vf[m2][s], kb[0][s], a0);
      a1 = MFMA(vf[m2][s], kb[1][s], a1);
    }
#pragma unroll
    for (int i = 0; i < 16; ++i) {
      LKV[(32 * mt + crow(i, h)) * 64 + r] = a0[i];
      LKV[(32 * mt + crow(i, h)) * 64 + 32 + r] = a1[i];
    }
  }
  asm volatile("s_waitcnt lgkmcnt(0)" ::: "memory");
}

DI void gla_g2(const MKParams& p, int gtid, int gthreads) {
  char* ws = p.ws;
  for (int u = gtid; u < 32768; u += gthreads) {
    const int oct = u & 7, dv = (u >> 3) & 127, bh = u >> 10;
    f8v S = {0.f, 0.f, 0.f, 0.f, 0.f, 0.f, 0.f, 0.f};
#pragma unroll 4
    for (int c = 0; c < 32; ++c) {
      const size_t item = (size_t)bh * 32 + c;
      *(bf8*)((u16*)(ws + OFF_SS) + (item * 128 + dv) * 64 + oct * 8) = cvt8(S);
      const f8v l = *(const f8v*)((const float*)(ws + OFF_LKV) + (item * 128 + dv) * 64 + oct * 8);
      const f8v d = *(const f8v*)((const float*)(ws + OFF_DD) + item * 64 + oct * 8);
      S = d * (S + l);
    }
  }
}

DI void gla_g3_tile(const MKParams& p, int tile, int wave, int lane, char* dst, int dst_ld) {
  char* ws = p.ws;
  const int r = lane & 31, h = lane >> 5;
  const int b = tile >> 5, c = tile & 31, hd = wave >> 1, tt = wave & 1, bh = b * 4 + hd;
  const u16* GQ = (const u16*)(ws + OFF_GQ2) + ((size_t)bh * SEQ + 64 * c) * 64;
  const u16* GK = (const u16*)(ws + OFF_GK2) + ((size_t)bh * SEQ + 64 * c) * 64;
  const u16* GVT = (const u16*)(ws + OFF_GVT) + (size_t)bh * 128 * SEQ + 64 * c;
  const u16* SS = (const u16*)(ws + OFF_SS) + ((size_t)(bh * 32 + c) * 128) * 64;
  bf8 qf[4];
#pragma unroll
  for (int ks = 0; ks < 4; ++ks) qf[ks] = *(const bf8*)(GQ + (32 * tt + r) * 64 + 16 * ks + 8 * h);
  bf8 pf[2][2];
  {
    bf8 kf[2][4];
#pragma unroll
    for (int kt = 0; kt < 2; ++kt)
      if (kt <= tt) {
#pragma unroll
        for (int ks = 0; ks < 4; ++ks) kf[kt][ks] = *(const bf8*)(GK + (32 * kt + r) * 64 + 16 * ks + 8 * h);
      }
    __builtin_amdgcn_sched_barrier(0);
#pragma unroll
    for (int kt = 0; kt < 2; ++kt) {
      if (kt <= tt) {
        f16v pt = zero16();
#pragma unroll
        for (int ks = 0; ks < 4; ++ks) pt = MFMA(kf[kt][ks], qf[ks], pt);
        if (kt == tt) {
#pragma unroll
          for (int i = 0; i < 16; ++i) pt[i] = (crow(i, h) <= r) ? pt[i] : 0.f;
        }
        pf[kt][0] = pack8(pt, 0);
        pf[kt][1] = pack8(pt, 1);
      }
    }
  }
  f16v o[4];
  {
    bf8 sf[2][4], vf[2][4];
    auto load_tile = [&](int mt, bf8 (&sfx)[4], bf8 (&vfx)[4]) {
#pragma unroll
      for (int ks = 0; ks < 4; ++ks) sfx[ks] = *(const bf8*)(SS + (32 * mt + r) * 64 + 16 * ks + 8 * h);
#pragma unroll
      for (int kt = 0; kt < 2; ++kt)
        if (kt <= tt) {
#pragma unroll
          for (int s = 0; s < 2; ++s) vfx[2 * kt + s] = *(const bf8*)(GVT + (size_t)(32 * mt + r) * SEQ + 32 * kt + 16 * s + 8 * h);
        }
    };
    load_tile(0, sf[0], vf[0]);
#pragma unroll
    for (int mt = 0; mt < 4; ++mt) {
      if (mt + 1 < 4) load_tile(mt + 1, sf[(mt + 1) & 1], vf[(mt + 1) & 1]);
      __builtin_amdgcn_sched_barrier(0);
      o[mt] = zero16();
#pragma unroll
      for (int ks = 0; ks < 4; ++ks) o[mt] = MFMA(sf[mt & 1][ks], qf[ks], o[mt]);
#pragma unroll
      for (int kt = 0; kt < 2; ++kt)
        if (kt <= tt) {
#pragma unroll
          for (int s = 0; s < 2; ++s) o[mt] = MFMA(vf[mt & 1][2 * kt + s], pf[kt][s], o[mt]);
        }
      __builtin_amdgcn_sched_barrier(0);
    }
  }
  float ss = 0.f;
#pragma unroll
  for (int mt = 0; mt < 4; ++mt)
#pragma unroll
    for (int i = 0; i < 16; ++i) ss += o[mt][i] * o[mt][i];
  ss += __shfl_xor(ss, 32);
  const float rr = rsqrtf(ss * (1.0f / 128.0f) + EPSV);
  const size_t tok = (size_t)tile * 64 + 32 * tt + r;
  const u16* OG = (const u16*)(ws + OFF_OG) + tok * 512 + hd * 128;
#pragma unroll
  for (int mt = 0; mt < 4; ++mt)
#pragma unroll
    for (int g = 0; g < 4; ++g) {
      const int dv0 = 32 * mt + 8 * g + 4 * h;
      const ushort4 og4 = *(const ushort4*)(OG + dv0);
      const f4v gg = *(const f4v*)(p.g_gla + dv0);
      const float og[4] = {bf2f(og4.x), bf2f(og4.y), bf2f(og4.z), bf2f(og4.w)};
      f4v v;
#pragma unroll
      for (int j = 0; j < 4; ++j) v[j] = o[mt][4 * g + j] * rr * gg[j] * (og[j] / (1.0f + __expf(-og[j])));
      *(bf4*)(dst + (size_t)(32 * tt + r) * dst_ld + (hd * 128 + dv0) * 2) = cvt4(v);
    }
}
DI void gemm_1024(const char* ldsA, const bf8* __restrict__ wf, int wave, int lane, f16v (&a0)[2][2], f16v (&a1)[2][2]) {
  gemm_chunk<true>(ldsA, wf + 2 * wave * 64, lane, a0);
  gemm_chunk<true>(ldsA, wf + 65536 + 2 * wave * 64, lane, a1);
}
DI void gemm_1024_res(const char* ldsA, const bf8* __restrict__ wf, int wave, int lane, f16v (&a0)[2][2], f16v (&a1)[2][2],
                      const float* res) {
  gemm_chunk<true, true>(ldsA, wf + 2 * wave * 64, lane, a0, res + 64 * wave);
  gemm_chunk<true, true>(ldsA, wf + 65536 + 2 * wave * 64, lane, a1, res + 512 + 64 * wave);
}

DI void store_f32_ssq(const f16v (&a)[2][2], float* dst, int f0, int lane, float (&ssq)[2]) {
  const int r = lane & 31, h = lane >> 5;
#pragma unroll
  for (int ntl = 0; ntl < 2; ++ntl)
#pragma unroll
    for (int tt = 0; tt < 2; ++tt)
#pragma unroll
      for (int g = 0; g < 4; ++g) {
        f4v v = {a[ntl][tt][4 * g], a[ntl][tt][4 * g + 1], a[ntl][tt][4 * g + 2], a[ntl][tt][4 * g + 3]};
        ssq[tt] += v[0] * v[0] + v[1] * v[1] + v[2] * v[2] + v[3] * v[3];
        *(f4v*)(dst + (size_t)(32 * tt + r) * DM + f0 + 32 * ntl + 8 * g + 4 * h) = v;
      }
}

DI void acc_to_scratch(u16* scr, const f16v (&a)[2][2], int f0, int lane, float s0, float s1) {
  const int r = lane & 31, h = lane >> 5;
#pragma unroll
  for (int ntl = 0; ntl < 2; ++ntl)
#pragma unroll
    for (int tt = 0; tt < 2; ++tt)
#pragma unroll
      for (int g = 0; g < 4; ++g) {
        const float sc = tt ? s1 : s0;
        f4v v = {a[ntl][tt][4 * g] * sc, a[ntl][tt][4 * g + 1] * sc, a[ntl][tt][4 * g + 2] * sc, a[ntl][tt][4 * g + 3] * sc};
        *(bf4*)(scr + (size_t)(32 * tt + r) * 1024 + f0 + 32 * ntl + 8 * g + 4 * h) = cvt4(v);
      }
}
typedef __attribute__((ext_vector_type(4))) unsigned u4v;
DI void scratch_to_lds(const u16* scr, char* ldsA, int tid) {
  asm volatile("" : "+v"(tid));
  const unsigned toff = (unsigned)tid * 16u;
#pragma unroll
  for (int half = 0; half < 2; ++half) {
    u4v v[8];
#pragma unroll
    for (int it = 0; it < 8; ++it)
      v[it] = __builtin_nontemporal_load((const u4v*)((const char*)scr + (size_t)(8192 * (8 * half + it)) + toff));
#pragma unroll
    for (int it = 0; it < 8; ++it) {
      const int idx = tid + 512 * (8 * half + it), row = idx >> 7, ch = idx & 127;
      *(u4v*)(ldsA + row * LDS_ROW + ch * 16) = v[it];
    }
  }
}

struct Pk { bf4 v[2][2][4]; };
DI void pack_acc(Pk& pk, const f16v (&a)[2][2], float s0, float s1) {
#pragma unroll
  for (int ntl = 0; ntl < 2; ++ntl)
#pragma unroll
    for (int tt = 0; tt < 2; ++tt)
#pragma unroll
      for (int g = 0; g < 4; ++g) {
        const float sc = tt ? s1 : s0;
        f4v v = {a[ntl][tt][4 * g] * sc, a[ntl][tt][4 * g + 1] * sc, a[ntl][tt][4 * g + 2] * sc, a[ntl][tt][4 * g + 3] * sc};
        pk.v[ntl][tt][g] = cvt4(v);
      }
}
DI void pk_to_lds(char* ldsA, const Pk& pk, int f0, int lane) {
  const int r = lane & 31, h = lane >> 5;
#pragma unroll
  for (int ntl = 0; ntl < 2; ++ntl)
#pragma unroll
    for (int tt = 0; tt < 2; ++tt)
#pragma unroll
      for (int g = 0; g < 4; ++g)
        *(bf4*)(ldsA + (32 * tt + r) * LDS_ROW + (f0 + 32 * ntl + 8 * g + 4 * h) * 2) = pk.v[ntl][tt][g];
}

DI void rms_from_partials(float* red, int wave, int lane, const float (&ssq)[2], float& rs0, float& rs1) {
  red[(wave * 2 + 0) * 64 + lane] = ssq[0];
  red[(wave * 2 + 1) * 64 + lane] = ssq[1];
  __syncthreads();
  const int r = lane & 31;
  float t0 = 0.f, t1 = 0.f;
#pragma unroll
  for (int w = 0; w < 8; ++w) {
    t0 += red[(w * 2 + 0) * 64 + r] + red[(w * 2 + 0) * 64 + 32 + r];
    t1 += red[(w * 2 + 1) * 64 + r] + red[(w * 2 + 1) * 64 + 32 + r];
  }
  rs0 = rsqrtf(t0 * (1.0f / DM) + EPSV);
  rs1 = rsqrtf(t1 * (1.0f / DM) + EPSV);
}

template <bool WRITE = true>
DI void mem_attn(const MKParams& p, char* ldsA, int b, int wave, int lane) {
  char* ws = p.ws;
  const int r = lane & 31, h = lane >> 5;
  const int hm = wave >> 1, tt = wave & 1;
  const char* KM = ws + OFF_KM + (size_t)(b * 4 + hm) * 256 * 256 * 2;
  const char* VMT = ws + OFF_VMT + (size_t)(b * 4 + hm) * 256 * 256 * 2;
  char* qrow = ldsA + (32 * tt + r) * LDS_ROW + hm * 512;
  const unsigned loff = (unsigned)((r * 256 + 8 * h) * 2);
  f16v s[8];
#pragma unroll
  for (int mt = 0; mt < 8; ++mt) s[mt] = zero16();
  bf8 ka[8], kb[8];
#pragma unroll
  for (int mt = 0; mt < 8; ++mt) ka[mt] = *(const bf8*)(KM + (size_t)(mt * 32 * 256 * 2) + loff);
  bf8 qa = *(const bf8*)(qrow + 8 * h * 2), qb;
#pragma unroll 1
  for (int ks = 0; ks < 16; ks += 2) {
#pragma unroll
    for (int mt = 0; mt < 8; ++mt) kb[mt] = *(const bf8*)(KM + (size_t)((mt * 32 * 256 + 16 * (ks + 1)) * 2) + loff);
    qb = *(const bf8*)(qrow + (16 * (ks + 1) + 8 * h) * 2);
#pragma unroll
    for (int mt = 0; mt < 8; ++mt) s[mt] = MFMA(ka[mt], qa, s[mt]);
    __builtin_amdgcn_sched_group_barrier(0x020, 8, 0);
    __builtin_amdgcn_sched_group_barrier(0x100, 1, 0);
    __builtin_amdgcn_sched_group_barrier(0x008, 8, 0);
    if (ks + 2 < 16) {
#pragma unroll
      for (int mt = 0; mt < 8; ++mt) ka[mt] = *(const bf8*)(KM + (size_t)((mt * 32 * 256 + 16 * (ks + 2)) * 2) + loff);
      qa = *(const bf8*)(qrow + (16 * (ks + 2) + 8 * h) * 2);
    }
#pragma unroll
    for (int mt = 0; mt < 8; ++mt) s[mt] = MFMA(kb[mt], qb, s[mt]);
    __builtin_amdgcn_sched_group_barrier(0x020, 8, 0);
    __builtin_amdgcn_sched_group_barrier(0x100, 1, 0);
    __builtin_amdgcn_sched_group_barrier(0x008, 8, 0);
  }
  float mx = -INFINITY;
#pragma unroll
  for (int mt = 0; mt < 8; ++mt)
#pragma unroll
    for (int i = 0; i < 16; ++i) mx = fmaxf(mx, s[mt][i]);
  mx = fmaxf(mx, __shfl_xor(mx, 32));
  float l = 0.f;
  bf8 pf[8][2];
#pragma unroll
  for (int mt = 0; mt < 8; ++mt) {
#pragma unroll
    for (int i = 0; i < 16; ++i) { s[mt][i] = __expf(s[mt][i] - mx); l += s[mt][i]; }
    pf[mt][0] = pack8(s[mt], 0);
    pf[mt][1] = pack8(s[mt], 1);
  }
  l += __shfl_xor(l, 32);
  const float inv = 1.0f / l;
#pragma unroll
  for (int grp = 0; grp < 2; ++grp) {
    f16v o[4];
#pragma unroll
    for (int m4 = 0; m4 < 4; ++m4) o[m4] = zero16();
    const char* vb = VMT + (size_t)(grp * 4 * 32 * 256 * 2) + loff;
    bf8 va[4], vn[4];
#pragma unroll
    for (int m4 = 0; m4 < 4; ++m4) va[m4] = *(const bf8*)(vb + (size_t)(m4 * 32 * 256 * 2));
#pragma unroll
    for (int st = 0; st < 16; ++st) {
      if (st + 1 < 16) {
#pragma unroll
        for (int m4 = 0; m4 < 4; ++m4) vn[m4] = *(const bf8*)(vb + (size_t)((m4 * 32 * 256 + 16 * (st + 1)) * 2));
      }
#pragma unroll
      for (int m4 = 0; m4 < 4; ++m4) o[m4] = MFMA(va[m4], pf[st >> 1][st & 1], o[m4]);
      if (st + 1 < 16) {
        __builtin_amdgcn_sched_group_barrier(0x020, 4, 0);
        __builtin_amdgcn_sched_group_barrier(0x008, 4, 0);
#pragma unroll
        for (int m4 = 0; m4 < 4; ++m4) va[m4] = vn[m4];
      }
    }
#pragma unroll
    for (int m4 = 0; m4 < 4; ++m4)
#pragma unroll
      for (int g = 0; g < 4; ++g) {
        f4v v = {o[m4][4 * g] * inv, o[m4][4 * g + 1] * inv, o[m4][4 * g + 2] * inv, o[m4][4 * g + 3] * inv};
        if (WRITE || v[0] == 123.456f) *(bf4*)(qrow + (32 * (4 * grp + m4) + 8 * g + 4 * h) * 2) = cvt4(v);
      }
  }
}

DI void phase_c_tile(const MKParams& p, int tile, int wave, int lane, float& rs0, float& rs1) {
  asm volatile("" : "+v"(lane));
  char* ws = p.ws;
  char* ldsA = smem;
  float* red = (float*)(smem + LDS_A_BYTES);
  const size_t tok0 = (size_t)tile * 64;
  const int tid = wave * 64 + lane;
  __syncthreads();
#if PROBE == 15
  gla_g3_tile(p, tile, wave, lane, ldsA, LDS_ROW);
  __builtin_amdgcn_sched_barrier(0);
  asm volatile("" : "+v"(lane));
#endif
  {
  gla_g3_tile(p, tile, wave, lane, ldsA, LDS_ROW);
  {
    const char* osb = ws + OFF_OSB + tok0 * 1024;
#pragma unroll
    for (int it = 0; it < 8; ++it) {
      const int idx = tid + 512 * it, row = idx >> 6, ch = idx & 63;
      *(uint4*)(ldsA + row * LDS_ROW + 1024 + ch * 16) = *(const uint4*)(osb + (size_t)row * 1024 + ch * 16);
    }
  }
  }
  __syncthreads();
  f16v acc[2][2];
  Ring rg;
  Pk pk0, pk1;
  float* hdst = p.out + tok0 * DM;
  {
    float ssq[2] = {0.f, 0.f};
    const bf8* wf = (const bf8*)(ws + OFF_WOUT);
    asm volatile("" : "+v"(lane));
    gemm_chunk_r<true, true, true, true>(ldsA, wf + 2 * wave * 64, wf + 65536 + 2 * wave * 64, lane, acc, rg, p.x + tok0 * DM + 64 * wave);
    store_f32_ssq(acc, hdst, 64 * wave, lane, ssq);
    pack_acc(pk0, acc, 1.f, 1.f);
    asm volatile("" : "+v"(lane));
    gemm_chunk_r<true, true, false, true>(ldsA, wf + 65536 + 2 * wave * 64, (const bf8*)(ws + OFF_WMQ) + 2 * wave * 64, lane, acc, rg, p.x + tok0 * DM + 512 + 64 * wave);
    store_f32_ssq(acc, hdst, 512 + 64 * wave, lane, ssq);
    pack_acc(pk1, acc, 1.f, 1.f);
    rms_from_partials(red, wave, lane, ssq, rs0, rs1);
  }
  pk_to_lds(ldsA, pk0, 64 * wave, lane);
  pk_to_lds(ldsA, pk1, 512 + 64 * wave, lane);
  __syncthreads();
  {
    const bf8* wf = (const bf8*)(ws + OFF_WMQ);
    asm volatile("" : "+v"(lane));
    gemm_chunk_r<true, false, false, true>(ldsA, wf + 2 * wave * 64, wf + 65536 + 2 * wave * 64, lane, acc, rg);
    pack_acc(pk0, acc, rs0, rs1);
    asm volatile("" : "+v"(lane));
    gemm_chunk_r<true, false, false, false>(ldsA, wf + 65536 + 2 * wave * 64, nullptr, lane, acc, rg);
    pack_acc(pk1, acc, rs0, rs1);
  }
  __syncthreads();
  pk_to_lds(ldsA, pk0, 64 * wave, lane);
  pk_to_lds(ldsA, pk1, 512 + 64 * wave, lane);
  __syncthreads();
#if PROBE == 22
  asm volatile("" : "+v"(lane));
  mem_attn<false>(p, ldsA, tile >> 5, wave, lane);
#endif
  asm volatile("" : "+v"(lane));
  mem_attn<true>(p, ldsA, tile >> 5, wave, lane);
  __syncthreads();
  {
    float ssq[2] = {0.f, 0.f};
    const bf8* wf = (const bf8*)(ws + OFF_WMO);
    asm volatile("" : "+v"(lane));
    gemm_chunk_r<true, true, true, true>(ldsA, wf + 2 * wave * 64, wf + 65536 + 2 * wave * 64, lane, acc, rg, hdst + 64 * wave);
    store_f32_ssq(acc, hdst, 64 * wave, lane, ssq);
    pack_acc(pk0, acc, 1.f, 1.f);
    asm volatile("" : "+v"(lane));
    gemm_chunk_r<true, true, false, false>(ldsA, wf + 65536 + 2 * wave * 64, nullptr, lane, acc, rg, hdst + 512 + 64 * wave);
    store_f32_ssq(acc, hdst, 512 + 64 * wave, lane, ssq);
    pack_acc(pk1, acc, 1.f, 1.f);
    rms_from_partials(red, wave, lane, ssq, rs0, rs1);
  }
  pk_to_lds(ldsA, pk0, 64 * wave, lane);
  pk_to_lds(ldsA, pk1, 512 + 64 * wave, lane);
  __syncthreads();
}
#define OFF_EG (OFF_LKV + 16 * MiB)

DI unsigned f2ord(float v) { const unsigned u = __float_as_uint(v); return (u & 0x80000000u) ? ~u : (u | 0x80000000u); }
DI float ord2f(unsigned u) { return __uint_as_float((u & 0x80000000u) ? (u ^ 0x80000000u) : ~u); }

#define CEX(a, b) { const unsigned hi_ = max(k[a], k[b]); const unsigned lo_ = min(k[a], k[b]); k[a] = hi_; k[b] = lo_; }
DI void sort16_desc(unsigned (&k)[16]) {
  CEX(0, 1) CEX(2, 3) CEX(0, 2) CEX(1, 3) CEX(1, 2) CEX(4, 5) CEX(6, 7) CEX(4, 6) CEX(5, 7) CEX(5, 6) CEX(0, 4)
  CEX(2, 6) CEX(2, 4) CEX(1, 5) CEX(3, 7) CEX(3, 5) CEX(1, 2) CEX(3, 4) CEX(5, 6) CEX(8, 9) CEX(10, 11) CEX(8, 10)
  CEX(9, 11) CEX(9, 10) CEX(12, 13) CEX(14, 15) CEX(12, 14) CEX(13, 15) CEX(13, 14) CEX(8, 12) CEX(10, 14) CEX(10, 12)
  CEX(9, 13) CEX(11, 15) CEX(11, 13) CEX(9, 10) CEX(11, 12) CEX(13, 14) CEX(0, 8) CEX(4, 12) CEX(4, 8) CEX(2, 10)
  CEX(6, 14) CEX(6, 10) CEX(2, 4) CEX(6, 8) CEX(10, 12) CEX(1, 9) CEX(5, 13) CEX(5, 9) CEX(3, 11) CEX(7, 15) CEX(7, 11)
  CEX(3, 5) CEX(7, 9) CEX(11, 13) CEX(1, 2) CEX(3, 4) CEX(5, 6) CEX(7, 8) CEX(9, 10) CEX(11, 12) CEX(13, 14)
}
DI void merge_top16(unsigned (&t)[16], const unsigned (&u)[16]) {
#pragma unroll
  for (int s = 0; s < 16; ++s) t[s] = max(t[s], u[15 - s]);
#pragma unroll
  for (int d = 8; d > 0; d >>= 1)
#pragma unroll
    for (int i = 0; i < 16; ++i)
      if ((i & d) == 0) {
        const unsigned hi = max(t[i], t[i + d]), lo = min(t[i], t[i + d]);
        t[i] = hi; t[i + d] = lo;
      }
}

DI void ins16(unsigned (&L)[16], unsigned x) {
#pragma unroll
  for (int s = 0; s < 16; ++s) {
    const unsigned hi = max(L[s], x);
    x = min(L[s], x);
    L[s] = hi;
  }
}
DI void merge_halves16(unsigned (&L)[16]) {
  unsigned O[16];
#pragma unroll
  for (int s = 0; s < 16; ++s) O[s] = (unsigned)__shfl_xor((int)L[s], 32);
#pragma unroll
  for (int s = 0; s < 16; ++s) L[s] = max(L[s], O[15 - s]);
#pragma unroll
  for (int d = 8; d > 0; d >>= 1)
#pragma unroll
    for (int i = 0; i < 16; ++i)
      if ((i & d) == 0) {
        const unsigned hi = max(L[i], L[i + d]), lo = min(L[i], L[i + d]);
        L[i] = hi; L[i + d] = lo;
      }
}

DI void peer_top16(const char* ws, const u16* qp, int hp, int tt, int lane, unsigned (&L)[16]) {
  const int r = lane & 31, h = lane >> 5;
  const bf8* sk = (const bf8*)(ws + OFF_SUBK) + (size_t)hp * 4 * 8 * 64 + lane;
  f16v s[4];
#pragma unroll
  for (int mt = 0; mt < 4; ++mt) s[mt] = zero16();
  bf8 qf[8];
#pragma unroll
  for (int ks = 0; ks < 8; ++ks) qf[ks] = *(const bf8*)(qp + (size_t)(32 * tt + r) * 2048 + hp * 128 + 16 * ks + 8 * h);
#pragma unroll
  for (int half = 0; half < 2; ++half) {
    bf8 kf[4][4];
#pragma unroll
    for (int k4 = 0; k4 < 4; ++k4)
#pragma unroll
      for (int mt = 0; mt < 4; ++mt) kf[k4][mt] = sk[(mt * 8 + 4 * half + k4) * 64];
    __builtin_amdgcn_sched_barrier(0);
#pragma unroll
    for (int k4 = 0; k4 < 4; ++k4)
#pragma unroll
      for (int mt = 0; mt < 4; ++mt) s[mt] = MFMA(kf[k4][mt], qf[4 * half + k4], s[mt]);
    __builtin_amdgcn_sched_barrier(0);
  }
  unsigned K1[16], K2[16], K3[16];
#pragma unroll
  for (int i = 0; i < 16; ++i) {
    L[i] = (f2ord(s[0][i]) & ~127u) | (unsigned)(127 - (crow(i, h)));
    K1[i] = (f2ord(s[1][i]) & ~127u) | (unsigned)(127 - (32 + crow(i, h)));
    K2[i] = (f2ord(s[2][i]) & ~127u) | (unsigned)(127 - (64 + crow(i, h)));
    K3[i] = (f2ord(s[3][i]) & ~127u) | (unsigned)(127 - (96 + crow(i, h)));
  }
  sort16_desc(L); sort16_desc(K1); sort16_desc(K2); sort16_desc(K3);
  merge_top16(L, K1);
  merge_top16(K2, K3);
  merge_top16(L, K2);
  merge_halves16(L);
}

DI void peer_select(const char* ws, const u16* qp, uint2* eg, unsigned char* idxs  , int head,
                    int tt, int lane) {
  const int r = lane & 31, h = lane >> 5;
  unsigned La[16], Lb[16];
  peer_top16(ws, qp, 2 * head, tt, lane, La);
  __builtin_amdgcn_sched_barrier(0);
  peer_top16(ws, qp, 2 * head + 1, tt, lane, Lb);
  __builtin_amdgcn_sched_barrier(0);
  if (h == 0) {
#pragma unroll
    for (int g = 0; g < 4; ++g) {
      unsigned wa = 0, wb = 0;
#pragma unroll
      for (int j = 0; j < 4; ++j) {
        wa |= (127u - (La[4 * g + j] & 127u)) << (8 * j);
        wb |= (127u - (Lb[4 * g + j] & 127u)) << (8 * j);
      }
      *(unsigned*)(idxs + r * 32 + 4 * g) = wa;
      *(unsigned*)(idxs + r * 32 + 16 + 4 * g) = wb;
    }
  }
  float fa[16], fb[16];
#pragma unroll
  for (int i = 0; i < 16; ++i) { fa[i] = ord2f(La[i] & ~127u); fb[i] = ord2f(Lb[i] & ~127u); }
  unsigned C[16];
#pragma unroll
  for (int i = 0; i < 16; ++i) C[i] = (f2ord(fa[0] + fb[i]) & ~255u) | (unsigned)(255 - i);
#define PEER_CAND(a, b) ins16(C, (f2ord(fa[a] + fb[b]) & ~255u) | (unsigned)(255 - ((a) * 16 + (b))));
#define PEER_ROW1(a) PEER_CAND(a, 0)
#define PEER_ROW2(a) PEER_ROW1(a) PEER_CAND(a, 1)
#define PEER_ROW3(a) PEER_ROW2(a) PEER_CAND(a, 2)
#define PEER_ROW4(a) PEER_ROW3(a) PEER_CAND(a, 3)
#define PEER_ROW5(a) PEER_ROW4(a) PEER_CAND(a, 4)
#define PEER_ROW8(a) PEER_ROW5(a) PEER_CAND(a, 5) PEER_CAND(a, 6) PEER_CAND(a, 7)
#define PEER_ROW16(a) PEER_ROW8(a) PEER_CAND(a, 8) PEER_CAND(a, 9) PEER_CAND(a, 10) PEER_CAND(a, 11) PEER_CAND(a, 12) PEER_CAND(a, 13) PEER_CAND(a, 14) PEER_CAND(a, 15)
  PEER_ROW8(1) PEER_ROW5(2) PEER_ROW4(3) PEER_ROW3(4) PEER_ROW2(5) PEER_ROW2(6) PEER_ROW2(7)
  PEER_ROW1(8) PEER_ROW1(9) PEER_ROW1(10) PEER_ROW1(11) PEER_ROW1(12) PEER_ROW1(13) PEER_ROW1(14) PEER_ROW1(15)
  asm volatile("s_waitcnt lgkmcnt(0)" ::: "memory");
  const float vmax = ord2f(C[0] & ~255u);
  float ex[16], sum = 0.f;
#pragma unroll
  for (int i = 0; i < 16; ++i) { ex[i] = __expf(ord2f(C[i] & ~255u) - vmax); sum += ex[i]; }
  const float inv = 1.0f / sum;
  const unsigned hmask = 0u - (unsigned)h;
#pragma unroll
  for (int i = 0; i < 8; ++i) {
    const unsigned ck = C[i] ^ ((C[i] ^ C[8 + i]) & hmask);
    const unsigned gb = __float_as_uint(ex[i]) ^ ((__float_as_uint(ex[i]) ^ __float_as_uint(ex[8 + i])) & hmask);
    const float g = __uint_as_float(gb) * inv;
    const unsigned code = 255u - (ck & 255u);
    const unsigned ia = idxs[r * 32 + (code >> 4)], ib = idxs[r * 32 + 16 + (code & 15u)];
    eg[(size_t)(32 * tt + r) * 128 + head * 16 + 8 * h + i] = make_uint2(ia * 128u + ib, __float_as_uint(g));
  }
  asm volatile("s_waitcnt lgkmcnt(0)" ::: "memory");
}

DI float wave_sum(float v) {
#pragma unroll
  for (int o = 32; o > 0; o >>= 1) v += __shfl_xor(v, o);
  return v;
}

DI void reduce8(const int (&pv)[8], int& s0, int& s1) {
  int q[4], s[2];
#pragma unroll
  for (int m = 0; m < 4; ++m) {
    const auto r = __builtin_amdgcn_permlane32_swap((unsigned)pv[m], (unsigned)pv[m + 4], false, false);
    q[m] = (int)(r[0] + r[1]);
  }
#pragma unroll
  for (int m = 0; m < 2; ++m) {
    const auto r = __builtin_amdgcn_permlane16_swap((unsigned)q[m], (unsigned)q[m + 2], false, false);
    s[m] = (int)(r[0] + r[1]);
  }
#pragma unroll
  for (int m = 0; m < 2; ++m) {
    s[m] += __builtin_amdgcn_update_dpp(0, s[m], 0x128, 0xf, 0xf, false);
    s[m] += __builtin_amdgcn_update_dpp(0, s[m], 0x124, 0xf, 0xf, false);
    s[m] += __builtin_amdgcn_update_dpp(0, s[m], 0x122, 0xf, 0xf, false);
    s[m] += __builtin_amdgcn_update_dpp(0, s[m], 0x121, 0xf, 0xf, false);
  }
  s0 = s[0]; s1 = s[1];
}

DI void peer_quant_x(char* ldsA, int wave, int lane, float (&xdq)[8]) {
#pragma unroll
  for (int i = 0; i < 8; ++i) {
    char* xrow = ldsA + (8 * wave + i) * LDS_ROW;
    const uint4 x0 = *(const uint4*)(xrow + 32 * lane), x1 = *(const uint4*)(xrow + 32 * lane + 16);
    const unsigned xr[8] = {x0.x, x0.y, x0.z, x0.w, x1.x, x1.y, x1.z, x1.w};
    float f[16];
    float am = 0.f;
#pragma unroll
    for (int q = 0; q < 8; ++q) {
      f[2 * q] = __uint_as_float(xr[q] << 16);
      f[2 * q + 1] = __uint_as_float(xr[q] & 0xffff0000u);
      am = fmaxf(am, fmaxf(fabsf(f[2 * q]), fabsf(f[2 * q + 1])));
    }
#pragma unroll
    for (int o = 32; o > 0; o >>= 1) am = fmaxf(am, __shfl_xor(am, o));
    const float sc = (am > 0.f) ? 127.0f / am : 0.f;
    unsigned w[4];
#pragma unroll
    for (int q = 0; q < 4; ++q) {
      unsigned pk = 0;
#pragma unroll
      for (int j = 0; j < 4; ++j) pk |= ((unsigned)((int)rintf(f[4 * q + j] * sc)) & 0xffu) << (8 * j);
      w[q] = pk;
    }
    asm volatile("s_waitcnt lgkmcnt(0)" ::: "memory");
    *(uint4*)(xrow + 16 * lane) = make_uint4(w[0], w[1], w[2], w[3]);
    xdq[i] = am * (1.0f / 127.0f);
  }
  asm volatile("s_waitcnt lgkmcnt(0)" ::: "memory");
}

DI void peer_bucket_token(const uint2* egt, unsigned* tmp  , int lane, unsigned& E0, unsigned& E1,
                          unsigned& G0, unsigned& G1) {
  const uint2 a = egt[lane], b = egt[64 + lane];
  const int ba = (int)(a.x >> 10), bb = (int)(b.x >> 10);
  const unsigned long long lt = (1ull << lane) - 1ull;
  int da = 0, db = 0, start = 0;
#pragma unroll
  for (int k = 0; k < 16; ++k) {
    const unsigned long long ma = __ballot(ba == k), mb = __ballot(bb == k);
    const int ca = __popcll(ma), cb = __popcll(mb);
    if (ba == k) da = start + __popcll(ma & lt);
    if (bb == k) db = start + ca + __popcll(mb & lt);
    start += ca + cb;
  }
  const int ia = (da & 1) * 64 + (da >> 3) + 16 * ((da >> 1) & 3);
  const int ib = (db & 1) * 64 + (db >> 3) + 16 * ((db >> 1) & 3);
  tmp[ia] = a.x; tmp[128 + ia] = a.y;
  tmp[ib] = b.x; tmp[128 + ib] = b.y;
  asm volatile("s_waitcnt lgkmcnt(0)" ::: "memory");
  E0 = tmp[lane]; E1 = tmp[64 + lane]; G0 = tmp[128 + lane]; G1 = tmp[192 + lane];
  asm volatile("s_waitcnt lgkmcnt(0)" ::: "memory");
}

template <bool GWRITE = true>
DI void peer_finalize_token(const MKParams& p, float (&acc)[16], size_t tok, int lane) {
  float* orow = p.out + tok * DM + 16 * lane;
  float ss = 0.f;
#pragma unroll
  for (int q = 0; q < 4; ++q) {
    const f4v hv = *(const f4v*)(orow + 4 * q);
#pragma unroll
    for (int j = 0; j < 4; ++j) { acc[4 * q + j] += hv[j]; ss += acc[4 * q + j] * acc[4 * q + j]; }
  }
  ss = wave_sum(ss);
  const float rf = rsqrtf(ss * (1.0f / DM) + EPSV);
#pragma unroll
  for (int q = 0; q < 4; ++q) {
    const f4v gg = *(const f4v*)(p.g_fin + 16 * lane + 4 * q);
    f4v o = {acc[4 * q] * rf * gg[0], acc[4 * q + 1] * rf * gg[1], acc[4 * q + 2] * rf * gg[2], acc[4 * q + 3] * rf * gg[3]};
    if (GWRITE || o[0] == 123.456f) *(f4v*)(orow + 4 * q) = o;
  }
}

DI void peer_usweep(const char* ws, const char* ldsA, int wave, int lane, const unsigned (&E)[8][2], int (&A)[8][2]) {
  const char* PU = ws + OFF_PU + 16 * lane;
#pragma unroll
  for (int i = 0; i < 8; ++i) { A[i][0] = 0; A[i][1] = 0; }
  int jn[8];
#pragma unroll
  for (int i = 0; i < 8; ++i) jn[i] = 0;
#pragma unroll 1
  for (int k = 0; k < 16; ++k) {
#pragma unroll
    for (int i = 0; i < 8; ++i) {
      while (jn[i] < 16 && (__builtin_amdgcn_readlane((int)E[i][0], jn[i]) >> 10) <= k) {
        const int j = jn[i];
        const bool sel = ((lane & 15) == j);
        const uint4 xq = *(const uint4*)(ldsA + (8 * wave + i) * LDS_ROW + 16 * lane);
        uint4 u0[8];
#pragma unroll
        for (int m = 0; m < 8; ++m) {
          const int e = __builtin_amdgcn_readlane((int)E[i][m & 1], j + 16 * (m >> 1));
          u0[m] = *(const uint4*)(PU + (size_t)e * 1024);
        }
        int pv[8];
#pragma unroll
        for (int m = 0; m < 8; ++m) {
          int dsum = __builtin_amdgcn_sdot4((int)u0[m].x, (int)xq.x, 0, false);
          dsum = __builtin_amdgcn_sdot4((int)u0[m].y, (int)xq.y, dsum, false);
          dsum = __builtin_amdgcn_sdot4((int)u0[m].z, (int)xq.z, dsum, false);
          dsum = __builtin_amdgcn_sdot4((int)u0[m].w, (int)xq.w, dsum, false);
          pv[m] = dsum;
        }
        int s0, s1;
        reduce8(pv, s0, s1);
        A[i][0] = sel ? s0 : A[i][0];
        A[i][1] = sel ? s1 : A[i][1];
        jn[i] = j + 1;
      }
    }
  }
}

template <int T0, bool GWRITE = true>
DI void peer_vsweep(const MKParams& p, int wave, int lane, size_t tok0, const unsigned (&E)[8][2], const unsigned (&WQ)[8],
                    const float (&tsc)[8]) {
  const char* PV = p.ws + OFF_PV + 16 * lane;
  int acc[4][16];
#pragma unroll
  for (int i = 0; i < 4; ++i)
#pragma unroll
    for (int q = 0; q < 16; ++q) acc[i][q] = 0;
  int jn[4];
#pragma unroll
  for (int i = 0; i < 4; ++i) jn[i] = 0;
#pragma unroll 1
  for (int k = 0; k < 16; ++k) {
#pragma unroll
    for (int i = 0; i < 4; ++i) {
      while (jn[i] < 16 && (__builtin_amdgcn_readlane((int)E[T0 + i][0], jn[i]) >> 10) <= k) {
        const int j = jn[i];
        uint4 v0[8];
#pragma unroll
        for (int m = 0; m < 8; ++m) {
          const int e = __builtin_amdgcn_readlane((int)E[T0 + i][m & 1], j + 16 * (m >> 1));
          v0[m] = *(const uint4*)(PV + (size_t)e * 1024);
        }
        const int wq0 = __builtin_amdgcn_readlane((int)WQ[T0 + i], j);
        const int wq1 = __builtin_amdgcn_readlane((int)WQ[T0 + i], j + 32);
#pragma unroll
        for (int rq = 0; rq < 2; ++rq) {
          const int wq = rq ? wq1 : wq0;
          const unsigned r0[4] = {v0[4 * rq].x, v0[4 * rq].y, v0[4 * rq].z, v0[4 * rq].w};
          const unsigned r1[4] = {v0[4 * rq + 1].x, v0[4 * rq + 1].y, v0[4 * rq + 1].z, v0[4 * rq + 1].w};
          const unsigned r2[4] = {v0[4 * rq + 2].x, v0[4 * rq + 2].y, v0[4 * rq + 2].z, v0[4 * rq + 2].w};
          const unsigned r3[4] = {v0[4 * rq + 3].x, v0[4 * rq + 3].y, v0[4 * rq + 3].z, v0[4 * rq + 3].w};
#pragma unroll
          for (int q = 0; q < 4; ++q) {
            const unsigned ta = __builtin_amdgcn_perm(r1[q], r0[q], 0x05010400);
            const unsigned tb = __builtin_amdgcn_perm(r1[q], r0[q], 0x07030602);
            const unsigned tc = __builtin_amdgcn_perm(r3[q], r2[q], 0x05010400);
            const unsigned td = __builtin_amdgcn_perm(r3[q], r2[q], 0x07030602);
            acc[i][4 * q] = __builtin_amdgcn_sdot4((int)__builtin_amdgcn_perm(tc, ta, 0x05040100), wq, acc[i][4 * q], false);
            acc[i][4 * q + 1] = __builtin_amdgcn_sdot4((int)__builtin_amdgcn_perm(tc, ta, 0x07060302), wq, acc[i][4 * q + 1], false);
            acc[i][4 * q + 2] = __builtin_amdgcn_sdot4((int)__builtin_amdgcn_perm(td, tb, 0x05040100), wq, acc[i][4 * q + 2], false);
            acc[i][4 * q + 3] = __builtin_amdgcn_sdot4((int)__builtin_amdgcn_perm(td, tb, 0x07060302), wq, acc[i][4 * q + 3], false);
          }
        }
        jn[i] = j + 1;
      }
    }
  }
#pragma unroll
  for (int i = 0; i < 4; ++i) {
    float accf[16];
#pragma unroll
    for (int q = 0; q < 16; ++q) accf[q] = (float)acc[i][q] * tsc[T0 + i];
    peer_finalize_token<GWRITE>(p, accf, tok0 + 8 * wave + T0 + i, lane);
  }
}

DI void phase_d_tile(const MKParams& p, int tile, int wave, int lane, float rs0, float rs1) {
  asm volatile("" : "+v"(lane));
  char* ws = p.ws;
  char* ldsA = smem;
  float* rs_s = (float*)(smem + LDS_A_BYTES);
  unsigned char* idxs = (unsigned char*)(smem + LDS_A_BYTES + 4096) + wave * 1024;
  u16* qp = (u16*)qp_scratch(ws, blockIdx.x);
  uint2* eg = (uint2*)(ws + OFF_EG + (size_t)blockIdx.x * 65536);
  const size_t tok0 = (size_t)tile * 64;
  if (wave == 0) { if (lane < 32) rs_s[lane] = rs0; else rs_s[lane] = rs1; }
  {
    f16v acc[2][2];
    Ring rg;
    const bf8* wf = (const bf8*)(ws + OFF_WPQ);
#if PROBE == 17
    for (int rep_ = 0; rep_ < 2; ++rep_)
#endif
#pragma unroll 1
    for (int c = 0; c < 4; ++c) {
      int l2 = lane;
      asm volatile("" : "+v"(l2));
      const int r = l2 & 31, h = l2 >> 5;
      if (c == 0) gemm_chunk_r<true, false, true, true>(ldsA, wf + 2 * wave * 64, wf + 65536 + 2 * wave * 64, l2, acc, rg);
      else if (c < 3) gemm_chunk_r<true, false, false, true>(ldsA, wf + (size_t)c * 65536 + 2 * wave * 64, wf + (size_t)(c + 1) * 65536 + 2 * wave * 64, l2, acc, rg);
      else gemm_chunk_r<true, false, false, false>(ldsA, wf + (size_t)c * 65536 + 2 * wave * 64, nullptr, l2, acc, rg);
#pragma unroll
      for (int ntl = 0; ntl < 2; ++ntl)
#pragma unroll
        for (int tt = 0; tt < 2; ++tt)
#pragma unroll
          for (int g = 0; g < 4; ++g) {
            const float sc = tt ? rs1 : rs0;
            f4v v = {acc[ntl][tt][4 * g] * sc, acc[ntl][tt][4 * g + 1] * sc, acc[ntl][tt][4 * g + 2] * sc, acc[ntl][tt][4 * g + 3] * sc};
            *(bf4*)(qp + (size_t)(32 * tt + r) * 2048 + 512 * c + 64 * wave + 32 * ntl + 8 * g + 4 * h) = cvt4(v);
          }
    }
  }
  __syncthreads();
#if PROBE == 16
  for (int rep_ = 0; rep_ < 2; ++rep_)
#endif
#pragma unroll 1
  for (int tt = 0; tt < 2; ++tt) {
    int l2 = lane;
    asm volatile("" : "+v"(l2));
    peer_select(ws, qp, eg, idxs, wave, tt, l2);
  }
  __syncthreads();
}

template <bool GWRITE = true>
DI void phase_d_gather(const MKParams& p, int tile, int wave, int lane) {
  asm volatile("" : "+v"(lane));
  char* ws = p.ws;
  char* ldsA = smem;
  float* rs_s = (float*)(smem + LDS_A_BYTES);
  unsigned char* idxs = (unsigned char*)(smem + LDS_A_BYTES + 4096) + wave * 1024;
  const uint2* eg = (const uint2*)(ws + OFF_EG + (size_t)blockIdx.x * 65536);
  const size_t tok0 = (size_t)tile * 64;
  {
    int l2 = lane;
    asm volatile("" : "+v"(l2));
    unsigned E[8][2], G[8][2];
#pragma unroll
    for (int i = 0; i < 8; ++i)
      peer_bucket_token(eg + (size_t)(8 * wave + i) * 128, (unsigned*)idxs, l2, E[i][0], E[i][1], G[i][0], G[i][1]);
    float xdq[8];
    peer_quant_x(ldsA, wave, l2, xdq);
    int A[8][2];
#if PROBE == 60
    peer_usweep(ws, ldsA, wave, l2, E, A);
    asm volatile("" :: "v"(A[0][0]), "v"(A[0][1]), "v"(A[1][0]), "v"(A[1][1]), "v"(A[2][0]), "v"(A[2][1]), "v"(A[3][0]), "v"(A[3][1]), "v"(A[4][0]), "v"(A[4][1]), "v"(A[5][0]), "v"(A[5][1]), "v"(A[6][0]), "v"(A[6][1]), "v"(A[7][0]), "v"(A[7][1]));
#endif
    peer_usweep(ws, ldsA, wave, l2, E, A);
    unsigned WQ[8];
    float tsc[8];
#pragma unroll
    for (int i = 0; i < 8; ++i) {
      const float rs = rs_s[8 * wave + i];
      float w[2];
#pragma unroll
      for (int cc = 0; cc < 2; ++cc) {
        const float a = (float)A[i][cc] * (rs * xdq[i]) * ((const float*)(ws + OFF_SU))[E[i][cc]];
        w[cc] = __uint_as_float(G[i][cc]) * 0.5f * a * (1.0f + erff(a * 0.70710678118654752f)) *
                ((const float*)(ws + OFF_SV))[E[i][cc]];
      }
      float wm = fmaxf(fabsf(w[0]), fabsf(w[1]));
#pragma unroll
      for (int o = 32; o > 0; o >>= 1) wm = fmaxf(wm, __shfl_xor(wm, o));
      const float sc = (wm > 0.f) ? 127.0f / wm : 0.f;
      tsc[i] = wm * (1.0f / 127.0f);
      const unsigned pr = ((unsigned)((int)rintf(w[0] * sc)) & 0xffu) | (((unsigned)((int)rintf(w[1] * sc)) & 0xffu) << 8);
      const unsigned up = (unsigned)__shfl((int)pr, (l2 + 16) & 63);
      WQ[i] = pr | (up << 16);
    }
    __builtin_amdgcn_sched_barrier(0);
    peer_vsweep<0, GWRITE>(p, wave, l2, tok0, E, WQ, tsc);
    __builtin_amdgcn_sched_barrier(0);
    peer_vsweep<4, GWRITE>(p, wave, l2, tok0, E, WQ, tsc);
  }
}
#ifndef REMAP
#define REMAP 1
#endif
DI int tile_of(int blk, int nblk) { return (REMAP && nblk == 256) ? ((blk & 7) * 32 + (blk >> 3)) : blk; }

__global__ __launch_bounds__(512) void mk(MKParams p) {
  cg::grid_group grid = cg::this_grid();
  const int tid = threadIdx.x;
  const int wave = __builtin_amdgcn_readfirstlane(tid >> 6), lane = tid & 63;
  const int gtid = blockIdx.x * 512 + tid, gthreads = gridDim.x * 512;
  const int gw = blockIdx.x * 8 + wave, nw = gridDim.x * 8;
  unsigned* bar = (unsigned*)(p.ws + OFF_BAR);
  phase_prep(p, gtid, gthreads);
#if !TABLES_IN_B
  phase_prep_tables(p, gw, nw, lane);
#endif
  if (blockIdx.x < 256) load_norm_tile(p.x + (size_t)tile_of(blockIdx.x, gridDim.x) * 64 * DM, smem, wave, lane);
#if FIRST_CG == 1
  grid.sync();
#elif FIRST_CG == 2
  if (p.ws == nullptr) grid.sync();
  grid_barrier(bar, 1u * gridDim.x);
#else
  grid_barrier(bar, 1u * gridDim.x);
#endif
  if (blockIdx.x < 256) { phase_a_tile<true>(p, tile_of(blockIdx.x, gridDim.x), wave, lane); __syncthreads(); gla_g1_tile(p, tile_of(blockIdx.x, gridDim.x), wave, lane); }
  for (int tile = blockIdx.x + gridDim.x; tile < 256; tile += gridDim.x) { phase_a_tile<false>(p, tile_of(tile, gridDim.x), wave, lane); __syncthreads(); gla_g1_tile(p, tile_of(tile, gridDim.x), wave, lane); }
#if PROBE == 40
  for (int tile = blockIdx.x; tile < 256; tile += gridDim.x) { phase_a_tile<false>(p, tile_of(tile, gridDim.x), wave, lane); __syncthreads(); gla_g1_tile(p, tile_of(tile, gridDim.x), wave, lane); }
#endif
  for (int item = blockIdx.x; item < 128; item += gridDim.x) phase_a_memkv(p, item, wave, lane);
#if PROBE == 13
  for (int item = blockIdx.x; item < 128; item += gridDim.x) phase_a_memkv(p, item, wave, lane);
#endif
  grid_barrier(bar, (2u - (FIRST_CG == 1)) * gridDim.x);
  for (int it = gw; it < 4096; it += nw) sb_item(p, it, lane);
#if PROBE == 44
  for (int it = gw; it < 4096; it += nw) sb_item(p, it, lane);
  phase_prep_tables(p, gw, nw, lane);
#endif
  gla_g2(p, gtid, gthreads);
#if TABLES_IN_B
  phase_prep_tables(p, gw, nw, lane);
#endif
  grid_barrier(bar, (3u - (FIRST_CG == 1)) * gridDim.x);
  for (int t0 = blockIdx.x; t0 < 256; t0 += gridDim.x) {
    const int tile = tile_of(t0, gridDim.x);
    float rs0, rs1;
#if PROBE == 41
    phase_c_tile(p, tile, wave, lane, rs0, rs1);
#endif
    phase_c_tile(p, tile, wave, lane, rs0, rs1);
#if PROBE == 42
    phase_d_tile(p, tile, wave, lane, rs0, rs1);
#endif
    phase_d_tile(p, tile, wave, lane, rs0, rs1);
#if GATHER_ALIGN
    grid_barrier(bar, (4u - (FIRST_CG == 1)) * gridDim.x);
#endif
#if PROBE == 43
    phase_d_gather<false>(p, tile, wave, lane);
#endif
    phase_d_gather<true>(p, tile, wave, lane);
  }
#if FIRST_CG == 0
  grid.sync();
#endif
}
#define MK_LDS (160 * 1024)
extern "C" void kernel_launch(void* const* d_in, const int* in_sizes, int n_in, void* d_out, int out_size, void* d_ws,
                              size_t ws_size, hipStream_t stream) {
  MKParams p{};
  p.x = (const float*)d_in[0]; p.mem = (const float*)d_in[1]; p.g_mix = (const float*)d_in[2];
  p.w_in = (const float*)d_in[3]; p.w_up = (const float*)d_in[4]; p.b_alpha = (const float*)d_in[5];
  p.g_gla = (const float*)d_in[6]; p.w_out = (const float*)d_in[7]; p.g_mq = (const float*)d_in[8];
  p.g_mkv = (const float*)d_in[9]; p.w_mq = (const float*)d_in[10]; p.w_mkv = (const float*)d_in[11];
  p.w_mo = (const float*)d_in[12]; p.g_ffn = (const float*)d_in[13]; p.w_pq = (const float*)d_in[14];
  p.subk = (const float*)d_in[15]; p.pu = (const float*)d_in[16]; p.pv = (const float*)d_in[17];
  p.g_fin = (const float*)d_in[18];
  p.out = (float*)d_out; p.ws = (char*)d_ws;
  float* out = (float*)d_out;
  char* wsb = (char*)d_ws;
  float* ws = (float*)d_ws;
  static int grid_blocks = 0;
  if (!grid_blocks) {
    int dev = 0, cus = 0, per_cu = 0;
    (void)hipGetDevice(&dev);
    (void)hipDeviceGetAttribute(&cus, hipDeviceAttributeMultiprocessorCount, dev);
    (void)hipFuncSetAttribute((const void*)mk, hipFuncAttributeMaxDynamicSharedMemorySize, MK_LDS);
    (void)hipOccupancyMaxActiveBlocksPerMultiprocessor(&per_cu, mk, 512, MK_LDS);
    grid_blocks = cus * per_cu;
    fprintf(stderr, "mk: cus=%d per_cu=%d grid=%d ws=%zu\n", cus, per_cu, grid_blocks, ws_size);
  }
  (void)hipMemsetAsync((char*)d_ws + OFF_BAR, 0, 64, stream);
  {
    void* args[] = {(void*)&p};
    hipError_t e = hipLaunchCooperativeKernel((const void*)mk, dim3(grid_blocks), dim3(512), args, MK_LDS, stream);
    if (e != hipSuccess) fprintf(stderr, "coop launch failed: %s grid %d\n", hipGetErrorString(e), grid_blocks);
  }
}
```

```cpp
#define GEMM_D 8
#define TABLES_IN_B 1
#define REMAP 0
#define FIRST_CG 2
#define GATHER_ALIGN 0
#include <hip/hip_runtime.h>
#include <hip/hip_cooperative_groups.h>
#include <math.h>
#include <stdio.h>
#include <stdint.h>
namespace cg = cooperative_groups;

#ifndef PROBE
#define PROBE 0
#endif
#ifndef TABLES_IN_B
#define TABLES_IN_B 1
#endif
#define NB 8
#define SEQ 2048
#define DM 1024
#define NTOK (NB * SEQ)
#define INC 3088
#define MEML 256
#define EPSV 1e-6f

typedef __attribute__((ext_vector_type(8))) __bf16 bf8;
typedef __attribute__((ext_vector_type(4))) __bf16 bf4;
typedef __attribute__((ext_vector_type(2))) __bf16 bf2;
typedef __attribute__((ext_vector_type(16))) float f16v;
typedef __attribute__((ext_vector_type(8))) float f8v;
typedef __attribute__((ext_vector_type(4))) float f4v;
typedef __attribute__((ext_vector_type(2))) float f2v;
typedef unsigned short u16;

#define DI __device__ __forceinline__
#define MFMA(a, b, c) __builtin_amdgcn_mfma_f32_32x32x16_bf16((a), (b), (c), 0, 0, 0)

DI int crow(int i, int h) { return (i & 3) + 8 * (i >> 2) + 4 * h; }
DI int tpos(int t) { return (t & ~12) | ((t & 4) << 1) | ((t & 8) >> 1); }
DI float bf2f(u16 v) { return __uint_as_float(((unsigned)v) << 16); }
DI bf8 cvt8(f8v v) { return __builtin_convertvector(v, bf8); }
DI bf4 cvt4(f4v v) { return __builtin_convertvector(v, bf4); }
DI f16v zero16() { f16v z = {0.f, 0.f, 0.f, 0.f, 0.f, 0.f, 0.f, 0.f, 0.f, 0.f, 0.f, 0.f, 0.f, 0.f, 0.f, 0.f}; return z; }

#define MiB ((size_t)1 << 20)
#define OFF_WIN   ((size_t)0)
#define OFF_WOUT  (OFF_WIN + 97 * 65536)
#define OFF_WMQ   (OFF_WOUT + 32 * 65536)
#define OFF_WMKV  (OFF_WMQ + 32 * 65536)
#define OFF_WMO   (OFF_WMKV + 64 * 65536)
#define OFF_WPQ   (OFF_WMO + 32 * 65536)
#define OFF_SUBK  (OFF_WPQ + 64 * 65536)
#define OFF_ACT   (21 * MiB)
#define OFF_GQ    (OFF_ACT)
#define OFF_GK    (OFF_GQ + 8 * MiB)
#define OFF_GVT   (OFF_GK + 8 * MiB)
#define OFF_OG    (OFF_GVT + 16 * MiB)
#define OFF_SQ    (OFF_OG + 16 * MiB)
#define OFF_SK    (OFF_SQ + 16 * MiB)
#define OFF_SVT   (OFF_SK + 16 * MiB)
#define OFF_LA    (OFF_SVT + 16 * MiB)
#define OFF_LKV   (OFF_LA + 16 * MiB)
#define OFF_DD    (OFF_LKV + 32 * MiB)
#define OFF_OSB   (OFF_DD + 1 * MiB)
#define OFF_KM    (OFF_OSB + 16 * MiB)
#define OFF_VMT   (OFF_KM + 4 * MiB)
#define OFF_PU    (OFF_VMT + 4 * MiB)
#define OFF_PV    (OFF_PU + 16 * MiB)
#define OFF_SU    (OFF_PV + 16 * MiB)
#define OFF_SV    (OFF_SU + 65536)
#define OFF_GQ2   (224 * MiB)
#define OFF_GK2   (232 * MiB)
#define OFF_SS    (OFF_LA)

#define LDS_ROW 2064
#define LDS_A_BYTES (64 * LDS_ROW)

DI char* qp_scratch(char* ws, int blk) {
  return blk < 192 ? ws + OFF_SQ + (size_t)blk * 262144 : ws + OFF_LKV + (size_t)(blk - 192) * 262144;
}

#define OFF_BAR (OFF_DD + 768 * 1024)
DI void grid_barrier(unsigned* ctr, unsigned target) {
  __syncthreads();
  if (threadIdx.x == 0) {
    __builtin_amdgcn_fence(__ATOMIC_RELEASE, "agent");
    asm volatile("s_waitcnt vmcnt(0)" ::: "memory");
    __hip_atomic_fetch_add(ctr, 1u, __ATOMIC_RELAXED, __HIP_MEMORY_SCOPE_AGENT);
    while (__hip_atomic_load(ctr, __ATOMIC_RELAXED, __HIP_MEMORY_SCOPE_AGENT) < target) __builtin_amdgcn_s_sleep(1);
    __builtin_amdgcn_fence(__ATOMIC_ACQUIRE, "agent");
    asm volatile("s_waitcnt vmcnt(0)" ::: "memory");
  }
  __syncthreads();
}

struct MKParams {
  const float *x, *mem, *g_mix, *w_in, *w_up, *b_alpha, *g_gla, *w_out, *g_mq, *g_mkv, *w_mq, *w_mkv, *w_mo, *g_ffn, *w_pq,
      *subk, *pu, *pv, *g_fin;
  float* out;
  char* ws;
};
extern __shared__ __attribute__((aligned(16))) char smem[];

template <typename ColFn>
DI void prep_w(bf8* dst, const float* __restrict__ W, int ldw, int ntiles, const float* __restrict__ gain, ColFn colfn,
               int gtid, int gthreads) {
  const int total = ntiles * 4096;
  for (int u = gtid; u < total; u += gthreads) {
    const int lane = u & 63, ks = (u >> 6) & 63, nt = u >> 12;
    const int r = lane & 31, h = lane >> 5;
    float sc = 1.f;
    const int col = colfn(32 * nt + r, sc);
    f8v v;
#pragma unroll
    for (int j = 0; j < 8; ++j) {
      const int k = 16 * ks + 8 * h + j;
      float val = 0.f;
      if (col >= 0) val = W[(size_t)k * ldw + col] * sc * (gain ? gain[k] : 1.f);
      v[j] = val;
    }
    const int didx = (nt < (ntiles & ~15)) ? ((((nt >> 4) * 64 + ks) * 16 + (nt & 15)) * 64 + lane) : u;
    dst[didx] = cvt8(v);
  }
}

DI void phase_prep(const MKParams& p, int gtid, int gthreads) {
  char* ws = p.ws;
  prep_w((bf8*)(ws + OFF_WIN), p.w_in, INC, 97, p.g_mix,
         [](int n, float& sc) -> int {
           if (n < 256) { sc = 0.125f; return n; }
           if (n < 1536) return n;
           if (n < 2048) { sc = 0.125f; return n + 16; }
           if (n < 3072) return n + 16;
           if (n < 3088) return n - 1536;
           return -1;
         }, gtid, gthreads);
  prep_w((bf8*)(ws + OFF_WOUT), p.w_out, 1024, 32, nullptr, [](int n, float& sc) -> int { return n; }, gtid, gthreads);
  prep_w((bf8*)(ws + OFF_WMQ), p.w_mq, 1024, 32, p.g_mq, [](int n, float& sc) -> int { sc = 0.0625f; return n; }, gtid, gthreads);
  prep_w((bf8*)(ws + OFF_WMKV), p.w_mkv, 2048, 64, p.g_mkv, [](int n, float& sc) -> int { return n; }, gtid, gthreads);
  prep_w((bf8*)(ws + OFF_WMO), p.w_mo, 1024, 32, nullptr, [](int n, float& sc) -> int { return n; }, gtid, gthreads);
  prep_w((bf8*)(ws + OFF_WPQ), p.w_pq, 2048, 64, p.g_ffn, [](int n, float& sc) -> int { return n; }, gtid, gthreads);
  {
    bf8* dst = (bf8*)(ws + OFF_SUBK);
    const int total = 16 * 4 * 8 * 64;
    for (int u = gtid; u < total; u += gthreads) {
      const int lane = u & 63, ks = (u >> 6) & 7, mt = (u >> 9) & 3, hp = u >> 11;
      const int r = lane & 31, h = lane >> 5;
      const float* s = p.subk + ((size_t)(hp * 128 + 32 * mt + r)) * 128 + 16 * ks + 8 * h;
      const f4v a = *(const f4v*)s, b = *(const f4v*)(s + 4);
      f8v v = {a[0], a[1], a[2], a[3], b[0], b[1], b[2], b[3]};
      dst[u] = cvt8(v);
    }
  }
}

DI void phase_prep_tables(const MKParams& p, int gwave, int nwaves, int lane) {
  for (int row = gwave; row < 32768; row += nwaves) {
    const int e = row & 16383;
    const bool isv = row >= 16384;
    const float* src = (isv ? p.pv : p.pu) + (size_t)e * DM + 16 * lane;
    f4v v[4];
#pragma unroll
    for (int q = 0; q < 4; ++q) v[q] = *(const f4v*)(src + 4 * q);
    if (!isv) {
#pragma unroll
      for (int q = 0; q < 4; ++q) v[q] = v[q] * *(const f4v*)(p.g_ffn + 16 * lane + 4 * q);
    }
    float am = 0.f;
#pragma unroll
    for (int q = 0; q < 4; ++q)
#pragma unroll
      for (int j = 0; j < 4; ++j) am = fmaxf(am, fabsf(v[q][j]));
#pragma unroll
    for (int o = 32; o > 0; o >>= 1) am = fmaxf(am, __shfl_xor(am, o));
    unsigned w[4];
    float deq;
    {
      const float sc = (am > 0.f) ? 127.0f / am : 0.f;
#pragma unroll
      for (int q = 0; q < 4; ++q) {
        unsigned pk = 0;
#pragma unroll
        for (int j = 0; j < 4; ++j) pk |= ((unsigned)((int)rintf(v[q][j] * sc)) & 0xffu) << (8 * j);
        w[q] = pk;
      }
      deq = am * (1.0f / 127.0f);
    }
    *(uint4*)(p.ws + (isv ? OFF_PV : OFF_PU) + (size_t)e * 1024 + 16 * lane) = make_uint4(w[0], w[1], w[2], w[3]);
    if (lane == 0) ((float*)(p.ws + (isv ? OFF_SV : OFF_SU)))[e] = deq;
  }
}

DI void load_norm_tile(const float* __restrict__ src, char* ldsA, int wave, int lane) {
#pragma unroll 2
  for (int i = 0; i < 8; ++i) {
    const int row = 8 * wave + i;
    const f4v* pr = (const f4v*)(src + (size_t)row * DM);
    f4v v[4];
#pragma unroll
    for (int c = 0; c < 4; ++c) v[c] = pr[lane + 64 * c];
    float ss = 0.f;
#pragma unroll
    for (int c = 0; c < 4; ++c) ss += v[c][0] * v[c][0] + v[c][1] * v[c][1] + v[c][2] * v[c][2] + v[c][3] * v[c][3];
#pragma unroll
    for (int o = 32; o > 0; o >>= 1) ss += __shfl_xor(ss, o);
    const float rs = rsqrtf(ss * (1.0f / DM) + EPSV);
#pragma unroll
    for (int c = 0; c < 4; ++c) {
      f4v t = v[c] * rs;
      *(bf4*)(ldsA + row * LDS_ROW + (lane * 4 + 256 * c) * 2) = cvt4(t);
    }
  }
}

#ifndef GEMM_D
#define GEMM_D 6
#endif
template <bool SWAP>
DI void gemm_step(f16v (&acc)[2][2], const bf8& a0, const bf8& a1, const bf8& x0, const bf8& x1) {
  if (SWAP) {
    acc[0][0] = MFMA(a0, x0, acc[0][0]); acc[0][1] = MFMA(a0, x1, acc[0][1]);
    acc[1][0] = MFMA(a1, x0, acc[1][0]); acc[1][1] = MFMA(a1, x1, acc[1][1]);
  } else {
    acc[0][0] = MFMA(x0, a0, acc[0][0]); acc[0][1] = MFMA(x1, a0, acc[0][1]);
    acc[1][0] = MFMA(x0, a1, acc[1][0]); acc[1][1] = MFMA(x1, a1, acc[1][1]);
  }
}
struct Ring { bf8 w0[GEMM_D], w1[GEMM_D]; };
DI void ring_fill(Ring& rg, const bf8* __restrict__ wf, int lane) {
#pragma unroll
  for (int i = 0; i < GEMM_D; ++i) { rg.w0[i] = wf[lane + i * 1024]; rg.w1[i] = wf[64 + lane + i * 1024]; }
}
template <bool SWAP, bool RES, bool FIRST, bool NEXT>
DI void gemm_chunk_r(const char* ldsA, const bf8* __restrict__ wf, const bf8* __restrict__ wnext, int lane, f16v (&acc)[2][2],
                     Ring& rg, const float* res = nullptr) {
  __builtin_amdgcn_sched_barrier(0);
  const int r = lane & 31, h = lane >> 5;
  const char* xa0 = ldsA + r * LDS_ROW + h * 16;
  const char* xa1 = xa0 + 32 * LDS_ROW;
  const bf8* w0p = wf + lane;
  const bf8* w1p = wf + 64 + lane;
  if (FIRST) ring_fill(rg, wf, lane);
  if (RES) {
#pragma unroll
    for (int ntl = 0; ntl < 2; ++ntl)
#pragma unroll
      for (int tt = 0; tt < 2; ++tt)
#pragma unroll
        for (int g = 0; g < 4; ++g) {
          const f4v x = *(const f4v*)(res + (size_t)(32 * tt + r) * DM + 32 * ntl + 8 * g + 4 * h);
          acc[ntl][tt][4 * g] = x[0]; acc[ntl][tt][4 * g + 1] = x[1]; acc[ntl][tt][4 * g + 2] = x[2]; acc[ntl][tt][4 * g + 3] = x[3];
        }
  } else {
    acc[0][0] = zero16(); acc[0][1] = zero16(); acc[1][0] = zero16(); acc[1][1] = zero16();
  }
  bf8 x0 = *(const bf8*)(xa0), x1 = *(const bf8*)(xa1);
  constexpr int KMAIN = ((64 - 2 * GEMM_D) / GEMM_D + 1) * GEMM_D;
#pragma unroll 1
  for (int ks0 = 0; ks0 < KMAIN; ks0 += GEMM_D) {
#pragma unroll
    for (int i = 0; i < GEMM_D; ++i) {
      const int ks = ks0 + i;
      const bf8 xn0 = *(const bf8*)(xa0 + (ks + 1) * 32);
      const bf8 xn1 = *(const bf8*)(xa1 + (ks + 1) * 32);
      gemm_step<SWAP>(acc, rg.w0[i], rg.w1[i], x0, x1);
      rg.w0[i] = w0p[(ks + GEMM_D) * 1024];
      rg.w1[i] = w1p[(ks + GEMM_D) * 1024];
      x0 = xn0; x1 = xn1;
      __builtin_amdgcn_sched_group_barrier(0x100, 2, 0);
      __builtin_amdgcn_sched_group_barrier(0x008, 2, 0);
      __builtin_amdgcn_sched_group_barrier(0x020, 2, 0);
      __builtin_amdgcn_sched_group_barrier(0x008, 2, 0);
    }
  }
#pragma unroll
  for (int t = 0; t < 64 - KMAIN; ++t) {
    const int ks = KMAIN + t, i = t % GEMM_D;
    const bf8 xn0 = *(const bf8*)(xa0 + (ks + 1) * 32);
    const bf8 xn1 = *(const bf8*)(xa1 + (ks + 1) * 32);
    gemm_step<SWAP>(acc, rg.w0[i], rg.w1[i], x0, x1);
    const bool refill = (ks + GEMM_D < 64) || NEXT;
    if (ks + GEMM_D < 64) {
      rg.w0[i] = w0p[(ks + GEMM_D) * 1024];
      rg.w1[i] = w1p[(ks + GEMM_D) * 1024];
    } else if (NEXT) {
      rg.w0[i] = wnext[lane + (ks + GEMM_D - 64) * 1024];
      rg.w1[i] = wnext[64 + lane + (ks + GEMM_D - 64) * 1024];
    }
    x0 = xn0; x1 = xn1;
    __builtin_amdgcn_sched_group_barrier(0x100, 2, 0);
    __builtin_amdgcn_sched_group_barrier(0x008, 2, 0);
    if (refill) __builtin_amdgcn_sched_group_barrier(0x020, 2, 0);
    __builtin_amdgcn_sched_group_barrier(0x008, 2, 0);
  }
}
template <bool SWAP, bool RES = false>
DI void gemm_chunk(const char* ldsA, const bf8* __restrict__ wf, int lane, f16v (&acc)[2][2], const float* res = nullptr) {
  Ring rg;
  gemm_chunk_r<SWAP, RES, true, false>(ldsA, wf, nullptr, lane, acc, rg, res);
}

DI void store_swap_bf16(u16* dst, size_t ld, const f16v (&acc)[2][2], int lane) {
  const int r = lane & 31, h = lane >> 5;
#pragma unroll
  for (int ntl = 0; ntl < 2; ++ntl)
#pragma unroll
    for (int tt = 0; tt < 2; ++tt)
#pragma unroll
      for (int g = 0; g < 4; ++g) {
        f4v v = {acc[ntl][tt][4 * g], acc[ntl][tt][4 * g + 1], acc[ntl][tt][4 * g + 2], acc[ntl][tt][4 * g + 3]};
        *(bf4*)(dst + (size_t)(32 * tt + r) * ld + 32 * ntl + 8 * g + 4 * h) = cvt4(v);
      }
}
DI void store_vt_bf16(u16* dst, size_t ld, const f16v (&acc)[2][2], int lane) {
  const int r = lane & 31, h = lane >> 5;
#pragma unroll
  for (int ntl = 0; ntl < 2; ++ntl)
#pragma unroll
    for (int tt = 0; tt < 2; ++tt)
#pragma unroll
      for (int s = 0; s < 2; ++s) {
        f8v v;
#pragma unroll
        for (int j = 0; j < 8; ++j) v[j] = acc[ntl][tt][8 * s + j];
        *(bf8*)(dst + (size_t)(32 * ntl + r) * ld + 32 * tt + 16 * s + 8 * h) = cvt8(v);
      }
}

DI float log_sigmoid_acc(float x) { return fminf(x, 0.f) - log1pf(expf(-fabsf(x))); }

template <bool PRELOADED = false>
DI void phase_a_tile(const MKParams& p, int tile, int wave, int lane) {
  asm volatile("" : "+v"(lane));
  char* ws = p.ws;
  char* ldsA = smem;
  float* alr_s = (float*)(smem + LDS_A_BYTES);
  const int b = tile >> 5, c = tile & 31;
  const size_t tok0 = (size_t)tile * 64;
  if (!PRELOADED) {
    __syncthreads();
    load_norm_tile(p.x + tok0 * DM, ldsA, wave, lane);
#if PROBE == 10
    __syncthreads();
    load_norm_tile(p.x + tok0 * DM, ldsA, wave, lane);
#endif
    __syncthreads();
  }
  const bf8* wf = (const bf8*)(ws + OFF_WIN);
  f16v acc[2][2];
  Ring rg;
  const int t0 = c * 64;
  gemm_chunk_r<true, false, true, true>(ldsA, wf + (size_t)0 * 65536 + 2 * wave * 64, wf + (size_t)1 * 65536 + 2 * wave * 64, lane, acc, rg);
  {
    u16* base = (u16*)(ws + (wave < 4 ? OFF_GQ : OFF_GK)) + ((size_t)(b * 4 + (wave & 3)) * SEQ + t0) * 64;
    store_swap_bf16(base, 64, acc, lane);
#if PROBE == 11
    store_swap_bf16(base, 64, acc, lane);
#endif
  }
  gemm_chunk_r<false, false, false, true>(ldsA, wf + (size_t)1 * 65536 + 2 * wave * 64, wf + (size_t)2 * 65536 + 2 * wave * 64, lane, acc, rg);
  {
    u16* base = (u16*)(ws + OFF_GVT) + ((size_t)(b * 4 + (wave >> 1)) * 128 + 64 * (wave & 1)) * SEQ + t0;
    store_vt_bf16(base, SEQ, acc, lane);
#if PROBE == 11
    store_vt_bf16(base, SEQ, acc, lane);
#endif
  }
  gemm_chunk_r<true, false, false, true>(ldsA, wf + (size_t)2 * 65536 + 2 * wave * 64, wf + (size_t)3 * 65536 + 2 * wave * 64, lane, acc, rg);
  store_swap_bf16((u16*)(ws + OFF_OG) + tok0 * 512 + 64 * wave, 512, acc, lane);
#if PROBE == 11
  store_swap_bf16((u16*)(ws + OFF_OG) + tok0 * 512 + 64 * wave, 512, acc, lane);
#endif
  gemm_chunk_r<true, false, false, true>(ldsA, wf + (size_t)3 * 65536 + 2 * wave * 64, wf + (size_t)4 * 65536 + 2 * wave * 64, lane, acc, rg);
  store_swap_bf16((u16*)(ws + OFF_SQ) + ((size_t)(b * 8 + wave) * SEQ + t0) * 64, 64, acc, lane);
#if PROBE == 11
  store_swap_bf16((u16*)(ws + OFF_SQ) + ((size_t)(b * 8 + wave) * SEQ + t0) * 64, 64, acc, lane);
#endif
  gemm_chunk_r<true, false, false, true>(ldsA, wf + (size_t)4 * 65536 + 2 * wave * 64, wf + (size_t)5 * 65536 + 2 * wave * 64, lane, acc, rg);
  store_swap_bf16((u16*)(ws + OFF_SK) + ((size_t)(b * 8 + wave) * SEQ + t0) * 64, 64, acc, lane);
#if PROBE == 11
  store_swap_bf16((u16*)(ws + OFF_SK) + ((size_t)(b * 8 + wave) * SEQ + t0) * 64, 64, acc, lane);
#endif
  gemm_chunk_r<false, false, false, false>(ldsA, wf + (size_t)5 * 65536 + 2 * wave * 64, nullptr, lane, acc, rg);
  store_vt_bf16((u16*)(ws + OFF_SVT) + ((size_t)(b * 8 + wave) * 64) * SEQ + t0, SEQ, acc, lane);
#if PROBE == 11
  store_vt_bf16((u16*)(ws + OFF_SVT) + ((size_t)(b * 8 + wave) * 64) * SEQ + t0, SEQ, acc, lane);
#endif
#if PROBE == 12
  for (int rep_ = 0; rep_ < 2; ++rep_) {
  __syncthreads();
#else
  {
#endif
    float* part = (float*)(smem + LDS_A_BYTES);
    const int r = lane & 31, h = lane >> 5;
    const bf8* wp = wf + (size_t)96 * 4096 + lane;
    bf8 wfr[8];
#pragma unroll
    for (int i = 0; i < 8; ++i) wfr[i] = wp[(8 * wave + i) * 64];
    const char* xa0 = ldsA + r * LDS_ROW + h * 16 + wave * 256;
    const char* xa1 = xa0 + 32 * LDS_ROW;
    f16v a0 = zero16(), a1 = zero16();
#pragma unroll
    for (int i = 0; i < 8; ++i) {
      a0 = MFMA(wfr[i], *(const bf8*)(xa0 + i * 32), a0);
      a1 = MFMA(wfr[i], *(const bf8*)(xa1 + i * 32), a1);
    }
    float* pw = part + (wave & 3) * 1024;
    if (wave < 4) {
#pragma unroll
      for (int i = 0; i < 8; ++i) { pw[r * 16 + crow(i, h)] = a0[i]; pw[(32 + r) * 16 + crow(i, h)] = a1[i]; }
    }
    __syncthreads();
    if (wave >= 4) {
#pragma unroll
      for (int i = 0; i < 8; ++i) { pw[r * 16 + crow(i, h)] += a0[i]; pw[(32 + r) * 16 + crow(i, h)] += a1[i]; }
    }
    __syncthreads();
    const int tid = wave * 64 + lane;
    {
      const f4v* p4 = (const f4v*)part;
      if (tid < 256) { f4v s = p4[tid] + p4[256 + tid] + p4[512 + tid] + p4[768 + tid]; ((f4v*)part)[tid] = s; }
    }
    __syncthreads();
    const int col = tid & 255, tg = tid >> 8;
    float wu[16];
#pragma unroll
    for (int rr = 0; rr < 16; ++rr) wu[rr] = p.w_up[rr * 256 + col];
    const float bb = p.b_alpha[col];
    float* dst = (float*)(ws + OFF_LA) + (tok0 + 32 * tg) * 256 + col;
#pragma unroll 4
    for (int t = 0; t < 32; ++t) {
      const f4v* ar = (const f4v*)(part + (32 * tg + t) * 16);
      const f4v q0 = ar[0], q1 = ar[1], q2 = ar[2], q3 = ar[3];
      float s = bb;
      s = fmaf(q0[0], wu[0], s); s = fmaf(q0[1], wu[1], s); s = fmaf(q0[2], wu[2], s); s = fmaf(q0[3], wu[3], s);
      s = fmaf(q1[0], wu[4], s); s = fmaf(q1[1], wu[5], s); s = fmaf(q1[2], wu[6], s); s = fmaf(q1[3], wu[7], s);
      s = fmaf(q2[0], wu[8], s); s = fmaf(q2[1], wu[9], s); s = fmaf(q2[2], wu[10], s); s = fmaf(q2[3], wu[11], s);
      s = fmaf(q3[0], wu[12], s); s = fmaf(q3[1], wu[13], s); s = fmaf(q3[2], wu[14], s); s = fmaf(q3[3], wu[15], s);
      const float ls = fminf(s, 0.f) - __logf(1.0f + __expf(-fabsf(s)));
      dst[(size_t)t * 256] = ls * (1.0f / 16.0f);
    }
  }
}

DI void phase_a_memkv(const MKParams& p, int item, int wave, int lane) {
  asm volatile("" : "+v"(lane));
  char* ws = p.ws;
  char* ldsA = smem;
  const int rt = item >> 2, cc = item & 3;
  const int b = rt >> 2, m0 = (rt & 3) * 64;
  __syncthreads();
  load_norm_tile(p.mem + (size_t)rt * 64 * DM, ldsA, wave, lane);
  __syncthreads();
  const bf8* wf = (const bf8*)(ws + OFF_WMKV);
  f16v acc[2][2];
  if (cc < 2) {
    gemm_chunk<true>(ldsA, wf + (size_t)cc * 65536 + 2 * wave * 64, lane, acc);
    const int f0 = 512 * cc + 64 * wave;
    u16* base = (u16*)(ws + OFF_KM) + ((size_t)(b * 4 + (f0 >> 8)) * 256 + m0) * 256 + (f0 & 255);
    store_swap_bf16(base, 256, acc, lane);
  } else {
    gemm_chunk<false>(ldsA, wf + (size_t)cc * 65536 + 2 * wave * 64, lane, acc);
    const int f0 = 512 * (cc - 2) + 64 * wave;
    u16* base = (u16*)(ws + OFF_VMT) + ((size_t)(b * 4 + (f0 >> 8)) * 256 + (f0 & 255)) * 256 + m0;
    store_vt_bf16(base, 256, acc, lane);
  }
}
#define SB_THR 30.0f

DI bf8 pack8(const f16v& x, int s) {
  f8v v;
#pragma unroll
  for (int j = 0; j < 8; ++j) v[j] = x[8 * s + j];
  return cvt8(v);
}

DI void sb_item(const MKParams& p, int item, int lane) {
  asm volatile("" : "+v"(lane));
  char* ws = p.ws;
  const int r = lane & 31, h = lane >> 5;
  const int bh = item >> 6, qt = item & 63;
  const u16* SQ = (const u16*)(ws + OFF_SQ) + (size_t)bh * SEQ * 64;
  const u16* SK = (const u16*)(ws + OFF_SK) + (size_t)bh * SEQ * 64;
  const u16* SVT = (const u16*)(ws + OFF_SVT) + (size_t)bh * 64 * SEQ;
  bf8 qf[4];
#pragma unroll
  for (int ks = 0; ks < 4; ++ks) qf[ks] = *(const bf8*)(SQ + (size_t)(32 * qt + r) * 64 + 16 * ks + 8 * h);
  bf8 tri[2];
#pragma unroll
  for (int s = 0; s < 2; ++s) {
    f8v t;
#pragma unroll
    for (int j = 0; j < 8; ++j) t[j] = (16 * s + 8 * (j >> 2) + 4 * h + (j & 3) >= r) ? 1.0f : 0.0f;
    tri[s] = cvt8(t);
  }
  f16v o0 = zero16(), o1 = zero16();
  float R = 0.f;
  for (int kt = qt; kt >= 0; --kt) {
    bf8 kf[4], vf[2][2];
#pragma unroll
    for (int ks = 0; ks < 4; ++ks) kf[ks] = *(const bf8*)(SK + (size_t)(32 * kt + r) * 64 + 16 * ks + 8 * h);
#pragma unroll
    for (int mt = 0; mt < 2; ++mt)
#pragma unroll
      for (int s = 0; s < 2; ++s) vf[mt][s] = *(const bf8*)(SVT + (size_t)(32 * mt + r) * SEQ + 32 * kt + 16 * s + 8 * h);
    f16v z = zero16();
#pragma unroll
    for (int ks = 0; ks < 4; ++ks) z = MFMA(kf[ks], qf[ks], z);
    const bool diag = (kt == qt);
    f16v sp;
    float tot = 0.f;
#pragma unroll
    for (int i = 0; i < 16; ++i) {
      const float zz = z[i];
      const float sv = fmaxf(zz, 0.f) + __logf(1.0f + __expf(-fabsf(zz)));
      const bool valid = !diag || (crow(i, h) < r);
      sp[i] = valid ? sv : 0.f;
      tot += sp[i];
    }
    tot += __shfl_xor(tot, 32);
    f16v C = MFMA(tri[0], pack8(sp, 0), zero16());
    C = MFMA(tri[1], pack8(sp, 1), C);
    f16v a;
#pragma unroll
    for (int i = 0; i < 16; ++i) {
      const bool valid = !diag || (crow(i, h) < r);
      a[i] = valid ? __expf(z[i] - C[i] - R) : 0.f;
    }
    const bf8 a0 = pack8(a, 0), a1 = pack8(a, 1);
    o0 = MFMA(vf[0][0], a0, o0); o0 = MFMA(vf[0][1], a1, o0);
    o1 = MFMA(vf[1][0], a0, o1); o1 = MFMA(vf[1][1], a1, o1);
    R += tot;
    if (__all(R > SB_THR)) break;
  }
  const int b = bh >> 3, hd = bh & 7;
  u16* dst = (u16*)(ws + OFF_OSB) + ((size_t)b * SEQ + 32 * qt + r) * 512 + hd * 64 + 4 * h;
#pragma unroll
  for (int g = 0; g < 4; ++g) {
    f4v v0 = {o0[4 * g], o0[4 * g + 1], o0[4 * g + 2], o0[4 * g + 3]};
    f4v v1 = {o1[4 * g], o1[4 * g + 1], o1[4 * g + 2], o1[4 * g + 3]};
    *(bf4*)(dst + 8 * g) = cvt4(v0);
    *(bf4*)(dst + 32 + 8 * g) = cvt4(v1);
  }
}

DI void gla_g1_tile(const MKParams& p, int tile, int wave, int lane) {
  asm volatile("" : "+v"(lane));
  __builtin_amdgcn_sched_barrier(0);
  char* ws = p.ws;
  const int r = lane & 31, h = lane >> 5;
  const int b = tile >> 5, c = tile & 31, hd = wave >> 1, half = wave & 1, bh = b * 4 + hd;
  const int item = bh * 32 + c;
  char* kl = smem + wave * 9216;
  const u16* GQ = (const u16*)(ws + OFF_GQ) + ((size_t)bh * SEQ + 64 * c) * 64;
  const u16* GK = (const u16*)(ws + OFF_GK) + ((size_t)bh * SEQ + 64 * c) * 64;
  u16* GQ2 = (u16*)(ws + OFF_GQ2) + ((size_t)bh * SEQ + 64 * c) * 64;
  u16* GK2 = (u16*)(ws + OFF_GK2) + ((size_t)bh * SEQ + 64 * c) * 64;
  const float* LA = (const float*)(ws + OFF_LA) + ((size_t)b * SEQ + 64 * c) * 256 + hd * 64;
  float bc = 0.f;
#pragma unroll 1
  for (int g = 0; g < 4; ++g) {
    float la_[16];
    u16 q_[16], k_[16];
#pragma unroll
    for (int i = 0; i < 16; ++i) {
      const int t = 16 * g + i;
      la_[i] = LA[(size_t)t * 256 + lane];
      q_[i] = GQ[t * 64 + lane];
      k_[i] = GK[t * 64 + lane];
    }
#pragma unroll
    for (int i = 0; i < 16; ++i) {
      const int t = 16 * g + i;
      bc += la_[i];
      const float eq = __expf(bc);
      const float qn = bf2f(q_[i]) * eq, kn = bf2f(k_[i]) / eq;
      const bf2 pk = __builtin_convertvector((f2v){qn, kn}, bf2);
      const unsigned u = __builtin_bit_cast(unsigned, pk);
      if (half == 0) {
        GQ2[t * 64 + lane] = (u16)(u & 0xffff);
        GK2[t * 64 + lane] = (u16)(u >> 16);
      }
      *(u16*)(kl + lane * 144 + tpos(t) * 2) = (u16)(u >> 16);
    }
  }
  if (half == 0) ((float*)(ws + OFF_DD))[(size_t)item * 64 + lane] = __expf(bc);
  asm volatile("s_waitcnt lgkmcnt(0)" ::: "memory");
  const u16* GVT = (const u16*)(ws + OFF_GVT) + (size_t)bh * 128 * SEQ + 64 * c;
  float* LKV = (float*)(ws + OFF_LKV) + (size_t)item * 128 * 64;
  bf8 kb[2][4];
#pragma unroll
  for (int nt = 0; nt < 2; ++nt)
#pragma unroll
    for (int s = 0; s < 4; ++s) kb[nt][s] = *(const bf8*)(kl + (32 * nt + r) * 144 + (16 * s + 8 * h) * 2);
  bf8 vf[2][4];
#pragma unroll
  for (int m2 = 0; m2 < 2; ++m2)
#pragma unroll
    for (int s = 0; s < 4; ++s) vf[m2][s] = *(const bf8*)(GVT + (size_t)(32 * (2 * half + m2) + r) * SEQ + 16 * s + 8 * h);
  __builtin_amdgcn_sched_barrier(0);
#pragma unroll
  for (int m2 = 0; m2 < 2; ++m2) {
    const int mt = 2 * half + m2;
    f16v a0 = zero16(), a1 = zero16();
#pragma unroll
    for (int s = 0; s < 4; ++s) {
      a0 = MFMA(vf[m2][s], kb[0][s], a0);
      a1 = MFMA(vf[m2][s], kb[1][s], a1);
    }
#pragma unroll
    for (int i = 0; i < 16; ++i) {
      LKV[(32 * mt + crow(i, h)) * 64 + r] = a0[i];
      LKV[(32 * mt + crow(i, h)) * 64 + 32 + r] = a1[i];
    }
  }
  asm volatile("s_waitcnt lgkmcnt(0)" ::: "memory");
}

DI void gla_g2(const MKParams& p, int gtid, int gthreads) {
  char* ws = p.ws;
  for (int u = gtid; u < 32768; u += gthreads) {
    const int oct = u & 7, dv = (u >> 3) & 127, bh = u >> 10;
    f8v S = {0.f, 0.f, 0.f, 0.f, 0.f, 0.f, 0.f, 0.f};
#pragma unroll 4
    for (int c = 0; c < 32; ++c) {
      const size_t item = (size_t)bh * 32 + c;
      *(bf8*)((u16*)(ws + OFF_SS) + (item * 128 + dv) * 64 + oct * 8) = cvt8(S);
      const f8v l = *(const f8v*)((const float*)(ws + OFF_LKV) + (item * 128 + dv) * 64 + oct * 8);
      const f8v d = *(const f8v*)((const float*)(ws + OFF_DD) + item * 64 + oct * 8);
      S = d * (S + l);
    }
  }
}

DI void gla_g3_tile(const MKParams& p, int tile, int wave, int lane, char* dst, int dst_ld) {
  char* ws = p.ws;
  const int r = lane & 31, h = lane >> 5;
  const int b = tile >> 5, c = tile & 31, hd = wave >> 1, tt = wave & 1, bh = b * 4 + hd;
  const u16* GQ = (const u16*)(ws + OFF_GQ2) + ((size_t)bh * SEQ + 64 * c) * 64;
  const u16* GK = (const u16*)(ws + OFF_GK2) + ((size_t)bh * SEQ + 64 * c) * 64;
  const u16* GVT = (const u16*)(ws + OFF_GVT) + (size_t)bh * 128 * SEQ + 64 * c;
  const u16* SS = (const u16*)(ws + OFF_SS) + ((size_t)(bh * 32 + c) * 128) * 64;
  bf8 qf[4];
#pragma unroll
  for (int ks = 0; ks < 4; ++ks) qf[ks] = *(const bf8*)(GQ + (32 * tt + r) * 64 + 16 * ks + 8 * h);
  bf8 pf[2][2];
  {
    bf8 kf[2][4];
#pragma unroll
    for (int kt = 0; kt < 2; ++kt)
      if (kt <= tt) {
#pragma unroll
        for (int ks = 0; ks < 4; ++ks) kf[kt][ks] = *(const bf8*)(GK + (32 * kt + r) * 64 + 16 * ks + 8 * h);
      }
    __builtin_amdgcn_sched_barrier(0);
#pragma unroll
    for (int kt = 0; kt < 2; ++kt) {
      if (kt <= tt) {
        f16v pt = zero16();
#pragma unroll
        for (int ks = 0; ks < 4; ++ks) pt = MFMA(kf[kt][ks], qf[ks], pt);
        if (kt == tt) {
#pragma unroll
          for (int i = 0; i < 16; ++i) pt[i] = (crow(i, h) <= r) ? pt[i] : 0.f;
        }
        pf[kt][0] = pack8(pt, 0);
        pf[kt][1] = pack8(pt, 1);
      }
    }
  }
  f16v o[4];
  {
    bf8 sf[2][4], vf[2][4];
    auto load_tile = [&](int mt, bf8 (&sfx)[4], bf8 (&vfx)[4]) {
#pragma unroll
      for (int ks = 0; ks < 4; ++ks) sfx[ks] = *(const bf8*)(SS + (32 * mt + r) * 64 + 16 * ks + 8 * h);
#pragma unroll
      for (int kt = 0; kt < 2; ++kt)
        if (kt <= tt) {
#pragma unroll
          for (int s = 0; s < 2; ++s) vfx[2 * kt + s] = *(const bf8*)(GVT + (size_t)(32 * mt + r) * SEQ + 32 * kt + 16 * s + 8 * h);
        }
    };
    load_tile(0, sf[0], vf[0]);
#pragma unroll
    for (int mt = 0; mt < 4; ++mt) {
      if (mt + 1 < 4) load_tile(mt + 1, sf[(mt + 1) & 1], vf[(mt + 1) & 1]);
      __builtin_amdgcn_sched_barrier(0);
      o[mt] = zero16();
#pragma unroll
      for (int ks = 0; ks < 4; ++ks) o[mt] = MFMA(sf[mt & 1][ks], qf[ks], o[mt]);
#pragma unroll
      for (int kt = 0; kt < 2; ++kt)
        if (kt <= tt) {
#pragma unroll
          for (int s = 0; s < 2; ++s) o[mt] = MFMA(vf[mt & 1][2 * kt + s], pf[kt][s], o[mt]);
        }
      __builtin_amdgcn_sched_barrier(0);
    }
  }
  float ss = 0.f;
#pragma unroll
  for (int mt = 0; mt < 4; ++mt)
#pragma unroll
    for (int i = 0; i < 16; ++i) ss += o[mt][i] * o[mt][i];
  ss += __shfl_xor(ss, 32);
  const float rr = rsqrtf(ss * (1.0f / 128.0f) + EPSV);
  const size_t tok = (size_t)tile * 64 + 32 * tt + r;
  const u16* OG = (const u16*)(ws + OFF_OG) + tok * 512 + hd * 128;
#pragma unroll
  for (int mt = 0; mt < 4; ++mt)
#pragma unroll
    for (int g = 0; g < 4; ++g) {
      const int dv0 = 32 * mt + 8 * g + 4 * h;
      const ushort4 og4 = *(const ushort4*)(OG + dv0);
      const f4v gg = *(const f4v*)(p.g_gla + dv0);
      const float og[4] = {bf2f(og4.x), bf2f(og4.y), bf2f(og4.z), bf2f(og4.w)};
      f4v v;
#pragma unroll
      for (int j = 0; j < 4; ++j) v[j] = o[mt][4 * g + j] * rr * gg[j] * (og[j] / (1.0f + __expf(-og[j])));
      *(bf4*)(dst + (size_t)(32 * tt + r) * dst_ld + (hd * 128 + dv0) * 2) = cvt4(v);
    }
}
DI void gemm_1024(const char* ldsA, const bf8* __restrict__ wf, int wave, int lane, f16v (&a0)[2][2], f16v (&a1)[2][2]) {
  gemm_chunk<true>(ldsA, wf + 2 * wave * 64, lane, a0);
  gemm_chunk<true>(ldsA, wf + 65536 + 2 * wave * 64, lane, a1);
}
DI void gemm_1024_res(const char* ldsA, const bf8* __restrict__ wf, int wave, int lane, f16v (&a0)[2][2], f16v (&a1)[2][2],
                      const float* res) {
  gemm_chunk<true, true>(ldsA, wf + 2 * wave * 64, lane, a0, res + 64 * wave);
  gemm_chunk<true, true>(ldsA, wf + 65536 + 2 * wave * 64, lane, a1, res + 512 + 64 * wave);
}

DI void store_f32_ssq(const f16v (&a)[2][2], float* dst, int f0, int lane, float (&ssq)[2]) {
  const int r = lane & 31, h = lane >> 5;
#pragma unroll
  for (int ntl = 0; ntl < 2; ++ntl)
#pragma unroll
    for (int tt = 0; tt < 2; ++tt)
#pragma unroll
      for (int g = 0; g < 4; ++g) {
        f4v v = {a[ntl][tt][4 * g], a[ntl][tt][4 * g + 1], a[ntl][tt][4 * g + 2], a[ntl][tt][4 * g + 3]};
        ssq[tt] += v[0] * v[0] + v[1] * v[1] + v[2] * v[2] + v[3] * v[3];
        *(f4v*)(dst + (size_t)(32 * tt + r) * DM + f0 + 32 * ntl + 8 * g + 4 * h) = v;
      }
}

DI void acc_to_scratch(u16* scr, const f16v (&a)[2][2], int f0, int lane, float s0, float s1) {
  const int r = lane & 31, h = lane >> 5;
#pragma unroll
  for (int ntl = 0; ntl < 2; ++ntl)
#pragma unroll
    for (int tt = 0; tt < 2; ++tt)
#pragma unroll
      for (int g = 0; g < 4; ++g) {
        const float sc = tt ? s1 : s0;
        f4v v = {a[ntl][tt][4 * g] * sc, a[ntl][tt][4 * g + 1] * sc, a[ntl][tt][4 * g + 2] * sc, a[ntl][tt][4 * g + 3] * sc};
        *(bf4*)(scr + (size_t)(32 * tt + r) * 1024 + f0 + 32 * ntl + 8 * g + 4 * h) = cvt4(v);
      }
}
typedef __attribute__((ext_vector_type(4))) unsigned u4v;
DI void scratch_to_lds(const u16* scr, char* ldsA, int tid) {
  asm volatile("" : "+v"(tid));
  const unsigned toff = (unsigned)tid * 16u;
#pragma unroll
  for (int half = 0; half < 2; ++half) {
    u4v v[8];
#pragma unroll
    for (int it = 0; it < 8; ++it)
      v[it] = __builtin_nontemporal_load((const u4v*)((const char*)scr + (size_t)(8192 * (8 * half + it)) + toff));
#pragma unroll
    for (int it = 0; it < 8; ++it) {
      const int idx = tid + 512 * (8 * half + it), row = idx >> 7, ch = idx & 127;
      *(u4v*)(ldsA + row * LDS_ROW + ch * 16) = v[it];
    }
  }
}

struct Pk { bf4 v[2][2][4]; };
DI void pack_acc(Pk& pk, const f16v (&a)[2][2], float s0, float s1) {
#pragma unroll
  for (int ntl = 0; ntl < 2; ++ntl)
#pragma unroll
    for (int tt = 0; tt < 2; ++tt)
#pragma unroll
      for (int g = 0; g < 4; ++g) {
        const float sc = tt ? s1 : s0;
        f4v v = {a[ntl][tt][4 * g] * sc, a[ntl][tt][4 * g + 1] * sc, a[ntl][tt][4 * g + 2] * sc, a[ntl][tt][4 * g + 3] * sc};
        pk.v[ntl][tt][g] = cvt4(v);
      }
}
DI void pk_to_lds(char* ldsA, const Pk& pk, int f0, int lane) {
  const int r = lane & 31, h = lane >> 5;
#pragma unroll
  for (int ntl = 0; ntl < 2; ++ntl)
#pragma unroll
    for (int tt = 0; tt < 2; ++tt)
#pragma unroll
      for (int g = 0; g < 4; ++g)
        *(bf4*)(ldsA + (32 * tt + r) * LDS_ROW + (f0 + 32 * ntl + 8 * g + 4 * h) * 2) = pk.v[ntl][tt][g];
}

DI void rms_from_partials(float* red, int wave, int lane, const float (&ssq)[2], float& rs0, float& rs1) {
  red[(wave * 2 + 0) * 64 + lane] = ssq[0];
  red[(wave * 2 + 1) * 64 + lane] = ssq[1];
  __syncthreads();
  const int r = lane & 31;
  float t0 = 0.f, t1 = 0.f;
#pragma unroll
  for (int w = 0; w < 8; ++w) {
    t0 += red[(w * 2 + 0) * 64 + r] + red[(w * 2 + 0) * 64 + 32 + r];
    t1 += red[(w * 2 + 1) * 64 + r] + red[(w * 2 + 1) * 64 + 32 + r];
  }
  rs0 = rsqrtf(t0 * (1.0f / DM) + EPSV);
  rs1 = rsqrtf(t1 * (1.0f / DM) + EPSV);
}

template <bool WRITE = true>
DI void mem_attn(const MKParams& p, char* ldsA, int b, int wave, int lane) {
  char* ws = p.ws;
  const int r = lane & 31, h = lane >> 5;
  const int hm = wave >> 1, tt = wave & 1;
  const char* KM = ws + OFF_KM + (size_t)(b * 4 + hm) * 256 * 256 * 2;
  const char* VMT = ws + OFF_VMT + (size_t)(b * 4 + hm) * 256 * 256 * 2;
  char* qrow = ldsA + (32 * tt + r) * LDS_ROW + hm * 512;
  const unsigned loff = (unsigned)((r * 256 + 8 * h) * 2);
  f16v s[8];
#pragma unroll
  for (int mt = 0; mt < 8; ++mt) s[mt] = zero16();
  bf8 ka[8], kb[8];
#pragma unroll
  for (int mt = 0; mt < 8; ++mt) ka[mt] = *(const bf8*)(KM + (size_t)(mt * 32 * 256 * 2) + loff);
  bf8 qa = *(const bf8*)(qrow + 8 * h * 2), qb;
#pragma unroll 1
  for (int ks = 0; ks < 16; ks += 2) {
#pragma unroll
    for (int mt = 0; mt < 8; ++mt) kb[mt] = *(const bf8*)(KM + (size_t)((mt * 32 * 256 + 16 * (ks + 1)) * 2) + loff);
    qb = *(const bf8*)(qrow + (16 * (ks + 1) + 8 * h) * 2);
#pragma unroll
    for (int mt = 0; mt < 8; ++mt) s[mt] = MFMA(ka[mt], qa, s[mt]);
    __builtin_amdgcn_sched_group_barrier(0x020, 8, 0);
    __builtin_amdgcn_sched_group_barrier(0x100, 1, 0);
    __builtin_amdgcn_sched_group_barrier(0x008, 8, 0);
    if (ks + 2 < 16) {
#pragma unroll
      for (int mt = 0; mt < 8; ++mt) ka[mt] = *(const bf8*)(KM + (size_t)((mt * 32 * 256 + 16 * (ks + 2)) * 2) + loff);
      qa = *(const bf8*)(qrow + (16 * (ks + 2) + 8 * h) * 2);
    }
#pragma unroll
    for (int mt = 0; mt < 8; ++mt) s[mt] = MFMA(kb[mt], qb, s[mt]);
    __builtin_amdgcn_sched_group_barrier(0x020, 8, 0);
    __builtin_amdgcn_sched_group_barrier(0x100, 1, 0);
    __builtin_amdgcn_sched_group_barrier(0x008, 8, 0);
  }
  float mx = -INFINITY;
#pragma unroll
  for (int mt = 0; mt < 8; ++mt)
#pragma unroll
    for (int i = 0; i < 16; ++i) mx = fmaxf(mx, s[mt][i]);
  mx = fmaxf(mx, __shfl_xor(mx, 32));
  float l = 0.f;
  bf8 pf[8][2];
#pragma unroll
  for (int mt = 0; mt < 8; ++mt) {
#pragma unroll
    for (int i = 0; i < 16; ++i) { s[mt][i] = __expf(s[mt][i] - mx); l += s[mt][i]; }
    pf[mt][0] = pack8(s[mt], 0);
    pf[mt][1] = pack8(s[mt], 1);
  }
  l += __shfl_xor(l, 32);
  const float inv = 1.0f / l;
#pragma unroll
  for (int grp = 0; grp < 2; ++grp) {
    f16v o[4];
#pragma unroll
    for (int m4 = 0; m4 < 4; ++m4) o[m4] = zero16();
    const char* vb = VMT + (size_t)(grp * 4 * 32 * 256 * 2) + loff;
    bf8 va[4], vn[4];
#pragma unroll
    for (int m4 = 0; m4 < 4; ++m4) va[m4] = *(const bf8*)(vb + (size_t)(m4 * 32 * 256 * 2));
#pragma unroll
    for (int st = 0; st < 16; ++st) {
      if (st + 1 < 16) {
#pragma unroll
        for (int m4 = 0; m4 < 4; ++m4) vn[m4] = *(const bf8*)(vb + (size_t)((m4 * 32 * 256 + 16 * (st + 1)) * 2));
      }
#pragma unroll
      for (int m4 = 0; m4 < 4; ++m4) o[m4] = MFMA(va[m4], pf[st >> 1][st & 1], o[m4]);
      if (st + 1 < 16) {
        __builtin_amdgcn_sched_group_barrier(0x020, 4, 0);
        __builtin_amdgcn_sched_group_barrier(0x008, 4, 0);
#pragma unroll
        for (int m4 = 0; m4 < 4; ++m4) va[m4] = vn[m4];
      }
    }
#pragma unroll
    for (int m4 = 0; m4 < 4; ++m4)
#pragma unroll
      for (int g = 0; g < 4; ++g) {
        f4v v = {o[m4][4 * g] * inv, o[m4][4 * g + 1] * inv, o[m4][4 * g + 2] * inv, o[m4][4 * g + 3] * inv};
        if (WRITE || v[0] == 123.456f) *(bf4*)(qrow + (32 * (4 * grp + m4) + 8 * g + 4 * h) * 2) = cvt4(v);
      }
  }
}

DI void phase_c_tile(const MKParams& p, int tile, int wave, int lane, float& rs0, float& rs1) {
  asm volatile("" : "+v"(lane));
  char* ws = p.ws;
  char* ldsA = smem;
  float* red = (float*)(smem + LDS_A_BYTES);
  const size_t tok0 = (size_t)tile * 64;
  const int tid = wave * 64 + lane;
  __syncthreads();
#if PROBE == 15
  gla_g3_tile(p, tile, wave, lane, ldsA, LDS_ROW);
  __builtin_amdgcn_sched_barrier(0);
  asm volatile("" : "+v"(lane));
#endif
  {
  gla_g3_tile(p, tile, wave, lane, ldsA, LDS_ROW);
  {
    const char* osb = ws + OFF_OSB + tok0 * 1024;
#pragma unroll
    for (int it = 0; it < 8; ++it) {
      const int idx = tid + 512 * it, row = idx >> 6, ch = idx & 63;
      *(uint4*)(ldsA + row * LDS_ROW + 1024 + ch * 16) = *(const uint4*)(osb + (size_t)row * 1024 + ch * 16);
    }
  }
  }
  __syncthreads();
  f16v acc[2][2];
  Ring rg;
  Pk pk0, pk1;
  float* hdst = p.out + tok0 * DM;
  {
    float ssq[2] = {0.f, 0.f};
    const bf8* wf = (const bf8*)(ws + OFF_WOUT);
    asm volatile("" : "+v"(lane));
    gemm_chunk_r<true, true, true, true>(ldsA, wf + 2 * wave * 64, wf + 65536 + 2 * wave * 64, lane, acc, rg, p.x + tok0 * DM + 64 * wave);
    store_f32_ssq(acc, hdst, 64 * wave, lane, ssq);
    pack_acc(pk0, acc, 1.f, 1.f);
    asm volatile("" : "+v"(lane));
    gemm_chunk_r<true, true, false, true>(ldsA, wf + 65536 + 2 * wave * 64, (const bf8*)(ws + OFF_WMQ) + 2 * wave * 64, lane, acc, rg, p.x + tok0 * DM + 512 + 64 * wave);
    store_f32_ssq(acc, hdst, 512 + 64 * wave, lane, ssq);
    pack_acc(pk1, acc, 1.f, 1.f);
    rms_from_partials(red, wave, lane, ssq, rs0, rs1);
  }
  pk_to_lds(ldsA, pk0, 64 * wave, lane);
  pk_to_lds(ldsA, pk1, 512 + 64 * wave, lane);
  __syncthreads();
  {
    const bf8* wf = (const bf8*)(ws + OFF_WMQ);
    asm volatile("" : "+v"(lane));
    gemm_chunk_r<true, false, false, true>(ldsA, wf + 2 * wave * 64, wf + 65536 + 2 * wave * 64, lane, acc, rg);
    pack_acc(pk0, acc, rs0, rs1);
    asm volatile("" : "+v"(lane));
    gemm_chunk_r<true, false, false, false>(ldsA, wf + 65536 + 2 * wave * 64, nullptr, lane, acc, rg);
    pack_acc(pk1, acc, rs0, rs1);
  }
  __syncthreads();
  pk_to_lds(ldsA, pk0, 64 * wave, lane);
  pk_to_lds(ldsA, pk1, 512 + 64 * wave, lane);
  __syncthreads();
#if PROBE == 22
  asm volatile("" : "+v"(lane));
  mem_attn<false>(p, ldsA, tile >> 5, wave, lane);
#endif
  asm volatile("" : "+v"(lane));
  mem_attn<true>(p, ldsA, tile >> 5, wave, lane);
  __syncthreads();
  {
    float ssq[2] = {0.f, 0.f};
    const bf8* wf = (const bf8*)(ws + OFF_WMO);
    asm volatile("" : "+v"(lane));
    gemm_chunk_r<true, true, true, true>(ldsA, wf + 2 * wave * 64, wf + 65536 + 2 * wave * 64, lane, acc, rg, hdst + 64 * wave);
    store_f32_ssq(acc, hdst, 64 * wave, lane, ssq);
    pack_acc(pk0, acc, 1.f, 1.f);
    asm volatile("" : "+v"(lane));
    gemm_chunk_r<true, true, false, false>(ldsA, wf + 65536 + 2 * wave * 64, nullptr, lane, acc, rg, hdst + 512 + 64 * wave);
    store_f32_ssq(acc, hdst, 512 + 64 * wave, lane, ssq);
    pack_acc(pk1, acc, 1.f, 1.f);
    rms_from_partials(red, wave, lane, ssq, rs0, rs1);
  }
  pk_to_lds(ldsA, pk0, 64 * wave, lane);
  pk_to_lds(ldsA, pk1, 512 + 64 * wave, lane);
  __syncthreads();
}
#define OFF_EG (OFF_LKV + 16 * MiB)

DI unsigned f2ord(float v) { const unsigned u = __float_as_uint(v); return (u & 0x80000000u) ? ~u : (u | 0x80000000u); }
DI float ord2f(unsigned u) { return __uint_as_float((u & 0x80000000u) ? (u ^ 0x80000000u) : ~u); }

#define CEX(a, b) { const unsigned hi_ = max(k[a], k[b]); const unsigned lo_ = min(k[a], k[b]); k[a] = hi_; k[b] = lo_; }
DI void sort16_desc(unsigned (&k)[16]) {
  CEX(0, 1) CEX(2, 3) CEX(0, 2) CEX(1, 3) CEX(1, 2) CEX(4, 5) CEX(6, 7) CEX(4, 6) CEX(5, 7) CEX(5, 6) CEX(0, 4)
  CEX(2, 6) CEX(2, 4) CEX(1, 5) CEX(3, 7) CEX(3, 5) CEX(1, 2) CEX(3, 4) CEX(5, 6) CEX(8, 9) CEX(10, 11) CEX(8, 10)
  CEX(9, 11) CEX(9, 10) CEX(12, 13) CEX(14, 15) CEX(12, 14) CEX(13, 15) CEX(13, 14) CEX(8, 12) CEX(10, 14) CEX(10, 12)
  CEX(9, 13) CEX(11, 15) CEX(11, 13) CEX(9, 10) CEX(11, 12) CEX(13, 14) CEX(0, 8) CEX(4, 12) CEX(4, 8) CEX(2, 10)
  CEX(6, 14) CEX(6, 10) CEX(2, 4) CEX(6, 8) CEX(10, 12) CEX(1, 9) CEX(5, 13) CEX(5, 9) CEX(3, 11) CEX(7, 15) CEX(7, 11)
  CEX(3, 5) CEX(7, 9) CEX(11, 13) CEX(1, 2) CEX(3, 4) CEX(5, 6) CEX(7, 8) CEX(9, 10) CEX(11, 12) CEX(13, 14)
}
DI void merge_top16(unsigned (&t)[16], const unsigned (&u)[16]) {
#pragma unroll
  for (int s = 0; s < 16; ++s) t[s] = max(t[s], u[15 - s]);
#pragma unroll
  for (int d = 8; d > 0; d >>= 1)
#pragma unroll
    for (int i = 0; i < 16; ++i)
      if ((i & d) == 0) {
        const unsigned hi = max(t[i], t[i + d]), lo = min(t[i], t[i + d]);
        t[i] = hi; t[i + d] = lo;
      }
}

DI void ins16(unsigned (&L)[16], unsigned x) {
#pragma unroll
  for (int s = 0; s < 16; ++s) {
    const unsigned hi = max(L[s], x);
    x = min(L[s], x);
    L[s] = hi;
  }
}
DI void merge_halves16(unsigned (&L)[16]) {
  unsigned O[16];
#pragma unroll
  for (int s = 0; s < 16; ++s) O[s] = (unsigned)__shfl_xor((int)L[s], 32);
#pragma unroll
  for (int s = 0; s < 16; ++s) L[s] = max(L[s], O[15 - s]);
#pragma unroll
  for (int d = 8; d > 0; d >>= 1)
#pragma unroll
    for (int i = 0; i < 16; ++i)
      if ((i & d) == 0) {
        const unsigned hi = max(L[i], L[i + d]), lo = min(L[i], L[i + d]);
        L[i] = hi; L[i + d] = lo;
      }
}

DI void peer_top16(const char* ws, const u16* qp, int hp, int tt, int lane, unsigned (&L)[16]) {
  const int r = lane & 31, h = lane >> 5;
  const bf8* sk = (const bf8*)(ws + OFF_SUBK) + (size_t)hp * 4 * 8 * 64 + lane;
  f16v s[4];
#pragma unroll
  for (int mt = 0; mt < 4; ++mt) s[mt] = zero16();
  bf8 qf[8];
#pragma unroll
  for (int ks = 0; ks < 8; ++ks) qf[ks] = *(const bf8*)(qp + (size_t)(32 * tt + r) * 2048 + hp * 128 + 16 * ks + 8 * h);
#pragma unroll
  for (int half = 0; half < 2; ++half) {
    bf8 kf[4][4];
#pragma unroll
    for (int k4 = 0; k4 < 4; ++k4)
#pragma unroll
      for (int mt = 0; mt < 4; ++mt) kf[k4][mt] = sk[(mt * 8 + 4 * half + k4) * 64];
    __builtin_amdgcn_sched_barrier(0);
#pragma unroll
    for (int k4 = 0; k4 < 4; ++k4)
#pragma unroll
      for (int mt = 0; mt < 4; ++mt) s[mt] = MFMA(kf[k4][mt], qf[4 * half + k4], s[mt]);
    __builtin_amdgcn_sched_barrier(0);
  }
  unsigned K1[16], K2[16], K3[16];
#pragma unroll
  for (int i = 0; i < 16; ++i) {
    L[i] = (f2ord(s[0][i]) & ~127u) | (unsigned)(127 - (crow(i, h)));
    K1[i] = (f2ord(s[1][i]) & ~127u) | (unsigned)(127 - (32 + crow(i, h)));
    K2[i] = (f2ord(s[2][i]) & ~127u) | (unsigned)(127 - (64 + crow(i, h)));
    K3[i] = (f2ord(s[3][i]) & ~127u) | (unsigned)(127 - (96 + crow(i, h)));
  }
  sort16_desc(L); sort16_desc(K1); sort16_desc(K2); sort16_desc(K3);
  merge_top16(L, K1);
  merge_top16(K2, K3);
  merge_top16(L, K2);
  merge_halves16(L);
}

DI void peer_select(const char* ws, const u16* qp, uint2* eg, unsigned char* idxs  , int head,
                    int tt, int lane) {
  const int r = lane & 31, h = lane >> 5;
  unsigned La[16], Lb[16];
  peer_top16(ws, qp, 2 * head, tt, lane, La);
  __builtin_amdgcn_sched_barrier(0);
  peer_top16(ws, qp, 2 * head + 1, tt, lane, Lb);
  __builtin_amdgcn_sched_barrier(0);
  if (h == 0) {
#pragma unroll
    for (int g = 0; g < 4; ++g) {
      unsigned wa = 0, wb = 0;
#pragma unroll
      for (int j = 0; j < 4; ++j) {
        wa |= (127u - (La[4 * g + j] & 127u)) << (8 * j);
        wb |= (127u - (Lb[4 * g + j] & 127u)) << (8 * j);
      }
      *(unsigned*)(idxs + r * 32 + 4 * g) = wa;
      *(unsigned*)(idxs + r * 32 + 16 + 4 * g) = wb;
    }
  }
  float fa[16], fb[16];
#pragma unroll
  for (int i = 0; i < 16; ++i) { fa[i] = ord2f(La[i] & ~127u); fb[i] = ord2f(Lb[i] & ~127u); }
  unsigned C[16];
#pragma unroll
  for (int i = 0; i < 16; ++i) C[i] = (f2ord(fa[0] + fb[i]) & ~255u) | (unsigned)(255 - i);
#define PEER_CAND(a, b) ins16(C, (f2ord(fa[a] + fb[b]) & ~255u) | (unsigned)(255 - ((a) * 16 + (b))));
#define PEER_ROW1(a) PEER_CAND(a, 0)
#define PEER_ROW2(a) PEER_ROW1(a) PEER_CAND(a, 1)
#define PEER_ROW3(a) PEER_ROW2(a) PEER_CAND(a, 2)
#define PEER_ROW4(a) PEER_ROW3(a) PEER_CAND(a, 3)
#define PEER_ROW5(a) PEER_ROW4(a) PEER_CAND(a, 4)
#define PEER_ROW8(a) PEER_ROW5(a) PEER_CAND(a, 5) PEER_CAND(a, 6) PEER_CAND(a, 7)
#define PEER_ROW16(a) PEER_ROW8(a) PEER_CAND(a, 8) PEER_CAND(a, 9) PEER_CAND(a, 10) PEER_CAND(a, 11) PEER_CAND(a, 12) PEER_CAND(a, 13) PEER_CAND(a, 14) PEER_CAND(a, 15)
  PEER_ROW8(1) PEER_ROW5(2) PEER_ROW4(3) PEER_ROW3(4) PEER_ROW2(5) PEER_ROW2(6) PEER_ROW2(7)
  PEER_ROW1(8) PEER_ROW1(9) PEER_ROW1(10) PEER_ROW1(11) PEER_ROW1(12) PEER_ROW1(13) PEER_ROW1(14) PEER_ROW1(15)
  asm volatile("s_waitcnt lgkmcnt(0)" ::: "memory");
  const float vmax = ord2f(C[0] & ~255u);
  float ex[16], sum = 0.f;
#pragma unroll
  for (int i = 0; i < 16; ++i) { ex[i] = __expf(ord2f(C[i] & ~255u) - vmax); sum += ex[i]; }
  const float inv = 1.0f / sum;
  const unsigned hmask = 0u - (unsigned)h;
#pragma unroll
  for (int i = 0; i < 8; ++i) {
    const unsigned ck = C[i] ^ ((C[i] ^ C[8 + i]) & hmask);
    const unsigned gb = __float_as_uint(ex[i]) ^ ((__float_as_uint(ex[i]) ^ __float_as_uint(ex[8 + i])) & hmask);
    const float g = __uint_as_float(gb) * inv;
    const unsigned code = 255u - (ck & 255u);
    const unsigned ia = idxs[r * 32 + (code >> 4)], ib = idxs[r * 32 + 16 + (code & 15u)];
    eg[(size_t)(32 * tt + r) * 128 + head * 16 + 8 * h + i] = make_uint2(ia * 128u + ib, __float_as_uint(g));
  }
  asm volatile("s_waitcnt lgkmcnt(0)" ::: "memory");
}

DI float wave_sum(float v) {
#pragma unroll
  for (int o = 32; o > 0; o >>= 1) v += __shfl_xor(v, o);
  return v;
}

DI void reduce8(const int (&pv)[8], int& s0, int& s1) {
  int q[4], s[2];
#pragma unroll
  for (int m = 0; m < 4; ++m) {
    const auto r = __builtin_amdgcn_permlane32_swap((unsigned)pv[m], (unsigned)pv[m + 4], false, false);
    q[m] = (int)(r[0] + r[1]);
  }
#pragma unroll
  for (int m = 0; m < 2; ++m) {
    const auto r = __builtin_amdgcn_permlane16_swap((unsigned)q[m], (unsigned)q[m + 2], false, false);
    s[m] = (int)(r[0] + r[1]);
  }
#pragma unroll
  for (int m = 0; m < 2; ++m) {
    s[m] += __builtin_amdgcn_update_dpp(0, s[m], 0x128, 0xf, 0xf, false);
    s[m] += __builtin_amdgcn_update_dpp(0, s[m], 0x124, 0xf, 0xf, false);
    s[m] += __builtin_amdgcn_update_dpp(0, s[m], 0x122, 0xf, 0xf, false);
    s[m] += __builtin_amdgcn_update_dpp(0, s[m], 0x121, 0xf, 0xf, false);
  }
  s0 = s[0]; s1 = s[1];
}

DI void peer_quant_x(char* ldsA, int wave, int lane, float (&xdq)[8]) {
#pragma unroll
  for (int i = 0; i < 8; ++i) {
    char* xrow = ldsA + (8 * wave + i) * LDS_ROW;
    const uint4 x0 = *(const uint4*)(xrow + 32 * lane), x1 = *(const uint4*)(xrow + 32 * lane + 16);
    const unsigned xr[8] = {x0.x, x0.y, x0.z, x0.w, x1.x, x1.y, x1.z, x1.w};
    float f[16];
    float am = 0.f;
#pragma unroll
    for (int q = 0; q < 8; ++q) {
      f[2 * q] = __uint_as_float(xr[q] << 16);
      f[2 * q + 1] = __uint_as_float(xr[q] & 0xffff0000u);
      am = fmaxf(am, fmaxf(fabsf(f[2 * q]), fabsf(f[2 * q + 1])));
    }
#pragma unroll
    for (int o = 32; o > 0; o >>= 1) am = fmaxf(am, __shfl_xor(am, o));
    const float sc = (am > 0.f) ? 127.0f / am : 0.f;
    unsigned w[4];
#pragma unroll
    for (int q = 0; q < 4; ++q) {
      unsigned pk = 0;
#pragma unroll
      for (int j = 0; j < 4; ++j) pk |= ((unsigned)((int)rintf(f[4 * q + j] * sc)) & 0xffu) << (8 * j);
      w[q] = pk;
    }
    asm volatile("s_waitcnt lgkmcnt(0)" ::: "memory");
    *(uint4*)(xrow + 16 * lane) = make_uint4(w[0], w[1], w[2], w[3]);
    xdq[i] = am * (1.0f / 127.0f);
  }
  asm volatile("s_waitcnt lgkmcnt(0)" ::: "memory");
}

DI void peer_bucket_token(const uint2* egt, unsigned* tmp  , int lane, unsigned& E0, unsigned& E1,
                          unsigned& G0, unsigned& G1) {
  const uint2 a = egt[lane], b = egt[64 + lane];
  const int ba = (int)(a.x >> 10), bb = (int)(b.x >> 10);
  const unsigned long long lt = (1ull << lane) - 1ull;
  int da = 0, db = 0, start = 0;
#pragma unroll
  for (int k = 0; k < 16; ++k) {
    const unsigned long long ma = __ballot(ba == k), mb = __ballot(bb == k);
    const int ca = __popcll(ma), cb = __popcll(mb);
    if (ba == k) da = start + __popcll(ma & lt);
    if (bb == k) db = start + ca + __popcll(mb & lt);
    start += ca + cb;
  }
  const int ia = (da & 1) * 64 + (da >> 3) + 16 * ((da >> 1) & 3);
  const int ib = (db & 1) * 64 + (db >> 3) + 16 * ((db >> 1) & 3);
  tmp[ia] = a.x; tmp[128 + ia] = a.y;
  tmp[ib] = b.x; tmp[128 + ib] = b.y;
  asm volatile("s_waitcnt lgkmcnt(0)" ::: "memory");
  E0 = tmp[lane]; E1 = tmp[64 + lane]; G0 = tmp[128 + lane]; G1 = tmp[192 + lane];
  asm volatile("s_waitcnt lgkmcnt(0)" ::: "memory");
}

template <bool GWRITE = true>
DI void peer_finalize_token(const MKParams& p, float (&acc)[16], size_t tok, int lane) {
  float* orow = p.out + tok * DM + 16 * lane;
  float ss = 0.f;
#pragma unroll
  for (int q = 0; q < 4; ++q) {
    const f4v hv = *(const f4v*)(orow + 4 * q);
#pragma unroll
    for (int j = 0; j < 4; ++j) { acc[4 * q + j] += hv[j]; ss += acc[4 * q + j] * acc[4 * q + j]; }
  }
  ss = wave_sum(ss);
  const float rf = rsqrtf(ss * (1.0f / DM) + EPSV);
#pragma unroll
  for (int q = 0; q < 4; ++q) {
    const f4v gg = *(const f4v*)(p.g_fin + 16 * lane + 4 * q);
    f4v o = {acc[4 * q] * rf * gg[0], acc[4 * q + 1] * rf * gg[1], acc[4 * q + 2] * rf * gg[2], acc[4 * q + 3] * rf * gg[3]};
    if (GWRITE || o[0] == 123.456f) *(f4v*)(orow + 4 * q) = o;
  }
}

DI void peer_usweep(const char* ws, const char* ldsA, int wave, int lane, const unsigned (&E)[8][2], int (&A)[8][2]) {
  const char* PU = ws + OFF_PU + 16 * lane;
#pragma unroll
  for (int i = 0; i < 8; ++i) { A[i][0] = 0; A[i][1] = 0; }
  int jn[8];
#pragma unroll
  for (int i = 0; i < 8; ++i) jn[i] = 0;
#pragma unroll 1
  for (int k = 0; k < 16; ++k) {
#pragma unroll
    for (int i = 0; i < 8; ++i) {
      while (jn[i] < 16 && (__builtin_amdgcn_readlane((int)E[i][0], jn[i]) >> 10) <= k) {
        const int j = jn[i];
        const bool sel = ((lane & 15) == j);
        const uint4 xq = *(const uint4*)(ldsA + (8 * wave + i) * LDS_ROW + 16 * lane);
        uint4 u0[8];
#pragma unroll
        for (int m = 0; m < 8; ++m) {
          const int e = __builtin_amdgcn_readlane((int)E[i][m & 1], j + 16 * (m >> 1));
          u0[m] = *(const uint4*)(PU + (size_t)e * 1024);
        }
        int pv[8];
#pragma unroll
        for (int m = 0; m < 8; ++m) {
          int dsum = __builtin_amdgcn_sdot4((int)u0[m].x, (int)xq.x, 0, false);
          dsum = __builtin_amdgcn_sdot4((int)u0[m].y, (int)xq.y, dsum, false);
          dsum = __builtin_amdgcn_sdot4((int)u0[m].z, (int)xq.z, dsum, false);
          dsum = __builtin_amdgcn_sdot4((int)u0[m].w, (int)xq.w, dsum, false);
          pv[m] = dsum;
        }
        int s0, s1;
        reduce8(pv, s0, s1);
        A[i][0] = sel ? s0 : A[i][0];
        A[i][1] = sel ? s1 : A[i][1];
        jn[i] = j + 1;
      }
    }
  }
}

template <int T0, bool GWRITE = true>
DI void peer_vsweep(const MKParams& p, int wave, int lane, size_t tok0, const unsigned (&E)[8][2], const unsigned (&WQ)[8],
                    const float (&tsc)[8]) {
  const char* PV = p.ws + OFF_PV + 16 * lane;
  int acc[4][16];
#pragma unroll
  for (int i = 0; i < 4; ++i)
#pragma unroll
    for (int q = 0; q < 16; ++q) acc[i][q] = 0;
  int jn[4];
#pragma unroll
  for (int i = 0; i < 4; ++i) jn[i] = 0;
#pragma unroll 1
  for (int k = 0; k < 16; ++k) {
#pragma unroll
    for (int i = 0; i < 4; ++i) {
      while (jn[i] < 16 && (__builtin_amdgcn_readlane((int)E[T0 + i][0], jn[i]) >> 10) <= k) {
        const int j = jn[i];
        uint4 v0[8];
#pragma unroll
        for (int m = 0; m < 8; ++m) {
          const int e = __builtin_amdgcn_readlane((int)E[T0 + i][m & 1], j + 16 * (m >> 1));
          v0[m] = *(const uint4*)(PV + (size_t)e * 1024);
        }
        const int wq0 = __builtin_amdgcn_readlane((int)WQ[T0 + i], j);
        const int wq1 = __builtin_amdgcn_readlane((int)WQ[T0 + i], j + 32);
#pragma unroll
        for (int rq = 0; rq < 2; ++rq) {
          const int wq = rq ? wq1 : wq0;
          const unsigned r0[4] = {v0[4 * rq].x, v0[4 * rq].y, v0[4 * rq].z, v0[4 * rq].w};
          const unsigned r1[4] = {v0[4 * rq + 1].x, v0[4 * rq + 1].y, v0[4 * rq + 1].z, v0[4 * rq + 1].w};
          const unsigned r2[4] = {v0[4 * rq + 2].x, v0[4 * rq + 2].y, v0[4 * rq + 2].z, v0[4 * rq + 2].w};
          const unsigned r3[4] = {v0[4 * rq + 3].x, v0[4 * rq + 3].y, v0[4 * rq + 3].z, v0[4 * rq + 3].w};
#pragma unroll
          for (int q = 0; q < 4; ++q) {
            const unsigned ta = __builtin_amdgcn_perm(r1[q], r0[q], 0x05010400);
            const unsigned tb = __builtin_amdgcn_perm(r1[q], r0[q], 0x07030602);
            const unsigned tc = __builtin_amdgcn_perm(r3[q], r2[q], 0x05010400);
            const unsigned td = __builtin_amdgcn_perm(r3[q], r2[q], 0x07030602);
            acc[i][4 * q] = __builtin_amdgcn_sdot4((int)__builtin_amdgcn_perm(tc, ta, 0x05040100), wq, acc[i][4 * q], false);
            acc[i][4 * q + 1] = __builtin_amdgcn_sdot4((int)__builtin_amdgcn_perm(tc, ta, 0x07060302), wq, acc[i][4 * q + 1], false);
            acc[i][4 * q + 2] = __builtin_amdgcn_sdot4((int)__builtin_amdgcn_perm(td, tb, 0x05040100), wq, acc[i][4 * q + 2], false);
            acc[i][4 * q + 3] = __builtin_amdgcn_sdot4((int)__builtin_amdgcn_perm(td, tb, 0x07060302), wq, acc[i][4 * q + 3], false);
          }
        }
        jn[i] = j + 1;
      }
    }
  }
#pragma unroll
  for (int i = 0; i < 4; ++i) {
    float accf[16];
#pragma unroll
    for (int q = 0; q < 16; ++q) accf[q] = (float)acc[i][q] * tsc[T0 + i];
    peer_finalize_token<GWRITE>(p, accf, tok0 + 8 * wave + T0 + i, lane);
  }
}

DI void phase_d_tile(const MKParams& p, int tile, int wave, int lane, float rs0, float rs1) {
  asm volatile("" : "+v"(lane));
  char* ws = p.ws;
  char* ldsA = smem;
  float* rs_s = (float*)(smem + LDS_A_BYTES);
  unsigned char* idxs = (unsigned char*)(smem + LDS_A_BYTES + 4096) + wave * 1024;
  u16* qp = (u16*)qp_scratch(ws, blockIdx.x);
  uint2* eg = (uint2*)(ws + OFF_EG + (size_t)blockIdx.x * 65536);
  const size_t tok0 = (size_t)tile * 64;
  if (wave == 0) { if (lane < 32) rs_s[lane] = rs0; else rs_s[lane] = rs1; }
  {
    f16v acc[2][2];
    Ring rg;
    const bf8* wf = (const bf8*)(ws + OFF_WPQ);
#if PROBE == 17
    for (int rep_ = 0; rep_ < 2; ++rep_)
#endif
#pragma unroll 1
    for (int c = 0; c < 4; ++c) {
      int l2 = lane;
      asm volatile("" : "+v"(l2));
      const int r = l2 & 31, h = l2 >> 5;
      if (c == 0) gemm_chunk_r<true, false, true, true>(ldsA, wf + 2 * wave * 64, wf + 65536 + 2 * wave * 64, l2, acc, rg);
      else if (c < 3) gemm_chunk_r<true, false, false, true>(ldsA, wf + (size_t)c * 65536 + 2 * wave * 64, wf + (size_t)(c + 1) * 65536 + 2 * wave * 64, l2, acc, rg);
      else gemm_chunk_r<true, false, false, false>(ldsA, wf + (size_t)c * 65536 + 2 * wave * 64, nullptr, l2, acc, rg);
#pragma unroll
      for (int ntl = 0; ntl < 2; ++ntl)
#pragma unroll
        for (int tt = 0; tt < 2; ++tt)
#pragma unroll
          for (int g = 0; g < 4; ++g) {
            const float sc = tt ? rs1 : rs0;
            f4v v = {acc[ntl][tt][4 * g] * sc, acc[ntl][tt][4 * g + 1] * sc, acc[ntl][tt][4 * g + 2] * sc, acc[ntl][tt][4 * g + 3] * sc};
            *(bf4*)(qp + (size_t)(32 * tt + r) * 2048 + 512 * c + 64 * wave + 32 * ntl + 8 * g + 4 * h) = cvt4(v);
          }
    }
  }
  __syncthreads();
#if PROBE == 16
  for (int rep_ = 0; rep_ < 2; ++rep_)
#endif
#pragma unroll 1
  for (int tt = 0; tt < 2; ++tt) {
    int l2 = lane;
    asm volatile("" : "+v"(l2));
    peer_select(ws, qp, eg, idxs, wave, tt, l2);
  }
  __syncthreads();
}

template <bool GWRITE = true>
DI void phase_d_gather(const MKParams& p, int tile, int wave, int lane) {
  asm volatile("" : "+v"(lane));
  char* ws = p.ws;
  char* ldsA = smem;
  float* rs_s = (float*)(smem + LDS_A_BYTES);
  unsigned char* idxs = (unsigned char*)(smem + LDS_A_BYTES + 4096) + wave * 1024;
  const uint2* eg = (const uint2*)(ws + OFF_EG + (size_t)blockIdx.x * 65536);
  const size_t tok0 = (size_t)tile * 64;
  {
    int l2 = lane;
    asm volatile("" : "+v"(l2));
    unsigned E[8][2], G[8][2];
#pragma unroll
    for (int i = 0; i < 8; ++i)
      peer_bucket_token(eg + (size_t)(8 * wave + i) * 128, (unsigned*)idxs, l2, E[i][0], E[i][1], G[i][0], G[i][1]);
    float xdq[8];
    peer_quant_x(ldsA, wave, l2, xdq);
    int A[8][2];
#if PROBE == 60
    peer_usweep(ws, ldsA, wave, l2, E, A);
    asm volatile("" :: "v"(A[0][0]), "v"(A[0][1]), "v"(A[1][0]), "v"(A[1][1]), "v"(A[2][0]), "v"(A[2][1]), "v"(A[3][0]), "v"(A[3][1]), "v"(A[4][0]), "v"(A[4][1]), "v"(A[5][0]), "v"(A[5][1]), "v"(A[6][0]), "v"(A[6][1]), "v"(A[7][0]), "v"(A[7][1]));
#endif
    peer_usweep(ws, ldsA, wave, l2, E, A);
    unsigned WQ[8];
    float tsc[8];
#pragma unroll
    for (int i = 0; i < 8; ++i) {
      const float rs = rs_s[8 * wave + i];
      float w[2];
#pragma unroll
      for (int cc = 0; cc < 2; ++cc) {
        const float a = (float)A[i][cc] * (rs * xdq[i]) * ((const float*)(ws + OFF_SU))[E[i][cc]];
        w[cc] = __uint_as_float(G[i][cc]) * 0.5f * a * (1.0f + erff(a * 0.70710678118654752f)) *
                ((const float*)(ws + OFF_SV))[E[i][cc]];
      }
      float wm = fmaxf(fabsf(w[0]), fabsf(w[1]));
#pragma unroll
      for (int o = 32; o > 0; o >>= 1) wm = fmaxf(wm, __shfl_xor(wm, o));
      const float sc = (wm > 0.f) ? 127.0f / wm : 0.f;
      tsc[i] = wm * (1.0f / 127.0f);
      const unsigned pr = ((unsigned)((int)rintf(w[0] * sc)) & 0xffu) | (((unsigned)((int)rintf(w[1] * sc)) & 0xffu) << 8);
      const unsigned up = (unsigned)__shfl((int)pr, (l2 + 16) & 63);
      WQ[i] = pr | (up << 16);
    }
    __builtin_amdgcn_sched_barrier(0);
    peer_vsweep<0, GWRITE>(p, wave, l2, tok0, E, WQ, tsc);
    __builtin_amdgcn_sched_barrier(0);
    peer_vsweep<4, GWRITE>(p, wave, l2, tok0, E, WQ, tsc);
  }
}
#ifndef REMAP
#define REMAP 1
#endif
DI int tile_of(int blk, int nblk) { return (REMAP && nblk == 256) ? ((blk & 7) * 32 + (blk >> 3)) : blk; }

__global__ __launch_bounds__(512) void mk(MKParams p) {
  cg::grid_group grid = cg::this_grid();
  const int tid = threadIdx.x;
  const int wave = __builtin_amdgcn_readfirstlane(tid >> 6), lane = tid & 63;
  const int gtid = blockIdx.x * 512 + tid, gthreads = gridDim.x * 512;
  const int gw = blockIdx.x * 8 + wave, nw = gridDim.x * 8;
  unsigned* bar = (unsigned*)(p.ws + OFF_BAR);
  phase_prep(p, gtid, gthreads);
#if !TABLES_IN_B
  phase_prep_tables(p, gw, nw, lane);
#endif
  if (blockIdx.x < 256) load_norm_tile(p.x + (size_t)tile_of(blockIdx.x, gridDim.x) * 64 * DM, smem, wave, lane);
#if FIRST_CG == 1
  grid.sync();
#elif FIRST_CG == 2
  if (p.ws == nullptr) grid.sync();
  grid_barrier(bar, 1u * gridDim.x);
#else
  grid_barrier(bar, 1u * gridDim.x);
#endif
  if (blockIdx.x < 256) { phase_a_tile<true>(p, tile_of(blockIdx.x, gridDim.x), wave, lane); __syncthreads(); gla_g1_tile(p, tile_of(blockIdx.x, gridDim.x), wave, lane); }
  for (int tile = blockIdx.x + gridDim.x; tile < 256; tile += gridDim.x) { phase_a_tile<false>(p, tile_of(tile, gridDim.x), wave, lane); __syncthreads(); gla_g1_tile(p, tile_of(tile, gridDim.x), wave, lane); }
#if PROBE == 40
  for (int tile = blockIdx.x; tile < 256; tile += gridDim.x) { phase_a_tile<false>(p, tile_of(tile, gridDim.x), wave, lane); __syncthreads(); gla_g1_tile(p, tile_of(tile, gridDim.x), wave, lane); }
#endif
  grid_barrier(bar, (2u - (FIRST_CG == 1)) * gridDim.x);
  for (int it = gw; it < 4096; it += nw) sb_item(p, it, lane);
#if PROBE == 44
  for (int it = gw; it < 4096; it += nw) sb_item(p, it, lane);
  phase_prep_tables(p, gw, nw, lane);
#endif
  for (int item = (int)((blockIdx.x + gridDim.x - 64u) % gridDim.x); item < 128; item += gridDim.x) phase_a_memkv(p, item, wave, lane);
  gla_g2(p, gtid, gthreads);
#if TABLES_IN_B
  phase_prep_tables(p, gw, nw, lane);
#endif
  grid_barrier(bar, (3u - (FIRST_CG == 1)) * gridDim.x);
  for (int t0 = blockIdx.x; t0 < 256; t0 += gridDim.x) {
    const int tile = tile_of(t0, gridDim.x);
    float rs0, rs1;
#if PROBE == 41
    phase_c_tile(p, tile, wave, lane, rs0, rs1);
#endif
    phase_c_tile(p, tile, wave, lane, rs0, rs1);
#if PROBE == 42
    phase_d_tile(p, tile, wave, lane, rs0, rs1);
#endif
    phase_d_tile(p, tile, wave, lane, rs0, rs1);
#if GATHER_ALIGN
    grid_barrier(bar, (4u - (FIRST_CG == 1)) * gridDim.x);
#endif
#if PROBE == 43
    phase_d_gather<false>(p, tile, wave, lane);
#endif
    phase_d_gather<true>(p, tile, wave, lane);
  }
#if FIRST_CG == 0
  grid.sync();
#endif
}
#define MK_LDS (160 * 1024)
extern "C" void kernel_launch(void* const* d_in, const int* in_sizes, int n_in, void* d_out, int out_size, void* d_ws,
                              size_t ws_size, hipStream_t stream) {
  MKParams p{};
  p.x = (const float*)d_in[0]; p.mem = (const float*)d_in[1]; p.g_mix = (const float*)d_in[2];
  p.w_in = (const float*)d_in[3]; p.w_up = (const float*)d_in[4]; p.b_alpha = (const float*)d_in[5];
  p.g_gla = (const float*)d_in[6]; p.w_out = (const float*)d_in[7]; p.g_mq = (const float*)d_in[8];
  p.g_mkv = (const float*)d_in[9]; p.w_mq = (const float*)d_in[10]; p.w_mkv = (const float*)d_in[11];
  p.w_mo = (const float*)d_in[12]; p.g_ffn = (const float*)d_in[13]; p.w_pq = (const float*)d_in[14];
  p.subk = (const float*)d_in[15]; p.pu = (const float*)d_in[16]; p.pv = (const float*)d_in[17];
  p.g_fin = (const float*)d_in[18];
  p.out = (float*)d_out; p.ws = (char*)d_ws;
  float* out = (float*)d_out;
  char* wsb = (char*)d_ws;
  float* ws = (float*)d_ws;
  static int grid_blocks = 0;
  if (!grid_blocks) {
    int dev = 0, cus = 0, per_cu = 0;
    (void)hipGetDevice(&dev);
    (void)hipDeviceGetAttribute(&cus, hipDeviceAttributeMultiprocessorCount, dev);
    (void)hipFuncSetAttribute((const void*)mk, hipFuncAttributeMaxDynamicSharedMemorySize, MK_LDS);
    (void)hipOccupancyMaxActiveBlocksPerMultiprocessor(&per_cu, mk, 512, MK_LDS);
    grid_blocks = cus * per_cu;
    fprintf(stderr, "mk: cus=%d per_cu=%d grid=%d ws=%zu\n", cus, per_cu, grid_blocks, ws_size);
  }
  (void)hipMemsetAsync((char*)d_ws + OFF_BAR, 0, 64, stream);
  {
    void* args[] = {(void*)&p};
    hipError_t e = hipLaunchCooperativeKernel((const void*)mk, dim3(grid_blocks), dim3(512), args, MK_LDS, stream);
    if (e != hipSuccess) fprintf(stderr, "coop launch failed: %s grid %d\n", hipGetErrorString(e), grid_blocks);
  }
}
```

```cpp
#ifndef GEMM_D
#define GEMM_D 8
#endif
#ifndef TABLES_IN_B
#define TABLES_IN_B 4
#endif
#ifndef REMAP
#define REMAP 0
#endif
#ifndef FIRST_CG
#define FIRST_CG 1
#endif
#ifndef GATHER_ALIGN
#define GATHER_ALIGN 0
#endif
#ifndef LATE_PREP
#define LATE_PREP 1
#endif
#ifndef B_ORDER
#define B_ORDER 0
#endif
#ifndef SWEEP_NB
#define SWEEP_NB 16
#define SWEEP_SH 10
#endif
#ifndef CLASS_ORDER
#define CLASS_ORDER 0
#endif
#ifndef STAGGER_B
#define STAGGER_B 0
#endif
#ifndef PROBE
#define PROBE 0
#endif
#include <hip/hip_runtime.h>
#include <hip/hip_cooperative_groups.h>
#include <math.h>
#include <stdio.h>
#include <stdint.h>
namespace cg = cooperative_groups;

#ifndef PROBE
#define PROBE 0
#endif
#ifndef TABLES_IN_B
#define TABLES_IN_B 1
#endif
#define NB 8
#define SEQ 2048
#define DM 1024
#define NTOK (NB * SEQ)
#define INC 3088
#define MEML 256
#define EPSV 1e-6f

typedef __attribute__((ext_vector_type(8))) __bf16 bf8;
typedef __attribute__((ext_vector_type(4))) __bf16 bf4;
typedef __attribute__((ext_vector_type(2))) __bf16 bf2;
typedef __attribute__((ext_vector_type(16))) float f16v;
typedef __attribute__((ext_vector_type(8))) float f8v;
typedef __attribute__((ext_vector_type(4))) float f4v;
typedef __attribute__((ext_vector_type(2))) float f2v;
typedef unsigned short u16;

#define DI __device__ __forceinline__
#ifndef USE_NT
#define USE_NT 1
#endif
#if USE_NT
#define NT_LOAD(p) __builtin_nontemporal_load(p)
#else
#define NT_LOAD(p) (*(p))
#endif
#define MFMA(a, b, c) __builtin_amdgcn_mfma_f32_32x32x16_bf16((a), (b), (c), 0, 0, 0)

DI int crow(int i, int h) { return (i & 3) + 8 * (i >> 2) + 4 * h; }
DI int tpos(int t) { return (t & ~12) | ((t & 4) << 1) | ((t & 8) >> 1); }
DI float bf2f(u16 v) { return __uint_as_float(((unsigned)v) << 16); }
DI bf8 cvt8(f8v v) { return __builtin_convertvector(v, bf8); }
DI bf4 cvt4(f4v v) { return __builtin_convertvector(v, bf4); }
DI f16v zero16() { f16v z = {0.f, 0.f, 0.f, 0.f, 0.f, 0.f, 0.f, 0.f, 0.f, 0.f, 0.f, 0.f, 0.f, 0.f, 0.f, 0.f}; return z; }

#define MiB ((size_t)1 << 20)
#define OFF_WIN   ((size_t)0)
#define OFF_WOUT  (OFF_WIN + 97 * 65536)
#define OFF_WMQ   (OFF_WOUT + 32 * 65536)
#define OFF_WMKV  (OFF_WMQ + 32 * 65536)
#define OFF_WMO   (OFF_WMKV + 64 * 65536)
#define OFF_WPQ   (OFF_WMO + 32 * 65536)
#define OFF_SUBK  (OFF_WPQ + 64 * 65536)
#define OFF_ACT   (21 * MiB)
#define OFF_GQ    (OFF_ACT)
#define OFF_GK    (OFF_GQ + 8 * MiB)
#define OFF_GVT   (OFF_GK + 8 * MiB)
#define OFF_OG    (OFF_GVT + 16 * MiB)
#define OFF_SQ    (OFF_OG + 16 * MiB)
#define OFF_SK    (OFF_SQ + 16 * MiB)
#define OFF_SVT   (OFF_SK + 16 * MiB)
#define OFF_LA    (OFF_SVT + 16 * MiB)
#define OFF_LKV   (OFF_LA + 16 * MiB)
#define OFF_DD    (OFF_LKV + 32 * MiB)
#define OFF_OSB   (OFF_DD + 1 * MiB)
#define OFF_KM    (OFF_OSB + 16 * MiB)
#define OFF_VMT   (OFF_KM + 4 * MiB)
#define OFF_PU    (OFF_VMT + 4 * MiB)
#define OFF_PV    (OFF_PU + 16 * MiB)
#define OFF_SU    (OFF_PV + 16 * MiB)
#define OFF_SV    (OFF_SU + 65536)
#define OFF_GQ2   (224 * MiB)
#define OFF_GK2   (232 * MiB)
#define OFF_SS    (OFF_LA)

#define LDS_ROW 2064
#define LDS_A_BYTES (64 * LDS_ROW)

DI char* qp_scratch(char* ws, int blk) {
  return blk < 192 ? ws + OFF_SQ + (size_t)blk * 262144 : ws + OFF_LKV + (size_t)(blk - 192) * 262144;
}

#define OFF_BAR (OFF_DD + 768 * 1024)
DI void grid_barrier(unsigned* ctr, unsigned target) {
  __syncthreads();
  if (threadIdx.x == 0) {
    __builtin_amdgcn_fence(__ATOMIC_RELEASE, "agent");
    asm volatile("s_waitcnt vmcnt(0)" ::: "memory");
    __hip_atomic_fetch_add(ctr, 1u, __ATOMIC_RELAXED, __HIP_MEMORY_SCOPE_AGENT);
    while (__hip_atomic_load(ctr, __ATOMIC_RELAXED, __HIP_MEMORY_SCOPE_AGENT) < target) __builtin_amdgcn_s_sleep(1);
    __builtin_amdgcn_fence(__ATOMIC_ACQUIRE, "agent");
    asm volatile("s_waitcnt vmcnt(0)" ::: "memory");
  }
  __syncthreads();
}

struct MKParams {
  const float *x, *mem, *g_mix, *w_in, *w_up, *b_alpha, *g_gla, *w_out, *g_mq, *g_mkv, *w_mq, *w_mkv, *w_mo, *g_ffn, *w_pq,
      *subk, *pu, *pv, *g_fin;
  float* out;
  char* ws;
};
extern __shared__ __attribute__((aligned(16))) char smem[];

template <typename ColFn>
DI void prep_w(bf8* dst, const float* __restrict__ W, int ldw, int ntiles, const float* __restrict__ gain, ColFn colfn,
               int gtid, int gthreads) {
  const int total = ntiles * 4096;
#pragma unroll 1
  for (int u0 = gtid; u0 < total; u0 += 4 * gthreads) {
    f8v v[4];
    int didx[4];
#pragma unroll
    for (int t = 0; t < 4; ++t) {
      const int u = u0 + t * gthreads;
      didx[t] = -1;
      if (u < total) {
        const int lane = u & 63, ks = (u >> 6) & 63, nt = u >> 12;
        const int r = lane & 31, h = lane >> 5;
        float sc = 1.f;
        const int col = colfn(32 * nt + r, sc);
#pragma unroll
        for (int j = 0; j < 8; ++j) {
          const int k = 16 * ks + 8 * h + j;
          float val = 0.f;
          if (col >= 0) val = NT_LOAD(W + (size_t)k * ldw + col) * sc * (gain ? gain[k] : 1.f);
          v[t][j] = val;
        }
        didx[t] = (nt < (ntiles & ~15)) ? ((((nt >> 4) * 64 + ks) * 16 + (nt & 15)) * 64 + lane) : u;
      }
    }
#pragma unroll
    for (int t = 0; t < 4; ++t)
      if (didx[t] >= 0) dst[didx[t]] = cvt8(v[t]);
  }
}

DI void phase_prep(const MKParams& p, int gtid, int gthreads) {
  char* ws = p.ws;
  prep_w((bf8*)(ws + OFF_WIN), p.w_in, INC, 97, p.g_mix,
         [](int n, float& sc) -> int {
           if (n < 256) { sc = 0.125f; return n; }
           if (n < 1536) return n;
           if (n < 2048) { sc = 0.125f; return n + 16; }
           if (n < 3072) return n + 16;
           if (n < 3088) return n - 1536;
           return -1;
         }, gtid, gthreads);
  prep_w((bf8*)(ws + OFF_WMKV), p.w_mkv, 2048, 64, p.g_mkv, [](int n, float& sc) -> int { return n; }, gtid, gthreads);
}
DI void phase_prep_late(const MKParams& p, int gtid, int gthreads) {
  char* ws = p.ws;
  prep_w((bf8*)(ws + OFF_WOUT), p.w_out, 1024, 32, nullptr, [](int n, float& sc) -> int { return n; }, gtid, gthreads);
  prep_w((bf8*)(ws + OFF_WMQ), p.w_mq, 1024, 32, p.g_mq, [](int n, float& sc) -> int { sc = 0.0625f; return n; }, gtid, gthreads);
  prep_w((bf8*)(ws + OFF_WMO), p.w_mo, 1024, 32, nullptr, [](int n, float& sc) -> int { return n; }, gtid, gthreads);
  prep_w((bf8*)(ws + OFF_WPQ), p.w_pq, 2048, 64, p.g_ffn, [](int n, float& sc) -> int { return n; }, gtid, gthreads);
  {
    bf8* dst = (bf8*)(ws + OFF_SUBK);
    const int total = 16 * 4 * 8 * 64;
    for (int u = gtid; u < total; u += gthreads) {
      const int lane = u & 63, ks = (u >> 6) & 7, mt = (u >> 9) & 3, hp = u >> 11;
      const int r = lane & 31, h = lane >> 5;
      const float* s = p.subk + ((size_t)(hp * 128 + 32 * mt + r)) * 128 + 16 * ks + 8 * h;
      const f4v a = *(const f4v*)s, b = *(const f4v*)(s + 4);
      f8v v = {a[0], a[1], a[2], a[3], b[0], b[1], b[2], b[3]};
      dst[u] = cvt8(v);
    }
  }
}

DI void table_row_issue(const MKParams& p, int row, int lane, f4v (&v)[4]) {
  const int e = row & 16383;
  const float* src = ((row >= 16384) ? p.pv : p.pu) + (size_t)e * DM + 16 * lane;
#pragma unroll
  for (int q = 0; q < 4; ++q) v[q] = NT_LOAD((const f4v*)(src + 4 * q));
}
DI void table_row_finish(const MKParams& p, int row, int lane, f4v (&v)[4]) {
  const int e = row & 16383;
  const bool isv = row >= 16384;
  if (!isv) {
#pragma unroll
    for (int q = 0; q < 4; ++q) v[q] = v[q] * *(const f4v*)(p.g_ffn + 16 * lane + 4 * q);
  }
  float am = 0.f;
#pragma unroll
  for (int q = 0; q < 4; ++q)
#pragma unroll
    for (int j = 0; j < 4; ++j) am = fmaxf(am, fabsf(v[q][j]));
#pragma unroll
  for (int o = 32; o > 0; o >>= 1) am = fmaxf(am, __shfl_xor(am, o));
  const float sc = (am > 0.f) ? 127.0f / am : 0.f;
  unsigned w[4];
#pragma unroll
  for (int q = 0; q < 4; ++q) {
    unsigned pk = 0;
#pragma unroll
    for (int j = 0; j < 4; ++j) pk |= ((unsigned)((int)rintf(v[q][j] * sc)) & 0xffu) << (8 * j);
    w[q] = pk;
  }
  *(uint4*)(p.ws + (isv ? OFF_PV : OFF_PU) + (size_t)e * 1024 + 16 * lane) = make_uint4(w[0], w[1], w[2], w[3]);
  if (lane == 0) ((float*)(p.ws + (isv ? OFF_SV : OFF_SU)))[e] = am * (1.0f / 127.0f);
}
DI void prep_table_row(const MKParams& p, int row, int lane) {
  f4v v[4];
  table_row_issue(p, row, lane, v);
  table_row_finish(p, row, lane, v);
}
DI void phase_prep_tables(const MKParams& p, int gwave, int nwaves, int lane) {
  for (int row = gwave; row < 32768; row += nwaves) prep_table_row(p, row, lane);
}
DI void phase_prep_tables_bal(const MKParams& p, int blk, int nblk, int wave, int lane) {
  if (nblk != 256) { phase_prep_tables(p, blk * 8 + wave, nblk * 8, lane); return; }
  int base, per, idx;
  if (blk >= 64 && blk < 192) { base = 0; per = 7; idx = (blk - 64) * 8 + wave; }
  else if (blk < 64) { base = 7168; per = 21; idx = blk * 8 + wave; }
  else { base = 17920; per = 29; idx = (blk - 192) * 8 + wave; }
  for (int i = 0; i < per; ++i) prep_table_row(p, base + idx * per + i, lane);
}
#ifndef TBL_IN_A
#define TBL_IN_A 12
#endif
DI void phase_prep_tables_rest(const MKParams& p, int gwave, int nwaves, int lane) {
  if (nwaves != 2048) { phase_prep_tables(p, gwave, nwaves, lane); return; }
  for (int rr = TBL_IN_A; rr < 16; ++rr) prep_table_row(p, gwave * 16 + rr, lane);
}
DI void phase_prep_tables_dyn(const MKParams& p, unsigned* qctr, int lane) {
  while (true) {
    unsigned c = 0;
    if (lane == 0) c = __hip_atomic_fetch_add(qctr, 1u, __ATOMIC_RELAXED, __HIP_MEMORY_SCOPE_AGENT);
    c = (unsigned)__builtin_amdgcn_readfirstlane((int)c);
    if (c >= 1024u) break;
#pragma unroll 2
    for (int rr = 0; rr < 32; ++rr) prep_table_row(p, (int)c * 32 + rr, lane);
  }
}

DI void load_norm_tile(const float* __restrict__ src, char* ldsA, int wave, int lane) {
#pragma unroll 2
  for (int i = 0; i < 8; ++i) {
    const int row = 8 * wave + i;
    const f4v* pr = (const f4v*)(src + (size_t)row * DM);
    f4v v[4];
#pragma unroll
    for (int c = 0; c < 4; ++c) v[c] = NT_LOAD(pr + lane + 64 * c);
    float ss = 0.f;
#pragma unroll
    for (int c = 0; c < 4; ++c) ss += v[c][0] * v[c][0] + v[c][1] * v[c][1] + v[c][2] * v[c][2] + v[c][3] * v[c][3];
#pragma unroll
    for (int o = 32; o > 0; o >>= 1) ss += __shfl_xor(ss, o);
    const float rs = rsqrtf(ss * (1.0f / DM) + EPSV);
#pragma unroll
    for (int c = 0; c < 4; ++c) {
      f4v t = v[c] * rs;
      *(bf4*)(ldsA + row * LDS_ROW + (lane * 4 + 256 * c) * 2) = cvt4(t);
    }
  }
}

#ifndef GEMM_D
#define GEMM_D 6
#endif
template <bool SWAP>
DI void gemm_step(f16v (&acc)[2][2], const bf8& a0, const bf8& a1, const bf8& x0, const bf8& x1) {
  if (SWAP) {
    acc[0][0] = MFMA(a0, x0, acc[0][0]); acc[0][1] = MFMA(a0, x1, acc[0][1]);
    acc[1][0] = MFMA(a1, x0, acc[1][0]); acc[1][1] = MFMA(a1, x1, acc[1][1]);
  } else {
    acc[0][0] = MFMA(x0, a0, acc[0][0]); acc[0][1] = MFMA(x1, a0, acc[0][1]);
    acc[1][0] = MFMA(x0, a1, acc[1][0]); acc[1][1] = MFMA(x1, a1, acc[1][1]);
  }
}
struct Ring { bf8 w0[GEMM_D], w1[GEMM_D]; };
DI void ring_fill(Ring& rg, const bf8* __restrict__ wf, int lane) {
#pragma unroll
  for (int i = 0; i < GEMM_D; ++i) { rg.w0[i] = wf[lane + i * 1024]; rg.w1[i] = wf[64 + lane + i * 1024]; }
}
template <bool SWAP, bool RES, bool FIRST, bool NEXT>
DI void gemm_chunk_r(const char* ldsA, const bf8* __restrict__ wf, const bf8* __restrict__ wnext, int lane, f16v (&acc)[2][2],
                     Ring& rg, const float* res = nullptr) {
  __builtin_amdgcn_sched_barrier(0);
  const int r = lane & 31, h = lane >> 5;
  const char* xa0 = ldsA + r * LDS_ROW + h * 16;
  const char* xa1 = xa0 + 32 * LDS_ROW;
  const bf8* w0p = wf + lane;
  const bf8* w1p = wf + 64 + lane;
  if (FIRST) ring_fill(rg, wf, lane);
  if (RES) {
#pragma unroll
    for (int ntl = 0; ntl < 2; ++ntl)
#pragma unroll
      for (int tt = 0; tt < 2; ++tt)
#pragma unroll
        for (int g = 0; g < 4; ++g) {
          const f4v x = *(const f4v*)(res + (size_t)(32 * tt + r) * DM + 32 * ntl + 8 * g + 4 * h);
          acc[ntl][tt][4 * g] = x[0]; acc[ntl][tt][4 * g + 1] = x[1]; acc[ntl][tt][4 * g + 2] = x[2]; acc[ntl][tt][4 * g + 3] = x[3];
        }
  } else {
    acc[0][0] = zero16(); acc[0][1] = zero16(); acc[1][0] = zero16(); acc[1][1] = zero16();
  }
  bf8 x0 = *(const bf8*)(xa0), x1 = *(const bf8*)(xa1);
  constexpr int KMAIN = ((64 - 2 * GEMM_D) / GEMM_D + 1) * GEMM_D;
#pragma unroll 1
  for (int ks0 = 0; ks0 < KMAIN; ks0 += GEMM_D) {
#pragma unroll
    for (int i = 0; i < GEMM_D; ++i) {
      const int ks = ks0 + i;
      const bf8 xn0 = *(const bf8*)(xa0 + (ks + 1) * 32);
      const bf8 xn1 = *(const bf8*)(xa1 + (ks + 1) * 32);
      gemm_step<SWAP>(acc, rg.w0[i], rg.w1[i], x0, x1);
      rg.w0[i] = w0p[(ks + GEMM_D) * 1024];
      rg.w1[i] = w1p[(ks + GEMM_D) * 1024];
      x0 = xn0; x1 = xn1;
      __builtin_amdgcn_sched_group_barrier(0x100, 2, 0);
      __builtin_amdgcn_sched_group_barrier(0x008, 2, 0);
      __builtin_amdgcn_sched_group_barrier(0x020, 2, 0);
      __builtin_amdgcn_sched_group_barrier(0x008, 2, 0);
    }
  }
#pragma unroll
  for (int t = 0; t < 64 - KMAIN; ++t) {
    const int ks = KMAIN + t, i = t % GEMM_D;
    const bf8 xn0 = *(const bf8*)(xa0 + (ks + 1) * 32);
    const bf8 xn1 = *(const bf8*)(xa1 + (ks + 1) * 32);
    gemm_step<SWAP>(acc, rg.w0[i], rg.w1[i], x0, x1);
    const bool refill = (ks + GEMM_D < 64) || NEXT;
    if (ks + GEMM_D < 64) {
      rg.w0[i] = w0p[(ks + GEMM_D) * 1024];
      rg.w1[i] = w1p[(ks + GEMM_D) * 1024];
    } else if (NEXT) {
      rg.w0[i] = wnext[lane + (ks + GEMM_D - 64) * 1024];
      rg.w1[i] = wnext[64 + lane + (ks + GEMM_D - 64) * 1024];
    }
    x0 = xn0; x1 = xn1;
    __builtin_amdgcn_sched_group_barrier(0x100, 2, 0);
    __builtin_amdgcn_sched_group_barrier(0x008, 2, 0);
    if (refill) __builtin_amdgcn_sched_group_barrier(0x020, 2, 0);
    __builtin_amdgcn_sched_group_barrier(0x008, 2, 0);
  }
}
template <bool SWAP, bool RES = false>
DI void gemm_chunk(const char* ldsA, const bf8* __restrict__ wf, int lane, f16v (&acc)[2][2], const float* res = nullptr) {
  Ring rg;
  gemm_chunk_r<SWAP, RES, true, false>(ldsA, wf, nullptr, lane, acc, rg, res);
}

DI void store_swap_bf16(u16* dst, size_t ld, const f16v (&acc)[2][2], int lane) {
  const int r = lane & 31, h = lane >> 5;
#pragma unroll
  for (int ntl = 0; ntl < 2; ++ntl)
#pragma unroll
    for (int tt = 0; tt < 2; ++tt)
#pragma unroll
      for (int g = 0; g < 4; ++g) {
        f4v v = {acc[ntl][tt][4 * g], acc[ntl][tt][4 * g + 1], acc[ntl][tt][4 * g + 2], acc[ntl][tt][4 * g + 3]};
        *(bf4*)(dst + (size_t)(32 * tt + r) * ld + 32 * ntl + 8 * g + 4 * h) = cvt4(v);
      }
}
DI void store_vt_bf16(u16* dst, size_t ld, const f16v (&acc)[2][2], int lane) {
  const int r = lane & 31, h = lane >> 5;
#pragma unroll
  for (int ntl = 0; ntl < 2; ++ntl)
#pragma unroll
    for (int tt = 0; tt < 2; ++tt)
#pragma unroll
      for (int s = 0; s < 2; ++s) {
        f8v v;
#pragma unroll
        for (int j = 0; j < 8; ++j) v[j] = acc[ntl][tt][8 * s + j];
        *(bf8*)(dst + (size_t)(32 * ntl + r) * ld + 32 * tt + 16 * s + 8 * h) = cvt8(v);
      }
}

DI float log_sigmoid_acc(float x) { return fminf(x, 0.f) - log1pf(expf(-fabsf(x))); }

template <bool PRELOADED = false, bool TBL = false>
DI void phase_a_tile(const MKParams& p, int tile, int wave, int lane) {
  asm volatile("" : "+v"(lane));
  char* ws = p.ws;
  char* ldsA = smem;
  float* alr_s = (float*)(smem + LDS_A_BYTES);
  const int b = tile >> 5, c = tile & 31;
  const size_t tok0 = (size_t)tile * 64;
  if (!PRELOADED) {
    __syncthreads();
    load_norm_tile(p.x + tok0 * DM, ldsA, wave, lane);
#if PROBE == 10
    __syncthreads();
    load_norm_tile(p.x + tok0 * DM, ldsA, wave, lane);
#endif
    __syncthreads();
  }
  const bf8* wf = (const bf8*)(ws + OFF_WIN);
  f16v acc[2][2];
  Ring rg;
  f4v tv[2][4];
  const int trow0 = (blockIdx.x * 8 + wave) * 16;
  const int t0 = c * 64;
  gemm_chunk_r<true, false, true, true>(ldsA, wf + (size_t)0 * 65536 + 2 * wave * 64, wf + (size_t)1 * 65536 + 2 * wave * 64, lane, acc, rg);
  if (TBL && 0 < TBL_IN_A) { table_row_issue(p, trow0 + 0, lane, tv[0]); table_row_issue(p, trow0 + 1, lane, tv[1]); }
  {
    u16* base = (u16*)(ws + (wave < 4 ? OFF_GQ : OFF_GK)) + ((size_t)(b * 4 + (wave & 3)) * SEQ + t0) * 64;
    store_swap_bf16(base, 64, acc, lane);
  if (TBL && 0 < TBL_IN_A) { table_row_finish(p, trow0 + 0, lane, tv[0]); table_row_finish(p, trow0 + 1, lane, tv[1]); }
#if PROBE == 11
    store_swap_bf16(base, 64, acc, lane);
#endif
  }
  gemm_chunk_r<false, false, false, true>(ldsA, wf + (size_t)1 * 65536 + 2 * wave * 64, wf + (size_t)2 * 65536 + 2 * wave * 64, lane, acc, rg);
  if (TBL && 2 < TBL_IN_A) { table_row_issue(p, trow0 + 2, lane, tv[0]); table_row_issue(p, trow0 + 3, lane, tv[1]); }
  {
    u16* base = (u16*)(ws + OFF_GVT) + ((size_t)(b * 4 + (wave >> 1)) * 128 + 64 * (wave & 1)) * SEQ + t0;
    store_vt_bf16(base, SEQ, acc, lane);
  if (TBL && 2 < TBL_IN_A) { table_row_finish(p, trow0 + 2, lane, tv[0]); table_row_finish(p, trow0 + 3, lane, tv[1]); }
#if PROBE == 11
    store_vt_bf16(base, SEQ, acc, lane);
#endif
  }
  gemm_chunk_r<true, false, false, true>(ldsA, wf + (size_t)2 * 65536 + 2 * wave * 64, wf + (size_t)3 * 65536 + 2 * wave * 64, lane, acc, rg);
  if (TBL && 4 < TBL_IN_A) { table_row_issue(p, trow0 + 4, lane, tv[0]); table_row_issue(p, trow0 + 5, lane, tv[1]); }
  store_swap_bf16((u16*)(ws + OFF_OG) + tok0 * 512 + 64 * wave, 512, acc, lane);
  if (TBL && 4 < TBL_IN_A) { table_row_finish(p, trow0 + 4, lane, tv[0]); table_row_finish(p, trow0 + 5, lane, tv[1]); }
#if PROBE == 11
  store_swap_bf16((u16*)(ws + OFF_OG) + tok0 * 512 + 64 * wave, 512, acc, lane);
#endif
  gemm_chunk_r<true, false, false, true>(ldsA, wf + (size_t)3 * 65536 + 2 * wave * 64, wf + (size_t)4 * 65536 + 2 * wave * 64, lane, acc, rg);
  if (TBL && 6 < TBL_IN_A) { table_row_issue(p, trow0 + 6, lane, tv[0]); table_row_issue(p, trow0 + 7, lane, tv[1]); }
  store_swap_bf16((u16*)(ws + OFF_SQ) + ((size_t)(b * 8 + wave) * SEQ + t0) * 64, 64, acc, lane);
  if (TBL && 6 < TBL_IN_A) { table_row_finish(p, trow0 + 6, lane, tv[0]); table_row_finish(p, trow0 + 7, lane, tv[1]); }
#if PROBE == 11
  store_swap_bf16((u16*)(ws + OFF_SQ) + ((size_t)(b * 8 + wave) * SEQ + t0) * 64, 64, acc, lane);
#endif
  gemm_chunk_r<true, false, false, true>(ldsA, wf + (size_t)4 * 65536 + 2 * wave * 64, wf + (size_t)5 * 65536 + 2 * wave * 64, lane, acc, rg);
  if (TBL && 8 < TBL_IN_A) { table_row_issue(p, trow0 + 8, lane, tv[0]); table_row_issue(p, trow0 + 9, lane, tv[1]); }
  store_swap_bf16((u16*)(ws + OFF_SK) + ((size_t)(b * 8 + wave) * SEQ + t0) * 64, 64, acc, lane);
  if (TBL && 8 < TBL_IN_A) { table_row_finish(p, trow0 + 8, lane, tv[0]); table_row_finish(p, trow0 + 9, lane, tv[1]); }
#if PROBE == 11
  store_swap_bf16((u16*)(ws + OFF_SK) + ((size_t)(b * 8 + wave) * SEQ + t0) * 64, 64, acc, lane);
#endif
  gemm_chunk_r<false, false, false, false>(ldsA, wf + (size_t)5 * 65536 + 2 * wave * 64, nullptr, lane, acc, rg);
  if (TBL && 10 < TBL_IN_A) { table_row_issue(p, trow0 + 10, lane, tv[0]); table_row_issue(p, trow0 + 11, lane, tv[1]); }
  store_vt_bf16((u16*)(ws + OFF_SVT) + ((size_t)(b * 8 + wave) * 64) * SEQ + t0, SEQ, acc, lane);
  if (TBL && 10 < TBL_IN_A) { table_row_finish(p, trow0 + 10, lane, tv[0]); table_row_finish(p, trow0 + 11, lane, tv[1]); }
#if PROBE == 11
  store_vt_bf16((u16*)(ws + OFF_SVT) + ((size_t)(b * 8 + wave) * 64) * SEQ + t0, SEQ, acc, lane);
#endif
#if PROBE == 12
  for (int rep_ = 0; rep_ < 2; ++rep_) {
  __syncthreads();
#else
  {
#endif
    float* part = (float*)(smem + LDS_A_BYTES);
    const int r = lane & 31, h = lane >> 5;
    const bf8* wp = wf + (size_t)96 * 4096 + lane;
    bf8 wfr[8];
#pragma unroll
    for (int i = 0; i < 8; ++i) wfr[i] = wp[(8 * wave + i) * 64];
    const char* xa0 = ldsA + r * LDS_ROW + h * 16 + wave * 256;
    const char* xa1 = xa0 + 32 * LDS_ROW;
    f16v a0 = zero16(), a1 = zero16();
#pragma unroll
    for (int i = 0; i < 8; ++i) {
      a0 = MFMA(wfr[i], *(const bf8*)(xa0 + i * 32), a0);
      a1 = MFMA(wfr[i], *(const bf8*)(xa1 + i * 32), a1);
    }
    float* pw = part + (wave & 3) * 1024;
    if (wave < 4) {
#pragma unroll
      for (int i = 0; i < 8; ++i) { pw[r * 16 + crow(i, h)] = a0[i]; pw[(32 + r) * 16 + crow(i, h)] = a1[i]; }
    }
    __syncthreads();
    if (wave >= 4) {
#pragma unroll
      for (int i = 0; i < 8; ++i) { pw[r * 16 + crow(i, h)] += a0[i]; pw[(32 + r) * 16 + crow(i, h)] += a1[i]; }
    }
    __syncthreads();
    const int tid = wave * 64 + lane;
    {
      const f4v* p4 = (const f4v*)part;
      if (tid < 256) { f4v s = p4[tid] + p4[256 + tid] + p4[512 + tid] + p4[768 + tid]; ((f4v*)part)[tid] = s; }
    }
    __syncthreads();
    const int col = tid & 255, tg = tid >> 8;
    float wu[16];
#pragma unroll
    for (int rr = 0; rr < 16; ++rr) wu[rr] = p.w_up[rr * 256 + col];
    const float bb = p.b_alpha[col];
    float* dst = (float*)(ws + OFF_LA) + (tok0 + 32 * tg) * 256 + col;
#pragma unroll 4
    for (int t = 0; t < 32; ++t) {
      const f4v* ar = (const f4v*)(part + (32 * tg + t) * 16);
      const f4v q0 = ar[0], q1 = ar[1], q2 = ar[2], q3 = ar[3];
      float s = bb;
      s = fmaf(q0[0], wu[0], s); s = fmaf(q0[1], wu[1], s); s = fmaf(q0[2], wu[2], s); s = fmaf(q0[3], wu[3], s);
      s = fmaf(q1[0], wu[4], s); s = fmaf(q1[1], wu[5], s); s = fmaf(q1[2], wu[6], s); s = fmaf(q1[3], wu[7], s);
      s = fmaf(q2[0], wu[8], s); s = fmaf(q2[1], wu[9], s); s = fmaf(q2[2], wu[10], s); s = fmaf(q2[3], wu[11], s);
      s = fmaf(q3[0], wu[12], s); s = fmaf(q3[1], wu[13], s); s = fmaf(q3[2], wu[14], s); s = fmaf(q3[3], wu[15], s);
      const float ls = fminf(s, 0.f) - __logf(1.0f + __expf(-fabsf(s)));
      dst[(size_t)t * 256] = ls * (1.0f / 16.0f);
    }
  }
}

DI void phase_a_memkv(const MKParams& p, int item, int wave, int lane) {
  asm volatile("" : "+v"(lane));
  char* ws = p.ws;
  char* ldsA = smem;
  const int rt = item >> 2, cc = item & 3;
  const int b = rt >> 2, m0 = (rt & 3) * 64;
  __syncthreads();
  load_norm_tile(p.mem + (size_t)rt * 64 * DM, ldsA, wave, lane);
  __syncthreads();
  const bf8* wf = (const bf8*)(ws + OFF_WMKV);
  f16v acc[2][2];
  if (cc < 2) {
    gemm_chunk<true>(ldsA, wf + (size_t)cc * 65536 + 2 * wave * 64, lane, acc);
    const int f0 = 512 * cc + 64 * wave;
    u16* base = (u16*)(ws + OFF_KM) + ((size_t)(b * 4 + (f0 >> 8)) * 256 + m0) * 256 + (f0 & 255);
    store_swap_bf16(base, 256, acc, lane);
  } else {
    gemm_chunk<false>(ldsA, wf + (size_t)cc * 65536 + 2 * wave * 64, lane, acc);
    const int f0 = 512 * (cc - 2) + 64 * wave;
    u16* base = (u16*)(ws + OFF_VMT) + ((size_t)(b * 4 + (f0 >> 8)) * 256 + (f0 & 255)) * 256 + m0;
    store_vt_bf16(base, 256, acc, lane);
  }
}
#define SB_THR 30.0f

DI bf8 pack8(const f16v& x, int s) {
  f8v v;
#pragma unroll
  for (int j = 0; j < 8; ++j) v[j] = x[8 * s + j];
  return cvt8(v);
}

DI void sb_item(const MKParams& p, int item, int lane) {
  asm volatile("" : "+v"(lane));
  char* ws = p.ws;
  const int r = lane & 31, h = lane >> 5;
  const int bh = item >> 6, qt = item & 63;
  const u16* SQ = (const u16*)(ws + OFF_SQ) + (size_t)bh * SEQ * 64;
  const u16* SK = (const u16*)(ws + OFF_SK) + (size_t)bh * SEQ * 64;
  const u16* SVT = (const u16*)(ws + OFF_SVT) + (size_t)bh * 64 * SEQ;
  bf8 qf[4];
#pragma unroll
  for (int ks = 0; ks < 4; ++ks) qf[ks] = *(const bf8*)(SQ + (size_t)(32 * qt + r) * 64 + 16 * ks + 8 * h);
  bf8 tri[2];
#pragma unroll
  for (int s = 0; s < 2; ++s) {
    f8v t;
#pragma unroll
    for (int j = 0; j < 8; ++j) t[j] = (16 * s + 8 * (j >> 2) + 4 * h + (j & 3) >= r) ? 1.0f : 0.0f;
    tri[s] = cvt8(t);
  }
  f16v o0 = zero16(), o1 = zero16();
  float R = 0.f;
  bf8 kf[4], vf[2][2];
#pragma unroll
  for (int ks = 0; ks < 4; ++ks) kf[ks] = *(const bf8*)(SK + (size_t)(32 * qt + r) * 64 + 16 * ks + 8 * h);
#pragma unroll
  for (int mt = 0; mt < 2; ++mt)
#pragma unroll
    for (int s = 0; s < 2; ++s) vf[mt][s] = *(const bf8*)(SVT + (size_t)(32 * mt + r) * SEQ + 32 * qt + 16 * s + 8 * h);
  for (int kt = qt; kt >= 0; --kt) {
    bf8 kfn[4], vfn[2][2];
    const int ktn = (kt > 0) ? kt - 1 : 0;
#pragma unroll
    for (int ks = 0; ks < 4; ++ks) kfn[ks] = *(const bf8*)(SK + (size_t)(32 * ktn + r) * 64 + 16 * ks + 8 * h);
#pragma unroll
    for (int mt = 0; mt < 2; ++mt)
#pragma unroll
      for (int s = 0; s < 2; ++s) vfn[mt][s] = *(const bf8*)(SVT + (size_t)(32 * mt + r) * SEQ + 32 * ktn + 16 * s + 8 * h);
    f16v z = zero16();
#pragma unroll
    for (int ks = 0; ks < 4; ++ks) z = MFMA(kf[ks], qf[ks], z);
    const bool diag = (kt == qt);
    f16v sp;
    float tot = 0.f;
#pragma unroll
    for (int i = 0; i < 16; ++i) {
      const float zz = z[i];
      const float sv = fmaxf(zz, 0.f) + __logf(1.0f + __expf(-fabsf(zz)));
      const bool valid = !diag || (crow(i, h) < r);
      sp[i] = valid ? sv : 0.f;
      tot += sp[i];
    }
    tot += __shfl_xor(tot, 32);
    f16v C = MFMA(tri[0], pack8(sp, 0), zero16());
    C = MFMA(tri[1], pack8(sp, 1), C);
    f16v a;
#pragma unroll
    for (int i = 0; i < 16; ++i) {
      const bool valid = !diag || (crow(i, h) < r);
      a[i] = valid ? __expf(z[i] - C[i] - R) : 0.f;
    }
    const bf8 a0 = pack8(a, 0), a1 = pack8(a, 1);
    o0 = MFMA(vf[0][0], a0, o0); o0 = MFMA(vf[0][1], a1, o0);
    o1 = MFMA(vf[1][0], a0, o1); o1 = MFMA(vf[1][1], a1, o1);
    R += tot;
    if (__all(R > SB_THR)) break;
#pragma unroll
    for (int ks = 0; ks < 4; ++ks) kf[ks] = kfn[ks];
#pragma unroll
    for (int mt = 0; mt < 2; ++mt)
#pragma unroll
      for (int s = 0; s < 2; ++s) vf[mt][s] = vfn[mt][s];
  }
  const int b = bh >> 3, hd = bh & 7;
  u16* dst = (u16*)(ws + OFF_OSB) + ((size_t)b * SEQ + 32 * qt + r) * 512 + hd * 64 + 4 * h;
#pragma unroll
  for (int g = 0; g < 4; ++g) {
    f4v v0 = {o0[4 * g], o0[4 * g + 1], o0[4 * g + 2], o0[4 * g + 3]};
    f4v v1 = {o1[4 * g], o1[4 * g + 1], o1[4 * g + 2], o1[4 * g + 3]};
    *(bf4*)(dst + 8 * g) = cvt4(v0);
    *(bf4*)(dst + 32 + 8 * g) = cvt4(v1);
  }
}

DI void gla_g1_tile(const MKParams& p, int tile, int wave, int lane) {
  asm volatile("" : "+v"(lane));
  __builtin_amdgcn_sched_barrier(0);
  char* ws = p.ws;
  const int r = lane & 31, h = lane >> 5;
  const int b = tile >> 5, c = tile & 31, hd = wave >> 1, half = wave & 1, bh = b * 4 + hd;
  const int item = bh * 32 + c;
  char* kl = smem + wave * 9216;
  const u16* GQ = (const u16*)(ws + OFF_GQ) + ((size_t)bh * SEQ + 64 * c) * 64;
  const u16* GK = (const u16*)(ws + OFF_GK) + ((size_t)bh * SEQ + 64 * c) * 64;
  u16* GQ2 = (u16*)(ws + OFF_GQ2) + ((size_t)bh * SEQ + 64 * c) * 64;
  u16* GK2 = (u16*)(ws + OFF_GK2) + ((size_t)bh * SEQ + 64 * c) * 64;
  const float* LA = (const float*)(ws + OFF_LA) + ((size_t)b * SEQ + 64 * c) * 256 + hd * 64;
  float bc = 0.f;
#pragma unroll 1
  for (int g = 0; g < 4; ++g) {
    float la_[16];
    u16 q_[16], k_[16];
#pragma unroll
    for (int i = 0; i < 16; ++i) {
      const int t = 16 * g + i;
      la_[i] = LA[(size_t)t * 256 + lane];
      q_[i] = GQ[t * 64 + lane];
      k_[i] = GK[t * 64 + lane];
    }
#pragma unroll
    for (int i = 0; i < 16; ++i) {
      const int t = 16 * g + i;
      bc += la_[i];
      const float eq = __expf(bc);
      const float qn = bf2f(q_[i]) * eq, kn = bf2f(k_[i]) / eq;
      const bf2 pk = __builtin_convertvector((f2v){qn, kn}, bf2);
      const unsigned u = __builtin_bit_cast(unsigned, pk);
      if (half == 0) {
        GQ2[t * 64 + lane] = (u16)(u & 0xffff);
        GK2[t * 64 + lane] = (u16)(u >> 16);
      }
      *(u16*)(kl + lane * 144 + tpos(t) * 2) = (u16)(u >> 16);
    }
  }
  if (half == 0) ((float*)(ws + OFF_DD))[(size_t)item * 64 + lane] = __expf(bc);
  asm volatile("s_waitcnt lgkmcnt(0)" ::: "memory");
  const u16* GVT = (const u16*)(ws + OFF_GVT) + (size_t)bh * 128 * SEQ + 64 * c;
  float* LKV = (float*)(ws + OFF_LKV) + (size_t)item * 128 * 64;
  bf8 kb[2][4];
#pragma unroll
  for (int nt = 0; nt < 2; ++nt)
#pragma unroll
    for (int s = 0; s < 4; ++s) kb[nt][s] = *(const bf8*)(kl + (32 * nt + r) * 144 + (16 * s + 8 * h) * 2);
  bf8 vf[2][4];
#pragma unroll
  for (int m2 = 0; m2 < 2; ++m2)
#pragma unroll
    for (int s = 0; s < 4; ++s) vf[m2][s] = *(const bf8*)(GVT + (size_t)(32 * (2 * half + m2) + r) * SEQ + 16 * s + 8 * h);
  __builtin_amdgcn_sched_barrier(0);
#pragma unroll
  for (int m2 = 0; m2 < 2; ++m2) {
    const int mt = 2 * half + m2;
    f16v a0 = zero16(), a1 = zero16();
#pragma unroll
    for (int s = 0; s < 4; ++s) {
      a0 = MFMA(vf[m2][s], kb[0][s], a0);
      a1 = MFMA(vf[m2][s], kb[1][s], a1);
    }
#pragma unroll
    for (int i = 0; i < 16; ++i) {
      LKV[(32 * mt + crow(i, h)) * 64 + r] = a0[i];
      LKV[(32 * mt + crow(i, h)) * 64 + 32 + r] = a1[i];
    }
  }
  asm volatile("s_waitcnt lgkmcnt(0)" ::: "memory");
}

DI void gla_g2(const MKParams& p, int gtid, int gthreads) {
  char* ws = p.ws;
  for (int u = gtid; u < 32768; u += gthreads) {
    const int oct = u & 7, dv = (u >> 3) & 127, bh = u >> 10;
    f8v S = {0.f, 0.f, 0.f, 0.f, 0.f, 0.f, 0.f, 0.f};
#pragma unroll 4
    for (int c = 0; c < 32; ++c) {
      const size_t item = (size_t)bh * 32 + c;
      *(bf8*)((u16*)(ws + OFF_SS) + (item * 128 + dv) * 64 + oct * 8) = cvt8(S);
      const f8v l = *(const f8v*)((const float*)(ws + OFF_LKV) + (item * 128 + dv) * 64 + oct * 8);
      const f8v d = *(const f8v*)((const float*)(ws + OFF_DD) + item * 64 + oct * 8);
      S = d * (S + l);
    }
  }
}

DI void gla_g3_tile(const MKParams& p, int tile, int wave, int lane, char* dst, int dst_ld) {
  char* ws = p.ws;
  const int r = lane & 31, h = lane >> 5;
  const int b = tile >> 5, c = tile & 31, hd = wave >> 1, tt = wave & 1, bh = b * 4 + hd;
  const u16* GQ = (const u16*)(ws + OFF_GQ2) + ((size_t)bh * SEQ + 64 * c) * 64;
  const u16* GK = (const u16*)(ws + OFF_GK2) + ((size_t)bh * SEQ + 64 * c) * 64;
  const u16* GVT = (const u16*)(ws + OFF_GVT) + (size_t)bh * 128 * SEQ + 64 * c;
  const u16* SS = (const u16*)(ws + OFF_SS) + ((size_t)(bh * 32 + c) * 128) * 64;
  bf8 qf[4];
#pragma unroll
  for (int ks = 0; ks < 4; ++ks) qf[ks] = *(const bf8*)(GQ + (32 * tt + r) * 64 + 16 * ks + 8 * h);
  bf8 pf[2][2];
  {
    bf8 kf[2][4];
#pragma unroll
    for (int kt = 0; kt < 2; ++kt)
      if (kt <= tt) {
#pragma unroll
        for (int ks = 0; ks < 4; ++ks) kf[kt][ks] = *(const bf8*)(GK + (32 * kt + r) * 64 + 16 * ks + 8 * h);
      }
    __builtin_amdgcn_sched_barrier(0);
#pragma unroll
    for (int kt = 0; kt < 2; ++kt) {
      if (kt <= tt) {
        f16v pt = zero16();
#pragma unroll
        for (int ks = 0; ks < 4; ++ks) pt = MFMA(kf[kt][ks], qf[ks], pt);
        if (kt == tt) {
#pragma unroll
          for (int i = 0; i < 16; ++i) pt[i] = (crow(i, h) <= r) ? pt[i] : 0.f;
        }
        pf[kt][0] = pack8(pt, 0);
        pf[kt][1] = pack8(pt, 1);
      }
    }
  }
  f16v o[4];
  {
    bf8 sf[2][4], vf[2][4];
    auto load_tile = [&](int mt, bf8 (&sfx)[4], bf8 (&vfx)[4]) {
#pragma unroll
      for (int ks = 0; ks < 4; ++ks) sfx[ks] = *(const bf8*)(SS + (32 * mt + r) * 64 + 16 * ks + 8 * h);
#pragma unroll
      for (int kt = 0; kt < 2; ++kt)
        if (kt <= tt) {
#pragma unroll
          for (int s = 0; s < 2; ++s) vfx[2 * kt + s] = *(const bf8*)(GVT + (size_t)(32 * mt + r) * SEQ + 32 * kt + 16 * s + 8 * h);
        }
    };
    load_tile(0, sf[0], vf[0]);
#pragma unroll
    for (int mt = 0; mt < 4; ++mt) {
      if (mt + 1 < 4) load_tile(mt + 1, sf[(mt + 1) & 1], vf[(mt + 1) & 1]);
      __builtin_amdgcn_sched_barrier(0);
      o[mt] = zero16();
#pragma unroll
      for (int ks = 0; ks < 4; ++ks) o[mt] = MFMA(sf[mt & 1][ks], qf[ks], o[mt]);
#pragma unroll
      for (int kt = 0; kt < 2; ++kt)
        if (kt <= tt) {
#pragma unroll
          for (int s = 0; s < 2; ++s) o[mt] = MFMA(vf[mt & 1][2 * kt + s], pf[kt][s], o[mt]);
        }
      __builtin_amdgcn_sched_barrier(0);
    }
  }
  float ss = 0.f;
#pragma unroll
  for (int mt = 0; mt < 4; ++mt)
#pragma unroll
    for (int i = 0; i < 16; ++i) ss += o[mt][i] * o[mt][i];
  ss += __shfl_xor(ss, 32);
  const float rr = rsqrtf(ss * (1.0f / 128.0f) + EPSV);
  const size_t tok = (size_t)tile * 64 + 32 * tt + r;
  const u16* OG = (const u16*)(ws + OFF_OG) + tok * 512 + hd * 128;
#pragma unroll
  for (int mt = 0; mt < 4; ++mt)
#pragma unroll
    for (int g = 0; g < 4; ++g) {
      const int dv0 = 32 * mt + 8 * g + 4 * h;
      const ushort4 og4 = *(const ushort4*)(OG + dv0);
      const f4v gg = *(const f4v*)(p.g_gla + dv0);
      const float og[4] = {bf2f(og4.x), bf2f(og4.y), bf2f(og4.z), bf2f(og4.w)};
      f4v v;
#pragma unroll
      for (int j = 0; j < 4; ++j) v[j] = o[mt][4 * g + j] * rr * gg[j] * (og[j] / (1.0f + __expf(-og[j])));
      *(bf4*)(dst + (size_t)(32 * tt + r) * dst_ld + (hd * 128 + dv0) * 2) = cvt4(v);
    }
}
DI void gemm_1024(const char* ldsA, const bf8* __restrict__ wf, int wave, int lane, f16v (&a0)[2][2], f16v (&a1)[2][2]) {
  gemm_chunk<true>(ldsA, wf + 2 * wave * 64, lane, a0);
  gemm_chunk<true>(ldsA, wf + 65536 + 2 * wave * 64, lane, a1);
}
DI void gemm_1024_res(const char* ldsA, const bf8* __restrict__ wf, int wave, int lane, f16v (&a0)[2][2], f16v (&a1)[2][2],
                      const float* res) {
  gemm_chunk<true, true>(ldsA, wf + 2 * wave * 64, lane, a0, res + 64 * wave);
  gemm_chunk<true, true>(ldsA, wf + 65536 + 2 * wave * 64, lane, a1, res + 512 + 64 * wave);
}

DI void store_f32_ssq(const f16v (&a)[2][2], float* dst, int f0, int lane, float (&ssq)[2]) {
  const int r = lane & 31, h = lane >> 5;
#pragma unroll
  for (int ntl = 0; ntl < 2; ++ntl)
#pragma unroll
    for (int tt = 0; tt < 2; ++tt)
#pragma unroll
      for (int g = 0; g < 4; ++g) {
        f4v v = {a[ntl][tt][4 * g], a[ntl][tt][4 * g + 1], a[ntl][tt][4 * g + 2], a[ntl][tt][4 * g + 3]};
        ssq[tt] += v[0] * v[0] + v[1] * v[1] + v[2] * v[2] + v[3] * v[3];
        *(f4v*)(dst + (size_t)(32 * tt + r) * DM + f0 + 32 * ntl + 8 * g + 4 * h) = v;
      }
}

DI void acc_to_scratch(u16* scr, const f16v (&a)[2][2], int f0, int lane, float s0, float s1) {
  const int r = lane & 31, h = lane >> 5;
#pragma unroll
  for (int ntl = 0; ntl < 2; ++ntl)
#pragma unroll
    for (int tt = 0; tt < 2; ++tt)
#pragma unroll
      for (int g = 0; g < 4; ++g) {
        const float sc = tt ? s1 : s0;
        f4v v = {a[ntl][tt][4 * g] * sc, a[ntl][tt][4 * g + 1] * sc, a[ntl][tt][4 * g + 2] * sc, a[ntl][tt][4 * g + 3] * sc};
        *(bf4*)(scr + (size_t)(32 * tt + r) * 1024 + f0 + 32 * ntl + 8 * g + 4 * h) = cvt4(v);
      }
}
typedef __attribute__((ext_vector_type(4))) unsigned u4v;
DI void scratch_to_lds(const u16* scr, char* ldsA, int tid) {
  asm volatile("" : "+v"(tid));
  const unsigned toff = (unsigned)tid * 16u;
#pragma unroll
  for (int half = 0; half < 2; ++half) {
    u4v v[8];
#pragma unroll
    for (int it = 0; it < 8; ++it)
      v[it] = __builtin_nontemporal_load((const u4v*)((const char*)scr + (size_t)(8192 * (8 * half + it)) + toff));
#pragma unroll
    for (int it = 0; it < 8; ++it) {
      const int idx = tid + 512 * (8 * half + it), row = idx >> 7, ch = idx & 127;
      *(u4v*)(ldsA + row * LDS_ROW + ch * 16) = v[it];
    }
  }
}

struct Pk { bf4 v[2][2][4]; };
DI void pack_acc(Pk& pk, const f16v (&a)[2][2], float s0, float s1) {
#pragma unroll
  for (int ntl = 0; ntl < 2; ++ntl)
#pragma unroll
    for (int tt = 0; tt < 2; ++tt)
#pragma unroll
      for (int g = 0; g < 4; ++g) {
        const float sc = tt ? s1 : s0;
        f4v v = {a[ntl][tt][4 * g] * sc, a[ntl][tt][4 * g + 1] * sc, a[ntl][tt][4 * g + 2] * sc, a[ntl][tt][4 * g + 3] * sc};
        pk.v[ntl][tt][g] = cvt4(v);
      }
}
DI void pk_to_lds(char* ldsA, const Pk& pk, int f0, int lane) {
  const int r = lane & 31, h = lane >> 5;
#pragma unroll
  for (int ntl = 0; ntl < 2; ++ntl)
#pragma unroll
    for (int tt = 0; tt < 2; ++tt)
#pragma unroll
      for (int g = 0; g < 4; ++g)
        *(bf4*)(ldsA + (32 * tt + r) * LDS_ROW + (f0 + 32 * ntl + 8 * g + 4 * h) * 2) = pk.v[ntl][tt][g];
}

DI void rms_from_partials(float* red, int wave, int lane, const float (&ssq)[2], float& rs0, float& rs1) {
  red[(wave * 2 + 0) * 64 + lane] = ssq[0];
  red[(wave * 2 + 1) * 64 + lane] = ssq[1];
  __syncthreads();
  const int r = lane & 31;
  float t0 = 0.f, t1 = 0.f;
#pragma unroll
  for (int w = 0; w < 8; ++w) {
    t0 += red[(w * 2 + 0) * 64 + r] + red[(w * 2 + 0) * 64 + 32 + r];
    t1 += red[(w * 2 + 1) * 64 + r] + red[(w * 2 + 1) * 64 + 32 + r];
  }
  rs0 = rsqrtf(t0 * (1.0f / DM) + EPSV);
  rs1 = rsqrtf(t1 * (1.0f / DM) + EPSV);
}

template <bool WRITE = true>
DI void mem_attn(const MKParams& p, char* ldsA, int b, int wave, int lane) {
  char* ws = p.ws;
  const int r = lane & 31, h = lane >> 5;
  const int hm = wave >> 1, tt = wave & 1;
  const char* KM = ws + OFF_KM + (size_t)(b * 4 + hm) * 256 * 256 * 2;
  const char* VMT = ws + OFF_VMT + (size_t)(b * 4 + hm) * 256 * 256 * 2;
  char* qrow = ldsA + (32 * tt + r) * LDS_ROW + hm * 512;
  const unsigned loff = (unsigned)((r * 256 + 8 * h) * 2);
  f16v s[8];
#pragma unroll
  for (int mt = 0; mt < 8; ++mt) s[mt] = zero16();
  bf8 ka[8], kb[8];
#pragma unroll
  for (int mt = 0; mt < 8; ++mt) ka[mt] = *(const bf8*)(KM + (size_t)(mt * 32 * 256 * 2) + loff);
  bf8 qa = *(const bf8*)(qrow + 8 * h * 2), qb;
#pragma unroll 1
  for (int ks = 0; ks < 16; ks += 2) {
#pragma unroll
    for (int mt = 0; mt < 8; ++mt) kb[mt] = *(const bf8*)(KM + (size_t)((mt * 32 * 256 + 16 * (ks + 1)) * 2) + loff);
    qb = *(const bf8*)(qrow + (16 * (ks + 1) + 8 * h) * 2);
#pragma unroll
    for (int mt = 0; mt < 8; ++mt) s[mt] = MFMA(ka[mt], qa, s[mt]);
    __builtin_amdgcn_sched_group_barrier(0x020, 8, 0);
    __builtin_amdgcn_sched_group_barrier(0x100, 1, 0);
    __builtin_amdgcn_sched_group_barrier(0x008, 8, 0);
    if (ks + 2 < 16) {
#pragma unroll
      for (int mt = 0; mt < 8; ++mt) ka[mt] = *(const bf8*)(KM + (size_t)((mt * 32 * 256 + 16 * (ks + 2)) * 2) + loff);
      qa = *(const bf8*)(qrow + (16 * (ks + 2) + 8 * h) * 2);
    }
#pragma unroll
    for (int mt = 0; mt < 8; ++mt) s[mt] = MFMA(kb[mt], qb, s[mt]);
    __builtin_amdgcn_sched_group_barrier(0x020, 8, 0);
    __builtin_amdgcn_sched_group_barrier(0x100, 1, 0);
    __builtin_amdgcn_sched_group_barrier(0x008, 8, 0);
  }
  float mx = -INFINITY;
#pragma unroll
  for (int mt = 0; mt < 8; ++mt)
#pragma unroll
    for (int i = 0; i < 16; ++i) mx = fmaxf(mx, s[mt][i]);
  mx = fmaxf(mx, __shfl_xor(mx, 32));
  float l = 0.f;
  bf8 pf[8][2];
#pragma unroll
  for (int mt = 0; mt < 8; ++mt) {
#pragma unroll
    for (int i = 0; i < 16; ++i) { s[mt][i] = __expf(s[mt][i] - mx); l += s[mt][i]; }
    pf[mt][0] = pack8(s[mt], 0);
    pf[mt][1] = pack8(s[mt], 1);
  }
  l += __shfl_xor(l, 32);
  const float inv = 1.0f / l;
#pragma unroll
  for (int grp = 0; grp < 2; ++grp) {
    f16v o[4];
#pragma unroll
    for (int m4 = 0; m4 < 4; ++m4) o[m4] = zero16();
    const char* vb = VMT + (size_t)(grp * 4 * 32 * 256 * 2) + loff;
    bf8 va[4], vn[4];
#pragma unroll
    for (int m4 = 0; m4 < 4; ++m4) va[m4] = *(const bf8*)(vb + (size_t)(m4 * 32 * 256 * 2));
#pragma unroll
    for (int st = 0; st < 16; ++st) {
      if (st + 1 < 16) {
#pragma unroll
        for (int m4 = 0; m4 < 4; ++m4) vn[m4] = *(const bf8*)(vb + (size_t)((m4 * 32 * 256 + 16 * (st + 1)) * 2));
      }
#pragma unroll
      for (int m4 = 0; m4 < 4; ++m4) o[m4] = MFMA(va[m4], pf[st >> 1][st & 1], o[m4]);
      if (st + 1 < 16) {
        __builtin_amdgcn_sched_group_barrier(0x020, 4, 0);
        __builtin_amdgcn_sched_group_barrier(0x008, 4, 0);
#pragma unroll
        for (int m4 = 0; m4 < 4; ++m4) va[m4] = vn[m4];
      }
    }
#pragma unroll
    for (int m4 = 0; m4 < 4; ++m4)
#pragma unroll
      for (int g = 0; g < 4; ++g) {
        f4v v = {o[m4][4 * g] * inv, o[m4][4 * g + 1] * inv, o[m4][4 * g + 2] * inv, o[m4][4 * g + 3] * inv};
        if (WRITE || v[0] == 123.456f) *(bf4*)(qrow + (32 * (4 * grp + m4) + 8 * g + 4 * h) * 2) = cvt4(v);
      }
  }
}

DI void phase_c_tile(const MKParams& p, int tile, int wave, int lane, float& rs0, float& rs1, Ring& rg) {
  asm volatile("" : "+v"(lane));
  char* ws = p.ws;
  char* ldsA = smem;
  float* red = (float*)(smem + LDS_A_BYTES);
  const size_t tok0 = (size_t)tile * 64;
  const int tid = wave * 64 + lane;
  __syncthreads();
  ring_fill(rg, (const bf8*)(ws + OFF_WOUT) + 2 * wave * 64, lane);
#if PROBE == 15
  gla_g3_tile(p, tile, wave, lane, ldsA, LDS_ROW);
  __builtin_amdgcn_sched_barrier(0);
  asm volatile("" : "+v"(lane));
#endif
  {
  gla_g3_tile(p, tile, wave, lane, ldsA, LDS_ROW);
  {
    const char* osb = ws + OFF_OSB + tok0 * 1024;
#pragma unroll
    for (int it = 0; it < 8; ++it) {
      const int idx = tid + 512 * it, row = idx >> 6, ch = idx & 63;
      *(uint4*)(ldsA + row * LDS_ROW + 1024 + ch * 16) = *(const uint4*)(osb + (size_t)row * 1024 + ch * 16);
    }
  }
  }
  __syncthreads();
  f16v acc[2][2];
  Pk pk0, pk1;
  float* hdst = p.out + tok0 * DM;
  {
    float ssq[2] = {0.f, 0.f};
    const bf8* wf = (const bf8*)(ws + OFF_WOUT);
    asm volatile("" : "+v"(lane));
    gemm_chunk_r<true, true, false, true>(ldsA, wf + 2 * wave * 64, wf + 65536 + 2 * wave * 64, lane, acc, rg, p.x + tok0 * DM + 64 * wave);
    store_f32_ssq(acc, hdst, 64 * wave, lane, ssq);
    pack_acc(pk0, acc, 1.f, 1.f);
    asm volatile("" : "+v"(lane));
    gemm_chunk_r<true, true, false, true>(ldsA, wf + 65536 + 2 * wave * 64, (const bf8*)(ws + OFF_WMQ) + 2 * wave * 64, lane, acc, rg, p.x + tok0 * DM + 512 + 64 * wave);
    store_f32_ssq(acc, hdst, 512 + 64 * wave, lane, ssq);
    pack_acc(pk1, acc, 1.f, 1.f);
    rms_from_partials(red, wave, lane, ssq, rs0, rs1);
  }
  pk_to_lds(ldsA, pk0, 64 * wave, lane);
  pk_to_lds(ldsA, pk1, 512 + 64 * wave, lane);
  __syncthreads();
  {
    const bf8* wf = (const bf8*)(ws + OFF_WMQ);
    asm volatile("" : "+v"(lane));
    gemm_chunk_r<true, false, false, true>(ldsA, wf + 2 * wave * 64, wf + 65536 + 2 * wave * 64, lane, acc, rg);
    pack_acc(pk0, acc, rs0, rs1);
    asm volatile("" : "+v"(lane));
    gemm_chunk_r<true, false, false, false>(ldsA, wf + 65536 + 2 * wave * 64, nullptr, lane, acc, rg);
    pack_acc(pk1, acc, rs0, rs1);
  }
  __syncthreads();
  pk_to_lds(ldsA, pk0, 64 * wave, lane);
  pk_to_lds(ldsA, pk1, 512 + 64 * wave, lane);
  __syncthreads();
#if PROBE == 22
  asm volatile("" : "+v"(lane));
  mem_attn<false>(p, ldsA, tile >> 5, wave, lane);
#endif
  asm volatile("" : "+v"(lane));
  mem_attn<true>(p, ldsA, tile >> 5, wave, lane);
  __syncthreads();
  {
    float ssq[2] = {0.f, 0.f};
    const bf8* wf = (const bf8*)(ws + OFF_WMO);
    asm volatile("" : "+v"(lane));
    gemm_chunk_r<true, true, true, true>(ldsA, wf + 2 * wave * 64, wf + 65536 + 2 * wave * 64, lane, acc, rg, hdst + 64 * wave);
    store_f32_ssq(acc, hdst, 64 * wave, lane, ssq);
    pack_acc(pk0, acc, 1.f, 1.f);
    asm volatile("" : "+v"(lane));
    gemm_chunk_r<true, true, false, true>(ldsA, wf + 65536 + 2 * wave * 64, (const bf8*)(ws + OFF_WPQ) + 2 * wave * 64, lane, acc, rg, hdst + 512 + 64 * wave);
    store_f32_ssq(acc, hdst, 512 + 64 * wave, lane, ssq);
    pack_acc(pk1, acc, 1.f, 1.f);
    rms_from_partials(red, wave, lane, ssq, rs0, rs1);
  }
  pk_to_lds(ldsA, pk0, 64 * wave, lane);
  pk_to_lds(ldsA, pk1, 512 + 64 * wave, lane);
  __syncthreads();
}
#define OFF_EG (OFF_LKV + 16 * MiB)

DI unsigned f2ord(float v) { const unsigned u = __float_as_uint(v); return (u & 0x80000000u) ? ~u : (u | 0x80000000u); }
DI float ord2f(unsigned u) { return __uint_as_float((u & 0x80000000u) ? (u ^ 0x80000000u) : ~u); }

#define CEX(a, b) { const unsigned hi_ = max(k[a], k[b]); const unsigned lo_ = min(k[a], k[b]); k[a] = hi_; k[b] = lo_; }
DI void sort16_desc(unsigned (&k)[16]) {
  CEX(0, 1) CEX(2, 3) CEX(0, 2) CEX(1, 3) CEX(1, 2) CEX(4, 5) CEX(6, 7) CEX(4, 6) CEX(5, 7) CEX(5, 6) CEX(0, 4)
  CEX(2, 6) CEX(2, 4) CEX(1, 5) CEX(3, 7) CEX(3, 5) CEX(1, 2) CEX(3, 4) CEX(5, 6) CEX(8, 9) CEX(10, 11) CEX(8, 10)
  CEX(9, 11) CEX(9, 10) CEX(12, 13) CEX(14, 15) CEX(12, 14) CEX(13, 15) CEX(13, 14) CEX(8, 12) CEX(10, 14) CEX(10, 12)
  CEX(9, 13) CEX(11, 15) CEX(11, 13) CEX(9, 10) CEX(11, 12) CEX(13, 14) CEX(0, 8) CEX(4, 12) CEX(4, 8) CEX(2, 10)
  CEX(6, 14) CEX(6, 10) CEX(2, 4) CEX(6, 8) CEX(10, 12) CEX(1, 9) CEX(5, 13) CEX(5, 9) CEX(3, 11) CEX(7, 15) CEX(7, 11)
  CEX(3, 5) CEX(7, 9) CEX(11, 13) CEX(1, 2) CEX(3, 4) CEX(5, 6) CEX(7, 8) CEX(9, 10) CEX(11, 12) CEX(13, 14)
}
DI void merge_top16(unsigned (&t)[16], const unsigned (&u)[16]) {
#pragma unroll
  for (int s = 0; s < 16; ++s) t[s] = max(t[s], u[15 - s]);
#pragma unroll
  for (int d = 8; d > 0; d >>= 1)
#pragma unroll
    for (int i = 0; i < 16; ++i)
      if ((i & d) == 0) {
        const unsigned hi = max(t[i], t[i + d]), lo = min(t[i], t[i + d]);
        t[i] = hi; t[i + d] = lo;
      }
}

DI void ins16(unsigned (&L)[16], unsigned x) {
#pragma unroll
  for (int s = 0; s < 16; ++s) {
    const unsigned hi = max(L[s], x);
    x = min(L[s], x);
    L[s] = hi;
  }
}
DI void merge_halves16(unsigned (&L)[16]) {
  unsigned O[16];
#pragma unroll
  for (int s = 0; s < 16; ++s) O[s] = (unsigned)__shfl_xor((int)L[s], 32);
#pragma unroll
  for (int s = 0; s < 16; ++s) L[s] = max(L[s], O[15 - s]);
#pragma unroll
  for (int d = 8; d > 0; d >>= 1)
#pragma unroll
    for (int i = 0; i < 16; ++i)
      if ((i & d) == 0) {
        const unsigned hi = max(L[i], L[i + d]), lo = min(L[i], L[i + d]);
        L[i] = hi; L[i + d] = lo;
      }
}

DI void peer_top16(const char* ws, const u16* qp, int hp, int tt, int lane, unsigned (&L)[16]) {
  const int r = lane & 31, h = lane >> 5;
  const bf8* sk = (const bf8*)(ws + OFF_SUBK) + (size_t)hp * 4 * 8 * 64 + lane;
  f16v s[4];
#pragma unroll
  for (int mt = 0; mt < 4; ++mt) s[mt] = zero16();
  bf8 qf[8];
#pragma unroll
  for (int ks = 0; ks < 8; ++ks) qf[ks] = *(const bf8*)(qp + (size_t)(32 * tt + r) * 2048 + hp * 128 + 16 * ks + 8 * h);
#pragma unroll
  for (int half = 0; half < 2; ++half) {
    bf8 kf[4][4];
#pragma unroll
    for (int k4 = 0; k4 < 4; ++k4)
#pragma unroll
      for (int mt = 0; mt < 4; ++mt) kf[k4][mt] = sk[(mt * 8 + 4 * half + k4) * 64];
    __builtin_amdgcn_sched_barrier(0);
#pragma unroll
    for (int k4 = 0; k4 < 4; ++k4)
#pragma unroll
      for (int mt = 0; mt < 4; ++mt) s[mt] = MFMA(kf[k4][mt], qf[4 * half + k4], s[mt]);
    __builtin_amdgcn_sched_barrier(0);
  }
  unsigned K1[16], K2[16], K3[16];
#pragma unroll
  for (int i = 0; i < 16; ++i) {
    L[i] = (f2ord(s[0][i]) & ~127u) | (unsigned)(127 - (crow(i, h)));
    K1[i] = (f2ord(s[1][i]) & ~127u) | (unsigned)(127 - (32 + crow(i, h)));
    K2[i] = (f2ord(s[2][i]) & ~127u) | (unsigned)(127 - (64 + crow(i, h)));
    K3[i] = (f2ord(s[3][i]) & ~127u) | (unsigned)(127 - (96 + crow(i, h)));
  }
  sort16_desc(L); sort16_desc(K1); sort16_desc(K2); sort16_desc(K3);
  merge_top16(L, K1);
  merge_top16(K2, K3);
  merge_top16(L, K2);
  merge_halves16(L);
}

DI void peer_select(const char* ws, const u16* qp, uint2* eg, unsigned char* idxs  , int head,
                    int tt, int lane) {
  const int r = lane & 31, h = lane >> 5;
  unsigned La[16], Lb[16];
  peer_top16(ws, qp, 2 * head, tt, lane, La);
  __builtin_amdgcn_sched_barrier(0);
  peer_top16(ws, qp, 2 * head + 1, tt, lane, Lb);
  __builtin_amdgcn_sched_barrier(0);
  if (h == 0) {
#pragma unroll
    for (int g = 0; g < 4; ++g) {
      unsigned wa = 0, wb = 0;
#pragma unroll
      for (int j = 0; j < 4; ++j) {
        wa |= (127u - (La[4 * g + j] & 127u)) << (8 * j);
        wb |= (127u - (Lb[4 * g + j] & 127u)) << (8 * j);
      }
      *(unsigned*)(idxs + r * 32 + 4 * g) = wa;
      *(unsigned*)(idxs + r * 32 + 16 + 4 * g) = wb;
    }
  }
  float fa[16], fb[16];
#pragma unroll
  for (int i = 0; i < 16; ++i) { fa[i] = ord2f(La[i] & ~127u); fb[i] = ord2f(Lb[i] & ~127u); }
  unsigned C[16];
#pragma unroll
  for (int i = 0; i < 16; ++i) C[i] = (f2ord(fa[0] + fb[i]) & ~255u) | (unsigned)(255 - i);
#define PEER_CAND(a, b) ins16(C, (f2ord(fa[a] + fb[b]) & ~255u) | (unsigned)(255 - ((a) * 16 + (b))));
#define PEER_ROW1(a) PEER_CAND(a, 0)
#define PEER_ROW2(a) PEER_ROW1(a) PEER_CAND(a, 1)
#define PEER_ROW3(a) PEER_ROW2(a) PEER_CAND(a, 2)
#define PEER_ROW4(a) PEER_ROW3(a) PEER_CAND(a, 3)
#define PEER_ROW5(a) PEER_ROW4(a) PEER_CAND(a, 4)
#define PEER_ROW8(a) PEER_ROW5(a) PEER_CAND(a, 5) PEER_CAND(a, 6) PEER_CAND(a, 7)
#define PEER_ROW16(a) PEER_ROW8(a) PEER_CAND(a, 8) PEER_CAND(a, 9) PEER_CAND(a, 10) PEER_CAND(a, 11) PEER_CAND(a, 12) PEER_CAND(a, 13) PEER_CAND(a, 14) PEER_CAND(a, 15)
  PEER_ROW8(1) PEER_ROW5(2) PEER_ROW4(3) PEER_ROW3(4) PEER_ROW2(5) PEER_ROW2(6) PEER_ROW2(7)
  PEER_ROW1(8) PEER_ROW1(9) PEER_ROW1(10) PEER_ROW1(11) PEER_ROW1(12) PEER_ROW1(13) PEER_ROW1(14) PEER_ROW1(15)
  asm volatile("s_waitcnt lgkmcnt(0)" ::: "memory");
  const float vmax = ord2f(C[0] & ~255u);
  float ex[16], sum = 0.f;
#pragma unroll
  for (int i = 0; i < 16; ++i) { ex[i] = __expf(ord2f(C[i] & ~255u) - vmax); sum += ex[i]; }
  const float inv = 1.0f / sum;
  const unsigned hmask = 0u - (unsigned)h;
#pragma unroll
  for (int i = 0; i < 8; ++i) {
    const unsigned ck = C[i] ^ ((C[i] ^ C[8 + i]) & hmask);
    const unsigned gb = __float_as_uint(ex[i]) ^ ((__float_as_uint(ex[i]) ^ __float_as_uint(ex[8 + i])) & hmask);
    const float g = __uint_as_float(gb) * inv;
    const unsigned code = 255u - (ck & 255u);
    const unsigned ia = idxs[r * 32 + (code >> 4)], ib = idxs[r * 32 + 16 + (code & 15u)];
    eg[(size_t)(32 * tt + r) * 128 + head * 16 + 8 * h + i] = make_uint2(ia * 128u + ib, __float_as_uint(g));
  }
  asm volatile("s_waitcnt lgkmcnt(0)" ::: "memory");
}

DI float wave_sum(float v) {
#pragma unroll
  for (int o = 32; o > 0; o >>= 1) v += __shfl_xor(v, o);
  return v;
}

DI void reduce8(const int (&pv)[8], int& s0, int& s1) {
  int q[4], s[2];
#pragma unroll
  for (int m = 0; m < 4; ++m) {
    const auto r = __builtin_amdgcn_permlane32_swap((unsigned)pv[m], (unsigned)pv[m + 4], false, false);
    q[m] = (int)(r[0] + r[1]);
  }
#pragma unroll
  for (int m = 0; m < 2; ++m) {
    const auto r = __builtin_amdgcn_permlane16_swap((unsigned)q[m], (unsigned)q[m + 2], false, false);
    s[m] = (int)(r[0] + r[1]);
  }
#pragma unroll
  for (int m = 0; m < 2; ++m) {
    s[m] += __builtin_amdgcn_update_dpp(0, s[m], 0x128, 0xf, 0xf, false);
    s[m] += __builtin_amdgcn_update_dpp(0, s[m], 0x124, 0xf, 0xf, false);
    s[m] += __builtin_amdgcn_update_dpp(0, s[m], 0x122, 0xf, 0xf, false);
    s[m] += __builtin_amdgcn_update_dpp(0, s[m], 0x121, 0xf, 0xf, false);
  }
  s0 = s[0]; s1 = s[1];
}

DI void peer_quant_x(char* ldsA, int wave, int lane, float (&xdq)[8]) {
#pragma unroll
  for (int i = 0; i < 8; ++i) {
    char* xrow = ldsA + (8 * wave + i) * LDS_ROW;
    const uint4 x0 = *(const uint4*)(xrow + 32 * lane), x1 = *(const uint4*)(xrow + 32 * lane + 16);
    const unsigned xr[8] = {x0.x, x0.y, x0.z, x0.w, x1.x, x1.y, x1.z, x1.w};
    float f[16];
    float am = 0.f;
#pragma unroll
    for (int q = 0; q < 8; ++q) {
      f[2 * q] = __uint_as_float(xr[q] << 16);
      f[2 * q + 1] = __uint_as_float(xr[q] & 0xffff0000u);
      am = fmaxf(am, fmaxf(fabsf(f[2 * q]), fabsf(f[2 * q + 1])));
    }
#pragma unroll
    for (int o = 32; o > 0; o >>= 1) am = fmaxf(am, __shfl_xor(am, o));
    const float sc = (am > 0.f) ? 127.0f / am : 0.f;
    unsigned w[4];
#pragma unroll
    for (int q = 0; q < 4; ++q) {
      unsigned pk = 0;
#pragma unroll
      for (int j = 0; j < 4; ++j) pk |= ((unsigned)((int)rintf(f[4 * q + j] * sc)) & 0xffu) << (8 * j);
      w[q] = pk;
    }
    asm volatile("s_waitcnt lgkmcnt(0)" ::: "memory");
    *(uint4*)(xrow + 16 * lane) = make_uint4(w[0], w[1], w[2], w[3]);
    xdq[i] = am * (1.0f / 127.0f);
  }
  asm volatile("s_waitcnt lgkmcnt(0)" ::: "memory");
}

DI void peer_bucket_token(const uint2* egt, unsigned* tmp  , int lane, unsigned& E0, unsigned& E1,
                          unsigned& G0, unsigned& G1) {
  const uint2 a = egt[lane], b = egt[64 + lane];
  const int ba = (int)(a.x >> SWEEP_SH), bb = (int)(b.x >> SWEEP_SH);
  const unsigned long long lt = (1ull << lane) - 1ull;
  int da = 0, db = 0, start = 0;
#pragma unroll
  for (int k = 0; k < SWEEP_NB; ++k) {
    const unsigned long long ma = __ballot(ba == k), mb = __ballot(bb == k);
    const int ca = __popcll(ma), cb = __popcll(mb);
    if (ba == k) da = start + __popcll(ma & lt);
    if (bb == k) db = start + ca + __popcll(mb & lt);
    start += ca + cb;
  }
  const int ia = (da & 1) * 64 + (da >> 3) + 16 * ((da >> 1) & 3);
  const int ib = (db & 1) * 64 + (db >> 3) + 16 * ((db >> 1) & 3);
  tmp[ia] = a.x; tmp[128 + ia] = a.y;
  tmp[ib] = b.x; tmp[128 + ib] = b.y;
  asm volatile("s_waitcnt lgkmcnt(0)" ::: "memory");
  E0 = tmp[lane]; E1 = tmp[64 + lane]; G0 = tmp[128 + lane]; G1 = tmp[192 + lane];
  asm volatile("s_waitcnt lgkmcnt(0)" ::: "memory");
}

template <bool GWRITE = true>
DI void peer_finalize_token(const MKParams& p, float (&acc)[16], size_t tok, int lane) {
  float* orow = p.out + tok * DM + 16 * lane;
  float ss = 0.f;
#pragma unroll
  for (int q = 0; q < 4; ++q) {
    const f4v hv = *(const f4v*)(orow + 4 * q);
#pragma unroll
    for (int j = 0; j < 4; ++j) { acc[4 * q + j] += hv[j]; ss += acc[4 * q + j] * acc[4 * q + j]; }
  }
  ss = wave_sum(ss);
  const float rf = rsqrtf(ss * (1.0f / DM) + EPSV);
#pragma unroll
  for (int q = 0; q < 4; ++q) {
    const f4v gg = *(const f4v*)(p.g_fin + 16 * lane + 4 * q);
    f4v o = {acc[4 * q] * rf * gg[0], acc[4 * q + 1] * rf * gg[1], acc[4 * q + 2] * rf * gg[2], acc[4 * q + 3] * rf * gg[3]};
    if (GWRITE || o[0] == 123.456f) *(f4v*)(orow + 4 * q) = o;
  }
}

DI void peer_usweep(const char* ws, const char* ldsA, int wave, int lane, const unsigned (&E)[8][2], int (&A)[8][2]) {
  const char* PU = ws + OFF_PU + 16 * lane;
#pragma unroll
  for (int i = 0; i < 8; ++i) { A[i][0] = 0; A[i][1] = 0; }
  int jn[8];
#pragma unroll
  for (int i = 0; i < 8; ++i) jn[i] = 0;
#pragma unroll 1
  for (int k = 0; k < SWEEP_NB; ++k) {
#pragma unroll
    for (int i = 0; i < 8; ++i) {
      while (jn[i] < 16 && (__builtin_amdgcn_readlane((int)E[i][0], jn[i]) >> SWEEP_SH) <= k) {
        const int j = jn[i];
        const bool sel = ((lane & 15) == j);
        const uint4 xq = *(const uint4*)(ldsA + (8 * wave + i) * LDS_ROW + 16 * lane);
        uint4 u0[8];
#pragma unroll
        for (int m = 0; m < 8; ++m) {
          const int e = __builtin_amdgcn_readlane((int)E[i][m & 1], j + 16 * (m >> 1));
          u0[m] = *(const uint4*)(PU + (size_t)e * 1024);
        }
        int pv[8];
#pragma unroll
        for (int m = 0; m < 8; ++m) {
          int dsum = __builtin_amdgcn_sdot4((int)u0[m].x, (int)xq.x, 0, false);
          dsum = __builtin_amdgcn_sdot4((int)u0[m].y, (int)xq.y, dsum, false);
          dsum = __builtin_amdgcn_sdot4((int)u0[m].z, (int)xq.z, dsum, false);
          dsum = __builtin_amdgcn_sdot4((int)u0[m].w, (int)xq.w, dsum, false);
          pv[m] = dsum;
        }
        int s0, s1;
        reduce8(pv, s0, s1);
        A[i][0] = sel ? s0 : A[i][0];
        A[i][1] = sel ? s1 : A[i][1];
        jn[i] = j + 1;
      }
    }
  }
}

#ifndef VT
#define VT 8
#endif
template <int T0, bool GWRITE = true>
DI void peer_vsweep(const MKParams& p, int wave, int lane, size_t tok0, const unsigned (&E)[8][2], const unsigned (&WQ)[8],
                    const float (&tsc)[8]) {
  const char* PV = p.ws + OFF_PV + 16 * lane;
  int acc[VT][16];
#pragma unroll
  for (int i = 0; i < VT; ++i)
#pragma unroll
    for (int q = 0; q < 16; ++q) acc[i][q] = 0;
  int jn[VT];
#pragma unroll
  for (int i = 0; i < VT; ++i) jn[i] = 0;
#pragma unroll 1
  for (int k = 0; k < SWEEP_NB; ++k) {
#pragma unroll
    for (int i = 0; i < VT; ++i) {
      while (jn[i] < 16 && (__builtin_amdgcn_readlane((int)E[T0 + i][0], jn[i]) >> SWEEP_SH) <= k) {
        const int j = jn[i];
        uint4 v0[8];
#pragma unroll
        for (int m = 0; m < 8; ++m) {
          const int e = __builtin_amdgcn_readlane((int)E[T0 + i][m & 1], j + 16 * (m >> 1));
          v0[m] = *(const uint4*)(PV + (size_t)e * 1024);
        }
        const int wq0 = __builtin_amdgcn_readlane((int)WQ[T0 + i], j);
        const int wq1 = __builtin_amdgcn_readlane((int)WQ[T0 + i], j + 32);
#pragma unroll
        for (int rq = 0; rq < 2; ++rq) {
          const int wq = rq ? wq1 : wq0;
          const unsigned r0[4] = {v0[4 * rq].x, v0[4 * rq].y, v0[4 * rq].z, v0[4 * rq].w};
          const unsigned r1[4] = {v0[4 * rq + 1].x, v0[4 * rq + 1].y, v0[4 * rq + 1].z, v0[4 * rq + 1].w};
          const unsigned r2[4] = {v0[4 * rq + 2].x, v0[4 * rq + 2].y, v0[4 * rq + 2].z, v0[4 * rq + 2].w};
          const unsigned r3[4] = {v0[4 * rq + 3].x, v0[4 * rq + 3].y, v0[4 * rq + 3].z, v0[4 * rq + 3].w};
#pragma unroll
          for (int q = 0; q < 4; ++q) {
            const unsigned ta = __builtin_amdgcn_perm(r1[q], r0[q], 0x05010400);
            const unsigned tb = __builtin_amdgcn_perm(r1[q], r0[q], 0x07030602);
            const unsigned tc = __builtin_amdgcn_perm(r3[q], r2[q], 0x05010400);
            const unsigned td = __builtin_amdgcn_perm(r3[q], r2[q], 0x07030602);
            acc[i][4 * q] = __builtin_amdgcn_sdot4((int)__builtin_amdgcn_perm(tc, ta, 0x05040100), wq, acc[i][4 * q], false);
            acc[i][4 * q + 1] = __builtin_amdgcn_sdot4((int)__builtin_amdgcn_perm(tc, ta, 0x07060302), wq, acc[i][4 * q + 1], false);
            acc[i][4 * q + 2] = __builtin_amdgcn_sdot4((int)__builtin_amdgcn_perm(td, tb, 0x05040100), wq, acc[i][4 * q + 2], false);
            acc[i][4 * q + 3] = __builtin_amdgcn_sdot4((int)__builtin_amdgcn_perm(td, tb, 0x07060302), wq, acc[i][4 * q + 3], false);
          }
        }
        jn[i] = j + 1;
      }
    }
  }
#pragma unroll
  for (int i = 0; i < VT; ++i) {
    float accf[16];
#pragma unroll
    for (int q = 0; q < 16; ++q) accf[q] = (float)acc[i][q] * tsc[T0 + i];
    peer_finalize_token<GWRITE>(p, accf, tok0 + 8 * wave + T0 + i, lane);
  }
}

DI void phase_d_tile(const MKParams& p, int tile, int wave, int lane, float rs0, float rs1, Ring& rg) {
  asm volatile("" : "+v"(lane));
  char* ws = p.ws;
  char* ldsA = smem;
  float* rs_s = (float*)(smem + LDS_A_BYTES);
  unsigned char* idxs = (unsigned char*)(smem + LDS_A_BYTES + 4096) + wave * 1024;
  u16* qp = (u16*)qp_scratch(ws, blockIdx.x);
  uint2* eg = (uint2*)(ws + OFF_EG + (size_t)blockIdx.x * 65536);
  const size_t tok0 = (size_t)tile * 64;
  if (wave == 0) { if (lane < 32) rs_s[lane] = rs0; else rs_s[lane] = rs1; }
  {
    f16v acc[2][2];
    const bf8* wf = (const bf8*)(ws + OFF_WPQ);
#if PROBE == 17
    for (int rep_ = 0; rep_ < 2; ++rep_)
#endif
#pragma unroll 1
    for (int c = 0; c < 4; ++c) {
      int l2 = lane;
      asm volatile("" : "+v"(l2));
      const int r = l2 & 31, h = l2 >> 5;
      if (c == 0) gemm_chunk_r<true, false, false, true>(ldsA, wf + 2 * wave * 64, wf + 65536 + 2 * wave * 64, l2, acc, rg);
      else if (c < 3) gemm_chunk_r<true, false, false, true>(ldsA, wf + (size_t)c * 65536 + 2 * wave * 64, wf + (size_t)(c + 1) * 65536 + 2 * wave * 64, l2, acc, rg);
      else gemm_chunk_r<true, false, false, false>(ldsA, wf + (size_t)c * 65536 + 2 * wave * 64, nullptr, l2, acc, rg);
#pragma unroll
      for (int ntl = 0; ntl < 2; ++ntl)
#pragma unroll
        for (int tt = 0; tt < 2; ++tt)
#pragma unroll
          for (int g = 0; g < 4; ++g) {
            const float sc = tt ? rs1 : rs0;
            f4v v = {acc[ntl][tt][4 * g] * sc, acc[ntl][tt][4 * g + 1] * sc, acc[ntl][tt][4 * g + 2] * sc, acc[ntl][tt][4 * g + 3] * sc};
            *(bf4*)(qp + (size_t)(32 * tt + r) * 2048 + 512 * c + 64 * wave + 32 * ntl + 8 * g + 4 * h) = cvt4(v);
          }
    }
  }
  __syncthreads();
#if PROBE == 16
  for (int rep_ = 0; rep_ < 2; ++rep_)
#endif
#pragma unroll 1
  for (int tt = 0; tt < 2; ++tt) {
    int l2 = lane;
    asm volatile("" : "+v"(l2));
    peer_select(ws, qp, eg, idxs, wave, tt, l2);
  }
  __syncthreads();
}

template <bool GWRITE = true>
DI void phase_d_gather(const MKParams& p, int tile, int wave, int lane) {
  asm volatile("" : "+v"(lane));
  char* ws = p.ws;
  char* ldsA = smem;
  float* rs_s = (float*)(smem + LDS_A_BYTES);
  unsigned char* idxs = (unsigned char*)(smem + LDS_A_BYTES + 4096) + wave * 1024;
  const uint2* eg = (const uint2*)(ws + OFF_EG + (size_t)blockIdx.x * 65536);
  const size_t tok0 = (size_t)tile * 64;
  {
    int l2 = lane;
    asm volatile("" : "+v"(l2));
    unsigned E[8][2], G[8][2];
#pragma unroll
    for (int i = 0; i < 8; ++i)
      peer_bucket_token(eg + (size_t)(8 * wave + i) * 128, (unsigned*)idxs, l2, E[i][0], E[i][1], G[i][0], G[i][1]);
    float xdq[8];
    peer_quant_x(ldsA, wave, l2, xdq);
    int A[8][2];
#if PROBE == 60
    peer_usweep(ws, ldsA, wave, l2, E, A);
    asm volatile("" :: "v"(A[0][0]), "v"(A[0][1]), "v"(A[1][0]), "v"(A[1][1]), "v"(A[2][0]), "v"(A[2][1]), "v"(A[3][0]), "v"(A[3][1]), "v"(A[4][0]), "v"(A[4][1]), "v"(A[5][0]), "v"(A[5][1]), "v"(A[6][0]), "v"(A[6][1]), "v"(A[7][0]), "v"(A[7][1]));
#endif
    peer_usweep(ws, ldsA, wave, l2, E, A);
    unsigned WQ[8];
    float tsc[8];
#pragma unroll
    for (int i = 0; i < 8; ++i) {
      const float rs = rs_s[8 * wave + i];
      float w[2];
#pragma unroll
      for (int cc = 0; cc < 2; ++cc) {
        const float a = (float)A[i][cc] * (rs * xdq[i]) * ((const float*)(ws + OFF_SU))[E[i][cc]];
        w[cc] = __uint_as_float(G[i][cc]) * 0.5f * a * (1.0f + erff(a * 0.70710678118654752f)) *
                ((const float*)(ws + OFF_SV))[E[i][cc]];
      }
      float wm = fmaxf(fabsf(w[0]), fabsf(w[1]));
#pragma unroll
      for (int o = 32; o > 0; o >>= 1) wm = fmaxf(wm, __shfl_xor(wm, o));
      const float sc = (wm > 0.f) ? 127.0f / wm : 0.f;
      tsc[i] = wm * (1.0f / 127.0f);
      const unsigned pr = ((unsigned)((int)rintf(w[0] * sc)) & 0xffu) | (((unsigned)((int)rintf(w[1] * sc)) & 0xffu) << 8);
      const unsigned up = (unsigned)__shfl((int)pr, (l2 + 16) & 63);
      WQ[i] = pr | (up << 16);
    }
    __builtin_amdgcn_sched_barrier(0);
    peer_vsweep<0, GWRITE>(p, wave, l2, tok0, E, WQ, tsc);
#if VT == 4
    __builtin_amdgcn_sched_barrier(0);
    peer_vsweep<4, GWRITE>(p, wave, l2, tok0, E, WQ, tsc);
#endif
  }
}
#ifndef REMAP
#define REMAP 1
#endif
DI int tile_of(int blk, int nblk) { return (REMAP && nblk == 256) ? ((blk & 7) * 32 + (blk >> 3)) : blk; }

__global__ __launch_bounds__(512) void mk(MKParams p) {
  cg::grid_group grid = cg::this_grid();
  const int tid = threadIdx.x;
  const int wave = __builtin_amdgcn_readfirstlane(tid >> 6), lane = tid & 63;
  const int gtid = blockIdx.x * 512 + tid, gthreads = gridDim.x * 512;
  const int gw = blockIdx.x * 8 + wave, nw = gridDim.x * 8;
  unsigned* bar = (unsigned*)(p.ws + OFF_BAR);
  phase_prep(p, gtid, gthreads);
  if (blockIdx.x < 256) load_norm_tile(p.x + (size_t)tile_of(blockIdx.x, gridDim.x) * 64 * DM, smem, wave, lane);
#if FIRST_CG == 1
  if (blockIdx.x == 0 && tid < 16) __hip_atomic_store(bar + tid, 0u, __ATOMIC_RELAXED, __HIP_MEMORY_SCOPE_AGENT);
  grid.sync();
#elif FIRST_CG == 2
  if (p.ws == nullptr) grid.sync();
  grid_barrier(bar, 1u * gridDim.x);
#else
  grid_barrier(bar, 1u * gridDim.x);
#endif
  if (blockIdx.x < 256) { phase_a_tile<true, (TABLES_IN_B == 3)>(p, tile_of(blockIdx.x, gridDim.x), wave, lane); __syncthreads(); gla_g1_tile(p, tile_of(blockIdx.x, gridDim.x), wave, lane); }
  for (int tile = blockIdx.x + gridDim.x; tile < 256; tile += gridDim.x) { phase_a_tile<false, false>(p, tile_of(tile, gridDim.x), wave, lane); __syncthreads(); gla_g1_tile(p, tile_of(tile, gridDim.x), wave, lane); }
#if PROBE == 40
  for (int tile = blockIdx.x; tile < 256; tile += gridDim.x) { phase_a_tile<false, false>(p, tile_of(tile, gridDim.x), wave, lane); __syncthreads(); gla_g1_tile(p, tile_of(tile, gridDim.x), wave, lane); }
#endif
  grid_barrier(bar, (2u - (FIRST_CG == 1)) * gridDim.x);
  {
    const bool kvblk = (gridDim.x == 256) && blockIdx.x >= 64 && blockIdx.x < 192;
    const bool conv_first = CLASS_ORDER && (gridDim.x == 256) && !kvblk;
    if (conv_first) phase_prep_tables_bal(p, blockIdx.x, gridDim.x, wave, lane);
    for (int it = gw; it < 4096; it += nw) sb_item(p, it, lane);
    for (int item = (int)((blockIdx.x + gridDim.x - 64u) % gridDim.x); item < 128; item += gridDim.x) phase_a_memkv(p, item, wave, lane);
    gla_g2(p, gtid, gthreads);
    if (!conv_first) phase_prep_tables_bal(p, blockIdx.x, gridDim.x, wave, lane);
    phase_prep_late(p, gtid, gthreads);
  }
  grid_barrier(bar, (3u - (FIRST_CG == 1)) * gridDim.x);
#if PROBE == 70
  grid_barrier(bar, 3u * gridDim.x); grid_barrier(bar, 4u * gridDim.x); grid_barrier(bar, 5u * gridDim.x); grid_barrier(bar, 6u * gridDim.x);
#endif
  for (int t0 = blockIdx.x; t0 < 256; t0 += gridDim.x) {
    const int tile = tile_of(t0, gridDim.x);
    float rs0, rs1;
    Ring rg;
#if PROBE == 41
    phase_c_tile(p, tile, wave, lane, rs0, rs1, rg);
#endif
    phase_c_tile(p, tile, wave, lane, rs0, rs1, rg);
#if PROBE == 42
    phase_d_tile(p, tile, wave, lane, rs0, rs1, rg);
#endif
    phase_d_tile(p, tile, wave, lane, rs0, rs1, rg);
#if GATHER_ALIGN
    grid_barrier(bar, (4u - (FIRST_CG == 1)) * gridDim.x);
#endif
#if PROBE == 43
    phase_d_gather<false>(p, tile, wave, lane);
#endif
    phase_d_gather<true>(p, tile, wave, lane);
  }
#if FIRST_CG == 0
  grid.sync();
#endif
}
#define MK_LDS (160 * 1024)
extern "C" void kernel_launch(void* const* d_in, const int* in_sizes, int n_in, void* d_out, int out_size, void* d_ws,
                              size_t ws_size, hipStream_t stream) {
  MKParams p{};
  p.x = (const float*)d_in[0]; p.mem = (const float*)d_in[1]; p.g_mix = (const float*)d_in[2];
  p.w_in = (const float*)d_in[3]; p.w_up = (const float*)d_in[4]; p.b_alpha = (const float*)d_in[5];
  p.g_gla = (const float*)d_in[6]; p.w_out = (const float*)d_in[7]; p.g_mq = (const float*)d_in[8];
  p.g_mkv = (const float*)d_in[9]; p.w_mq = (const float*)d_in[10]; p.w_mkv = (const float*)d_in[11];
  p.w_mo = (const float*)d_in[12]; p.g_ffn = (const float*)d_in[13]; p.w_pq = (const float*)d_in[14];
  p.subk = (const float*)d_in[15]; p.pu = (const float*)d_in[16]; p.pv = (const float*)d_in[17];
  p.g_fin = (const float*)d_in[18];
  p.out = (float*)d_out; p.ws = (char*)d_ws;
  float* out = (float*)d_out;
  char* wsb = (char*)d_ws;
  float* ws = (float*)d_ws;
  static int grid_blocks = 0;
  if (!grid_blocks) {
    int dev = 0, cus = 0, per_cu = 0;
    (void)hipGetDevice(&dev);
    (void)hipDeviceGetAttribute(&cus, hipDeviceAttributeMultiprocessorCount, dev);
    (void)hipFuncSetAttribute((const void*)mk, hipFuncAttributeMaxDynamicSharedMemorySize, MK_LDS);
    (void)hipOccupancyMaxActiveBlocksPerMultiprocessor(&per_cu, mk, 512, MK_LDS);
    grid_blocks = cus * per_cu;
    fprintf(stderr, "mk: cus=%d per_cu=%d grid=%d ws=%zu\n", cus, per_cu, grid_blocks, ws_size);
  }
#if FIRST_CG != 1
  (void)hipMemsetAsync((char*)d_ws + OFF_BAR, 0, 64, stream);
#endif
  {
    void* args[] = {(void*)&p};
    hipError_t e = hipLaunchCooperativeKernel((const void*)mk, dim3(grid_blocks), dim3(512), args, MK_LDS, stream);
    if (e != hipSuccess) fprintf(stderr, "coop launch failed: %s grid %d\n", hipGetErrorString(e), grid_blocks);
  }
}
```

```cpp
#ifndef GEMM_D
#define GEMM_D 8
#endif
#ifndef TABLES_IN_B
#define TABLES_IN_B 4
#endif
#ifndef REMAP
#define REMAP 0
#endif
#ifndef FIRST_CG
#define FIRST_CG 1
#endif
#ifndef GATHER_ALIGN
#define GATHER_ALIGN 0
#endif
#ifndef LATE_PREP
#define LATE_PREP 1
#endif
#ifndef B_ORDER
#define B_ORDER 0
#endif
#ifndef SWEEP_NB
#define SWEEP_NB 16
#define SWEEP_SH 10
#endif
#ifndef CLASS_ORDER
#define CLASS_ORDER 0
#endif
#ifndef STAGGER_B
#define STAGGER_B 0
#endif
#ifndef PROBE
#define PROBE 0
#endif
#ifndef W8
#define W8 1
#endif
#ifndef GEMM_D2
#define GEMM_D2 8
#endif
#ifndef ATTN_LOCKSTEP
#define ATTN_LOCKSTEP 0
#endif
#ifndef L2_TOUCH
#define L2_TOUCH 0
#endif
#include <hip/hip_runtime.h>
#include <hip/hip_cooperative_groups.h>
#include <math.h>
#include <stdio.h>
#include <stdint.h>
namespace cg = cooperative_groups;

#ifndef PROBE
#define PROBE 0
#endif
#ifndef TABLES_IN_B
#define TABLES_IN_B 1
#endif
#define NB 8
#define SEQ 2048
#define DM 1024
#define NTOK (NB * SEQ)
#define INC 3088
#define MEML 256
#define EPSV 1e-6f

typedef __attribute__((ext_vector_type(8))) __bf16 bf8;
typedef __attribute__((ext_vector_type(4))) __bf16 bf4;
typedef __attribute__((ext_vector_type(2))) __bf16 bf2;
typedef __attribute__((ext_vector_type(16))) float f16v;
typedef __attribute__((ext_vector_type(8))) float f8v;
typedef __attribute__((ext_vector_type(4))) float f4v;
typedef __attribute__((ext_vector_type(2))) float f2v;
typedef unsigned short u16;

#define DI __device__ __forceinline__
#ifndef USE_NT
#define USE_NT 1
#endif
#if USE_NT
#define NT_LOAD(p) __builtin_nontemporal_load(p)
#else
#define NT_LOAD(p) (*(p))
#endif
#define MFMA(a, b, c) __builtin_amdgcn_mfma_f32_32x32x16_bf16((a), (b), (c), 0, 0, 0)

DI int crow(int i, int h) { return (i & 3) + 8 * (i >> 2) + 4 * h; }
DI int tpos(int t) { return (t & ~12) | ((t & 4) << 1) | ((t & 8) >> 1); }
DI float bf2f(u16 v) { return __uint_as_float(((unsigned)v) << 16); }
DI bf8 cvt8(f8v v) { return __builtin_convertvector(v, bf8); }
DI bf4 cvt4(f4v v) { return __builtin_convertvector(v, bf4); }
DI f16v zero16() { f16v z = {0.f, 0.f, 0.f, 0.f, 0.f, 0.f, 0.f, 0.f, 0.f, 0.f, 0.f, 0.f, 0.f, 0.f, 0.f, 0.f}; return z; }

#define MiB ((size_t)1 << 20)
#define OFF_WIN   ((size_t)0)
#define OFF_WOUT  (OFF_WIN + 97 * 65536)
#define OFF_WMQ   (OFF_WOUT + 32 * 65536)
#define OFF_WMKV  (OFF_WMQ + 32 * 65536)
#define OFF_WMO   (OFF_WMKV + 64 * 65536)
#define OFF_WPQ   (OFF_WMO + 32 * 65536)
#define OFF_SUBK  (OFF_WPQ + 64 * 65536)
#define OFF_ACT   (21 * MiB)
#define OFF_GQ    (OFF_ACT)
#define OFF_GK    (OFF_GQ + 8 * MiB)
#define OFF_GVT   (OFF_GK + 8 * MiB)
#define OFF_OG    (OFF_GVT + 16 * MiB)
#define OFF_SQ    (OFF_OG + 16 * MiB)
#define OFF_SK    (OFF_SQ + 16 * MiB)
#define OFF_SVT   (OFF_SK + 16 * MiB)
#define OFF_LA    (OFF_SVT + 16 * MiB)
#define OFF_LKV   (OFF_LA + 16 * MiB)
#define OFF_DD    (OFF_LKV + 32 * MiB)
#define OFF_OSB   (OFF_DD + 1 * MiB)
#define OFF_KM    (OFF_OSB + 16 * MiB)
#define OFF_VMT   (OFF_KM + 4 * MiB)
#define OFF_PU    (OFF_VMT + 4 * MiB)
#define OFF_PV    (OFF_PU + 16 * MiB)
#define OFF_SU    (OFF_PV + 16 * MiB)
#define OFF_SV    (OFF_SU + 65536)
#define OFF_GQ2   (224 * MiB)
#define OFF_GK2   (232 * MiB)
#define OFF_SS    (OFF_LA)

#define LDS_ROW 2064
#define LDS_A_BYTES (64 * LDS_ROW)

DI char* qp_scratch(char* ws, int blk) {
  return blk < 192 ? ws + OFF_SQ + (size_t)blk * 262144 : ws + OFF_LKV + (size_t)(blk - 192) * 262144;
}

#define OFF_CS  (OFF_DD + 512 * 1024)
#define OFF_ICS (OFF_CS + 128 * 1024)
#define OFF_BAR (OFF_DD + 768 * 1024)
DI void grid_barrier(unsigned* ctr, unsigned target) {
  __syncthreads();
  if (threadIdx.x == 0) {
    __builtin_amdgcn_fence(__ATOMIC_RELEASE, "agent");
    asm volatile("s_waitcnt vmcnt(0)" ::: "memory");
    __hip_atomic_fetch_add(ctr, 1u, __ATOMIC_RELAXED, __HIP_MEMORY_SCOPE_AGENT);
    while (__hip_atomic_load(ctr, __ATOMIC_RELAXED, __HIP_MEMORY_SCOPE_AGENT) < target) __builtin_amdgcn_s_sleep(1);
    __builtin_amdgcn_fence(__ATOMIC_ACQUIRE, "agent");
    asm volatile("s_waitcnt vmcnt(0)" ::: "memory");
  }
  __syncthreads();
}

struct MKParams {
  const float *x, *mem, *g_mix, *w_in, *w_up, *b_alpha, *g_gla, *w_out, *g_mq, *g_mkv, *w_mq, *w_mkv, *w_mo, *g_ffn, *w_pq,
      *subk, *pu, *pv, *g_fin;
  float* out;
  char* ws;
};
extern __shared__ __attribute__((aligned(16))) char smem[];

template <typename ColFn>
DI void prep_w(bf8* dst, const float* __restrict__ W, int ldw, int ntiles, const float* __restrict__ gain, ColFn colfn,
               int gtid, int gthreads) {
  const int total = ntiles * 4096;
#pragma unroll 1
  for (int u0 = gtid; u0 < total; u0 += 4 * gthreads) {
    f8v v[4];
    int didx[4];
#pragma unroll
    for (int t = 0; t < 4; ++t) {
      const int u = u0 + t * gthreads;
      didx[t] = -1;
      if (u < total) {
        const int lane = u & 63, ks = (u >> 6) & 63, nt = u >> 12;
        const int r = lane & 31, h = lane >> 5;
        float sc = 1.f;
        const int col = colfn(32 * nt + r, sc);
#pragma unroll
        for (int j = 0; j < 8; ++j) {
          const int k = 16 * ks + 8 * h + j;
          float val = 0.f;
          if (col >= 0) val = NT_LOAD(W + (size_t)k * ldw + col) * sc * (gain ? gain[k] : 1.f);
          v[t][j] = val;
        }
        didx[t] = (nt < (ntiles & ~15)) ? ((((nt >> 4) * 64 + ks) * 16 + (nt & 15)) * 64 + lane) : u;
      }
    }
#pragma unroll
    for (int t = 0; t < 4; ++t)
      if (didx[t] >= 0) dst[didx[t]] = cvt8(v[t]);
  }
}

template <typename ColFn>
DI void prep_w8_item(char* dst, float* cs, float* ics, const float* __restrict__ W, int ldw, const float* __restrict__ gain,
                     ColFn colfn, int grp, float* smax, int tid) {
  const int c = tid & 31, g = tid >> 5;
  const int n = grp * 32 + c;
  float sc = 1.f;
  const int col = colfn(n, sc);
  float w[64];
  float am = 0.f;
  const float* q = W + (size_t)(64 * g) * ldw + col;
#pragma unroll
  for (int j = 0; j < 64; ++j) {
    w[j] = NT_LOAD(q);
    q += ldw;
    asm volatile("" : "+v"(q));
  }
#pragma unroll
  for (int j = 0; j < 64; ++j) {
    w[j] *= sc * (gain ? gain[64 * g + j] : 1.f);
    am = fmaxf(am, fabsf(w[j]));
  }
  __syncthreads();
  if (tid < 32) ((unsigned*)smax)[tid] = 0u;
  __syncthreads();
  atomicMax((unsigned*)smax + c, __float_as_uint(am));
  __syncthreads();
  const float cm = smax[c];
  const float qs = (cm > 0.f) ? 127.0f / cm : 0.f;
  const int nt = n >> 5;
#pragma unroll
  for (int kp2 = 0; kp2 < 2; ++kp2)
#pragma unroll
    for (int h = 0; h < 2; ++h) {
      unsigned q[4];
#pragma unroll
      for (int d = 0; d < 4; ++d) {
        const int kb = 32 * kp2 + (d >> 1) * 16 + 8 * h + 4 * (d & 1);
        unsigned pk = 0;
#pragma unroll
        for (int j = 0; j < 4; ++j) pk |= ((unsigned)((int)rintf(w[kb + j] * qs)) & 0xffu) << (8 * j);
        q[d] = pk;
      }
      const int kp = 2 * g + kp2;
      const size_t unit = (size_t)(((nt >> 4) * 32 + kp) * 16 + (nt & 15)) * 64 + c + 32 * h;
      *(uint4*)(dst + unit * 16) = make_uint4(q[0], q[1], q[2], q[3]);
    }
  if (g == 0) { cs[n] = (cm > 0.f) ? cm * (1.0f / 127.0f) : 1.f; ics[n] = (cm > 0.f) ? 127.0f / cm : 1.f; }
}

DI void phase_prep(const MKParams& p, int gtid, int gthreads) {
  char* ws = p.ws;
  prep_w((bf8*)(ws + OFF_WIN), p.w_in, INC, 97, p.g_mix,
         [](int n, float& sc) -> int {
           if (n < 256) { sc = 0.125f; return n; }
           if (n < 1536) return n;
           if (n < 2048) { sc = 0.125f; return n + 16; }
           if (n < 3072) return n + 16;
           if (n < 3088) return n - 1536;
           return -1;
         }, gtid, gthreads);
  prep_w((bf8*)(ws + OFF_WMKV), p.w_mkv, 2048, 64, p.g_mkv, [](int n, float& sc) -> int { return n; }, gtid, gthreads);
}
DI void phase_prep_late(const MKParams& p, int gtid, int gthreads) {
  char* ws = p.ws;
#if W8
  {
    float* smax = (float*)(smem + LDS_A_BYTES);
    float* cs = (float*)(ws + OFF_CS);
    float* ics = (float*)(ws + OFF_ICS);
    const int tid = threadIdx.x;
    for (int item = blockIdx.x; item < 160; item += gridDim.x) {
      if (item < 32) prep_w8_item(ws + OFF_WOUT, cs + 4096, ics + 4096, p.w_out, 1024, nullptr, [](int n, float& sc) -> int { return n; }, item, smax, tid);
      else if (item < 64) prep_w8_item(ws + OFF_WMQ, cs + 8192, ics + 8192, p.w_mq, 1024, p.g_mq, [](int n, float& sc) -> int { sc = 0.0625f; return n; }, item - 32, smax, tid);
      else if (item < 96) prep_w8_item(ws + OFF_WMO, cs + 12288, ics + 12288, p.w_mo, 1024, nullptr, [](int n, float& sc) -> int { return n; }, item - 64, smax, tid);
      else prep_w8_item(ws + OFF_WPQ, cs + 16384, ics + 16384, p.w_pq, 2048, p.g_ffn, [](int n, float& sc) -> int { return n; }, item - 96, smax, tid);
    }
  }
#else
  prep_w((bf8*)(ws + OFF_WOUT), p.w_out, 1024, 32, nullptr, [](int n, float& sc) -> int { return n; }, gtid, gthreads);
  prep_w((bf8*)(ws + OFF_WMQ), p.w_mq, 1024, 32, p.g_mq, [](int n, float& sc) -> int { sc = 0.0625f; return n; }, gtid, gthreads);
  prep_w((bf8*)(ws + OFF_WMO), p.w_mo, 1024, 32, nullptr, [](int n, float& sc) -> int { return n; }, gtid, gthreads);
  prep_w((bf8*)(ws + OFF_WPQ), p.w_pq, 2048, 64, p.g_ffn, [](int n, float& sc) -> int { return n; }, gtid, gthreads);
#endif
  {
    bf8* dst = (bf8*)(ws + OFF_SUBK);
    const int total = 16 * 4 * 8 * 64;
    for (int u = gtid; u < total; u += gthreads) {
      const int lane = u & 63, ks = (u >> 6) & 7, mt = (u >> 9) & 3, hp = u >> 11;
      const int r = lane & 31, h = lane >> 5;
      const float* s = p.subk + ((size_t)(hp * 128 + 32 * mt + r)) * 128 + 16 * ks + 8 * h;
      const f4v a = *(const f4v*)s, b = *(const f4v*)(s + 4);
      f8v v = {a[0], a[1], a[2], a[3], b[0], b[1], b[2], b[3]};
      dst[u] = cvt8(v);
    }
  }
}

DI void table_row_issue(const MKParams& p, int row, int lane, f4v (&v)[4]) {
  const int e = row & 16383;
  const float* src = ((row >= 16384) ? p.pv : p.pu) + (size_t)e * DM + 16 * lane;
#pragma unroll
  for (int q = 0; q < 4; ++q) v[q] = NT_LOAD((const f4v*)(src + 4 * q));
}
DI void table_row_finish(const MKParams& p, int row, int lane, f4v (&v)[4]) {
  const int e = row & 16383;
  const bool isv = row >= 16384;
  if (!isv) {
#pragma unroll
    for (int q = 0; q < 4; ++q) v[q] = v[q] * *(const f4v*)(p.g_ffn + 16 * lane + 4 * q);
  }
  float am = 0.f;
#pragma unroll
  for (int q = 0; q < 4; ++q)
#pragma unroll
    for (int j = 0; j < 4; ++j) am = fmaxf(am, fabsf(v[q][j]));
#pragma unroll
  for (int o = 32; o > 0; o >>= 1) am = fmaxf(am, __shfl_xor(am, o));
  const float sc = (am > 0.f) ? 127.0f / am : 0.f;
  unsigned w[4];
#pragma unroll
  for (int q = 0; q < 4; ++q) {
    unsigned pk = 0;
#pragma unroll
    for (int j = 0; j < 4; ++j) pk |= ((unsigned)((int)rintf(v[q][j] * sc)) & 0xffu) << (8 * j);
    w[q] = pk;
  }
  *(uint4*)(p.ws + (isv ? OFF_PV : OFF_PU) + (size_t)e * 1024 + 16 * lane) = make_uint4(w[0], w[1], w[2], w[3]);
  if (lane == 0) ((float*)(p.ws + (isv ? OFF_SV : OFF_SU)))[e] = am * (1.0f / 127.0f);
}
DI void prep_table_row(const MKParams& p, int row, int lane) {
  f4v v[4];
  table_row_issue(p, row, lane, v);
  table_row_finish(p, row, lane, v);
}
DI void phase_prep_tables(const MKParams& p, int gwave, int nwaves, int lane) {
  for (int row = gwave; row < 32768; row += nwaves) prep_table_row(p, row, lane);
}
DI void phase_prep_tables_bal(const MKParams& p, int blk, int nblk, int wave, int lane) {
  if (nblk != 256) { phase_prep_tables(p, blk * 8 + wave, nblk * 8, lane); return; }
  int base, per, idx;
  if (blk >= 64 && blk < 192) { base = 0; per = 7; idx = (blk - 64) * 8 + wave; }
  else if (blk < 64) { base = 7168; per = 21; idx = blk * 8 + wave; }
  else { base = 17920; per = 29; idx = (blk - 192) * 8 + wave; }
  for (int i = 0; i < per; ++i) prep_table_row(p, base + idx * per + i, lane);
}
#ifndef TBL_IN_A
#define TBL_IN_A 12
#endif
DI void phase_prep_tables_rest(const MKParams& p, int gwave, int nwaves, int lane) {
  if (nwaves != 2048) { phase_prep_tables(p, gwave, nwaves, lane); return; }
  for (int rr = TBL_IN_A; rr < 16; ++rr) prep_table_row(p, gwave * 16 + rr, lane);
}
DI void phase_prep_tables_dyn(const MKParams& p, unsigned* qctr, int lane) {
  while (true) {
    unsigned c = 0;
    if (lane == 0) c = __hip_atomic_fetch_add(qctr, 1u, __ATOMIC_RELAXED, __HIP_MEMORY_SCOPE_AGENT);
    c = (unsigned)__builtin_amdgcn_readfirstlane((int)c);
    if (c >= 1024u) break;
#pragma unroll 2
    for (int rr = 0; rr < 32; ++rr) prep_table_row(p, (int)c * 32 + rr, lane);
  }
}

DI void load_norm_tile(const float* __restrict__ src, char* ldsA, int wave, int lane) {
#pragma unroll 2
  for (int i = 0; i < 8; ++i) {
    const int row = 8 * wave + i;
    const f4v* pr = (const f4v*)(src + (size_t)row * DM);
    f4v v[4];
#pragma unroll
    for (int c = 0; c < 4; ++c) v[c] = NT_LOAD(pr + lane + 64 * c);
    float ss = 0.f;
#pragma unroll
    for (int c = 0; c < 4; ++c) ss += v[c][0] * v[c][0] + v[c][1] * v[c][1] + v[c][2] * v[c][2] + v[c][3] * v[c][3];
#pragma unroll
    for (int o = 32; o > 0; o >>= 1) ss += __shfl_xor(ss, o);
    const float rs = rsqrtf(ss * (1.0f / DM) + EPSV);
#pragma unroll
    for (int c = 0; c < 4; ++c) {
      f4v t = v[c] * rs;
      *(bf4*)(ldsA + row * LDS_ROW + (lane * 4 + 256 * c) * 2) = cvt4(t);
    }
  }
}

#ifndef GEMM_D
#define GEMM_D 6
#endif
template <bool SWAP>
DI void gemm_step(f16v (&acc)[2][2], const bf8& a0, const bf8& a1, const bf8& x0, const bf8& x1) {
  if (SWAP) {
    acc[0][0] = MFMA(a0, x0, acc[0][0]); acc[0][1] = MFMA(a0, x1, acc[0][1]);
    acc[1][0] = MFMA(a1, x0, acc[1][0]); acc[1][1] = MFMA(a1, x1, acc[1][1]);
  } else {
    acc[0][0] = MFMA(x0, a0, acc[0][0]); acc[0][1] = MFMA(x1, a0, acc[0][1]);
    acc[1][0] = MFMA(x0, a1, acc[1][0]); acc[1][1] = MFMA(x1, a1, acc[1][1]);
  }
}
struct Ring { bf8 w0[GEMM_D], w1[GEMM_D]; };
DI void ring_fill(Ring& rg, const bf8* __restrict__ wf, int lane) {
#pragma unroll
  for (int i = 0; i < GEMM_D; ++i) { rg.w0[i] = wf[lane + i * 1024]; rg.w1[i] = wf[64 + lane + i * 1024]; }
}
template <bool SWAP, bool RES, bool FIRST, bool NEXT>
DI void gemm_chunk_r(const char* ldsA, const bf8* __restrict__ wf, const bf8* __restrict__ wnext, int lane, f16v (&acc)[2][2],
                     Ring& rg, const float* res = nullptr) {
  __builtin_amdgcn_sched_barrier(0);
  const int r = lane & 31, h = lane >> 5;
  const char* xa0 = ldsA + r * LDS_ROW + h * 16;
  const char* xa1 = xa0 + 32 * LDS_ROW;
  const bf8* w0p = wf + lane;
  const bf8* w1p = wf + 64 + lane;
  if (FIRST) ring_fill(rg, wf, lane);
  if (RES) {
#pragma unroll
    for (int ntl = 0; ntl < 2; ++ntl)
#pragma unroll
      for (int tt = 0; tt < 2; ++tt)
#pragma unroll
        for (int g = 0; g < 4; ++g) {
          const f4v x = *(const f4v*)(res + (size_t)(32 * tt + r) * DM + 32 * ntl + 8 * g + 4 * h);
          acc[ntl][tt][4 * g] = x[0]; acc[ntl][tt][4 * g + 1] = x[1]; acc[ntl][tt][4 * g + 2] = x[2]; acc[ntl][tt][4 * g + 3] = x[3];
        }
  } else {
    acc[0][0] = zero16(); acc[0][1] = zero16(); acc[1][0] = zero16(); acc[1][1] = zero16();
  }
  bf8 x0 = *(const bf8*)(xa0), x1 = *(const bf8*)(xa1);
  constexpr int KMAIN = ((64 - 2 * GEMM_D) / GEMM_D + 1) * GEMM_D;
#pragma unroll 1
  for (int ks0 = 0; ks0 < KMAIN; ks0 += GEMM_D) {
#pragma unroll
    for (int i = 0; i < GEMM_D; ++i) {
      const int ks = ks0 + i;
      const bf8 xn0 = *(const bf8*)(xa0 + (ks + 1) * 32);
      const bf8 xn1 = *(const bf8*)(xa1 + (ks + 1) * 32);
      gemm_step<SWAP>(acc, rg.w0[i], rg.w1[i], x0, x1);
      rg.w0[i] = w0p[(ks + GEMM_D) * 1024];
      rg.w1[i] = w1p[(ks + GEMM_D) * 1024];
      x0 = xn0; x1 = xn1;
      __builtin_amdgcn_sched_group_barrier(0x100, 2, 0);
      __builtin_amdgcn_sched_group_barrier(0x008, 2, 0);
      __builtin_amdgcn_sched_group_barrier(0x020, 2, 0);
      __builtin_amdgcn_sched_group_barrier(0x008, 2, 0);
    }
  }
#pragma unroll
  for (int t = 0; t < 64 - KMAIN; ++t) {
    const int ks = KMAIN + t, i = t % GEMM_D;
    const bf8 xn0 = *(const bf8*)(xa0 + (ks + 1) * 32);
    const bf8 xn1 = *(const bf8*)(xa1 + (ks + 1) * 32);
    gemm_step<SWAP>(acc, rg.w0[i], rg.w1[i], x0, x1);
    const bool refill = (ks + GEMM_D < 64) || NEXT;
    if (ks + GEMM_D < 64) {
      rg.w0[i] = w0p[(ks + GEMM_D) * 1024];
      rg.w1[i] = w1p[(ks + GEMM_D) * 1024];
    } else if (NEXT) {
      rg.w0[i] = wnext[lane + (ks + GEMM_D - 64) * 1024];
      rg.w1[i] = wnext[64 + lane + (ks + GEMM_D - 64) * 1024];
    }
    x0 = xn0; x1 = xn1;
    __builtin_amdgcn_sched_group_barrier(0x100, 2, 0);
    __builtin_amdgcn_sched_group_barrier(0x008, 2, 0);
    if (refill) __builtin_amdgcn_sched_group_barrier(0x020, 2, 0);
    __builtin_amdgcn_sched_group_barrier(0x008, 2, 0);
  }
}
struct Ring8 { uint4 w0[GEMM_D2], w1[GEMM_D2]; bf8 c0, c1; };
DI void ring8_fill(Ring8& rg, const uint4* __restrict__ wf, int lane) {
#pragma unroll
  for (int i = 0; i < GEMM_D2; ++i) { rg.w0[i] = wf[lane + i * 1024]; rg.w1[i] = wf[64 + lane + i * 1024]; }
}
DI bf8 deq8(unsigned lo, unsigned hi) {
  f8v v;
  v[0] = (float)(signed char)(lo); v[1] = (float)(signed char)(lo >> 8); v[2] = (float)(signed char)(lo >> 16); v[3] = (float)((int)lo >> 24);
  v[4] = (float)(signed char)(hi); v[5] = (float)(signed char)(hi >> 8); v[6] = (float)(signed char)(hi >> 16); v[7] = (float)((int)hi >> 24);
  return cvt8(v);
}
template <bool SWAP, bool RES, bool FIRST, bool NEXT, bool CUR>
DI void gemm_chunk_w8(const char* ldsA, const uint4* __restrict__ wf, const uint4* __restrict__ wnext, int lane, f16v (&acc)[2][2],
                      Ring8& rg, const float* res = nullptr, const float* ics = nullptr) {
  __builtin_amdgcn_sched_barrier(0);
  const int r = lane & 31, h = lane >> 5;
  const char* xa0 = ldsA + r * LDS_ROW + h * 16;
  const char* xa1 = xa0 + 32 * LDS_ROW;
  const uint4* w0p = wf + lane;
  const uint4* w1p = wf + 64 + lane;
  if (FIRST) ring8_fill(rg, wf, lane);
  if (RES) {
#pragma unroll
    for (int ntl = 0; ntl < 2; ++ntl)
#pragma unroll
      for (int g = 0; g < 4; ++g) {
        const f4v ic = *(const f4v*)(ics + 32 * ntl + 8 * g + 4 * h);
#pragma unroll
        for (int tt = 0; tt < 2; ++tt) {
          const f4v x = *(const f4v*)(res + (size_t)(32 * tt + r) * DM + 32 * ntl + 8 * g + 4 * h);
          acc[ntl][tt][4 * g] = x[0] * ic[0]; acc[ntl][tt][4 * g + 1] = x[1] * ic[1]; acc[ntl][tt][4 * g + 2] = x[2] * ic[2]; acc[ntl][tt][4 * g + 3] = x[3] * ic[3];
        }
      }
  } else {
    acc[0][0] = zero16(); acc[0][1] = zero16(); acc[1][0] = zero16(); acc[1][1] = zero16();
  }
  bf8 x0 = *(const bf8*)(xa0), x1 = *(const bf8*)(xa1);
  bf8 cur0, cur1;
  if (CUR && !FIRST) { cur0 = rg.c0; cur1 = rg.c1; }
  else { cur0 = deq8(rg.w0[0].x, rg.w0[0].y); cur1 = deq8(rg.w1[0].x, rg.w1[0].y); }
  constexpr int NP = 32;
  constexpr int KM = ((NP - 2 * GEMM_D2) / GEMM_D2 + 1) * GEMM_D2;
#define W8_PAIR(p, i, REFILL_STMT, CONV_NEXT)                                                                          \
  {                                                                                                                    \
    const bf8 xn0 = *(const bf8*)(xa0 + (2 * (p) + 1) * 32);                                                           \
    const bf8 xn1 = *(const bf8*)(xa1 + (2 * (p) + 1) * 32);                                                           \
    gemm_step<SWAP>(acc, cur0, cur1, x0, x1);                                                                          \
    cur0 = deq8(rg.w0[i].z, rg.w0[i].w); cur1 = deq8(rg.w1[i].z, rg.w1[i].w);     \
    __builtin_amdgcn_sched_group_barrier(0x100, 2, 0);                                                                 \
    __builtin_amdgcn_sched_group_barrier(0x008, 4, 0);                                                                 \
    __builtin_amdgcn_sched_group_barrier(0x002, 24, 0);                                                                \
    x0 = *(const bf8*)(xa0 + (2 * (p) + 2) * 32);                                                                      \
    x1 = *(const bf8*)(xa1 + (2 * (p) + 2) * 32);                                                                      \
    gemm_step<SWAP>(acc, cur0, cur1, xn0, xn1);                                                                        \
    if (CONV_NEXT) { cur0 = deq8(rg.w0[((i) + 1) % GEMM_D2].x, rg.w0[((i) + 1) % GEMM_D2].y);                          \
                     cur1 = deq8(rg.w1[((i) + 1) % GEMM_D2].x, rg.w1[((i) + 1) % GEMM_D2].y); }                        \
    REFILL_STMT                                                                                                        \
    __builtin_amdgcn_sched_group_barrier(0x100, 2, 0);                                                                 \
    __builtin_amdgcn_sched_group_barrier(0x008, 4, 0);                                                                 \
    __builtin_amdgcn_sched_group_barrier(0x020, 2, 0);                                                                 \
    __builtin_amdgcn_sched_group_barrier(0x002, 24, 0);                                                                \
  }
#pragma unroll 1
  for (int p0 = 0; p0 < KM; p0 += GEMM_D2) {
#pragma unroll
    for (int i = 0; i < GEMM_D2; ++i) {
      const int p = p0 + i;
      W8_PAIR(p, i, { rg.w0[i] = w0p[(p + GEMM_D2) * 1024]; rg.w1[i] = w1p[(p + GEMM_D2) * 1024]; }, true)
    }
  }
#pragma unroll
  for (int t = 0; t < NP - KM; ++t) {
    const int p = KM + t, i = t % GEMM_D2;
    if (p + GEMM_D2 < NP) {
      W8_PAIR(p, i, { rg.w0[i] = w0p[(p + GEMM_D2) * 1024]; rg.w1[i] = w1p[(p + GEMM_D2) * 1024]; }, true)
    } else if (NEXT) {
      W8_PAIR(p, i, { rg.w0[i] = wnext[lane + (p + GEMM_D2 - NP) * 1024]; rg.w1[i] = wnext[64 + lane + (p + GEMM_D2 - NP) * 1024]; }, true)
    } else {
      W8_PAIR(p, i, {}, (p + 1 < NP))
    }
  }
#undef W8_PAIR
  if (NEXT) { rg.c0 = cur0; rg.c1 = cur1; }
}
DI void scale_cols(f16v (&acc)[2][2], const float* __restrict__ cs, int lane) {
  __builtin_amdgcn_sched_barrier(0);
  asm volatile("" : "+v"(lane));
  const int h = lane >> 5;
#pragma unroll
  for (int ntl = 0; ntl < 2; ++ntl)
#pragma unroll
    for (int g = 0; g < 4; ++g) {
      const f4v c4 = *(const f4v*)(cs + 32 * ntl + 8 * g + 4 * h);
#pragma unroll
      for (int tt = 0; tt < 2; ++tt)
#pragma unroll
        for (int e = 0; e < 4; ++e) acc[ntl][tt][4 * g + e] *= c4[e];
    }
}
#if W8
typedef Ring8 RingC;
#else
typedef Ring RingC;
#endif

DI unsigned l2_touch(const void* chunk, int lane) {
  unsigned v = 0;
#if L2_TOUCH
  asm volatile("" : "+v"(lane));
  const char* q = (const char*)chunk + (size_t)((blockIdx.x >> 3) & 31) * 32768 + (unsigned)(lane & 31) * 128u +
                  (unsigned)__builtin_amdgcn_readfirstlane((int)(threadIdx.x >> 6)) * 4096u;
  if (lane < 32) v = *(const unsigned*)q;
#endif
  return v;
}
DI void l2_sink(unsigned v) {
#if L2_TOUCH
  asm volatile("" :: "v"(v));
#endif
}
template <bool SWAP, bool RES = false>
DI void gemm_chunk(const char* ldsA, const bf8* __restrict__ wf, int lane, f16v (&acc)[2][2], const float* res = nullptr) {
  Ring rg;
  gemm_chunk_r<SWAP, RES, true, false>(ldsA, wf, nullptr, lane, acc, rg, res);
}

DI void store_swap_bf16(u16* dst, size_t ld, const f16v (&acc)[2][2], int lane) {
  const int r = lane & 31, h = lane >> 5;
#pragma unroll
  for (int ntl = 0; ntl < 2; ++ntl)
#pragma unroll
    for (int tt = 0; tt < 2; ++tt)
#pragma unroll
      for (int g = 0; g < 4; ++g) {
        f4v v = {acc[ntl][tt][4 * g], acc[ntl][tt][4 * g + 1], acc[ntl][tt][4 * g + 2], acc[ntl][tt][4 * g + 3]};
        *(bf4*)(dst + (size_t)(32 * tt + r) * ld + 32 * ntl + 8 * g + 4 * h) = cvt4(v);
      }
}
DI void store_vt_bf16(u16* dst, size_t ld, const f16v (&acc)[2][2], int lane) {
  const int r = lane & 31, h = lane >> 5;
#pragma unroll
  for (int ntl = 0; ntl < 2; ++ntl)
#pragma unroll
    for (int tt = 0; tt < 2; ++tt)
#pragma unroll
      for (int s = 0; s < 2; ++s) {
        f8v v;
#pragma unroll
        for (int j = 0; j < 8; ++j) v[j] = acc[ntl][tt][8 * s + j];
        *(bf8*)(dst + (size_t)(32 * ntl + r) * ld + 32 * tt + 16 * s + 8 * h) = cvt8(v);
      }
}

DI float log_sigmoid_acc(float x) { return fminf(x, 0.f) - log1pf(expf(-fabsf(x))); }

template <bool PRELOADED = false, bool TBL = false>
DI void phase_a_tile(const MKParams& p, int tile, int wave, int lane) {
  asm volatile("" : "+v"(lane));
  char* ws = p.ws;
  char* ldsA = smem;
  float* alr_s = (float*)(smem + LDS_A_BYTES);
  const int b = tile >> 5, c = tile & 31;
  const size_t tok0 = (size_t)tile * 64;
  if (!PRELOADED) {
    __syncthreads();
    load_norm_tile(p.x + tok0 * DM, ldsA, wave, lane);
#if PROBE == 10
    __syncthreads();
    load_norm_tile(p.x + tok0 * DM, ldsA, wave, lane);
#endif
    __syncthreads();
  }
  const bf8* wf = (const bf8*)(ws + OFF_WIN);
  f16v acc[2][2];
  Ring rg;
  f4v tv[2][4];
  const int trow0 = (blockIdx.x * 8 + wave) * 16;
  const int t0 = c * 64;
  { const unsigned pf = l2_touch(wf + (size_t)1 * 65536, lane);
  gemm_chunk_r<true, false, true, true>(ldsA, wf + (size_t)0 * 65536 + 2 * wave * 64, wf + (size_t)1 * 65536 + 2 * wave * 64, lane, acc, rg);
    l2_sink(pf); }
  if (TBL && 0 < TBL_IN_A) { table_row_issue(p, trow0 + 0, lane, tv[0]); table_row_issue(p, trow0 + 1, lane, tv[1]); }
  {
    u16* base = (u16*)(ws + (wave < 4 ? OFF_GQ : OFF_GK)) + ((size_t)(b * 4 + (wave & 3)) * SEQ + t0) * 64;
    store_swap_bf16(base, 64, acc, lane);
  if (TBL && 0 < TBL_IN_A) { table_row_finish(p, trow0 + 0, lane, tv[0]); table_row_finish(p, trow0 + 1, lane, tv[1]); }
#if PROBE == 11
    store_swap_bf16(base, 64, acc, lane);
#endif
  }
  { const unsigned pf = l2_touch(wf + (size_t)2 * 65536, lane);
  gemm_chunk_r<false, false, false, true>(ldsA, wf + (size_t)1 * 65536 + 2 * wave * 64, wf + (size_t)2 * 65536 + 2 * wave * 64, lane, acc, rg);
    l2_sink(pf); }
  if (TBL && 2 < TBL_IN_A) { table_row_issue(p, trow0 + 2, lane, tv[0]); table_row_issue(p, trow0 + 3, lane, tv[1]); }
  {
    u16* base = (u16*)(ws + OFF_GVT) + ((size_t)(b * 4 + (wave >> 1)) * 128 + 64 * (wave & 1)) * SEQ + t0;
    store_vt_bf16(base, SEQ, acc, lane);
  if (TBL && 2 < TBL_IN_A) { table_row_finish(p, trow0 + 2, lane, tv[0]); table_row_finish(p, trow0 + 3, lane, tv[1]); }
#if PROBE == 11
    store_vt_bf16(base, SEQ, acc, lane);
#endif
  }
  { const unsigned pf = l2_touch(wf + (size_t)3 * 65536, lane);
  gemm_chunk_r<true, false, false, true>(ldsA, wf + (size_t)2 * 65536 + 2 * wave * 64, wf + (size_t)3 * 65536 + 2 * wave * 64, lane, acc, rg);
    l2_sink(pf); }
  if (TBL && 4 < TBL_IN_A) { table_row_issue(p, trow0 + 4, lane, tv[0]); table_row_issue(p, trow0 + 5, lane, tv[1]); }
  store_swap_bf16((u16*)(ws + OFF_OG) + tok0 * 512 + 64 * wave, 512, acc, lane);
  if (TBL && 4 < TBL_IN_A) { table_row_finish(p, trow0 + 4, lane, tv[0]); table_row_finish(p, trow0 + 5, lane, tv[1]); }
#if PROBE == 11
  store_swap_bf16((u16*)(ws + OFF_OG) + tok0 * 512 + 64 * wave, 512, acc, lane);
#endif
  { const unsigned pf = l2_touch(wf + (size_t)4 * 65536, lane);
  gemm_chunk_r<true, false, false, true>(ldsA, wf + (size_t)3 * 65536 + 2 * wave * 64, wf + (size_t)4 * 65536 + 2 * wave * 64, lane, acc, rg);
    l2_sink(pf); }
  if (TBL && 6 < TBL_IN_A) { table_row_issue(p, trow0 + 6, lane, tv[0]); table_row_issue(p, trow0 + 7, lane, tv[1]); }
  store_swap_bf16((u16*)(ws + OFF_SQ) + ((size_t)(b * 8 + wave) * SEQ + t0) * 64, 64, acc, lane);
  if (TBL && 6 < TBL_IN_A) { table_row_finish(p, trow0 + 6, lane, tv[0]); table_row_finish(p, trow0 + 7, lane, tv[1]); }
#if PROBE == 11
  store_swap_bf16((u16*)(ws + OFF_SQ) + ((size_t)(b * 8 + wave) * SEQ + t0) * 64, 64, acc, lane);
#endif
  { const unsigned pf = l2_touch(wf + (size_t)5 * 65536, lane);
  gemm_chunk_r<true, false, false, true>(ldsA, wf + (size_t)4 * 65536 + 2 * wave * 64, wf + (size_t)5 * 65536 + 2 * wave * 64, lane, acc, rg);
    l2_sink(pf); }
  if (TBL && 8 < TBL_IN_A) { table_row_issue(p, trow0 + 8, lane, tv[0]); table_row_issue(p, trow0 + 9, lane, tv[1]); }
  store_swap_bf16((u16*)(ws + OFF_SK) + ((size_t)(b * 8 + wave) * SEQ + t0) * 64, 64, acc, lane);
  if (TBL && 8 < TBL_IN_A) { table_row_finish(p, trow0 + 8, lane, tv[0]); table_row_finish(p, trow0 + 9, lane, tv[1]); }
#if PROBE == 11
  store_swap_bf16((u16*)(ws + OFF_SK) + ((size_t)(b * 8 + wave) * SEQ + t0) * 64, 64, acc, lane);
#endif
  gemm_chunk_r<false, false, false, false>(ldsA, wf + (size_t)5 * 65536 + 2 * wave * 64, nullptr, lane, acc, rg);
  if (TBL && 10 < TBL_IN_A) { table_row_issue(p, trow0 + 10, lane, tv[0]); table_row_issue(p, trow0 + 11, lane, tv[1]); }
  store_vt_bf16((u16*)(ws + OFF_SVT) + ((size_t)(b * 8 + wave) * 64) * SEQ + t0, SEQ, acc, lane);
  if (TBL && 10 < TBL_IN_A) { table_row_finish(p, trow0 + 10, lane, tv[0]); table_row_finish(p, trow0 + 11, lane, tv[1]); }
#if PROBE == 11
  store_vt_bf16((u16*)(ws + OFF_SVT) + ((size_t)(b * 8 + wave) * 64) * SEQ + t0, SEQ, acc, lane);
#endif
#if PROBE == 12
  for (int rep_ = 0; rep_ < 2; ++rep_) {
  __syncthreads();
#else
  {
#endif
    float* part = (float*)(smem + LDS_A_BYTES);
    const int r = lane & 31, h = lane >> 5;
    const bf8* wp = wf + (size_t)96 * 4096 + lane;
    bf8 wfr[8];
#pragma unroll
    for (int i = 0; i < 8; ++i) wfr[i] = wp[(8 * wave + i) * 64];
    const char* xa0 = ldsA + r * LDS_ROW + h * 16 + wave * 256;
    const char* xa1 = xa0 + 32 * LDS_ROW;
    f16v a0 = zero16(), a1 = zero16();
#pragma unroll
    for (int i = 0; i < 8; ++i) {
      a0 = MFMA(wfr[i], *(const bf8*)(xa0 + i * 32), a0);
      a1 = MFMA(wfr[i], *(const bf8*)(xa1 + i * 32), a1);
    }
    float* pw = part + (wave & 3) * 1024;
    if (wave < 4) {
#pragma unroll
      for (int i = 0; i < 8; ++i) { pw[r * 16 + crow(i, h)] = a0[i]; pw[(32 + r) * 16 + crow(i, h)] = a1[i]; }
    }
    __syncthreads();
    if (wave >= 4) {
#pragma unroll
      for (int i = 0; i < 8; ++i) { pw[r * 16 + crow(i, h)] += a0[i]; pw[(32 + r) * 16 + crow(i, h)] += a1[i]; }
    }
    __syncthreads();
    const int tid = wave * 64 + lane;
    {
      const f4v* p4 = (const f4v*)part;
      if (tid < 256) { f4v s = p4[tid] + p4[256 + tid] + p4[512 + tid] + p4[768 + tid]; ((f4v*)part)[tid] = s; }
    }
    __syncthreads();
    const int col = tid & 255, tg = tid >> 8;
    float wu[16];
#pragma unroll
    for (int rr = 0; rr < 16; ++rr) wu[rr] = p.w_up[rr * 256 + col];
    const float bb = p.b_alpha[col];
    float* dst = (float*)(ws + OFF_LA) + (tok0 + 32 * tg) * 256 + col;
#pragma unroll 4
    for (int t = 0; t < 32; ++t) {
      const f4v* ar = (const f4v*)(part + (32 * tg + t) * 16);
      const f4v q0 = ar[0], q1 = ar[1], q2 = ar[2], q3 = ar[3];
      float s = bb;
      s = fmaf(q0[0], wu[0], s); s = fmaf(q0[1], wu[1], s); s = fmaf(q0[2], wu[2], s); s = fmaf(q0[3], wu[3], s);
      s = fmaf(q1[0], wu[4], s); s = fmaf(q1[1], wu[5], s); s = fmaf(q1[2], wu[6], s); s = fmaf(q1[3], wu[7], s);
      s = fmaf(q2[0], wu[8], s); s = fmaf(q2[1], wu[9], s); s = fmaf(q2[2], wu[10], s); s = fmaf(q2[3], wu[11], s);
      s = fmaf(q3[0], wu[12], s); s = fmaf(q3[1], wu[13], s); s = fmaf(q3[2], wu[14], s); s = fmaf(q3[3], wu[15], s);
      const float ls = fminf(s, 0.f) - __logf(1.0f + __expf(-fabsf(s)));
      dst[(size_t)t * 256] = ls * (1.0f / 16.0f);
    }
  }
}

DI void phase_a_memkv(const MKParams& p, int item, int wave, int lane) {
  asm volatile("" : "+v"(lane));
  char* ws = p.ws;
  char* ldsA = smem;
  const int rt = item >> 2, cc = item & 3;
  const int b = rt >> 2, m0 = (rt & 3) * 64;
  __syncthreads();
  load_norm_tile(p.mem + (size_t)rt * 64 * DM, ldsA, wave, lane);
  __syncthreads();
  const bf8* wf = (const bf8*)(ws + OFF_WMKV);
  f16v acc[2][2];
  if (cc < 2) {
    gemm_chunk<true>(ldsA, wf + (size_t)cc * 65536 + 2 * wave * 64, lane, acc);
    const int f0 = 512 * cc + 64 * wave;
    u16* base = (u16*)(ws + OFF_KM) + ((size_t)(b * 4 + (f0 >> 8)) * 256 + m0) * 256 + (f0 & 255);
    store_swap_bf16(base, 256, acc, lane);
  } else {
    gemm_chunk<false>(ldsA, wf + (size_t)cc * 65536 + 2 * wave * 64, lane, acc);
    const int f0 = 512 * (cc - 2) + 64 * wave;
    u16* base = (u16*)(ws + OFF_VMT) + ((size_t)(b * 4 + (f0 >> 8)) * 256 + (f0 & 255)) * 256 + m0;
    store_vt_bf16(base, 256, acc, lane);
  }
}
#define SB_THR 30.0f

DI bf8 pack8(const f16v& x, int s) {
  f8v v;
#pragma unroll
  for (int j = 0; j < 8; ++j) v[j] = x[8 * s + j];
  return cvt8(v);
}

DI void sb_item(const MKParams& p, int item, int lane) {
  asm volatile("" : "+v"(lane));
  char* ws = p.ws;
  const int r = lane & 31, h = lane >> 5;
  const int bh = item >> 6, qt = item & 63;
  const u16* SQ = (const u16*)(ws + OFF_SQ) + (size_t)bh * SEQ * 64;
  const u16* SK = (const u16*)(ws + OFF_SK) + (size_t)bh * SEQ * 64;
  const u16* SVT = (const u16*)(ws + OFF_SVT) + (size_t)bh * 64 * SEQ;
  bf8 qf[4];
#pragma unroll
  for (int ks = 0; ks < 4; ++ks) qf[ks] = *(const bf8*)(SQ + (size_t)(32 * qt + r) * 64 + 16 * ks + 8 * h);
  bf8 tri[2];
#pragma unroll
  for (int s = 0; s < 2; ++s) {
    f8v t;
#pragma unroll
    for (int j = 0; j < 8; ++j) t[j] = (16 * s + 8 * (j >> 2) + 4 * h + (j & 3) >= r) ? 1.0f : 0.0f;
    tri[s] = cvt8(t);
  }
  f16v o0 = zero16(), o1 = zero16();
  float R = 0.f;
  bf8 kf[4], vf[2][2];
#pragma unroll
  for (int ks = 0; ks < 4; ++ks) kf[ks] = *(const bf8*)(SK + (size_t)(32 * qt + r) * 64 + 16 * ks + 8 * h);
#pragma unroll
  for (int mt = 0; mt < 2; ++mt)
#pragma unroll
    for (int s = 0; s < 2; ++s) vf[mt][s] = *(const bf8*)(SVT + (size_t)(32 * mt + r) * SEQ + 32 * qt + 16 * s + 8 * h);
  for (int kt = qt; kt >= 0; --kt) {
    bf8 kfn[4], vfn[2][2];
    const int ktn = (kt > 0) ? kt - 1 : 0;
#pragma unroll
    for (int ks = 0; ks < 4; ++ks) kfn[ks] = *(const bf8*)(SK + (size_t)(32 * ktn + r) * 64 + 16 * ks + 8 * h);
#pragma unroll
    for (int mt = 0; mt < 2; ++mt)
#pragma unroll
      for (int s = 0; s < 2; ++s) vfn[mt][s] = *(const bf8*)(SVT + (size_t)(32 * mt + r) * SEQ + 32 * ktn + 16 * s + 8 * h);
    f16v z = zero16();
#pragma unroll
    for (int ks = 0; ks < 4; ++ks) z = MFMA(kf[ks], qf[ks], z);
    const bool diag = (kt == qt);
    f16v sp;
    float tot = 0.f;
#pragma unroll
    for (int i = 0; i < 16; ++i) {
      const float zz = z[i];
      const float sv = fmaxf(zz, 0.f) + __logf(1.0f + __expf(-fabsf(zz)));
      const bool valid = !diag || (crow(i, h) < r);
      sp[i] = valid ? sv : 0.f;
      tot += sp[i];
    }
    tot += __shfl_xor(tot, 32);
    f16v C = MFMA(tri[0], pack8(sp, 0), zero16());
    C = MFMA(tri[1], pack8(sp, 1), C);
    f16v a;
#pragma unroll
    for (int i = 0; i < 16; ++i) {
      const bool valid = !diag || (crow(i, h) < r);
      a[i] = valid ? __expf(z[i] - C[i] - R) : 0.f;
    }
    const bf8 a0 = pack8(a, 0), a1 = pack8(a, 1);
    o0 = MFMA(vf[0][0], a0, o0); o0 = MFMA(vf[0][1], a1, o0);
    o1 = MFMA(vf[1][0], a0, o1); o1 = MFMA(vf[1][1], a1, o1);
    R += tot;
    if (__all(R > SB_THR)) break;
#pragma unroll
    for (int ks = 0; ks < 4; ++ks) kf[ks] = kfn[ks];
#pragma unroll
    for (int mt = 0; mt < 2; ++mt)
#pragma unroll
      for (int s = 0; s < 2; ++s) vf[mt][s] = vfn[mt][s];
  }
  const int b = bh >> 3, hd = bh & 7;
  u16* dst = (u16*)(ws + OFF_OSB) + ((size_t)b * SEQ + 32 * qt + r) * 512 + hd * 64 + 4 * h;
#pragma unroll
  for (int g = 0; g < 4; ++g) {
    f4v v0 = {o0[4 * g], o0[4 * g + 1], o0[4 * g + 2], o0[4 * g + 3]};
    f4v v1 = {o1[4 * g], o1[4 * g + 1], o1[4 * g + 2], o1[4 * g + 3]};
    *(bf4*)(dst + 8 * g) = cvt4(v0);
    *(bf4*)(dst + 32 + 8 * g) = cvt4(v1);
  }
}

DI void gla_g1_tile(const MKParams& p, int tile, int wave, int lane) {
  asm volatile("" : "+v"(lane));
  __builtin_amdgcn_sched_barrier(0);
  char* ws = p.ws;
  const int r = lane & 31, h = lane >> 5;
  const int b = tile >> 5, c = tile & 31, hd = wave >> 1, half = wave & 1, bh = b * 4 + hd;
  const int item = bh * 32 + c;
  char* kl = smem + wave * 9216;
  const u16* GQ = (const u16*)(ws + OFF_GQ) + ((size_t)bh * SEQ + 64 * c) * 64;
  const u16* GK = (const u16*)(ws + OFF_GK) + ((size_t)bh * SEQ + 64 * c) * 64;
  u16* GQ2 = (u16*)(ws + OFF_GQ2) + ((size_t)bh * SEQ + 64 * c) * 64;
  u16* GK2 = (u16*)(ws + OFF_GK2) + ((size_t)bh * SEQ + 64 * c) * 64;
  const float* LA = (const float*)(ws + OFF_LA) + ((size_t)b * SEQ + 64 * c) * 256 + hd * 64;
  float bc = 0.f;
#pragma unroll 1
  for (int g = 0; g < 4; ++g) {
    float la_[16];
    u16 q_[16], k_[16];
#pragma unroll
    for (int i = 0; i < 16; ++i) {
      const int t = 16 * g + i;
      la_[i] = LA[(size_t)t * 256 + lane];
      q_[i] = GQ[t * 64 + lane];
      k_[i] = GK[t * 64 + lane];
    }
#pragma unroll
    for (int i = 0; i < 16; ++i) {
      const int t = 16 * g + i;
      bc += la_[i];
      const float eq = __expf(bc);
      const float qn = bf2f(q_[i]) * eq, kn = bf2f(k_[i]) / eq;
      const bf2 pk = __builtin_convertvector((f2v){qn, kn}, bf2);
      const unsigned u = __builtin_bit_cast(unsigned, pk);
      if (half == 0) {
        GQ2[t * 64 + lane] = (u16)(u & 0xffff);
        GK2[t * 64 + lane] = (u16)(u >> 16);
      }
      *(u16*)(kl + lane * 144 + tpos(t) * 2) = (u16)(u >> 16);
    }
  }
  if (half == 0) ((float*)(ws + OFF_DD))[(size_t)item * 64 + lane] = __expf(bc);
  asm volatile("s_waitcnt lgkmcnt(0)" ::: "memory");
  const u16* GVT = (const u16*)(ws + OFF_GVT) + (size_t)bh * 128 * SEQ + 64 * c;
  float* LKV = (float*)(ws + OFF_LKV) + (size_t)item * 128 * 64;
  bf8 kb[2][4];
#pragma unroll
  for (int nt = 0; nt < 2; ++nt)
#pragma unroll
    for (int s = 0; s < 4; ++s) kb[nt][s] = *(const bf8*)(kl + (32 * nt + r) * 144 + (16 * s + 8 * h) * 2);
  bf8 vf[2][4];
#pragma unroll
  for (int m2 = 0; m2 < 2; ++m2)
#pragma unroll
    for (int s = 0; s < 4; ++s) vf[m2][s] = *(const bf8*)(GVT + (size_t)(32 * (2 * half + m2) + r) * SEQ + 16 * s + 8 * h);
  __builtin_amdgcn_sched_barrier(0);
#pragma unroll
  for (int m2 = 0; m2 < 2; ++m2) {
    const int mt = 2 * half + m2;
    f16v a0 = zero16(), a1 = zero16();
#pragma unroll
    for (int s = 0; s < 4; ++s) {
      a0 = MFMA(vf[m2][s], kb[0][s], a0);
      a1 = MFMA(vf[m2][s], kb[1][s], a1);
    }
#pragma unroll
    for (int i = 0; i < 16; ++i) {
      LKV[(32 * mt + crow(i, h)) * 64 + r] = a0[i];
      LKV[(32 * mt + crow(i, h)) * 64 + 32 + r] = a1[i];
    }
  }
  asm volatile("s_waitcnt lgkmcnt(0)" ::: "memory");
}

DI void gla_g2(const MKParams& p, int gtid, int gthreads) {
  char* ws = p.ws;
  for (int u = gtid; u < 32768; u += gthreads) {
    const int oct = u & 7, dv = (u >> 3) & 127, bh = u >> 10;
    f8v S = {0.f, 0.f, 0.f, 0.f, 0.f, 0.f, 0.f, 0.f};
#pragma unroll 4
    for (int c = 0; c < 32; ++c) {
      const size_t item = (size_t)bh * 32 + c;
      *(bf8*)((u16*)(ws + OFF_SS) + (item * 128 + dv) * 64 + oct * 8) = cvt8(S);
      const f8v l = *(const f8v*)((const float*)(ws + OFF_LKV) + (item * 128 + dv) * 64 + oct * 8);
      const f8v d = *(const f8v*)((const float*)(ws + OFF_DD) + item * 64 + oct * 8);
      S = d * (S + l);
    }
  }
}

DI void gla_g3_tile(const MKParams& p, int tile, int wave, int lane, char* dst, int dst_ld) {
  char* ws = p.ws;
  const int r = lane & 31, h = lane >> 5;
  const int b = tile >> 5, c = tile & 31, hd = wave >> 1, tt = wave & 1, bh = b * 4 + hd;
  const u16* GQ = (const u16*)(ws + OFF_GQ2) + ((size_t)bh * SEQ + 64 * c) * 64;
  const u16* GK = (const u16*)(ws + OFF_GK2) + ((size_t)bh * SEQ + 64 * c) * 64;
  const u16* GVT = (const u16*)(ws + OFF_GVT) + (size_t)bh * 128 * SEQ + 64 * c;
  const u16* SS = (const u16*)(ws + OFF_SS) + ((size_t)(bh * 32 + c) * 128) * 64;
  bf8 qf[4];
#pragma unroll
  for (int ks = 0; ks < 4; ++ks) qf[ks] = *(const bf8*)(GQ + (32 * tt + r) * 64 + 16 * ks + 8 * h);
  bf8 pf[2][2];
  {
    bf8 kf[2][4];
#pragma unroll
    for (int kt = 0; kt < 2; ++kt)
      if (kt <= tt) {
#pragma unroll
        for (int ks = 0; ks < 4; ++ks) kf[kt][ks] = *(const bf8*)(GK + (32 * kt + r) * 64 + 16 * ks + 8 * h);
      }
    __builtin_amdgcn_sched_barrier(0);
#pragma unroll
    for (int kt = 0; kt < 2; ++kt) {
      if (kt <= tt) {
        f16v pt = zero16();
#pragma unroll
        for (int ks = 0; ks < 4; ++ks) pt = MFMA(kf[kt][ks], qf[ks], pt);
        if (kt == tt) {
#pragma unroll
          for (int i = 0; i < 16; ++i) pt[i] = (crow(i, h) <= r) ? pt[i] : 0.f;
        }
        pf[kt][0] = pack8(pt, 0);
        pf[kt][1] = pack8(pt, 1);
      }
    }
  }
  f16v o[4];
  {
    bf8 sf[2][4], vf[2][4];
    auto load_tile = [&](int mt, bf8 (&sfx)[4], bf8 (&vfx)[4]) {
#pragma unroll
      for (int ks = 0; ks < 4; ++ks) sfx[ks] = *(const bf8*)(SS + (32 * mt + r) * 64 + 16 * ks + 8 * h);
#pragma unroll
      for (int kt = 0; kt < 2; ++kt)
        if (kt <= tt) {
#pragma unroll
          for (int s = 0; s < 2; ++s) vfx[2 * kt + s] = *(const bf8*)(GVT + (size_t)(32 * mt + r) * SEQ + 32 * kt + 16 * s + 8 * h);
        }
    };
    load_tile(0, sf[0], vf[0]);
#pragma unroll
    for (int mt = 0; mt < 4; ++mt) {
      if (mt + 1 < 4) load_tile(mt + 1, sf[(mt + 1) & 1], vf[(mt + 1) & 1]);
      __builtin_amdgcn_sched_barrier(0);
      o[mt] = zero16();
#pragma unroll
      for (int ks = 0; ks < 4; ++ks) o[mt] = MFMA(sf[mt & 1][ks], qf[ks], o[mt]);
#pragma unroll
      for (int kt = 0; kt < 2; ++kt)
        if (kt <= tt) {
#pragma unroll
          for (int s = 0; s < 2; ++s) o[mt] = MFMA(vf[mt & 1][2 * kt + s], pf[kt][s], o[mt]);
        }
      __builtin_amdgcn_sched_barrier(0);
    }
  }
  float ss = 0.f;
#pragma unroll
  for (int mt = 0; mt < 4; ++mt)
#pragma unroll
    for (int i = 0; i < 16; ++i) ss += o[mt][i] * o[mt][i];
  ss += __shfl_xor(ss, 32);
  const float rr = rsqrtf(ss * (1.0f / 128.0f) + EPSV);
  const size_t tok = (size_t)tile * 64 + 32 * tt + r;
  const u16* OG = (const u16*)(ws + OFF_OG) + tok * 512 + hd * 128;
#pragma unroll
  for (int mt = 0; mt < 4; ++mt)
#pragma unroll
    for (int g = 0; g < 4; ++g) {
      const int dv0 = 32 * mt + 8 * g + 4 * h;
      const ushort4 og4 = *(const ushort4*)(OG + dv0);
      const f4v gg = *(const f4v*)(p.g_gla + dv0);
      const float og[4] = {bf2f(og4.x), bf2f(og4.y), bf2f(og4.z), bf2f(og4.w)};
      f4v v;
#pragma unroll
      for (int j = 0; j < 4; ++j) v[j] = o[mt][4 * g + j] * rr * gg[j] * (og[j] / (1.0f + __expf(-og[j])));
      *(bf4*)(dst + (size_t)(32 * tt + r) * dst_ld + (hd * 128 + dv0) * 2) = cvt4(v);
    }
}
DI void gemm_1024(const char* ldsA, const bf8* __restrict__ wf, int wave, int lane, f16v (&a0)[2][2], f16v (&a1)[2][2]) {
  gemm_chunk<true>(ldsA, wf + 2 * wave * 64, lane, a0);
  gemm_chunk<true>(ldsA, wf + 65536 + 2 * wave * 64, lane, a1);
}
DI void gemm_1024_res(const char* ldsA, const bf8* __restrict__ wf, int wave, int lane, f16v (&a0)[2][2], f16v (&a1)[2][2],
                      const float* res) {
  gemm_chunk<true, true>(ldsA, wf + 2 * wave * 64, lane, a0, res + 64 * wave);
  gemm_chunk<true, true>(ldsA, wf + 65536 + 2 * wave * 64, lane, a1, res + 512 + 64 * wave);
}

DI void store_f32_ssq(const f16v (&a)[2][2], float* dst, int f0, int lane, float (&ssq)[2]) {
  const int r = lane & 31, h = lane >> 5;
#pragma unroll
  for (int ntl = 0; ntl < 2; ++ntl)
#pragma unroll
    for (int tt = 0; tt < 2; ++tt)
#pragma unroll
      for (int g = 0; g < 4; ++g) {
        f4v v = {a[ntl][tt][4 * g], a[ntl][tt][4 * g + 1], a[ntl][tt][4 * g + 2], a[ntl][tt][4 * g + 3]};
        ssq[tt] += v[0] * v[0] + v[1] * v[1] + v[2] * v[2] + v[3] * v[3];
        *(f4v*)(dst + (size_t)(32 * tt + r) * DM + f0 + 32 * ntl + 8 * g + 4 * h) = v;
      }
  asm volatile("" : "+v"(ssq[0]), "+v"(ssq[1]));
}

DI void acc_to_scratch(u16* scr, const f16v (&a)[2][2], int f0, int lane, float s0, float s1) {
  const int r = lane & 31, h = lane >> 5;
#pragma unroll
  for (int ntl = 0; ntl < 2; ++ntl)
#pragma unroll
    for (int tt = 0; tt < 2; ++tt)
#pragma unroll
      for (int g = 0; g < 4; ++g) {
        const float sc = tt ? s1 : s0;
        f4v v = {a[ntl][tt][4 * g] * sc, a[ntl][tt][4 * g + 1] * sc, a[ntl][tt][4 * g + 2] * sc, a[ntl][tt][4 * g + 3] * sc};
        *(bf4*)(scr + (size_t)(32 * tt + r) * 1024 + f0 + 32 * ntl + 8 * g + 4 * h) = cvt4(v);
      }
}
typedef __attribute__((ext_vector_type(4))) unsigned u4v;
DI void scratch_to_lds(const u16* scr, char* ldsA, int tid) {
  asm volatile("" : "+v"(tid));
  const unsigned toff = (unsigned)tid * 16u;
#pragma unroll
  for (int half = 0; half < 2; ++half) {
    u4v v[8];
#pragma unroll
    for (int it = 0; it < 8; ++it)
      v[it] = __builtin_nontemporal_load((const u4v*)((const char*)scr + (size_t)(8192 * (8 * half + it)) + toff));
#pragma unroll
    for (int it = 0; it < 8; ++it) {
      const int idx = tid + 512 * (8 * half + it), row = idx >> 7, ch = idx & 127;
      *(u4v*)(ldsA + row * LDS_ROW + ch * 16) = v[it];
    }
  }
}

struct Pk { bf4 v[2][2][4]; };
DI void pack_acc(Pk& pk, const f16v (&a)[2][2], float s0, float s1) {
#pragma unroll
  for (int ntl = 0; ntl < 2; ++ntl)
#pragma unroll
    for (int tt = 0; tt < 2; ++tt)
#pragma unroll
      for (int g = 0; g < 4; ++g) {
        const float sc = tt ? s1 : s0;
        f4v v = {a[ntl][tt][4 * g] * sc, a[ntl][tt][4 * g + 1] * sc, a[ntl][tt][4 * g + 2] * sc, a[ntl][tt][4 * g + 3] * sc};
        unsigned long long u = __builtin_bit_cast(unsigned long long, cvt4(v));
        asm volatile("" : "+v"(u));
        pk.v[ntl][tt][g] = __builtin_bit_cast(bf4, u);
      }
}
DI void pk_to_lds(char* ldsA, const Pk& pk, int f0, int lane) {
  const int r = lane & 31, h = lane >> 5;
#pragma unroll
  for (int ntl = 0; ntl < 2; ++ntl)
#pragma unroll
    for (int tt = 0; tt < 2; ++tt)
#pragma unroll
      for (int g = 0; g < 4; ++g)
        *(bf4*)(ldsA + (32 * tt + r) * LDS_ROW + (f0 + 32 * ntl + 8 * g + 4 * h) * 2) = pk.v[ntl][tt][g];
}

DI void rms_from_partials(float* red, int wave, int lane, const float (&ssq)[2], float& rs0, float& rs1) {
  red[(wave * 2 + 0) * 64 + lane] = ssq[0];
  red[(wave * 2 + 1) * 64 + lane] = ssq[1];
  __syncthreads();
  const int r = lane & 31;
  float t0 = 0.f, t1 = 0.f;
#pragma unroll
  for (int w = 0; w < 8; ++w) {
    t0 += red[(w * 2 + 0) * 64 + r] + red[(w * 2 + 0) * 64 + 32 + r];
    t1 += red[(w * 2 + 1) * 64 + r] + red[(w * 2 + 1) * 64 + 32 + r];
  }
  rs0 = rsqrtf(t0 * (1.0f / DM) + EPSV);
  rs1 = rsqrtf(t1 * (1.0f / DM) + EPSV);
}

template <bool WRITE = true>
DI void mem_attn(const MKParams& p, char* ldsA, int b, int wave, int lane) {
  char* ws = p.ws;
  const int r = lane & 31, h = lane >> 5;
  const int hm = wave >> 1, tt = wave & 1;
  const char* KM = ws + OFF_KM + (size_t)(b * 4 + hm) * 256 * 256 * 2;
  const char* VMT = ws + OFF_VMT + (size_t)(b * 4 + hm) * 256 * 256 * 2;
  char* qrow = ldsA + (32 * tt + r) * LDS_ROW + hm * 512;
  const unsigned loff = (unsigned)((r * 256 + 8 * h) * 2);
  f16v s[8];
#pragma unroll
  for (int mt = 0; mt < 8; ++mt) s[mt] = zero16();
  bf8 ka[8], kb[8];
#pragma unroll
  for (int mt = 0; mt < 8; ++mt) ka[mt] = *(const bf8*)(KM + (size_t)(mt * 32 * 256 * 2) + loff);
  bf8 qa = *(const bf8*)(qrow + 8 * h * 2), qb;
#pragma unroll 1
  for (int ks = 0; ks < 16; ks += 2) {
#if ATTN_LOCKSTEP
    __builtin_amdgcn_s_barrier();
#endif
#pragma unroll
    for (int mt = 0; mt < 8; ++mt) kb[mt] = *(const bf8*)(KM + (size_t)((mt * 32 * 256 + 16 * (ks + 1)) * 2) + loff);
    qb = *(const bf8*)(qrow + (16 * (ks + 1) + 8 * h) * 2);
#pragma unroll
    for (int mt = 0; mt < 8; ++mt) s[mt] = MFMA(ka[mt], qa, s[mt]);
    __builtin_amdgcn_sched_group_barrier(0x020, 8, 0);
    __builtin_amdgcn_sched_group_barrier(0x100, 1, 0);
    __builtin_amdgcn_sched_group_barrier(0x008, 8, 0);
    if (ks + 2 < 16) {
#pragma unroll
      for (int mt = 0; mt < 8; ++mt) ka[mt] = *(const bf8*)(KM + (size_t)((mt * 32 * 256 + 16 * (ks + 2)) * 2) + loff);
      qa = *(const bf8*)(qrow + (16 * (ks + 2) + 8 * h) * 2);
    }
#pragma unroll
    for (int mt = 0; mt < 8; ++mt) s[mt] = MFMA(kb[mt], qb, s[mt]);
    __builtin_amdgcn_sched_group_barrier(0x020, 8, 0);
    __builtin_amdgcn_sched_group_barrier(0x100, 1, 0);
    __builtin_amdgcn_sched_group_barrier(0x008, 8, 0);
  }
  float mx = -INFINITY;
#pragma unroll
  for (int mt = 0; mt < 8; ++mt)
#pragma unroll
    for (int i = 0; i < 16; ++i) mx = fmaxf(mx, s[mt][i]);
  mx = fmaxf(mx, __shfl_xor(mx, 32));
  float l = 0.f;
  bf8 pf[8][2];
#pragma unroll
  for (int mt = 0; mt < 8; ++mt) {
#pragma unroll
    for (int i = 0; i < 16; ++i) { s[mt][i] = __expf(s[mt][i] - mx); l += s[mt][i]; }
    pf[mt][0] = pack8(s[mt], 0);
    pf[mt][1] = pack8(s[mt], 1);
  }
  l += __shfl_xor(l, 32);
  const float inv = 1.0f / l;
#pragma unroll
  for (int grp = 0; grp < 2; ++grp) {
    f16v o[4];
#pragma unroll
    for (int m4 = 0; m4 < 4; ++m4) o[m4] = zero16();
    const char* vb = VMT + (size_t)(grp * 4 * 32 * 256 * 2) + loff;
    bf8 va[4], vn[4];
#pragma unroll
    for (int m4 = 0; m4 < 4; ++m4) va[m4] = *(const bf8*)(vb + (size_t)(m4 * 32 * 256 * 2));
#pragma unroll
    for (int st = 0; st < 16; ++st) {
#if ATTN_LOCKSTEP
      if ((st & 1) == 0) __builtin_amdgcn_s_barrier();
#endif
      if (st + 1 < 16) {
#pragma unroll
        for (int m4 = 0; m4 < 4; ++m4) vn[m4] = *(const bf8*)(vb + (size_t)((m4 * 32 * 256 + 16 * (st + 1)) * 2));
      }
#pragma unroll
      for (int m4 = 0; m4 < 4; ++m4) o[m4] = MFMA(va[m4], pf[st >> 1][st & 1], o[m4]);
      if (st + 1 < 16) {
        __builtin_amdgcn_sched_group_barrier(0x020, 4, 0);
        __builtin_amdgcn_sched_group_barrier(0x008, 4, 0);
#pragma unroll
        for (int m4 = 0; m4 < 4; ++m4) va[m4] = vn[m4];
      }
    }
#pragma unroll
    for (int m4 = 0; m4 < 4; ++m4)
#pragma unroll
      for (int g = 0; g < 4; ++g) {
        f4v v = {o[m4][4 * g] * inv, o[m4][4 * g + 1] * inv, o[m4][4 * g + 2] * inv, o[m4][4 * g + 3] * inv};
        if (WRITE || v[0] == 123.456f) *(bf4*)(qrow + (32 * (4 * grp + m4) + 8 * g + 4 * h) * 2) = cvt4(v);
      }
  }
}

DI void phase_c_tile(const MKParams& p, int tile, int wave, int lane, float& rs0, float& rs1, RingC& rg) {
  asm volatile("" : "+v"(lane));
  char* ws = p.ws;
  char* ldsA = smem;
  float* red = (float*)(smem + LDS_A_BYTES);
  const size_t tok0 = (size_t)tile * 64;
  const int tid = wave * 64 + lane;
  __syncthreads();
#if W8
  ring8_fill(rg, (const uint4*)(ws + OFF_WOUT) + 2 * wave * 64, lane);
#else
  ring_fill(rg, (const bf8*)(ws + OFF_WOUT) + 2 * wave * 64, lane);
#endif
  const unsigned pf0 = l2_touch(ws + OFF_WOUT, lane), pf1 = l2_touch(ws + OFF_WOUT + 1048576, lane);
#if PROBE == 15
  gla_g3_tile(p, tile, wave, lane, ldsA, LDS_ROW);
  __builtin_amdgcn_sched_barrier(0);
  asm volatile("" : "+v"(lane));
#endif
  {
  gla_g3_tile(p, tile, wave, lane, ldsA, LDS_ROW);
  {
    const char* osb = ws + OFF_OSB + tok0 * 1024;
#pragma unroll
    for (int it = 0; it < 8; ++it) {
      const int idx = tid + 512 * it, row = idx >> 6, ch = idx & 63;
      *(uint4*)(ldsA + row * LDS_ROW + 1024 + ch * 16) = *(const uint4*)(osb + (size_t)row * 1024 + ch * 16);
    }
  }
  }
  __syncthreads();
  l2_sink(pf0); l2_sink(pf1);
  f16v acc[2][2];
  Pk pk0, pk1;
  float* hdst = p.out + tok0 * DM;
#if W8
  const float* csb = (const float*)(ws + OFF_CS);
  const float* icsb = (const float*)(ws + OFF_ICS);
  {
    float ssq[2] = {0.f, 0.f};
    const uint4* wf = (const uint4*)(ws + OFF_WOUT);
    asm volatile("" : "+v"(lane));
    gemm_chunk_w8<true, true, false, true, false>(ldsA, wf + 2 * wave * 64, wf + 32768 + 2 * wave * 64, lane, acc, rg, p.x + tok0 * DM + 64 * wave, icsb + 4096 + 64 * wave);
    scale_cols(acc, csb + 4096 + 64 * wave, lane);
    store_f32_ssq(acc, hdst, 64 * wave, lane, ssq);
    pack_acc(pk0, acc, 1.f, 1.f);
    asm volatile("" : "+v"(lane));
    gemm_chunk_w8<true, true, false, true, true>(ldsA, wf + 32768 + 2 * wave * 64, (const uint4*)(ws + OFF_WMQ) + 2 * wave * 64, lane, acc, rg, p.x + tok0 * DM + 512 + 64 * wave, icsb + 4096 + 512 + 64 * wave);
    scale_cols(acc, csb + 4096 + 512 + 64 * wave, lane);
    store_f32_ssq(acc, hdst, 512 + 64 * wave, lane, ssq);
    pack_acc(pk1, acc, 1.f, 1.f);
    rms_from_partials(red, wave, lane, ssq, rs0, rs1);
  }
  pk_to_lds(ldsA, pk0, 64 * wave, lane);
  pk_to_lds(ldsA, pk1, 512 + 64 * wave, lane);
  __syncthreads();
  {
    const uint4* wf = (const uint4*)(ws + OFF_WMQ);
    asm volatile("" : "+v"(lane));
    gemm_chunk_w8<true, false, false, true, true>(ldsA, wf + 2 * wave * 64, wf + 32768 + 2 * wave * 64, lane, acc, rg);
    scale_cols(acc, csb + 8192 + 64 * wave, lane);
    pack_acc(pk0, acc, rs0, rs1);
    asm volatile("" : "+v"(lane));
    gemm_chunk_w8<true, false, false, false, true>(ldsA, wf + 32768 + 2 * wave * 64, nullptr, lane, acc, rg);
    scale_cols(acc, csb + 8192 + 512 + 64 * wave, lane);
    pack_acc(pk1, acc, rs0, rs1);
  }
  __syncthreads();
  pk_to_lds(ldsA, pk0, 64 * wave, lane);
  pk_to_lds(ldsA, pk1, 512 + 64 * wave, lane);
  __syncthreads();
  asm volatile("" : "+v"(lane));
  mem_attn<true>(p, ldsA, tile >> 5, wave, lane);
  __syncthreads();
  {
    float ssq[2] = {0.f, 0.f};
    const uint4* wf = (const uint4*)(ws + OFF_WMO);
    asm volatile("" : "+v"(lane));
    gemm_chunk_w8<true, true, true, true, false>(ldsA, wf + 2 * wave * 64, wf + 32768 + 2 * wave * 64, lane, acc, rg, hdst + 64 * wave, icsb + 12288 + 64 * wave);
    scale_cols(acc, csb + 12288 + 64 * wave, lane);
    store_f32_ssq(acc, hdst, 64 * wave, lane, ssq);
    pack_acc(pk0, acc, 1.f, 1.f);
    asm volatile("" : "+v"(lane));
    gemm_chunk_w8<true, true, false, true, true>(ldsA, wf + 32768 + 2 * wave * 64, (const uint4*)(ws + OFF_WPQ) + 2 * wave * 64, lane, acc, rg, hdst + 512 + 64 * wave, icsb + 12288 + 512 + 64 * wave);
    scale_cols(acc, csb + 12288 + 512 + 64 * wave, lane);
    store_f32_ssq(acc, hdst, 512 + 64 * wave, lane, ssq);
    pack_acc(pk1, acc, 1.f, 1.f);
    rms_from_partials(red, wave, lane, ssq, rs0, rs1);
  }
  pk_to_lds(ldsA, pk0, 64 * wave, lane);
  pk_to_lds(ldsA, pk1, 512 + 64 * wave, lane);
  __syncthreads();
}
#else
  {
    float ssq[2] = {0.f, 0.f};
    const bf8* wf = (const bf8*)(ws + OFF_WOUT);
    asm volatile("" : "+v"(lane));
    { const unsigned pf = l2_touch(ws + OFF_WMQ, lane);
    gemm_chunk_r<true, true, false, true>(ldsA, wf + 2 * wave * 64, wf + 65536 + 2 * wave * 64, lane, acc, rg, p.x + tok0 * DM + 64 * wave);
      l2_sink(pf); }
    store_f32_ssq(acc, hdst, 64 * wave, lane, ssq);
    pack_acc(pk0, acc, 1.f, 1.f);
    asm volatile("" : "+v"(lane));
    { const unsigned pf = l2_touch(ws + OFF_WMQ + 1048576, lane);
    gemm_chunk_r<true, true, false, true>(ldsA, wf + 65536 + 2 * wave * 64, (const bf8*)(ws + OFF_WMQ) + 2 * wave * 64, lane, acc, rg, p.x + tok0 * DM + 512 + 64 * wave);
      l2_sink(pf); }
    store_f32_ssq(acc, hdst, 512 + 64 * wave, lane, ssq);
    pack_acc(pk1, acc, 1.f, 1.f);
    rms_from_partials(red, wave, lane, ssq, rs0, rs1);
  }
  pk_to_lds(ldsA, pk0, 64 * wave, lane);
  pk_to_lds(ldsA, pk1, 512 + 64 * wave, lane);
  __syncthreads();
  {
    const bf8* wf = (const bf8*)(ws + OFF_WMQ);
    asm volatile("" : "+v"(lane));
    { const unsigned pf = l2_touch(ws + OFF_WMO, lane);
    gemm_chunk_r<true, false, false, true>(ldsA, wf + 2 * wave * 64, wf + 65536 + 2 * wave * 64, lane, acc, rg);
      l2_sink(pf); }
    pack_acc(pk0, acc, rs0, rs1);
    asm volatile("" : "+v"(lane));
    { const unsigned pf = l2_touch(ws + OFF_WMO + 1048576, lane);
    gemm_chunk_r<true, false, false, false>(ldsA, wf + 65536 + 2 * wave * 64, nullptr, lane, acc, rg);
      l2_sink(pf); }
    pack_acc(pk1, acc, rs0, rs1);
  }
  __syncthreads();
  pk_to_lds(ldsA, pk0, 64 * wave, lane);
  pk_to_lds(ldsA, pk1, 512 + 64 * wave, lane);
  __syncthreads();
#if PROBE == 22
  asm volatile("" : "+v"(lane));
  mem_attn<false>(p, ldsA, tile >> 5, wave, lane);
#endif
  asm volatile("" : "+v"(lane));
  mem_attn<true>(p, ldsA, tile >> 5, wave, lane);
  __syncthreads();
  {
    float ssq[2] = {0.f, 0.f};
    const bf8* wf = (const bf8*)(ws + OFF_WMO);
    asm volatile("" : "+v"(lane));
    { const unsigned pf = l2_touch(ws + OFF_WPQ, lane);
    gemm_chunk_r<true, true, true, true>(ldsA, wf + 2 * wave * 64, wf + 65536 + 2 * wave * 64, lane, acc, rg, hdst + 64 * wave);
      l2_sink(pf); }
    store_f32_ssq(acc, hdst, 64 * wave, lane, ssq);
    pack_acc(pk0, acc, 1.f, 1.f);
    asm volatile("" : "+v"(lane));
    { const unsigned pf = l2_touch(ws + OFF_WPQ + 1048576, lane);
    gemm_chunk_r<true, true, false, true>(ldsA, wf + 65536 + 2 * wave * 64, (const bf8*)(ws + OFF_WPQ) + 2 * wave * 64, lane, acc, rg, hdst + 512 + 64 * wave);
      l2_sink(pf); }
    store_f32_ssq(acc, hdst, 512 + 64 * wave, lane, ssq);
    pack_acc(pk1, acc, 1.f, 1.f);
    rms_from_partials(red, wave, lane, ssq, rs0, rs1);
  }
  pk_to_lds(ldsA, pk0, 64 * wave, lane);
  pk_to_lds(ldsA, pk1, 512 + 64 * wave, lane);
  __syncthreads();
}
#endif
#define OFF_EG (OFF_LKV + 16 * MiB)

DI unsigned f2ord(float v) { const unsigned u = __float_as_uint(v); return (u & 0x80000000u) ? ~u : (u | 0x80000000u); }
DI float ord2f(unsigned u) { return __uint_as_float((u & 0x80000000u) ? (u ^ 0x80000000u) : ~u); }

#define CEX(a, b) { const unsigned hi_ = max(k[a], k[b]); const unsigned lo_ = min(k[a], k[b]); k[a] = hi_; k[b] = lo_; }
DI void sort16_desc(unsigned (&k)[16]) {
  CEX(0, 1) CEX(2, 3) CEX(0, 2) CEX(1, 3) CEX(1, 2) CEX(4, 5) CEX(6, 7) CEX(4, 6) CEX(5, 7) CEX(5, 6) CEX(0, 4)
  CEX(2, 6) CEX(2, 4) CEX(1, 5) CEX(3, 7) CEX(3, 5) CEX(1, 2) CEX(3, 4) CEX(5, 6) CEX(8, 9) CEX(10, 11) CEX(8, 10)
  CEX(9, 11) CEX(9, 10) CEX(12, 13) CEX(14, 15) CEX(12, 14) CEX(13, 15) CEX(13, 14) CEX(8, 12) CEX(10, 14) CEX(10, 12)
  CEX(9, 13) CEX(11, 15) CEX(11, 13) CEX(9, 10) CEX(11, 12) CEX(13, 14) CEX(0, 8) CEX(4, 12) CEX(4, 8) CEX(2, 10)
  CEX(6, 14) CEX(6, 10) CEX(2, 4) CEX(6, 8) CEX(10, 12) CEX(1, 9) CEX(5, 13) CEX(5, 9) CEX(3, 11) CEX(7, 15) CEX(7, 11)
  CEX(3, 5) CEX(7, 9) CEX(11, 13) CEX(1, 2) CEX(3, 4) CEX(5, 6) CEX(7, 8) CEX(9, 10) CEX(11, 12) CEX(13, 14)
}
DI void merge_top16(unsigned (&t)[16], const unsigned (&u)[16]) {
#pragma unroll
  for (int s = 0; s < 16; ++s) t[s] = max(t[s], u[15 - s]);
#pragma unroll
  for (int d = 8; d > 0; d >>= 1)
#pragma unroll
    for (int i = 0; i < 16; ++i)
      if ((i & d) == 0) {
        const unsigned hi = max(t[i], t[i + d]), lo = min(t[i], t[i + d]);
        t[i] = hi; t[i + d] = lo;
      }
}

DI void ins16(unsigned (&L)[16], unsigned x) {
#pragma unroll
  for (int s = 0; s < 16; ++s) {
    const unsigned hi = max(L[s], x);
    x = min(L[s], x);
    L[s] = hi;
  }
}
DI void merge_halves16(unsigned (&L)[16]) {
  unsigned O[16];
#pragma unroll
  for (int s = 0; s < 16; ++s) O[s] = (unsigned)__shfl_xor((int)L[s], 32);
#pragma unroll
  for (int s = 0; s < 16; ++s) L[s] = max(L[s], O[15 - s]);
#pragma unroll
  for (int d = 8; d > 0; d >>= 1)
#pragma unroll
    for (int i = 0; i < 16; ++i)
      if ((i & d) == 0) {
        const unsigned hi = max(L[i], L[i + d]), lo = min(L[i], L[i + d]);
        L[i] = hi; L[i + d] = lo;
      }
}

DI void peer_top16(const char* ws, const u16* qp, int hp, int tt, int lane, unsigned (&L)[16]) {
  const int r = lane & 31, h = lane >> 5;
  const bf8* sk = (const bf8*)(ws + OFF_SUBK) + (size_t)hp * 4 * 8 * 64 + lane;
  f16v s[4];
#pragma unroll
  for (int mt = 0; mt < 4; ++mt) s[mt] = zero16();
  bf8 qf[8];
#pragma unroll
  for (int ks = 0; ks < 8; ++ks) qf[ks] = *(const bf8*)(qp + (size_t)(32 * tt + r) * 2048 + hp * 128 + 16 * ks + 8 * h);
#pragma unroll
  for (int half = 0; half < 2; ++half) {
    bf8 kf[4][4];
#pragma unroll
    for (int k4 = 0; k4 < 4; ++k4)
#pragma unroll
      for (int mt = 0; mt < 4; ++mt) kf[k4][mt] = sk[(mt * 8 + 4 * half + k4) * 64];
    __builtin_amdgcn_sched_barrier(0);
#pragma unroll
    for (int k4 = 0; k4 < 4; ++k4)
#pragma unroll
      for (int mt = 0; mt < 4; ++mt) s[mt] = MFMA(kf[k4][mt], qf[4 * half + k4], s[mt]);
    __builtin_amdgcn_sched_barrier(0);
  }
  unsigned K1[16], K2[16], K3[16];
#pragma unroll
  for (int i = 0; i < 16; ++i) {
    L[i] = (f2ord(s[0][i]) & ~127u) | (unsigned)(127 - (crow(i, h)));
    K1[i] = (f2ord(s[1][i]) & ~127u) | (unsigned)(127 - (32 + crow(i, h)));
    K2[i] = (f2ord(s[2][i]) & ~127u) | (unsigned)(127 - (64 + crow(i, h)));
    K3[i] = (f2ord(s[3][i]) & ~127u) | (unsigned)(127 - (96 + crow(i, h)));
  }
  sort16_desc(L); sort16_desc(K1); sort16_desc(K2); sort16_desc(K3);
  merge_top16(L, K1);
  merge_top16(K2, K3);
  merge_top16(L, K2);
  merge_halves16(L);
}

DI void peer_select(const char* ws, const u16* qp, uint2* eg, unsigned char* idxs  , int head,
                    int tt, int lane) {
  const int r = lane & 31, h = lane >> 5;
  unsigned La[16], Lb[16];
  peer_top16(ws, qp, 2 * head, tt, lane, La);
  __builtin_amdgcn_sched_barrier(0);
  peer_top16(ws, qp, 2 * head + 1, tt, lane, Lb);
  __builtin_amdgcn_sched_barrier(0);
  if (h == 0) {
#pragma unroll
    for (int g = 0; g < 4; ++g) {
      unsigned wa = 0, wb = 0;
#pragma unroll
      for (int j = 0; j < 4; ++j) {
        wa |= (127u - (La[4 * g + j] & 127u)) << (8 * j);
        wb |= (127u - (Lb[4 * g + j] & 127u)) << (8 * j);
      }
      *(unsigned*)(idxs + r * 32 + 4 * g) = wa;
      *(unsigned*)(idxs + r * 32 + 16 + 4 * g) = wb;
    }
  }
  float fa[16], fb[16];
#pragma unroll
  for (int i = 0; i < 16; ++i) { fa[i] = ord2f(La[i] & ~127u); fb[i] = ord2f(Lb[i] & ~127u); }
  unsigned C[16];
#pragma unroll
  for (int i = 0; i < 16; ++i) C[i] = (f2ord(fa[0] + fb[i]) & ~255u) | (unsigned)(255 - i);
#define PEER_CAND(a, b) ins16(C, (f2ord(fa[a] + fb[b]) & ~255u) | (unsigned)(255 - ((a) * 16 + (b))));
#define PEER_ROW1(a) PEER_CAND(a, 0)
#define PEER_ROW2(a) PEER_ROW1(a) PEER_CAND(a, 1)
#define PEER_ROW3(a) PEER_ROW2(a) PEER_CAND(a, 2)
#define PEER_ROW4(a) PEER_ROW3(a) PEER_CAND(a, 3)
#define PEER_ROW5(a) PEER_ROW4(a) PEER_CAND(a, 4)
#define PEER_ROW8(a) PEER_ROW5(a) PEER_CAND(a, 5) PEER_CAND(a, 6) PEER_CAND(a, 7)
#define PEER_ROW16(a) PEER_ROW8(a) PEER_CAND(a, 8) PEER_CAND(a, 9) PEER_CAND(a, 10) PEER_CAND(a, 11) PEER_CAND(a, 12) PEER_CAND(a, 13) PEER_CAND(a, 14) PEER_CAND(a, 15)
  PEER_ROW8(1) PEER_ROW5(2) PEER_ROW4(3) PEER_ROW3(4) PEER_ROW2(5) PEER_ROW2(6) PEER_ROW2(7)
  PEER_ROW1(8) PEER_ROW1(9) PEER_ROW1(10) PEER_ROW1(11) PEER_ROW1(12) PEER_ROW1(13) PEER_ROW1(14) PEER_ROW1(15)
  asm volatile("s_waitcnt lgkmcnt(0)" ::: "memory");
  const float vmax = ord2f(C[0] & ~255u);
  float ex[16], sum = 0.f;
#pragma unroll
  for (int i = 0; i < 16; ++i) { ex[i] = __expf(ord2f(C[i] & ~255u) - vmax); sum += ex[i]; }
  const float inv = 1.0f / sum;
  const unsigned hmask = 0u - (unsigned)h;
#pragma unroll
  for (int i = 0; i < 8; ++i) {
    const unsigned ck = C[i] ^ ((C[i] ^ C[8 + i]) & hmask);
    const unsigned gb = __float_as_uint(ex[i]) ^ ((__float_as_uint(ex[i]) ^ __float_as_uint(ex[8 + i])) & hmask);
    const float g = __uint_as_float(gb) * inv;
    const unsigned code = 255u - (ck & 255u);
    const unsigned ia = idxs[r * 32 + (code >> 4)], ib = idxs[r * 32 + 16 + (code & 15u)];
    eg[(size_t)(32 * tt + r) * 128 + head * 16 + 8 * h + i] = make_uint2(ia * 128u + ib, __float_as_uint(g));
  }
  asm volatile("s_waitcnt lgkmcnt(0)" ::: "memory");
}

DI float wave_sum(float v) {
#pragma unroll
  for (int o = 32; o > 0; o >>= 1) v += __shfl_xor(v, o);
  return v;
}

DI void reduce8(const int (&pv)[8], int& s0, int& s1) {
  int q[4], s[2];
#pragma unroll
  for (int m = 0; m < 4; ++m) {
    const auto r = __builtin_amdgcn_permlane32_swap((unsigned)pv[m], (unsigned)pv[m + 4], false, false);
    q[m] = (int)(r[0] + r[1]);
  }
#pragma unroll
  for (int m = 0; m < 2; ++m) {
    const auto r = __builtin_amdgcn_permlane16_swap((unsigned)q[m], (unsigned)q[m + 2], false, false);
    s[m] = (int)(r[0] + r[1]);
  }
#pragma unroll
  for (int m = 0; m < 2; ++m) {
    s[m] += __builtin_amdgcn_update_dpp(0, s[m], 0x128, 0xf, 0xf, false);
    s[m] += __builtin_amdgcn_update_dpp(0, s[m], 0x124, 0xf, 0xf, false);
    s[m] += __builtin_amdgcn_update_dpp(0, s[m], 0x122, 0xf, 0xf, false);
    s[m] += __builtin_amdgcn_update_dpp(0, s[m], 0x121, 0xf, 0xf, false);
  }
  s0 = s[0]; s1 = s[1];
}

DI void peer_quant_x(char* ldsA, int wave, int lane, float (&xdq)[8]) {
#pragma unroll
  for (int i = 0; i < 8; ++i) {
    char* xrow = ldsA + (8 * wave + i) * LDS_ROW;
    const uint4 x0 = *(const uint4*)(xrow + 32 * lane), x1 = *(const uint4*)(xrow + 32 * lane + 16);
    const unsigned xr[8] = {x0.x, x0.y, x0.z, x0.w, x1.x, x1.y, x1.z, x1.w};
    float f[16];
    float am = 0.f;
#pragma unroll
    for (int q = 0; q < 8; ++q) {
      f[2 * q] = __uint_as_float(xr[q] << 16);
      f[2 * q + 1] = __uint_as_float(xr[q] & 0xffff0000u);
      am = fmaxf(am, fmaxf(fabsf(f[2 * q]), fabsf(f[2 * q + 1])));
    }
#pragma unroll
    for (int o = 32; o > 0; o >>= 1) am = fmaxf(am, __shfl_xor(am, o));
    const float sc = (am > 0.f) ? 127.0f / am : 0.f;
    unsigned w[4];
#pragma unroll
    for (int q = 0; q < 4; ++q) {
      unsigned pk = 0;
#pragma unroll
      for (int j = 0; j < 4; ++j) pk |= ((unsigned)((int)rintf(f[4 * q + j] * sc)) & 0xffu) << (8 * j);
      w[q] = pk;
    }
    asm volatile("s_waitcnt lgkmcnt(0)" ::: "memory");
    *(uint4*)(xrow + 16 * lane) = make_uint4(w[0], w[1], w[2], w[3]);
    xdq[i] = am * (1.0f / 127.0f);
  }
  asm volatile("s_waitcnt lgkmcnt(0)" ::: "memory");
}

DI void peer_bucket_token(const uint2* egt, unsigned* tmp  , int lane, unsigned& E0, unsigned& E1,
                          unsigned& G0, unsigned& G1) {
  const uint2 a = egt[lane], b = egt[64 + lane];
  const int ba = (int)(a.x >> SWEEP_SH), bb = (int)(b.x >> SWEEP_SH);
  const unsigned long long lt = (1ull << lane) - 1ull;
  int da = 0, db = 0, start = 0;
#pragma unroll
  for (int k = 0; k < SWEEP_NB; ++k) {
    const unsigned long long ma = __ballot(ba == k), mb = __ballot(bb == k);
    const int ca = __popcll(ma), cb = __popcll(mb);
    if (ba == k) da = start + __popcll(ma & lt);
    if (bb == k) db = start + ca + __popcll(mb & lt);
    start += ca + cb;
  }
  const int ia = (da & 1) * 64 + (da >> 3) + 16 * ((da >> 1) & 3);
  const int ib = (db & 1) * 64 + (db >> 3) + 16 * ((db >> 1) & 3);
  tmp[ia] = a.x; tmp[128 + ia] = a.y;
  tmp[ib] = b.x; tmp[128 + ib] = b.y;
  asm volatile("s_waitcnt lgkmcnt(0)" ::: "memory");
  E0 = tmp[lane]; E1 = tmp[64 + lane]; G0 = tmp[128 + lane]; G1 = tmp[192 + lane];
  asm volatile("s_waitcnt lgkmcnt(0)" ::: "memory");
}

template <bool GWRITE = true>
DI void peer_finalize_token(const MKParams& p, float (&acc)[16], size_t tok, int lane) {
  float* orow = p.out + tok * DM + 16 * lane;
  float ss = 0.f;
#pragma unroll
  for (int q = 0; q < 4; ++q) {
    const f4v hv = *(const f4v*)(orow + 4 * q);
#pragma unroll
    for (int j = 0; j < 4; ++j) { acc[4 * q + j] += hv[j]; ss += acc[4 * q + j] * acc[4 * q + j]; }
  }
  ss = wave_sum(ss);
  const float rf = rsqrtf(ss * (1.0f / DM) + EPSV);
#pragma unroll
  for (int q = 0; q < 4; ++q) {
    const f4v gg = *(const f4v*)(p.g_fin + 16 * lane + 4 * q);
    f4v o = {acc[4 * q] * rf * gg[0], acc[4 * q + 1] * rf * gg[1], acc[4 * q + 2] * rf * gg[2], acc[4 * q + 3] * rf * gg[3]};
    if (GWRITE || o[0] == 123.456f) *(f4v*)(orow + 4 * q) = o;
  }
}

DI void peer_usweep(const char* ws, const char* ldsA, int wave, int lane, const unsigned (&E)[8][2], int (&A)[8][2]) {
  const char* PU = ws + OFF_PU + 16 * lane;
#pragma unroll
  for (int i = 0; i < 8; ++i) { A[i][0] = 0; A[i][1] = 0; }
  int jn[8];
#pragma unroll
  for (int i = 0; i < 8; ++i) jn[i] = 0;
#pragma unroll 1
  for (int k = 0; k < SWEEP_NB; ++k) {
#pragma unroll
    for (int i = 0; i < 8; ++i) {
      while (jn[i] < 16 && (__builtin_amdgcn_readlane((int)E[i][0], jn[i]) >> SWEEP_SH) <= k) {
        const int j = jn[i];
        const bool sel = ((lane & 15) == j);
        const uint4 xq = *(const uint4*)(ldsA + (8 * wave + i) * LDS_ROW + 16 * lane);
        uint4 u0[8];
#pragma unroll
        for (int m = 0; m < 8; ++m) {
          const int e = __builtin_amdgcn_readlane((int)E[i][m & 1], j + 16 * (m >> 1));
          u0[m] = *(const uint4*)(PU + (size_t)e * 1024);
        }
        int pv[8];
#pragma unroll
        for (int m = 0; m < 8; ++m) {
          int dsum = __builtin_amdgcn_sdot4((int)u0[m].x, (int)xq.x, 0, false);
          dsum = __builtin_amdgcn_sdot4((int)u0[m].y, (int)xq.y, dsum, false);
          dsum = __builtin_amdgcn_sdot4((int)u0[m].z, (int)xq.z, dsum, false);
          dsum = __builtin_amdgcn_sdot4((int)u0[m].w, (int)xq.w, dsum, false);
          pv[m] = dsum;
        }
        int s0, s1;
        reduce8(pv, s0, s1);
        A[i][0] = sel ? s0 : A[i][0];
        A[i][1] = sel ? s1 : A[i][1];
        jn[i] = j + 1;
      }
    }
  }
}

#ifndef VT
#define VT 8
#endif
template <int T0, bool GWRITE = true>
DI void peer_vsweep(const MKParams& p, int wave, int lane, size_t tok0, const unsigned (&E)[8][2], const unsigned (&WQ)[8],
                    const float (&tsc)[8]) {
  const char* PV = p.ws + OFF_PV + 16 * lane;
  int acc[VT][16];
#pragma unroll
  for (int i = 0; i < VT; ++i)
#pragma unroll
    for (int q = 0; q < 16; ++q) acc[i][q] = 0;
  int jn[VT];
#pragma unroll
  for (int i = 0; i < VT; ++i) jn[i] = 0;
#pragma unroll 1
  for (int k = 0; k < SWEEP_NB; ++k) {
#pragma unroll
    for (int i = 0; i < VT; ++i) {
      while (jn[i] < 16 && (__builtin_amdgcn_readlane((int)E[T0 + i][0], jn[i]) >> SWEEP_SH) <= k) {
        const int j = jn[i];
        uint4 v0[8];
#pragma unroll
        for (int m = 0; m < 8; ++m) {
          const int e = __builtin_amdgcn_readlane((int)E[T0 + i][m & 1], j + 16 * (m >> 1));
          v0[m] = *(const uint4*)(PV + (size_t)e * 1024);
        }
        const int wq0 = __builtin_amdgcn_readlane((int)WQ[T0 + i], j);
        const int wq1 = __builtin_amdgcn_readlane((int)WQ[T0 + i], j + 32);
#pragma unroll
        for (int rq = 0; rq < 2; ++rq) {
          const int wq = rq ? wq1 : wq0;
          const unsigned r0[4] = {v0[4 * rq].x, v0[4 * rq].y, v0[4 * rq].z, v0[4 * rq].w};
          const unsigned r1[4] = {v0[4 * rq + 1].x, v0[4 * rq + 1].y, v0[4 * rq + 1].z, v0[4 * rq + 1].w};
          const unsigned r2[4] = {v0[4 * rq + 2].x, v0[4 * rq + 2].y, v0[4 * rq + 2].z, v0[4 * rq + 2].w};
          const unsigned r3[4] = {v0[4 * rq + 3].x, v0[4 * rq + 3].y, v0[4 * rq + 3].z, v0[4 * rq + 3].w};
#pragma unroll
          for (int q = 0; q < 4; ++q) {
            const unsigned ta = __builtin_amdgcn_perm(r1[q], r0[q], 0x05010400);
            const unsigned tb = __builtin_amdgcn_perm(r1[q], r0[q], 0x07030602);
            const unsigned tc = __builtin_amdgcn_perm(r3[q], r2[q], 0x05010400);
            const unsigned td = __builtin_amdgcn_perm(r3[q], r2[q], 0x07030602);
            acc[i][4 * q] = __builtin_amdgcn_sdot4((int)__builtin_amdgcn_perm(tc, ta, 0x05040100), wq, acc[i][4 * q], false);
            acc[i][4 * q + 1] = __builtin_amdgcn_sdot4((int)__builtin_amdgcn_perm(tc, ta, 0x07060302), wq, acc[i][4 * q + 1], false);
            acc[i][4 * q + 2] = __builtin_amdgcn_sdot4((int)__builtin_amdgcn_perm(td, tb, 0x05040100), wq, acc[i][4 * q + 2], false);
            acc[i][4 * q + 3] = __builtin_amdgcn_sdot4((int)__builtin_amdgcn_perm(td, tb, 0x07060302), wq, acc[i][4 * q + 3], false);
          }
        }
        jn[i] = j + 1;
      }
    }
  }
#pragma unroll
  for (int i = 0; i < VT; ++i) {
    float accf[16];
#pragma unroll
    for (int q = 0; q < 16; ++q) accf[q] = (float)acc[i][q] * tsc[T0 + i];
    peer_finalize_token<GWRITE>(p, accf, tok0 + 8 * wave + T0 + i, lane);
  }
}

DI void phase_d_tile(const MKParams& p, int tile, int wave, int lane, float rs0, float rs1, RingC& rg) {
  asm volatile("" : "+v"(lane));
  char* ws = p.ws;
  char* ldsA = smem;
  float* rs_s = (float*)(smem + LDS_A_BYTES);
  unsigned char* idxs = (unsigned char*)(smem + LDS_A_BYTES + 4096) + wave * 1024;
  u16* qp = (u16*)qp_scratch(ws, blockIdx.x);
  uint2* eg = (uint2*)(ws + OFF_EG + (size_t)blockIdx.x * 65536);
  const size_t tok0 = (size_t)tile * 64;
  if (wave == 0) { if (lane < 32) rs_s[lane] = rs0; else rs_s[lane] = rs1; }
  {
    f16v acc[2][2];
    const bf8* wf = (const bf8*)(ws + OFF_WPQ);
#if PROBE == 17
    for (int rep_ = 0; rep_ < 2; ++rep_)
#endif
#pragma unroll 1
    for (int c = 0; c < 4; ++c) {
      int l2 = lane;
      asm volatile("" : "+v"(l2));
      const int r = l2 & 31, h = l2 >> 5;
#if W8
      {
        const uint4* w8 = (const uint4*)(ws + OFF_WPQ);
        if (c < 3) gemm_chunk_w8<true, false, false, true, true>(ldsA, w8 + (size_t)c * 32768 + 2 * wave * 64, w8 + (size_t)(c + 1) * 32768 + 2 * wave * 64, l2, acc, rg);
        else gemm_chunk_w8<true, false, false, false, true>(ldsA, w8 + (size_t)c * 32768 + 2 * wave * 64, nullptr, l2, acc, rg);
        scale_cols(acc, (const float*)(ws + OFF_CS) + 16384 + 512 * c + 64 * wave, l2);
      }
#else
      if (c == 0) gemm_chunk_r<true, false, false, true>(ldsA, wf + 2 * wave * 64, wf + 65536 + 2 * wave * 64, l2, acc, rg);
      else if (c < 3) gemm_chunk_r<true, false, false, true>(ldsA, wf + (size_t)c * 65536 + 2 * wave * 64, wf + (size_t)(c + 1) * 65536 + 2 * wave * 64, l2, acc, rg);
      else gemm_chunk_r<true, false, false, false>(ldsA, wf + (size_t)c * 65536 + 2 * wave * 64, nullptr, l2, acc, rg);
#endif
#pragma unroll
      for (int ntl = 0; ntl < 2; ++ntl)
#pragma unroll
        for (int tt = 0; tt < 2; ++tt)
#pragma unroll
          for (int g = 0; g < 4; ++g) {
            const float sc = tt ? rs1 : rs0;
            f4v v = {acc[ntl][tt][4 * g] * sc, acc[ntl][tt][4 * g + 1] * sc, acc[ntl][tt][4 * g + 2] * sc, acc[ntl][tt][4 * g + 3] * sc};
            *(bf4*)(qp + (size_t)(32 * tt + r) * 2048 + 512 * c + 64 * wave + 32 * ntl + 8 * g + 4 * h) = cvt4(v);
          }
    }
  }
  __syncthreads();
#if PROBE == 16
  for (int rep_ = 0; rep_ < 2; ++rep_)
#endif
#pragma unroll 1
  for (int tt = 0; tt < 2; ++tt) {
    int l2 = lane;
    asm volatile("" : "+v"(l2));
    peer_select(ws, qp, eg, idxs, wave, tt, l2);
  }
  __syncthreads();
}

template <bool GWRITE = true>
DI void phase_d_gather(const MKParams& p, int tile, int wave, int lane) {
  asm volatile("" : "+v"(lane));
  char* ws = p.ws;
  char* ldsA = smem;
  float* rs_s = (float*)(smem + LDS_A_BYTES);
  unsigned char* idxs = (unsigned char*)(smem + LDS_A_BYTES + 4096) + wave * 1024;
  const uint2* eg = (const uint2*)(ws + OFF_EG + (size_t)blockIdx.x * 65536);
  const size_t tok0 = (size_t)tile * 64;
  {
    int l2 = lane;
    asm volatile("" : "+v"(l2));
    unsigned E[8][2], G[8][2];
#pragma unroll
    for (int i = 0; i < 8; ++i)
      peer_bucket_token(eg + (size_t)(8 * wave + i) * 128, (unsigned*)idxs, l2, E[i][0], E[i][1], G[i][0], G[i][1]);
    float xdq[8];
    peer_quant_x(ldsA, wave, l2, xdq);
    int A[8][2];
#if PROBE == 60
    peer_usweep(ws, ldsA, wave, l2, E, A);
    asm volatile("" :: "v"(A[0][0]), "v"(A[0][1]), "v"(A[1][0]), "v"(A[1][1]), "v"(A[2][0]), "v"(A[2][1]), "v"(A[3][0]), "v"(A[3][1]), "v"(A[4][0]), "v"(A[4][1]), "v"(A[5][0]), "v"(A[5][1]), "v"(A[6][0]), "v"(A[6][1]), "v"(A[7][0]), "v"(A[7][1]));
#endif
    peer_usweep(ws, ldsA, wave, l2, E, A);
    unsigned WQ[8];
    float tsc[8];
#pragma unroll
    for (int i = 0; i < 8; ++i) {
      const float rs = rs_s[8 * wave + i];
      float w[2];
#pragma unroll
      for (int cc = 0; cc < 2; ++cc) {
        const float a = (float)A[i][cc] * (rs * xdq[i]) * ((const float*)(ws + OFF_SU))[E[i][cc]];
        w[cc] = __uint_as_float(G[i][cc]) * 0.5f * a * (1.0f + erff(a * 0.70710678118654752f)) *
                ((const float*)(ws + OFF_SV))[E[i][cc]];
      }
      float wm = fmaxf(fabsf(w[0]), fabsf(w[1]));
#pragma unroll
      for (int o = 32; o > 0; o >>= 1) wm = fmaxf(wm, __shfl_xor(wm, o));
      const float sc = (wm > 0.f) ? 127.0f / wm : 0.f;
      tsc[i] = wm * (1.0f / 127.0f);
      const unsigned pr = ((unsigned)((int)rintf(w[0] * sc)) & 0xffu) | (((unsigned)((int)rintf(w[1] * sc)) & 0xffu) << 8);
      const unsigned up = (unsigned)__shfl((int)pr, (l2 + 16) & 63);
      WQ[i] = pr | (up << 16);
    }
    __builtin_amdgcn_sched_barrier(0);
    peer_vsweep<0, GWRITE>(p, wave, l2, tok0, E, WQ, tsc);
#if VT == 4
    __builtin_amdgcn_sched_barrier(0);
    peer_vsweep<4, GWRITE>(p, wave, l2, tok0, E, WQ, tsc);
#endif
  }
}
#ifndef REMAP
#define REMAP 1
#endif
DI int tile_of(int blk, int nblk) { return (REMAP && nblk == 256) ? ((blk & 7) * 32 + (blk >> 3)) : blk; }

__global__ __launch_bounds__(512) void mk(MKParams p) {
  cg::grid_group grid = cg::this_grid();
  const int tid = threadIdx.x;
  const int wave = __builtin_amdgcn_readfirstlane(tid >> 6), lane = tid & 63;
  const int gtid = blockIdx.x * 512 + tid, gthreads = gridDim.x * 512;
  const int gw = blockIdx.x * 8 + wave, nw = gridDim.x * 8;
  unsigned* bar = (unsigned*)(p.ws + OFF_BAR);
  phase_prep(p, gtid, gthreads);
  if (blockIdx.x < 256) load_norm_tile(p.x + (size_t)tile_of(blockIdx.x, gridDim.x) * 64 * DM, smem, wave, lane);
#if FIRST_CG == 1
  if (blockIdx.x == 0 && tid < 16) __hip_atomic_store(bar + tid, 0u, __ATOMIC_RELAXED, __HIP_MEMORY_SCOPE_AGENT);
  grid.sync();
#elif FIRST_CG == 2
  if (p.ws == nullptr) grid.sync();
  grid_barrier(bar, 1u * gridDim.x);
#else
  grid_barrier(bar, 1u * gridDim.x);
#endif
  if (blockIdx.x < 256) { phase_a_tile<true, (TABLES_IN_B == 3)>(p, tile_of(blockIdx.x, gridDim.x), wave, lane); __syncthreads(); gla_g1_tile(p, tile_of(blockIdx.x, gridDim.x), wave, lane); }
  for (int tile = blockIdx.x + gridDim.x; tile < 256; tile += gridDim.x) { phase_a_tile<false, false>(p, tile_of(tile, gridDim.x), wave, lane); __syncthreads(); gla_g1_tile(p, tile_of(tile, gridDim.x), wave, lane); }
#if PROBE == 40
  for (int tile = blockIdx.x; tile < 256; tile += gridDim.x) { phase_a_tile<false, false>(p, tile_of(tile, gridDim.x), wave, lane); __syncthreads(); gla_g1_tile(p, tile_of(tile, gridDim.x), wave, lane); }
#endif
  grid_barrier(bar, (2u - (FIRST_CG == 1)) * gridDim.x);
  {
    const bool kvblk = (gridDim.x == 256) && blockIdx.x >= 64 && blockIdx.x < 192;
    const bool conv_first = CLASS_ORDER && (gridDim.x == 256) && !kvblk;
    if (conv_first) phase_prep_tables_bal(p, blockIdx.x, gridDim.x, wave, lane);
    for (int it = gw; it < 4096; it += nw) sb_item(p, it, lane);
    for (int item = (int)((blockIdx.x + gridDim.x - 64u) % gridDim.x); item < 128; item += gridDim.x) phase_a_memkv(p, item, wave, lane);
    gla_g2(p, gtid, gthreads);
    if (!conv_first) phase_prep_tables_bal(p, blockIdx.x, gridDim.x, wave, lane);
    phase_prep_late(p, gtid, gthreads);
  }
  grid_barrier(bar, (3u - (FIRST_CG == 1)) * gridDim.x);
#if PROBE == 70
  grid_barrier(bar, 3u * gridDim.x); grid_barrier(bar, 4u * gridDim.x); grid_barrier(bar, 5u * gridDim.x); grid_barrier(bar, 6u * gridDim.x);
#endif
  for (int t0 = blockIdx.x; t0 < 256; t0 += gridDim.x) {
    const int tile = tile_of(t0, gridDim.x);
    float rs0, rs1;
    RingC rg;
#if PROBE == 41
    phase_c_tile(p, tile, wave, lane, rs0, rs1, rg);
#endif
    phase_c_tile(p, tile, wave, lane, rs0, rs1, rg);
#if PROBE == 42
    phase_d_tile(p, tile, wave, lane, rs0, rs1, rg);
#endif
    phase_d_tile(p, tile, wave, lane, rs0, rs1, rg);
#if GATHER_ALIGN
    grid_barrier(bar, (4u - (FIRST_CG == 1)) * gridDim.x);
#endif
#if PROBE == 43
    phase_d_gather<false>(p, tile, wave, lane);
#endif
    phase_d_gather<true>(p, tile, wave, lane);
  }
#if FIRST_CG == 0
  grid.sync();
#endif
}
#define MK_LDS (160 * 1024)
extern "C" void kernel_launch(void* const* d_in, const int* in_sizes, int n_in, void* d_out, int out_size, void* d_ws,
                              size_t ws_size, hipStream_t stream) {
  MKParams p{};
  p.x = (const float*)d_in[0]; p.mem = (const float*)d_in[1]; p.g_mix = (const float*)d_in[2];
  p.w_in = (const float*)d_in[3]; p.w_up = (const float*)d_in[4]; p.b_alpha = (const float*)d_in[5];
  p.g_gla = (const float*)d_in[6]; p.w_out = (const float*)d_in[7]; p.g_mq = (const float*)d_in[8];
  p.g_mkv = (const float*)d_in[9]; p.w_mq = (const float*)d_in[10]; p.w_mkv = (const float*)d_in[11];
  p.w_mo = (const float*)d_in[12]; p.g_ffn = (const float*)d_in[13]; p.w_pq = (const float*)d_in[14];
  p.subk = (const float*)d_in[15]; p.pu = (const float*)d_in[16]; p.pv = (const float*)d_in[17];
  p.g_fin = (const float*)d_in[18];
  p.out = (float*)d_out; p.ws = (char*)d_ws;
  float* out = (float*)d_out;
  char* wsb = (char*)d_ws;
  float* ws = (float*)d_ws;
  static int grid_blocks = 0;
  if (!grid_blocks) {
    int dev = 0, cus = 0, per_cu = 0;
    (void)hipGetDevice(&dev);
    (void)hipDeviceGetAttribute(&cus, hipDeviceAttributeMultiprocessorCount, dev);
    (void)hipFuncSetAttribute((const void*)mk, hipFuncAttributeMaxDynamicSharedMemorySize, MK_LDS);
    (void)hipOccupancyMaxActiveBlocksPerMultiprocessor(&per_cu, mk, 512, MK_LDS);
    grid_blocks = cus * per_cu;
    fprintf(stderr, "mk: cus=%d per_cu=%d grid=%d ws=%zu\n", cus, per_cu, grid_blocks, ws_size);
  }
#if FIRST_CG != 1
  (void)hipMemsetAsync((char*)d_ws + OFF_BAR, 0, 64, stream);
#endif
  {
    void* args[] = {(void*)&p};
    hipError_t e = hipLaunchCooperativeKernel((const void*)mk, dim3(grid_blocks), dim3(512), args, MK_LDS, stream);
    if (e != hipSuccess) fprintf(stderr, "coop launch failed: %s grid %d\n", hipGetErrorString(e), grid_blocks);
  }
}
```

```cpp
#ifndef GEMM_D
#define GEMM_D 8
#endif
#ifndef TABLES_IN_B
#define TABLES_IN_B 4
#endif
#ifndef REMAP
#define REMAP 0
#endif
#ifndef FIRST_CG
#define FIRST_CG 1
#endif
#ifndef GATHER_ALIGN
#define GATHER_ALIGN 0
#endif
#ifndef LATE_PREP
#define LATE_PREP 1
#endif
#ifndef B_ORDER
#define B_ORDER 0
#endif
#ifndef SWEEP_NB
#define SWEEP_NB 16
#define SWEEP_SH 10
#endif
#ifndef CLASS_ORDER
#define CLASS_ORDER 0
#endif
#ifndef STAGGER_B
#define STAGGER_B 0
#endif
#ifndef PROBE
#define PROBE 0
#endif
#ifndef W8
#define W8 1
#endif
#ifndef W8F
#define W8F W8
#endif
#ifndef GEMM_D2
#define GEMM_D2 8
#endif
#ifndef SETPRIO
#define SETPRIO 0
#endif
#ifndef ATTN_LOCKSTEP
#define ATTN_LOCKSTEP 0
#endif
#ifndef L2_TOUCH
#define L2_TOUCH 0
#endif
#include <hip/hip_runtime.h>
#include <hip/hip_cooperative_groups.h>
#include <math.h>
#include <stdio.h>
#include <stdint.h>
namespace cg = cooperative_groups;

#ifndef PROBE
#define PROBE 0
#endif
#ifndef TABLES_IN_B
#define TABLES_IN_B 1
#endif
#define NB 8
#define SEQ 2048
#define DM 1024
#define NTOK (NB * SEQ)
#define INC 3088
#define MEML 256
#define EPSV 1e-6f

typedef __attribute__((ext_vector_type(8))) __bf16 bf8;
typedef __attribute__((ext_vector_type(4))) __bf16 bf4;
typedef __attribute__((ext_vector_type(2))) __bf16 bf2;
typedef __attribute__((ext_vector_type(16))) float f16v;
typedef __attribute__((ext_vector_type(8))) float f8v;
typedef __attribute__((ext_vector_type(4))) float f4v;
typedef __attribute__((ext_vector_type(2))) float f2v;
typedef unsigned short u16;

#define DI __device__ __forceinline__
#ifndef USE_NT
#define USE_NT 1
#endif
#if USE_NT
#define NT_LOAD(p) __builtin_nontemporal_load(p)
#else
#define NT_LOAD(p) (*(p))
#endif
#define MFMA(a, b, c) __builtin_amdgcn_mfma_f32_32x32x16_bf16((a), (b), (c), 0, 0, 0)
typedef __attribute__((ext_vector_type(8))) _Float16 hf8;
typedef __attribute__((ext_vector_type(4))) _Float16 hf4;
typedef __attribute__((ext_vector_type(2))) _Float16 hf2;
#define MFMAH(a, b, c) __builtin_amdgcn_mfma_f32_32x32x16_f16(__builtin_bit_cast(hf8, (a)), __builtin_bit_cast(hf8, (b)), (c), 0, 0, 0)

DI int crow(int i, int h) { return (i & 3) + 8 * (i >> 2) + 4 * h; }
DI int tpos(int t) { return (t & ~12) | ((t & 4) << 1) | ((t & 8) >> 1); }
DI float bf2f(u16 v) { return __uint_as_float(((unsigned)v) << 16); }
DI bf8 cvt8(f8v v) { return __builtin_convertvector(v, bf8); }
DI bf4 cvt4(f4v v) { return __builtin_convertvector(v, bf4); }
#if W8F
DI bf4 cvt4a(f4v v) { return __builtin_bit_cast(bf4, __builtin_convertvector(v, hf4)); }
#else
DI bf4 cvt4a(f4v v) { return __builtin_convertvector(v, bf4); }
#endif
DI f16v zero16() { f16v z = {0.f, 0.f, 0.f, 0.f, 0.f, 0.f, 0.f, 0.f, 0.f, 0.f, 0.f, 0.f, 0.f, 0.f, 0.f, 0.f}; return z; }

#define MiB ((size_t)1 << 20)
#define OFF_WIN   ((size_t)0)
#define OFF_WOUT  (OFF_WIN + 97 * 65536)
#define OFF_WMQ   (OFF_WOUT + 32 * 65536)
#define OFF_WMKV  (OFF_WMQ + 32 * 65536)
#define OFF_WMO   (OFF_WMKV + 64 * 65536)
#define OFF_WPQ   (OFF_WMO + 32 * 65536)
#define OFF_SUBK  (OFF_WPQ + 64 * 65536)
#define OFF_ACT   (21 * MiB)
#define OFF_GQ    (OFF_ACT)
#define OFF_GK    (OFF_GQ + 8 * MiB)
#define OFF_GVT   (OFF_GK + 8 * MiB)
#define OFF_OG    (OFF_GVT + 16 * MiB)
#define OFF_SQ    (OFF_OG + 16 * MiB)
#define OFF_SK    (OFF_SQ + 16 * MiB)
#define OFF_SVT   (OFF_SK + 16 * MiB)
#define OFF_LA    (OFF_SVT + 16 * MiB)
#define OFF_LKV   (OFF_LA + 16 * MiB)
#define OFF_DD    (OFF_LKV + 32 * MiB)
#define OFF_OSB   (OFF_DD + 1 * MiB)
#define OFF_KM    (OFF_OSB + 16 * MiB)
#define OFF_VMT   (OFF_KM + 4 * MiB)
#define OFF_PU    (OFF_VMT + 4 * MiB)
#define OFF_PV    (OFF_PU + 16 * MiB)
#define OFF_SU    (OFF_PV + 16 * MiB)
#define OFF_SV    (OFF_SU + 65536)
#define OFF_GQ2   (224 * MiB)
#define OFF_GK2   (232 * MiB)
#define OFF_SS    (OFF_LA)

#define LDS_ROW 2064
#define LDS_A_BYTES (64 * LDS_ROW)

DI char* qp_scratch(char* ws, int blk) {
  return blk < 192 ? ws + OFF_SQ + (size_t)blk * 262144 : ws + OFF_LKV + (size_t)(blk - 192) * 262144;
}

#define OFF_CS  (OFF_DD + 512 * 1024)
#define OFF_ICS (OFF_CS + 128 * 1024)
#define OFF_BAR (OFF_DD + 768 * 1024)
DI void grid_barrier(unsigned* ctr, unsigned target) {
  __syncthreads();
  if (threadIdx.x == 0) {
    __builtin_amdgcn_fence(__ATOMIC_RELEASE, "agent");
    asm volatile("s_waitcnt vmcnt(0)" ::: "memory");
    __hip_atomic_fetch_add(ctr, 1u, __ATOMIC_RELAXED, __HIP_MEMORY_SCOPE_AGENT);
    while (__hip_atomic_load(ctr, __ATOMIC_RELAXED, __HIP_MEMORY_SCOPE_AGENT) < target) __builtin_amdgcn_s_sleep(1);
    __builtin_amdgcn_fence(__ATOMIC_ACQUIRE, "agent");
    asm volatile("s_waitcnt vmcnt(0)" ::: "memory");
  }
  __syncthreads();
}

struct MKParams {
  const float *x, *mem, *g_mix, *w_in, *w_up, *b_alpha, *g_gla, *w_out, *g_mq, *g_mkv, *w_mq, *w_mkv, *w_mo, *g_ffn, *w_pq,
      *subk, *pu, *pv, *g_fin;
  float* out;
  char* ws;
};
extern __shared__ __attribute__((aligned(16))) char smem[];

template <typename ColFn>
DI void prep_w(bf8* dst, const float* __restrict__ W, int ldw, int ntiles, const float* __restrict__ gain, ColFn colfn,
               int gtid, int gthreads) {
  const int total = ntiles * 4096;
#pragma unroll 1
  for (int u0 = gtid; u0 < total; u0 += 4 * gthreads) {
    f8v v[4];
    int didx[4];
#pragma unroll
    for (int t = 0; t < 4; ++t) {
      const int u = u0 + t * gthreads;
      didx[t] = -1;
      if (u < total) {
        const int lane = u & 63, ks = (u >> 6) & 63, nt = u >> 12;
        const int r = lane & 31, h = lane >> 5;
        float sc = 1.f;
        const int col = colfn(32 * nt + r, sc);
#pragma unroll
        for (int j = 0; j < 8; ++j) {
          const int k = 16 * ks + 8 * h + j;
          float val = 0.f;
          if (col >= 0) val = NT_LOAD(W + (size_t)k * ldw + col) * sc * (gain ? gain[k] : 1.f);
          v[t][j] = val;
        }
        didx[t] = (nt < (ntiles & ~15)) ? ((((nt >> 4) * 64 + ks) * 16 + (nt & 15)) * 64 + lane) : u;
      }
    }
#pragma unroll
    for (int t = 0; t < 4; ++t)
      if (didx[t] >= 0) dst[didx[t]] = cvt8(v[t]);
  }
}

template <typename ColFn>
DI void prep_w8_item(char* dst, float* cs, float* ics, const float* __restrict__ W, int ldw, const float* __restrict__ gain,
                     ColFn colfn, int grp, float* smax, int tid) {
  const int c = tid & 31, g = tid >> 5;
  const int n = grp * 32 + c;
  float sc = 1.f;
  const int col = colfn(n, sc);
  float w[64];
  float am = 0.f;
  const float* q = W + (size_t)(64 * g) * ldw + col;
#pragma unroll
  for (int j = 0; j < 64; ++j) {
    w[j] = NT_LOAD(q);
    q += ldw;
    asm volatile("" : "+v"(q));
  }
#pragma unroll
  for (int j = 0; j < 64; ++j) {
    w[j] *= sc * (gain ? gain[64 * g + j] : 1.f);
    am = fmaxf(am, fabsf(w[j]));
  }
  __syncthreads();
  if (tid < 32) ((unsigned*)smax)[tid] = 0u;
  __syncthreads();
  atomicMax((unsigned*)smax + c, __float_as_uint(am));
  __syncthreads();
  const float cm = smax[c];
  const float qs = (cm > 0.f) ? 127.0f / cm : 0.f;
  const int nt = n >> 5;
#pragma unroll
  for (int kp2 = 0; kp2 < 2; ++kp2)
#pragma unroll
    for (int h = 0; h < 2; ++h) {
      unsigned q[4];
#pragma unroll
      for (int d = 0; d < 4; ++d) {
        const int kb = 32 * kp2 + (d >> 1) * 16 + 8 * h + 4 * (d & 1);
        unsigned pk = 0;
#pragma unroll
        for (int j = 0; j < 4; ++j) pk |= ((unsigned)((int)rintf(w[kb + j] * qs) + (W8F ? 128 : 0)) & 0xffu) << (8 * j);
        q[d] = pk;
      }
      const int kp = 2 * g + kp2;
      const size_t unit = (size_t)(((nt >> 4) * 32 + kp) * 16 + (nt & 15)) * 64 + c + 32 * h;
      *(uint4*)(dst + unit * 16) = make_uint4(q[0], q[1], q[2], q[3]);
    }
  if (g == 0) { cs[n] = (cm > 0.f) ? cm * (1.0f / 127.0f) : 1.f; ics[n] = (cm > 0.f) ? 127.0f / cm : 1.f; }
}

DI void phase_prep(const MKParams& p, int gtid, int gthreads) {
  char* ws = p.ws;
  prep_w((bf8*)(ws + OFF_WIN), p.w_in, INC, 97, p.g_mix,
         [](int n, float& sc) -> int {
           if (n < 256) { sc = 0.125f; return n; }
           if (n < 1536) return n;
           if (n < 2048) { sc = 0.125f; return n + 16; }
           if (n < 3072) return n + 16;
           if (n < 3088) return n - 1536;
           return -1;
         }, gtid, gthreads);
  prep_w((bf8*)(ws + OFF_WMKV), p.w_mkv, 2048, 64, p.g_mkv, [](int n, float& sc) -> int { return n; }, gtid, gthreads);
}
DI void phase_prep_late(const MKParams& p, int gtid, int gthreads) {
  char* ws = p.ws;
#if W8
  {
    float* smax = (float*)(smem + LDS_A_BYTES);
    float* cs = (float*)(ws + OFF_CS);
    float* ics = (float*)(ws + OFF_ICS);
    const int tid = threadIdx.x;
    for (int item = blockIdx.x; item < 160; item += gridDim.x) {
      if (item < 32) prep_w8_item(ws + OFF_WOUT, cs + 4096, ics + 4096, p.w_out, 1024, nullptr, [](int n, float& sc) -> int { return n; }, item, smax, tid);
      else if (item < 64) prep_w8_item(ws + OFF_WMQ, cs + 8192, ics + 8192, p.w_mq, 1024, p.g_mq, [](int n, float& sc) -> int { sc = 0.0625f; return n; }, item - 32, smax, tid);
      else if (item < 96) prep_w8_item(ws + OFF_WMO, cs + 12288, ics + 12288, p.w_mo, 1024, nullptr, [](int n, float& sc) -> int { return n; }, item - 64, smax, tid);
      else prep_w8_item(ws + OFF_WPQ, cs + 16384, ics + 16384, p.w_pq, 2048, p.g_ffn, [](int n, float& sc) -> int { return n; }, item - 96, smax, tid);
    }
  }
#else
  prep_w((bf8*)(ws + OFF_WOUT), p.w_out, 1024, 32, nullptr, [](int n, float& sc) -> int { return n; }, gtid, gthreads);
  prep_w((bf8*)(ws + OFF_WMQ), p.w_mq, 1024, 32, p.g_mq, [](int n, float& sc) -> int { sc = 0.0625f; return n; }, gtid, gthreads);
  prep_w((bf8*)(ws + OFF_WMO), p.w_mo, 1024, 32, nullptr, [](int n, float& sc) -> int { return n; }, gtid, gthreads);
  prep_w((bf8*)(ws + OFF_WPQ), p.w_pq, 2048, 64, p.g_ffn, [](int n, float& sc) -> int { return n; }, gtid, gthreads);
#endif
  {
    bf8* dst = (bf8*)(ws + OFF_SUBK);
    const int total = 16 * 4 * 8 * 64;
    for (int u = gtid; u < total; u += gthreads) {
      const int lane = u & 63, ks = (u >> 6) & 7, mt = (u >> 9) & 3, hp = u >> 11;
      const int r = lane & 31, h = lane >> 5;
      const float* s = p.subk + ((size_t)(hp * 128 + 32 * mt + r)) * 128 + 16 * ks + 8 * h;
      const f4v a = *(const f4v*)s, b = *(const f4v*)(s + 4);
      f8v v = {a[0], a[1], a[2], a[3], b[0], b[1], b[2], b[3]};
      dst[u] = cvt8(v);
    }
  }
}

DI void table_row_issue(const MKParams& p, int row, int lane, f4v (&v)[4]) {
  const int e = row & 16383;
  const float* src = ((row >= 16384) ? p.pv : p.pu) + (size_t)e * DM + 16 * lane;
#pragma unroll
  for (int q = 0; q < 4; ++q) v[q] = NT_LOAD((const f4v*)(src + 4 * q));
}
DI void table_row_finish(const MKParams& p, int row, int lane, f4v (&v)[4]) {
  const int e = row & 16383;
  const bool isv = row >= 16384;
  if (!isv) {
#pragma unroll
    for (int q = 0; q < 4; ++q) v[q] = v[q] * *(const f4v*)(p.g_ffn + 16 * lane + 4 * q);
  }
  float am = 0.f;
#pragma unroll
  for (int q = 0; q < 4; ++q)
#pragma unroll
    for (int j = 0; j < 4; ++j) am = fmaxf(am, fabsf(v[q][j]));
#pragma unroll
  for (int o = 32; o > 0; o >>= 1) am = fmaxf(am, __shfl_xor(am, o));
  const float sc = (am > 0.f) ? 127.0f / am : 0.f;
  unsigned w[4];
#pragma unroll
  for (int q = 0; q < 4; ++q) {
    unsigned pk = 0;
#pragma unroll
    for (int j = 0; j < 4; ++j) pk |= ((unsigned)((int)rintf(v[q][j] * sc)) & 0xffu) << (8 * j);
    w[q] = pk;
  }
  *(uint4*)(p.ws + (isv ? OFF_PV : OFF_PU) + (size_t)e * 1024 + 16 * lane) = make_uint4(w[0], w[1], w[2], w[3]);
  if (lane == 0) ((float*)(p.ws + (isv ? OFF_SV : OFF_SU)))[e] = am * (1.0f / 127.0f);
}
DI void prep_table_row(const MKParams& p, int row, int lane) {
  f4v v[4];
  table_row_issue(p, row, lane, v);
  table_row_finish(p, row, lane, v);
}
DI void phase_prep_tables(const MKParams& p, int gwave, int nwaves, int lane) {
  for (int row = gwave; row < 32768; row += nwaves) prep_table_row(p, row, lane);
}
DI void phase_prep_tables_bal(const MKParams& p, int blk, int nblk, int wave, int lane) {
  if (nblk != 256) { phase_prep_tables(p, blk * 8 + wave, nblk * 8, lane); return; }
  int base, per, idx;
  if (blk >= 64 && blk < 192) { base = 0; per = 7; idx = (blk - 64) * 8 + wave; }
  else if (blk < 64) { base = 7168; per = 21; idx = blk * 8 + wave; }
  else { base = 17920; per = 29; idx = (blk - 192) * 8 + wave; }
  for (int i = 0; i < per; ++i) prep_table_row(p, base + idx * per + i, lane);
}
#ifndef TBL_IN_A
#define TBL_IN_A 12
#endif
DI void phase_prep_tables_rest(const MKParams& p, int gwave, int nwaves, int lane) {
  if (nwaves != 2048) { phase_prep_tables(p, gwave, nwaves, lane); return; }
  for (int rr = TBL_IN_A; rr < 16; ++rr) prep_table_row(p, gwave * 16 + rr, lane);
}
DI void phase_prep_tables_dyn(const MKParams& p, unsigned* qctr, int lane) {
  while (true) {
    unsigned c = 0;
    if (lane == 0) c = __hip_atomic_fetch_add(qctr, 1u, __ATOMIC_RELAXED, __HIP_MEMORY_SCOPE_AGENT);
    c = (unsigned)__builtin_amdgcn_readfirstlane((int)c);
    if (c >= 1024u) break;
#pragma unroll 2
    for (int rr = 0; rr < 32; ++rr) prep_table_row(p, (int)c * 32 + rr, lane);
  }
}

DI void load_norm_tile(const float* __restrict__ src, char* ldsA, int wave, int lane) {
#pragma unroll 2
  for (int i = 0; i < 8; ++i) {
    const int row = 8 * wave + i;
    const f4v* pr = (const f4v*)(src + (size_t)row * DM);
    f4v v[4];
#pragma unroll
    for (int c = 0; c < 4; ++c) v[c] = NT_LOAD(pr + lane + 64 * c);
    float ss = 0.f;
#pragma unroll
    for (int c = 0; c < 4; ++c) ss += v[c][0] * v[c][0] + v[c][1] * v[c][1] + v[c][2] * v[c][2] + v[c][3] * v[c][3];
#pragma unroll
    for (int o = 32; o > 0; o >>= 1) ss += __shfl_xor(ss, o);
    const float rs = rsqrtf(ss * (1.0f / DM) + EPSV);
#pragma unroll
    for (int c = 0; c < 4; ++c) {
      f4v t = v[c] * rs;
      *(bf4*)(ldsA + row * LDS_ROW + (lane * 4 + 256 * c) * 2) = cvt4(t);
    }
  }
}

#ifndef GEMM_D
#define GEMM_D 6
#endif
template <bool SWAP, bool F16 = false>
DI void gemm_step(f16v (&acc)[2][2], const bf8& a0, const bf8& a1, const bf8& x0, const bf8& x1) {
  if (F16) {
    if (SWAP) {
      acc[0][0] = MFMAH(a0, x0, acc[0][0]); acc[0][1] = MFMAH(a0, x1, acc[0][1]);
      acc[1][0] = MFMAH(a1, x0, acc[1][0]); acc[1][1] = MFMAH(a1, x1, acc[1][1]);
    } else {
      acc[0][0] = MFMAH(x0, a0, acc[0][0]); acc[0][1] = MFMAH(x1, a0, acc[0][1]);
      acc[1][0] = MFMAH(x0, a1, acc[1][0]); acc[1][1] = MFMAH(x1, a1, acc[1][1]);
    }
  } else if (SWAP) {
    acc[0][0] = MFMA(a0, x0, acc[0][0]); acc[0][1] = MFMA(a0, x1, acc[0][1]);
    acc[1][0] = MFMA(a1, x0, acc[1][0]); acc[1][1] = MFMA(a1, x1, acc[1][1]);
  } else {
    acc[0][0] = MFMA(x0, a0, acc[0][0]); acc[0][1] = MFMA(x1, a0, acc[0][1]);
    acc[1][0] = MFMA(x0, a1, acc[1][0]); acc[1][1] = MFMA(x1, a1, acc[1][1]);
  }
}
struct Ring { bf8 w0[GEMM_D], w1[GEMM_D]; };
DI void ring_fill(Ring& rg, const bf8* __restrict__ wf, int lane) {
#pragma unroll
  for (int i = 0; i < GEMM_D; ++i) { rg.w0[i] = wf[lane + i * 1024]; rg.w1[i] = wf[64 + lane + i * 1024]; }
}
template <bool SWAP, bool RES, bool FIRST, bool NEXT>
DI void gemm_chunk_r(const char* ldsA, const bf8* __restrict__ wf, const bf8* __restrict__ wnext, int lane, f16v (&acc)[2][2],
                     Ring& rg, const float* res = nullptr) {
  __builtin_amdgcn_sched_barrier(0);
  const int r = lane & 31, h = lane >> 5;
  const char* xa0 = ldsA + r * LDS_ROW + h * 16;
  const char* xa1 = xa0 + 32 * LDS_ROW;
  const bf8* w0p = wf + lane;
  const bf8* w1p = wf + 64 + lane;
  if (FIRST) ring_fill(rg, wf, lane);
  if (RES) {
#pragma unroll
    for (int ntl = 0; ntl < 2; ++ntl)
#pragma unroll
      for (int tt = 0; tt < 2; ++tt)
#pragma unroll
        for (int g = 0; g < 4; ++g) {
          const f4v x = *(const f4v*)(res + (size_t)(32 * tt + r) * DM + 32 * ntl + 8 * g + 4 * h);
          acc[ntl][tt][4 * g] = x[0]; acc[ntl][tt][4 * g + 1] = x[1]; acc[ntl][tt][4 * g + 2] = x[2]; acc[ntl][tt][4 * g + 3] = x[3];
        }
  } else {
    acc[0][0] = zero16(); acc[0][1] = zero16(); acc[1][0] = zero16(); acc[1][1] = zero16();
  }
  bf8 x0 = *(const bf8*)(xa0), x1 = *(const bf8*)(xa1);
  constexpr int KMAIN = ((64 - 2 * GEMM_D) / GEMM_D + 1) * GEMM_D;
#pragma unroll 1
  for (int ks0 = 0; ks0 < KMAIN; ks0 += GEMM_D) {
#pragma unroll
    for (int i = 0; i < GEMM_D; ++i) {
      const int ks = ks0 + i;
      const bf8 xn0 = *(const bf8*)(xa0 + (ks + 1) * 32);
      const bf8 xn1 = *(const bf8*)(xa1 + (ks + 1) * 32);
      gemm_step<SWAP>(acc, rg.w0[i], rg.w1[i], x0, x1);
      rg.w0[i] = w0p[(ks + GEMM_D) * 1024];
      rg.w1[i] = w1p[(ks + GEMM_D) * 1024];
      x0 = xn0; x1 = xn1;
      __builtin_amdgcn_sched_group_barrier(0x100, 2, 0);
      __builtin_amdgcn_sched_group_barrier(0x008, 2, 0);
      __builtin_amdgcn_sched_group_barrier(0x020, 2, 0);
      __builtin_amdgcn_sched_group_barrier(0x008, 2, 0);
    }
  }
#pragma unroll
  for (int t = 0; t < 64 - KMAIN; ++t) {
    const int ks = KMAIN + t, i = t % GEMM_D;
    const bf8 xn0 = *(const bf8*)(xa0 + (ks + 1) * 32);
    const bf8 xn1 = *(const bf8*)(xa1 + (ks + 1) * 32);
    gemm_step<SWAP>(acc, rg.w0[i], rg.w1[i], x0, x1);
    const bool refill = (ks + GEMM_D < 64) || NEXT;
    if (ks + GEMM_D < 64) {
      rg.w0[i] = w0p[(ks + GEMM_D) * 1024];
      rg.w1[i] = w1p[(ks + GEMM_D) * 1024];
    } else if (NEXT) {
      rg.w0[i] = wnext[lane + (ks + GEMM_D - 64) * 1024];
      rg.w1[i] = wnext[64 + lane + (ks + GEMM_D - 64) * 1024];
    }
    x0 = xn0; x1 = xn1;
    __builtin_amdgcn_sched_group_barrier(0x100, 2, 0);
    __builtin_amdgcn_sched_group_barrier(0x008, 2, 0);
    if (refill) __builtin_amdgcn_sched_group_barrier(0x020, 2, 0);
    __builtin_amdgcn_sched_group_barrier(0x008, 2, 0);
  }
}
struct Ring8 { uint4 w0[GEMM_D2], w1[GEMM_D2]; bf8 c0, c1; };
DI void ring8_fill(Ring8& rg, const uint4* __restrict__ wf, int lane) {
#pragma unroll
  for (int i = 0; i < GEMM_D2; ++i) { rg.w0[i] = wf[lane + i * 1024]; rg.w1[i] = wf[64 + lane + i * 1024]; }
}
#if W8F
DI bf8 deq8(unsigned lo, unsigned hi) {
  const unsigned K = 0x64646464u;
  const hf2 off = {(_Float16)-1152.0f, (_Float16)-1152.0f};
  const hf2 a = __builtin_bit_cast(hf2, __builtin_amdgcn_perm(K, lo, 0x05010400u)) + off;
  const hf2 b = __builtin_bit_cast(hf2, __builtin_amdgcn_perm(K, lo, 0x07030602u)) + off;
  const hf2 c = __builtin_bit_cast(hf2, __builtin_amdgcn_perm(K, hi, 0x05010400u)) + off;
  const hf2 d = __builtin_bit_cast(hf2, __builtin_amdgcn_perm(K, hi, 0x07030602u)) + off;
  const hf8 r = {a[0], a[1], b[0], b[1], c[0], c[1], d[0], d[1]};
  return __builtin_bit_cast(bf8, r);
}
#else
DI bf8 deq8(unsigned lo, unsigned hi) {
  f8v v;
  v[0] = (float)(signed char)(lo); v[1] = (float)(signed char)(lo >> 8); v[2] = (float)(signed char)(lo >> 16); v[3] = (float)((int)lo >> 24);
  v[4] = (float)(signed char)(hi); v[5] = (float)(signed char)(hi >> 8); v[6] = (float)(signed char)(hi >> 16); v[7] = (float)((int)hi >> 24);
  return cvt8(v);
}
#endif
template <bool SWAP, bool RES, bool FIRST, bool NEXT, bool CUR, int PR = 0>
DI void gemm_chunk_w8(const char* ldsA, const uint4* __restrict__ wf, const uint4* __restrict__ wnext, int lane, f16v (&acc)[2][2],
                      Ring8& rg, const float* res = nullptr, const float* ics = nullptr) {
  __builtin_amdgcn_sched_barrier(0);
  const int r = lane & 31, h = lane >> 5;
  const char* xa0 = ldsA + r * LDS_ROW + h * 16;
  const char* xa1 = xa0 + 32 * LDS_ROW;
  const uint4* w0p = wf + lane;
  const uint4* w1p = wf + 64 + lane;
  if (FIRST) ring8_fill(rg, wf, lane);
  if (RES) {
#pragma unroll
    for (int ntl = 0; ntl < 2; ++ntl)
#pragma unroll
      for (int g = 0; g < 4; ++g) {
        const f4v ic = *(const f4v*)(ics + 32 * ntl + 8 * g + 4 * h);
#pragma unroll
        for (int tt = 0; tt < 2; ++tt) {
          const f4v x = *(const f4v*)(res + (size_t)(32 * tt + r) * DM + 32 * ntl + 8 * g + 4 * h);
          acc[ntl][tt][4 * g] = x[0] * ic[0]; acc[ntl][tt][4 * g + 1] = x[1] * ic[1]; acc[ntl][tt][4 * g + 2] = x[2] * ic[2]; acc[ntl][tt][4 * g + 3] = x[3] * ic[3];
        }
      }
  } else {
    acc[0][0] = zero16(); acc[0][1] = zero16(); acc[1][0] = zero16(); acc[1][1] = zero16();
  }
  bf8 x0 = *(const bf8*)(xa0), x1 = *(const bf8*)(xa1);
  bf8 cur0, cur1, nxt0, nxt1;
  if (CUR && !FIRST) { cur0 = rg.c0; cur1 = rg.c1; }
  else { cur0 = deq8(rg.w0[0].x, rg.w0[0].y); cur1 = deq8(rg.w1[0].x, rg.w1[0].y); }
  constexpr int NP = 32;
  constexpr int KM = ((NP - 2 * GEMM_D2) / GEMM_D2 + 1) * GEMM_D2;
#define W8_VQ (W8F ? 4 : 6)
#define W8_PAIR(p, i, REFILL_STMT, CONV_NEXT)                                                                          \
  {                                                                                                                    \
    bf8 xn0 = x1, xn1 = x0;                                                                                          \
    if (PR != 2) { xn0 = *(const bf8*)(xa0 + (2 * (p) + 1) * 32); xn1 = *(const bf8*)(xa1 + (2 * (p) + 1) * 32); }     \
    nxt0 = deq8(rg.w0[i].z, rg.w0[i].w); nxt1 = deq8(rg.w1[i].z, rg.w1[i].w);     \
    gemm_step<SWAP, (W8F != 0)>(acc, cur0, cur1, x0, x1);                                                              \
    __builtin_amdgcn_sched_group_barrier(0x100, 2, 0);                                                                 \
    __builtin_amdgcn_sched_group_barrier(0x008, 1, 0); __builtin_amdgcn_sched_group_barrier(0x002, W8_VQ, 0);          \
    __builtin_amdgcn_sched_group_barrier(0x008, 1, 0); __builtin_amdgcn_sched_group_barrier(0x002, W8_VQ, 0);          \
    __builtin_amdgcn_sched_group_barrier(0x008, 1, 0); __builtin_amdgcn_sched_group_barrier(0x002, W8_VQ, 0);          \
    __builtin_amdgcn_sched_group_barrier(0x008, 1, 0); __builtin_amdgcn_sched_group_barrier(0x002, W8_VQ, 0);          \
    if (PR != 2) { x0 = *(const bf8*)(xa0 + (2 * (p) + 2) * 32); x1 = *(const bf8*)(xa1 + (2 * (p) + 2) * 32); }       \
    if (CONV_NEXT) { cur0 = deq8(rg.w0[((i) + 1) % GEMM_D2].x, rg.w0[((i) + 1) % GEMM_D2].y);                          \
                     cur1 = deq8(rg.w1[((i) + 1) % GEMM_D2].x, rg.w1[((i) + 1) % GEMM_D2].y); }                        \
    gemm_step<SWAP, (W8F != 0)>(acc, nxt0, nxt1, xn0, xn1);                                                            \
    if (PR != 1) REFILL_STMT                                                                                           \
    __builtin_amdgcn_sched_group_barrier(0x100, 2, 0);                                                                 \
    __builtin_amdgcn_sched_group_barrier(0x008, 1, 0); __builtin_amdgcn_sched_group_barrier(0x002, W8_VQ, 0);          \
    __builtin_amdgcn_sched_group_barrier(0x008, 1, 0); __builtin_amdgcn_sched_group_barrier(0x002, W8_VQ, 0);          \
    __builtin_amdgcn_sched_group_barrier(0x020, 2, 0);                                                                 \
    __builtin_amdgcn_sched_group_barrier(0x008, 1, 0); __builtin_amdgcn_sched_group_barrier(0x002, W8_VQ, 0);          \
    __builtin_amdgcn_sched_group_barrier(0x008, 1, 0); __builtin_amdgcn_sched_group_barrier(0x002, W8_VQ, 0);          \
  }
#pragma unroll 1
  for (int p0 = 0; p0 < KM; p0 += GEMM_D2) {
#pragma unroll
    for (int i = 0; i < GEMM_D2; ++i) {
      const int p = p0 + i;
      W8_PAIR(p, i, { rg.w0[i] = w0p[(p + GEMM_D2) * 1024]; rg.w1[i] = w1p[(p + GEMM_D2) * 1024]; }, true)
    }
  }
#pragma unroll
  for (int t = 0; t < NP - KM; ++t) {
    const int p = KM + t, i = t % GEMM_D2;
    if (p + GEMM_D2 < NP) {
      W8_PAIR(p, i, { rg.w0[i] = w0p[(p + GEMM_D2) * 1024]; rg.w1[i] = w1p[(p + GEMM_D2) * 1024]; }, true)
    } else if (NEXT) {
      W8_PAIR(p, i, { rg.w0[i] = wnext[lane + (p + GEMM_D2 - NP) * 1024]; rg.w1[i] = wnext[64 + lane + (p + GEMM_D2 - NP) * 1024]; }, true)
    } else {
      W8_PAIR(p, i, {}, (p + 1 < NP))
    }
  }
#undef W8_PAIR
  if (NEXT) { rg.c0 = cur0; rg.c1 = cur1; }
}
DI void scale_cols(f16v (&acc)[2][2], const float* __restrict__ cs, int lane) {
  __builtin_amdgcn_sched_barrier(0);
  asm volatile("" : "+v"(lane));
  const int h = lane >> 5;
#pragma unroll
  for (int ntl = 0; ntl < 2; ++ntl)
#pragma unroll
    for (int g = 0; g < 4; ++g) {
      const f4v c4 = *(const f4v*)(cs + 32 * ntl + 8 * g + 4 * h);
#pragma unroll
      for (int tt = 0; tt < 2; ++tt)
#pragma unroll
        for (int e = 0; e < 4; ++e) acc[ntl][tt][4 * g + e] *= c4[e];
    }
}
#if W8
typedef Ring8 RingC;
#else
typedef Ring RingC;
#endif

DI unsigned l2_touch(const void* chunk, int lane) {
  unsigned v = 0;
#if L2_TOUCH
  asm volatile("" : "+v"(lane));
  const char* q = (const char*)chunk + (size_t)((blockIdx.x >> 3) & 31) * 32768 + (unsigned)(lane & 31) * 128u +
                  (unsigned)__builtin_amdgcn_readfirstlane((int)(threadIdx.x >> 6)) * 4096u;
  if (lane < 32) v = *(const unsigned*)q;
#endif
  return v;
}
DI void l2_sink(unsigned v) {
#if L2_TOUCH
  asm volatile("" :: "v"(v));
#endif
}
template <bool SWAP, bool RES = false>
DI void gemm_chunk(const char* ldsA, const bf8* __restrict__ wf, int lane, f16v (&acc)[2][2], const float* res = nullptr) {
  Ring rg;
  gemm_chunk_r<SWAP, RES, true, false>(ldsA, wf, nullptr, lane, acc, rg, res);
}

DI void store_swap_bf16(u16* dst, size_t ld, const f16v (&acc)[2][2], int lane) {
  const int r = lane & 31, h = lane >> 5;
#pragma unroll
  for (int ntl = 0; ntl < 2; ++ntl)
#pragma unroll
    for (int tt = 0; tt < 2; ++tt)
#pragma unroll
      for (int g = 0; g < 4; ++g) {
        f4v v = {acc[ntl][tt][4 * g], acc[ntl][tt][4 * g + 1], acc[ntl][tt][4 * g + 2], acc[ntl][tt][4 * g + 3]};
        *(bf4*)(dst + (size_t)(32 * tt + r) * ld + 32 * ntl + 8 * g + 4 * h) = cvt4(v);
      }
}
DI void store_vt_bf16(u16* dst, size_t ld, const f16v (&acc)[2][2], int lane) {
  const int r = lane & 31, h = lane >> 5;
#pragma unroll
  for (int ntl = 0; ntl < 2; ++ntl)
#pragma unroll
    for (int tt = 0; tt < 2; ++tt)
#pragma unroll
      for (int s = 0; s < 2; ++s) {
        f8v v;
#pragma unroll
        for (int j = 0; j < 8; ++j) v[j] = acc[ntl][tt][8 * s + j];
        *(bf8*)(dst + (size_t)(32 * ntl + r) * ld + 32 * tt + 16 * s + 8 * h) = cvt8(v);
      }
}

DI float log_sigmoid_acc(float x) { return fminf(x, 0.f) - log1pf(expf(-fabsf(x))); }

template <bool PRELOADED = false, bool TBL = false>
DI void phase_a_tile(const MKParams& p, int tile, int wave, int lane) {
  asm volatile("" : "+v"(lane));
  char* ws = p.ws;
  char* ldsA = smem;
  float* alr_s = (float*)(smem + LDS_A_BYTES);
  const int b = tile >> 5, c = tile & 31;
  const size_t tok0 = (size_t)tile * 64;
  if (!PRELOADED) {
    __syncthreads();
    load_norm_tile(p.x + tok0 * DM, ldsA, wave, lane);
#if PROBE == 10
    __syncthreads();
    load_norm_tile(p.x + tok0 * DM, ldsA, wave, lane);
#endif
    __syncthreads();
  }
  const bf8* wf = (const bf8*)(ws + OFF_WIN);
  f16v acc[2][2];
  Ring rg;
  f4v tv[2][4];
  const int trow0 = (blockIdx.x * 8 + wave) * 16;
  const int t0 = c * 64;
  { const unsigned pf = l2_touch(wf + (size_t)1 * 65536, lane);
  gemm_chunk_r<true, false, true, true>(ldsA, wf + (size_t)0 * 65536 + 2 * wave * 64, wf + (size_t)1 * 65536 + 2 * wave * 64, lane, acc, rg);
    l2_sink(pf); }
  if (TBL && 0 < TBL_IN_A) { table_row_issue(p, trow0 + 0, lane, tv[0]); table_row_issue(p, trow0 + 1, lane, tv[1]); }
  {
    u16* base = (u16*)(ws + (wave < 4 ? OFF_GQ : OFF_GK)) + ((size_t)(b * 4 + (wave & 3)) * SEQ + t0) * 64;
    store_swap_bf16(base, 64, acc, lane);
  if (TBL && 0 < TBL_IN_A) { table_row_finish(p, trow0 + 0, lane, tv[0]); table_row_finish(p, trow0 + 1, lane, tv[1]); }
#if PROBE == 11
    store_swap_bf16(base, 64, acc, lane);
#endif
  }
  { const unsigned pf = l2_touch(wf + (size_t)2 * 65536, lane);
  gemm_chunk_r<false, false, false, true>(ldsA, wf + (size_t)1 * 65536 + 2 * wave * 64, wf + (size_t)2 * 65536 + 2 * wave * 64, lane, acc, rg);
    l2_sink(pf); }
  if (TBL && 2 < TBL_IN_A) { table_row_issue(p, trow0 + 2, lane, tv[0]); table_row_issue(p, trow0 + 3, lane, tv[1]); }
  {
    u16* base = (u16*)(ws + OFF_GVT) + ((size_t)(b * 4 + (wave >> 1)) * 128 + 64 * (wave & 1)) * SEQ + t0;
    store_vt_bf16(base, SEQ, acc, lane);
  if (TBL && 2 < TBL_IN_A) { table_row_finish(p, trow0 + 2, lane, tv[0]); table_row_finish(p, trow0 + 3, lane, tv[1]); }
#if PROBE == 11
    store_vt_bf16(base, SEQ, acc, lane);
#endif
  }
  { const unsigned pf = l2_touch(wf + (size_t)3 * 65536, lane);
  gemm_chunk_r<true, false, false, true>(ldsA, wf + (size_t)2 * 65536 + 2 * wave * 64, wf + (size_t)3 * 65536 + 2 * wave * 64, lane, acc, rg);
    l2_sink(pf); }
  if (TBL && 4 < TBL_IN_A) { table_row_issue(p, trow0 + 4, lane, tv[0]); table_row_issue(p, trow0 + 5, lane, tv[1]); }
  store_swap_bf16((u16*)(ws + OFF_OG) + tok0 * 512 + 64 * wave, 512, acc, lane);
  if (TBL && 4 < TBL_IN_A) { table_row_finish(p, trow0 + 4, lane, tv[0]); table_row_finish(p, trow0 + 5, lane, tv[1]); }
#if PROBE == 11
  store_swap_bf16((u16*)(ws + OFF_OG) + tok0 * 512 + 64 * wave, 512, acc, lane);
#endif
  { const unsigned pf = l2_touch(wf + (size_t)4 * 65536, lane);
  gemm_chunk_r<true, false, false, true>(ldsA, wf + (size_t)3 * 65536 + 2 * wave * 64, wf + (size_t)4 * 65536 + 2 * wave * 64, lane, acc, rg);
    l2_sink(pf); }
  if (TBL && 6 < TBL_IN_A) { table_row_issue(p, trow0 + 6, lane, tv[0]); table_row_issue(p, trow0 + 7, lane, tv[1]); }
  store_swap_bf16((u16*)(ws + OFF_SQ) + ((size_t)(b * 8 + wave) * SEQ + t0) * 64, 64, acc, lane);
  if (TBL && 6 < TBL_IN_A) { table_row_finish(p, trow0 + 6, lane, tv[0]); table_row_finish(p, trow0 + 7, lane, tv[1]); }
#if PROBE == 11
  store_swap_bf16((u16*)(ws + OFF_SQ) + ((size_t)(b * 8 + wave) * SEQ + t0) * 64, 64, acc, lane);
#endif
  { const unsigned pf = l2_touch(wf + (size_t)5 * 65536, lane);
  gemm_chunk_r<true, false, false, true>(ldsA, wf + (size_t)4 * 65536 + 2 * wave * 64, wf + (size_t)5 * 65536 + 2 * wave * 64, lane, acc, rg);
    l2_sink(pf); }
  if (TBL && 8 < TBL_IN_A) { table_row_issue(p, trow0 + 8, lane, tv[0]); table_row_issue(p, trow0 + 9, lane, tv[1]); }
  store_swap_bf16((u16*)(ws + OFF_SK) + ((size_t)(b * 8 + wave) * SEQ + t0) * 64, 64, acc, lane);
  if (TBL && 8 < TBL_IN_A) { table_row_finish(p, trow0 + 8, lane, tv[0]); table_row_finish(p, trow0 + 9, lane, tv[1]); }
#if PROBE == 11
  store_swap_bf16((u16*)(ws + OFF_SK) + ((size_t)(b * 8 + wave) * SEQ + t0) * 64, 64, acc, lane);
#endif
  gemm_chunk_r<false, false, false, false>(ldsA, wf + (size_t)5 * 65536 + 2 * wave * 64, nullptr, lane, acc, rg);
  if (TBL && 10 < TBL_IN_A) { table_row_issue(p, trow0 + 10, lane, tv[0]); table_row_issue(p, trow0 + 11, lane, tv[1]); }
  store_vt_bf16((u16*)(ws + OFF_SVT) + ((size_t)(b * 8 + wave) * 64) * SEQ + t0, SEQ, acc, lane);
  if (TBL && 10 < TBL_IN_A) { table_row_finish(p, trow0 + 10, lane, tv[0]); table_row_finish(p, trow0 + 11, lane, tv[1]); }
#if PROBE == 11
  store_vt_bf16((u16*)(ws + OFF_SVT) + ((size_t)(b * 8 + wave) * 64) * SEQ + t0, SEQ, acc, lane);
#endif
#if PROBE == 12
  for (int rep_ = 0; rep_ < 2; ++rep_) {
  __syncthreads();
#else
  {
#endif
    float* part = (float*)(smem + LDS_A_BYTES);
    const int r = lane & 31, h = lane >> 5;
    const bf8* wp = wf + (size_t)96 * 4096 + lane;
    bf8 wfr[8];
#pragma unroll
    for (int i = 0; i < 8; ++i) wfr[i] = wp[(8 * wave + i) * 64];
    const char* xa0 = ldsA + r * LDS_ROW + h * 16 + wave * 256;
    const char* xa1 = xa0 + 32 * LDS_ROW;
    f16v a0 = zero16(), a1 = zero16();
#pragma unroll
    for (int i = 0; i < 8; ++i) {
      a0 = MFMA(wfr[i], *(const bf8*)(xa0 + i * 32), a0);
      a1 = MFMA(wfr[i], *(const bf8*)(xa1 + i * 32), a1);
    }
    float* pw = part + (wave & 3) * 1024;
    if (wave < 4) {
#pragma unroll
      for (int i = 0; i < 8; ++i) { pw[r * 16 + crow(i, h)] = a0[i]; pw[(32 + r) * 16 + crow(i, h)] = a1[i]; }
    }
    __syncthreads();
    if (wave >= 4) {
#pragma unroll
      for (int i = 0; i < 8; ++i) { pw[r * 16 + crow(i, h)] += a0[i]; pw[(32 + r) * 16 + crow(i, h)] += a1[i]; }
    }
    __syncthreads();
    const int tid = wave * 64 + lane;
    {
      const f4v* p4 = (const f4v*)part;
      if (tid < 256) { f4v s = p4[tid] + p4[256 + tid] + p4[512 + tid] + p4[768 + tid]; ((f4v*)part)[tid] = s; }
    }
    __syncthreads();
    const int col = tid & 255, tg = tid >> 8;
    float wu[16];
#pragma unroll
    for (int rr = 0; rr < 16; ++rr) wu[rr] = p.w_up[rr * 256 + col];
    const float bb = p.b_alpha[col];
    float* dst = (float*)(ws + OFF_LA) + (tok0 + 32 * tg) * 256 + col;
#pragma unroll 4
    for (int t = 0; t < 32; ++t) {
      const f4v* ar = (const f4v*)(part + (32 * tg + t) * 16);
      const f4v q0 = ar[0], q1 = ar[1], q2 = ar[2], q3 = ar[3];
      float s = bb;
      s = fmaf(q0[0], wu[0], s); s = fmaf(q0[1], wu[1], s); s = fmaf(q0[2], wu[2], s); s = fmaf(q0[3], wu[3], s);
      s = fmaf(q1[0], wu[4], s); s = fmaf(q1[1], wu[5], s); s = fmaf(q1[2], wu[6], s); s = fmaf(q1[3], wu[7], s);
      s = fmaf(q2[0], wu[8], s); s = fmaf(q2[1], wu[9], s); s = fmaf(q2[2], wu[10], s); s = fmaf(q2[3], wu[11], s);
      s = fmaf(q3[0], wu[12], s); s = fmaf(q3[1], wu[13], s); s = fmaf(q3[2], wu[14], s); s = fmaf(q3[3], wu[15], s);
      const float ls = fminf(s, 0.f) - __logf(1.0f + __expf(-fabsf(s)));
      dst[(size_t)t * 256] = ls * (1.0f / 16.0f);
    }
  }
}

DI void phase_a_memkv(const MKParams& p, int item, int wave, int lane) {
  asm volatile("" : "+v"(lane));
  char* ws = p.ws;
  char* ldsA = smem;
  const int rt = item >> 2, cc = item & 3;
  const int b = rt >> 2, m0 = (rt & 3) * 64;
  __syncthreads();
  load_norm_tile(p.mem + (size_t)rt * 64 * DM, ldsA, wave, lane);
  __syncthreads();
  const bf8* wf = (const bf8*)(ws + OFF_WMKV);
  f16v acc[2][2];
  if (cc < 2) {
    gemm_chunk<true>(ldsA, wf + (size_t)cc * 65536 + 2 * wave * 64, lane, acc);
    const int f0 = 512 * cc + 64 * wave;
    u16* base = (u16*)(ws + OFF_KM) + ((size_t)(b * 4 + (f0 >> 8)) * 256 + m0) * 256 + (f0 & 255);
    store_swap_bf16(base, 256, acc, lane);
  } else {
    gemm_chunk<false>(ldsA, wf + (size_t)cc * 65536 + 2 * wave * 64, lane, acc);
    const int f0 = 512 * (cc - 2) + 64 * wave;
    u16* base = (u16*)(ws + OFF_VMT) + ((size_t)(b * 4 + (f0 >> 8)) * 256 + (f0 & 255)) * 256 + m0;
    store_vt_bf16(base, 256, acc, lane);
  }
}
#define SB_THR 30.0f

DI bf8 pack8(const f16v& x, int s) {
  f8v v;
#pragma unroll
  for (int j = 0; j < 8; ++j) v[j] = x[8 * s + j];
  return cvt8(v);
}

DI void sb_item(const MKParams& p, int item, int lane) {
  asm volatile("" : "+v"(lane));
  char* ws = p.ws;
  const int r = lane & 31, h = lane >> 5;
  const int bh = item >> 6, qt = item & 63;
  const u16* SQ = (const u16*)(ws + OFF_SQ) + (size_t)bh * SEQ * 64;
  const u16* SK = (const u16*)(ws + OFF_SK) + (size_t)bh * SEQ * 64;
  const u16* SVT = (const u16*)(ws + OFF_SVT) + (size_t)bh * 64 * SEQ;
  bf8 qf[4];
#pragma unroll
  for (int ks = 0; ks < 4; ++ks) qf[ks] = *(const bf8*)(SQ + (size_t)(32 * qt + r) * 64 + 16 * ks + 8 * h);
  bf8 tri[2];
#pragma unroll
  for (int s = 0; s < 2; ++s) {
    f8v t;
#pragma unroll
    for (int j = 0; j < 8; ++j) t[j] = (16 * s + 8 * (j >> 2) + 4 * h + (j & 3) >= r) ? 1.0f : 0.0f;
    tri[s] = cvt8(t);
  }
  f16v o0 = zero16(), o1 = zero16();
  float R = 0.f;
  bf8 kf[4], vf[2][2];
#pragma unroll
  for (int ks = 0; ks < 4; ++ks) kf[ks] = *(const bf8*)(SK + (size_t)(32 * qt + r) * 64 + 16 * ks + 8 * h);
#pragma unroll
  for (int mt = 0; mt < 2; ++mt)
#pragma unroll
    for (int s = 0; s < 2; ++s) vf[mt][s] = *(const bf8*)(SVT + (size_t)(32 * mt + r) * SEQ + 32 * qt + 16 * s + 8 * h);
  for (int kt = qt; kt >= 0; --kt) {
    bf8 kfn[4], vfn[2][2];
    const int ktn = (kt > 0) ? kt - 1 : 0;
#pragma unroll
    for (int ks = 0; ks < 4; ++ks) kfn[ks] = *(const bf8*)(SK + (size_t)(32 * ktn + r) * 64 + 16 * ks + 8 * h);
#pragma unroll
    for (int mt = 0; mt < 2; ++mt)
#pragma unroll
      for (int s = 0; s < 2; ++s) vfn[mt][s] = *(const bf8*)(SVT + (size_t)(32 * mt + r) * SEQ + 32 * ktn + 16 * s + 8 * h);
    f16v z = zero16();
#pragma unroll
    for (int ks = 0; ks < 4; ++ks) z = MFMA(kf[ks], qf[ks], z);
    const bool diag = (kt == qt);
    f16v sp;
    float tot = 0.f;
#pragma unroll
    for (int i = 0; i < 16; ++i) {
      const float zz = z[i];
      const float sv = fmaxf(zz, 0.f) + __logf(1.0f + __expf(-fabsf(zz)));
      const bool valid = !diag || (crow(i, h) < r);
      sp[i] = valid ? sv : 0.f;
      tot += sp[i];
    }
    tot += __shfl_xor(tot, 32);
    f16v C = MFMA(tri[0], pack8(sp, 0), zero16());
    C = MFMA(tri[1], pack8(sp, 1), C);
    f16v a;
#pragma unroll
    for (int i = 0; i < 16; ++i) {
      const bool valid = !diag || (crow(i, h) < r);
      a[i] = valid ? __expf(z[i] - C[i] - R) : 0.f;
    }
    const bf8 a0 = pack8(a, 0), a1 = pack8(a, 1);
    o0 = MFMA(vf[0][0], a0, o0); o0 = MFMA(vf[0][1], a1, o0);
    o1 = MFMA(vf[1][0], a0, o1); o1 = MFMA(vf[1][1], a1, o1);
    R += tot;
    if (__all(R > SB_THR)) break;
#pragma unroll
    for (int ks = 0; ks < 4; ++ks) kf[ks] = kfn[ks];
#pragma unroll
    for (int mt = 0; mt < 2; ++mt)
#pragma unroll
      for (int s = 0; s < 2; ++s) vf[mt][s] = vfn[mt][s];
  }
  const int b = bh >> 3, hd = bh & 7;
  u16* dst = (u16*)(ws + OFF_OSB) + ((size_t)b * SEQ + 32 * qt + r) * 512 + hd * 64 + 4 * h;
#pragma unroll
  for (int g = 0; g < 4; ++g) {
    f4v v0 = {o0[4 * g], o0[4 * g + 1], o0[4 * g + 2], o0[4 * g + 3]};
    f4v v1 = {o1[4 * g], o1[4 * g + 1], o1[4 * g + 2], o1[4 * g + 3]};
    *(bf4*)(dst + 8 * g) = cvt4a(v0);
    *(bf4*)(dst + 32 + 8 * g) = cvt4a(v1);
  }
}

DI void gla_g1_tile(const MKParams& p, int tile, int wave, int lane) {
  asm volatile("" : "+v"(lane));
  __builtin_amdgcn_sched_barrier(0);
  char* ws = p.ws;
  const int r = lane & 31, h = lane >> 5;
  const int b = tile >> 5, c = tile & 31, hd = wave >> 1, half = wave & 1, bh = b * 4 + hd;
  const int item = bh * 32 + c;
  char* kl = smem + wave * 9216;
  const u16* GQ = (const u16*)(ws + OFF_GQ) + ((size_t)bh * SEQ + 64 * c) * 64;
  const u16* GK = (const u16*)(ws + OFF_GK) + ((size_t)bh * SEQ + 64 * c) * 64;
  u16* GQ2 = (u16*)(ws + OFF_GQ2) + ((size_t)bh * SEQ + 64 * c) * 64;
  u16* GK2 = (u16*)(ws + OFF_GK2) + ((size_t)bh * SEQ + 64 * c) * 64;
  const float* LA = (const float*)(ws + OFF_LA) + ((size_t)b * SEQ + 64 * c) * 256 + hd * 64;
  float bc = 0.f;
#pragma unroll 1
  for (int g = 0; g < 4; ++g) {
    float la_[16];
    u16 q_[16], k_[16];
#pragma unroll
    for (int i = 0; i < 16; ++i) {
      const int t = 16 * g + i;
      la_[i] = LA[(size_t)t * 256 + lane];
      q_[i] = GQ[t * 64 + lane];
      k_[i] = GK[t * 64 + lane];
    }
#pragma unroll
    for (int i = 0; i < 16; ++i) {
      const int t = 16 * g + i;
      bc += la_[i];
      const float eq = __expf(bc);
      const float qn = bf2f(q_[i]) * eq, kn = bf2f(k_[i]) / eq;
      const bf2 pk = __builtin_convertvector((f2v){qn, kn}, bf2);
      const unsigned u = __builtin_bit_cast(unsigned, pk);
      if (half == 0) {
        GQ2[t * 64 + lane] = (u16)(u & 0xffff);
        GK2[t * 64 + lane] = (u16)(u >> 16);
      }
      *(u16*)(kl + lane * 144 + tpos(t) * 2) = (u16)(u >> 16);
    }
  }
  if (half == 0) ((float*)(ws + OFF_DD))[(size_t)item * 64 + lane] = __expf(bc);
  asm volatile("s_waitcnt lgkmcnt(0)" ::: "memory");
  const u16* GVT = (const u16*)(ws + OFF_GVT) + (size_t)bh * 128 * SEQ + 64 * c;
  float* LKV = (float*)(ws + OFF_LKV) + (size_t)item * 128 * 64;
  bf8 kb[2][4];
#pragma unroll
  for (int nt = 0; nt < 2; ++nt)
#pragma unroll
    for (int s = 0; s < 4; ++s) kb[nt][s] = *(const bf8*)(kl + (32 * nt + r) * 144 + (16 * s + 8 * h) * 2);
  bf8 vf[2][4];
#pragma unroll
  for (int m2 = 0; m2 < 2; ++m2)
#pragma unroll
    for (int s = 0; s < 4; ++s) vf[m2][s] = *(const bf8*)(GVT + (size_t)(32 * (2 * half + m2) + r) * SEQ + 16 * s + 8 * h);
  __builtin_amdgcn_sched_barrier(0);
#pragma unroll
  for (int m2 = 0; m2 < 2; ++m2) {
    const int mt = 2 * half + m2;
    f16v a0 = zero16(), a1 = zero16();
#pragma unroll
    for (int s = 0; s < 4; ++s) {
      a0 = MFMA(vf[m2][s], kb[0][s], a0);
      a1 = MFMA(vf[m2][s], kb[1][s], a1);
    }
#pragma unroll
    for (int i = 0; i < 16; ++i) {
      LKV[(32 * mt + crow(i, h)) * 64 + r] = a0[i];
      LKV[(32 * mt + crow(i, h)) * 64 + 32 + r] = a1[i];
    }
  }
  asm volatile("s_waitcnt lgkmcnt(0)" ::: "memory");
}

DI void gla_g2(const MKParams& p, int gtid, int gthreads) {
  char* ws = p.ws;
  for (int u = gtid; u < 32768; u += gthreads) {
    const int oct = u & 7, dv = (u >> 3) & 127, bh = u >> 10;
    f8v S = {0.f, 0.f, 0.f, 0.f, 0.f, 0.f, 0.f, 0.f};
#pragma unroll 4
    for (int c = 0; c < 32; ++c) {
      const size_t item = (size_t)bh * 32 + c;
      *(bf8*)((u16*)(ws + OFF_SS) + (item * 128 + dv) * 64 + oct * 8) = cvt8(S);
      const f8v l = *(const f8v*)((const float*)(ws + OFF_LKV) + (item * 128 + dv) * 64 + oct * 8);
      const f8v d = *(const f8v*)((const float*)(ws + OFF_DD) + item * 64 + oct * 8);
      S = d * (S + l);
    }
  }
}

DI void gla_g3_tile(const MKParams& p, int tile, int wave, int lane, char* dst, int dst_ld) {
  asm volatile("" : "+s"(wave));
  char* ws = p.ws;
  const int r = lane & 31, h = lane >> 5;
  const int b = tile >> 5, c = tile & 31, hd = wave >> 1, tt = wave & 1, bh = b * 4 + hd;
  const u16* GQ = (const u16*)(ws + OFF_GQ2) + ((size_t)bh * SEQ + 64 * c) * 64;
  const u16* GK = (const u16*)(ws + OFF_GK2) + ((size_t)bh * SEQ + 64 * c) * 64;
  const u16* GVT = (const u16*)(ws + OFF_GVT) + (size_t)bh * 128 * SEQ + 64 * c;
  const u16* SS = (const u16*)(ws + OFF_SS) + ((size_t)(bh * 32 + c) * 128) * 64;
  bf8 qf[4];
#pragma unroll
  for (int ks = 0; ks < 4; ++ks) qf[ks] = *(const bf8*)(GQ + (32 * tt + r) * 64 + 16 * ks + 8 * h);
  bf8 pf[2][2];
  {
    bf8 kf[2][4];
#pragma unroll
    for (int kt = 0; kt < 2; ++kt)
      if (kt <= tt) {
#pragma unroll
        for (int ks = 0; ks < 4; ++ks) kf[kt][ks] = *(const bf8*)(GK + (32 * kt + r) * 64 + 16 * ks + 8 * h);
      }
    __builtin_amdgcn_sched_barrier(0);
#pragma unroll
    for (int kt = 0; kt < 2; ++kt) {
      if (kt <= tt) {
        f16v pt = zero16();
#pragma unroll
        for (int ks = 0; ks < 4; ++ks) pt = MFMA(kf[kt][ks], qf[ks], pt);
        if (kt == tt) {
#pragma unroll
          for (int i = 0; i < 16; ++i) pt[i] = (crow(i, h) <= r) ? pt[i] : 0.f;
        }
        pf[kt][0] = pack8(pt, 0);
        pf[kt][1] = pack8(pt, 1);
      }
    }
  }
  f16v o[4];
  {
    bf8 sf[2][4], vf[2][4];
    auto load_tile = [&](int mt, bf8 (&sfx)[4], bf8 (&vfx)[4]) {
#pragma unroll
      for (int ks = 0; ks < 4; ++ks) sfx[ks] = *(const bf8*)(SS + (32 * mt + r) * 64 + 16 * ks + 8 * h);
#pragma unroll
      for (int kt = 0; kt < 2; ++kt)
        if (kt <= tt) {
#pragma unroll
          for (int s = 0; s < 2; ++s) vfx[2 * kt + s] = *(const bf8*)(GVT + (size_t)(32 * mt + r) * SEQ + 32 * kt + 16 * s + 8 * h);
        }
    };
    load_tile(0, sf[0], vf[0]);
#pragma unroll
    for (int mt = 0; mt < 4; ++mt) {
      if (mt + 1 < 4) load_tile(mt + 1, sf[(mt + 1) & 1], vf[(mt + 1) & 1]);
      __builtin_amdgcn_sched_barrier(0);
      o[mt] = zero16();
#pragma unroll
      for (int ks = 0; ks < 4; ++ks) o[mt] = MFMA(sf[mt & 1][ks], qf[ks], o[mt]);
#pragma unroll
      for (int kt = 0; kt < 2; ++kt)
        if (kt <= tt) {
#pragma unroll
          for (int s = 0; s < 2; ++s) o[mt] = MFMA(vf[mt & 1][2 * kt + s], pf[kt][s], o[mt]);
        }
      __builtin_amdgcn_sched_barrier(0);
    }
  }
  float ss = 0.f;
#pragma unroll
  for (int mt = 0; mt < 4; ++mt)
#pragma unroll
    for (int i = 0; i < 16; ++i) ss += o[mt][i] * o[mt][i];
  ss += __shfl_xor(ss, 32);
  const float rr = rsqrtf(ss * (1.0f / 128.0f) + EPSV);
  const size_t tok = (size_t)tile * 64 + 32 * tt + r;
  const u16* OG = (const u16*)(ws + OFF_OG) + tok * 512 + hd * 128;
#pragma unroll
  for (int mt = 0; mt < 4; ++mt)
#pragma unroll
    for (int g = 0; g < 4; ++g) {
      const int dv0 = 32 * mt + 8 * g + 4 * h;
      const ushort4 og4 = *(const ushort4*)(OG + dv0);
      const f4v gg = *(const f4v*)(p.g_gla + dv0);
      const float og[4] = {bf2f(og4.x), bf2f(og4.y), bf2f(og4.z), bf2f(og4.w)};
      f4v v;
#pragma unroll
      for (int j = 0; j < 4; ++j) v[j] = o[mt][4 * g + j] * rr * gg[j] * (og[j] / (1.0f + __expf(-og[j])));
      *(bf4*)(dst + (size_t)(32 * tt + r) * dst_ld + (hd * 128 + dv0) * 2) = cvt4a(v);
    }
}
DI void gemm_1024(const char* ldsA, const bf8* __restrict__ wf, int wave, int lane, f16v (&a0)[2][2], f16v (&a1)[2][2]) {
  gemm_chunk<true>(ldsA, wf + 2 * wave * 64, lane, a0);
  gemm_chunk<true>(ldsA, wf + 65536 + 2 * wave * 64, lane, a1);
}
DI void gemm_1024_res(const char* ldsA, const bf8* __restrict__ wf, int wave, int lane, f16v (&a0)[2][2], f16v (&a1)[2][2],
                      const float* res) {
  gemm_chunk<true, true>(ldsA, wf + 2 * wave * 64, lane, a0, res + 64 * wave);
  gemm_chunk<true, true>(ldsA, wf + 65536 + 2 * wave * 64, lane, a1, res + 512 + 64 * wave);
}

DI void store_f32_ssq(const f16v (&a)[2][2], float* dst, int f0, int lane, float (&ssq)[2]) {
  const int r = lane & 31, h = lane >> 5;
#pragma unroll
  for (int ntl = 0; ntl < 2; ++ntl)
#pragma unroll
    for (int tt = 0; tt < 2; ++tt)
#pragma unroll
      for (int g = 0; g < 4; ++g) {
        f4v v = {a[ntl][tt][4 * g], a[ntl][tt][4 * g + 1], a[ntl][tt][4 * g + 2], a[ntl][tt][4 * g + 3]};
        ssq[tt] += v[0] * v[0] + v[1] * v[1] + v[2] * v[2] + v[3] * v[3];
        *(f4v*)(dst + (size_t)(32 * tt + r) * DM + f0 + 32 * ntl + 8 * g + 4 * h) = v;
      }
  asm volatile("" : "+v"(ssq[0]), "+v"(ssq[1]));
}

DI void acc_to_scratch(u16* scr, const f16v (&a)[2][2], int f0, int lane, float s0, float s1) {
  const int r = lane & 31, h = lane >> 5;
#pragma unroll
  for (int ntl = 0; ntl < 2; ++ntl)
#pragma unroll
    for (int tt = 0; tt < 2; ++tt)
#pragma unroll
      for (int g = 0; g < 4; ++g) {
        const float sc = tt ? s1 : s0;
        f4v v = {a[ntl][tt][4 * g] * sc, a[ntl][tt][4 * g + 1] * sc, a[ntl][tt][4 * g + 2] * sc, a[ntl][tt][4 * g + 3] * sc};
        *(bf4*)(scr + (size_t)(32 * tt + r) * 1024 + f0 + 32 * ntl + 8 * g + 4 * h) = cvt4(v);
      }
}
typedef __attribute__((ext_vector_type(4))) unsigned u4v;
DI void scratch_to_lds(const u16* scr, char* ldsA, int tid) {
  asm volatile("" : "+v"(tid));
  const unsigned toff = (unsigned)tid * 16u;
#pragma unroll
  for (int half = 0; half < 2; ++half) {
    u4v v[8];
#pragma unroll
    for (int it = 0; it < 8; ++it)
      v[it] = __builtin_nontemporal_load((const u4v*)((const char*)scr + (size_t)(8192 * (8 * half + it)) + toff));
#pragma unroll
    for (int it = 0; it < 8; ++it) {
      const int idx = tid + 512 * (8 * half + it), row = idx >> 7, ch = idx & 127;
      *(u4v*)(ldsA + row * LDS_ROW + ch * 16) = v[it];
    }
  }
}

struct Pk { bf4 v[2][2][4]; };
template <bool ACT = false>
DI void pack_acc(Pk& pk, const f16v (&a)[2][2], float s0, float s1) {
#pragma unroll
  for (int ntl = 0; ntl < 2; ++ntl)
#pragma unroll
    for (int tt = 0; tt < 2; ++tt)
#pragma unroll
      for (int g = 0; g < 4; ++g) {
        const float sc = tt ? s1 : s0;
        f4v v = {a[ntl][tt][4 * g] * sc, a[ntl][tt][4 * g + 1] * sc, a[ntl][tt][4 * g + 2] * sc, a[ntl][tt][4 * g + 3] * sc};
        unsigned long long u = __builtin_bit_cast(unsigned long long, ACT ? cvt4a(v) : cvt4(v));
        asm volatile("" : "+v"(u));
        pk.v[ntl][tt][g] = __builtin_bit_cast(bf4, u);
      }
}
DI void pk_to_lds(char* ldsA, const Pk& pk, int f0, int lane) {
  const int r = lane & 31, h = lane >> 5;
#pragma unroll
  for (int ntl = 0; ntl < 2; ++ntl)
#pragma unroll
    for (int tt = 0; tt < 2; ++tt)
#pragma unroll
      for (int g = 0; g < 4; ++g)
        *(bf4*)(ldsA + (32 * tt + r) * LDS_ROW + (f0 + 32 * ntl + 8 * g + 4 * h) * 2) = pk.v[ntl][tt][g];
}

DI void rms_from_partials(float* red, int wave, int lane, const float (&ssq)[2], float& rs0, float& rs1) {
  red[(wave * 2 + 0) * 64 + lane] = ssq[0];
  red[(wave * 2 + 1) * 64 + lane] = ssq[1];
  __syncthreads();
  const int r = lane & 31;
  float t0 = 0.f, t1 = 0.f;
#pragma unroll
  for (int w = 0; w < 8; ++w) {
    t0 += red[(w * 2 + 0) * 64 + r] + red[(w * 2 + 0) * 64 + 32 + r];
    t1 += red[(w * 2 + 1) * 64 + r] + red[(w * 2 + 1) * 64 + 32 + r];
  }
  rs0 = rsqrtf(t0 * (1.0f / DM) + EPSV);
  rs1 = rsqrtf(t1 * (1.0f / DM) + EPSV);
}

template <bool WRITE = true>
DI void mem_attn(const MKParams& p, char* ldsA, int b, int wave, int lane) {
  char* ws = p.ws;
  const int r = lane & 31, h = lane >> 5;
  const int hm = wave >> 1, tt = wave & 1;
  const char* KM = ws + OFF_KM + (size_t)(b * 4 + hm) * 256 * 256 * 2;
  const char* VMT = ws + OFF_VMT + (size_t)(b * 4 + hm) * 256 * 256 * 2;
  char* qrow = ldsA + (32 * tt + r) * LDS_ROW + hm * 512;
  const unsigned loff = (unsigned)((r * 256 + 8 * h) * 2);
  f16v s[8];
#pragma unroll
  for (int mt = 0; mt < 8; ++mt) s[mt] = zero16();
  bf8 ka[8], kb[8];
#pragma unroll
  for (int mt = 0; mt < 8; ++mt) ka[mt] = *(const bf8*)(KM + (size_t)(mt * 32 * 256 * 2) + loff);
  bf8 qa = *(const bf8*)(qrow + 8 * h * 2), qb;
#pragma unroll 1
  for (int ks = 0; ks < 16; ks += 2) {
#if ATTN_LOCKSTEP
    __builtin_amdgcn_s_barrier();
#endif
#pragma unroll
    for (int mt = 0; mt < 8; ++mt) kb[mt] = *(const bf8*)(KM + (size_t)((mt * 32 * 256 + 16 * (ks + 1)) * 2) + loff);
    qb = *(const bf8*)(qrow + (16 * (ks + 1) + 8 * h) * 2);
#pragma unroll
    for (int mt = 0; mt < 8; ++mt) s[mt] = MFMA(ka[mt], qa, s[mt]);
    __builtin_amdgcn_sched_group_barrier(0x020, 8, 0);
    __builtin_amdgcn_sched_group_barrier(0x100, 1, 0);
    __builtin_amdgcn_sched_group_barrier(0x008, 8, 0);
    if (ks + 2 < 16) {
#pragma unroll
      for (int mt = 0; mt < 8; ++mt) ka[mt] = *(const bf8*)(KM + (size_t)((mt * 32 * 256 + 16 * (ks + 2)) * 2) + loff);
      qa = *(const bf8*)(qrow + (16 * (ks + 2) + 8 * h) * 2);
    }
#pragma unroll
    for (int mt = 0; mt < 8; ++mt) s[mt] = MFMA(kb[mt], qb, s[mt]);
    __builtin_amdgcn_sched_group_barrier(0x020, 8, 0);
    __builtin_amdgcn_sched_group_barrier(0x100, 1, 0);
    __builtin_amdgcn_sched_group_barrier(0x008, 8, 0);
  }
  float mx = -INFINITY;
#pragma unroll
  for (int mt = 0; mt < 8; ++mt)
#pragma unroll
    for (int i = 0; i < 16; ++i) mx = fmaxf(mx, s[mt][i]);
  mx = fmaxf(mx, __shfl_xor(mx, 32));
  float l = 0.f;
  bf8 pf[8][2];
#pragma unroll
  for (int mt = 0; mt < 8; ++mt) {
#pragma unroll
    for (int i = 0; i < 16; ++i) { s[mt][i] = __expf(s[mt][i] - mx); l += s[mt][i]; }
    pf[mt][0] = pack8(s[mt], 0);
    pf[mt][1] = pack8(s[mt], 1);
  }
  l += __shfl_xor(l, 32);
  const float inv = 1.0f / l;
#pragma unroll
  for (int grp = 0; grp < 2; ++grp) {
    f16v o[4];
#pragma unroll
    for (int m4 = 0; m4 < 4; ++m4) o[m4] = zero16();
    const char* vb = VMT + (size_t)(grp * 4 * 32 * 256 * 2) + loff;
    bf8 va[4], vn[4];
#pragma unroll
    for (int m4 = 0; m4 < 4; ++m4) va[m4] = *(const bf8*)(vb + (size_t)(m4 * 32 * 256 * 2));
#pragma unroll
    for (int st = 0; st < 16; ++st) {
#if ATTN_LOCKSTEP
      if ((st & 1) == 0) __builtin_amdgcn_s_barrier();
#endif
      if (st + 1 < 16) {
#pragma unroll
        for (int m4 = 0; m4 < 4; ++m4) vn[m4] = *(const bf8*)(vb + (size_t)((m4 * 32 * 256 + 16 * (st + 1)) * 2));
      }
#pragma unroll
      for (int m4 = 0; m4 < 4; ++m4) o[m4] = MFMA(va[m4], pf[st >> 1][st & 1], o[m4]);
      if (st + 1 < 16) {
        __builtin_amdgcn_sched_group_barrier(0x020, 4, 0);
        __builtin_amdgcn_sched_group_barrier(0x008, 4, 0);
#pragma unroll
        for (int m4 = 0; m4 < 4; ++m4) va[m4] = vn[m4];
      }
    }
#pragma unroll
    for (int m4 = 0; m4 < 4; ++m4)
#pragma unroll
      for (int g = 0; g < 4; ++g) {
        f4v v = {o[m4][4 * g] * inv, o[m4][4 * g + 1] * inv, o[m4][4 * g + 2] * inv, o[m4][4 * g + 3] * inv};
        if (WRITE || v[0] == 123.456f) *(bf4*)(qrow + (32 * (4 * grp + m4) + 8 * g + 4 * h) * 2) = cvt4a(v);
      }
  }
}

DI void phase_c_tile(const MKParams& p, int tile, int wave, int lane, float& rs0, float& rs1, RingC& rg) {
  asm volatile("" : "+v"(lane));
  char* ws = p.ws;
  char* ldsA = smem;
  float* red = (float*)(smem + LDS_A_BYTES);
  const size_t tok0 = (size_t)tile * 64;
  const int tid = wave * 64 + lane;
  __syncthreads();
#if W8
  ring8_fill(rg, (const uint4*)(ws + OFF_WOUT) + 2 * wave * 64, lane);
#else
  ring_fill(rg, (const bf8*)(ws + OFF_WOUT) + 2 * wave * 64, lane);
#endif
  const unsigned pf0 = l2_touch(ws + OFF_WOUT, lane), pf1 = l2_touch(ws + OFF_WOUT + 1048576, lane);
#if PROBE == 15
  gla_g3_tile(p, tile, wave, lane, ldsA, LDS_ROW);
  __builtin_amdgcn_sched_barrier(0);
  asm volatile("" : "+v"(lane));
#endif
  {
  gla_g3_tile(p, tile, wave, lane, ldsA, LDS_ROW);
  {
    const char* osb = ws + OFF_OSB + tok0 * 1024;
#pragma unroll
    for (int it = 0; it < 8; ++it) {
      const int idx = tid + 512 * it, row = idx >> 6, ch = idx & 63;
      *(uint4*)(ldsA + row * LDS_ROW + 1024 + ch * 16) = *(const uint4*)(osb + (size_t)row * 1024 + ch * 16);
    }
  }
  }
  __syncthreads();
  l2_sink(pf0); l2_sink(pf1);
  f16v acc[2][2];
  Pk pk0, pk1;
  float* hdst = p.out + tok0 * DM;
#if W8
  const float* csb = (const float*)(ws + OFF_CS);
  const float* icsb = (const float*)(ws + OFF_ICS);
  {
    float ssq[2] = {0.f, 0.f};
    const uint4* wf = (const uint4*)(ws + OFF_WOUT);
    asm volatile("" : "+v"(lane));
    gemm_chunk_w8<true, true, false, true, false>(ldsA, wf + 2 * wave * 64, wf + 32768 + 2 * wave * 64, lane, acc, rg, p.x + tok0 * DM + 64 * wave, icsb + 4096 + 64 * wave);
    scale_cols(acc, csb + 4096 + 64 * wave, lane);
    store_f32_ssq(acc, hdst, 64 * wave, lane, ssq);
    pack_acc<true>(pk0, acc, 1.f, 1.f);
    asm volatile("" : "+v"(lane));
    gemm_chunk_w8<true, true, false, true, true>(ldsA, wf + 32768 + 2 * wave * 64, (const uint4*)(ws + OFF_WMQ) + 2 * wave * 64, lane, acc, rg, p.x + tok0 * DM + 512 + 64 * wave, icsb + 4096 + 512 + 64 * wave);
    scale_cols(acc, csb + 4096 + 512 + 64 * wave, lane);
    store_f32_ssq(acc, hdst, 512 + 64 * wave, lane, ssq);
    pack_acc<true>(pk1, acc, 1.f, 1.f);
    rms_from_partials(red, wave, lane, ssq, rs0, rs1);
  }
  pk_to_lds(ldsA, pk0, 64 * wave, lane);
  pk_to_lds(ldsA, pk1, 512 + 64 * wave, lane);
  __syncthreads();
  {
    const uint4* wf = (const uint4*)(ws + OFF_WMQ);
    asm volatile("" : "+v"(lane));
#if PROBE == 84 || PROBE == 85 || PROBE == 86
    for (int rep_ = 0; rep_ < 4; ++rep_) {
      Ring8 rg2;
      f16v acc2[2][2];
#if PROBE == 85
      gemm_chunk_w8<true, false, false, false, false, 1>(ldsA, wf + 2 * wave * 64, nullptr, lane, acc2, rg);
#else
      gemm_chunk_w8<true, false, true, false, false, (PROBE == 86 ? 2 : 0)>(ldsA, wf + 2 * wave * 64, nullptr, lane, acc2, rg2);
#endif
      asm volatile("" :: "v"(acc2[0][0]), "v"(acc2[0][1]), "v"(acc2[1][0]), "v"(acc2[1][1]));
      asm volatile("" : "+v"(lane));
    }
#endif
    gemm_chunk_w8<true, false, false, true, true>(ldsA, wf + 2 * wave * 64, wf + 32768 + 2 * wave * 64, lane, acc, rg);
    scale_cols(acc, csb + 8192 + 64 * wave, lane);
    pack_acc(pk0, acc, rs0, rs1);
    asm volatile("" : "+v"(lane));
    gemm_chunk_w8<true, false, false, false, true>(ldsA, wf + 32768 + 2 * wave * 64, nullptr, lane, acc, rg);
    scale_cols(acc, csb + 8192 + 512 + 64 * wave, lane);
    pack_acc(pk1, acc, rs0, rs1);
  }
  __syncthreads();
  pk_to_lds(ldsA, pk0, 64 * wave, lane);
  pk_to_lds(ldsA, pk1, 512 + 64 * wave, lane);
  __syncthreads();
  asm volatile("" : "+v"(lane));
  mem_attn<true>(p, ldsA, tile >> 5, wave, lane);
  __syncthreads();
  {
    float ssq[2] = {0.f, 0.f};
    const uint4* wf = (const uint4*)(ws + OFF_WMO);
    asm volatile("" : "+v"(lane));
    gemm_chunk_w8<true, true, true, true, false>(ldsA, wf + 2 * wave * 64, wf + 32768 + 2 * wave * 64, lane, acc, rg, hdst + 64 * wave, icsb + 12288 + 64 * wave);
    scale_cols(acc, csb + 12288 + 64 * wave, lane);
    store_f32_ssq(acc, hdst, 64 * wave, lane, ssq);
    pack_acc<true>(pk0, acc, 1.f, 1.f);
    asm volatile("" : "+v"(lane));
    gemm_chunk_w8<true, true, false, true, true>(ldsA, wf + 32768 + 2 * wave * 64, (const uint4*)(ws + OFF_WPQ) + 2 * wave * 64, lane, acc, rg, hdst + 512 + 64 * wave, icsb + 12288 + 512 + 64 * wave);
    scale_cols(acc, csb + 12288 + 512 + 64 * wave, lane);
    store_f32_ssq(acc, hdst, 512 + 64 * wave, lane, ssq);
    pack_acc<true>(pk1, acc, 1.f, 1.f);
    rms_from_partials(red, wave, lane, ssq, rs0, rs1);
  }
  pk_to_lds(ldsA, pk0, 64 * wave, lane);
  pk_to_lds(ldsA, pk1, 512 + 64 * wave, lane);
  __syncthreads();
}
#else
  {
    float ssq[2] = {0.f, 0.f};
    const bf8* wf = (const bf8*)(ws + OFF_WOUT);
    asm volatile("" : "+v"(lane));
    { const unsigned pf = l2_touch(ws + OFF_WMQ, lane);
    gemm_chunk_r<true, true, false, true>(ldsA, wf + 2 * wave * 64, wf + 65536 + 2 * wave * 64, lane, acc, rg, p.x + tok0 * DM + 64 * wave);
      l2_sink(pf); }
    store_f32_ssq(acc, hdst, 64 * wave, lane, ssq);
    pack_acc(pk0, acc, 1.f, 1.f);
    asm volatile("" : "+v"(lane));
    { const unsigned pf = l2_touch(ws + OFF_WMQ + 1048576, lane);
    gemm_chunk_r<true, true, false, true>(ldsA, wf + 65536 + 2 * wave * 64, (const bf8*)(ws + OFF_WMQ) + 2 * wave * 64, lane, acc, rg, p.x + tok0 * DM + 512 + 64 * wave);
      l2_sink(pf); }
    store_f32_ssq(acc, hdst, 512 + 64 * wave, lane, ssq);
    pack_acc(pk1, acc, 1.f, 1.f);
    rms_from_partials(red, wave, lane, ssq, rs0, rs1);
  }
  pk_to_lds(ldsA, pk0, 64 * wave, lane);
  pk_to_lds(ldsA, pk1, 512 + 64 * wave, lane);
  __syncthreads();
  {
    const bf8* wf = (const bf8*)(ws + OFF_WMQ);
    asm volatile("" : "+v"(lane));
    { const unsigned pf = l2_touch(ws + OFF_WMO, lane);
    gemm_chunk_r<true, false, false, true>(ldsA, wf + 2 * wave * 64, wf + 65536 + 2 * wave * 64, lane, acc, rg);
      l2_sink(pf); }
    pack_acc(pk0, acc, rs0, rs1);
    asm volatile("" : "+v"(lane));
    { const unsigned pf = l2_touch(ws + OFF_WMO + 1048576, lane);
    gemm_chunk_r<true, false, false, false>(ldsA, wf + 65536 + 2 * wave * 64, nullptr, lane, acc, rg);
      l2_sink(pf); }
    pack_acc(pk1, acc, rs0, rs1);
  }
  __syncthreads();
  pk_to_lds(ldsA, pk0, 64 * wave, lane);
  pk_to_lds(ldsA, pk1, 512 + 64 * wave, lane);
  __syncthreads();
#if PROBE == 22
  asm volatile("" : "+v"(lane));
  mem_attn<false>(p, ldsA, tile >> 5, wave, lane);
#endif
  asm volatile("" : "+v"(lane));
  mem_attn<true>(p, ldsA, tile >> 5, wave, lane);
  __syncthreads();
  {
    float ssq[2] = {0.f, 0.f};
    const bf8* wf = (const bf8*)(ws + OFF_WMO);
    asm volatile("" : "+v"(lane));
    { const unsigned pf = l2_touch(ws + OFF_WPQ, lane);
    gemm_chunk_r<true, true, true, true>(ldsA, wf + 2 * wave * 64, wf + 65536 + 2 * wave * 64, lane, acc, rg, hdst + 64 * wave);
      l2_sink(pf); }
    store_f32_ssq(acc, hdst, 64 * wave, lane, ssq);
    pack_acc(pk0, acc, 1.f, 1.f);
    asm volatile("" : "+v"(lane));
    { const unsigned pf = l2_touch(ws + OFF_WPQ + 1048576, lane);
    gemm_chunk_r<true, true, false, true>(ldsA, wf + 65536 + 2 * wave * 64, (const bf8*)(ws + OFF_WPQ) + 2 * wave * 64, lane, acc, rg, hdst + 512 + 64 * wave);
      l2_sink(pf); }
    store_f32_ssq(acc, hdst, 512 + 64 * wave, lane, ssq);
    pack_acc(pk1, acc, 1.f, 1.f);
    rms_from_partials(red, wave, lane, ssq, rs0, rs1);
  }
  pk_to_lds(ldsA, pk0, 64 * wave, lane);
  pk_to_lds(ldsA, pk1, 512 + 64 * wave, lane);
  __syncthreads();
}
#endif
#define OFF_EG (OFF_LKV + 16 * MiB)

DI unsigned f2ord(float v) { const unsigned u = __float_as_uint(v); return (u & 0x80000000u) ? ~u : (u | 0x80000000u); }
DI float ord2f(unsigned u) { return __uint_as_float((u & 0x80000000u) ? (u ^ 0x80000000u) : ~u); }

#define CEX(a, b) { const unsigned hi_ = max(k[a], k[b]); const unsigned lo_ = min(k[a], k[b]); k[a] = hi_; k[b] = lo_; }
DI void sort16_desc(unsigned (&k)[16]) {
  CEX(0, 1) CEX(2, 3) CEX(0, 2) CEX(1, 3) CEX(1, 2) CEX(4, 5) CEX(6, 7) CEX(4, 6) CEX(5, 7) CEX(5, 6) CEX(0, 4)
  CEX(2, 6) CEX(2, 4) CEX(1, 5) CEX(3, 7) CEX(3, 5) CEX(1, 2) CEX(3, 4) CEX(5, 6) CEX(8, 9) CEX(10, 11) CEX(8, 10)
  CEX(9, 11) CEX(9, 10) CEX(12, 13) CEX(14, 15) CEX(12, 14) CEX(13, 15) CEX(13, 14) CEX(8, 12) CEX(10, 14) CEX(10, 12)
  CEX(9, 13) CEX(11, 15) CEX(11, 13) CEX(9, 10) CEX(11, 12) CEX(13, 14) CEX(0, 8) CEX(4, 12) CEX(4, 8) CEX(2, 10)
  CEX(6, 14) CEX(6, 10) CEX(2, 4) CEX(6, 8) CEX(10, 12) CEX(1, 9) CEX(5, 13) CEX(5, 9) CEX(3, 11) CEX(7, 15) CEX(7, 11)
  CEX(3, 5) CEX(7, 9) CEX(11, 13) CEX(1, 2) CEX(3, 4) CEX(5, 6) CEX(7, 8) CEX(9, 10) CEX(11, 12) CEX(13, 14)
}
DI void merge_top16(unsigned (&t)[16], const unsigned (&u)[16]) {
#pragma unroll
  for (int s = 0; s < 16; ++s) t[s] = max(t[s], u[15 - s]);
#pragma unroll
  for (int d = 8; d > 0; d >>= 1)
#pragma unroll
    for (int i = 0; i < 16; ++i)
      if ((i & d) == 0) {
        const unsigned hi = max(t[i], t[i + d]), lo = min(t[i], t[i + d]);
        t[i] = hi; t[i + d] = lo;
      }
}

DI void ins16(unsigned (&L)[16], unsigned x) {
#pragma unroll
  for (int s = 0; s < 16; ++s) {
    const unsigned hi = max(L[s], x);
    x = min(L[s], x);
    L[s] = hi;
  }
}
DI void merge_halves16(unsigned (&L)[16]) {
  unsigned O[16];
#pragma unroll
  for (int s = 0; s < 16; ++s) O[s] = (unsigned)__shfl_xor((int)L[s], 32);
#pragma unroll
  for (int s = 0; s < 16; ++s) L[s] = max(L[s], O[15 - s]);
#pragma unroll
  for (int d = 8; d > 0; d >>= 1)
#pragma unroll
    for (int i = 0; i < 16; ++i)
      if ((i & d) == 0) {
        const unsigned hi = max(L[i], L[i + d]), lo = min(L[i], L[i + d]);
        L[i] = hi; L[i + d] = lo;
      }
}

DI void peer_top16(const char* ws, const u16* qp, int hp, int tt, int lane, unsigned (&L)[16]) {
  const int r = lane & 31, h = lane >> 5;
  const bf8* sk = (const bf8*)(ws + OFF_SUBK) + (size_t)hp * 4 * 8 * 64 + lane;
  f16v s[4];
#pragma unroll
  for (int mt = 0; mt < 4; ++mt) s[mt] = zero16();
  bf8 qf[8];
#pragma unroll
  for (int ks = 0; ks < 8; ++ks) qf[ks] = *(const bf8*)(qp + (size_t)(32 * tt + r) * 2048 + hp * 128 + 16 * ks + 8 * h);
#pragma unroll
  for (int half = 0; half < 2; ++half) {
    bf8 kf[4][4];
#pragma unroll
    for (int k4 = 0; k4 < 4; ++k4)
#pragma unroll
      for (int mt = 0; mt < 4; ++mt) kf[k4][mt] = sk[(mt * 8 + 4 * half + k4) * 64];
    __builtin_amdgcn_sched_barrier(0);
#pragma unroll
    for (int k4 = 0; k4 < 4; ++k4)
#pragma unroll
      for (int mt = 0; mt < 4; ++mt) s[mt] = MFMA(kf[k4][mt], qf[4 * half + k4], s[mt]);
    __builtin_amdgcn_sched_barrier(0);
  }
  unsigned K1[16], K2[16], K3[16];
#pragma unroll
  for (int i = 0; i < 16; ++i) {
    L[i] = (f2ord(s[0][i]) & ~127u) | (unsigned)(127 - (crow(i, h)));
    K1[i] = (f2ord(s[1][i]) & ~127u) | (unsigned)(127 - (32 + crow(i, h)));
    K2[i] = (f2ord(s[2][i]) & ~127u) | (unsigned)(127 - (64 + crow(i, h)));
    K3[i] = (f2ord(s[3][i]) & ~127u) | (unsigned)(127 - (96 + crow(i, h)));
  }
  sort16_desc(L); sort16_desc(K1); sort16_desc(K2); sort16_desc(K3);
  merge_top16(L, K1);
  merge_top16(K2, K3);
  merge_top16(L, K2);
  merge_halves16(L);
}

DI void peer_select(const char* ws, const u16* qp, uint2* eg, unsigned char* idxs  , int head,
                    int tt, int lane) {
  const int r = lane & 31, h = lane >> 5;
  unsigned La[16], Lb[16];
  peer_top16(ws, qp, 2 * head, tt, lane, La);
  __builtin_amdgcn_sched_barrier(0);
  peer_top16(ws, qp, 2 * head + 1, tt, lane, Lb);
  __builtin_amdgcn_sched_barrier(0);
  if (h == 0) {
#pragma unroll
    for (int g = 0; g < 4; ++g) {
      unsigned wa = 0, wb = 0;
#pragma unroll
      for (int j = 0; j < 4; ++j) {
        wa |= (127u - (La[4 * g + j] & 127u)) << (8 * j);
        wb |= (127u - (Lb[4 * g + j] & 127u)) << (8 * j);
      }
      *(unsigned*)(idxs + r * 32 + 4 * g) = wa;
      *(unsigned*)(idxs + r * 32 + 16 + 4 * g) = wb;
    }
  }
  float fa[16], fb[16];
#pragma unroll
  for (int i = 0; i < 16; ++i) { fa[i] = ord2f(La[i] & ~127u); fb[i] = ord2f(Lb[i] & ~127u); }
  unsigned C[16];
#pragma unroll
  for (int i = 0; i < 16; ++i) C[i] = (f2ord(fa[0] + fb[i]) & ~255u) | (unsigned)(255 - i);
#define PEER_KEY(a, b) ((f2ord(fa[a] + fb[b]) & ~255u) | (unsigned)(255 - ((a) * 16 + (b))))
  {
    unsigned U[16] = {PEER_KEY(1, 0), PEER_KEY(1, 1), PEER_KEY(1, 2), PEER_KEY(1, 3), PEER_KEY(1, 4), PEER_KEY(1, 5), PEER_KEY(1, 6), PEER_KEY(1, 7),
                      PEER_KEY(2, 0), PEER_KEY(2, 1), PEER_KEY(2, 2), PEER_KEY(2, 3), PEER_KEY(2, 4), PEER_KEY(3, 0), PEER_KEY(3, 1), PEER_KEY(3, 2)};
    sort16_desc(U);
    merge_top16(C, U);
  }
  {
    unsigned U[16] = {PEER_KEY(3, 3), PEER_KEY(4, 0), PEER_KEY(4, 1), PEER_KEY(4, 2), PEER_KEY(5, 0), PEER_KEY(5, 1), PEER_KEY(6, 0), PEER_KEY(6, 1),
                      PEER_KEY(7, 0), PEER_KEY(7, 1), PEER_KEY(8, 0), PEER_KEY(9, 0), PEER_KEY(10, 0), PEER_KEY(11, 0), PEER_KEY(12, 0), PEER_KEY(13, 0)};
    sort16_desc(U);
    merge_top16(C, U);
  }
  ins16(C, PEER_KEY(14, 0));
  ins16(C, PEER_KEY(15, 0));
#undef PEER_KEY
  asm volatile("s_waitcnt lgkmcnt(0)" ::: "memory");
  const float vmax = ord2f(C[0] & ~255u);
  float ex[16], sum = 0.f;
#pragma unroll
  for (int i = 0; i < 16; ++i) { ex[i] = __expf(ord2f(C[i] & ~255u) - vmax); sum += ex[i]; }
  const float inv = 1.0f / sum;
  const unsigned hmask = 0u - (unsigned)h;
#pragma unroll
  for (int i = 0; i < 8; ++i) {
    const unsigned ck = C[i] ^ ((C[i] ^ C[8 + i]) & hmask);
    const unsigned gb = __float_as_uint(ex[i]) ^ ((__float_as_uint(ex[i]) ^ __float_as_uint(ex[8 + i])) & hmask);
    const float g = __uint_as_float(gb) * inv;
    const unsigned code = 255u - (ck & 255u);
    const unsigned ia = idxs[r * 32 + (code >> 4)], ib = idxs[r * 32 + 16 + (code & 15u)];
    eg[(size_t)(32 * tt + r) * 128 + head * 16 + 8 * h + i] = make_uint2(ia * 128u + ib, __float_as_uint(g));
  }
  asm volatile("s_waitcnt lgkmcnt(0)" ::: "memory");
}

DI float wave_sum(float v) {
#pragma unroll
  for (int o = 32; o > 0; o >>= 1) v += __shfl_xor(v, o);
  return v;
}

DI void reduce8(const int (&pv)[8], int& s0, int& s1) {
  int q[4], s[2];
#pragma unroll
  for (int m = 0; m < 4; ++m) {
    const auto r = __builtin_amdgcn_permlane32_swap((unsigned)pv[m], (unsigned)pv[m + 4], false, false);
    q[m] = (int)(r[0] + r[1]);
  }
#pragma unroll
  for (int m = 0; m < 2; ++m) {
    const auto r = __builtin_amdgcn_permlane16_swap((unsigned)q[m], (unsigned)q[m + 2], false, false);
    s[m] = (int)(r[0] + r[1]);
  }
#pragma unroll
  for (int m = 0; m < 2; ++m) {
    s[m] += __builtin_amdgcn_update_dpp(0, s[m], 0x128, 0xf, 0xf, false);
    s[m] += __builtin_amdgcn_update_dpp(0, s[m], 0x124, 0xf, 0xf, false);
    s[m] += __builtin_amdgcn_update_dpp(0, s[m], 0x122, 0xf, 0xf, false);
    s[m] += __builtin_amdgcn_update_dpp(0, s[m], 0x121, 0xf, 0xf, false);
  }
  s0 = s[0]; s1 = s[1];
}

DI void peer_quant_x(char* ldsA, int wave, int lane, float (&xdq)[8]) {
#pragma unroll
  for (int i = 0; i < 8; ++i) {
    char* xrow = ldsA + (8 * wave + i) * LDS_ROW;
    const uint4 x0 = *(const uint4*)(xrow + 32 * lane), x1 = *(const uint4*)(xrow + 32 * lane + 16);
    const unsigned xr[8] = {x0.x, x0.y, x0.z, x0.w, x1.x, x1.y, x1.z, x1.w};
    float f[16];
    float am = 0.f;
#pragma unroll
    for (int q = 0; q < 8; ++q) {
#if W8F
      const hf2 hh = __builtin_bit_cast(hf2, xr[q]);
      f[2 * q] = (float)hh[0];
      f[2 * q + 1] = (float)hh[1];
#else
      f[2 * q] = __uint_as_float(xr[q] << 16);
      f[2 * q + 1] = __uint_as_float(xr[q] & 0xffff0000u);
#endif
      am = fmaxf(am, fmaxf(fabsf(f[2 * q]), fabsf(f[2 * q + 1])));
    }
#pragma unroll
    for (int o = 32; o > 0; o >>= 1) am = fmaxf(am, __shfl_xor(am, o));
    const float sc = (am > 0.f) ? 127.0f / am : 0.f;
    unsigned w[4];
#pragma unroll
    for (int q = 0; q < 4; ++q) {
      unsigned pk = 0;
#pragma unroll
      for (int j = 0; j < 4; ++j) pk |= ((unsigned)((int)rintf(f[4 * q + j] * sc)) & 0xffu) << (8 * j);
      w[q] = pk;
    }
    asm volatile("s_waitcnt lgkmcnt(0)" ::: "memory");
    *(uint4*)(xrow + 16 * lane) = make_uint4(w[0], w[1], w[2], w[3]);
    xdq[i] = am * (1.0f / 127.0f);
  }
  asm volatile("s_waitcnt lgkmcnt(0)" ::: "memory");
}

DI void peer_bucket_token(const uint2* egt, unsigned* tmp  , int lane, unsigned& E0, unsigned& E1,
                          unsigned& G0, unsigned& G1) {
  const uint2 a = egt[lane], b = egt[64 + lane];
  const int ba = (int)(a.x >> SWEEP_SH), bb = (int)(b.x >> SWEEP_SH);
  const unsigned long long lt = (1ull << lane) - 1ull;
  int da = 0, db = 0, start = 0;
#pragma unroll
  for (int k = 0; k < SWEEP_NB; ++k) {
    const unsigned long long ma = __ballot(ba == k), mb = __ballot(bb == k);
    const int ca = __popcll(ma), cb = __popcll(mb);
    if (ba == k) da = start + __popcll(ma & lt);
    if (bb == k) db = start + ca + __popcll(mb & lt);
    start += ca + cb;
  }
  const int ia = (da & 1) * 64 + (da >> 3) + 16 * ((da >> 1) & 3);
  const int ib = (db & 1) * 64 + (db >> 3) + 16 * ((db >> 1) & 3);
  tmp[ia] = a.x; tmp[128 + ia] = a.y;
  tmp[ib] = b.x; tmp[128 + ib] = b.y;
  asm volatile("s_waitcnt lgkmcnt(0)" ::: "memory");
  E0 = tmp[lane]; E1 = tmp[64 + lane]; G0 = tmp[128 + lane]; G1 = tmp[192 + lane];
  asm volatile("s_waitcnt lgkmcnt(0)" ::: "memory");
}

template <bool GWRITE = true>
DI void peer_finalize_token(const MKParams& p, float (&acc)[16], size_t tok, int lane) {
  float* orow = p.out + tok * DM + 16 * lane;
  float ss = 0.f;
#pragma unroll
  for (int q = 0; q < 4; ++q) {
    const f4v hv = *(const f4v*)(orow + 4 * q);
#pragma unroll
    for (int j = 0; j < 4; ++j) { acc[4 * q + j] += hv[j]; ss += acc[4 * q + j] * acc[4 * q + j]; }
  }
  ss = wave_sum(ss);
  const float rf = rsqrtf(ss * (1.0f / DM) + EPSV);
#pragma unroll
  for (int q = 0; q < 4; ++q) {
    const f4v gg = *(const f4v*)(p.g_fin + 16 * lane + 4 * q);
    f4v o = {acc[4 * q] * rf * gg[0], acc[4 * q + 1] * rf * gg[1], acc[4 * q + 2] * rf * gg[2], acc[4 * q + 3] * rf * gg[3]};
    if (GWRITE || o[0] == 123.456f) *(f4v*)(orow + 4 * q) = o;
  }
}

DI void peer_usweep(const char* ws, const char* ldsA, int wave, int lane, const unsigned (&E)[8][2], int (&A)[8][2]) {
  const char* PU = ws + OFF_PU + 16 * lane;
#pragma unroll
  for (int i = 0; i < 8; ++i) { A[i][0] = 0; A[i][1] = 0; }
  int jn[8];
#pragma unroll
  for (int i = 0; i < 8; ++i) jn[i] = 0;
#pragma unroll 1
  for (int k = 0; k < SWEEP_NB; ++k) {
#pragma unroll
    for (int i = 0; i < 8; ++i) {
      while (jn[i] < 16 && (__builtin_amdgcn_readlane((int)E[i][0], jn[i]) >> SWEEP_SH) <= k) {
        const int j = jn[i];
        const bool sel = ((lane & 15) == j);
        const uint4 xq = *(const uint4*)(ldsA + (8 * wave + i) * LDS_ROW + 16 * lane);
        uint4 u0[8];
#pragma unroll
        for (int m = 0; m < 8; ++m) {
          const int e = __builtin_amdgcn_readlane((int)E[i][m & 1], j + 16 * (m >> 1));
          u0[m] = *(const uint4*)(PU + (size_t)e * 1024);
        }
        int pv[8];
#pragma unroll
        for (int m = 0; m < 8; ++m) {
          int dsum = __builtin_amdgcn_sdot4((int)u0[m].x, (int)xq.x, 0, false);
          dsum = __builtin_amdgcn_sdot4((int)u0[m].y, (int)xq.y, dsum, false);
          dsum = __builtin_amdgcn_sdot4((int)u0[m].z, (int)xq.z, dsum, false);
          dsum = __builtin_amdgcn_sdot4((int)u0[m].w, (int)xq.w, dsum, false);
          pv[m] = dsum;
        }
        int s0, s1;
        reduce8(pv, s0, s1);
        A[i][0] = sel ? s0 : A[i][0];
        A[i][1] = sel ? s1 : A[i][1];
        jn[i] = j + 1;
      }
    }
  }
}

#ifndef VT
#define VT 8
#endif
template <int T0, bool GWRITE = true>
DI void peer_vsweep(const MKParams& p, int wave, int lane, size_t tok0, const unsigned (&E)[8][2], const unsigned (&WQ)[8],
                    const float (&tsc)[8]) {
  const char* PV = p.ws + OFF_PV + 16 * lane;
  int acc[VT][16];
#pragma unroll
  for (int i = 0; i < VT; ++i)
#pragma unroll
    for (int q = 0; q < 16; ++q) acc[i][q] = 0;
  int jn[VT];
#pragma unroll
  for (int i = 0; i < VT; ++i) jn[i] = 0;
#pragma unroll 1
  for (int k = 0; k < SWEEP_NB; ++k) {
#pragma unroll
    for (int i = 0; i < VT; ++i) {
      while (jn[i] < 16 && (__builtin_amdgcn_readlane((int)E[T0 + i][0], jn[i]) >> SWEEP_SH) <= k) {
        const int j = jn[i];
        uint4 v0[8];
#pragma unroll
        for (int m = 0; m < 8; ++m) {
          const int e = __builtin_amdgcn_readlane((int)E[T0 + i][m & 1], j + 16 * (m >> 1));
          v0[m] = *(const uint4*)(PV + (size_t)e * 1024);
        }
        const int wq0 = __builtin_amdgcn_readlane((int)WQ[T0 + i], j);
        const int wq1 = __builtin_amdgcn_readlane((int)WQ[T0 + i], j + 32);
#pragma unroll
        for (int rq = 0; rq < 2; ++rq) {
          const int wq = rq ? wq1 : wq0;
          const unsigned r0[4] = {v0[4 * rq].x, v0[4 * rq].y, v0[4 * rq].z, v0[4 * rq].w};
          const unsigned r1[4] = {v0[4 * rq + 1].x, v0[4 * rq + 1].y, v0[4 * rq + 1].z, v0[4 * rq + 1].w};
          const unsigned r2[4] = {v0[4 * rq + 2].x, v0[4 * rq + 2].y, v0[4 * rq + 2].z, v0[4 * rq + 2].w};
          const unsigned r3[4] = {v0[4 * rq + 3].x, v0[4 * rq + 3].y, v0[4 * rq + 3].z, v0[4 * rq + 3].w};
#pragma unroll
          for (int q = 0; q < 4; ++q) {
            const unsigned ta = __builtin_amdgcn_perm(r1[q], r0[q], 0x05010400);
            const unsigned tb = __builtin_amdgcn_perm(r1[q], r0[q], 0x07030602);
            const unsigned tc = __builtin_amdgcn_perm(r3[q], r2[q], 0x05010400);
            const unsigned td = __builtin_amdgcn_perm(r3[q], r2[q], 0x07030602);
            acc[i][4 * q] = __builtin_amdgcn_sdot4((int)__builtin_amdgcn_perm(tc, ta, 0x05040100), wq, acc[i][4 * q], false);
            acc[i][4 * q + 1] = __builtin_amdgcn_sdot4((int)__builtin_amdgcn_perm(tc, ta, 0x07060302), wq, acc[i][4 * q + 1], false);
            acc[i][4 * q + 2] = __builtin_amdgcn_sdot4((int)__builtin_amdgcn_perm(td, tb, 0x05040100), wq, acc[i][4 * q + 2], false);
            acc[i][4 * q + 3] = __builtin_amdgcn_sdot4((int)__builtin_amdgcn_perm(td, tb, 0x07060302), wq, acc[i][4 * q + 3], false);
          }
        }
        jn[i] = j + 1;
      }
    }
  }
#pragma unroll
  for (int i = 0; i < VT; ++i) {
    float accf[16];
#pragma unroll
    for (int q = 0; q < 16; ++q) accf[q] = (float)acc[i][q] * tsc[T0 + i];
    peer_finalize_token<GWRITE>(p, accf, tok0 + 8 * wave + T0 + i, lane);
  }
}

DI void phase_d_tile(const MKParams& p, int tile, int wave, int lane, float rs0, float rs1, RingC& rg) {
  asm volatile("" : "+v"(lane));
  char* ws = p.ws;
  char* ldsA = smem;
  float* rs_s = (float*)(smem + LDS_A_BYTES);
  unsigned char* idxs = (unsigned char*)(smem + LDS_A_BYTES + 4096) + wave * 1024;
  u16* qp = (u16*)qp_scratch(ws, blockIdx.x);
  uint2* eg = (uint2*)(ws + OFF_EG + (size_t)blockIdx.x * 65536);
  const size_t tok0 = (size_t)tile * 64;
  if (wave == 0) { if (lane < 32) rs_s[lane] = rs0; else rs_s[lane] = rs1; }
  {
    f16v acc[2][2];
    const bf8* wf = (const bf8*)(ws + OFF_WPQ);
#if PROBE == 17
    for (int rep_ = 0; rep_ < 2; ++rep_)
#endif
#pragma unroll 1
    for (int c = 0; c < 4; ++c) {
      int l2 = lane;
      asm volatile("" : "+v"(l2));
      const int r = l2 & 31, h = l2 >> 5;
#if W8
      {
        const uint4* w8 = (const uint4*)(ws + OFF_WPQ);
        if (c < 3) gemm_chunk_w8<true, false, false, true, true>(ldsA, w8 + (size_t)c * 32768 + 2 * wave * 64, w8 + (size_t)(c + 1) * 32768 + 2 * wave * 64, l2, acc, rg);
        else gemm_chunk_w8<true, false, false, false, true>(ldsA, w8 + (size_t)c * 32768 + 2 * wave * 64, nullptr, l2, acc, rg);
        scale_cols(acc, (const float*)(ws + OFF_CS) + 16384 + 512 * c + 64 * wave, l2);
      }
#else
      if (c == 0) gemm_chunk_r<true, false, false, true>(ldsA, wf + 2 * wave * 64, wf + 65536 + 2 * wave * 64, l2, acc, rg);
      else if (c < 3) gemm_chunk_r<true, false, false, true>(ldsA, wf + (size_t)c * 65536 + 2 * wave * 64, wf + (size_t)(c + 1) * 65536 + 2 * wave * 64, l2, acc, rg);
      else gemm_chunk_r<true, false, false, false>(ldsA, wf + (size_t)c * 65536 + 2 * wave * 64, nullptr, l2, acc, rg);
#endif
#pragma unroll
      for (int ntl = 0; ntl < 2; ++ntl)
#pragma unroll
        for (int tt = 0; tt < 2; ++tt)
#pragma unroll
          for (int g = 0; g < 4; ++g) {
            const float sc = tt ? rs1 : rs0;
            f4v v = {acc[ntl][tt][4 * g] * sc, acc[ntl][tt][4 * g + 1] * sc, acc[ntl][tt][4 * g + 2] * sc, acc[ntl][tt][4 * g + 3] * sc};
            *(bf4*)(qp + (size_t)(32 * tt + r) * 2048 + 512 * c + 64 * wave + 32 * ntl + 8 * g + 4 * h) = cvt4(v);
          }
    }
  }
  __syncthreads();
#if PROBE == 16
  for (int rep_ = 0; rep_ < 2; ++rep_)
#endif
#pragma unroll 1
  for (int tt = 0; tt < 2; ++tt) {
    int l2 = lane;
    asm volatile("" : "+v"(l2));
    peer_select(ws, qp, eg, idxs, wave, tt, l2);
  }
  __syncthreads();
}

template <bool GWRITE = true>
DI void phase_d_gather(const MKParams& p, int tile, int wave, int lane) {
  asm volatile("" : "+v"(lane));
  char* ws = p.ws;
  char* ldsA = smem;
  float* rs_s = (float*)(smem + LDS_A_BYTES);
  unsigned char* idxs = (unsigned char*)(smem + LDS_A_BYTES + 4096) + wave * 1024;
  const uint2* eg = (const uint2*)(ws + OFF_EG + (size_t)blockIdx.x * 65536);
  const size_t tok0 = (size_t)tile * 64;
  {
    int l2 = lane;
    asm volatile("" : "+v"(l2));
    unsigned E[8][2], G[8][2];
#pragma unroll
    for (int i = 0; i < 8; ++i)
      peer_bucket_token(eg + (size_t)(8 * wave + i) * 128, (unsigned*)idxs, l2, E[i][0], E[i][1], G[i][0], G[i][1]);
    float xdq[8];
    peer_quant_x(ldsA, wave, l2, xdq);
    int A[8][2];
#if PROBE == 60
    peer_usweep(ws, ldsA, wave, l2, E, A);
    asm volatile("" :: "v"(A[0][0]), "v"(A[0][1]), "v"(A[1][0]), "v"(A[1][1]), "v"(A[2][0]), "v"(A[2][1]), "v"(A[3][0]), "v"(A[3][1]), "v"(A[4][0]), "v"(A[4][1]), "v"(A[5][0]), "v"(A[5][1]), "v"(A[6][0]), "v"(A[6][1]), "v"(A[7][0]), "v"(A[7][1]));
#endif
    peer_usweep(ws, ldsA, wave, l2, E, A);
    unsigned WQ[8];
    float tsc[8];
#pragma unroll
    for (int i = 0; i < 8; ++i) {
      const float rs = rs_s[8 * wave + i];
      float w[2];
#pragma unroll
      for (int cc = 0; cc < 2; ++cc) {
        const float a = (float)A[i][cc] * (rs * xdq[i]) * ((const float*)(ws + OFF_SU))[E[i][cc]];
        w[cc] = __uint_as_float(G[i][cc]) * 0.5f * a * (1.0f + erff(a * 0.70710678118654752f)) *
                ((const float*)(ws + OFF_SV))[E[i][cc]];
      }
      float wm = fmaxf(fabsf(w[0]), fabsf(w[1]));
#pragma unroll
      for (int o = 32; o > 0; o >>= 1) wm = fmaxf(wm, __shfl_xor(wm, o));
      const float sc = (wm > 0.f) ? 127.0f / wm : 0.f;
      tsc[i] = wm * (1.0f / 127.0f);
      const unsigned pr = ((unsigned)((int)rintf(w[0] * sc)) & 0xffu) | (((unsigned)((int)rintf(w[1] * sc)) & 0xffu) << 8);
      const unsigned up = (unsigned)__shfl((int)pr, (l2 + 16) & 63);
      WQ[i] = pr | (up << 16);
    }
    __builtin_amdgcn_sched_barrier(0);
    peer_vsweep<0, GWRITE>(p, wave, l2, tok0, E, WQ, tsc);
#if VT == 4
    __builtin_amdgcn_sched_barrier(0);
    peer_vsweep<4, GWRITE>(p, wave, l2, tok0, E, WQ, tsc);
#endif
  }
}
#ifndef REMAP
#define REMAP 1
#endif
DI int tile_of(int blk, int nblk) { return (REMAP && nblk == 256) ? ((blk & 7) * 32 + (blk >> 3)) : blk; }

__global__ __launch_bounds__(512) void mk(MKParams p) {
  cg::grid_group grid = cg::this_grid();
  const int tid = threadIdx.x;
  const int wave = __builtin_amdgcn_readfirstlane(tid >> 6), lane = tid & 63;
  const int gtid = blockIdx.x * 512 + tid, gthreads = gridDim.x * 512;
  const int gw = blockIdx.x * 8 + wave, nw = gridDim.x * 8;
  unsigned* bar = (unsigned*)(p.ws + OFF_BAR);
#if SETPRIO
  if (wave >= 4) __builtin_amdgcn_s_setprio(SETPRIO);
#endif
  phase_prep(p, gtid, gthreads);
  if (blockIdx.x < 256) load_norm_tile(p.x + (size_t)tile_of(blockIdx.x, gridDim.x) * 64 * DM, smem, wave, lane);
#if FIRST_CG == 1
  if (blockIdx.x == 0 && tid < 16) __hip_atomic_store(bar + tid, 0u, __ATOMIC_RELAXED, __HIP_MEMORY_SCOPE_AGENT);
  grid.sync();
#elif FIRST_CG == 2
  if (p.ws == nullptr) grid.sync();
  grid_barrier(bar, 1u * gridDim.x);
#else
  grid_barrier(bar, 1u * gridDim.x);
#endif
  if (blockIdx.x < 256) { phase_a_tile<true, (TABLES_IN_B == 3)>(p, tile_of(blockIdx.x, gridDim.x), wave, lane); __syncthreads(); gla_g1_tile(p, tile_of(blockIdx.x, gridDim.x), wave, lane); }
  for (int tile = blockIdx.x + gridDim.x; tile < 256; tile += gridDim.x) { phase_a_tile<false, false>(p, tile_of(tile, gridDim.x), wave, lane); __syncthreads(); gla_g1_tile(p, tile_of(tile, gridDim.x), wave, lane); }
#if PROBE == 40
  for (int tile = blockIdx.x; tile < 256; tile += gridDim.x) { phase_a_tile<false, false>(p, tile_of(tile, gridDim.x), wave, lane); __syncthreads(); gla_g1_tile(p, tile_of(tile, gridDim.x), wave, lane); }
#endif
  grid_barrier(bar, (2u - (FIRST_CG == 1)) * gridDim.x);
  {
    const bool kvblk = (gridDim.x == 256) && blockIdx.x >= 64 && blockIdx.x < 192;
    const bool conv_first = CLASS_ORDER && (gridDim.x == 256) && !kvblk;
    if (conv_first) phase_prep_tables_bal(p, blockIdx.x, gridDim.x, wave, lane);
    for (int it = gw; it < 4096; it += nw) sb_item(p, it, lane);
    for (int item = (int)((blockIdx.x + gridDim.x - 64u) % gridDim.x); item < 128; item += gridDim.x) phase_a_memkv(p, item, wave, lane);
    gla_g2(p, gtid, gthreads);
    if (!conv_first) phase_prep_tables_bal(p, blockIdx.x, gridDim.x, wave, lane);
    phase_prep_late(p, gtid, gthreads);
  }
  grid_barrier(bar, (3u - (FIRST_CG == 1)) * gridDim.x);
#if PROBE == 70
  grid_barrier(bar, 3u * gridDim.x); grid_barrier(bar, 4u * gridDim.x); grid_barrier(bar, 5u * gridDim.x); grid_barrier(bar, 6u * gridDim.x);
#endif
  for (int t0 = blockIdx.x; t0 < 256; t0 += gridDim.x) {
    const int tile = tile_of(t0, gridDim.x);
    float rs0, rs1;
    RingC rg;
#if PROBE == 41
    phase_c_tile(p, tile, wave, lane, rs0, rs1, rg);
#endif
    phase_c_tile(p, tile, wave, lane, rs0, rs1, rg);
#if PROBE == 42
    phase_d_tile(p, tile, wave, lane, rs0, rs1, rg);
#endif
    phase_d_tile(p, tile, wave, lane, rs0, rs1, rg);
#if GATHER_ALIGN
    grid_barrier(bar, (4u - (FIRST_CG == 1)) * gridDim.x);
#endif
#if PROBE == 43
    phase_d_gather<false>(p, tile, wave, lane);
#endif
    phase_d_gather<true>(p, tile, wave, lane);
  }
#if FIRST_CG == 0
  grid.sync();
#endif
}
#define MK_LDS (160 * 1024)
extern "C" void kernel_launch(void* const* d_in, const int* in_sizes, int n_in, void* d_out, int out_size, void* d_ws,
                              size_t ws_size, hipStream_t stream) {
  MKParams p{};
  p.x = (const float*)d_in[0]; p.mem = (const float*)d_in[1]; p.g_mix = (const float*)d_in[2];
  p.w_in = (const float*)d_in[3]; p.w_up = (const float*)d_in[4]; p.b_alpha = (const float*)d_in[5];
  p.g_gla = (const float*)d_in[6]; p.w_out = (const float*)d_in[7]; p.g_mq = (const float*)d_in[8];
  p.g_mkv = (const float*)d_in[9]; p.w_mq = (const float*)d_in[10]; p.w_mkv = (const float*)d_in[11];
  p.w_mo = (const float*)d_in[12]; p.g_ffn = (const float*)d_in[13]; p.w_pq = (const float*)d_in[14];
  p.subk = (const float*)d_in[15]; p.pu = (const float*)d_in[16]; p.pv = (const float*)d_in[17];
  p.g_fin = (const float*)d_in[18];
  p.out = (float*)d_out; p.ws = (char*)d_ws;
  float* out = (float*)d_out;
  char* wsb = (char*)d_ws;
  float* ws = (float*)d_ws;
  static int grid_blocks = 0;
  if (!grid_blocks) {
    int dev = 0, cus = 0, per_cu = 0;
    (void)hipGetDevice(&dev);
    (void)hipDeviceGetAttribute(&cus, hipDeviceAttributeMultiprocessorCount, dev);
    (void)hipFuncSetAttribute((const void*)mk, hipFuncAttributeMaxDynamicSharedMemorySize, MK_LDS);
    (void)hipOccupancyMaxActiveBlocksPerMultiprocessor(&per_cu, mk, 512, MK_LDS);
    grid_blocks = cus * per_cu;
    fprintf(stderr, "mk: cus=%d per_cu=%d grid=%d ws=%zu\n", cus, per_cu, grid_blocks, ws_size);
  }
#if FIRST_CG != 1
  (void)hipMemsetAsync((char*)d_ws + OFF_BAR, 0, 64, stream);
#endif
  {
    void* args[] = {(void*)&p};
    hipError_t e = hipLaunchCooperativeKernel((const void*)mk, dim3(grid_blocks), dim3(512), args, MK_LDS, stream);
    if (e != hipSuccess) fprintf(stderr, "coop launch failed: %s grid %d\n", hipGetErrorString(e), grid_blocks);
  }
}
```

```cpp
#ifndef GEMM_D
#define GEMM_D 8
#endif
#ifndef TABLES_IN_B
#define TABLES_IN_B 4
#endif
#ifndef REMAP
#define REMAP 0
#endif
#ifndef FIRST_CG
#define FIRST_CG 1
#endif
#ifndef GATHER_ALIGN
#define GATHER_ALIGN 0
#endif
#ifndef LATE_PREP
#define LATE_PREP 1
#endif
#ifndef B_ORDER
#define B_ORDER 0
#endif
#ifndef SWEEP_NB
#define SWEEP_NB 16
#define SWEEP_SH 10
#endif
#ifndef CLASS_ORDER
#define CLASS_ORDER 0
#endif
#ifndef STAGGER_B
#define STAGGER_B 0
#endif
#ifndef PROBE
#define PROBE 0
#endif
#ifndef W8
#define W8 1
#endif
#ifndef W8F
#define W8F W8
#endif
#ifndef GEMM_D2
#define GEMM_D2 8
#endif
#ifndef SETPRIO
#define SETPRIO 0
#endif
#ifndef ATTN_LOCKSTEP
#define ATTN_LOCKSTEP 0
#endif
#ifndef L2_TOUCH
#define L2_TOUCH 0
#endif
#include <hip/hip_runtime.h>
#include <hip/hip_cooperative_groups.h>
#include <math.h>
#include <stdio.h>
#include <stdint.h>
namespace cg = cooperative_groups;

#ifndef PROBE
#define PROBE 0
#endif
#ifndef TABLES_IN_B
#define TABLES_IN_B 1
#endif
#define NB 8
#define SEQ 2048
#define DM 1024
#define NTOK (NB * SEQ)
#define INC 3088
#define MEML 256
#define EPSV 1e-6f

typedef __attribute__((ext_vector_type(8))) __bf16 bf8;
typedef __attribute__((ext_vector_type(4))) __bf16 bf4;
typedef __attribute__((ext_vector_type(2))) __bf16 bf2;
typedef __attribute__((ext_vector_type(16))) float f16v;
typedef __attribute__((ext_vector_type(8))) float f8v;
typedef __attribute__((ext_vector_type(4))) float f4v;
typedef __attribute__((ext_vector_type(2))) float f2v;
typedef unsigned short u16;

#define DI __device__ __forceinline__
#ifndef USE_NT
#define USE_NT 1
#endif
#if USE_NT
#define NT_LOAD(p) __builtin_nontemporal_load(p)
#else
#define NT_LOAD(p) (*(p))
#endif
#define MFMA(a, b, c) __builtin_amdgcn_mfma_f32_32x32x16_bf16((a), (b), (c), 0, 0, 0)
typedef __attribute__((ext_vector_type(8))) _Float16 hf8;
typedef __attribute__((ext_vector_type(4))) _Float16 hf4;
typedef __attribute__((ext_vector_type(2))) _Float16 hf2;
#define MFMAH(a, b, c) __builtin_amdgcn_mfma_f32_32x32x16_f16(__builtin_bit_cast(hf8, (a)), __builtin_bit_cast(hf8, (b)), (c), 0, 0, 0)

DI int crow(int i, int h) { return (i & 3) + 8 * (i >> 2) + 4 * h; }
DI int tpos(int t) { return (t & ~12) | ((t & 4) << 1) | ((t & 8) >> 1); }
DI float bf2f(u16 v) { return __uint_as_float(((unsigned)v) << 16); }
DI bf8 cvt8(f8v v) { return __builtin_convertvector(v, bf8); }
DI bf4 cvt4(f4v v) { return __builtin_convertvector(v, bf4); }
#if W8F
DI bf4 cvt4a(f4v v) { return __builtin_bit_cast(bf4, __builtin_convertvector(v, hf4)); }
#else
DI bf4 cvt4a(f4v v) { return __builtin_convertvector(v, bf4); }
#endif
DI f16v zero16() { f16v z = {0.f, 0.f, 0.f, 0.f, 0.f, 0.f, 0.f, 0.f, 0.f, 0.f, 0.f, 0.f, 0.f, 0.f, 0.f, 0.f}; return z; }


#define DPP_ROR_F(v, ctrl) __builtin_bit_cast(float, __builtin_amdgcn_update_dpp(0, __builtin_bit_cast(int, (v)), (ctrl), 0xf, 0xf, false))
DI float rl_f(float v, int l) { return __builtin_bit_cast(float, __builtin_amdgcn_readlane(__builtin_bit_cast(int, v), l)); }
DI float wave_allmax(float v) {
  v = fmaxf(v, DPP_ROR_F(v, 0x128)); v = fmaxf(v, DPP_ROR_F(v, 0x124)); v = fmaxf(v, DPP_ROR_F(v, 0x122)); v = fmaxf(v, DPP_ROR_F(v, 0x121));
  return fmaxf(fmaxf(rl_f(v, 0), rl_f(v, 16)), fmaxf(rl_f(v, 32), rl_f(v, 48)));
}
DI float wave_allsum(float v) {
  v += DPP_ROR_F(v, 0x128); v += DPP_ROR_F(v, 0x124); v += DPP_ROR_F(v, 0x122); v += DPP_ROR_F(v, 0x121);
  return (rl_f(v, 0) + rl_f(v, 16)) + (rl_f(v, 32) + rl_f(v, 48));
}

#define MiB ((size_t)1 << 20)
#define OFF_WIN   ((size_t)0)
#define OFF_WOUT  (OFF_WIN + 97 * 65536)
#define OFF_WMQ   (OFF_WOUT + 32 * 65536)
#define OFF_WMKV  (OFF_WMQ + 32 * 65536)
#define OFF_WMO   (OFF_WMKV + 64 * 65536)
#define OFF_WPQ   (OFF_WMO + 32 * 65536)
#define OFF_SUBK  (OFF_WPQ + 64 * 65536)
#define OFF_ACT   (21 * MiB)
#define OFF_GQ    (OFF_ACT)
#define OFF_GK    (OFF_GQ + 8 * MiB)
#define OFF_GVT   (OFF_GK + 8 * MiB)
#define OFF_OG    (OFF_GVT + 16 * MiB)
#define OFF_SQ    (OFF_OG + 16 * MiB)
#define OFF_SK    (OFF_SQ + 16 * MiB)
#define OFF_SVT   (OFF_SK + 16 * MiB)
#define OFF_LA    (OFF_SVT + 16 * MiB)
#define OFF_LKV   (OFF_LA + 16 * MiB)
#define OFF_DD    (OFF_LKV + 32 * MiB)
#define OFF_OSB   (OFF_DD + 1 * MiB)
#define OFF_KM    (OFF_OSB + 16 * MiB)
#define OFF_VMT   (OFF_KM + 4 * MiB)
#define OFF_PU    (OFF_VMT + 4 * MiB)
#define OFF_PV    (OFF_PU + 16 * MiB)
#define OFF_SU    (OFF_PV + 16 * MiB)
#define OFF_SV    (OFF_SU + 65536)
#define OFF_GQ2   (224 * MiB)
#define OFF_GK2   (232 * MiB)
#define OFF_SS    (OFF_LA)

#define LDS_ROW 2064
#define LDS_A_BYTES (64 * LDS_ROW)

DI char* qp_scratch(char* ws, int blk) {
  return blk < 192 ? ws + OFF_SQ + (size_t)blk * 262144 : ws + OFF_LKV + (size_t)(blk - 192) * 262144;
}

#define OFF_CS  (OFF_DD + 512 * 1024)
#define OFF_ICS (OFF_CS + 128 * 1024)
#define OFF_BAR (OFF_DD + 768 * 1024)
DI void grid_barrier(unsigned* ctr, unsigned target) {
  __syncthreads();
  if (threadIdx.x == 0) {
    __builtin_amdgcn_fence(__ATOMIC_RELEASE, "agent");
    asm volatile("s_waitcnt vmcnt(0)" ::: "memory");
    __hip_atomic_fetch_add(ctr, 1u, __ATOMIC_RELAXED, __HIP_MEMORY_SCOPE_AGENT);
    while (__hip_atomic_load(ctr, __ATOMIC_RELAXED, __HIP_MEMORY_SCOPE_AGENT) < target) __builtin_amdgcn_s_sleep(1);
    __builtin_amdgcn_fence(__ATOMIC_ACQUIRE, "agent");
    asm volatile("s_waitcnt vmcnt(0)" ::: "memory");
  }
  __syncthreads();
}

struct MKParams {
  const float *x, *mem, *g_mix, *w_in, *w_up, *b_alpha, *g_gla, *w_out, *g_mq, *g_mkv, *w_mq, *w_mkv, *w_mo, *g_ffn, *w_pq,
      *subk, *pu, *pv, *g_fin;
  float* out;
  char* ws;
};
extern __shared__ __attribute__((aligned(16))) char smem[];

template <typename ColFn>
DI void prep_w(bf8* dst, const float* __restrict__ W, int ldw, int ntiles, const float* __restrict__ gain, ColFn colfn,
               int gtid, int gthreads) {
  const int total = ntiles * 4096;
#pragma unroll 1
  for (int u0 = gtid; u0 < total; u0 += 4 * gthreads) {
    f8v v[4];
    int didx[4];
#pragma unroll
    for (int t = 0; t < 4; ++t) {
      const int u = u0 + t * gthreads;
      didx[t] = -1;
      if (u < total) {
        const int lane = u & 63, ks = (u >> 6) & 63, nt = u >> 12;
        const int r = lane & 31, h = lane >> 5;
        float sc = 1.f;
        const int col = colfn(32 * nt + r, sc);
#pragma unroll
        for (int j = 0; j < 8; ++j) {
          const int k = 16 * ks + 8 * h + j;
          float val = 0.f;
          if (col >= 0) val = NT_LOAD(W + (size_t)k * ldw + col) * sc * (gain ? gain[k] : 1.f);
          v[t][j] = val;
        }
        didx[t] = (nt < (ntiles & ~15)) ? ((((nt >> 4) * 64 + ks) * 16 + (nt & 15)) * 64 + lane) : u;
      }
    }
#pragma unroll
    for (int t = 0; t < 4; ++t)
      if (didx[t] >= 0) dst[didx[t]] = cvt8(v[t]);
  }
}

template <typename ColFn>
DI void prep_w8_item(char* dst, float* cs, float* ics, const float* __restrict__ W, int ldw, const float* __restrict__ gain,
                     ColFn colfn, int grp, float* smax, int tid) {
  const int c = tid & 31, g = tid >> 5;
  const int n = grp * 32 + c;
  float sc = 1.f;
  const int col = colfn(n, sc);
  float w[64];
  float am = 0.f;
  const float* q = W + (size_t)(64 * g) * ldw + col;
#pragma unroll
  for (int j = 0; j < 64; ++j) {
    w[j] = NT_LOAD(q);
    q += ldw;
    asm volatile("" : "+v"(q));
  }
#pragma unroll
  for (int j = 0; j < 64; ++j) {
    w[j] *= sc * (gain ? gain[64 * g + j] : 1.f);
    am = fmaxf(am, fabsf(w[j]));
  }
  __syncthreads();
  if (tid < 32) ((unsigned*)smax)[tid] = 0u;
  __syncthreads();
  atomicMax((unsigned*)smax + c, __float_as_uint(am));
  __syncthreads();
  const float cm = smax[c];
  const float qs = (cm > 0.f) ? 127.0f / cm : 0.f;
  const int nt = n >> 5;
#pragma unroll
  for (int kp2 = 0; kp2 < 2; ++kp2)
#pragma unroll
    for (int h = 0; h < 2; ++h) {
      unsigned q[4];
#pragma unroll
      for (int d = 0; d < 4; ++d) {
        const int kb = 32 * kp2 + (d >> 1) * 16 + 8 * h + 4 * (d & 1);
        unsigned pk = 0;
#pragma unroll
        for (int j = 0; j < 4; ++j) pk |= ((unsigned)((int)rintf(w[kb + j] * qs) + (W8F ? 128 : 0)) & 0xffu) << (8 * j);
        q[d] = pk;
      }
      const int kp = 2 * g + kp2;
      const size_t unit = (size_t)(((nt >> 4) * 32 + kp) * 16 + (nt & 15)) * 64 + c + 32 * h;
      *(uint4*)(dst + unit * 16) = make_uint4(q[0], q[1], q[2], q[3]);
    }
  if (g == 0) { cs[n] = (cm > 0.f) ? cm * (1.0f / 127.0f) : 1.f; ics[n] = (cm > 0.f) ? 127.0f / cm : 1.f; }
}

DI void phase_prep(const MKParams& p, int gtid, int gthreads) {
  char* ws = p.ws;
  prep_w((bf8*)(ws + OFF_WIN), p.w_in, INC, 97, p.g_mix,
         [](int n, float& sc) -> int {
           if (n < 256) { sc = 0.125f; return n; }
           if (n < 1536) return n;
           if (n < 2048) { sc = 0.125f; return n + 16; }
           if (n < 3072) return n + 16;
           if (n < 3088) return n - 1536;
           return -1;
         }, gtid, gthreads);
  prep_w((bf8*)(ws + OFF_WMKV), p.w_mkv, 2048, 64, p.g_mkv, [](int n, float& sc) -> int { return n; }, gtid, gthreads);
}
DI void phase_prep_late(const MKParams& p, int gtid, int gthreads) {
  char* ws = p.ws;
#if W8
  {
    float* smax = (float*)(smem + LDS_A_BYTES);
    float* cs = (float*)(ws + OFF_CS);
    float* ics = (float*)(ws + OFF_ICS);
    const int tid = threadIdx.x;
    for (int item = blockIdx.x; item < 160; item += gridDim.x) {
      if (item < 32) prep_w8_item(ws + OFF_WOUT, cs + 4096, ics + 4096, p.w_out, 1024, nullptr, [](int n, float& sc) -> int { return n; }, item, smax, tid);
      else if (item < 64) prep_w8_item(ws + OFF_WMQ, cs + 8192, ics + 8192, p.w_mq, 1024, p.g_mq, [](int n, float& sc) -> int { sc = 0.0625f; return n; }, item - 32, smax, tid);
      else if (item < 96) prep_w8_item(ws + OFF_WMO, cs + 12288, ics + 12288, p.w_mo, 1024, nullptr, [](int n, float& sc) -> int { return n; }, item - 64, smax, tid);
      else prep_w8_item(ws + OFF_WPQ, cs + 16384, ics + 16384, p.w_pq, 2048, p.g_ffn, [](int n, float& sc) -> int { return n; }, item - 96, smax, tid);
    }
  }
#else
  prep_w((bf8*)(ws + OFF_WOUT), p.w_out, 1024, 32, nullptr, [](int n, float& sc) -> int { return n; }, gtid, gthreads);
  prep_w((bf8*)(ws + OFF_WMQ), p.w_mq, 1024, 32, p.g_mq, [](int n, float& sc) -> int { sc = 0.0625f; return n; }, gtid, gthreads);
  prep_w((bf8*)(ws + OFF_WMO), p.w_mo, 1024, 32, nullptr, [](int n, float& sc) -> int { return n; }, gtid, gthreads);
  prep_w((bf8*)(ws + OFF_WPQ), p.w_pq, 2048, 64, p.g_ffn, [](int n, float& sc) -> int { return n; }, gtid, gthreads);
#endif
  {
    bf8* dst = (bf8*)(ws + OFF_SUBK);
    const int total = 16 * 4 * 8 * 64;
    for (int u = gtid; u < total; u += gthreads) {
      const int lane = u & 63, ks = (u >> 6) & 7, mt = (u >> 9) & 3, hp = u >> 11;
      const int r = lane & 31, h = lane >> 5;
      const float* s = p.subk + ((size_t)(hp * 128 + 32 * mt + r)) * 128 + 16 * ks + 8 * h;
      const f4v a = *(const f4v*)s, b = *(const f4v*)(s + 4);
      f8v v = {a[0], a[1], a[2], a[3], b[0], b[1], b[2], b[3]};
      dst[u] = cvt8(v);
    }
  }
}

DI void table_row_issue(const MKParams& p, int row, int lane, f4v (&v)[4]) {
  const int e = row & 16383;
  const float* src = ((row >= 16384) ? p.pv : p.pu) + (size_t)e * DM + 16 * lane;
#pragma unroll
  for (int q = 0; q < 4; ++q) v[q] = NT_LOAD((const f4v*)(src + 4 * q));
}
DI void table_row_finish(const MKParams& p, int row, int lane, f4v (&v)[4]) {
  const int e = row & 16383;
  const bool isv = row >= 16384;
  if (!isv) {
#pragma unroll
    for (int q = 0; q < 4; ++q) v[q] = v[q] * *(const f4v*)(p.g_ffn + 16 * lane + 4 * q);
  }
  float am = 0.f;
#pragma unroll
  for (int q = 0; q < 4; ++q)
#pragma unroll
    for (int j = 0; j < 4; ++j) am = fmaxf(am, fabsf(v[q][j]));
  am = wave_allmax(am);
  const float sc = (am > 0.f) ? 127.0f / am : 0.f;
  unsigned w[4];
#pragma unroll
  for (int q = 0; q < 4; ++q) {
    unsigned pk = 0;
#pragma unroll
    for (int j = 0; j < 4; ++j) pk |= ((unsigned)((int)rintf(v[q][j] * sc)) & 0xffu) << (8 * j);
    w[q] = pk;
  }
  *(uint4*)(p.ws + (isv ? OFF_PV : OFF_PU) + (size_t)e * 1024 + 16 * lane) = make_uint4(w[0], w[1], w[2], w[3]);
  if (lane == 0) ((float*)(p.ws + (isv ? OFF_SV : OFF_SU)))[e] = am * (1.0f / 127.0f);
}
DI void prep_table_row(const MKParams& p, int row, int lane) {
  f4v v[4];
  table_row_issue(p, row, lane, v);
  table_row_finish(p, row, lane, v);
}
DI void phase_prep_tables(const MKParams& p, int gwave, int nwaves, int lane) {
  for (int row = gwave; row < 32768; row += nwaves) prep_table_row(p, row, lane);
}
DI void phase_prep_tables_bal(const MKParams& p, int blk, int nblk, int wave, int lane) {
  if (nblk != 256) { phase_prep_tables(p, blk * 8 + wave, nblk * 8, lane); return; }
  int base, per, idx;
  if (blk >= 64 && blk < 192) { base = 0; per = 7; idx = (blk - 64) * 8 + wave; }
  else if (blk < 64) { base = 7168; per = 21; idx = blk * 8 + wave; }
  else { base = 17920; per = 29; idx = (blk - 192) * 8 + wave; }
  for (int i = 0; i < per; ++i) prep_table_row(p, base + idx * per + i, lane);
}
#ifndef TBL_IN_A
#define TBL_IN_A 12
#endif
DI void phase_prep_tables_rest(const MKParams& p, int gwave, int nwaves, int lane) {
  if (nwaves != 2048) { phase_prep_tables(p, gwave, nwaves, lane); return; }
  for (int rr = TBL_IN_A; rr < 16; ++rr) prep_table_row(p, gwave * 16 + rr, lane);
}
DI void phase_prep_tables_dyn(const MKParams& p, unsigned* qctr, int lane) {
  while (true) {
    unsigned c = 0;
    if (lane == 0) c = __hip_atomic_fetch_add(qctr, 1u, __ATOMIC_RELAXED, __HIP_MEMORY_SCOPE_AGENT);
    c = (unsigned)__builtin_amdgcn_readfirstlane((int)c);
    if (c >= 1024u) break;
#pragma unroll 2
    for (int rr = 0; rr < 32; ++rr) prep_table_row(p, (int)c * 32 + rr, lane);
  }
}

DI void load_norm_tile(const float* __restrict__ src, char* ldsA, int wave, int lane) {
#pragma unroll 2
  for (int i = 0; i < 8; ++i) {
    const int row = 8 * wave + i;
    const f4v* pr = (const f4v*)(src + (size_t)row * DM);
    f4v v[4];
#pragma unroll
    for (int c = 0; c < 4; ++c) v[c] = NT_LOAD(pr + lane + 64 * c);
    float ss = 0.f;
#pragma unroll
    for (int c = 0; c < 4; ++c) ss += v[c][0] * v[c][0] + v[c][1] * v[c][1] + v[c][2] * v[c][2] + v[c][3] * v[c][3];
    ss = wave_allsum(ss);
    const float rs = rsqrtf(ss * (1.0f / DM) + EPSV);
#pragma unroll
    for (int c = 0; c < 4; ++c) {
      f4v t = v[c] * rs;
      *(bf4*)(ldsA + row * LDS_ROW + (lane * 4 + 256 * c) * 2) = cvt4(t);
    }
  }
}

#ifndef GEMM_D
#define GEMM_D 6
#endif
template <bool SWAP, bool F16 = false>
DI void gemm_step(f16v (&acc)[2][2], const bf8& a0, const bf8& a1, const bf8& x0, const bf8& x1) {
  if (F16) {
    if (SWAP) {
      acc[0][0] = MFMAH(a0, x0, acc[0][0]); acc[0][1] = MFMAH(a0, x1, acc[0][1]);
      acc[1][0] = MFMAH(a1, x0, acc[1][0]); acc[1][1] = MFMAH(a1, x1, acc[1][1]);
    } else {
      acc[0][0] = MFMAH(x0, a0, acc[0][0]); acc[0][1] = MFMAH(x1, a0, acc[0][1]);
      acc[1][0] = MFMAH(x0, a1, acc[1][0]); acc[1][1] = MFMAH(x1, a1, acc[1][1]);
    }
  } else if (SWAP) {
    acc[0][0] = MFMA(a0, x0, acc[0][0]); acc[0][1] = MFMA(a0, x1, acc[0][1]);
    acc[1][0] = MFMA(a1, x0, acc[1][0]); acc[1][1] = MFMA(a1, x1, acc[1][1]);
  } else {
    acc[0][0] = MFMA(x0, a0, acc[0][0]); acc[0][1] = MFMA(x1, a0, acc[0][1]);
    acc[1][0] = MFMA(x0, a1, acc[1][0]); acc[1][1] = MFMA(x1, a1, acc[1][1]);
  }
}
struct Ring { bf8 w0[GEMM_D], w1[GEMM_D]; };
DI void ring_fill(Ring& rg, const bf8* __restrict__ wf, int lane) {
#pragma unroll
  for (int i = 0; i < GEMM_D; ++i) { rg.w0[i] = wf[lane + i * 1024]; rg.w1[i] = wf[64 + lane + i * 1024]; }
}
template <bool SWAP, bool RES, bool FIRST, bool NEXT>
DI void gemm_chunk_r(const char* ldsA, const bf8* __restrict__ wf, const bf8* __restrict__ wnext, int lane, f16v (&acc)[2][2],
                     Ring& rg, const float* res = nullptr) {
  __builtin_amdgcn_sched_barrier(0);
  const int r = lane & 31, h = lane >> 5;
  const char* xa0 = ldsA + r * LDS_ROW + h * 16;
  const char* xa1 = xa0 + 32 * LDS_ROW;
  const bf8* w0p = wf + lane;
  const bf8* w1p = wf + 64 + lane;
  if (FIRST) ring_fill(rg, wf, lane);
  if (RES) {
#pragma unroll
    for (int ntl = 0; ntl < 2; ++ntl)
#pragma unroll
      for (int tt = 0; tt < 2; ++tt)
#pragma unroll
        for (int g = 0; g < 4; ++g) {
          const f4v x = *(const f4v*)(res + (size_t)(32 * tt + r) * DM + 32 * ntl + 8 * g + 4 * h);
          acc[ntl][tt][4 * g] = x[0]; acc[ntl][tt][4 * g + 1] = x[1]; acc[ntl][tt][4 * g + 2] = x[2]; acc[ntl][tt][4 * g + 3] = x[3];
        }
  } else {
    acc[0][0] = zero16(); acc[0][1] = zero16(); acc[1][0] = zero16(); acc[1][1] = zero16();
  }
  bf8 x0 = *(const bf8*)(xa0), x1 = *(const bf8*)(xa1);
  constexpr int KMAIN = ((64 - 2 * GEMM_D) / GEMM_D + 1) * GEMM_D;
#pragma unroll 1
  for (int ks0 = 0; ks0 < KMAIN; ks0 += GEMM_D) {
#pragma unroll
    for (int i = 0; i < GEMM_D; ++i) {
      const int ks = ks0 + i;
      const bf8 xn0 = *(const bf8*)(xa0 + (ks + 1) * 32);
      const bf8 xn1 = *(const bf8*)(xa1 + (ks + 1) * 32);
      gemm_step<SWAP>(acc, rg.w0[i], rg.w1[i], x0, x1);
      rg.w0[i] = w0p[(ks + GEMM_D) * 1024];
      rg.w1[i] = w1p[(ks + GEMM_D) * 1024];
      x0 = xn0; x1 = xn1;
      __builtin_amdgcn_sched_group_barrier(0x100, 2, 0);
      __builtin_amdgcn_sched_group_barrier(0x008, 2, 0);
      __builtin_amdgcn_sched_group_barrier(0x020, 2, 0);
      __builtin_amdgcn_sched_group_barrier(0x008, 2, 0);
    }
  }
#pragma unroll
  for (int t = 0; t < 64 - KMAIN; ++t) {
    const int ks = KMAIN + t, i = t % GEMM_D;
    const bf8 xn0 = *(const bf8*)(xa0 + (ks + 1) * 32);
    const bf8 xn1 = *(const bf8*)(xa1 + (ks + 1) * 32);
    gemm_step<SWAP>(acc, rg.w0[i], rg.w1[i], x0, x1);
    const bool refill = (ks + GEMM_D < 64) || NEXT;
    if (ks + GEMM_D < 64) {
      rg.w0[i] = w0p[(ks + GEMM_D) * 1024];
      rg.w1[i] = w1p[(ks + GEMM_D) * 1024];
    } else if (NEXT) {
      rg.w0[i] = wnext[lane + (ks + GEMM_D - 64) * 1024];
      rg.w1[i] = wnext[64 + lane + (ks + GEMM_D - 64) * 1024];
    }
    x0 = xn0; x1 = xn1;
    __builtin_amdgcn_sched_group_barrier(0x100, 2, 0);
    __builtin_amdgcn_sched_group_barrier(0x008, 2, 0);
    if (refill) __builtin_amdgcn_sched_group_barrier(0x020, 2, 0);
    __builtin_amdgcn_sched_group_barrier(0x008, 2, 0);
  }
}
struct Ring8 { uint4 w0[GEMM_D2], w1[GEMM_D2]; bf8 c0, c1; };
DI void ring8_fill(Ring8& rg, const uint4* __restrict__ wf, int lane) {
#pragma unroll
  for (int i = 0; i < GEMM_D2; ++i) { rg.w0[i] = wf[lane + i * 1024]; rg.w1[i] = wf[64 + lane + i * 1024]; }
}
#if W8F
DI bf8 deq8(unsigned lo, unsigned hi) {
  const unsigned K = 0x64646464u;
  const hf2 off = {(_Float16)-1152.0f, (_Float16)-1152.0f};
  const hf2 a = __builtin_bit_cast(hf2, __builtin_amdgcn_perm(K, lo, 0x05010400u)) + off;
  const hf2 b = __builtin_bit_cast(hf2, __builtin_amdgcn_perm(K, lo, 0x07030602u)) + off;
  const hf2 c = __builtin_bit_cast(hf2, __builtin_amdgcn_perm(K, hi, 0x05010400u)) + off;
  const hf2 d = __builtin_bit_cast(hf2, __builtin_amdgcn_perm(K, hi, 0x07030602u)) + off;
  const hf8 r = {a[0], a[1], b[0], b[1], c[0], c[1], d[0], d[1]};
  return __builtin_bit_cast(bf8, r);
}
#else
DI bf8 deq8(unsigned lo, unsigned hi) {
  f8v v;
  v[0] = (float)(signed char)(lo); v[1] = (float)(signed char)(lo >> 8); v[2] = (float)(signed char)(lo >> 16); v[3] = (float)((int)lo >> 24);
  v[4] = (float)(signed char)(hi); v[5] = (float)(signed char)(hi >> 8); v[6] = (float)(signed char)(hi >> 16); v[7] = (float)((int)hi >> 24);
  return cvt8(v);
}
#endif
template <bool SWAP, bool RES, bool FIRST, bool NEXT, bool CUR, int PR = 0>
DI void gemm_chunk_w8(const char* ldsA, const uint4* __restrict__ wf, const uint4* __restrict__ wnext, int lane, f16v (&acc)[2][2],
                      Ring8& rg, const float* res = nullptr, const float* ics = nullptr) {
  __builtin_amdgcn_sched_barrier(0);
  const int r = lane & 31, h = lane >> 5;
  const char* xa0 = ldsA + r * LDS_ROW + h * 16;
  const char* xa1 = xa0 + 32 * LDS_ROW;
  const uint4* w0p = wf + lane;
  const uint4* w1p = wf + 64 + lane;
  if (FIRST) ring8_fill(rg, wf, lane);
  if (RES) {
#pragma unroll
    for (int ntl = 0; ntl < 2; ++ntl)
#pragma unroll
      for (int g = 0; g < 4; ++g) {
        const f4v ic = *(const f4v*)(ics + 32 * ntl + 8 * g + 4 * h);
#pragma unroll
        for (int tt = 0; tt < 2; ++tt) {
          const f4v x = *(const f4v*)(res + (size_t)(32 * tt + r) * DM + 32 * ntl + 8 * g + 4 * h);
          acc[ntl][tt][4 * g] = x[0] * ic[0]; acc[ntl][tt][4 * g + 1] = x[1] * ic[1]; acc[ntl][tt][4 * g + 2] = x[2] * ic[2]; acc[ntl][tt][4 * g + 3] = x[3] * ic[3];
        }
      }
  } else {
    acc[0][0] = zero16(); acc[0][1] = zero16(); acc[1][0] = zero16(); acc[1][1] = zero16();
  }
  bf8 x0 = *(const bf8*)(xa0), x1 = *(const bf8*)(xa1);
  bf8 cur0, cur1, nxt0, nxt1;
  if (CUR && !FIRST) { cur0 = rg.c0; cur1 = rg.c1; }
  else { cur0 = deq8(rg.w0[0].x, rg.w0[0].y); cur1 = deq8(rg.w1[0].x, rg.w1[0].y); }
  constexpr int NP = 32;
  constexpr int KM = ((NP - 2 * GEMM_D2) / GEMM_D2 + 1) * GEMM_D2;
#define W8_VQ (W8F ? 4 : 6)
#define W8_PAIR(p, i, REFILL_STMT, CONV_NEXT)                                                                          \
  {                                                                                                                    \
    bf8 xn0 = x1, xn1 = x0;                                                                                          \
    if (PR != 2) { xn0 = *(const bf8*)(xa0 + (2 * (p) + 1) * 32); xn1 = *(const bf8*)(xa1 + (2 * (p) + 1) * 32); }     \
    nxt0 = deq8(rg.w0[i].z, rg.w0[i].w); nxt1 = deq8(rg.w1[i].z, rg.w1[i].w);     \
    gemm_step<SWAP, (W8F != 0)>(acc, cur0, cur1, x0, x1);                                                              \
    __builtin_amdgcn_sched_group_barrier(0x100, 2, 0);                                                                 \
    __builtin_amdgcn_sched_group_barrier(0x008, 1, 0); __builtin_amdgcn_sched_group_barrier(0x002, W8_VQ, 0);          \
    __builtin_amdgcn_sched_group_barrier(0x008, 1, 0); __builtin_amdgcn_sched_group_barrier(0x002, W8_VQ, 0);          \
    __builtin_amdgcn_sched_group_barrier(0x008, 1, 0); __builtin_amdgcn_sched_group_barrier(0x002, W8_VQ, 0);          \
    __builtin_amdgcn_sched_group_barrier(0x008, 1, 0); __builtin_amdgcn_sched_group_barrier(0x002, W8_VQ, 0);          \
    if (PR != 2) { x0 = *(const bf8*)(xa0 + (2 * (p) + 2) * 32); x1 = *(const bf8*)(xa1 + (2 * (p) + 2) * 32); }       \
    if (CONV_NEXT) { cur0 = deq8(rg.w0[((i) + 1) % GEMM_D2].x, rg.w0[((i) + 1) % GEMM_D2].y);                          \
                     cur1 = deq8(rg.w1[((i) + 1) % GEMM_D2].x, rg.w1[((i) + 1) % GEMM_D2].y); }                        \
    gemm_step<SWAP, (W8F != 0)>(acc, nxt0, nxt1, xn0, xn1);                                                            \
    if (PR != 1) REFILL_STMT                                                                                           \
    __builtin_amdgcn_sched_group_barrier(0x100, 2, 0);                                                                 \
    __builtin_amdgcn_sched_group_barrier(0x008, 1, 0); __builtin_amdgcn_sched_group_barrier(0x002, W8_VQ, 0);          \
    __builtin_amdgcn_sched_group_barrier(0x008, 1, 0); __builtin_amdgcn_sched_group_barrier(0x002, W8_VQ, 0);          \
    __builtin_amdgcn_sched_group_barrier(0x020, 2, 0);                                                                 \
    __builtin_amdgcn_sched_group_barrier(0x008, 1, 0); __builtin_amdgcn_sched_group_barrier(0x002, W8_VQ, 0);          \
    __builtin_amdgcn_sched_group_barrier(0x008, 1, 0); __builtin_amdgcn_sched_group_barrier(0x002, W8_VQ, 0);          \
  }
#pragma unroll 1
  for (int p0 = 0; p0 < KM; p0 += GEMM_D2) {
#pragma unroll
    for (int i = 0; i < GEMM_D2; ++i) {
      const int p = p0 + i;
      W8_PAIR(p, i, { rg.w0[i] = w0p[(p + GEMM_D2) * 1024]; rg.w1[i] = w1p[(p + GEMM_D2) * 1024]; }, true)
    }
  }
#pragma unroll
  for (int t = 0; t < NP - KM; ++t) {
    const int p = KM + t, i = t % GEMM_D2;
    if (p + GEMM_D2 < NP) {
      W8_PAIR(p, i, { rg.w0[i] = w0p[(p + GEMM_D2) * 1024]; rg.w1[i] = w1p[(p + GEMM_D2) * 1024]; }, true)
    } else if (NEXT) {
      W8_PAIR(p, i, { rg.w0[i] = wnext[lane + (p + GEMM_D2 - NP) * 1024]; rg.w1[i] = wnext[64 + lane + (p + GEMM_D2 - NP) * 1024]; }, true)
    } else {
      W8_PAIR(p, i, {}, (p + 1 < NP))
    }
  }
#undef W8_PAIR
  if (NEXT) { rg.c0 = cur0; rg.c1 = cur1; }
}
DI void scale_cols(f16v (&acc)[2][2], const float* __restrict__ cs, int lane) {
  __builtin_amdgcn_sched_barrier(0);
  asm volatile("" : "+v"(lane));
  const int h = lane >> 5;
#pragma unroll
  for (int ntl = 0; ntl < 2; ++ntl)
#pragma unroll
    for (int g = 0; g < 4; ++g) {
      const f4v c4 = *(const f4v*)(cs + 32 * ntl + 8 * g + 4 * h);
#pragma unroll
      for (int tt = 0; tt < 2; ++tt)
#pragma unroll
        for (int e = 0; e < 4; ++e) acc[ntl][tt][4 * g + e] *= c4[e];
    }
}
#if W8
typedef Ring8 RingC;
#else
typedef Ring RingC;
#endif

DI unsigned l2_touch(const void* chunk, int lane) {
  unsigned v = 0;
#if L2_TOUCH
  asm volatile("" : "+v"(lane));
  const char* q = (const char*)chunk + (size_t)((blockIdx.x >> 3) & 31) * 32768 + (unsigned)(lane & 31) * 128u +
                  (unsigned)__builtin_amdgcn_readfirstlane((int)(threadIdx.x >> 6)) * 4096u;
  if (lane < 32) v = *(const unsigned*)q;
#endif
  return v;
}
DI void l2_sink(unsigned v) {
#if L2_TOUCH
  asm volatile("" :: "v"(v));
#endif
}
template <bool SWAP, bool RES = false>
DI void gemm_chunk(const char* ldsA, const bf8* __restrict__ wf, int lane, f16v (&acc)[2][2], const float* res = nullptr) {
  Ring rg;
  gemm_chunk_r<SWAP, RES, true, false>(ldsA, wf, nullptr, lane, acc, rg, res);
}

DI void store_swap_bf16(u16* dst, size_t ld, const f16v (&acc)[2][2], int lane) {
  const int r = lane & 31, h = lane >> 5;
#pragma unroll
  for (int ntl = 0; ntl < 2; ++ntl)
#pragma unroll
    for (int tt = 0; tt < 2; ++tt)
#pragma unroll
      for (int g = 0; g < 4; ++g) {
        f4v v = {acc[ntl][tt][4 * g], acc[ntl][tt][4 * g + 1], acc[ntl][tt][4 * g + 2], acc[ntl][tt][4 * g + 3]};
        *(bf4*)(dst + (size_t)(32 * tt + r) * ld + 32 * ntl + 8 * g + 4 * h) = cvt4(v);
      }
}
DI void store_vt_bf16(u16* dst, size_t ld, const f16v (&acc)[2][2], int lane) {
  const int r = lane & 31, h = lane >> 5;
#pragma unroll
  for (int ntl = 0; ntl < 2; ++ntl)
#pragma unroll
    for (int tt = 0; tt < 2; ++tt)
#pragma unroll
      for (int s = 0; s < 2; ++s) {
        f8v v;
#pragma unroll
        for (int j = 0; j < 8; ++j) v[j] = acc[ntl][tt][8 * s + j];
        *(bf8*)(dst + (size_t)(32 * ntl + r) * ld + 32 * tt + 16 * s + 8 * h) = cvt8(v);
      }
}

DI float log_sigmoid_acc(float x) { return fminf(x, 0.f) - log1pf(expf(-fabsf(x))); }

template <bool PRELOADED = false, bool TBL = false>
DI void phase_a_tile(const MKParams& p, int tile, int wave, int lane) {
  asm volatile("" : "+v"(lane));
  char* ws = p.ws;
  char* ldsA = smem;
  float* alr_s = (float*)(smem + LDS_A_BYTES);
  const int b = tile >> 5, c = tile & 31;
  const size_t tok0 = (size_t)tile * 64;
  if (!PRELOADED) {
    __syncthreads();
    load_norm_tile(p.x + tok0 * DM, ldsA, wave, lane);
#if PROBE == 10
    __syncthreads();
    load_norm_tile(p.x + tok0 * DM, ldsA, wave, lane);
#endif
    __syncthreads();
  }
  const bf8* wf = (const bf8*)(ws + OFF_WIN);
  f16v acc[2][2];
  Ring rg;
  f4v tv[2][4];
  const int trow0 = (blockIdx.x * 8 + wave) * 16;
  const int t0 = c * 64;
  { const unsigned pf = l2_touch(wf + (size_t)1 * 65536, lane);
  gemm_chunk_r<true, false, true, true>(ldsA, wf + (size_t)0 * 65536 + 2 * wave * 64, wf + (size_t)1 * 65536 + 2 * wave * 64, lane, acc, rg);
    l2_sink(pf); }
  if (TBL && 0 < TBL_IN_A) { table_row_issue(p, trow0 + 0, lane, tv[0]); table_row_issue(p, trow0 + 1, lane, tv[1]); }
  {
    u16* base = (u16*)(ws + (wave < 4 ? OFF_GQ : OFF_GK)) + ((size_t)(b * 4 + (wave & 3)) * SEQ + t0) * 64;
    store_swap_bf16(base, 64, acc, lane);
  if (TBL && 0 < TBL_IN_A) { table_row_finish(p, trow0 + 0, lane, tv[0]); table_row_finish(p, trow0 + 1, lane, tv[1]); }
#if PROBE == 11
    store_swap_bf16(base, 64, acc, lane);
#endif
  }
  { const unsigned pf = l2_touch(wf + (size_t)2 * 65536, lane);
  gemm_chunk_r<false, false, false, true>(ldsA, wf + (size_t)1 * 65536 + 2 * wave * 64, wf + (size_t)2 * 65536 + 2 * wave * 64, lane, acc, rg);
    l2_sink(pf); }
  if (TBL && 2 < TBL_IN_A) { table_row_issue(p, trow0 + 2, lane, tv[0]); table_row_issue(p, trow0 + 3, lane, tv[1]); }
  {
    u16* base = (u16*)(ws + OFF_GVT) + ((size_t)(b * 4 + (wave >> 1)) * 128 + 64 * (wave & 1)) * SEQ + t0;
    store_vt_bf16(base, SEQ, acc, lane);
  if (TBL && 2 < TBL_IN_A) { table_row_finish(p, trow0 + 2, lane, tv[0]); table_row_finish(p, trow0 + 3, lane, tv[1]); }
#if PROBE == 11
    store_vt_bf16(base, SEQ, acc, lane);
#endif
  }
  { const unsigned pf = l2_touch(wf + (size_t)3 * 65536, lane);
  gemm_chunk_r<true, false, false, true>(ldsA, wf + (size_t)2 * 65536 + 2 * wave * 64, wf + (size_t)3 * 65536 + 2 * wave * 64, lane, acc, rg);
    l2_sink(pf); }
  if (TBL && 4 < TBL_IN_A) { table_row_issue(p, trow0 + 4, lane, tv[0]); table_row_issue(p, trow0 + 5, lane, tv[1]); }
  store_swap_bf16((u16*)(ws + OFF_OG) + tok0 * 512 + 64 * wave, 512, acc, lane);
  if (TBL && 4 < TBL_IN_A) { table_row_finish(p, trow0 + 4, lane, tv[0]); table_row_finish(p, trow0 + 5, lane, tv[1]); }
#if PROBE == 11
  store_swap_bf16((u16*)(ws + OFF_OG) + tok0 * 512 + 64 * wave, 512, acc, lane);
#endif
  { const unsigned pf = l2_touch(wf + (size_t)4 * 65536, lane);
  gemm_chunk_r<true, false, false, true>(ldsA, wf + (size_t)3 * 65536 + 2 * wave * 64, wf + (size_t)4 * 65536 + 2 * wave * 64, lane, acc, rg);
    l2_sink(pf); }
  if (TBL && 6 < TBL_IN_A) { table_row_issue(p, trow0 + 6, lane, tv[0]); table_row_issue(p, trow0 + 7, lane, tv[1]); }
  store_swap_bf16((u16*)(ws + OFF_SQ) + ((size_t)(b * 8 + wave) * SEQ + t0) * 64, 64, acc, lane);
  if (TBL && 6 < TBL_IN_A) { table_row_finish(p, trow0 + 6, lane, tv[0]); table_row_finish(p, trow0 + 7, lane, tv[1]); }
#if PROBE == 11
  store_swap_bf16((u16*)(ws + OFF_SQ) + ((size_t)(b * 8 + wave) * SEQ + t0) * 64, 64, acc, lane);
#endif
  { const unsigned pf = l2_touch(wf + (size_t)5 * 65536, lane);
  gemm_chunk_r<true, false, false, true>(ldsA, wf + (size_t)4 * 65536 + 2 * wave * 64, wf + (size_t)5 * 65536 + 2 * wave * 64, lane, acc, rg);
    l2_sink(pf); }
  if (TBL && 8 < TBL_IN_A) { table_row_issue(p, trow0 + 8, lane, tv[0]); table_row_issue(p, trow0 + 9, lane, tv[1]); }
  store_swap_bf16((u16*)(ws + OFF_SK) + ((size_t)(b * 8 + wave) * SEQ + t0) * 64, 64, acc, lane);
  if (TBL && 8 < TBL_IN_A) { table_row_finish(p, trow0 + 8, lane, tv[0]); table_row_finish(p, trow0 + 9, lane, tv[1]); }
#if PROBE == 11
  store_swap_bf16((u16*)(ws + OFF_SK) + ((size_t)(b * 8 + wave) * SEQ + t0) * 64, 64, acc, lane);
#endif
  gemm_chunk_r<false, false, false, false>(ldsA, wf + (size_t)5 * 65536 + 2 * wave * 64, nullptr, lane, acc, rg);
  if (TBL && 10 < TBL_IN_A) { table_row_issue(p, trow0 + 10, lane, tv[0]); table_row_issue(p, trow0 + 11, lane, tv[1]); }
  store_vt_bf16((u16*)(ws + OFF_SVT) + ((size_t)(b * 8 + wave) * 64) * SEQ + t0, SEQ, acc, lane);
  if (TBL && 10 < TBL_IN_A) { table_row_finish(p, trow0 + 10, lane, tv[0]); table_row_finish(p, trow0 + 11, lane, tv[1]); }
#if PROBE == 11
  store_vt_bf16((u16*)(ws + OFF_SVT) + ((size_t)(b * 8 + wave) * 64) * SEQ + t0, SEQ, acc, lane);
#endif
#if PROBE == 12
  for (int rep_ = 0; rep_ < 2; ++rep_) {
  __syncthreads();
#else
  {
#endif
    float* part = (float*)(smem + LDS_A_BYTES);
    const int r = lane & 31, h = lane >> 5;
    const bf8* wp = wf + (size_t)96 * 4096 + lane;
    bf8 wfr[8];
#pragma unroll
    for (int i = 0; i < 8; ++i) wfr[i] = wp[(8 * wave + i) * 64];
    const char* xa0 = ldsA + r * LDS_ROW + h * 16 + wave * 256;
    const char* xa1 = xa0 + 32 * LDS_ROW;
    f16v a0 = zero16(), a1 = zero16();
#pragma unroll
    for (int i = 0; i < 8; ++i) {
      a0 = MFMA(wfr[i], *(const bf8*)(xa0 + i * 32), a0);
      a1 = MFMA(wfr[i], *(const bf8*)(xa1 + i * 32), a1);
    }
    float* pw = part + (wave & 3) * 1024;
    if (wave < 4) {
#pragma unroll
      for (int i = 0; i < 8; ++i) { pw[r * 16 + crow(i, h)] = a0[i]; pw[(32 + r) * 16 + crow(i, h)] = a1[i]; }
    }
    __syncthreads();
    if (wave >= 4) {
#pragma unroll
      for (int i = 0; i < 8; ++i) { pw[r * 16 + crow(i, h)] += a0[i]; pw[(32 + r) * 16 + crow(i, h)] += a1[i]; }
    }
    __syncthreads();
    const int tid = wave * 64 + lane;
    {
      const f4v* p4 = (const f4v*)part;
      if (tid < 256) { f4v s = p4[tid] + p4[256 + tid] + p4[512 + tid] + p4[768 + tid]; ((f4v*)part)[tid] = s; }
    }
    __syncthreads();
    const int col = tid & 255, tg = tid >> 8;
    float wu[16];
#pragma unroll
    for (int rr = 0; rr < 16; ++rr) wu[rr] = p.w_up[rr * 256 + col];
    const float bb = p.b_alpha[col];
    float* dst = (float*)(ws + OFF_LA) + (tok0 + 32 * tg) * 256 + col;
#pragma unroll 4
    for (int t = 0; t < 32; ++t) {
      const f4v* ar = (const f4v*)(part + (32 * tg + t) * 16);
      const f4v q0 = ar[0], q1 = ar[1], q2 = ar[2], q3 = ar[3];
      float s = bb;
      s = fmaf(q0[0], wu[0], s); s = fmaf(q0[1], wu[1], s); s = fmaf(q0[2], wu[2], s); s = fmaf(q0[3], wu[3], s);
      s = fmaf(q1[0], wu[4], s); s = fmaf(q1[1], wu[5], s); s = fmaf(q1[2], wu[6], s); s = fmaf(q1[3], wu[7], s);
      s = fmaf(q2[0], wu[8], s); s = fmaf(q2[1], wu[9], s); s = fmaf(q2[2], wu[10], s); s = fmaf(q2[3], wu[11], s);
      s = fmaf(q3[0], wu[12], s); s = fmaf(q3[1], wu[13], s); s = fmaf(q3[2], wu[14], s); s = fmaf(q3[3], wu[15], s);
      const float ls = fminf(s, 0.f) - __logf(1.0f + __expf(-fabsf(s)));
      dst[(size_t)t * 256] = ls * (1.0f / 16.0f);
    }
  }
}

DI void phase_a_memkv(const MKParams& p, int item, int wave, int lane) {
  asm volatile("" : "+v"(lane));
  char* ws = p.ws;
  char* ldsA = smem;
  const int rt = item >> 2, cc = item & 3;
  const int b = rt >> 2, m0 = (rt & 3) * 64;
  __syncthreads();
  load_norm_tile(p.mem + (size_t)rt * 64 * DM, ldsA, wave, lane);
  __syncthreads();
  const bf8* wf = (const bf8*)(ws + OFF_WMKV);
  f16v acc[2][2];
  if (cc < 2) {
    gemm_chunk<true>(ldsA, wf + (size_t)cc * 65536 + 2 * wave * 64, lane, acc);
    const int f0 = 512 * cc + 64 * wave;
    u16* base = (u16*)(ws + OFF_KM) + ((size_t)(b * 4 + (f0 >> 8)) * 256 + m0) * 256 + (f0 & 255);
    store_swap_bf16(base, 256, acc, lane);
  } else {
    gemm_chunk<false>(ldsA, wf + (size_t)cc * 65536 + 2 * wave * 64, lane, acc);
    const int f0 = 512 * (cc - 2) + 64 * wave;
    u16* base = (u16*)(ws + OFF_VMT) + ((size_t)(b * 4 + (f0 >> 8)) * 256 + (f0 & 255)) * 256 + m0;
    store_vt_bf16(base, 256, acc, lane);
  }
}
#define SB_THR 30.0f

DI bf8 pack8(const f16v& x, int s) {
  f8v v;
#pragma unroll
  for (int j = 0; j < 8; ++j) v[j] = x[8 * s + j];
  return cvt8(v);
}

DI void sb_item(const MKParams& p, int item, int lane) {
  asm volatile("" : "+v"(lane));
  char* ws = p.ws;
  const int r = lane & 31, h = lane >> 5;
  const int bh = item >> 6, qt = item & 63;
  const u16* SQ = (const u16*)(ws + OFF_SQ) + (size_t)bh * SEQ * 64;
  const u16* SK = (const u16*)(ws + OFF_SK) + (size_t)bh * SEQ * 64;
  const u16* SVT = (const u16*)(ws + OFF_SVT) + (size_t)bh * 64 * SEQ;
  bf8 qf[4];
#pragma unroll
  for (int ks = 0; ks < 4; ++ks) qf[ks] = *(const bf8*)(SQ + (size_t)(32 * qt + r) * 64 + 16 * ks + 8 * h);
  bf8 tri[2];
#pragma unroll
  for (int s = 0; s < 2; ++s) {
    f8v t;
#pragma unroll
    for (int j = 0; j < 8; ++j) t[j] = (16 * s + 8 * (j >> 2) + 4 * h + (j & 3) >= r) ? 1.0f : 0.0f;
    tri[s] = cvt8(t);
  }
  f16v o0 = zero16(), o1 = zero16();
  float R = 0.f;
  bf8 kf[4], vf[2][2];
#pragma unroll
  for (int ks = 0; ks < 4; ++ks) kf[ks] = *(const bf8*)(SK + (size_t)(32 * qt + r) * 64 + 16 * ks + 8 * h);
#pragma unroll
  for (int mt = 0; mt < 2; ++mt)
#pragma unroll
    for (int s = 0; s < 2; ++s) vf[mt][s] = *(const bf8*)(SVT + (size_t)(32 * mt + r) * SEQ + 32 * qt + 16 * s + 8 * h);
  for (int kt = qt; kt >= 0; --kt) {
    bf8 kfn[4], vfn[2][2];
    const int ktn = (kt > 0) ? kt - 1 : 0;
#pragma unroll
    for (int ks = 0; ks < 4; ++ks) kfn[ks] = *(const bf8*)(SK + (size_t)(32 * ktn + r) * 64 + 16 * ks + 8 * h);
#pragma unroll
    for (int mt = 0; mt < 2; ++mt)
#pragma unroll
      for (int s = 0; s < 2; ++s) vfn[mt][s] = *(const bf8*)(SVT + (size_t)(32 * mt + r) * SEQ + 32 * ktn + 16 * s + 8 * h);
    f16v z = zero16();
#pragma unroll
    for (int ks = 0; ks < 4; ++ks) z = MFMA(kf[ks], qf[ks], z);
    const bool diag = (kt == qt);
    f16v sp;
    float tot = 0.f;
#pragma unroll
    for (int i = 0; i < 16; ++i) {
      const float zz = z[i];
      const float sv = fmaxf(zz, 0.f) + __logf(1.0f + __expf(-fabsf(zz)));
      const bool valid = !diag || (crow(i, h) < r);
      sp[i] = valid ? sv : 0.f;
      tot += sp[i];
    }
    tot += __shfl_xor(tot, 32);
    f16v C = MFMA(tri[0], pack8(sp, 0), zero16());
    C = MFMA(tri[1], pack8(sp, 1), C);
    f16v a;
#pragma unroll
    for (int i = 0; i < 16; ++i) {
      const bool valid = !diag || (crow(i, h) < r);
      a[i] = valid ? __expf(z[i] - C[i] - R) : 0.f;
    }
    const bf8 a0 = pack8(a, 0), a1 = pack8(a, 1);
    o0 = MFMA(vf[0][0], a0, o0); o0 = MFMA(vf[0][1], a1, o0);
    o1 = MFMA(vf[1][0], a0, o1); o1 = MFMA(vf[1][1], a1, o1);
    R += tot;
    if (__all(R > SB_THR)) break;
#pragma unroll
    for (int ks = 0; ks < 4; ++ks) kf[ks] = kfn[ks];
#pragma unroll
    for (int mt = 0; mt < 2; ++mt)
#pragma unroll
      for (int s = 0; s < 2; ++s) vf[mt][s] = vfn[mt][s];
  }
  const int b = bh >> 3, hd = bh & 7;
  u16* dst = (u16*)(ws + OFF_OSB) + ((size_t)b * SEQ + 32 * qt + r) * 512 + hd * 64 + 4 * h;
#pragma unroll
  for (int g = 0; g < 4; ++g) {
    f4v v0 = {o0[4 * g], o0[4 * g + 1], o0[4 * g + 2], o0[4 * g + 3]};
    f4v v1 = {o1[4 * g], o1[4 * g + 1], o1[4 * g + 2], o1[4 * g + 3]};
    *(bf4*)(dst + 8 * g) = cvt4a(v0);
    *(bf4*)(dst + 32 + 8 * g) = cvt4a(v1);
  }
}

DI void gla_g1_tile(const MKParams& p, int tile, int wave, int lane) {
  asm volatile("" : "+v"(lane));
  __builtin_amdgcn_sched_barrier(0);
  char* ws = p.ws;
  const int r = lane & 31, h = lane >> 5;
  const int b = tile >> 5, c = tile & 31, hd = wave >> 1, half = wave & 1, bh = b * 4 + hd;
  const int item = bh * 32 + c;
  char* kl = smem + wave * 9216;
  const u16* GQ = (const u16*)(ws + OFF_GQ) + ((size_t)bh * SEQ + 64 * c) * 64;
  const u16* GK = (const u16*)(ws + OFF_GK) + ((size_t)bh * SEQ + 64 * c) * 64;
  u16* GQ2 = (u16*)(ws + OFF_GQ2) + ((size_t)bh * SEQ + 64 * c) * 64;
  u16* GK2 = (u16*)(ws + OFF_GK2) + ((size_t)bh * SEQ + 64 * c) * 64;
  const float* LA = (const float*)(ws + OFF_LA) + ((size_t)b * SEQ + 64 * c) * 256 + hd * 64;
  float bc = 0.f;
#pragma unroll 1
  for (int g = 0; g < 4; ++g) {
    float la_[16];
    u16 q_[16], k_[16];
#pragma unroll
    for (int i = 0; i < 16; ++i) {
      const int t = 16 * g + i;
      la_[i] = LA[(size_t)t * 256 + lane];
      q_[i] = GQ[t * 64 + lane];
      k_[i] = GK[t * 64 + lane];
    }
#pragma unroll
    for (int i = 0; i < 16; ++i) {
      const int t = 16 * g + i;
      bc += la_[i];
      const float eq = __expf(bc);
      const float qn = bf2f(q_[i]) * eq, kn = bf2f(k_[i]) / eq;
      const bf2 pk = __builtin_convertvector((f2v){qn, kn}, bf2);
      const unsigned u = __builtin_bit_cast(unsigned, pk);
      if (half == 0) {
        GQ2[t * 64 + lane] = (u16)(u & 0xffff);
        GK2[t * 64 + lane] = (u16)(u >> 16);
      }
      *(u16*)(kl + lane * 144 + tpos(t) * 2) = (u16)(u >> 16);
    }
  }
  if (half == 0) ((float*)(ws + OFF_DD))[(size_t)item * 64 + lane] = __expf(bc);
  asm volatile("s_waitcnt lgkmcnt(0)" ::: "memory");
  const u16* GVT = (const u16*)(ws + OFF_GVT) + (size_t)bh * 128 * SEQ + 64 * c;
  float* LKV = (float*)(ws + OFF_LKV) + (size_t)item * 128 * 64;
  bf8 kb[2][4];
#pragma unroll
  for (int nt = 0; nt < 2; ++nt)
#pragma unroll
    for (int s = 0; s < 4; ++s) kb[nt][s] = *(const bf8*)(kl + (32 * nt + r) * 144 + (16 * s + 8 * h) * 2);
  bf8 vf[2][4];
#pragma unroll
  for (int m2 = 0; m2 < 2; ++m2)
#pragma unroll
    for (int s = 0; s < 4; ++s) vf[m2][s] = *(const bf8*)(GVT + (size_t)(32 * (2 * half + m2) + r) * SEQ + 16 * s + 8 * h);
  __builtin_amdgcn_sched_barrier(0);
#pragma unroll
  for (int m2 = 0; m2 < 2; ++m2) {
    const int mt = 2 * half + m2;
    f16v a0 = zero16(), a1 = zero16();
#pragma unroll
    for (int s = 0; s < 4; ++s) {
      a0 = MFMA(vf[m2][s], kb[0][s], a0);
      a1 = MFMA(vf[m2][s], kb[1][s], a1);
    }
#pragma unroll
    for (int i = 0; i < 16; ++i) {
      LKV[(32 * mt + crow(i, h)) * 64 + r] = a0[i];
      LKV[(32 * mt + crow(i, h)) * 64 + 32 + r] = a1[i];
    }
  }
  asm volatile("s_waitcnt lgkmcnt(0)" ::: "memory");
}

DI void gla_g2(const MKParams& p, int gtid, int gthreads) {
  char* ws = p.ws;
  for (int u = gtid; u < 32768; u += gthreads) {
    const int oct = u & 7, dv = (u >> 3) & 127, bh = u >> 10;
    f8v S = {0.f, 0.f, 0.f, 0.f, 0.f, 0.f, 0.f, 0.f};
#pragma unroll 4
    for (int c = 0; c < 32; ++c) {
      const size_t item = (size_t)bh * 32 + c;
      *(bf8*)((u16*)(ws + OFF_SS) + (item * 128 + dv) * 64 + oct * 8) = cvt8(S);
      const f8v l = *(const f8v*)((const float*)(ws + OFF_LKV) + (item * 128 + dv) * 64 + oct * 8);
      const f8v d = *(const f8v*)((const float*)(ws + OFF_DD) + item * 64 + oct * 8);
      S = d * (S + l);
    }
  }
}

DI void gla_g3_tile(const MKParams& p, int tile, int wave, int lane, char* dst, int dst_ld) {
  asm volatile("" : "+s"(wave));
  char* ws = p.ws;
  const int r = lane & 31, h = lane >> 5;
  const int b = tile >> 5, c = tile & 31, hd = wave >> 1, tt = wave & 1, bh = b * 4 + hd;
  const u16* GQ = (const u16*)(ws + OFF_GQ2) + ((size_t)bh * SEQ + 64 * c) * 64;
  const u16* GK = (const u16*)(ws + OFF_GK2) + ((size_t)bh * SEQ + 64 * c) * 64;
  const u16* GVT = (const u16*)(ws + OFF_GVT) + (size_t)bh * 128 * SEQ + 64 * c;
  const u16* SS = (const u16*)(ws + OFF_SS) + ((size_t)(bh * 32 + c) * 128) * 64;
  bf8 qf[4];
#pragma unroll
  for (int ks = 0; ks < 4; ++ks) qf[ks] = *(const bf8*)(GQ + (32 * tt + r) * 64 + 16 * ks + 8 * h);
  bf8 pf[2][2];
  {
    bf8 kf[2][4];
#pragma unroll
    for (int kt = 0; kt < 2; ++kt)
      if (kt <= tt) {
#pragma unroll
        for (int ks = 0; ks < 4; ++ks) kf[kt][ks] = *(const bf8*)(GK + (32 * kt + r) * 64 + 16 * ks + 8 * h);
      }
    __builtin_amdgcn_sched_barrier(0);
#pragma unroll
    for (int kt = 0; kt < 2; ++kt) {
      if (kt <= tt) {
        f16v pt = zero16();
#pragma unroll
        for (int ks = 0; ks < 4; ++ks) pt = MFMA(kf[kt][ks], qf[ks], pt);
        if (kt == tt) {
#pragma unroll
          for (int i = 0; i < 16; ++i) pt[i] = (crow(i, h) <= r) ? pt[i] : 0.f;
        }
        pf[kt][0] = pack8(pt, 0);
        pf[kt][1] = pack8(pt, 1);
      }
    }
  }
  f16v o[4];
  {
    bf8 sf[2][4], vf[2][4];
    auto load_tile = [&](int mt, bf8 (&sfx)[4], bf8 (&vfx)[4]) {
#pragma unroll
      for (int ks = 0; ks < 4; ++ks) sfx[ks] = *(const bf8*)(SS + (32 * mt + r) * 64 + 16 * ks + 8 * h);
#pragma unroll
      for (int kt = 0; kt < 2; ++kt)
        if (kt <= tt) {
#pragma unroll
          for (int s = 0; s < 2; ++s) vfx[2 * kt + s] = *(const bf8*)(GVT + (size_t)(32 * mt + r) * SEQ + 32 * kt + 16 * s + 8 * h);
        }
    };
    load_tile(0, sf[0], vf[0]);
#pragma unroll
    for (int mt = 0; mt < 4; ++mt) {
      if (mt + 1 < 4) load_tile(mt + 1, sf[(mt + 1) & 1], vf[(mt + 1) & 1]);
      __builtin_amdgcn_sched_barrier(0);
      o[mt] = zero16();
#pragma unroll
      for (int ks = 0; ks < 4; ++ks) o[mt] = MFMA(sf[mt & 1][ks], qf[ks], o[mt]);
#pragma unroll
      for (int kt = 0; kt < 2; ++kt)
        if (kt <= tt) {
#pragma unroll
          for (int s = 0; s < 2; ++s) o[mt] = MFMA(vf[mt & 1][2 * kt + s], pf[kt][s], o[mt]);
        }
      __builtin_amdgcn_sched_barrier(0);
    }
  }
  float ss = 0.f;
#pragma unroll
  for (int mt = 0; mt < 4; ++mt)
#pragma unroll
    for (int i = 0; i < 16; ++i) ss += o[mt][i] * o[mt][i];
  ss += __shfl_xor(ss, 32);
  const float rr = rsqrtf(ss * (1.0f / 128.0f) + EPSV);
  const size_t tok = (size_t)tile * 64 + 32 * tt + r;
  const u16* OG = (const u16*)(ws + OFF_OG) + tok * 512 + hd * 128;
#pragma unroll
  for (int mt = 0; mt < 4; ++mt)
#pragma unroll
    for (int g = 0; g < 4; ++g) {
      const int dv0 = 32 * mt + 8 * g + 4 * h;
      const ushort4 og4 = *(const ushort4*)(OG + dv0);
      const f4v gg = *(const f4v*)(p.g_gla + dv0);
      const float og[4] = {bf2f(og4.x), bf2f(og4.y), bf2f(og4.z), bf2f(og4.w)};
      f4v v;
#pragma unroll
      for (int j = 0; j < 4; ++j) v[j] = o[mt][4 * g + j] * rr * gg[j] * (og[j] / (1.0f + __expf(-og[j])));
      *(bf4*)(dst + (size_t)(32 * tt + r) * dst_ld + (hd * 128 + dv0) * 2) = cvt4a(v);
    }
}
DI void gemm_1024(const char* ldsA, const bf8* __restrict__ wf, int wave, int lane, f16v (&a0)[2][2], f16v (&a1)[2][2]) {
  gemm_chunk<true>(ldsA, wf + 2 * wave * 64, lane, a0);
  gemm_chunk<true>(ldsA, wf + 65536 + 2 * wave * 64, lane, a1);
}
DI void gemm_1024_res(const char* ldsA, const bf8* __restrict__ wf, int wave, int lane, f16v (&a0)[2][2], f16v (&a1)[2][2],
                      const float* res) {
  gemm_chunk<true, true>(ldsA, wf + 2 * wave * 64, lane, a0, res + 64 * wave);
  gemm_chunk<true, true>(ldsA, wf + 65536 + 2 * wave * 64, lane, a1, res + 512 + 64 * wave);
}

DI void store_f32_ssq(const f16v (&a)[2][2], float* dst, int f0, int lane, float (&ssq)[2]) {
  const int r = lane & 31, h = lane >> 5;
#pragma unroll
  for (int ntl = 0; ntl < 2; ++ntl)
#pragma unroll
    for (int tt = 0; tt < 2; ++tt)
#pragma unroll
      for (int g = 0; g < 4; ++g) {
        f4v v = {a[ntl][tt][4 * g], a[ntl][tt][4 * g + 1], a[ntl][tt][4 * g + 2], a[ntl][tt][4 * g + 3]};
        ssq[tt] += v[0] * v[0] + v[1] * v[1] + v[2] * v[2] + v[3] * v[3];
        *(f4v*)(dst + (size_t)(32 * tt + r) * DM + f0 + 32 * ntl + 8 * g + 4 * h) = v;
      }
  asm volatile("" : "+v"(ssq[0]), "+v"(ssq[1]));
}

DI void acc_to_scratch(u16* scr, const f16v (&a)[2][2], int f0, int lane, float s0, float s1) {
  const int r = lane & 31, h = lane >> 5;
#pragma unroll
  for (int ntl = 0; ntl < 2; ++ntl)
#pragma unroll
    for (int tt = 0; tt < 2; ++tt)
#pragma unroll
      for (int g = 0; g < 4; ++g) {
        const float sc = tt ? s1 : s0;
        f4v v = {a[ntl][tt][4 * g] * sc, a[ntl][tt][4 * g + 1] * sc, a[ntl][tt][4 * g + 2] * sc, a[ntl][tt][4 * g + 3] * sc};
        *(bf4*)(scr + (size_t)(32 * tt + r) * 1024 + f0 + 32 * ntl + 8 * g + 4 * h) = cvt4(v);
      }
}
typedef __attribute__((ext_vector_type(4))) unsigned u4v;
DI void scratch_to_lds(const u16* scr, char* ldsA, int tid) {
  asm volatile("" : "+v"(tid));
  const unsigned toff = (unsigned)tid * 16u;
#pragma unroll
  for (int half = 0; half < 2; ++half) {
    u4v v[8];
#pragma unroll
    for (int it = 0; it < 8; ++it)
      v[it] = __builtin_nontemporal_load((const u4v*)((const char*)scr + (size_t)(8192 * (8 * half + it)) + toff));
#pragma unroll
    for (int it = 0; it < 8; ++it) {
      const int idx = tid + 512 * (8 * half + it), row = idx >> 7, ch = idx & 127;
      *(u4v*)(ldsA + row * LDS_ROW + ch * 16) = v[it];
    }
  }
}

struct Pk { bf4 v[2][2][4]; };
template <bool ACT = false>
DI void pack_acc(Pk& pk, const f16v (&a)[2][2], float s0, float s1) {
#pragma unroll
  for (int ntl = 0; ntl < 2; ++ntl)
#pragma unroll
    for (int tt = 0; tt < 2; ++tt)
#pragma unroll
      for (int g = 0; g < 4; ++g) {
        const float sc = tt ? s1 : s0;
        f4v v = {a[ntl][tt][4 * g] * sc, a[ntl][tt][4 * g + 1] * sc, a[ntl][tt][4 * g + 2] * sc, a[ntl][tt][4 * g + 3] * sc};
        unsigned long long u = __builtin_bit_cast(unsigned long long, ACT ? cvt4a(v) : cvt4(v));
        asm volatile("" : "+v"(u));
        pk.v[ntl][tt][g] = __builtin_bit_cast(bf4, u);
      }
}
DI void pk_to_lds(char* ldsA, const Pk& pk, int f0, int lane) {
  const int r = lane & 31, h = lane >> 5;
#pragma unroll
  for (int ntl = 0; ntl < 2; ++ntl)
#pragma unroll
    for (int tt = 0; tt < 2; ++tt)
#pragma unroll
      for (int g = 0; g < 4; ++g)
        *(bf4*)(ldsA + (32 * tt + r) * LDS_ROW + (f0 + 32 * ntl + 8 * g + 4 * h) * 2) = pk.v[ntl][tt][g];
}

DI void rms_from_partials(float* red, int wave, int lane, const float (&ssq)[2], float& rs0, float& rs1) {
  red[(wave * 2 + 0) * 64 + lane] = ssq[0];
  red[(wave * 2 + 1) * 64 + lane] = ssq[1];
  __syncthreads();
  const int r = lane & 31;
  float t0 = 0.f, t1 = 0.f;
#pragma unroll
  for (int w = 0; w < 8; ++w) {
    t0 += red[(w * 2 + 0) * 64 + r] + red[(w * 2 + 0) * 64 + 32 + r];
    t1 += red[(w * 2 + 1) * 64 + r] + red[(w * 2 + 1) * 64 + 32 + r];
  }
  rs0 = rsqrtf(t0 * (1.0f / DM) + EPSV);
  rs1 = rsqrtf(t1 * (1.0f / DM) + EPSV);
}

template <bool WRITE = true>
DI void mem_attn(const MKParams& p, char* ldsA, int b, int wave, int lane) {
  char* ws = p.ws;
  const int r = lane & 31, h = lane >> 5;
  const int hm = wave >> 1, tt = wave & 1;
  const char* KM = ws + OFF_KM + (size_t)(b * 4 + hm) * 256 * 256 * 2;
  const char* VMT = ws + OFF_VMT + (size_t)(b * 4 + hm) * 256 * 256 * 2;
  char* qrow = ldsA + (32 * tt + r) * LDS_ROW + hm * 512;
  const unsigned loff = (unsigned)((r * 256 + 8 * h) * 2);
  f16v s[8];
#pragma unroll
  for (int mt = 0; mt < 8; ++mt) s[mt] = zero16();
  bf8 ka[8], kb[8];
#pragma unroll
  for (int mt = 0; mt < 8; ++mt) ka[mt] = *(const bf8*)(KM + (size_t)(mt * 32 * 256 * 2) + loff);
  bf8 qa = *(const bf8*)(qrow + 8 * h * 2), qb;
#pragma unroll 1
  for (int ks = 0; ks < 16; ks += 2) {
#if ATTN_LOCKSTEP
    __builtin_amdgcn_s_barrier();
#endif
#pragma unroll
    for (int mt = 0; mt < 8; ++mt) kb[mt] = *(const bf8*)(KM + (size_t)((mt * 32 * 256 + 16 * (ks + 1)) * 2) + loff);
    qb = *(const bf8*)(qrow + (16 * (ks + 1) + 8 * h) * 2);
#pragma unroll
    for (int mt = 0; mt < 8; ++mt) s[mt] = MFMA(ka[mt], qa, s[mt]);
    __builtin_amdgcn_sched_group_barrier(0x020, 8, 0);
    __builtin_amdgcn_sched_group_barrier(0x100, 1, 0);
    __builtin_amdgcn_sched_group_barrier(0x008, 8, 0);
    if (ks + 2 < 16) {
#pragma unroll
      for (int mt = 0; mt < 8; ++mt) ka[mt] = *(const bf8*)(KM + (size_t)((mt * 32 * 256 + 16 * (ks + 2)) * 2) + loff);
      qa = *(const bf8*)(qrow + (16 * (ks + 2) + 8 * h) * 2);
    }
#pragma unroll
    for (int mt = 0; mt < 8; ++mt) s[mt] = MFMA(kb[mt], qb, s[mt]);
    __builtin_amdgcn_sched_group_barrier(0x020, 8, 0);
    __builtin_amdgcn_sched_group_barrier(0x100, 1, 0);
    __builtin_amdgcn_sched_group_barrier(0x008, 8, 0);
  }
  float mx = -INFINITY;
#pragma unroll
  for (int mt = 0; mt < 8; ++mt)
#pragma unroll
    for (int i = 0; i < 16; ++i) mx = fmaxf(mx, s[mt][i]);
  mx = fmaxf(mx, __shfl_xor(mx, 32));
  float l = 0.f;
  bf8 pf[8][2];
#pragma unroll
  for (int mt = 0; mt < 8; ++mt) {
#pragma unroll
    for (int i = 0; i < 16; ++i) { s[mt][i] = __expf(s[mt][i] - mx); l += s[mt][i]; }
    pf[mt][0] = pack8(s[mt], 0);
    pf[mt][1] = pack8(s[mt], 1);
  }
  l += __shfl_xor(l, 32);
  const float inv = 1.0f / l;
#pragma unroll
  for (int grp = 0; grp < 2; ++grp) {
    f16v o[4];
#pragma unroll
    for (int m4 = 0; m4 < 4; ++m4) o[m4] = zero16();
    const char* vb = VMT + (size_t)(grp * 4 * 32 * 256 * 2) + loff;
    bf8 va[4], vn[4];
#pragma unroll
    for (int m4 = 0; m4 < 4; ++m4) va[m4] = *(const bf8*)(vb + (size_t)(m4 * 32 * 256 * 2));
#pragma unroll
    for (int st = 0; st < 16; ++st) {
#if ATTN_LOCKSTEP
      if ((st & 1) == 0) __builtin_amdgcn_s_barrier();
#endif
      if (st + 1 < 16) {
#pragma unroll
        for (int m4 = 0; m4 < 4; ++m4) vn[m4] = *(const bf8*)(vb + (size_t)((m4 * 32 * 256 + 16 * (st + 1)) * 2));
      }
#pragma unroll
      for (int m4 = 0; m4 < 4; ++m4) o[m4] = MFMA(va[m4], pf[st >> 1][st & 1], o[m4]);
      if (st + 1 < 16) {
        __builtin_amdgcn_sched_group_barrier(0x020, 4, 0);
        __builtin_amdgcn_sched_group_barrier(0x008, 4, 0);
#pragma unroll
        for (int m4 = 0; m4 < 4; ++m4) va[m4] = vn[m4];
      }
    }
#pragma unroll
    for (int m4 = 0; m4 < 4; ++m4)
#pragma unroll
      for (int g = 0; g < 4; ++g) {
        f4v v = {o[m4][4 * g] * inv, o[m4][4 * g + 1] * inv, o[m4][4 * g + 2] * inv, o[m4][4 * g + 3] * inv};
        if (WRITE || v[0] == 123.456f) *(bf4*)(qrow + (32 * (4 * grp + m4) + 8 * g + 4 * h) * 2) = cvt4a(v);
      }
  }
}

DI void phase_c_tile(const MKParams& p, int tile, int wave, int lane, float& rs0, float& rs1, RingC& rg) {
  asm volatile("" : "+v"(lane));
  char* ws = p.ws;
  char* ldsA = smem;
  float* red = (float*)(smem + LDS_A_BYTES);
  const size_t tok0 = (size_t)tile * 64;
  const int tid = wave * 64 + lane;
  __syncthreads();
#if W8
  ring8_fill(rg, (const uint4*)(ws + OFF_WOUT) + 2 * wave * 64, lane);
#else
  ring_fill(rg, (const bf8*)(ws + OFF_WOUT) + 2 * wave * 64, lane);
#endif
  const unsigned pf0 = l2_touch(ws + OFF_WOUT, lane), pf1 = l2_touch(ws + OFF_WOUT + 1048576, lane);
#if PROBE == 15
  gla_g3_tile(p, tile, wave, lane, ldsA, LDS_ROW);
  __builtin_amdgcn_sched_barrier(0);
  asm volatile("" : "+v"(lane));
#endif
  {
  gla_g3_tile(p, tile, wave, lane, ldsA, LDS_ROW);
  {
    const char* osb = ws + OFF_OSB + tok0 * 1024;
#pragma unroll
    for (int it = 0; it < 8; ++it) {
      const int idx = tid + 512 * it, row = idx >> 6, ch = idx & 63;
      *(uint4*)(ldsA + row * LDS_ROW + 1024 + ch * 16) = *(const uint4*)(osb + (size_t)row * 1024 + ch * 16);
    }
  }
  }
  __syncthreads();
  l2_sink(pf0); l2_sink(pf1);
  f16v acc[2][2];
  Pk pk0, pk1;
  float* hdst = p.out + tok0 * DM;
#if W8
  const float* csb = (const float*)(ws + OFF_CS);
  const float* icsb = (const float*)(ws + OFF_ICS);
  {
    float ssq[2] = {0.f, 0.f};
    const uint4* wf = (const uint4*)(ws + OFF_WOUT);
    asm volatile("" : "+v"(lane));
    gemm_chunk_w8<true, true, false, true, false>(ldsA, wf + 2 * wave * 64, wf + 32768 + 2 * wave * 64, lane, acc, rg, p.x + tok0 * DM + 64 * wave, icsb + 4096 + 64 * wave);
    scale_cols(acc, csb + 4096 + 64 * wave, lane);
    store_f32_ssq(acc, hdst, 64 * wave, lane, ssq);
    pack_acc<true>(pk0, acc, 1.f, 1.f);
    asm volatile("" : "+v"(lane));
    gemm_chunk_w8<true, true, false, true, true>(ldsA, wf + 32768 + 2 * wave * 64, (const uint4*)(ws + OFF_WMQ) + 2 * wave * 64, lane, acc, rg, p.x + tok0 * DM + 512 + 64 * wave, icsb + 4096 + 512 + 64 * wave);
    scale_cols(acc, csb + 4096 + 512 + 64 * wave, lane);
    store_f32_ssq(acc, hdst, 512 + 64 * wave, lane, ssq);
    pack_acc<true>(pk1, acc, 1.f, 1.f);
    rms_from_partials(red, wave, lane, ssq, rs0, rs1);
  }
  pk_to_lds(ldsA, pk0, 64 * wave, lane);
  pk_to_lds(ldsA, pk1, 512 + 64 * wave, lane);
  __syncthreads();
  {
    const uint4* wf = (const uint4*)(ws + OFF_WMQ);
    asm volatile("" : "+v"(lane));
#if PROBE == 84 || PROBE == 85 || PROBE == 86
    for (int rep_ = 0; rep_ < 4; ++rep_) {
      Ring8 rg2;
      f16v acc2[2][2];
#if PROBE == 85
      gemm_chunk_w8<true, false, false, false, false, 1>(ldsA, wf + 2 * wave * 64, nullptr, lane, acc2, rg);
#else
      gemm_chunk_w8<true, false, true, false, false, (PROBE == 86 ? 2 : 0)>(ldsA, wf + 2 * wave * 64, nullptr, lane, acc2, rg2);
#endif
      asm volatile("" :: "v"(acc2[0][0]), "v"(acc2[0][1]), "v"(acc2[1][0]), "v"(acc2[1][1]));
      asm volatile("" : "+v"(lane));
    }
#endif
    gemm_chunk_w8<true, false, false, true, true>(ldsA, wf + 2 * wave * 64, wf + 32768 + 2 * wave * 64, lane, acc, rg);
    scale_cols(acc, csb + 8192 + 64 * wave, lane);
    pack_acc(pk0, acc, rs0, rs1);
    asm volatile("" : "+v"(lane));
    gemm_chunk_w8<true, false, false, false, true>(ldsA, wf + 32768 + 2 * wave * 64, nullptr, lane, acc, rg);
    scale_cols(acc, csb + 8192 + 512 + 64 * wave, lane);
    pack_acc(pk1, acc, rs0, rs1);
  }
  __syncthreads();
  pk_to_lds(ldsA, pk0, 64 * wave, lane);
  pk_to_lds(ldsA, pk1, 512 + 64 * wave, lane);
  __syncthreads();
  asm volatile("" : "+v"(lane));
  mem_attn<true>(p, ldsA, tile >> 5, wave, lane);
  __syncthreads();
  {
    float ssq[2] = {0.f, 0.f};
    const uint4* wf = (const uint4*)(ws + OFF_WMO);
    asm volatile("" : "+v"(lane));
    gemm_chunk_w8<true, true, true, true, false>(ldsA, wf + 2 * wave * 64, wf + 32768 + 2 * wave * 64, lane, acc, rg, hdst + 64 * wave, icsb + 12288 + 64 * wave);
    scale_cols(acc, csb + 12288 + 64 * wave, lane);
    store_f32_ssq(acc, hdst, 64 * wave, lane, ssq);
    pack_acc<true>(pk0, acc, 1.f, 1.f);
    asm volatile("" : "+v"(lane));
    gemm_chunk_w8<true, true, false, true, true>(ldsA, wf + 32768 + 2 * wave * 64, (const uint4*)(ws + OFF_WPQ) + 2 * wave * 64, lane, acc, rg, hdst + 512 + 64 * wave, icsb + 12288 + 512 + 64 * wave);
    scale_cols(acc, csb + 12288 + 512 + 64 * wave, lane);
    store_f32_ssq(acc, hdst, 512 + 64 * wave, lane, ssq);
    pack_acc<true>(pk1, acc, 1.f, 1.f);
    rms_from_partials(red, wave, lane, ssq, rs0, rs1);
  }
  pk_to_lds(ldsA, pk0, 64 * wave, lane);
  pk_to_lds(ldsA, pk1, 512 + 64 * wave, lane);
  __syncthreads();
}
#else
  {
    float ssq[2] = {0.f, 0.f};
    const bf8* wf = (const bf8*)(ws + OFF_WOUT);
    asm volatile("" : "+v"(lane));
    { const unsigned pf = l2_touch(ws + OFF_WMQ, lane);
    gemm_chunk_r<true, true, false, true>(ldsA, wf + 2 * wave * 64, wf + 65536 + 2 * wave * 64, lane, acc, rg, p.x + tok0 * DM + 64 * wave);
      l2_sink(pf); }
    store_f32_ssq(acc, hdst, 64 * wave, lane, ssq);
    pack_acc(pk0, acc, 1.f, 1.f);
    asm volatile("" : "+v"(lane));
    { const unsigned pf = l2_touch(ws + OFF_WMQ + 1048576, lane);
    gemm_chunk_r<true, true, false, true>(ldsA, wf + 65536 + 2 * wave * 64, (const bf8*)(ws + OFF_WMQ) + 2 * wave * 64, lane, acc, rg, p.x + tok0 * DM + 512 + 64 * wave);
      l2_sink(pf); }
    store_f32_ssq(acc, hdst, 512 + 64 * wave, lane, ssq);
    pack_acc(pk1, acc, 1.f, 1.f);
    rms_from_partials(red, wave, lane, ssq, rs0, rs1);
  }
  pk_to_lds(ldsA, pk0, 64 * wave, lane);
  pk_to_lds(ldsA, pk1, 512 + 64 * wave, lane);
  __syncthreads();
  {
    const bf8* wf = (const bf8*)(ws + OFF_WMQ);
    asm volatile("" : "+v"(lane));
    { const unsigned pf = l2_touch(ws + OFF_WMO, lane);
    gemm_chunk_r<true, false, false, true>(ldsA, wf + 2 * wave * 64, wf + 65536 + 2 * wave * 64, lane, acc, rg);
      l2_sink(pf); }
    pack_acc(pk0, acc, rs0, rs1);
    asm volatile("" : "+v"(lane));
    { const unsigned pf = l2_touch(ws + OFF_WMO + 1048576, lane);
    gemm_chunk_r<true, false, false, false>(ldsA, wf + 65536 + 2 * wave * 64, nullptr, lane, acc, rg);
      l2_sink(pf); }
    pack_acc(pk1, acc, rs0, rs1);
  }
  __syncthreads();
  pk_to_lds(ldsA, pk0, 64 * wave, lane);
  pk_to_lds(ldsA, pk1, 512 + 64 * wave, lane);
  __syncthreads();
#if PROBE == 22
  asm volatile("" : "+v"(lane));
  mem_attn<false>(p, ldsA, tile >> 5, wave, lane);
#endif
  asm volatile("" : "+v"(lane));
  mem_attn<true>(p, ldsA, tile >> 5, wave, lane);
  __syncthreads();
  {
    float ssq[2] = {0.f, 0.f};
    const bf8* wf = (const bf8*)(ws + OFF_WMO);
    asm volatile("" : "+v"(lane));
    { const unsigned pf = l2_touch(ws + OFF_WPQ, lane);
    gemm_chunk_r<true, true, true, true>(ldsA, wf + 2 * wave * 64, wf + 65536 + 2 * wave * 64, lane, acc, rg, hdst + 64 * wave);
      l2_sink(pf); }
    store_f32_ssq(acc, hdst, 64 * wave, lane, ssq);
    pack_acc(pk0, acc, 1.f, 1.f);
    asm volatile("" : "+v"(lane));
    { const unsigned pf = l2_touch(ws + OFF_WPQ + 1048576, lane);
    gemm_chunk_r<true, true, false, true>(ldsA, wf + 65536 + 2 * wave * 64, (const bf8*)(ws + OFF_WPQ) + 2 * wave * 64, lane, acc, rg, hdst + 512 + 64 * wave);
      l2_sink(pf); }
    store_f32_ssq(acc, hdst, 512 + 64 * wave, lane, ssq);
    pack_acc(pk1, acc, 1.f, 1.f);
    rms_from_partials(red, wave, lane, ssq, rs0, rs1);
  }
  pk_to_lds(ldsA, pk0, 64 * wave, lane);
  pk_to_lds(ldsA, pk1, 512 + 64 * wave, lane);
  __syncthreads();
}
#endif
#define OFF_EG (OFF_LKV + 16 * MiB)

DI unsigned f2ord(float v) { const unsigned u = __float_as_uint(v); return (u & 0x80000000u) ? ~u : (u | 0x80000000u); }
DI float ord2f(unsigned u) { return __uint_as_float((u & 0x80000000u) ? (u ^ 0x80000000u) : ~u); }

#define CEX(a, b) { const unsigned hi_ = max(k[a], k[b]); const unsigned lo_ = min(k[a], k[b]); k[a] = hi_; k[b] = lo_; }
DI void sort16_desc(unsigned (&k)[16]) {
  CEX(0, 1) CEX(2, 3) CEX(0, 2) CEX(1, 3) CEX(1, 2) CEX(4, 5) CEX(6, 7) CEX(4, 6) CEX(5, 7) CEX(5, 6) CEX(0, 4)
  CEX(2, 6) CEX(2, 4) CEX(1, 5) CEX(3, 7) CEX(3, 5) CEX(1, 2) CEX(3, 4) CEX(5, 6) CEX(8, 9) CEX(10, 11) CEX(8, 10)
  CEX(9, 11) CEX(9, 10) CEX(12, 13) CEX(14, 15) CEX(12, 14) CEX(13, 15) CEX(13, 14) CEX(8, 12) CEX(10, 14) CEX(10, 12)
  CEX(9, 13) CEX(11, 15) CEX(11, 13) CEX(9, 10) CEX(11, 12) CEX(13, 14) CEX(0, 8) CEX(4, 12) CEX(4, 8) CEX(2, 10)
  CEX(6, 14) CEX(6, 10) CEX(2, 4) CEX(6, 8) CEX(10, 12) CEX(1, 9) CEX(5, 13) CEX(5, 9) CEX(3, 11) CEX(7, 15) CEX(7, 11)
  CEX(3, 5) CEX(7, 9) CEX(11, 13) CEX(1, 2) CEX(3, 4) CEX(5, 6) CEX(7, 8) CEX(9, 10) CEX(11, 12) CEX(13, 14)
}
DI void merge_top16(unsigned (&t)[16], const unsigned (&u)[16]) {
#pragma unroll
  for (int s = 0; s < 16; ++s) t[s] = max(t[s], u[15 - s]);
#pragma unroll
  for (int d = 8; d > 0; d >>= 1)
#pragma unroll
    for (int i = 0; i < 16; ++i)
      if ((i & d) == 0) {
        const unsigned hi = max(t[i], t[i + d]), lo = min(t[i], t[i + d]);
        t[i] = hi; t[i + d] = lo;
      }
}

DI void ins16(unsigned (&L)[16], unsigned x) {
#pragma unroll
  for (int s = 0; s < 16; ++s) {
    const unsigned hi = max(L[s], x);
    x = min(L[s], x);
    L[s] = hi;
  }
}
DI void merge_halves16(unsigned (&L)[16]) {
  unsigned O[16];
#pragma unroll
  for (int s = 0; s < 16; ++s) O[s] = (unsigned)__shfl_xor((int)L[s], 32);
#pragma unroll
  for (int s = 0; s < 16; ++s) L[s] = max(L[s], O[15 - s]);
#pragma unroll
  for (int d = 8; d > 0; d >>= 1)
#pragma unroll
    for (int i = 0; i < 16; ++i)
      if ((i & d) == 0) {
        const unsigned hi = max(L[i], L[i + d]), lo = min(L[i], L[i + d]);
        L[i] = hi; L[i + d] = lo;
      }
}

DI void peer_top16(const char* ws, const u16* qp, int hp, int tt, int lane, unsigned (&L)[16]) {
  const int r = lane & 31, h = lane >> 5;
  const bf8* sk = (const bf8*)(ws + OFF_SUBK) + (size_t)hp * 4 * 8 * 64 + lane;
  f16v s[4];
#pragma unroll
  for (int mt = 0; mt < 4; ++mt) s[mt] = zero16();
  bf8 qf[8];
#pragma unroll
  for (int ks = 0; ks < 8; ++ks) qf[ks] = *(const bf8*)(qp + (size_t)(32 * tt + r) * 2048 + hp * 128 + 16 * ks + 8 * h);
#pragma unroll
  for (int half = 0; half < 2; ++half) {
    bf8 kf[4][4];
#pragma unroll
    for (int k4 = 0; k4 < 4; ++k4)
#pragma unroll
      for (int mt = 0; mt < 4; ++mt) kf[k4][mt] = sk[(mt * 8 + 4 * half + k4) * 64];
    __builtin_amdgcn_sched_barrier(0);
#pragma unroll
    for (int k4 = 0; k4 < 4; ++k4)
#pragma unroll
      for (int mt = 0; mt < 4; ++mt) s[mt] = MFMA(kf[k4][mt], qf[4 * half + k4], s[mt]);
    __builtin_amdgcn_sched_barrier(0);
  }
  unsigned K1[16], K2[16], K3[16];
#pragma unroll
  for (int i = 0; i < 16; ++i) {
    L[i] = (f2ord(s[0][i]) & ~127u) | (unsigned)(127 - (crow(i, h)));
    K1[i] = (f2ord(s[1][i]) & ~127u) | (unsigned)(127 - (32 + crow(i, h)));
    K2[i] = (f2ord(s[2][i]) & ~127u) | (unsigned)(127 - (64 + crow(i, h)));
    K3[i] = (f2ord(s[3][i]) & ~127u) | (unsigned)(127 - (96 + crow(i, h)));
  }
  sort16_desc(L); sort16_desc(K1); sort16_desc(K2); sort16_desc(K3);
  merge_top16(L, K1);
  merge_top16(K2, K3);
  merge_top16(L, K2);
  merge_halves16(L);
}

DI void peer_select(const char* ws, const u16* qp, uint2* eg, unsigned char* idxs  , int head,
                    int tt, int lane) {
  const int r = lane & 31, h = lane >> 5;
  unsigned La[16], Lb[16];
  peer_top16(ws, qp, 2 * head, tt, lane, La);
  __builtin_amdgcn_sched_barrier(0);
  peer_top16(ws, qp, 2 * head + 1, tt, lane, Lb);
  __builtin_amdgcn_sched_barrier(0);
  if (h == 0) {
#pragma unroll
    for (int g = 0; g < 4; ++g) {
      unsigned wa = 0, wb = 0;
#pragma unroll
      for (int j = 0; j < 4; ++j) {
        wa |= (127u - (La[4 * g + j] & 127u)) << (8 * j);
        wb |= (127u - (Lb[4 * g + j] & 127u)) << (8 * j);
      }
      *(unsigned*)(idxs + r * 32 + 4 * g) = wa;
      *(unsigned*)(idxs + r * 32 + 16 + 4 * g) = wb;
    }
  }
  float fa[16], fb[16];
#pragma unroll
  for (int i = 0; i < 16; ++i) { fa[i] = ord2f(La[i] & ~127u); fb[i] = ord2f(Lb[i] & ~127u); }
  unsigned C[16];
#pragma unroll
  for (int i = 0; i < 16; ++i) C[i] = (f2ord(fa[0] + fb[i]) & ~255u) | (unsigned)(255 - i);
#define PEER_KEY(a, b) ((f2ord(fa[a] + fb[b]) & ~255u) | (unsigned)(255 - ((a) * 16 + (b))))
  {
    unsigned U[16] = {PEER_KEY(1, 0), PEER_KEY(1, 1), PEER_KEY(1, 2), PEER_KEY(1, 3), PEER_KEY(1, 4), PEER_KEY(1, 5), PEER_KEY(1, 6), PEER_KEY(1, 7),
                      PEER_KEY(2, 0), PEER_KEY(2, 1), PEER_KEY(2, 2), PEER_KEY(2, 3), PEER_KEY(2, 4), PEER_KEY(3, 0), PEER_KEY(3, 1), PEER_KEY(3, 2)};
    sort16_desc(U);
    merge_top16(C, U);
  }
  {
    unsigned U[16] = {PEER_KEY(3, 3), PEER_KEY(4, 0), PEER_KEY(4, 1), PEER_KEY(4, 2), PEER_KEY(5, 0), PEER_KEY(5, 1), PEER_KEY(6, 0), PEER_KEY(6, 1),
                      PEER_KEY(7, 0), PEER_KEY(7, 1), PEER_KEY(8, 0), PEER_KEY(9, 0), PEER_KEY(10, 0), PEER_KEY(11, 0), PEER_KEY(12, 0), PEER_KEY(13, 0)};
    sort16_desc(U);
    merge_top16(C, U);
  }
  ins16(C, PEER_KEY(14, 0));
  ins16(C, PEER_KEY(15, 0));
#undef PEER_KEY
  asm volatile("s_waitcnt lgkmcnt(0)" ::: "memory");
  const float vmax = ord2f(C[0] & ~255u);
  float ex[16], sum = 0.f;
#pragma unroll
  for (int i = 0; i < 16; ++i) { ex[i] = __expf(ord2f(C[i] & ~255u) - vmax); sum += ex[i]; }
  const float inv = 1.0f / sum;
  const unsigned hmask = 0u - (unsigned)h;
#pragma unroll
  for (int i = 0; i < 8; ++i) {
    const unsigned ck = C[i] ^ ((C[i] ^ C[8 + i]) & hmask);
    const unsigned gb = __float_as_uint(ex[i]) ^ ((__float_as_uint(ex[i]) ^ __float_as_uint(ex[8 + i])) & hmask);
    const float g = __uint_as_float(gb) * inv;
    const unsigned code = 255u - (ck & 255u);
    const unsigned ia = idxs[r * 32 + (code >> 4)], ib = idxs[r * 32 + 16 + (code & 15u)];
    eg[(size_t)(32 * tt + r) * 128 + head * 16 + 8 * h + i] = make_uint2(ia * 128u + ib, __float_as_uint(g));
  }
  asm volatile("s_waitcnt lgkmcnt(0)" ::: "memory");
}

DI float wave_sum(float v) {
  v = wave_allsum(v);
  return v;
}

DI void reduce8(const int (&pv)[8], int& s0, int& s1) {
  int q[4], s[2];
#pragma unroll
  for (int m = 0; m < 4; ++m) {
    const auto r = __builtin_amdgcn_permlane32_swap((unsigned)pv[m], (unsigned)pv[m + 4], false, false);
    q[m] = (int)(r[0] + r[1]);
  }
#pragma unroll
  for (int m = 0; m < 2; ++m) {
    const auto r = __builtin_amdgcn_permlane16_swap((unsigned)q[m], (unsigned)q[m + 2], false, false);
    s[m] = (int)(r[0] + r[1]);
  }
#pragma unroll
  for (int m = 0; m < 2; ++m) {
    s[m] += __builtin_amdgcn_update_dpp(0, s[m], 0x128, 0xf, 0xf, false);
    s[m] += __builtin_amdgcn_update_dpp(0, s[m], 0x124, 0xf, 0xf, false);
    s[m] += __builtin_amdgcn_update_dpp(0, s[m], 0x122, 0xf, 0xf, false);
    s[m] += __builtin_amdgcn_update_dpp(0, s[m], 0x121, 0xf, 0xf, false);
  }
  s0 = s[0]; s1 = s[1];
}

DI void peer_quant_x(char* ldsA, int wave, int lane, float (&xdq)[8]) {
#pragma unroll
  for (int i = 0; i < 8; ++i) {
    char* xrow = ldsA + (8 * wave + i) * LDS_ROW;
    const uint4 x0 = *(const uint4*)(xrow + 32 * lane), x1 = *(const uint4*)(xrow + 32 * lane + 16);
    const unsigned xr[8] = {x0.x, x0.y, x0.z, x0.w, x1.x, x1.y, x1.z, x1.w};
    float f[16];
    float am = 0.f;
#pragma unroll
    for (int q = 0; q < 8; ++q) {
#if W8F
      const hf2 hh = __builtin_bit_cast(hf2, xr[q]);
      f[2 * q] = (float)hh[0];
      f[2 * q + 1] = (float)hh[1];
#else
      f[2 * q] = __uint_as_float(xr[q] << 16);
      f[2 * q + 1] = __uint_as_float(xr[q] & 0xffff0000u);
#endif
      am = fmaxf(am, fmaxf(fabsf(f[2 * q]), fabsf(f[2 * q + 1])));
    }
    am = wave_allmax(am);
    const float sc = (am > 0.f) ? 127.0f / am : 0.f;
    unsigned w[4];
#pragma unroll
    for (int q = 0; q < 4; ++q) {
      unsigned pk = 0;
#pragma unroll
      for (int j = 0; j < 4; ++j) pk |= ((unsigned)((int)rintf(f[4 * q + j] * sc)) & 0xffu) << (8 * j);
      w[q] = pk;
    }
    asm volatile("s_waitcnt lgkmcnt(0)" ::: "memory");
    *(uint4*)(xrow + 16 * lane) = make_uint4(w[0], w[1], w[2], w[3]);
    xdq[i] = am * (1.0f / 127.0f);
  }
  asm volatile("s_waitcnt lgkmcnt(0)" ::: "memory");
}

DI void peer_bucket_token(const uint2* egt, unsigned* tmp  , int lane, unsigned& E0, unsigned& E1,
                          unsigned& G0, unsigned& G1) {
  const uint2 a = egt[lane], b = egt[64 + lane];
  const int ba = (int)(a.x >> SWEEP_SH), bb = (int)(b.x >> SWEEP_SH);
  const unsigned long long lt = (1ull << lane) - 1ull;
  int da = 0, db = 0, start = 0;
#pragma unroll
  for (int k = 0; k < SWEEP_NB; ++k) {
    const unsigned long long ma = __ballot(ba == k), mb = __ballot(bb == k);
    const int ca = __popcll(ma), cb = __popcll(mb);
    if (ba == k) da = start + __popcll(ma & lt);
    if (bb == k) db = start + ca + __popcll(mb & lt);
    start += ca + cb;
  }
  const int ia = (da & 1) * 64 + (da >> 3) + 16 * ((da >> 1) & 3);
  const int ib = (db & 1) * 64 + (db >> 3) + 16 * ((db >> 1) & 3);
  tmp[ia] = a.x; tmp[128 + ia] = a.y;
  tmp[ib] = b.x; tmp[128 + ib] = b.y;
  asm volatile("s_waitcnt lgkmcnt(0)" ::: "memory");
  E0 = tmp[lane]; E1 = tmp[64 + lane]; G0 = tmp[128 + lane]; G1 = tmp[192 + lane];
  asm volatile("s_waitcnt lgkmcnt(0)" ::: "memory");
}

template <bool GWRITE = true>
DI void peer_finalize_token(const MKParams& p, float (&acc)[16], size_t tok, int lane) {
  float* orow = p.out + tok * DM + 16 * lane;
  float ss = 0.f;
#pragma unroll
  for (int q = 0; q < 4; ++q) {
    const f4v hv = *(const f4v*)(orow + 4 * q);
#pragma unroll
    for (int j = 0; j < 4; ++j) { acc[4 * q + j] += hv[j]; ss += acc[4 * q + j] * acc[4 * q + j]; }
  }
  ss = wave_sum(ss);
  const float rf = rsqrtf(ss * (1.0f / DM) + EPSV);
#pragma unroll
  for (int q = 0; q < 4; ++q) {
    const f4v gg = *(const f4v*)(p.g_fin + 16 * lane + 4 * q);
    f4v o = {acc[4 * q] * rf * gg[0], acc[4 * q + 1] * rf * gg[1], acc[4 * q + 2] * rf * gg[2], acc[4 * q + 3] * rf * gg[3]};
    if (GWRITE || o[0] == 123.456f) *(f4v*)(orow + 4 * q) = o;
  }
}

DI void peer_usweep(const char* ws, const char* ldsA, int wave, int lane, const unsigned (&E)[8][2], int (&A)[8][2]) {
  const char* PU = ws + OFF_PU + 16 * lane;
#pragma unroll
  for (int i = 0; i < 8; ++i) { A[i][0] = 0; A[i][1] = 0; }
  int jn[8];
#pragma unroll
  for (int i = 0; i < 8; ++i) jn[i] = 0;
#pragma unroll 1
  for (int k = 0; k < SWEEP_NB; ++k) {
#pragma unroll
    for (int i = 0; i < 8; ++i) {
      while (jn[i] < 16 && (__builtin_amdgcn_readlane((int)E[i][0], jn[i]) >> SWEEP_SH) <= k) {
        const int j = jn[i];
        const bool sel = ((lane & 15) == j);
        const uint4 xq = *(const uint4*)(ldsA + (8 * wave + i) * LDS_ROW + 16 * lane);
        uint4 u0[8];
#pragma unroll
        for (int m = 0; m < 8; ++m) {
          const int e = __builtin_amdgcn_readlane((int)E[i][m & 1], j + 16 * (m >> 1));
          u0[m] = *(const uint4*)(PU + (size_t)e * 1024);
        }
        int pv[8];
#pragma unroll
        for (int m = 0; m < 8; ++m) {
          int dsum = __builtin_amdgcn_sdot4((int)u0[m].x, (int)xq.x, 0, false);
          dsum = __builtin_amdgcn_sdot4((int)u0[m].y, (int)xq.y, dsum, false);
          dsum = __builtin_amdgcn_sdot4((int)u0[m].z, (int)xq.z, dsum, false);
          dsum = __builtin_amdgcn_sdot4((int)u0[m].w, (int)xq.w, dsum, false);
          pv[m] = dsum;
        }
        int s0, s1;
        reduce8(pv, s0, s1);
        A[i][0] = sel ? s0 : A[i][0];
        A[i][1] = sel ? s1 : A[i][1];
        jn[i] = j + 1;
      }
    }
  }
}

#ifndef VT
#define VT 8
#endif
template <int T0, bool GWRITE = true>
DI void peer_vsweep(const MKParams& p, int wave, int lane, size_t tok0, const unsigned (&E)[8][2], const unsigned (&WQ)[8],
                    const float (&tsc)[8]) {
  const char* PV = p.ws + OFF_PV + 16 * lane;
  int acc[VT][16];
#pragma unroll
  for (int i = 0; i < VT; ++i)
#pragma unroll
    for (int q = 0; q < 16; ++q) acc[i][q] = 0;
  int jn[VT];
#pragma unroll
  for (int i = 0; i < VT; ++i) jn[i] = 0;
#pragma unroll 1
  for (int k = 0; k < SWEEP_NB; ++k) {
#pragma unroll
    for (int i = 0; i < VT; ++i) {
      while (jn[i] < 16 && (__builtin_amdgcn_readlane((int)E[T0 + i][0], jn[i]) >> SWEEP_SH) <= k) {
        const int j = jn[i];
        uint4 v0[8];
#pragma unroll
        for (int m = 0; m < 8; ++m) {
          const int e = __builtin_amdgcn_readlane((int)E[T0 + i][m & 1], j + 16 * (m >> 1));
          v0[m] = *(const uint4*)(PV + (size_t)e * 1024);
        }
        const int wq0 = __builtin_amdgcn_readlane((int)WQ[T0 + i], j);
        const int wq1 = __builtin_amdgcn_readlane((int)WQ[T0 + i], j + 32);
#pragma unroll
        for (int rq = 0; rq < 2; ++rq) {
          const int wq = rq ? wq1 : wq0;
          const unsigned r0[4] = {v0[4 * rq].x, v0[4 * rq].y, v0[4 * rq].z, v0[4 * rq].w};
          const unsigned r1[4] = {v0[4 * rq + 1].x, v0[4 * rq + 1].y, v0[4 * rq + 1].z, v0[4 * rq + 1].w};
          const unsigned r2[4] = {v0[4 * rq + 2].x, v0[4 * rq + 2].y, v0[4 * rq + 2].z, v0[4 * rq + 2].w};
          const unsigned r3[4] = {v0[4 * rq + 3].x, v0[4 * rq + 3].y, v0[4 * rq + 3].z, v0[4 * rq + 3].w};
#pragma unroll
          for (int q = 0; q < 4; ++q) {
            const unsigned ta = __builtin_amdgcn_perm(r1[q], r0[q], 0x05010400);
            const unsigned tb = __builtin_amdgcn_perm(r1[q], r0[q], 0x07030602);
            const unsigned tc = __builtin_amdgcn_perm(r3[q], r2[q], 0x05010400);
            const unsigned td = __builtin_amdgcn_perm(r3[q], r2[q], 0x07030602);
            acc[i][4 * q] = __builtin_amdgcn_sdot4((int)__builtin_amdgcn_perm(tc, ta, 0x05040100), wq, acc[i][4 * q], false);
            acc[i][4 * q + 1] = __builtin_amdgcn_sdot4((int)__builtin_amdgcn_perm(tc, ta, 0x07060302), wq, acc[i][4 * q + 1], false);
            acc[i][4 * q + 2] = __builtin_amdgcn_sdot4((int)__builtin_amdgcn_perm(td, tb, 0x05040100), wq, acc[i][4 * q + 2], false);
            acc[i][4 * q + 3] = __builtin_amdgcn_sdot4((int)__builtin_amdgcn_perm(td, tb, 0x07060302), wq, acc[i][4 * q + 3], false);
          }
        }
        jn[i] = j + 1;
      }
    }
  }
#pragma unroll
  for (int i = 0; i < VT; ++i) {
    float accf[16];
#pragma unroll
    for (int q = 0; q < 16; ++q) accf[q] = (float)acc[i][q] * tsc[T0 + i];
    peer_finalize_token<GWRITE>(p, accf, tok0 + 8 * wave + T0 + i, lane);
  }
}

DI void phase_d_tile(const MKParams& p, int tile, int wave, int lane, float rs0, float rs1, RingC& rg) {
  asm volatile("" : "+v"(lane));
  char* ws = p.ws;
  char* ldsA = smem;
  float* rs_s = (float*)(smem + LDS_A_BYTES);
  unsigned char* idxs = (unsigned char*)(smem + LDS_A_BYTES + 4096) + wave * 1024;
  u16* qp = (u16*)qp_scratch(ws, blockIdx.x);
  uint2* eg = (uint2*)(ws + OFF_EG + (size_t)blockIdx.x * 65536);
  const size_t tok0 = (size_t)tile * 64;
  if (wave == 0) { if (lane < 32) rs_s[lane] = rs0; else rs_s[lane] = rs1; }
  {
    f16v acc[2][2];
    const bf8* wf = (const bf8*)(ws + OFF_WPQ);
#if PROBE == 17
    for (int rep_ = 0; rep_ < 2; ++rep_)
#endif
#pragma unroll 1
    for (int c = 0; c < 4; ++c) {
      int l2 = lane;
      asm volatile("" : "+v"(l2));
      const int r = l2 & 31, h = l2 >> 5;
#if W8
      {
        const uint4* w8 = (const uint4*)(ws + OFF_WPQ);
        if (c < 3) gemm_chunk_w8<true, false, false, true, true>(ldsA, w8 + (size_t)c * 32768 + 2 * wave * 64, w8 + (size_t)(c + 1) * 32768 + 2 * wave * 64, l2, acc, rg);
        else gemm_chunk_w8<true, false, false, false, true>(ldsA, w8 + (size_t)c * 32768 + 2 * wave * 64, nullptr, l2, acc, rg);
        scale_cols(acc, (const float*)(ws + OFF_CS) + 16384 + 512 * c + 64 * wave, l2);
      }
#else
      if (c == 0) gemm_chunk_r<true, false, false, true>(ldsA, wf + 2 * wave * 64, wf + 65536 + 2 * wave * 64, l2, acc, rg);
      else if (c < 3) gemm_chunk_r<true, false, false, true>(ldsA, wf + (size_t)c * 65536 + 2 * wave * 64, wf + (size_t)(c + 1) * 65536 + 2 * wave * 64, l2, acc, rg);
      else gemm_chunk_r<true, false, false, false>(ldsA, wf + (size_t)c * 65536 + 2 * wave * 64, nullptr, l2, acc, rg);
#endif
#pragma unroll
      for (int ntl = 0; ntl < 2; ++ntl)
#pragma unroll
        for (int tt = 0; tt < 2; ++tt)
#pragma unroll
          for (int g = 0; g < 4; ++g) {
            const float sc = tt ? rs1 : rs0;
            f4v v = {acc[ntl][tt][4 * g] * sc, acc[ntl][tt][4 * g + 1] * sc, acc[ntl][tt][4 * g + 2] * sc, acc[ntl][tt][4 * g + 3] * sc};
            *(bf4*)(qp + (size_t)(32 * tt + r) * 2048 + 512 * c + 64 * wave + 32 * ntl + 8 * g + 4 * h) = cvt4(v);
          }
    }
  }
  __syncthreads();
#if PROBE == 16
  for (int rep_ = 0; rep_ < 2; ++rep_)
#endif
#pragma unroll 1
  for (int tt = 0; tt < 2; ++tt) {
    int l2 = lane;
    asm volatile("" : "+v"(l2));
    peer_select(ws, qp, eg, idxs, wave, tt, l2);
  }
  __syncthreads();
}

template <bool GWRITE = true>
DI void phase_d_gather(const MKParams& p, int tile, int wave, int lane) {
  asm volatile("" : "+v"(lane));
  char* ws = p.ws;
  char* ldsA = smem;
  float* rs_s = (float*)(smem + LDS_A_BYTES);
  unsigned char* idxs = (unsigned char*)(smem + LDS_A_BYTES + 4096) + wave * 1024;
  const uint2* eg = (const uint2*)(ws + OFF_EG + (size_t)blockIdx.x * 65536);
  const size_t tok0 = (size_t)tile * 64;
  {
    int l2 = lane;
    asm volatile("" : "+v"(l2));
    unsigned E[8][2], G[8][2];
#pragma unroll
    for (int i = 0; i < 8; ++i)
      peer_bucket_token(eg + (size_t)(8 * wave + i) * 128, (unsigned*)idxs, l2, E[i][0], E[i][1], G[i][0], G[i][1]);
    float xdq[8];
    peer_quant_x(ldsA, wave, l2, xdq);
    int A[8][2];
#if PROBE == 60
    peer_usweep(ws, ldsA, wave, l2, E, A);
    asm volatile("" :: "v"(A[0][0]), "v"(A[0][1]), "v"(A[1][0]), "v"(A[1][1]), "v"(A[2][0]), "v"(A[2][1]), "v"(A[3][0]), "v"(A[3][1]), "v"(A[4][0]), "v"(A[4][1]), "v"(A[5][0]), "v"(A[5][1]), "v"(A[6][0]), "v"(A[6][1]), "v"(A[7][0]), "v"(A[7][1]));
#endif
    peer_usweep(ws, ldsA, wave, l2, E, A);
    unsigned WQ[8];
    float tsc[8];
#pragma unroll
    for (int i = 0; i < 8; ++i) {
      const float rs = rs_s[8 * wave + i];
      float w[2];
#pragma unroll
      for (int cc = 0; cc < 2; ++cc) {
        const float a = (float)A[i][cc] * (rs * xdq[i]) * ((const float*)(ws + OFF_SU))[E[i][cc]];
        w[cc] = __uint_as_float(G[i][cc]) * 0.5f * a * (1.0f + erff(a * 0.70710678118654752f)) *
                ((const float*)(ws + OFF_SV))[E[i][cc]];
      }
      float wm = fmaxf(fabsf(w[0]), fabsf(w[1]));
      wm = wave_allmax(wm);
      const float sc = (wm > 0.f) ? 127.0f / wm : 0.f;
      tsc[i] = wm * (1.0f / 127.0f);
      const unsigned pr = ((unsigned)((int)rintf(w[0] * sc)) & 0xffu) | (((unsigned)((int)rintf(w[1] * sc)) & 0xffu) << 8);
      const unsigned up = (unsigned)__shfl((int)pr, (l2 + 16) & 63);
      WQ[i] = pr | (up << 16);
    }
    __builtin_amdgcn_sched_barrier(0);
    peer_vsweep<0, GWRITE>(p, wave, l2, tok0, E, WQ, tsc);
#if VT == 4
    __builtin_amdgcn_sched_barrier(0);
    peer_vsweep<4, GWRITE>(p, wave, l2, tok0, E, WQ, tsc);
#endif
  }
}
#ifndef REMAP
#define REMAP 1
#endif
DI int tile_of(int blk, int nblk) { return (REMAP && nblk == 256) ? ((blk & 7) * 32 + (blk >> 3)) : blk; }

__global__ __launch_bounds__(512) void mk(MKParams p) {
  cg::grid_group grid = cg::this_grid();
  const int tid = threadIdx.x;
  const int wave = __builtin_amdgcn_readfirstlane(tid >> 6), lane = tid & 63;
  const int gtid = blockIdx.x * 512 + tid, gthreads = gridDim.x * 512;
  const int gw = blockIdx.x * 8 + wave, nw = gridDim.x * 8;
  unsigned* bar = (unsigned*)(p.ws + OFF_BAR);
#if SETPRIO
  if (wave >= 4) __builtin_amdgcn_s_setprio(SETPRIO);
#endif
  phase_prep(p, gtid, gthreads);
  if (blockIdx.x < 256) load_norm_tile(p.x + (size_t)tile_of(blockIdx.x, gridDim.x) * 64 * DM, smem, wave, lane);
#if FIRST_CG == 1
  if (blockIdx.x == 0 && tid < 16) __hip_atomic_store(bar + tid, 0u, __ATOMIC_RELAXED, __HIP_MEMORY_SCOPE_AGENT);
  grid.sync();
#elif FIRST_CG == 2
  if (p.ws == nullptr) grid.sync();
  grid_barrier(bar, 1u * gridDim.x);
#else
  grid_barrier(bar, 1u * gridDim.x);
#endif
  if (blockIdx.x < 256) { phase_a_tile<true, (TABLES_IN_B == 3)>(p, tile_of(blockIdx.x, gridDim.x), wave, lane); __syncthreads(); gla_g1_tile(p, tile_of(blockIdx.x, gridDim.x), wave, lane); }
  for (int tile = blockIdx.x + gridDim.x; tile < 256; tile += gridDim.x) { phase_a_tile<false, false>(p, tile_of(tile, gridDim.x), wave, lane); __syncthreads(); gla_g1_tile(p, tile_of(tile, gridDim.x), wave, lane); }
#if PROBE == 40
  for (int tile = blockIdx.x; tile < 256; tile += gridDim.x) { phase_a_tile<false, false>(p, tile_of(tile, gridDim.x), wave, lane); __syncthreads(); gla_g1_tile(p, tile_of(tile, gridDim.x), wave, lane); }
#endif
  grid_barrier(bar, (2u - (FIRST_CG == 1)) * gridDim.x);
  {
    const bool kvblk = (gridDim.x == 256) && blockIdx.x >= 64 && blockIdx.x < 192;
    const bool conv_first = CLASS_ORDER && (gridDim.x == 256) && !kvblk;
    if (conv_first) phase_prep_tables_bal(p, blockIdx.x, gridDim.x, wave, lane);
    for (int it = gw; it < 4096; it += nw) sb_item(p, it, lane);
    for (int item = (int)((blockIdx.x + gridDim.x - 64u) % gridDim.x); item < 128; item += gridDim.x) phase_a_memkv(p, item, wave, lane);
    gla_g2(p, gtid, gthreads);
    if (!conv_first) phase_prep_tables_bal(p, blockIdx.x, gridDim.x, wave, lane);
    phase_prep_late(p, gtid, gthreads);
  }
  grid_barrier(bar, (3u - (FIRST_CG == 1)) * gridDim.x);
#if PROBE == 70
  grid_barrier(bar, 3u * gridDim.x); grid_barrier(bar, 4u * gridDim.x); grid_barrier(bar, 5u * gridDim.x); grid_barrier(bar, 6u * gridDim.x);
#endif
  for (int t0 = blockIdx.x; t0 < 256; t0 += gridDim.x) {
    const int tile = tile_of(t0, gridDim.x);
    float rs0, rs1;
    RingC rg;
#if PROBE == 41
    phase_c_tile(p, tile, wave, lane, rs0, rs1, rg);
#endif
    phase_c_tile(p, tile, wave, lane, rs0, rs1, rg);
#if PROBE == 42
    phase_d_tile(p, tile, wave, lane, rs0, rs1, rg);
#endif
    phase_d_tile(p, tile, wave, lane, rs0, rs1, rg);
#if GATHER_ALIGN
    grid_barrier(bar, (4u - (FIRST_CG == 1)) * gridDim.x);
#endif
#if PROBE == 43
    phase_d_gather<false>(p, tile, wave, lane);
#endif
    phase_d_gather<true>(p, tile, wave, lane);
  }
#if FIRST_CG == 0
  grid.sync();
#endif
}
#define MK_LDS (160 * 1024)
extern "C" void kernel_launch(void* const* d_in, const int* in_sizes, int n_in, void* d_out, int out_size, void* d_ws,
                              size_t ws_size, hipStream_t stream) {
  MKParams p{};
  p.x = (const float*)d_in[0]; p.mem = (const float*)d_in[1]; p.g_mix = (const float*)d_in[2];
  p.w_in = (const float*)d_in[3]; p.w_up = (const float*)d_in[4]; p.b_alpha = (const float*)d_in[5];
  p.g_gla = (const float*)d_in[6]; p.w_out = (const float*)d_in[7]; p.g_mq = (const float*)d_in[8];
  p.g_mkv = (const float*)d_in[9]; p.w_mq = (const float*)d_in[10]; p.w_mkv = (const float*)d_in[11];
  p.w_mo = (const float*)d_in[12]; p.g_ffn = (const float*)d_in[13]; p.w_pq = (const float*)d_in[14];
  p.subk = (const float*)d_in[15]; p.pu = (const float*)d_in[16]; p.pv = (const float*)d_in[17];
  p.g_fin = (const float*)d_in[18];
  p.out = (float*)d_out; p.ws = (char*)d_ws;
  float* out = (float*)d_out;
  char* wsb = (char*)d_ws;
  float* ws = (float*)d_ws;
  static int grid_blocks = 0;
  if (!grid_blocks) {
    int dev = 0, cus = 0, per_cu = 0;
    (void)hipGetDevice(&dev);
    (void)hipDeviceGetAttribute(&cus, hipDeviceAttributeMultiprocessorCount, dev);
    (void)hipFuncSetAttribute((const void*)mk, hipFuncAttributeMaxDynamicSharedMemorySize, MK_LDS);
    (void)hipOccupancyMaxActiveBlocksPerMultiprocessor(&per_cu, mk, 512, MK_LDS);
    grid_blocks = cus * per_cu;
    fprintf(stderr, "mk: cus=%d per_cu=%d grid=%d ws=%zu\n", cus, per_cu, grid_blocks, ws_size);
  }
#if FIRST_CG != 1
  (void)hipMemsetAsync((char*)d_ws + OFF_BAR, 0, 64, stream);
#endif
  {
    void* args[] = {(void*)&p};
    hipError_t e = hipLaunchCooperativeKernel((const void*)mk, dim3(grid_blocks), dim3(512), args, MK_LDS, stream);
    if (e != hipSuccess) fprintf(stderr, "coop launch failed: %s grid %d\n", hipGetErrorString(e), grid_blocks);
  }
}
```
